# Optimizing an MI355X kernel written in HIP

```python
import math
import jax, jax.numpy as jnp
from jax import lax
import numpy as np

D_MODEL = 2048
BATCH = 1
SEQ = 16384
DEPTH = 1

DN_HEADS = 8
DN_HEAD_DIM = 128
DN_CHUNK = 64
CONV_WIDTH = 5
SWA_HEADS = 8
SWA_KV_HEADS = 2
SWA_HEAD_DIM = 128
WINDOW = 128
NUM_BUCKETS = 32
MAX_DISTANCE = 128
MEM_TOKENS = 256
MEM_HEADS = 4
MEM_HEAD_DIM = 128
D_FF = -(-8 * D_MODEL // (3 * 256)) * 256
RMS_EPS = 1e-6

DN_QK = DN_HEADS * DN_HEAD_DIM
DN_V = DN_HEADS * DN_HEAD_DIM
SWA_Q = SWA_HEADS * SWA_HEAD_DIM
SWA_KV = SWA_KV_HEADS * SWA_HEAD_DIM
IN_WIDTH = 2 * DN_QK + 2 * DN_V + 4 * DN_HEADS + SWA_Q + 2 * SWA_KV
MIX_WIDTH = DN_V + SWA_Q

kernel_name = "hybrid_deltanet_swa_memory_encoder"


def rmsnorm(x, g):
    xf = x.astype(jnp.float32)
    y = xf * lax.rsqrt(jnp.mean(xf * xf, axis=-1, keepdims=True) + RMS_EPS)
    return (y * g.astype(jnp.float32)).astype(x.dtype)


def l2norm(x):
    return x * lax.rsqrt(jnp.sum(x * x, axis=-1, keepdims=True) + 1e-6)


def split_proj(proj):
    sizes = [DN_QK + DN_QK + DN_V, DN_V, DN_HEADS, DN_HEADS, DN_HEADS, DN_HEADS, SWA_Q, SWA_KV, SWA_KV]
    out, off = [], 0
    for s in sizes:
        out.append(proj[..., off:off + s])
        off += s
    return out


def short_conv(u, w):
    C = u.shape[-1]
    pad = (CONV_WIDTH - 1) // 2
    out = lax.conv_general_dilated(
        u, w[:, None, :].astype(u.dtype), window_strides=(1,), padding=[(pad, pad)],
        dimension_numbers=('NWC', 'WIO', 'NWC'), feature_group_count=C)
    return jax.nn.silu(out)


def chunk_gated_delta(q, k, v, beta, g):
    B, H, S, dk = q.shape
    dv = v.shape[-1]
    C = DN_CHUNK
    N = S // C
    q = q.reshape(B, H, N, C, dk)
    k = k.reshape(B, H, N, C, dk)
    v = v.reshape(B, H, N, C, dv)
    beta = beta.reshape(B, H, N, C)
    g = jnp.cumsum(g.reshape(B, H, N, C), axis=-1)
    tril = jnp.tril(jnp.ones((C, C), dtype=bool))
    tril_strict = jnp.tril(jnp.ones((C, C), dtype=bool), -1)
    decay = jnp.exp(jnp.where(tril, g[..., :, None] - g[..., None, :], -jnp.inf))
    k_beta = k * beta[..., None]
    v_beta = v * beta[..., None]
    m = jnp.where(tril_strict, jnp.einsum('bhncd,bhnsd->bhncs', k_beta, k) * decay, 0.0)
    eye = jnp.eye(C, dtype=q.dtype)
    t_mat = lax.linalg.triangular_solve(eye + m, jnp.broadcast_to(eye, m.shape),
                                        left_side=True, lower=True, unit_diagonal=True)
    u = jnp.einsum('bhncs,bhnsd->bhncd', t_mat, v_beta)
    w = jnp.einsum('bhncs,bhnsd->bhncd', t_mat, k_beta * jnp.exp(g)[..., None])
    a_intra = jnp.einsum('bhncd,bhnsd->bhncs', q, k) * decay
    q_dec = q * jnp.exp(g)[..., None]
    k_dec = k * jnp.exp(g[..., -1:] - g)[..., None]
    g_last = jnp.exp(g[..., -1])

    def step(state, inp):
        q_c, k_c, u_c, w_c, a_c, gl_c = inp
        v_new = u_c - jnp.einsum('bhck,bhkv->bhcv', w_c, state)
        o_c = jnp.einsum('bhck,bhkv->bhcv', q_c, state) + jnp.einsum('bhcs,bhsv->bhcv', a_c, v_new)
        state = state * gl_c[..., None, None] + jnp.einsum('bhck,bhcv->bhkv', k_c, v_new)
        return state, o_c

    xs = tuple(jnp.moveaxis(t, 2, 0) for t in (q_dec, k_dec, u, w, a_intra, g_last))
    s0 = jnp.zeros((B, H, dk, dv), dtype=q.dtype)
    _, o = lax.scan(step, s0, xs)
    return jnp.moveaxis(o, 0, 2).reshape(B, H, S, dv)


def bidir_gated_deltanet(qkv, z, b_f, b_b, a_f, a_b, a_log_f, a_log_b, dt_bias_f, dt_bias_b, norm_g):
    B, S, _ = z.shape
    f32 = jnp.float32
    H, d = DN_HEADS, DN_HEAD_DIM
    qkv = qkv.astype(f32)
    q = l2norm(qkv[..., :DN_QK].reshape(B, S, H, d)) * (d ** -0.5)
    k = l2norm(qkv[..., DN_QK:2 * DN_QK].reshape(B, S, H, d))
    v = qkv[..., 2 * DN_QK:].reshape(B, S, H, d)

    def log_decay(a, a_log, dt_bias):
        return -jnp.exp(a_log.astype(f32)) * jax.nn.softplus(a.astype(f32) + dt_bias.astype(f32))

    to_bhs = lambda t: jnp.moveaxis(t, 2, 1)
    rev = lambda t: jnp.flip(t, axis=2)
    qh, kh, vh = to_bhs(q), to_bhs(k), to_bhs(v)
    beta_f = to_bhs(jax.nn.sigmoid(b_f.astype(f32)))
    beta_b = to_bhs(jax.nn.sigmoid(b_b.astype(f32)))
    g_f = to_bhs(log_decay(a_f, a_log_f, dt_bias_f))
    g_b = to_bhs(log_decay(a_b, a_log_b, dt_bias_b))
    o_fwd = chunk_gated_delta(qh, kh, vh, beta_f, g_f)
    o_bwd = rev(chunk_gated_delta(rev(qh), rev(kh), rev(vh), rev(beta_b), rev(g_b)))
    o = jnp.moveaxis(o_fwd + o_bwd, 1, 2)
    o = rmsnorm(o, norm_g) * jax.nn.silu(z.astype(f32).reshape(B, S, H, d))
    return o.reshape(B, S, DN_V).astype(z.dtype)


def t5_bucket(rel):
    nb = NUM_BUCKETS // 2
    max_exact = nb // 2
    n = jnp.abs(rel)
    large = max_exact + (jnp.log(jnp.maximum(n, max_exact).astype(jnp.float32) / max_exact)
                         / math.log(MAX_DISTANCE / max_exact) * (nb - max_exact)).astype(jnp.int32)
    large = jnp.minimum(large, nb - 1)
    return jnp.where(rel > 0, nb, 0) + jnp.where(n < max_exact, n, large)


def window_rel_bias(rel_bias):
    rel = (jnp.arange(3 * WINDOW)[None, :] - WINDOW) - jnp.arange(WINDOW)[:, None]
    bias = rel_bias.astype(jnp.float32)[t5_bucket(rel)]
    bias = jnp.transpose(bias, (2, 0, 1))
    return bias.reshape(SWA_KV_HEADS, SWA_HEADS // SWA_KV_HEADS, WINDOW, 3 * WINDOW)


def window_gqa(q, k, v, sink, bias):
    B, S, _ = q.shape
    W, d, Hkv = WINDOW, SWA_HEAD_DIM, SWA_KV_HEADS
    G = SWA_HEADS // Hkv
    nb = S // W
    qb = q.reshape(B, nb, W, Hkv, G, d)

    def band(t):
        tp = jnp.pad(t.reshape(B, S, Hkv, d), ((0, 0), (W, W), (0, 0), (0, 0)))
        tp = tp.reshape(B, nb + 2, W, Hkv, d)
        return jnp.concatenate([tp[:, :-2], tp[:, 1:-1], tp[:, 2:]], axis=2)

    kb, vb = band(k), band(v)
    s = jnp.einsum('bnqkgd,bnjkd->bnkgqj', qb, kb).astype(jnp.float32) * (d ** -0.5) + bias
    rel = (jnp.arange(3 * W)[None, :] - W) - jnp.arange(W)[:, None]
    key_pos = jnp.arange(nb)[:, None, None] * W + jnp.arange(3 * W)[None, None, :] - W
    valid = (jnp.abs(rel) <= W)[None] & (key_pos >= 0) & (key_pos < S)
    s = jnp.where(valid[None, :, None, None], s, -jnp.inf)
    sk = sink.astype(jnp.float32).reshape(Hkv, G)[None, None, :, :, None, None]
    mx = jnp.maximum(jnp.max(s, axis=-1, keepdims=True), sk)
    p = jnp.exp(s - mx)
    p = p / (jnp.sum(p, axis=-1, keepdims=True) + jnp.exp(sk - mx))
    o = jnp.einsum('bnkgqj,bnjkd->bnqkgd', p.astype(vb.dtype), vb)
    return o.reshape(B, S, SWA_Q)


def memory_cross_attn(hn, memn, w_q, w_kv, w_o):
    B, S, _ = hn.shape
    M = memn.shape[1]
    q = (hn @ w_q).reshape(B, S, MEM_HEADS, MEM_HEAD_DIM)
    kv = memn @ w_kv
    k = kv[..., :MEM_HEADS * MEM_HEAD_DIM].reshape(B, M, MEM_HEADS, MEM_HEAD_DIM)
    v = kv[..., MEM_HEADS * MEM_HEAD_DIM:].reshape(B, M, MEM_HEADS, MEM_HEAD_DIM)
    s = jnp.einsum('bshd,bmhd->bhsm', q, k).astype(jnp.float32) * (MEM_HEAD_DIM ** -0.5)
    p = jax.nn.softmax(s, axis=-1).astype(v.dtype)
    o = jnp.einsum('bhsm,bmhd->bshd', p, v).reshape(B, S, MEM_HEADS * MEM_HEAD_DIM)
    return o @ w_o


def setup_inputs(seed: int = 0) -> dict:
    key = jax.random.key(seed)
    ks = jax.random.split(key, 24)
    L = DEPTH

    def dense(k, shape, fan_in):
        return jax.random.normal(k, shape, jnp.float32) * (fan_in ** -0.5)

    def gain(k, shape):
        return 1.0 + 0.02 * jax.random.normal(k, shape, jnp.float32)

    def dt_bias(k):
        u = jax.random.uniform(k, (L, DN_HEADS), jnp.float32)
        dt = jnp.exp(u * (math.log(0.1) - math.log(0.001)) + math.log(0.001))
        return dt + jnp.log(-jnp.expm1(-dt))

    def a_log(k):
        return jnp.log(jax.random.uniform(k, (L, DN_HEADS), jnp.float32, minval=1.0, maxval=16.0))

    return {
        "x": jax.random.normal(ks[0], (BATCH, SEQ, D_MODEL), jnp.float32),
        "mem": jax.random.normal(ks[1], (BATCH, MEM_TOKENS, D_MODEL), jnp.float32),
        "norm_mix_g": gain(ks[2], (L, D_MODEL)),
        "w_in": dense(ks[3], (L, D_MODEL, IN_WIDTH), D_MODEL),
        "conv_w": dense(ks[4], (L, CONV_WIDTH, 3 * DN_QK), CONV_WIDTH),
        "a_log_f": a_log(ks[5]),
        "a_log_b": a_log(ks[6]),
        "dt_bias_f": dt_bias(ks[7]),
        "dt_bias_b": dt_bias(ks[8]),
        "dn_norm_g": gain(ks[9], (L, DN_HEAD_DIM)),
        "attn_sink": 0.5 * jax.random.normal(ks[10], (L, SWA_HEADS), jnp.float32),
        "rel_bias": 0.2 * jax.random.normal(ks[11], (NUM_BUCKETS, SWA_HEADS), jnp.float32),
        "w_out": dense(ks[12], (L, MIX_WIDTH, D_MODEL), MIX_WIDTH),
        "norm_x_g": gain(ks[13], (L, D_MODEL)),
        "norm_mem_g": gain(ks[14], (L, D_MODEL)),
        "w_q_mem": dense(ks[15], (L, D_MODEL, MEM_HEADS * MEM_HEAD_DIM), D_MODEL),
        "w_kv_mem": dense(ks[16], (L, D_MODEL, 2 * MEM_HEADS * MEM_HEAD_DIM), D_MODEL),
        "w_o_mem": dense(ks[17], (L, MEM_HEADS * MEM_HEAD_DIM, D_MODEL), MEM_HEADS * MEM_HEAD_DIM),
        "norm_ffn_g": gain(ks[18], (L, D_MODEL)),
        "w_gate": dense(ks[19], (L, D_MODEL, D_FF), D_MODEL),
        "w_up": dense(ks[20], (L, D_MODEL, D_FF), D_MODEL),
        "w_down": dense(ks[21], (L, D_FF, D_MODEL), D_FF),
        "norm_final_g": gain(ks[22], (D_MODEL,)),
    }


def reference(x, mem, norm_mix_g, w_in, conv_w, a_log_f, a_log_b, dt_bias_f, dt_bias_b,
              dn_norm_g, attn_sink, rel_bias, w_out, norm_x_g, norm_mem_g, w_q_mem,
              w_kv_mem, w_o_mem, norm_ffn_g, w_gate, w_up, w_down, norm_final_g):
    bias_win = window_rel_bias(rel_bias)
    h = x
    for l in range(DEPTH):
        n = rmsnorm(h, norm_mix_g[l])
        proj = n @ w_in[l]
        qkv_dn, z_dn, b_f, b_b, a_f, a_b, q_sw, k_sw, v_sw = split_proj(proj)
        qkv_dn = short_conv(qkv_dn, conv_w[l])
        y_dn = bidir_gated_deltanet(qkv_dn, z_dn, b_f, b_b, a_f, a_b, a_log_f[l], a_log_b[l],
                                    dt_bias_f[l], dt_bias_b[l], dn_norm_g[l])
        y_sw = window_gqa(q_sw, k_sw, v_sw, attn_sink[l], bias_win).astype(y_dn.dtype)
        h = h + jnp.concatenate([y_dn, y_sw], axis=-1) @ w_out[l]
        h = h + memory_cross_attn(rmsnorm(h, norm_x_g[l]), rmsnorm(mem, norm_mem_g[l]),
                                  w_q_mem[l], w_kv_mem[l], w_o_mem[l])
        f = rmsnorm(h, norm_ffn_g[l])
        h = h + (jax.nn.silu(f @ w_gate[l]) * (f @ w_up[l])) @ w_down[l]
    return rmsnorm(h, norm_final_g)
```

```cpp
#include <hip/hip_runtime.h>
#include <cstdio>
#include <cstdint>
namespace pg8 {
__device__ __forceinline__ unsigned cvt_pk_bf16(float lo, float hi) { unsigned r; asm volatile("v_cvt_pk_bf16_f32 %0, %1, %2" : "=v"(r) : "v"(lo), "v"(hi)); return r; }
#define PG8_LAS __attribute__((address_space(3)))
typedef unsigned short bf16_t;
typedef short bf16x8 __attribute__((ext_vector_type(8)));
typedef float f32x4 __attribute__((ext_vector_type(4)));
typedef unsigned u32x4 __attribute__((ext_vector_type(4)));
constexpr int BM = 256, BK = 64, HALF = 128, HTB = HALF * BK * 2  , STAGE_BYTES = 8 * HTB, NXCD = 8, WGM = 8;

__host__ __device__ __forceinline__ int lds_byte(int r, int c) { const int st = (r >> 4) * 2 + (c >> 5), rr = r & 15, cc = c & 31, ob = rr * 64 + cc * 2; return st * 1024 + (ob ^ (((ob >> 9) & 1) << 5)); }
__host__ __device__ __forceinline__ void stage_rc(int b, int& R, int& C) { const int st = b / 1024, sb = b % 1024, swz = sb ^ (((sb >> 9) & 1) << 5); R = (st >> 1) * 16 + swz / 64; C = (st & 1) * 32 + (swz % 64) / 2; }
__host__ __device__ __forceinline__ int perm32(int rho) { const int n = rho >> 4, i = rho & 15; return 8 * (i >> 2) + 4 * n + (i & 3); }

struct Unit { int pm, pn; };
struct Gemm { const bf16_t* A; const bf16_t* Bt; int M, N, K; };

struct StaticOrder {
    int nM, nN, nwg, G, c;
    __host__ __device__ void init(int M, int N, int G_, int c_) { nM = M / BM; nN = N / BM; nwg = nM * nN; G = G_; c = c_; }
    __host__ __device__ bool next(int i, Unit& u) const {
        const long L = (long)i * G + c; if (L >= nwg) return false;
        int wgid = (int)L; { const int q = nwg / NXCD, r = nwg % NXCD, xcd = wgid % NXCD, off = wgid / NXCD; wgid = (xcd < r ? xcd * (q + 1) : r * (q + 1) + (xcd - r) * q) + off; }
        const int nig = WGM * nN, gid = wgid / nig, fm = gid * WGM, gsz = (nM - fm) < WGM ? (nM - fm) : WGM;
        u.pm = fm + ((wgid % nig) % gsz); u.pn = (wgid % nig) / gsz; return true;
    }
    __device__ __forceinline__ void a_ready(const Unit&) const {}
    __device__ __forceinline__ void done(const Unit&) const {}
};

template <class Epi, class Sched, bool ALIGN_EPI = false, bool SP2 = false>
__device__ __forceinline__ void gemm_phase(PG8_LAS unsigned char* lds, const Gemm g, const Sched& S, const Epi& E) {
    const int tid = threadIdx.x, wid = __builtin_amdgcn_readfirstlane(tid >> 6), lane = tid & 63, wr = wid >> 2, wc = wid & 3, fr = lane & 15, fq = lane >> 4;
    const int K = g.K, nt = K / BK;
    unsigned voffA[2], voffB[2];
#pragma unroll
    for (int i = 0; i < 2; ++i) { int R, C; stage_rc(tid * 16 + i * 8192, R, C); const int Rb = Epi::PERM ? ((R & ~31) + perm32(R & 31)) : R;
        voffA[i] = (unsigned)(R * K + C) * 2u; voffB[i] = (unsigned)(Rb * K + C) * 2u; }
    const size_t kstep = (size_t)(BK * 2);
    const size_t hstep = (size_t)HALF * K * 2;
    const size_t tstep = 2 * hstep;
    const unsigned ldsw = (unsigned)wid * 1024u;
    const int aoff = lds_byte(wr * 64 + fr, fq * 8), boff = lds_byte(wc * 32 + fr, fq * 8);
#define PG8_SA(b, h) (((b) * 2 + (h)) * HTB)
#define PG8_SB(b, h) ((4 + (b) * 2 + (h)) * HTB)
#define PG8_STAGE(bufoff, gbase, voff) do { _Pragma("unroll") for (int _i = 0; _i < 2; ++_i) \
        __builtin_amdgcn_global_load_lds((const unsigned*)((const char*)(gbase) + (voff)[_i]), (PG8_LAS unsigned*)(lds + (bufoff) + ldsw + _i * 8192), 16, 0, 0); } while (0)
#define PG8_LDA(dst, b, h) do { _Pragma("unroll") for (int m = 0; m < 4; ++m) _Pragma("unroll") for (int k = 0; k < 2; ++k) dst[m][k] = *(const PG8_LAS bf16x8*)(lds + PG8_SA(b, h) + aoff + m * 2048 + k * 1024); } while (0)
#define PG8_LDB(dst, b, h) do { _Pragma("unroll") for (int n = 0; n < 2; ++n) _Pragma("unroll") for (int k = 0; k < 2; ++k) dst[n][k] = *(const PG8_LAS bf16x8*)(lds + PG8_SB(b, h) + boff + n * 2048 + k * 1024); } while (0)
#define PG8_MMA(ai, bj, At, Bt) do { __builtin_amdgcn_s_setprio(1); _Pragma("unroll") for (int m = 0; m < 4; ++m) _Pragma("unroll") for (int n = 0; n < 2; ++n) _Pragma("unroll") for (int k = 0; k < 2; ++k) \
        acc[ai][bj][m][n] = __builtin_amdgcn_mfma_f32_16x16x32_bf16(Bt[n][k], At[m][k], acc[ai][bj][m][n], 0, 0, 0); __builtin_amdgcn_s_setprio(0); } while (0)
#define PG8_WAIT_V(n) asm volatile("s_waitcnt vmcnt(" #n ")" ::: "memory")
#define PG8_WAIT_L(n) asm volatile("s_waitcnt lgkmcnt(" #n ")" ::: "memory")
#define PG8_BAR __builtin_amdgcn_s_barrier()
#define PG8_SCHED __builtin_amdgcn_sched_barrier(0)
    Unit cur, nxt; int ui = 0;
    if (!S.next(0, cur)) return;
    f32x4 acc[2][2][4][2];
#pragma unroll
    for (int a = 0; a < 2; ++a)
#pragma unroll
        for (int b = 0; b < 2; ++b)
#pragma unroll
            for (int m = 0; m < 4; ++m)
#pragma unroll
                for (int n = 0; n < 2; ++n) acc[a][b][m][n] = (f32x4){0.f, 0.f, 0.f, 0.f};
    bf16x8 At[4][2], B0[2][2], B1[2][2];
    const char* cA = (const char*)g.A + (size_t)cur.pm * tstep; const char* cB = (const char*)g.Bt + (size_t)cur.pn * tstep;
    S.a_ready(cur);
    if constexpr (SP2) {
        PG8_STAGE(PG8_SB(0, 0), cB, voffB); PG8_STAGE(PG8_SB(0, 1), cB + hstep, voffB); PG8_STAGE(PG8_SA(0, 0), cA, voffA); PG8_STAGE(PG8_SA(0, 1), cA + hstep, voffA);
        if (wr == 1) PG8_BAR;
        PG8_WAIT_V(2); PG8_BAR;
        PG8_STAGE(PG8_SB(1, 0), cB + kstep, voffB); PG8_STAGE(PG8_SA(1, 0), cA + kstep, voffA); PG8_STAGE(PG8_SB(1, 1), cB + hstep + kstep, voffB);
        PG8_WAIT_V(6); PG8_BAR;
    } else {
        PG8_STAGE(PG8_SB(0, 0), cB, voffB); PG8_STAGE(PG8_SA(0, 0), cA, voffA); PG8_STAGE(PG8_SB(0, 1), cB + hstep, voffB); PG8_STAGE(PG8_SA(0, 1), cA + hstep, voffA);
        if (wr == 1) PG8_BAR;
        PG8_WAIT_V(4); PG8_BAR;
        PG8_STAGE(PG8_SB(1, 0), cB + kstep, voffB); PG8_STAGE(PG8_SA(1, 0), cA + kstep, voffA); PG8_STAGE(PG8_SB(1, 1), cB + hstep + kstep, voffB);
        PG8_WAIT_V(6); PG8_BAR;
    }
    for (;;) {
        const bool has_next = S.next(ui + 1, nxt);
        const char* nA = has_next ? (const char*)g.A + (size_t)nxt.pm * tstep : cA; const char* nB = has_next ? (const char*)g.Bt + (size_t)nxt.pn * tstep : cB;
        for (int t = 0; t < nt; t += 2) {
            const bool last = (t == nt - 2);
            const char* a1 = cA + (size_t)(t + 1) * kstep;
            const char* a2 = last ? nA : cA + (size_t)(t + 2) * kstep; const char* b2 = last ? nB : cB + (size_t)(t + 2) * kstep;
            const char* a3 = a2 + kstep; const char* b3 = b2 + kstep;
            if (last && has_next) S.a_ready(nxt);
            if constexpr (SP2) {
            PG8_LDB(B0, 0, 0); PG8_LDB(B1, 0, 1); PG8_SCHED; PG8_LDA(At, 0, 0); PG8_STAGE(PG8_SA(1, 1), a1 + hstep, voffA);
            PG8_WAIT_V(8); PG8_WAIT_L(0); PG8_BAR; PG8_MMA(0, 0, At, B0); PG8_MMA(0, 1, At, B1); PG8_BAR; PG8_SCHED;
            PG8_LDA(At, 0, 1); PG8_STAGE(PG8_SB(0, 0), b2, voffB); PG8_STAGE(PG8_SB(0, 1), b2 + hstep, voffB); PG8_STAGE(PG8_SA(0, 0), a2, voffA);
            PG8_WAIT_V(8); PG8_WAIT_L(0); PG8_BAR; PG8_MMA(1, 0, At, B0); PG8_MMA(1, 1, At, B1); PG8_BAR; PG8_SCHED;
            PG8_LDB(B0, 1, 0); PG8_LDB(B1, 1, 1); PG8_SCHED; PG8_LDA(At, 1, 0); PG8_STAGE(PG8_SA(0, 1), a2 + hstep, voffA);
            PG8_WAIT_V(8); PG8_WAIT_L(0); PG8_BAR; PG8_MMA(0, 0, At, B0); PG8_MMA(0, 1, At, B1); PG8_BAR; PG8_SCHED;
            PG8_LDA(At, 1, 1); PG8_STAGE(PG8_SB(1, 0), b3, voffB); PG8_STAGE(PG8_SB(1, 1), b3 + hstep, voffB); PG8_STAGE(PG8_SA(1, 0), a3, voffA);
            PG8_WAIT_V(8); PG8_WAIT_L(0); PG8_BAR; PG8_MMA(1, 0, At, B0); PG8_MMA(1, 1, At, B1); PG8_BAR; PG8_SCHED;
            } else {
            PG8_LDB(B0, 0, 0); PG8_SCHED; PG8_LDA(At, 0, 0); PG8_STAGE(PG8_SA(1, 1), a1 + hstep, voffA);
            PG8_WAIT_L(8); PG8_BAR; PG8_WAIT_L(0); PG8_MMA(0, 0, At, B0); PG8_BAR; PG8_SCHED;
            PG8_LDB(B1, 0, 1); PG8_STAGE(PG8_SB(0, 0), b2, voffB);
            PG8_BAR; PG8_WAIT_L(0); PG8_MMA(0, 1, At, B1); PG8_BAR;
            PG8_LDA(At, 0, 1); PG8_STAGE(PG8_SA(0, 0), a2, voffA);
            PG8_BAR; PG8_WAIT_L(0); PG8_MMA(1, 0, At, B0); PG8_BAR; PG8_SCHED;
            PG8_STAGE(PG8_SB(0, 1), b2 + hstep, voffB);
            PG8_WAIT_V(6); PG8_BAR; PG8_MMA(1, 1, At, B1); PG8_BAR;
            PG8_LDB(B0, 1, 0); PG8_SCHED; PG8_LDA(At, 1, 0); PG8_STAGE(PG8_SA(0, 1), a2 + hstep, voffA);
            PG8_WAIT_L(8); PG8_BAR; PG8_WAIT_L(0); PG8_MMA(0, 0, At, B0); PG8_BAR; PG8_SCHED;
            PG8_LDB(B1, 1, 1); PG8_STAGE(PG8_SB(1, 0), b3, voffB);
            PG8_BAR; PG8_WAIT_L(0); PG8_MMA(0, 1, At, B1); PG8_BAR;
            PG8_LDA(At, 1, 1); PG8_STAGE(PG8_SA(1, 0), a3, voffA);
            PG8_BAR; PG8_WAIT_L(0); PG8_MMA(1, 0, At, B0); PG8_BAR; PG8_SCHED;
            PG8_STAGE(PG8_SB(1, 1), b3 + hstep, voffB);
            PG8_WAIT_V(6); PG8_BAR; PG8_MMA(1, 1, At, B1); PG8_BAR;
            }
        }
        if constexpr (ALIGN_EPI) { if (wr == 0) PG8_BAR; }
        if constexpr (!Epi::AFTER_DRAIN) { E(acc, cur, wr, wc, fr, fq); S.done(cur); }
        if (!has_next) break;
#pragma unroll
        for (int a = 0; a < 2; ++a)
#pragma unroll
            for (int b = 0; b < 2; ++b)
#pragma unroll
                for (int m = 0; m < 4; ++m)
#pragma unroll
                    for (int n = 0; n < 2; ++n) acc[a][b][m][n] = (f32x4){0.f, 0.f, 0.f, 0.f};
        cur = nxt; cA = nA; cB = nB; ++ui;
        if constexpr (ALIGN_EPI) { if (wr == 1) PG8_BAR; }
    }
    PG8_WAIT_V(0);
    if constexpr (!ALIGN_EPI) { if (wr == 0) PG8_BAR; }
    PG8_BAR;
    if constexpr (Epi::AFTER_DRAIN) { E.fused(acc, cur, wr, wc, fr, fq, lds, wid, lane); S.done(cur); }
#undef PG8_SA
#undef PG8_SB
#undef PG8_STAGE
#undef PG8_LDA
#undef PG8_LDB
#undef PG8_MMA
#undef PG8_WAIT_V
#undef PG8_WAIT_L
#undef PG8_BAR
#undef PG8_SCHED
}
}

constexpr int NWAVES = 8;
constexpr int SEQ = 16384, DM = 2048, NIN = 5664, NINP = 5888, DFF = 5632;
constexpr int DNH = 8, HD = 128, SWH = 8, MEMH = 4, MEMT = 256;
constexpr float RMS_EPS = 1e-6f;
constexpr float LOG2E = 1.4426950408889634f;
constexpr float QSCALE = 0.08838834764831845f * 1.4426950408889634f;

constexpr size_t MiB = 1u << 20;
constexpr size_t WS_CTL = 0, CTL_ZERO_BYTES = 1 * MiB;
constexpr size_t CTL_SUMSQ2 = 256 * 1024, CTL_SUMSQ3 = 320 * 1024, CTL_SUMSQ4 = 384 * 1024;
constexpr size_t WS_RSTD1 = 1 * MiB, WS_RSTDM = 1 * MiB + 64 * 1024;
constexpr size_t WS_MEMB = 2 * MiB, WS_KVM = 3 * MiB, WS_AB = 4 * MiB, WS_BG = 6 * MiB;
constexpr size_t WS_WOUT = 8 * MiB, WS_WQ = 16 * MiB, WS_WKV = 18 * MiB, WS_WO = 22 * MiB, WS_WIN = 24 * MiB;
constexpr size_t WS_XB = 48 * MiB;
constexpr size_t WS_QKV = 112 * MiB;
constexpr size_t WS_OF = 112 * MiB, WS_OB = 144 * MiB, WS_H1B = 112 * MiB, WS_QM = 176 * MiB, WS_OM = 192 * MiB;
constexpr size_t WS_DNX = 208 * MiB;
constexpr size_t WS_WGU = 208 * MiB, WS_WD = 252 * MiB, WS_HID = 274 * MiB, WS_END = 496 * MiB;
constexpr size_t DO_Z = 0, DO_QSW = 32 * MiB, DO_KVSW = 64 * MiB;
constexpr int CW_BAR = 4096;

constexpr int RING_OFF = 0, RING_BYTES = 131072;
constexpr int LDSCTL_OFF = RING_BYTES, MISC_OFF = LDSCTL_OFF + 320;
constexpr int LDS_BYTES = 147456;

#define GAS __attribute__((address_space(1)))
#define LAS __attribute__((address_space(3)))
typedef unsigned short bf16;
typedef unsigned v4u __attribute__((ext_vector_type(4)));
typedef unsigned v2u __attribute__((ext_vector_type(2)));
typedef float f32x4 __attribute__((ext_vector_type(4)));
typedef short bf16x8 __attribute__((ext_vector_type(8)));
typedef short s16x4 __attribute__((ext_vector_type(4)));
typedef GAS unsigned gu32;
#define RLX_AGENT __ATOMIC_RELAXED, __HIP_MEMORY_SCOPE_AGENT
#define LDS_WAIT() asm volatile("s_waitcnt lgkmcnt(0)" ::: "memory")
#define VM_WAIT() asm volatile("s_waitcnt vmcnt(0)" ::: "memory")
__device__ __forceinline__ unsigned f2bf(float f) { unsigned u = __builtin_bit_cast(unsigned, f); return (u + 0x7fffu + ((u >> 16) & 1u)) >> 16; }
__device__ __forceinline__ unsigned pk2(float lo, float hi) { return f2bf(lo) | (f2bf(hi) << 16); }
__device__ __forceinline__ float bf2f(unsigned short b) { return __builtin_bit_cast(float, (unsigned)b << 16); }
__device__ __forceinline__ float bflo(unsigned w) { return __builtin_bit_cast(float, w << 16); }
__device__ __forceinline__ float bfhi(unsigned w) { return __builtin_bit_cast(float, w & 0xffff0000u); }
__device__ __forceinline__ unsigned cvtpk(float lo, float hi) { unsigned r; asm volatile("v_cvt_pk_bf16_f32 %0, %1, %2" : "=v"(r) : "v"(lo), "v"(hi)); return r; }
__device__ __forceinline__ float wave_sum(float v) {
#pragma unroll
    for (int o = 1; o < 64; o <<= 1) v += __shfl_xor(v, o);
    return v;
}
__device__ __forceinline__ float siluf(float x) { return x / (1.0f + __expf(-x)); }
#define XB_TMO      128
#define XB_XCNT(j)  (256  + 64 * (j))
#define XB_XSUB(j)  (1280 + 64 * (j))
#define XB_XGEN(j)  (2304 + 64 * (j))
#define XB_TOP      3328
#define XB_TOPGEN   3392
#define XCD_BAR_WORDS 3456
#define XB_SPIN_CAP (1u << 18)

__device__ __forceinline__ unsigned xb_ld(unsigned* p)              { return __hip_atomic_load(p, __ATOMIC_RELAXED, __HIP_MEMORY_SCOPE_AGENT); }
__device__ __forceinline__ unsigned xb_add(unsigned* p, unsigned v) { return __hip_atomic_fetch_add(p, v, __ATOMIC_RELAXED, __HIP_MEMORY_SCOPE_AGENT); }
__device__ __forceinline__ unsigned xb_xcc_id() { return (unsigned)__builtin_amdgcn_s_getreg((3 << 11) | 20) & 0xFu; }
#define XB_SPIN(cond, bar) do { unsigned _sp = 0; while (cond) { __builtin_amdgcn_s_sleep(1); \
    if ((++_sp & 255u) == 0u) { if (xb_ld(&(bar)[XB_TMO])) break; if (_sp > XB_SPIN_CAP) { atomicAdd(&(bar)[XB_TMO], 1u); break; } } } } while (0)

struct XcdBarrier {
    unsigned* bar; unsigned x;
    volatile LAS unsigned* st;
};

__device__ __forceinline__ XcdBarrier xcd_barrier_post(unsigned* bar, volatile LAS unsigned* st) {
    XcdBarrier b; b.bar = bar; b.x = xb_xcc_id(); b.st = st;
    if (threadIdx.x == 0) (void)xb_add(&bar[XB_XCNT(b.x)], 1u);
    return b;
}
__device__ __forceinline__ void xcd_barrier_complete(unsigned* bar, unsigned x, unsigned& nloc, unsigned& nx) {
    const unsigned G = gridDim.x * gridDim.y * gridDim.z;
    unsigned sum, cnt, mine, sp = 0u;
    for (;;) {
        sum = 0u; cnt = 0u; mine = 0u;
#pragma unroll
        for (unsigned j = 0; j < 16; ++j) { const unsigned c = xb_ld(&bar[XB_XCNT(j)]); sum += c; cnt += (c > 0u) ? 1u : 0u; mine = (j == x) ? c : mine; }
        if (sum == G) break;
        __builtin_amdgcn_s_sleep(1);
        if ((++sp & 255u) == 0u) { if (xb_ld(&bar[XB_TMO])) break; if (sp > XB_SPIN_CAP) { atomicAdd(&bar[XB_TMO], 1u); break; } }
    }
    nloc = mine > 0u ? mine : 1u; nx = cnt > 0u ? cnt : 1u;
}

__device__ __forceinline__ void xcd_barrier(const XcdBarrier& b) {
    asm volatile("s_waitcnt vmcnt(0)" ::: "memory");
    __syncthreads();
    if (threadIdx.x == 0) {
        unsigned* bar = b.bar;
        __builtin_amdgcn_s_waitcnt(0);
        unsigned nloc = b.st[0], nx = b.st[1];
        if (nloc == 0u) { xcd_barrier_complete(bar, b.x, nloc, nx); b.st[0] = nloc; b.st[1] = nx; }
        const unsigned old = xb_add(&bar[XB_XSUB(b.x)], 1u);
        const unsigned gen = old / nloc;
        if (old + 1u == (gen + 1u) * nloc) {
            __builtin_amdgcn_fence(__ATOMIC_RELEASE, "agent");
            asm volatile("s_waitcnt vmcnt(0)" ::: "memory");
            const unsigned og = xb_add(&bar[XB_TOP], 1u);
            const unsigned tg = og / nx;
            if (og + 1u == (tg + 1u) * nx) xb_add(&bar[XB_TOPGEN], 1u);
            else XB_SPIN(xb_ld(&bar[XB_TOPGEN]) == tg, bar);
            __builtin_amdgcn_fence(__ATOMIC_ACQUIRE, "agent");
            xb_add(&bar[XB_XGEN(b.x)], 1u);
            asm volatile("s_waitcnt vmcnt(0)" ::: "memory");
        } else {
            XB_SPIN(xb_ld(&bar[XB_XGEN(b.x)]) == gen, bar);
            __builtin_amdgcn_fence(__ATOMIC_ACQUIRE, "agent");
            asm volatile("s_waitcnt vmcnt(0)" ::: "memory");
        }
    }
    __syncthreads();
}

using pg8::Unit;
__device__ __forceinline__ v4u pack8(f32x4 v0, f32x4 v1) { v4u w; w.x = cvtpk(v0[0], v0[1]); w.y = cvtpk(v0[2], v0[3]); w.z = cvtpk(v1[0], v1[1]); w.w = cvtpk(v1[2], v1[3]); return w; }

struct EpiProj {
    static constexpr bool PERM = true, AFTER_DRAIN = false;
    const float* rstd; bf16* qkv; bf16* z; bf16* qsw; bf16* kvsw; float* ab;
    __device__ __forceinline__ void operator()(const f32x4 (&acc)[2][2][4][2], const Unit& u, int wr, int wc, int fr, int fq) const {
        const int pn = u.pn; bf16* base; int ldc, colt; float sc = 1.f;
        if (pn < 12) { base = qkv; ldc = 3072; colt = pn * 256; }
        else if (pn < 16) { base = z; ldc = 1024; colt = (pn - 12) * 256; }
        else if (pn < 20) { base = qsw; ldc = 1024; colt = (pn - 16) * 256; sc = QSCALE; }
        else if (pn < 22) { base = kvsw; ldc = 512; colt = (pn - 20) * 256; }
        else { base = nullptr; ldc = 0; colt = 0; }
        const int row0 = u.pm * 256 + wr * 64 + fr, col0 = colt + wc * 32 + 8 * fq;
#pragma unroll
        for (int ai = 0; ai < 2; ++ai)
#pragma unroll
            for (int m = 0; m < 4; ++m) {
                const int row = row0 + ai * 128 + m * 16; const float rs = rstd[row] * sc;
                if (base) {
                    bf16* rowp = base + (size_t)row * ldc + col0;
#pragma unroll
                    for (int bj = 0; bj < 2; ++bj) *(v4u*)(rowp + bj * 128) = pack8(acc[ai][bj][m][0] * rs, acc[ai][bj][m][1] * rs);
                } else if (wc == 0) {
                    float* rowp = ab + (size_t)row * 32 + 8 * fq;
                    *(f32x4*)(rowp) = acc[ai][0][m][0] * rs; *(f32x4*)(rowp + 4) = acc[ai][0][m][1] * rs;
                }
            }
    }
};
struct EpiScaleBf16 {
    static constexpr bool PERM = true, AFTER_DRAIN = false;
    const float* rs; int from_sumsq; float sc; bf16* O; int ldc;
    __device__ __forceinline__ void operator()(const f32x4 (&acc)[2][2][4][2], const Unit& u, int wr, int wc, int fr, int fq) const {
        const int row0 = u.pm * 256 + wr * 64 + fr, col0 = u.pn * 256 + wc * 32 + 8 * fq;
#pragma unroll
        for (int ai = 0; ai < 2; ++ai)
#pragma unroll
            for (int m = 0; m < 4; ++m) {
                const int row = row0 + ai * 128 + m * 16; float r = rs[row];
                if (from_sumsq) r = __builtin_amdgcn_rsqf(r * (1.0f / DM) + RMS_EPS);
                r *= sc; bf16* rowp = O + (size_t)row * ldc + col0;
#pragma unroll
                for (int bj = 0; bj < 2; ++bj) *(v4u*)(rowp + bj * 128) = pack8(acc[ai][bj][m][0] * r, acc[ai][bj][m][1] * r);
            }
    }
};
struct EpiRes {
    static constexpr bool PERM = true, AFTER_DRAIN = false;
    const float* res; float* out; bf16* ob; float* sumsq;
    __device__ __forceinline__ void operator()(const f32x4 (&acc)[2][2][4][2], const Unit& u, int wr, int wc, int fr, int fq) const {
        const int row0 = u.pm * 256 + wr * 64 + fr, col0 = u.pn * 256 + wc * 32 + 8 * fq;
#pragma unroll
        for (int ai = 0; ai < 2; ++ai)
#pragma unroll
            for (int m = 0; m < 4; ++m) {
                const int row = row0 + ai * 128 + m * 16; const size_t off = (size_t)row * DM + col0; float ss = 0.f;
#pragma unroll
                for (int bj = 0; bj < 2; ++bj) {
                    const f32x4 r0 = *(const f32x4*)(res + off + bj * 128), r1 = *(const f32x4*)(res + off + bj * 128 + 4);
                    const f32x4 v0 = acc[ai][bj][m][0] + r0, v1 = acc[ai][bj][m][1] + r1;
                    *(f32x4*)(out + off + bj * 128) = v0; *(f32x4*)(out + off + bj * 128 + 4) = v1;
                    if (ob) *(v4u*)(ob + off + bj * 128) = pack8(v0, v1);
                    ss += (v0[0] * v0[0] + v0[1] * v0[1]) + (v0[2] * v0[2] + v0[3] * v0[3]) + (v1[0] * v1[0] + v1[1] * v1[1]) + (v1[2] * v1[2] + v1[3] * v1[3]);
                }
                ss += __shfl_xor(ss, 16); ss += __shfl_xor(ss, 32);
                if (fq == 0) atomicAdd(sumsq + row, ss);
            }
    }
};
struct EpiSwiglu {
    static constexpr bool PERM = true, AFTER_DRAIN = false;
    const float* sumsq; bf16* H;
    __device__ __forceinline__ void operator()(const f32x4 (&acc)[2][2][4][2], const Unit& u, int wr, int wc, int fr, int fq) const {
        const int row0 = u.pm * 256 + wr * 64 + fr, col0 = u.pn * 128 + wc * 32 + 8 * fq;
#pragma unroll
        for (int ai = 0; ai < 2; ++ai)
#pragma unroll
            for (int m = 0; m < 4; ++m) {
                const int row = row0 + ai * 128 + m * 16; const float r = __builtin_amdgcn_rsqf(sumsq[row] * (1.0f / DM) + RMS_EPS);
                f32x4 h[2];
#pragma unroll
                for (int n = 0; n < 2; ++n)
#pragma unroll
                    for (int e = 0; e < 4; ++e) { const float g = acc[ai][0][m][n][e] * r, up = acc[ai][1][m][n][e] * r; h[n][e] = siluf(g) * up; }
                *(v4u*)(H + (size_t)row * DFF + col0) = pack8(h[0], h[1]);
            }
    }
};

struct Frame {
    LAS unsigned char* lds;
    volatile LAS unsigned* MISC;
    gu32* ctl;
    int tid, lane, wave, vcu, G;
    const float* in[23]; float* out; unsigned char* ws;
};
#define WSP(T, off) ((T*)(F.ws + (off)))
#define DOP(T, off) ((T*)((unsigned char*)F.out + (off)))

__device__ __forceinline__ void tr_item(const float* W, int K, int Nsrc, int src_col0, const float* gain, bf16* WT, int dst_row0, int k0, LAS float* scr, int lane) {
#pragma unroll 8
    for (int i = 0; i < 32; ++i) {
        const int kk = 2 * i + (lane >> 5); float v = 0.f;
        if (src_col0 >= 0) { v = W[(size_t)(k0 + kk) * Nsrc + src_col0 + (lane & 31)]; if (gain) v *= gain[k0 + kk]; }
        scr[kk * 33 + (lane & 31)] = v;
    }
    LDS_WAIT(); asm volatile("" ::: "memory");
    const int c = lane & 7;
#pragma unroll
    for (int j = 0; j < 4; ++j) { const int n = (lane >> 3) + 8 * j; const LAS float* s = scr + (8 * c) * 33 + n;
        v4u o; o.x = pk2(s[0 * 33], s[1 * 33]); o.y = pk2(s[2 * 33], s[3 * 33]); o.z = pk2(s[4 * 33], s[5 * 33]); o.w = pk2(s[6 * 33], s[7 * 33]);
        *(GAS v4u*)(WT + (size_t)(dst_row0 + n) * K + k0 + 8 * c) = o; }
    LDS_WAIT(); asm volatile("" ::: "memory");
}
__device__ __forceinline__ int win_src_col(int c) {
    if (c < 4096) return c;
    if (c < 5120) return c - 4096 + 4128;
    if (c < 5376) return c - 5120 + 5152;
    if (c < 5632) return c - 5376 + 5408;
    if (c < 5664) return c - 5632 + 4096;
    return -1;
}
__device__ __forceinline__ void row_to_bf16_rstd(const float* xrow, bf16* orow, float* rstd_out, int lane) {
    const GAS f32x4* xr = (const GAS f32x4*)xrow + lane;
    f32x4 v[8]; float s = 0.f;
#pragma unroll
    for (int j = 0; j < 8; ++j) { v[j] = xr[64 * j]; s += (v[j].x * v[j].x + v[j].y * v[j].y) + (v[j].z * v[j].z + v[j].w * v[j].w); }
    s = wave_sum(s);
    if (lane == 0) *rstd_out = 1.0f / sqrtf(s * (1.0f / DM) + RMS_EPS);
    GAS v2u* o8 = (GAS v2u*)orow + lane;
#pragma unroll
    for (int j = 0; j < 8; ++j) { v2u w; w.x = pk2(v[j].x, v[j].y); w.y = pk2(v[j].z, v[j].w); o8[64 * j] = w; }
}

__device__ __forceinline__ void p0_prologue(Frame& F) {
    LAS float* scr = (LAS float*)(F.lds + RING_OFF + F.wave * 16384);
    const int gw = F.vcu * NWAVES + F.wave, NGW = F.G * NWAVES;
    constexpr int I_IN = 32 * (NINP / 32), I_OUT = 32 * 64, I_Q = 32 * 16, I_KV = 32 * 32, I_O = 8 * 64;
    constexpr int NITEMS = I_IN + I_OUT + I_Q + I_KV + I_O;
    for (int it = gw; it < NITEMS; it += NGW) {
        int r = it;
        if (r < I_IN) { const int nblk = NINP / 32, kb = r / nblk, nb = r % nblk; tr_item(F.in[3], DM, NIN, win_src_col(nb * 32), F.in[2], WSP(bf16, WS_WIN), nb * 32, kb * 64, scr, F.lane); continue; } r -= I_IN;
        if (r < I_OUT) { const int kb = r / 64, nb = r % 64; tr_item(F.in[12], DM, DM, nb * 32, nullptr, WSP(bf16, WS_WOUT), nb * 32, kb * 64, scr, F.lane); continue; } r -= I_OUT;
        if (r < I_Q) { const int kb = r / 16, nb = r % 16; tr_item(F.in[15], DM, 512, nb * 32, F.in[13], WSP(bf16, WS_WQ), nb * 32, kb * 64, scr, F.lane); continue; } r -= I_Q;
        if (r < I_KV) { const int kb = r / 32, nb = r % 32; tr_item(F.in[16], DM, 1024, nb * 32, F.in[14], WSP(bf16, WS_WKV), nb * 32, kb * 64, scr, F.lane); continue; } r -= I_KV;
        { const int kb = r / 64, nb = r % 64; tr_item(F.in[17], 512, DM, nb * 32, nullptr, WSP(bf16, WS_WO), nb * 32, kb * 64, scr, F.lane); }
    }
    for (int m = gw; m < SEQ; m += NGW) row_to_bf16_rstd(F.in[0] + (size_t)m * DM, WSP(bf16, WS_XB) + (size_t)m * DM, WSP(float, WS_RSTD1) + m, F.lane);
    for (int m = gw; m < MEMT; m += NGW) row_to_bf16_rstd(F.in[1] + (size_t)m * DM, WSP(bf16, WS_MEMB) + (size_t)m * DM, WSP(float, WS_RSTDM) + m, F.lane);
}
__device__ __forceinline__ void p4_transposes(Frame& F) {
    LAS float* scr = (LAS float*)(F.lds + RING_OFF + F.wave * 16384);
    const int gw = F.vcu * NWAVES + F.wave, NGW = F.G * NWAVES;
    constexpr int I_GU = 32 * (2 * DFF / 32), I_D = (DFF / 64) * 64;
    for (int it = gw; it < I_GU + I_D; it += NGW) {
        int r = it;
        if (r < I_GU) { const int nblk = 2 * DFF / 32, kb = r / nblk, nb = r % nblk; const int row = nb * 32, t = row / 256, w = row % 256;
            const float* src = (w < 128) ? F.in[19] : F.in[20]; const int sc = 128 * t + (w & 127);
            tr_item(src, DM, DFF, sc, F.in[18], WSP(bf16, WS_WGU), row, kb * 64, scr, F.lane); continue; } r -= I_GU;
        { const int kb = r / 64, nb = r % 64; tr_item(F.in[21], DFF, DM, nb * 32, nullptr, WSP(bf16, WS_WD), nb * 32, kb * 64, scr, F.lane); }
    }
}

__device__ __forceinline__ float softplusf(float x) { return x > 20.f ? x : log1pf(__expf(x)); }
__device__ __forceinline__ void dn_naive_prep(Frame& F) {
    const int gw = F.vcu * NWAVES + F.wave, NGW = F.G * NWAVES, lane = F.lane;
    const bf16* QKV = WSP(bf16, WS_QKV); const float* AB = WSP(float, WS_AB); const float* cw = F.in[4];
    float* QN = WSP(float, WS_DNX); float* KN = QN + (size_t)SEQ * 1024; float* VN = KN + (size_t)SEQ * 1024; float* BG = WSP(float, WS_BG);
    for (int it = gw; it < SEQ * DNH; it += NGW) {
        const int t = it >> 3, h = it & 7, c0 = h * 128 + 2 * lane;
        float o[3][2];
#pragma unroll
        for (int s = 0; s < 3; ++s) {
            float a0 = 0.f, a1 = 0.f;
#pragma unroll
            for (int j = 0; j < 5; ++j) { const int tt = t + j - 2; if (tt >= 0 && tt < SEQ) {
                const unsigned w = *(const unsigned*)(QKV + (size_t)tt * 3072 + s * 1024 + c0);
                a0 += cw[j * 3072 + s * 1024 + c0] * bflo(w); a1 += cw[j * 3072 + s * 1024 + c0 + 1] * bfhi(w); } }
            o[s][0] = siluf(a0); o[s][1] = siluf(a1);
        }
        const float sq = wave_sum(o[0][0] * o[0][0] + o[0][1] * o[0][1]), sk = wave_sum(o[1][0] * o[1][0] + o[1][1] * o[1][1]);
        const float rq = (1.0f / sqrtf(sq + 1e-6f)) * 0.08838834764831845f, rk = 1.0f / sqrtf(sk + 1e-6f);
        const size_t off = (size_t)t * 1024 + c0;
        *(float2*)(QN + off) = make_float2(o[0][0] * rq, o[0][1] * rq); *(float2*)(KN + off) = make_float2(o[1][0] * rk, o[1][1] * rk); *(float2*)(VN + off) = make_float2(o[2][0], o[2][1]);
        if (lane == 0) {
            const float* ab = AB + (size_t)t * 32;
            const float bf = 1.0f / (1.0f + __expf(-ab[h])), bb = 1.0f / (1.0f + __expf(-ab[8 + h]));
            const float gf = -__expf(F.in[5][h]) * softplusf(ab[16 + h] + F.in[7][h]), gb = -__expf(F.in[6][h]) * softplusf(ab[24 + h] + F.in[8][h]);
            *(float4*)(BG + (size_t)it * 4) = make_float4(bf, bb, gf, gb);
        }
    }
}
__device__ __forceinline__ void dn_naive_scan(Frame& F) {
    const int b = blockIdx.x; if (b >= 16) return;
    const int dir = b >> 3, h = b & 7, tid = F.tid, dv = tid & 127, kg = tid >> 7;
    const float* QN = WSP(float, WS_DNX); const float* KN = QN + (size_t)SEQ * 1024; const float* VN = KN + (size_t)SEQ * 1024; const float* BG = WSP(float, WS_BG);
    bf16* O = WSP(bf16, dir ? WS_OB : WS_OF);
    LAS float* sh = (LAS float*)(F.lds + RING_OFF);
    LAS float* ks = sh; LAS float* qs = sh + 128; LAS float* vs = sh + 256; LAS float* sc = sh + 384; LAS float* red = sh + 512; LAS float* red2 = sh + 1024;
    float M[32];
#pragma unroll
    for (int i = 0; i < 32; ++i) M[i] = 0.f;
    for (int step = 0; step < SEQ; ++step) {
        const int t = dir ? (SEQ - 1 - step) : step; const size_t off = (size_t)t * 1024 + h * 128;
        if (tid < 128) ks[tid] = KN[off + tid]; else if (tid < 256) qs[tid - 128] = QN[off + tid - 128]; else if (tid < 384) vs[tid - 256] = VN[off + tid - 256];
        else if (tid == 384) { const float4 bg = *(const float4*)(BG + ((size_t)t * 8 + h) * 4); sc[0] = dir ? bg.y : bg.x; sc[1] = __expf(dir ? bg.w : bg.z); }
        __syncthreads();
        const float beta = sc[0], eg = sc[1]; float r = 0.f;
#pragma unroll
        for (int i = 0; i < 32; ++i) { M[i] *= eg; r += ks[kg * 32 + i] * M[i]; }
        red[kg * 128 + dv] = r;
        __syncthreads();
        const float vn = beta * (vs[dv] - (red[dv] + red[128 + dv] + red[256 + dv] + red[384 + dv])); float op = 0.f;
#pragma unroll
        for (int i = 0; i < 32; ++i) { M[i] += ks[kg * 32 + i] * vn; op += qs[kg * 32 + i] * M[i]; }
        red2[kg * 128 + dv] = op;
        __syncthreads();
        if (kg == 0) O[off + dv] = (bf16)f2bf(red2[dv] + red2[128 + dv] + red2[256 + dv] + red2[384 + dv]);
    }
}
__device__ __forceinline__ void dn_combine(Frame& F) {
    const int gw = F.vcu * NWAVES + F.wave, NGW = F.G * NWAVES, lane = F.lane;
    const bf16* OFp = WSP(bf16, WS_OF); const bf16* OBp = WSP(bf16, WS_OB); const bf16* Z = DOP(bf16, DO_Z); bf16* Y = WSP(bf16, WS_XB); const float* gn = F.in[9];
    for (int t = gw; t < SEQ; t += NGW) {
        const size_t off = (size_t)t * 1024 + 16 * lane;
        const v4u a0 = *(const v4u*)(OFp + off), a1 = *(const v4u*)(OFp + off + 8), b0 = *(const v4u*)(OBp + off), b1 = *(const v4u*)(OBp + off + 8);
        const v4u z0 = *(const v4u*)(Z + off), z1 = *(const v4u*)(Z + off + 8);
        float o[16], zz[16];
#pragma unroll
        for (int i = 0; i < 4; ++i) { o[2 * i] = bflo(a0[i]) + bflo(b0[i]); o[2 * i + 1] = bfhi(a0[i]) + bfhi(b0[i]); o[8 + 2 * i] = bflo(a1[i]) + bflo(b1[i]); o[8 + 2 * i + 1] = bfhi(a1[i]) + bfhi(b1[i]);
            zz[2 * i] = bflo(z0[i]); zz[2 * i + 1] = bfhi(z0[i]); zz[8 + 2 * i] = bflo(z1[i]); zz[8 + 2 * i + 1] = bfhi(z1[i]); }
        float ss = 0.f;
#pragma unroll
        for (int i = 0; i < 16; ++i) ss += o[i] * o[i];
        ss += __shfl_xor(ss, 1); ss += __shfl_xor(ss, 2); ss += __shfl_xor(ss, 4);
        const float rs = 1.0f / sqrtf(ss * (1.0f / 128.0f) + RMS_EPS); const int cb = (16 * lane) & 127;
        float y[16];
#pragma unroll
        for (int i = 0; i < 16; ++i) y[i] = o[i] * rs * gn[cb + i] * siluf(zz[i]);
        v4u w0, w1;
#pragma unroll
        for (int i = 0; i < 4; ++i) { w0[i] = pk2(y[2 * i], y[2 * i + 1]); w1[i] = pk2(y[8 + 2 * i], y[8 + 2 * i + 1]); }
        bf16* yp = Y + (size_t)t * DM + 16 * lane; *(v4u*)yp = w0; *(v4u*)(yp + 8) = w1;
    }
}
__device__ __forceinline__ void final_norm(Frame& F) {
    const int gw = F.vcu * NWAVES + F.wave, NGW = F.G * NWAVES, lane = F.lane;
    const float* ss = (const float*)(F.ws + WS_CTL + CTL_SUMSQ4); const GAS f32x4* g = (const GAS f32x4*)F.in[22] + lane;
    for (int m = gw; m < SEQ; m += NGW) {
        const float r = 1.0f / sqrtf(ss[m] * (1.0f / DM) + RMS_EPS);
        GAS f32x4* o = (GAS f32x4*)(F.out + (size_t)m * DM) + lane;
#pragma unroll
        for (int j = 0; j < 8; ++j) { f32x4 v = o[64 * j]; v = v * r * g[64 * j]; o[64 * j] = v; }
    }
}

__device__ __forceinline__ int t5_bucket(int rel) {
    const int n = rel < 0 ? -rel : rel; int b;
    if (n < 8) b = n; else { int k = (31 - __builtin_clz((unsigned)(n * n))) - 6; b = 8 + k; if (b > 15) b = 15; }
    return (rel > 0 ? 16 : 0) + b;
}
template <int MODE  >
__device__ __forceinline__ void attn_unit(Frame& F, const bf16* Q, int qpitch, const bf16* Kp, const bf16* Vp, int kvpitch, bf16* O, int opitch, int q0, int kt_beg, int kt_end, const LAS float* btab, float sink2) {
    LAS unsigned char* Ks = F.lds + RING_OFF; LAS unsigned char* Vs = Ks + 16384;
    const int lane = F.lane, c = lane & 15, g = lane >> 4, qw0 = q0 + 16 * F.wave, tid = F.tid;
    bf16x8 qf[4];
#pragma unroll
    for (int t = 0; t < 4; ++t) qf[t] = *(const bf16x8*)(Q + (size_t)(qw0 + c) * qpitch + 32 * t + 8 * g);
    f32x4 oacc[8];
#pragma unroll
    for (int i = 0; i < 8; ++i) oacc[i] = (f32x4){0.f, 0.f, 0.f, 0.f};
    float mrun = (MODE == 0) ? sink2 : -1e30f, lsum = (MODE == 0 && g == 0) ? 1.0f : 0.0f;
    for (int kt = kt_beg; kt < kt_end; ++kt) {
        __syncthreads();
#pragma unroll
        for (int i = 0; i < 2; ++i) { const int ci = tid + 512 * i, key = ci >> 4, ch = ci & 15;
            const v4u kv = *(const v4u*)(Kp + (size_t)(64 * kt + key) * kvpitch + ch * 8), vv = *(const v4u*)(Vp + (size_t)(64 * kt + key) * kvpitch + ch * 8);
            *(LAS v4u*)(Ks + key * 256 + ((ch ^ (key & 15)) << 4)) = kv; *(LAS v4u*)(Vs + key * 256 + ((ch ^ ((key & 7) << 1)) << 4)) = vv; }
        __syncthreads();
        bool rel_ok = true;
        if (MODE == 0) rel_ok = (64 * kt <= qw0 + 15 + 128) && (64 * kt + 63 >= qw0 - 128);
        if (!rel_ok) continue;
        f32x4 s[4];
#pragma unroll
        for (int mt = 0; mt < 4; ++mt) s[mt] = (f32x4){0.f, 0.f, 0.f, 0.f};
#pragma unroll
        for (int t = 0; t < 4; ++t)
#pragma unroll
            for (int mt = 0; mt < 4; ++mt) { const bf16x8 kf = *(const LAS bf16x8*)(Ks + (16 * mt + c) * 256 + (((4 * t + g) ^ c) << 4));
                s[mt] = __builtin_amdgcn_mfma_f32_16x16x32_bf16(kf, qf[t], s[mt], 0, 0, 0); }
        float tmax = -INFINITY;
#pragma unroll
        for (int mt = 0; mt < 4; ++mt)
#pragma unroll
            for (int r = 0; r < 4; ++r) {
                if (MODE == 0) { const int rel = (64 * kt + 16 * mt + 4 * g + r) - (qw0 + c); const bool ok = (rel >= -128) && (rel <= 128);
                    const int ri = ok ? rel + 128 : 128; const float bv = btab[ri]; s[mt][r] = ok ? s[mt][r] + bv : -INFINITY; }
                tmax = fmaxf(tmax, s[mt][r]); }
        tmax = fmaxf(tmax, __shfl_xor(tmax, 16)); tmax = fmaxf(tmax, __shfl_xor(tmax, 32));
        const float mnew = fmaxf(mrun, tmax), alpha = __builtin_amdgcn_exp2f(mrun - mnew); mrun = mnew; float ps = 0.f;
#pragma unroll
        for (int mt = 0; mt < 4; ++mt)
#pragma unroll
            for (int r = 0; r < 4; ++r) { const float p = __builtin_amdgcn_exp2f(s[mt][r] - mnew); s[mt][r] = p; ps += p; }
        lsum = lsum * alpha + ps;
#pragma unroll
        for (int i = 0; i < 8; ++i) oacc[i] = oacc[i] * alpha;
        bf16x8 pf[2];
#pragma unroll
        for (int t2 = 0; t2 < 2; ++t2) { v4u w; w.x = cvtpk(s[2 * t2][0], s[2 * t2][1]); w.y = cvtpk(s[2 * t2][2], s[2 * t2][3]); w.z = cvtpk(s[2 * t2 + 1][0], s[2 * t2 + 1][1]); w.w = cvtpk(s[2 * t2 + 1][2], s[2 * t2 + 1][3]);
            pf[t2] = __builtin_bit_cast(bf16x8, w); }
        const int q4 = c >> 2, p4 = c & 3;
#pragma unroll
        for (int t2 = 0; t2 < 2; ++t2)
#pragma unroll
            for (int mo = 0; mo < 8; ++mo) {
                const int k1 = 32 * t2 + 4 * g + q4, k2 = k1 + 16, chn = 2 * mo + (p4 >> 1);
                const s16x4 lo = __builtin_bit_cast(s16x4, __builtin_amdgcn_ds_read_tr16_b64_v4i16((LAS s16x4*)(Vs + k1 * 256 + ((chn ^ ((k1 & 7) << 1)) << 4) + (p4 & 1) * 8)));
                const s16x4 hi = __builtin_bit_cast(s16x4, __builtin_amdgcn_ds_read_tr16_b64_v4i16((LAS s16x4*)(Vs + k2 * 256 + ((chn ^ ((k2 & 7) << 1)) << 4) + (p4 & 1) * 8)));
                const bf16x8 vf = (bf16x8){lo[0], lo[1], lo[2], lo[3], hi[0], hi[1], hi[2], hi[3]};
                oacc[mo] = __builtin_amdgcn_mfma_f32_16x16x32_bf16(vf, pf[t2], oacc[mo], 0, 0, 0); }
    }
    lsum += __shfl_xor(lsum, 16); lsum += __shfl_xor(lsum, 32);
    const float inv = 1.0f / lsum;
#pragma unroll
    for (int mo = 0; mo < 8; ++mo) { v2u w; w.x = cvtpk(oacc[mo][0] * inv, oacc[mo][1] * inv); w.y = cvtpk(oacc[mo][2] * inv, oacc[mo][3] * inv);
        *(v2u*)(O + (size_t)(qw0 + c) * opitch + 16 * mo + 4 * g) = w; }
}
__device__ __forceinline__ void swa_phase(Frame& F) {
    LAS float* btab = (LAS float*)(F.lds + RING_OFF + 32768);
    const bf16* QS = DOP(bf16, DO_QSW); const bf16* KV = DOP(bf16, DO_KVSW); bf16* Y = WSP(bf16, WS_XB);
    for (int u = blockIdx.x; u < SWH * (SEQ / 128); u += F.G) {
        const int h = u & 7, qb = u >> 3, kvh = h >> 2;
        __syncthreads();
        if (F.tid < 257) btab[F.tid] = F.in[11][t5_bucket(F.tid - 128) * 8 + h] * LOG2E;
        __syncthreads();
        int kb = 2 * qb - 2, ke = 2 * qb + 4; if (kb < 0) kb = 0; if (ke > SEQ / 64) ke = SEQ / 64;
        attn_unit<0>(F, QS + h * 128, 1024, KV + kvh * 128, KV + 256 + kvh * 128, 512, Y + 1024 + h * 128, DM, qb * 128, kb, ke, btab, F.in[10][h] * LOG2E);
    }
}
__device__ __forceinline__ void mem_attn_phase(Frame& F) {
    const bf16* QM = WSP(bf16, WS_QM); const bf16* KVm = WSP(bf16, WS_KVM); bf16* OM = WSP(bf16, WS_OM);
    for (int u = blockIdx.x; u < MEMH * (SEQ / 128); u += F.G) {
        const int h = u & 3, qb = u >> 2;
        attn_unit<1>(F, QM + h * 128, 512, KVm + h * 128, KVm + 512 + h * 128, 1024, OM + h * 128, 512, qb * 128, 0, 4, nullptr, 0.f);
    }
}

#ifndef MK_N_LAUNCHES
#define MK_N_LAUNCHES 12
#endif
constexpr int N_PHASES = 12;
struct Args { const float* in[23]; float* out; unsigned char* ws; int ph_lo, ph_hi; };
static_assert(sizeof(Args) == 23 * 8 + 8 + 8 + 8, "Args has no padding");

__global__ void __launch_bounds__(NWAVES * 64, 2) enc_fwd(Args args) {
    extern __shared__ __attribute__((aligned(16))) unsigned char lds[];
    Frame F;
    F.lds = (LAS unsigned char*)lds;
    F.MISC = (volatile LAS unsigned*)(F.lds + MISC_OFF);
    F.tid = threadIdx.x; F.lane = F.tid & 63; F.wave = __builtin_amdgcn_readfirstlane(F.tid >> 6);
    F.G = gridDim.x; { const int bx = blockIdx.x; F.vcu = (F.G % 8 == 0) ? (bx % 8) * (F.G / 8) + bx / 8 : bx; }
#pragma unroll
    for (int i = 0; i < 23; ++i) F.in[i] = args.in[i];
    F.out = args.out; F.ws = args.ws; F.ctl = (gu32*)(args.ws + WS_CTL);
    for (int u = F.tid; u < (LDS_BYTES - LDSCTL_OFF) / 4; u += NWAVES * 64) ((LAS unsigned*)(F.lds + LDSCTL_OFF))[u] = 0u;
    __syncthreads();
    const int lo = args.ph_lo, hi = args.ph_hi;
    XcdBarrier bar; bar.bar = (unsigned*)(F.ctl + CW_BAR); bar.x = 0; bar.st = nullptr;
    if (hi - lo > 1) bar = xcd_barrier_post((unsigned*)(F.ctl + CW_BAR), F.MISC + 8);
#define IN(k) (lo <= (k) && (k) < hi)
#define SEAM(k) do { if (IN(k) && IN((k) + 1)) xcd_barrier(bar); } while (0)
    float* sumsq2 = (float*)(F.ws + WS_CTL + CTL_SUMSQ2); float* sumsq3 = (float*)(F.ws + WS_CTL + CTL_SUMSQ3); float* sumsq4 = (float*)(F.ws + WS_CTL + CTL_SUMSQ4);

    if (IN(0)) { p0_prologue(F); } SEAM(0);
    if (IN(1)) {
        { pg8::Gemm g{WSP(bf16, WS_XB), WSP(bf16, WS_WIN), SEQ, NINP, DM}; pg8::StaticOrder S; S.init(SEQ, NINP, F.G, (int)blockIdx.x);
          EpiProj E{WSP(float, WS_RSTD1), WSP(bf16, WS_QKV), DOP(bf16, DO_Z), DOP(bf16, DO_QSW), DOP(bf16, DO_KVSW), WSP(float, WS_AB)};
          pg8::gemm_phase<EpiProj, pg8::StaticOrder, true, true>(F.lds + RING_OFF, g, S, E); }
        { pg8::Gemm g{WSP(bf16, WS_MEMB), WSP(bf16, WS_WKV), MEMT, 1024, DM}; pg8::StaticOrder S; S.init(MEMT, 1024, F.G, (int)blockIdx.x);
          EpiScaleBf16 E{WSP(float, WS_RSTDM), 0, 1.0f, WSP(bf16, WS_KVM), 1024};
          pg8::gemm_phase<EpiScaleBf16, pg8::StaticOrder, true, true>(F.lds + RING_OFF, g, S, E); }
    } SEAM(1);
    if (IN(2)) { dn_naive_prep(F); swa_phase(F); } SEAM(2);
    if (IN(3)) { dn_naive_scan(F); } SEAM(3);
    if (IN(4)) { dn_combine(F); p4_transposes(F); } SEAM(4);
    if (IN(5)) {
        pg8::Gemm g{WSP(bf16, WS_XB), WSP(bf16, WS_WOUT), SEQ, DM, DM}; pg8::StaticOrder S; S.init(SEQ, DM, F.G, (int)blockIdx.x);
        EpiRes E{F.in[0], F.out, WSP(bf16, WS_H1B), sumsq2};
        pg8::gemm_phase<EpiRes, pg8::StaticOrder, true, true>(F.lds + RING_OFF, g, S, E);
    } SEAM(5);
    if (IN(6)) {
        pg8::Gemm g{WSP(bf16, WS_H1B), WSP(bf16, WS_WQ), SEQ, 512, DM}; pg8::StaticOrder S; S.init(SEQ, 512, F.G, (int)blockIdx.x);
        EpiScaleBf16 E{sumsq2, 1, QSCALE, WSP(bf16, WS_QM), 512};
        pg8::gemm_phase<EpiScaleBf16, pg8::StaticOrder, true, true>(F.lds + RING_OFF, g, S, E);
    } SEAM(6);
    if (IN(7)) { mem_attn_phase(F); } SEAM(7);
    if (IN(8)) {
        pg8::Gemm g{WSP(bf16, WS_OM), WSP(bf16, WS_WO), SEQ, DM, 512}; pg8::StaticOrder S; S.init(SEQ, DM, F.G, (int)blockIdx.x);
        EpiRes E{F.out, F.out, WSP(bf16, WS_XB), sumsq3};
        pg8::gemm_phase<EpiRes, pg8::StaticOrder, true, true>(F.lds + RING_OFF, g, S, E);
    } SEAM(8);
    if (IN(9)) {
        pg8::Gemm g{WSP(bf16, WS_XB), WSP(bf16, WS_WGU), SEQ, 2 * DFF, DM}; pg8::StaticOrder S; S.init(SEQ, 2 * DFF, F.G, (int)blockIdx.x);
        EpiSwiglu E{sumsq3, WSP(bf16, WS_HID)};
        pg8::gemm_phase<EpiSwiglu, pg8::StaticOrder, true, true>(F.lds + RING_OFF, g, S, E);
    } SEAM(9);
    if (IN(10)) {
        pg8::Gemm g{WSP(bf16, WS_HID), WSP(bf16, WS_WD), SEQ, DM, DFF}; pg8::StaticOrder S; S.init(SEQ, DM, F.G, (int)blockIdx.x);
        EpiRes E{F.out, F.out, nullptr, sumsq4};
        pg8::gemm_phase<EpiRes, pg8::StaticOrder, true, true>(F.lds + RING_OFF, g, S, E);
    } SEAM(10);
    if (IN(11)) { final_norm(F); }
#undef IN
#undef SEAM
}

extern "C" void kernel_launch(void* const* d_in, const int* in_sizes, int n_in, void* d_out, int out_size, void* d_ws, size_t ws_size, hipStream_t stream) {
    static int grid = 0;
    if (grid == 0) {
        if (n_in != 23 || out_size != SEQ * DM || ws_size < WS_END) { fprintf(stderr, "kernel_launch: unexpected shapes (n_in %d out %d ws %zu)\n", n_in, out_size, ws_size); grid = -1; return; }
        int dev = 0, cus = 0;
        if (hipGetDevice(&dev) != hipSuccess || hipDeviceGetAttribute(&cus, hipDeviceAttributeMultiprocessorCount, dev) != hipSuccess) { grid = -1; return; }
        if (hipFuncSetAttribute((const void*)enc_fwd, hipFuncAttributeMaxDynamicSharedMemorySize, LDS_BYTES) != hipSuccess) { fprintf(stderr, "kernel_launch: hipFuncSetAttribute failed\n"); grid = -1; return; }
        (void)hipGetLastError();
        grid = cus;
    }
    if (grid < 0) return;
    if (hipMemsetAsync((char*)d_ws + WS_CTL, 0, CTL_ZERO_BYTES, stream) != hipSuccess) return;
    Args a{};
    for (int i = 0; i < 23; ++i) a.in[i] = (const float*)d_in[i];
    a.out = (float*)d_out; a.ws = (unsigned char*)d_ws;
    const int per = (N_PHASES + MK_N_LAUNCHES - 1) / MK_N_LAUNCHES;
    for (int lo = 0; lo < N_PHASES; lo += per) {
        a.ph_lo = lo; a.ph_hi = (lo + per < N_PHASES) ? lo + per : N_PHASES;
        hipLaunchKernelGGL(enc_fwd, dim3(grid), dim3(NWAVES * 64), LDS_BYTES, stream, a);
    }
}
```

```cpp
#include <hip/hip_runtime.h>
#include <cstdio>
#include <cstdint>
namespace pg8 {
__device__ __forceinline__ unsigned cvt_pk_bf16(float lo, float hi) { unsigned r; asm volatile("v_cvt_pk_bf16_f32 %0, %1, %2" : "=v"(r) : "v"(lo), "v"(hi)); return r; }
#define PG8_LAS __attribute__((address_space(3)))
typedef unsigned short bf16_t;
typedef short bf16x8 __attribute__((ext_vector_type(8)));
typedef float f32x4 __attribute__((ext_vector_type(4)));
typedef unsigned u32x4 __attribute__((ext_vector_type(4)));
constexpr int BM = 256, BK = 64, HALF = 128, HTB = HALF * BK * 2  , STAGE_BYTES = 8 * HTB, NXCD = 8, WGM = 8;

__host__ __device__ __forceinline__ int lds_byte(int r, int c) { const int st = (r >> 4) * 2 + (c >> 5), rr = r & 15, cc = c & 31, ob = rr * 64 + cc * 2; return st * 1024 + (ob ^ (((ob >> 9) & 1) << 5)); }
__host__ __device__ __forceinline__ void stage_rc(int b, int& R, int& C) { const int st = b / 1024, sb = b % 1024, swz = sb ^ (((sb >> 9) & 1) << 5); R = (st >> 1) * 16 + swz / 64; C = (st & 1) * 32 + (swz % 64) / 2; }
__host__ __device__ __forceinline__ int perm32(int rho) { const int n = rho >> 4, i = rho & 15; return 8 * (i >> 2) + 4 * n + (i & 3); }

struct Unit { int pm, pn; };
struct Gemm { const bf16_t* A; const bf16_t* Bt; int M, N, K; };

struct StaticOrder {
    int nM, nN, nwg, G, c;
    __host__ __device__ void init(int M, int N, int G_, int c_) { nM = M / BM; nN = N / BM; nwg = nM * nN; G = G_; c = c_; }
    __host__ __device__ bool next(int i, Unit& u) const {
        const long L = (long)i * G + c; if (L >= nwg) return false;
        int wgid = (int)L; { const int q = nwg / NXCD, r = nwg % NXCD, xcd = wgid % NXCD, off = wgid / NXCD; wgid = (xcd < r ? xcd * (q + 1) : r * (q + 1) + (xcd - r) * q) + off; }
        const int nig = WGM * nN, gid = wgid / nig, fm = gid * WGM, gsz = (nM - fm) < WGM ? (nM - fm) : WGM;
        u.pm = fm + ((wgid % nig) % gsz); u.pn = (wgid % nig) / gsz; return true;
    }
    __device__ __forceinline__ void a_ready(const Unit&) const {}
    __device__ __forceinline__ void done(const Unit&) const {}
};

template <class Epi, class Sched, bool ALIGN_EPI = false, bool SP2 = false>
__device__ __forceinline__ void gemm_phase(PG8_LAS unsigned char* lds, const Gemm g, const Sched& S, const Epi& E) {
    const int tid = threadIdx.x, wid = __builtin_amdgcn_readfirstlane(tid >> 6), lane = tid & 63, wr = wid >> 2, wc = wid & 3, fr = lane & 15, fq = lane >> 4;
    const int K = g.K, nt = K / BK;
    unsigned voffA[2], voffB[2];
#pragma unroll
    for (int i = 0; i < 2; ++i) { int R, C; stage_rc(tid * 16 + i * 8192, R, C); const int Rb = Epi::PERM ? ((R & ~31) + perm32(R & 31)) : R;
        voffA[i] = (unsigned)(R * K + C) * 2u; voffB[i] = (unsigned)(Rb * K + C) * 2u; }
    const size_t kstep = (size_t)(BK * 2);
    const size_t hstep = (size_t)HALF * K * 2;
    const size_t tstep = 2 * hstep;
    const unsigned ldsw = (unsigned)wid * 1024u;
    const int aoff = lds_byte(wr * 64 + fr, fq * 8), boff = lds_byte(wc * 32 + fr, fq * 8);
#define PG8_SA(b, h) (((b) * 2 + (h)) * HTB)
#define PG8_SB(b, h) ((4 + (b) * 2 + (h)) * HTB)
#define PG8_STAGE(bufoff, gbase, voff) do { _Pragma("unroll") for (int _i = 0; _i < 2; ++_i) \
        __builtin_amdgcn_global_load_lds((const unsigned*)((const char*)(gbase) + (voff)[_i]), (PG8_LAS unsigned*)(lds + (bufoff) + ldsw + _i * 8192), 16, 0, 0); } while (0)
#define PG8_LDA(dst, b, h) do { _Pragma("unroll") for (int m = 0; m < 4; ++m) _Pragma("unroll") for (int k = 0; k < 2; ++k) dst[m][k] = *(const PG8_LAS bf16x8*)(lds + PG8_SA(b, h) + aoff + m * 2048 + k * 1024); } while (0)
#define PG8_LDB(dst, b, h) do { _Pragma("unroll") for (int n = 0; n < 2; ++n) _Pragma("unroll") for (int k = 0; k < 2; ++k) dst[n][k] = *(const PG8_LAS bf16x8*)(lds + PG8_SB(b, h) + boff + n * 2048 + k * 1024); } while (0)
#define PG8_MMA(ai, bj, At, Bt) do { __builtin_amdgcn_s_setprio(1); _Pragma("unroll") for (int m = 0; m < 4; ++m) _Pragma("unroll") for (int n = 0; n < 2; ++n) _Pragma("unroll") for (int k = 0; k < 2; ++k) \
        acc[ai][bj][m][n] = __builtin_amdgcn_mfma_f32_16x16x32_bf16(Bt[n][k], At[m][k], acc[ai][bj][m][n], 0, 0, 0); __builtin_amdgcn_s_setprio(0); } while (0)
#define PG8_WAIT_V(n) asm volatile("s_waitcnt vmcnt(" #n ")" ::: "memory")
#define PG8_WAIT_L(n) asm volatile("s_waitcnt lgkmcnt(" #n ")" ::: "memory")
#define PG8_BAR __builtin_amdgcn_s_barrier()
#define PG8_SCHED __builtin_amdgcn_sched_barrier(0)
    Unit cur, nxt; int ui = 0;
    if (!S.next(0, cur)) return;
    f32x4 acc[2][2][4][2];
#pragma unroll
    for (int a = 0; a < 2; ++a)
#pragma unroll
        for (int b = 0; b < 2; ++b)
#pragma unroll
            for (int m = 0; m < 4; ++m)
#pragma unroll
                for (int n = 0; n < 2; ++n) acc[a][b][m][n] = (f32x4){0.f, 0.f, 0.f, 0.f};
    bf16x8 At[4][2], B0[2][2], B1[2][2];
    const char* cA = (const char*)g.A + (size_t)cur.pm * tstep; const char* cB = (const char*)g.Bt + (size_t)cur.pn * tstep;
    S.a_ready(cur);
    if constexpr (SP2) {
        PG8_STAGE(PG8_SB(0, 0), cB, voffB); PG8_STAGE(PG8_SB(0, 1), cB + hstep, voffB); PG8_STAGE(PG8_SA(0, 0), cA, voffA); PG8_STAGE(PG8_SA(0, 1), cA + hstep, voffA);
        if (wr == 1) PG8_BAR;
        PG8_WAIT_V(2); PG8_BAR;
        PG8_STAGE(PG8_SB(1, 0), cB + kstep, voffB); PG8_STAGE(PG8_SA(1, 0), cA + kstep, voffA); PG8_STAGE(PG8_SB(1, 1), cB + hstep + kstep, voffB);
        PG8_WAIT_V(6); PG8_BAR;
    } else {
        PG8_STAGE(PG8_SB(0, 0), cB, voffB); PG8_STAGE(PG8_SA(0, 0), cA, voffA); PG8_STAGE(PG8_SB(0, 1), cB + hstep, voffB); PG8_STAGE(PG8_SA(0, 1), cA + hstep, voffA);
        if (wr == 1) PG8_BAR;
        PG8_WAIT_V(4); PG8_BAR;
        PG8_STAGE(PG8_SB(1, 0), cB + kstep, voffB); PG8_STAGE(PG8_SA(1, 0), cA + kstep, voffA); PG8_STAGE(PG8_SB(1, 1), cB + hstep + kstep, voffB);
        PG8_WAIT_V(6); PG8_BAR;
    }
    for (;;) {
        const bool has_next = S.next(ui + 1, nxt);
        const char* nA = has_next ? (const char*)g.A + (size_t)nxt.pm * tstep : cA; const char* nB = has_next ? (const char*)g.Bt + (size_t)nxt.pn * tstep : cB;
        for (int t = 0; t < nt; t += 2) {
            const bool last = (t == nt - 2);
            const char* a1 = cA + (size_t)(t + 1) * kstep;
            const char* a2 = last ? nA : cA + (size_t)(t + 2) * kstep; const char* b2 = last ? nB : cB + (size_t)(t + 2) * kstep;
            const char* a3 = a2 + kstep; const char* b3 = b2 + kstep;
            if (last && has_next) S.a_ready(nxt);
            if constexpr (SP2) {
            PG8_LDB(B0, 0, 0); PG8_LDB(B1, 0, 1); PG8_SCHED; PG8_LDA(At, 0, 0); PG8_STAGE(PG8_SA(1, 1), a1 + hstep, voffA);
            PG8_WAIT_V(8); PG8_WAIT_L(0); PG8_BAR; PG8_MMA(0, 0, At, B0); PG8_MMA(0, 1, At, B1); PG8_BAR; PG8_SCHED;
            PG8_LDA(At, 0, 1); PG8_STAGE(PG8_SB(0, 0), b2, voffB); PG8_STAGE(PG8_SB(0, 1), b2 + hstep, voffB); PG8_STAGE(PG8_SA(0, 0), a2, voffA);
            PG8_WAIT_V(8); PG8_WAIT_L(0); PG8_BAR; PG8_MMA(1, 0, At, B0); PG8_MMA(1, 1, At, B1); PG8_BAR; PG8_SCHED;
            PG8_LDB(B0, 1, 0); PG8_LDB(B1, 1, 1); PG8_SCHED; PG8_LDA(At, 1, 0); PG8_STAGE(PG8_SA(0, 1), a2 + hstep, voffA);
            PG8_WAIT_V(8); PG8_WAIT_L(0); PG8_BAR; PG8_MMA(0, 0, At, B0); PG8_MMA(0, 1, At, B1); PG8_BAR; PG8_SCHED;
            PG8_LDA(At, 1, 1); PG8_STAGE(PG8_SB(1, 0), b3, voffB); PG8_STAGE(PG8_SB(1, 1), b3 + hstep, voffB); PG8_STAGE(PG8_SA(1, 0), a3, voffA);
            PG8_WAIT_V(8); PG8_WAIT_L(0); PG8_BAR; PG8_MMA(1, 0, At, B0); PG8_MMA(1, 1, At, B1); PG8_BAR; PG8_SCHED;
            } else {
            PG8_LDB(B0, 0, 0); PG8_SCHED; PG8_LDA(At, 0, 0); PG8_STAGE(PG8_SA(1, 1), a1 + hstep, voffA);
            PG8_WAIT_L(8); PG8_BAR; PG8_WAIT_L(0); PG8_MMA(0, 0, At, B0); PG8_BAR; PG8_SCHED;
            PG8_LDB(B1, 0, 1); PG8_STAGE(PG8_SB(0, 0), b2, voffB);
            PG8_BAR; PG8_WAIT_L(0); PG8_MMA(0, 1, At, B1); PG8_BAR;
            PG8_LDA(At, 0, 1); PG8_STAGE(PG8_SA(0, 0), a2, voffA);
            PG8_BAR; PG8_WAIT_L(0); PG8_MMA(1, 0, At, B0); PG8_BAR; PG8_SCHED;
            PG8_STAGE(PG8_SB(0, 1), b2 + hstep, voffB);
            PG8_WAIT_V(6); PG8_BAR; PG8_MMA(1, 1, At, B1); PG8_BAR;
            PG8_LDB(B0, 1, 0); PG8_SCHED; PG8_LDA(At, 1, 0); PG8_STAGE(PG8_SA(0, 1), a2 + hstep, voffA);
            PG8_WAIT_L(8); PG8_BAR; PG8_WAIT_L(0); PG8_MMA(0, 0, At, B0); PG8_BAR; PG8_SCHED;
            PG8_LDB(B1, 1, 1); PG8_STAGE(PG8_SB(1, 0), b3, voffB);
            PG8_BAR; PG8_WAIT_L(0); PG8_MMA(0, 1, At, B1); PG8_BAR;
            PG8_LDA(At, 1, 1); PG8_STAGE(PG8_SA(1, 0), a3, voffA);
            PG8_BAR; PG8_WAIT_L(0); PG8_MMA(1, 0, At, B0); PG8_BAR; PG8_SCHED;
            PG8_STAGE(PG8_SB(1, 1), b3 + hstep, voffB);
            PG8_WAIT_V(6); PG8_BAR; PG8_MMA(1, 1, At, B1); PG8_BAR;
            }
        }
        if constexpr (ALIGN_EPI) { if (wr == 0) PG8_BAR; }
        if constexpr (!Epi::AFTER_DRAIN) { E(acc, cur, wr, wc, fr, fq); S.done(cur); }
        if (!has_next) break;
#pragma unroll
        for (int a = 0; a < 2; ++a)
#pragma unroll
            for (int b = 0; b < 2; ++b)
#pragma unroll
                for (int m = 0; m < 4; ++m)
#pragma unroll
                    for (int n = 0; n < 2; ++n) acc[a][b][m][n] = (f32x4){0.f, 0.f, 0.f, 0.f};
        cur = nxt; cA = nA; cB = nB; ++ui;
        if constexpr (ALIGN_EPI) { if (wr == 1) PG8_BAR; }
    }
    PG8_WAIT_V(0);
    if constexpr (!ALIGN_EPI) { if (wr == 0) PG8_BAR; }
    PG8_BAR;
    if constexpr (Epi::AFTER_DRAIN) { E.fused(acc, cur, wr, wc, fr, fq, lds, wid, lane); S.done(cur); }
#undef PG8_SA
#undef PG8_SB
#undef PG8_STAGE
#undef PG8_LDA
#undef PG8_LDB
#undef PG8_MMA
#undef PG8_WAIT_V
#undef PG8_WAIT_L
#undef PG8_BAR
#undef PG8_SCHED
}
}

constexpr int NWAVES = 8;
constexpr int SEQ = 16384, DM = 2048, NIN = 5664, NINP = 5888, DFF = 5632;
constexpr int DNH = 8, HD = 128, SWH = 8, MEMH = 4, MEMT = 256;
constexpr float RMS_EPS = 1e-6f;
constexpr float LOG2E = 1.4426950408889634f;
constexpr float QSCALE = 0.08838834764831845f * 1.4426950408889634f;

constexpr size_t MiB = 1u << 20;
constexpr size_t WS_CTL = 0, CTL_ZERO_BYTES = 1 * MiB;
constexpr size_t CTL_SUMSQ2 = 256 * 1024, CTL_SUMSQ3 = 320 * 1024, CTL_SUMSQ4 = 384 * 1024;
constexpr size_t WS_RSTD1 = 1 * MiB, WS_RSTDM = 1 * MiB + 64 * 1024;
constexpr size_t WS_MEMB = 2 * MiB, WS_KVM = 3 * MiB, WS_AB = 4 * MiB, WS_BG = 6 * MiB;
constexpr size_t WS_WOUT = 8 * MiB, WS_WQ = 16 * MiB, WS_WKV = 18 * MiB, WS_WO = 22 * MiB, WS_WIN = 24 * MiB;
constexpr size_t WS_XB = 48 * MiB;
constexpr size_t WS_QKV = 112 * MiB;
constexpr size_t WS_OF = 112 * MiB, WS_OB = 144 * MiB, WS_H1B = 112 * MiB, WS_QM = 176 * MiB, WS_OM = 192 * MiB;
constexpr size_t WS_DNX = 208 * MiB;
constexpr size_t WS_WGU = 208 * MiB, WS_WD = 252 * MiB, WS_HID = 274 * MiB, WS_END = 496 * MiB;
constexpr size_t DO_Z = 0, DO_QSW = 32 * MiB, DO_KVSW = 64 * MiB;
constexpr int CW_BAR = 4096;

constexpr int RING_OFF = 0, RING_BYTES = 131072;
constexpr int LDSCTL_OFF = RING_BYTES, MISC_OFF = LDSCTL_OFF + 320;
constexpr int LDS_BYTES = 147456;

#define GAS __attribute__((address_space(1)))
#define LAS __attribute__((address_space(3)))
typedef unsigned short bf16;
typedef unsigned v4u __attribute__((ext_vector_type(4)));
typedef unsigned v2u __attribute__((ext_vector_type(2)));
typedef float f32x4 __attribute__((ext_vector_type(4)));
typedef short bf16x8 __attribute__((ext_vector_type(8)));
typedef short s16x4 __attribute__((ext_vector_type(4)));
typedef GAS unsigned gu32;
#define RLX_AGENT __ATOMIC_RELAXED, __HIP_MEMORY_SCOPE_AGENT
#define LDS_WAIT() asm volatile("s_waitcnt lgkmcnt(0)" ::: "memory")
#define VM_WAIT() asm volatile("s_waitcnt vmcnt(0)" ::: "memory")
__device__ __forceinline__ unsigned f2bf(float f) { unsigned u = __builtin_bit_cast(unsigned, f); return (u + 0x7fffu + ((u >> 16) & 1u)) >> 16; }
__device__ __forceinline__ unsigned pk2(float lo, float hi) { return f2bf(lo) | (f2bf(hi) << 16); }
__device__ __forceinline__ float bf2f(unsigned short b) { return __builtin_bit_cast(float, (unsigned)b << 16); }
__device__ __forceinline__ float bflo(unsigned w) { return __builtin_bit_cast(float, w << 16); }
__device__ __forceinline__ float bfhi(unsigned w) { return __builtin_bit_cast(float, w & 0xffff0000u); }
__device__ __forceinline__ unsigned cvtpk(float lo, float hi) { unsigned r; asm volatile("v_cvt_pk_bf16_f32 %0, %1, %2" : "=v"(r) : "v"(lo), "v"(hi)); return r; }
__device__ __forceinline__ float wave_sum(float v) {
#pragma unroll
    for (int o = 1; o < 64; o <<= 1) v += __shfl_xor(v, o);
    return v;
}
__device__ __forceinline__ float siluf(float x) { return x / (1.0f + __expf(-x)); }
#define XB_TMO      128
#define XB_XCNT(j)  (256  + 64 * (j))
#define XB_XSUB(j)  (1280 + 64 * (j))
#define XB_XGEN(j)  (2304 + 64 * (j))
#define XB_TOP      3328
#define XB_TOPGEN   3392
#define XCD_BAR_WORDS 3456
#define XB_SPIN_CAP (1u << 18)

__device__ __forceinline__ unsigned xb_ld(unsigned* p)              { return __hip_atomic_load(p, __ATOMIC_RELAXED, __HIP_MEMORY_SCOPE_AGENT); }
__device__ __forceinline__ unsigned xb_add(unsigned* p, unsigned v) { return __hip_atomic_fetch_add(p, v, __ATOMIC_RELAXED, __HIP_MEMORY_SCOPE_AGENT); }
__device__ __forceinline__ unsigned xb_xcc_id() { return (unsigned)__builtin_amdgcn_s_getreg((3 << 11) | 20) & 0xFu; }
#define XB_SPIN(cond, bar) do { unsigned _sp = 0; while (cond) { __builtin_amdgcn_s_sleep(1); \
    if ((++_sp & 255u) == 0u) { if (xb_ld(&(bar)[XB_TMO])) break; if (_sp > XB_SPIN_CAP) { atomicAdd(&(bar)[XB_TMO], 1u); break; } } } } while (0)

struct XcdBarrier {
    unsigned* bar; unsigned x;
    volatile LAS unsigned* st;
};

__device__ __forceinline__ XcdBarrier xcd_barrier_post(unsigned* bar, volatile LAS unsigned* st) {
    XcdBarrier b; b.bar = bar; b.x = xb_xcc_id(); b.st = st;
    if (threadIdx.x == 0) (void)xb_add(&bar[XB_XCNT(b.x)], 1u);
    return b;
}
__device__ __forceinline__ void xcd_barrier_complete(unsigned* bar, unsigned x, unsigned& nloc, unsigned& nx) {
    const unsigned G = gridDim.x * gridDim.y * gridDim.z;
    unsigned sum, cnt, mine, sp = 0u;
    for (;;) {
        sum = 0u; cnt = 0u; mine = 0u;
#pragma unroll
        for (unsigned j = 0; j < 16; ++j) { const unsigned c = xb_ld(&bar[XB_XCNT(j)]); sum += c; cnt += (c > 0u) ? 1u : 0u; mine = (j == x) ? c : mine; }
        if (sum == G) break;
        __builtin_amdgcn_s_sleep(1);
        if ((++sp & 255u) == 0u) { if (xb_ld(&bar[XB_TMO])) break; if (sp > XB_SPIN_CAP) { atomicAdd(&bar[XB_TMO], 1u); break; } }
    }
    nloc = mine > 0u ? mine : 1u; nx = cnt > 0u ? cnt : 1u;
}

__device__ __forceinline__ void xcd_barrier(const XcdBarrier& b) {
    asm volatile("s_waitcnt vmcnt(0)" ::: "memory");
    __syncthreads();
    if (threadIdx.x == 0) {
        unsigned* bar = b.bar;
        __builtin_amdgcn_s_waitcnt(0);
        unsigned nloc = b.st[0], nx = b.st[1];
        if (nloc == 0u) { xcd_barrier_complete(bar, b.x, nloc, nx); b.st[0] = nloc; b.st[1] = nx; }
        const unsigned old = xb_add(&bar[XB_XSUB(b.x)], 1u);
        const unsigned gen = old / nloc;
        if (old + 1u == (gen + 1u) * nloc) {
            __builtin_amdgcn_fence(__ATOMIC_RELEASE, "agent");
            asm volatile("s_waitcnt vmcnt(0)" ::: "memory");
            const unsigned og = xb_add(&bar[XB_TOP], 1u);
            const unsigned tg = og / nx;
            if (og + 1u == (tg + 1u) * nx) xb_add(&bar[XB_TOPGEN], 1u);
            else XB_SPIN(xb_ld(&bar[XB_TOPGEN]) == tg, bar);
            __builtin_amdgcn_fence(__ATOMIC_ACQUIRE, "agent");
            xb_add(&bar[XB_XGEN(b.x)], 1u);
            asm volatile("s_waitcnt vmcnt(0)" ::: "memory");
        } else {
            XB_SPIN(xb_ld(&bar[XB_XGEN(b.x)]) == gen, bar);
            __builtin_amdgcn_fence(__ATOMIC_ACQUIRE, "agent");
            asm volatile("s_waitcnt vmcnt(0)" ::: "memory");
        }
    }
    __syncthreads();
}

using pg8::Unit;
__device__ __forceinline__ v4u pack8(f32x4 v0, f32x4 v1) { v4u w; w.x = cvtpk(v0[0], v0[1]); w.y = cvtpk(v0[2], v0[3]); w.z = cvtpk(v1[0], v1[1]); w.w = cvtpk(v1[2], v1[3]); return w; }

struct EpiProj {
    static constexpr bool PERM = true, AFTER_DRAIN = false;
    const float* rstd; bf16* qkv; bf16* z; bf16* qsw; bf16* kvsw; float* ab;
    __device__ __forceinline__ void operator()(const f32x4 (&acc)[2][2][4][2], const Unit& u, int wr, int wc, int fr, int fq) const {
        const int pn = u.pn; bf16* base; int ldc, colt; float sc = 1.f;
        if (pn < 12) { base = qkv; ldc = 3072; colt = pn * 256; }
        else if (pn < 16) { base = z; ldc = 1024; colt = (pn - 12) * 256; }
        else if (pn < 20) { base = qsw; ldc = 1024; colt = (pn - 16) * 256; sc = QSCALE; }
        else if (pn < 22) { base = kvsw; ldc = 512; colt = (pn - 20) * 256; }
        else { base = nullptr; ldc = 0; colt = 0; }
        const int row0 = u.pm * 256 + wr * 64 + fr, col0 = colt + wc * 32 + 8 * fq;
#pragma unroll
        for (int ai = 0; ai < 2; ++ai)
#pragma unroll
            for (int m = 0; m < 4; ++m) {
                const int row = row0 + ai * 128 + m * 16; const float rs = rstd[row] * sc;
                if (base) {
                    bf16* rowp = base + (size_t)row * ldc + col0;
#pragma unroll
                    for (int bj = 0; bj < 2; ++bj) *(v4u*)(rowp + bj * 128) = pack8(acc[ai][bj][m][0] * rs, acc[ai][bj][m][1] * rs);
                } else if (wc == 0) {
                    float* rowp = ab + (size_t)row * 32 + 8 * fq;
                    *(f32x4*)(rowp) = acc[ai][0][m][0] * rs; *(f32x4*)(rowp + 4) = acc[ai][0][m][1] * rs;
                }
            }
    }
};
struct EpiScaleBf16 {
    static constexpr bool PERM = true, AFTER_DRAIN = false;
    const float* rs; int from_sumsq; float sc; bf16* O; int ldc;
    __device__ __forceinline__ void operator()(const f32x4 (&acc)[2][2][4][2], const Unit& u, int wr, int wc, int fr, int fq) const {
        const int row0 = u.pm * 256 + wr * 64 + fr, col0 = u.pn * 256 + wc * 32 + 8 * fq;
#pragma unroll
        for (int ai = 0; ai < 2; ++ai)
#pragma unroll
            for (int m = 0; m < 4; ++m) {
                const int row = row0 + ai * 128 + m * 16; float r = rs[row];
                if (from_sumsq) r = __builtin_amdgcn_rsqf(r * (1.0f / DM) + RMS_EPS);
                r *= sc; bf16* rowp = O + (size_t)row * ldc + col0;
#pragma unroll
                for (int bj = 0; bj < 2; ++bj) *(v4u*)(rowp + bj * 128) = pack8(acc[ai][bj][m][0] * r, acc[ai][bj][m][1] * r);
            }
    }
};
struct EpiRes {
    static constexpr bool PERM = true, AFTER_DRAIN = false;
    const float* res; float* out; bf16* ob; float* sumsq;
    __device__ __forceinline__ void operator()(const f32x4 (&acc)[2][2][4][2], const Unit& u, int wr, int wc, int fr, int fq) const {
        const int row0 = u.pm * 256 + wr * 64 + fr, col0 = u.pn * 256 + wc * 32 + 8 * fq;
#pragma unroll
        for (int ai = 0; ai < 2; ++ai)
#pragma unroll
            for (int m = 0; m < 4; ++m) {
                const int row = row0 + ai * 128 + m * 16; const size_t off = (size_t)row * DM + col0; float ss = 0.f;
#pragma unroll
                for (int bj = 0; bj < 2; ++bj) {
                    const f32x4 r0 = *(const f32x4*)(res + off + bj * 128), r1 = *(const f32x4*)(res + off + bj * 128 + 4);
                    const f32x4 v0 = acc[ai][bj][m][0] + r0, v1 = acc[ai][bj][m][1] + r1;
                    *(f32x4*)(out + off + bj * 128) = v0; *(f32x4*)(out + off + bj * 128 + 4) = v1;
                    if (ob) *(v4u*)(ob + off + bj * 128) = pack8(v0, v1);
                    ss += (v0[0] * v0[0] + v0[1] * v0[1]) + (v0[2] * v0[2] + v0[3] * v0[3]) + (v1[0] * v1[0] + v1[1] * v1[1]) + (v1[2] * v1[2] + v1[3] * v1[3]);
                }
                ss += __shfl_xor(ss, 16); ss += __shfl_xor(ss, 32);
                if (fq == 0) atomicAdd(sumsq + row, ss);
            }
    }
};
struct EpiSwiglu {
    static constexpr bool PERM = true, AFTER_DRAIN = false;
    const float* sumsq; bf16* H;
    __device__ __forceinline__ void operator()(const f32x4 (&acc)[2][2][4][2], const Unit& u, int wr, int wc, int fr, int fq) const {
        const int row0 = u.pm * 256 + wr * 64 + fr, col0 = u.pn * 128 + wc * 32 + 8 * fq;
#pragma unroll
        for (int ai = 0; ai < 2; ++ai)
#pragma unroll
            for (int m = 0; m < 4; ++m) {
                const int row = row0 + ai * 128 + m * 16; const float r = __builtin_amdgcn_rsqf(sumsq[row] * (1.0f / DM) + RMS_EPS);
                f32x4 h[2];
#pragma unroll
                for (int n = 0; n < 2; ++n)
#pragma unroll
                    for (int e = 0; e < 4; ++e) { const float g = acc[ai][0][m][n][e] * r, up = acc[ai][1][m][n][e] * r; h[n][e] = siluf(g) * up; }
                *(v4u*)(H + (size_t)row * DFF + col0) = pack8(h[0], h[1]);
            }
    }
};

struct Frame {
    LAS unsigned char* lds;
    volatile LAS unsigned* MISC;
    gu32* ctl;
    int tid, lane, wave, vcu, G;
    const float* in[23]; float* out; unsigned char* ws;
};
#define WSP(T, off) ((T*)(F.ws + (off)))
#define DOP(T, off) ((T*)((unsigned char*)F.out + (off)))

__device__ __forceinline__ void tr_item(const float* W, int K, int Nsrc, int src_col0, const float* gain, bf16* WT, int dst_row0, int k0, LAS float* scr, int lane) {
#pragma unroll 8
    for (int i = 0; i < 32; ++i) {
        const int kk = 2 * i + (lane >> 5); float v = 0.f;
        if (src_col0 >= 0) { v = W[(size_t)(k0 + kk) * Nsrc + src_col0 + (lane & 31)]; if (gain) v *= gain[k0 + kk]; }
        scr[kk * 33 + (lane & 31)] = v;
    }
    LDS_WAIT(); asm volatile("" ::: "memory");
    const int c = lane & 7;
#pragma unroll
    for (int j = 0; j < 4; ++j) { const int n = (lane >> 3) + 8 * j; const LAS float* s = scr + (8 * c) * 33 + n;
        v4u o; o.x = pk2(s[0 * 33], s[1 * 33]); o.y = pk2(s[2 * 33], s[3 * 33]); o.z = pk2(s[4 * 33], s[5 * 33]); o.w = pk2(s[6 * 33], s[7 * 33]);
        *(GAS v4u*)(WT + (size_t)(dst_row0 + n) * K + k0 + 8 * c) = o; }
    LDS_WAIT(); asm volatile("" ::: "memory");
}
__device__ __forceinline__ int win_src_col(int c) {
    if (c < 4096) return c;
    if (c < 5120) return c - 4096 + 4128;
    if (c < 5376) return c - 5120 + 5152;
    if (c < 5632) return c - 5376 + 5408;
    if (c < 5664) return c - 5632 + 4096;
    return -1;
}
__device__ __forceinline__ void row_to_bf16_rstd(const float* xrow, bf16* orow, float* rstd_out, int lane) {
    const GAS f32x4* xr = (const GAS f32x4*)xrow + lane;
    f32x4 v[8]; float s = 0.f;
#pragma unroll
    for (int j = 0; j < 8; ++j) { v[j] = xr[64 * j]; s += (v[j].x * v[j].x + v[j].y * v[j].y) + (v[j].z * v[j].z + v[j].w * v[j].w); }
    s = wave_sum(s);
    if (lane == 0) *rstd_out = 1.0f / sqrtf(s * (1.0f / DM) + RMS_EPS);
    GAS v2u* o8 = (GAS v2u*)orow + lane;
#pragma unroll
    for (int j = 0; j < 8; ++j) { v2u w; w.x = pk2(v[j].x, v[j].y); w.y = pk2(v[j].z, v[j].w); o8[64 * j] = w; }
}

__device__ __forceinline__ void p0_prologue(Frame& F) {
    LAS float* scr = (LAS float*)(F.lds + RING_OFF + F.wave * 16384);
    const int gw = F.vcu * NWAVES + F.wave, NGW = F.G * NWAVES;
    constexpr int I_IN = 32 * (NINP / 32), I_OUT = 32 * 64, I_Q = 32 * 16, I_KV = 32 * 32, I_O = 8 * 64;
    constexpr int NITEMS = I_IN + I_OUT + I_Q + I_KV + I_O;
    for (int it = gw; it < NITEMS; it += NGW) {
        int r = it;
        if (r < I_IN) { const int nblk = NINP / 32, kb = r / nblk, nb = r % nblk; tr_item(F.in[3], DM, NIN, win_src_col(nb * 32), F.in[2], WSP(bf16, WS_WIN), nb * 32, kb * 64, scr, F.lane); continue; } r -= I_IN;
        if (r < I_OUT) { const int kb = r / 64, nb = r % 64; tr_item(F.in[12], DM, DM, nb * 32, nullptr, WSP(bf16, WS_WOUT), nb * 32, kb * 64, scr, F.lane); continue; } r -= I_OUT;
        if (r < I_Q) { const int kb = r / 16, nb = r % 16; tr_item(F.in[15], DM, 512, nb * 32, F.in[13], WSP(bf16, WS_WQ), nb * 32, kb * 64, scr, F.lane); continue; } r -= I_Q;
        if (r < I_KV) { const int kb = r / 32, nb = r % 32; tr_item(F.in[16], DM, 1024, nb * 32, F.in[14], WSP(bf16, WS_WKV), nb * 32, kb * 64, scr, F.lane); continue; } r -= I_KV;
        { const int kb = r / 64, nb = r % 64; tr_item(F.in[17], 512, DM, nb * 32, nullptr, WSP(bf16, WS_WO), nb * 32, kb * 64, scr, F.lane); }
    }
    for (int m = gw; m < SEQ; m += NGW) row_to_bf16_rstd(F.in[0] + (size_t)m * DM, WSP(bf16, WS_XB) + (size_t)m * DM, WSP(float, WS_RSTD1) + m, F.lane);
    for (int m = gw; m < MEMT; m += NGW) row_to_bf16_rstd(F.in[1] + (size_t)m * DM, WSP(bf16, WS_MEMB) + (size_t)m * DM, WSP(float, WS_RSTDM) + m, F.lane);
}
__device__ __forceinline__ void p4_transposes(Frame& F) {
    LAS float* scr = (LAS float*)(F.lds + RING_OFF + F.wave * 16384);
    const int gw = F.vcu * NWAVES + F.wave, NGW = F.G * NWAVES;
    constexpr int I_GU = 32 * (2 * DFF / 32), I_D = (DFF / 64) * 64;
    for (int it = gw; it < I_GU + I_D; it += NGW) {
        int r = it;
        if (r < I_GU) { const int nblk = 2 * DFF / 32, kb = r / nblk, nb = r % nblk; const int row = nb * 32, t = row / 256, w = row % 256;
            const float* src = (w < 128) ? F.in[19] : F.in[20]; const int sc = 128 * t + (w & 127);
            tr_item(src, DM, DFF, sc, F.in[18], WSP(bf16, WS_WGU), row, kb * 64, scr, F.lane); continue; } r -= I_GU;
        { const int kb = r / 64, nb = r % 64; tr_item(F.in[21], DFF, DM, nb * 32, nullptr, WSP(bf16, WS_WD), nb * 32, kb * 64, scr, F.lane); }
    }
}

__device__ __forceinline__ float softplusf(float x) { return x > 20.f ? x : log1pf(__expf(x)); }
__device__ __forceinline__ void dn_naive_prep(Frame& F) {
    const int gw = F.vcu * NWAVES + F.wave, NGW = F.G * NWAVES, lane = F.lane;
    const bf16* QKV = WSP(bf16, WS_QKV); const float* AB = WSP(float, WS_AB); const float* cw = F.in[4];
    float* QN = WSP(float, WS_DNX); float* KN = QN + (size_t)SEQ * 1024; float* VN = KN + (size_t)SEQ * 1024; float* BG = WSP(float, WS_BG);
    for (int it = gw; it < SEQ * DNH; it += NGW) {
        const int t = it >> 3, h = it & 7, c0 = h * 128 + 2 * lane;
        float o[3][2];
#pragma unroll
        for (int s = 0; s < 3; ++s) {
            float a0 = 0.f, a1 = 0.f;
#pragma unroll
            for (int j = 0; j < 5; ++j) { const int tt = t + j - 2; if (tt >= 0 && tt < SEQ) {
                const unsigned w = *(const unsigned*)(QKV + (size_t)tt * 3072 + s * 1024 + c0);
                a0 += cw[j * 3072 + s * 1024 + c0] * bflo(w); a1 += cw[j * 3072 + s * 1024 + c0 + 1] * bfhi(w); } }
            o[s][0] = siluf(a0); o[s][1] = siluf(a1);
        }
        const float sq = wave_sum(o[0][0] * o[0][0] + o[0][1] * o[0][1]), sk = wave_sum(o[1][0] * o[1][0] + o[1][1] * o[1][1]);
        const float rq = (1.0f / sqrtf(sq + 1e-6f)) * 0.08838834764831845f, rk = 1.0f / sqrtf(sk + 1e-6f);
        const size_t off = (size_t)t * 1024 + c0;
        *(float2*)(QN + off) = make_float2(o[0][0] * rq, o[0][1] * rq); *(float2*)(KN + off) = make_float2(o[1][0] * rk, o[1][1] * rk); *(float2*)(VN + off) = make_float2(o[2][0], o[2][1]);
        if (lane == 0) {
            const float* ab = AB + (size_t)t * 32;
            const float bf = 1.0f / (1.0f + __expf(-ab[h])), bb = 1.0f / (1.0f + __expf(-ab[8 + h]));
            const float gf = -__expf(F.in[5][h]) * softplusf(ab[16 + h] + F.in[7][h]), gb = -__expf(F.in[6][h]) * softplusf(ab[24 + h] + F.in[8][h]);
            *(float4*)(BG + (size_t)it * 4) = make_float4(bf, bb, gf, gb);
        }
    }
}
__device__ __forceinline__ void dn_naive_scan(Frame& F) {
    const int b = blockIdx.x; if (b >= 16) return;
    const int dir = b >> 3, h = b & 7, tid = F.tid, dv = tid & 127, kg = tid >> 7;
    const float* QN = WSP(float, WS_DNX); const float* KN = QN + (size_t)SEQ * 1024; const float* VN = KN + (size_t)SEQ * 1024; const float* BG = WSP(float, WS_BG);
    bf16* O = WSP(bf16, dir ? WS_OB : WS_OF);
    LAS float* sh = (LAS float*)(F.lds + RING_OFF);
    LAS float* ks = sh; LAS float* qs = sh + 128; LAS float* vs = sh + 256; LAS float* sc = sh + 384; LAS float* red = sh + 512; LAS float* red2 = sh + 1024;
    float M[32];
#pragma unroll
    for (int i = 0; i < 32; ++i) M[i] = 0.f;
    for (int step = 0; step < SEQ; ++step) {
        const int t = dir ? (SEQ - 1 - step) : step; const size_t off = (size_t)t * 1024 + h * 128;
        if (tid < 128) ks[tid] = KN[off + tid]; else if (tid < 256) qs[tid - 128] = QN[off + tid - 128]; else if (tid < 384) vs[tid - 256] = VN[off + tid - 256];
        else if (tid == 384) { const float4 bg = *(const float4*)(BG + ((size_t)t * 8 + h) * 4); sc[0] = dir ? bg.y : bg.x; sc[1] = __expf(dir ? bg.w : bg.z); }
        __syncthreads();
        const float beta = sc[0], eg = sc[1]; float r = 0.f;
#pragma unroll
        for (int i = 0; i < 32; ++i) { M[i] *= eg; r += ks[kg * 32 + i] * M[i]; }
        red[kg * 128 + dv] = r;
        __syncthreads();
        const float vn = beta * (vs[dv] - (red[dv] + red[128 + dv] + red[256 + dv] + red[384 + dv])); float op = 0.f;
#pragma unroll
        for (int i = 0; i < 32; ++i) { M[i] += ks[kg * 32 + i] * vn; op += qs[kg * 32 + i] * M[i]; }
        red2[kg * 128 + dv] = op;
        __syncthreads();
        if (kg == 0) O[off + dv] = (bf16)f2bf(red2[dv] + red2[128 + dv] + red2[256 + dv] + red2[384 + dv]);
    }
}
__device__ __forceinline__ void dn_combine(Frame& F) {
    const int gw = F.vcu * NWAVES + F.wave, NGW = F.G * NWAVES, lane = F.lane;
    const bf16* OFp = WSP(bf16, WS_OF); const bf16* OBp = WSP(bf16, WS_OB); const bf16* Z = DOP(bf16, DO_Z); bf16* Y = WSP(bf16, WS_XB); const float* gn = F.in[9];
    for (int t = gw; t < SEQ; t += NGW) {
        const size_t off = (size_t)t * 1024 + 16 * lane;
        const v4u a0 = *(const v4u*)(OFp + off), a1 = *(const v4u*)(OFp + off + 8), b0 = *(const v4u*)(OBp + off), b1 = *(const v4u*)(OBp + off + 8);
        const v4u z0 = *(const v4u*)(Z + off), z1 = *(const v4u*)(Z + off + 8);
        float o[16], zz[16];
#pragma unroll
        for (int i = 0; i < 4; ++i) { o[2 * i] = bflo(a0[i]) + bflo(b0[i]); o[2 * i + 1] = bfhi(a0[i]) + bfhi(b0[i]); o[8 + 2 * i] = bflo(a1[i]) + bflo(b1[i]); o[8 + 2 * i + 1] = bfhi(a1[i]) + bfhi(b1[i]);
            zz[2 * i] = bflo(z0[i]); zz[2 * i + 1] = bfhi(z0[i]); zz[8 + 2 * i] = bflo(z1[i]); zz[8 + 2 * i + 1] = bfhi(z1[i]); }
        float ss = 0.f;
#pragma unroll
        for (int i = 0; i < 16; ++i) ss += o[i] * o[i];
        ss += __shfl_xor(ss, 1); ss += __shfl_xor(ss, 2); ss += __shfl_xor(ss, 4);
        const float rs = 1.0f / sqrtf(ss * (1.0f / 128.0f) + RMS_EPS); const int cb = (16 * lane) & 127;
        float y[16];
#pragma unroll
        for (int i = 0; i < 16; ++i) y[i] = o[i] * rs * gn[cb + i] * siluf(zz[i]);
        v4u w0, w1;
#pragma unroll
        for (int i = 0; i < 4; ++i) { w0[i] = pk2(y[2 * i], y[2 * i + 1]); w1[i] = pk2(y[8 + 2 * i], y[8 + 2 * i + 1]); }
        bf16* yp = Y + (size_t)t * DM + 16 * lane; *(v4u*)yp = w0; *(v4u*)(yp + 8) = w1;
    }
}
__device__ __forceinline__ void final_norm(Frame& F) {
    const int gw = F.vcu * NWAVES + F.wave, NGW = F.G * NWAVES, lane = F.lane;
    const float* ss = (const float*)(F.ws + WS_CTL + CTL_SUMSQ4); const GAS f32x4* g = (const GAS f32x4*)F.in[22] + lane;
    for (int m = gw; m < SEQ; m += NGW) {
        const float r = 1.0f / sqrtf(ss[m] * (1.0f / DM) + RMS_EPS);
        GAS f32x4* o = (GAS f32x4*)(F.out + (size_t)m * DM) + lane;
#pragma unroll
        for (int j = 0; j < 8; ++j) { f32x4 v = o[64 * j]; v = v * r * g[64 * j]; o[64 * j] = v; }
    }
}

__device__ __forceinline__ int t5_bucket(int rel) {
    const int n = rel < 0 ? -rel : rel; int b;
    if (n < 8) b = n; else { int k = (31 - __builtin_clz((unsigned)(n * n))) - 6; b = 8 + k; if (b > 15) b = 15; }
    return (rel > 0 ? 16 : 0) + b;
}
template <int MODE  >
__device__ __forceinline__ void attn_unit(Frame& F, const bf16* Q, int qpitch, const bf16* Kp, const bf16* Vp, int kvpitch, bf16* O, int opitch, int q0, int kt_beg, int kt_end, const LAS float* btab, float sink2) {
    LAS unsigned char* Ks = F.lds + RING_OFF; LAS unsigned char* Vs = Ks + 16384;
    const int lane = F.lane, c = lane & 15, g = lane >> 4, qw0 = q0 + 16 * F.wave, tid = F.tid;
    bf16x8 qf[4];
#pragma unroll
    for (int t = 0; t < 4; ++t) qf[t] = *(const bf16x8*)(Q + (size_t)(qw0 + c) * qpitch + 32 * t + 8 * g);
    f32x4 oacc[8];
#pragma unroll
    for (int i = 0; i < 8; ++i) oacc[i] = (f32x4){0.f, 0.f, 0.f, 0.f};
    float mrun = (MODE == 0) ? sink2 : -1e30f, lsum = (MODE == 0 && g == 0) ? 1.0f : 0.0f;
    for (int kt = kt_beg; kt < kt_end; ++kt) {
        __syncthreads();
#pragma unroll
        for (int i = 0; i < 2; ++i) { const int ci = tid + 512 * i, key = ci >> 4, ch = ci & 15;
            const v4u kv = *(const v4u*)(Kp + (size_t)(64 * kt + key) * kvpitch + ch * 8), vv = *(const v4u*)(Vp + (size_t)(64 * kt + key) * kvpitch + ch * 8);
            *(LAS v4u*)(Ks + key * 256 + ((ch ^ (key & 15)) << 4)) = kv; *(LAS v4u*)(Vs + key * 256 + ((ch ^ ((key & 7) << 1)) << 4)) = vv; }
        __syncthreads();
        bool rel_ok = true;
        if (MODE == 0) rel_ok = (64 * kt <= qw0 + 15 + 128) && (64 * kt + 63 >= qw0 - 128);
        if (!rel_ok) continue;
        f32x4 s[4];
#pragma unroll
        for (int mt = 0; mt < 4; ++mt) s[mt] = (f32x4){0.f, 0.f, 0.f, 0.f};
#pragma unroll
        for (int t = 0; t < 4; ++t)
#pragma unroll
            for (int mt = 0; mt < 4; ++mt) { const bf16x8 kf = *(const LAS bf16x8*)(Ks + (16 * mt + c) * 256 + (((4 * t + g) ^ c) << 4));
                s[mt] = __builtin_amdgcn_mfma_f32_16x16x32_bf16(kf, qf[t], s[mt], 0, 0, 0); }
        float tmax = -INFINITY;
#pragma unroll
        for (int mt = 0; mt < 4; ++mt)
#pragma unroll
            for (int r = 0; r < 4; ++r) {
                if (MODE == 0) { const int rel = (64 * kt + 16 * mt + 4 * g + r) - (qw0 + c); const bool ok = (rel >= -128) && (rel <= 128);
                    const int ri = ok ? rel + 128 : 128; const float bv = btab[ri]; s[mt][r] = ok ? s[mt][r] + bv : -INFINITY; }
                tmax = fmaxf(tmax, s[mt][r]); }
        tmax = fmaxf(tmax, __shfl_xor(tmax, 16)); tmax = fmaxf(tmax, __shfl_xor(tmax, 32));
        const float mnew = fmaxf(mrun, tmax), alpha = __builtin_amdgcn_exp2f(mrun - mnew); mrun = mnew; float ps = 0.f;
#pragma unroll
        for (int mt = 0; mt < 4; ++mt)
#pragma unroll
            for (int r = 0; r < 4; ++r) { const float p = __builtin_amdgcn_exp2f(s[mt][r] - mnew); s[mt][r] = p; ps += p; }
        lsum = lsum * alpha + ps;
#pragma unroll
        for (int i = 0; i < 8; ++i) oacc[i] = oacc[i] * alpha;
        bf16x8 pf[2];
#pragma unroll
        for (int t2 = 0; t2 < 2; ++t2) { v4u w; w.x = cvtpk(s[2 * t2][0], s[2 * t2][1]); w.y = cvtpk(s[2 * t2][2], s[2 * t2][3]); w.z = cvtpk(s[2 * t2 + 1][0], s[2 * t2 + 1][1]); w.w = cvtpk(s[2 * t2 + 1][2], s[2 * t2 + 1][3]);
            pf[t2] = __builtin_bit_cast(bf16x8, w); }
        const int q4 = c >> 2, p4 = c & 3;
#pragma unroll
        for (int t2 = 0; t2 < 2; ++t2)
#pragma unroll
            for (int mo = 0; mo < 8; ++mo) {
                const int k1 = 32 * t2 + 4 * g + q4, k2 = k1 + 16, chn = 2 * mo + (p4 >> 1);
                const s16x4 lo = __builtin_bit_cast(s16x4, __builtin_amdgcn_ds_read_tr16_b64_v4i16((LAS s16x4*)(Vs + k1 * 256 + ((chn ^ ((k1 & 7) << 1)) << 4) + (p4 & 1) * 8)));
                const s16x4 hi = __builtin_bit_cast(s16x4, __builtin_amdgcn_ds_read_tr16_b64_v4i16((LAS s16x4*)(Vs + k2 * 256 + ((chn ^ ((k2 & 7) << 1)) << 4) + (p4 & 1) * 8)));
                const bf16x8 vf = (bf16x8){lo[0], lo[1], lo[2], lo[3], hi[0], hi[1], hi[2], hi[3]};
                oacc[mo] = __builtin_amdgcn_mfma_f32_16x16x32_bf16(vf, pf[t2], oacc[mo], 0, 0, 0); }
    }
    lsum += __shfl_xor(lsum, 16); lsum += __shfl_xor(lsum, 32);
    const float inv = 1.0f / lsum;
#pragma unroll
    for (int mo = 0; mo < 8; ++mo) { v2u w; w.x = cvtpk(oacc[mo][0] * inv, oacc[mo][1] * inv); w.y = cvtpk(oacc[mo][2] * inv, oacc[mo][3] * inv);
        *(v2u*)(O + (size_t)(qw0 + c) * opitch + 16 * mo + 4 * g) = w; }
}
__device__ __forceinline__ void swa_phase(Frame& F) {
    LAS float* btab = (LAS float*)(F.lds + RING_OFF + 32768);
    const bf16* QS = DOP(bf16, DO_QSW); const bf16* KV = DOP(bf16, DO_KVSW); bf16* Y = WSP(bf16, WS_XB);
    for (int u = blockIdx.x; u < SWH * (SEQ / 128); u += F.G) {
        const int h = u & 7, qb = u >> 3, kvh = h >> 2;
        __syncthreads();
        if (F.tid < 257) btab[F.tid] = F.in[11][t5_bucket(F.tid - 128) * 8 + h] * LOG2E;
        __syncthreads();
        int kb = 2 * qb - 2, ke = 2 * qb + 4; if (kb < 0) kb = 0; if (ke > SEQ / 64) ke = SEQ / 64;
        attn_unit<0>(F, QS + h * 128, 1024, KV + kvh * 128, KV + 256 + kvh * 128, 512, Y + 1024 + h * 128, DM, qb * 128, kb, ke, btab, F.in[10][h] * LOG2E);
    }
}
__device__ __forceinline__ void mem_attn_phase(Frame& F) {
    const bf16* QM = WSP(bf16, WS_QM); const bf16* KVm = WSP(bf16, WS_KVM); bf16* OM = WSP(bf16, WS_OM);
    for (int u = blockIdx.x; u < MEMH * (SEQ / 128); u += F.G) {
        const int h = u & 3, qb = u >> 2;
        attn_unit<1>(F, QM + h * 128, 512, KVm + h * 128, KVm + 512 + h * 128, 1024, OM + h * 128, 512, qb * 128, 0, 4, nullptr, 0.f);
    }
}

#ifndef MK_N_LAUNCHES
#define MK_N_LAUNCHES 1
#endif
constexpr int N_PHASES = 12;
struct Args { const float* in[23]; float* out; unsigned char* ws; int ph_lo, ph_hi; };
static_assert(sizeof(Args) == 23 * 8 + 8 + 8 + 8, "Args has no padding");

__global__ void __launch_bounds__(NWAVES * 64, 2) enc_fwd(Args args) {
    extern __shared__ __attribute__((aligned(16))) unsigned char lds[];
    Frame F;
    F.lds = (LAS unsigned char*)lds;
    F.MISC = (volatile LAS unsigned*)(F.lds + MISC_OFF);
    F.tid = threadIdx.x; F.lane = F.tid & 63; F.wave = __builtin_amdgcn_readfirstlane(F.tid >> 6);
    F.G = gridDim.x; { const int bx = blockIdx.x; F.vcu = (F.G % 8 == 0) ? (bx % 8) * (F.G / 8) + bx / 8 : bx; }
#pragma unroll
    for (int i = 0; i < 23; ++i) F.in[i] = args.in[i];
    F.out = args.out; F.ws = args.ws; F.ctl = (gu32*)(args.ws + WS_CTL);
    for (int u = F.tid; u < (LDS_BYTES - LDSCTL_OFF) / 4; u += NWAVES * 64) ((LAS unsigned*)(F.lds + LDSCTL_OFF))[u] = 0u;
    __syncthreads();
    const int lo = args.ph_lo, hi = args.ph_hi;
    XcdBarrier bar; bar.bar = (unsigned*)(F.ctl + CW_BAR); bar.x = 0; bar.st = nullptr;
    if (hi - lo > 1) bar = xcd_barrier_post((unsigned*)(F.ctl + CW_BAR), F.MISC + 8);
#define IN(k) (lo <= (k) && (k) < hi)
#define SEAM(k) do { if (IN(k) && IN((k) + 1)) xcd_barrier(bar); } while (0)
    float* sumsq2 = (float*)(F.ws + WS_CTL + CTL_SUMSQ2); float* sumsq3 = (float*)(F.ws + WS_CTL + CTL_SUMSQ3); float* sumsq4 = (float*)(F.ws + WS_CTL + CTL_SUMSQ4);

    if (IN(0)) { p0_prologue(F); } SEAM(0);
    if (IN(1)) {
        { pg8::Gemm g{WSP(bf16, WS_XB), WSP(bf16, WS_WIN), SEQ, NINP, DM}; pg8::StaticOrder S; S.init(SEQ, NINP, F.G, (int)blockIdx.x);
          EpiProj E{WSP(float, WS_RSTD1), WSP(bf16, WS_QKV), DOP(bf16, DO_Z), DOP(bf16, DO_QSW), DOP(bf16, DO_KVSW), WSP(float, WS_AB)};
          pg8::gemm_phase<EpiProj, pg8::StaticOrder, true, true>(F.lds + RING_OFF, g, S, E); }
        { pg8::Gemm g{WSP(bf16, WS_MEMB), WSP(bf16, WS_WKV), MEMT, 1024, DM}; pg8::StaticOrder S; S.init(MEMT, 1024, F.G, (int)blockIdx.x);
          EpiScaleBf16 E{WSP(float, WS_RSTDM), 0, 1.0f, WSP(bf16, WS_KVM), 1024};
          pg8::gemm_phase<EpiScaleBf16, pg8::StaticOrder, true, true>(F.lds + RING_OFF, g, S, E); }
    } SEAM(1);
    if (IN(2)) { dn_naive_prep(F); swa_phase(F); } SEAM(2);
    if (IN(3)) { dn_naive_scan(F); } SEAM(3);
    if (IN(4)) { dn_combine(F); p4_transposes(F); } SEAM(4);
    if (IN(5)) {
        pg8::Gemm g{WSP(bf16, WS_XB), WSP(bf16, WS_WOUT), SEQ, DM, DM}; pg8::StaticOrder S; S.init(SEQ, DM, F.G, (int)blockIdx.x);
        EpiRes E{F.in[0], F.out, WSP(bf16, WS_H1B), sumsq2};
        pg8::gemm_phase<EpiRes, pg8::StaticOrder, true, true>(F.lds + RING_OFF, g, S, E);
    } SEAM(5);
    if (IN(6)) {
        pg8::Gemm g{WSP(bf16, WS_H1B), WSP(bf16, WS_WQ), SEQ, 512, DM}; pg8::StaticOrder S; S.init(SEQ, 512, F.G, (int)blockIdx.x);
        EpiScaleBf16 E{sumsq2, 1, QSCALE, WSP(bf16, WS_QM), 512};
        pg8::gemm_phase<EpiScaleBf16, pg8::StaticOrder, true, true>(F.lds + RING_OFF, g, S, E);
    } SEAM(6);
    if (IN(7)) { mem_attn_phase(F); } SEAM(7);
    if (IN(8)) {
        pg8::Gemm g{WSP(bf16, WS_OM), WSP(bf16, WS_WO), SEQ, DM, 512}; pg8::StaticOrder S; S.init(SEQ, DM, F.G, (int)blockIdx.x);
        EpiRes E{F.out, F.out, WSP(bf16, WS_XB), sumsq3};
        pg8::gemm_phase<EpiRes, pg8::StaticOrder, true, true>(F.lds + RING_OFF, g, S, E);
    } SEAM(8);
    if (IN(9)) {
        pg8::Gemm g{WSP(bf16, WS_XB), WSP(bf16, WS_WGU), SEQ, 2 * DFF, DM}; pg8::StaticOrder S; S.init(SEQ, 2 * DFF, F.G, (int)blockIdx.x);
        EpiSwiglu E{sumsq3, WSP(bf16, WS_HID)};
        pg8::gemm_phase<EpiSwiglu, pg8::StaticOrder, true, true>(F.lds + RING_OFF, g, S, E);
    } SEAM(9);
    if (IN(10)) {
        pg8::Gemm g{WSP(bf16, WS_HID), WSP(bf16, WS_WD), SEQ, DM, DFF}; pg8::StaticOrder S; S.init(SEQ, DM, F.G, (int)blockIdx.x);
        EpiRes E{F.out, F.out, nullptr, sumsq4};
        pg8::gemm_phase<EpiRes, pg8::StaticOrder, true, true>(F.lds + RING_OFF, g, S, E);
    } SEAM(10);
    if (IN(11)) { final_norm(F); }
#undef IN
#undef SEAM
}

extern "C" void kernel_launch(void* const* d_in, const int* in_sizes, int n_in, void* d_out, int out_size, void* d_ws, size_t ws_size, hipStream_t stream) {
    static int grid = 0;
    if (grid == 0) {
        if (n_in != 23 || out_size != SEQ * DM || ws_size < WS_END) { fprintf(stderr, "kernel_launch: unexpected shapes (n_in %d out %d ws %zu)\n", n_in, out_size, ws_size); grid = -1; return; }
        int dev = 0, cus = 0;
        if (hipGetDevice(&dev) != hipSuccess || hipDeviceGetAttribute(&cus, hipDeviceAttributeMultiprocessorCount, dev) != hipSuccess) { grid = -1; return; }
        if (hipFuncSetAttribute((const void*)enc_fwd, hipFuncAttributeMaxDynamicSharedMemorySize, LDS_BYTES) != hipSuccess) { fprintf(stderr, "kernel_launch: hipFuncSetAttribute failed\n"); grid = -1; return; }
        (void)hipGetLastError();
        grid = cus;
    }
    if (grid < 0) return;
    if (hipMemsetAsync((char*)d_ws + WS_CTL, 0, CTL_ZERO_BYTES, stream) != hipSuccess) return;
    Args a{};
    for (int i = 0; i < 23; ++i) a.in[i] = (const float*)d_in[i];
    a.out = (float*)d_out; a.ws = (unsigned char*)d_ws;
    const int per = (N_PHASES + MK_N_LAUNCHES - 1) / MK_N_LAUNCHES;
    for (int lo = 0; lo < N_PHASES; lo += per) {
        a.ph_lo = lo; a.ph_hi = (lo + per < N_PHASES) ? lo + per : N_PHASES;
        hipLaunchKernelGGL(enc_fwd, dim3(grid), dim3(NWAVES * 64), LDS_BYTES, stream, a);
    }
}
```

```cpp
#include <hip/hip_runtime.h>
#include <cstdio>
#include <cstdint>
namespace pg8 {
__device__ __forceinline__ unsigned cvt_pk_bf16(float lo, float hi) { unsigned r; asm volatile("v_cvt_pk_bf16_f32 %0, %1, %2" : "=v"(r) : "v"(lo), "v"(hi)); return r; }
#define PG8_LAS __attribute__((address_space(3)))
typedef unsigned short bf16_t;
typedef short bf16x8 __attribute__((ext_vector_type(8)));
typedef float f32x4 __attribute__((ext_vector_type(4)));
typedef unsigned u32x4 __attribute__((ext_vector_type(4)));
constexpr int BM = 256, BK = 64, HALF = 128, HTB = HALF * BK * 2  , STAGE_BYTES = 8 * HTB, NXCD = 8, WGM = 8;

__host__ __device__ __forceinline__ int lds_byte(int r, int c) { const int st = (r >> 4) * 2 + (c >> 5), rr = r & 15, cc = c & 31, ob = rr * 64 + cc * 2; return st * 1024 + (ob ^ (((ob >> 9) & 1) << 5)); }
__host__ __device__ __forceinline__ void stage_rc(int b, int& R, int& C) { const int st = b / 1024, sb = b % 1024, swz = sb ^ (((sb >> 9) & 1) << 5); R = (st >> 1) * 16 + swz / 64; C = (st & 1) * 32 + (swz % 64) / 2; }
__host__ __device__ __forceinline__ int perm32(int rho) { const int n = rho >> 4, i = rho & 15; return 8 * (i >> 2) + 4 * n + (i & 3); }

struct Unit { int pm, pn; };
struct Gemm { const bf16_t* A; const bf16_t* Bt; int M, N, K; };

struct StaticOrder {
    int nM, nN, nwg, G, c;
    __host__ __device__ void init(int M, int N, int G_, int c_) { nM = M / BM; nN = N / BM; nwg = nM * nN; G = G_; c = c_; }
    __host__ __device__ bool next(int i, Unit& u) const {
        const long L = (long)i * G + c; if (L >= nwg) return false;
        int wgid = (int)L; { const int q = nwg / NXCD, r = nwg % NXCD, xcd = wgid % NXCD, off = wgid / NXCD; wgid = (xcd < r ? xcd * (q + 1) : r * (q + 1) + (xcd - r) * q) + off; }
        const int nig = WGM * nN, gid = wgid / nig, fm = gid * WGM, gsz = (nM - fm) < WGM ? (nM - fm) : WGM;
        u.pm = fm + ((wgid % nig) % gsz); u.pn = (wgid % nig) / gsz; return true;
    }
    __device__ __forceinline__ void a_ready(const Unit&) const {}
    __device__ __forceinline__ void done(const Unit&) const {}
};

template <class Epi, class Sched, bool ALIGN_EPI = false, bool SP2 = false>
__device__ __forceinline__ void gemm_phase(PG8_LAS unsigned char* lds, const Gemm g, const Sched& S, const Epi& E) {
    const int tid = threadIdx.x, wid = __builtin_amdgcn_readfirstlane(tid >> 6), lane = tid & 63, wr = wid >> 2, wc = wid & 3, fr = lane & 15, fq = lane >> 4;
    const int K = g.K, nt = K / BK;
    unsigned voffA[2], voffB[2];
#pragma unroll
    for (int i = 0; i < 2; ++i) { int R, C; stage_rc(tid * 16 + i * 8192, R, C); const int Rb = Epi::PERM ? ((R & ~31) + perm32(R & 31)) : R;
        voffA[i] = (unsigned)(R * K + C) * 2u; voffB[i] = (unsigned)(Rb * K + C) * 2u; }
    const size_t kstep = (size_t)(BK * 2);
    const size_t hstep = (size_t)HALF * K * 2;
    const size_t tstep = 2 * hstep;
    const unsigned ldsw = (unsigned)wid * 1024u;
    const int aoff = lds_byte(wr * 64 + fr, fq * 8), boff = lds_byte(wc * 32 + fr, fq * 8);
#define PG8_SA(b, h) (((b) * 2 + (h)) * HTB)
#define PG8_SB(b, h) ((4 + (b) * 2 + (h)) * HTB)
#define PG8_STAGE(bufoff, gbase, voff) do { _Pragma("unroll") for (int _i = 0; _i < 2; ++_i) \
        __builtin_amdgcn_global_load_lds((const unsigned*)((const char*)(gbase) + (voff)[_i]), (PG8_LAS unsigned*)(lds + (bufoff) + ldsw + _i * 8192), 16, 0, 0); } while (0)
#define PG8_LDA(dst, b, h) do { _Pragma("unroll") for (int m = 0; m < 4; ++m) _Pragma("unroll") for (int k = 0; k < 2; ++k) dst[m][k] = *(const PG8_LAS bf16x8*)(lds + PG8_SA(b, h) + aoff + m * 2048 + k * 1024); } while (0)
#define PG8_LDB(dst, b, h) do { _Pragma("unroll") for (int n = 0; n < 2; ++n) _Pragma("unroll") for (int k = 0; k < 2; ++k) dst[n][k] = *(const PG8_LAS bf16x8*)(lds + PG8_SB(b, h) + boff + n * 2048 + k * 1024); } while (0)
#define PG8_MMA(ai, bj, At, Bt) do { __builtin_amdgcn_s_setprio(1); _Pragma("unroll") for (int m = 0; m < 4; ++m) _Pragma("unroll") for (int n = 0; n < 2; ++n) _Pragma("unroll") for (int k = 0; k < 2; ++k) \
        acc[ai][bj][m][n] = __builtin_amdgcn_mfma_f32_16x16x32_bf16(Bt[n][k], At[m][k], acc[ai][bj][m][n], 0, 0, 0); __builtin_amdgcn_s_setprio(0); } while (0)
#define PG8_WAIT_V(n) asm volatile("s_waitcnt vmcnt(" #n ")" ::: "memory")
#define PG8_WAIT_L(n) asm volatile("s_waitcnt lgkmcnt(" #n ")" ::: "memory")
#define PG8_BAR __builtin_amdgcn_s_barrier()
#define PG8_SCHED __builtin_amdgcn_sched_barrier(0)
    Unit cur, nxt; int ui = 0;
    if (!S.next(0, cur)) return;
    f32x4 acc[2][2][4][2];
#pragma unroll
    for (int a = 0; a < 2; ++a)
#pragma unroll
        for (int b = 0; b < 2; ++b)
#pragma unroll
            for (int m = 0; m < 4; ++m)
#pragma unroll
                for (int n = 0; n < 2; ++n) acc[a][b][m][n] = (f32x4){0.f, 0.f, 0.f, 0.f};
    bf16x8 At[4][2], B0[2][2], B1[2][2];
    const char* cA = (const char*)g.A + (size_t)cur.pm * tstep; const char* cB = (const char*)g.Bt + (size_t)cur.pn * tstep;
    S.a_ready(cur);
    if constexpr (SP2) {
        PG8_STAGE(PG8_SB(0, 0), cB, voffB); PG8_STAGE(PG8_SB(0, 1), cB + hstep, voffB); PG8_STAGE(PG8_SA(0, 0), cA, voffA); PG8_STAGE(PG8_SA(0, 1), cA + hstep, voffA);
        if (wr == 1) PG8_BAR;
        PG8_WAIT_V(2); PG8_BAR;
        PG8_STAGE(PG8_SB(1, 0), cB + kstep, voffB); PG8_STAGE(PG8_SA(1, 0), cA + kstep, voffA); PG8_STAGE(PG8_SB(1, 1), cB + hstep + kstep, voffB);
        PG8_WAIT_V(6); PG8_BAR;
    } else {
        PG8_STAGE(PG8_SB(0, 0), cB, voffB); PG8_STAGE(PG8_SA(0, 0), cA, voffA); PG8_STAGE(PG8_SB(0, 1), cB + hstep, voffB); PG8_STAGE(PG8_SA(0, 1), cA + hstep, voffA);
        if (wr == 1) PG8_BAR;
        PG8_WAIT_V(4); PG8_BAR;
        PG8_STAGE(PG8_SB(1, 0), cB + kstep, voffB); PG8_STAGE(PG8_SA(1, 0), cA + kstep, voffA); PG8_STAGE(PG8_SB(1, 1), cB + hstep + kstep, voffB);
        PG8_WAIT_V(6); PG8_BAR;
    }
    for (;;) {
        const bool has_next = S.next(ui + 1, nxt);
        const char* nA = has_next ? (const char*)g.A + (size_t)nxt.pm * tstep : cA; const char* nB = has_next ? (const char*)g.Bt + (size_t)nxt.pn * tstep : cB;
        for (int t = 0; t < nt; t += 2) {
            const bool last = (t == nt - 2);
            const char* a1 = cA + (size_t)(t + 1) * kstep;
            const char* a2 = last ? nA : cA + (size_t)(t + 2) * kstep; const char* b2 = last ? nB : cB + (size_t)(t + 2) * kstep;
            const char* a3 = a2 + kstep; const char* b3 = b2 + kstep;
            if (last && has_next) S.a_ready(nxt);
            if constexpr (SP2) {
            PG8_LDB(B0, 0, 0); PG8_LDB(B1, 0, 1); PG8_SCHED; PG8_LDA(At, 0, 0); PG8_STAGE(PG8_SA(1, 1), a1 + hstep, voffA);
            PG8_WAIT_V(8); PG8_WAIT_L(0); PG8_BAR; PG8_MMA(0, 0, At, B0); PG8_MMA(0, 1, At, B1); PG8_BAR; PG8_SCHED;
            PG8_LDA(At, 0, 1); PG8_STAGE(PG8_SB(0, 0), b2, voffB); PG8_STAGE(PG8_SB(0, 1), b2 + hstep, voffB); PG8_STAGE(PG8_SA(0, 0), a2, voffA);
            PG8_WAIT_V(8); PG8_WAIT_L(0); PG8_BAR; PG8_MMA(1, 0, At, B0); PG8_MMA(1, 1, At, B1); PG8_BAR; PG8_SCHED;
            PG8_LDB(B0, 1, 0); PG8_LDB(B1, 1, 1); PG8_SCHED; PG8_LDA(At, 1, 0); PG8_STAGE(PG8_SA(0, 1), a2 + hstep, voffA);
            PG8_WAIT_V(8); PG8_WAIT_L(0); PG8_BAR; PG8_MMA(0, 0, At, B0); PG8_MMA(0, 1, At, B1); PG8_BAR; PG8_SCHED;
            PG8_LDA(At, 1, 1); PG8_STAGE(PG8_SB(1, 0), b3, voffB); PG8_STAGE(PG8_SB(1, 1), b3 + hstep, voffB); PG8_STAGE(PG8_SA(1, 0), a3, voffA);
            PG8_WAIT_V(8); PG8_WAIT_L(0); PG8_BAR; PG8_MMA(1, 0, At, B0); PG8_MMA(1, 1, At, B1); PG8_BAR; PG8_SCHED;
            } else {
            PG8_LDB(B0, 0, 0); PG8_SCHED; PG8_LDA(At, 0, 0); PG8_STAGE(PG8_SA(1, 1), a1 + hstep, voffA);
            PG8_WAIT_L(8); PG8_BAR; PG8_WAIT_L(0); PG8_MMA(0, 0, At, B0); PG8_BAR; PG8_SCHED;
            PG8_LDB(B1, 0, 1); PG8_STAGE(PG8_SB(0, 0), b2, voffB);
            PG8_BAR; PG8_WAIT_L(0); PG8_MMA(0, 1, At, B1); PG8_BAR;
            PG8_LDA(At, 0, 1); PG8_STAGE(PG8_SA(0, 0), a2, voffA);
            PG8_BAR; PG8_WAIT_L(0); PG8_MMA(1, 0, At, B0); PG8_BAR; PG8_SCHED;
            PG8_STAGE(PG8_SB(0, 1), b2 + hstep, voffB);
            PG8_WAIT_V(6); PG8_BAR; PG8_MMA(1, 1, At, B1); PG8_BAR;
            PG8_LDB(B0, 1, 0); PG8_SCHED; PG8_LDA(At, 1, 0); PG8_STAGE(PG8_SA(0, 1), a2 + hstep, voffA);
            PG8_WAIT_L(8); PG8_BAR; PG8_WAIT_L(0); PG8_MMA(0, 0, At, B0); PG8_BAR; PG8_SCHED;
            PG8_LDB(B1, 1, 1); PG8_STAGE(PG8_SB(1, 0), b3, voffB);
            PG8_BAR; PG8_WAIT_L(0); PG8_MMA(0, 1, At, B1); PG8_BAR;
            PG8_LDA(At, 1, 1); PG8_STAGE(PG8_SA(1, 0), a3, voffA);
            PG8_BAR; PG8_WAIT_L(0); PG8_MMA(1, 0, At, B0); PG8_BAR; PG8_SCHED;
            PG8_STAGE(PG8_SB(1, 1), b3 + hstep, voffB);
            PG8_WAIT_V(6); PG8_BAR; PG8_MMA(1, 1, At, B1); PG8_BAR;
            }
        }
        if constexpr (ALIGN_EPI) { if (wr == 0) PG8_BAR; }
        if constexpr (!Epi::AFTER_DRAIN) { E(acc, cur, wr, wc, fr, fq); S.done(cur); }
        if (!has_next) break;
#pragma unroll
        for (int a = 0; a < 2; ++a)
#pragma unroll
            for (int b = 0; b < 2; ++b)
#pragma unroll
                for (int m = 0; m < 4; ++m)
#pragma unroll
                    for (int n = 0; n < 2; ++n) acc[a][b][m][n] = (f32x4){0.f, 0.f, 0.f, 0.f};
        cur = nxt; cA = nA; cB = nB; ++ui;
        if constexpr (ALIGN_EPI) { if (wr == 1) PG8_BAR; }
    }
    PG8_WAIT_V(0);
    if constexpr (!ALIGN_EPI) { if (wr == 0) PG8_BAR; }
    PG8_BAR;
    if constexpr (Epi::AFTER_DRAIN) { E.fused(acc, cur, wr, wc, fr, fq, lds, wid, lane); S.done(cur); }
#undef PG8_SA
#undef PG8_SB
#undef PG8_STAGE
#undef PG8_LDA
#undef PG8_LDB
#undef PG8_MMA
#undef PG8_WAIT_V
#undef PG8_WAIT_L
#undef PG8_BAR
#undef PG8_SCHED
}
}

constexpr int NWAVES = 8;
constexpr int SEQ = 16384, DM = 2048, NIN = 5664, NINP = 5888, DFF = 5632;
constexpr int DNH = 8, HD = 128, SWH = 8, MEMH = 4, MEMT = 256;
constexpr float RMS_EPS = 1e-6f;
constexpr float LOG2E = 1.4426950408889634f;
constexpr float QSCALE = 0.08838834764831845f * 1.4426950408889634f;

constexpr size_t MiB = 1u << 20;
constexpr size_t WS_CTL = 0, CTL_ZERO_BYTES = 1 * MiB;
constexpr size_t CTL_SUMSQ2 = 256 * 1024, CTL_SUMSQ3 = 320 * 1024, CTL_SUMSQ4 = 384 * 1024;
constexpr size_t WS_RSTD1 = 1 * MiB, WS_RSTDM = 1 * MiB + 64 * 1024;
constexpr size_t WS_MEMB = 2 * MiB, WS_KVM = 3 * MiB, WS_AB = 4 * MiB, WS_BG = 6 * MiB;
constexpr size_t WS_WOUT = 8 * MiB, WS_WQ = 16 * MiB, WS_WKV = 18 * MiB, WS_WO = 22 * MiB, WS_WIN = 24 * MiB;
constexpr size_t WS_XB = 48 * MiB;
constexpr size_t WS_QKV = 112 * MiB;
constexpr size_t WS_OF = 112 * MiB, WS_OB = 144 * MiB, WS_H1B = 112 * MiB, WS_QM = 176 * MiB, WS_OM = 192 * MiB;
constexpr size_t WS_DNX = 208 * MiB;
constexpr size_t WS_WGU = 208 * MiB, WS_WD = 252 * MiB, WS_HID = 274 * MiB, WS_END = 496 * MiB;
constexpr size_t DO_Z = 0, DO_QSW = 32 * MiB, DO_KVSW = 64 * MiB;
constexpr int CW_BAR = 4096;

constexpr int RING_OFF = 0, RING_BYTES = 131072;
constexpr int LDS_BYTES = 163840;
constexpr int LDSCTL_OFF = LDS_BYTES - 512, MISC_OFF = LDSCTL_OFF + 320;

#define GAS __attribute__((address_space(1)))
#define LAS __attribute__((address_space(3)))
typedef unsigned short bf16;
typedef unsigned v4u __attribute__((ext_vector_type(4)));
typedef unsigned v2u __attribute__((ext_vector_type(2)));
typedef float f32x4 __attribute__((ext_vector_type(4)));
typedef short bf16x8 __attribute__((ext_vector_type(8)));
typedef short s16x4 __attribute__((ext_vector_type(4)));
typedef GAS unsigned gu32;
#define RLX_AGENT __ATOMIC_RELAXED, __HIP_MEMORY_SCOPE_AGENT
#define LDS_WAIT() asm volatile("s_waitcnt lgkmcnt(0)" ::: "memory")
#define VM_WAIT() asm volatile("s_waitcnt vmcnt(0)" ::: "memory")
__device__ __forceinline__ unsigned f2bf(float f) { unsigned u = __builtin_bit_cast(unsigned, f); return (u + 0x7fffu + ((u >> 16) & 1u)) >> 16; }
__device__ __forceinline__ unsigned pk2(float lo, float hi) { return f2bf(lo) | (f2bf(hi) << 16); }
__device__ __forceinline__ float bf2f(unsigned short b) { return __builtin_bit_cast(float, (unsigned)b << 16); }
__device__ __forceinline__ float bflo(unsigned w) { return __builtin_bit_cast(float, w << 16); }
__device__ __forceinline__ float bfhi(unsigned w) { return __builtin_bit_cast(float, w & 0xffff0000u); }
typedef float f32x2_t __attribute__((ext_vector_type(2))); typedef __bf16 bf16x2_t __attribute__((ext_vector_type(2)));
__device__ __forceinline__ unsigned cvtpk(float lo, float hi) { f32x2_t v = {lo, hi}; bf16x2_t b = __builtin_convertvector(v, bf16x2_t); return __builtin_bit_cast(unsigned, b); }
__device__ __forceinline__ float wave_sum(float v) {
#pragma unroll
    for (int o = 1; o < 64; o <<= 1) v += __shfl_xor(v, o);
    return v;
}
__device__ __forceinline__ float siluf(float x) { return x / (1.0f + __expf(-x)); }
#define XB_TMO      128
#define XB_XCNT(j)  (256  + 64 * (j))
#define XB_XSUB(j)  (1280 + 64 * (j))
#define XB_XGEN(j)  (2304 + 64 * (j))
#define XB_TOP      3328
#define XB_TOPGEN   3392
#define XCD_BAR_WORDS 3456
#define XB_SPIN_CAP (1u << 18)

__device__ __forceinline__ unsigned xb_ld(unsigned* p)              { return __hip_atomic_load(p, __ATOMIC_RELAXED, __HIP_MEMORY_SCOPE_AGENT); }
__device__ __forceinline__ unsigned xb_add(unsigned* p, unsigned v) { return __hip_atomic_fetch_add(p, v, __ATOMIC_RELAXED, __HIP_MEMORY_SCOPE_AGENT); }
__device__ __forceinline__ unsigned xb_xcc_id() { return (unsigned)__builtin_amdgcn_s_getreg((3 << 11) | 20) & 0xFu; }
#define XB_SPIN(cond, bar) do { unsigned _sp = 0; while (cond) { __builtin_amdgcn_s_sleep(1); \
    if ((++_sp & 255u) == 0u) { if (xb_ld(&(bar)[XB_TMO])) break; if (_sp > XB_SPIN_CAP) { atomicAdd(&(bar)[XB_TMO], 1u); break; } } } } while (0)

struct XcdBarrier {
    unsigned* bar; unsigned x;
    volatile LAS unsigned* st;
};

__device__ __forceinline__ XcdBarrier xcd_barrier_post(unsigned* bar, volatile LAS unsigned* st) {
    XcdBarrier b; b.bar = bar; b.x = xb_xcc_id(); b.st = st;
    if (threadIdx.x == 0) (void)xb_add(&bar[XB_XCNT(b.x)], 1u);
    return b;
}
__device__ __forceinline__ void xcd_barrier_complete(unsigned* bar, unsigned x, unsigned& nloc, unsigned& nx) {
    const unsigned G = gridDim.x * gridDim.y * gridDim.z;
    unsigned sum, cnt, mine, sp = 0u;
    for (;;) {
        sum = 0u; cnt = 0u; mine = 0u;
#pragma unroll
        for (unsigned j = 0; j < 16; ++j) { const unsigned c = xb_ld(&bar[XB_XCNT(j)]); sum += c; cnt += (c > 0u) ? 1u : 0u; mine = (j == x) ? c : mine; }
        if (sum == G) break;
        __builtin_amdgcn_s_sleep(1);
        if ((++sp & 255u) == 0u) { if (xb_ld(&bar[XB_TMO])) break; if (sp > XB_SPIN_CAP) { atomicAdd(&bar[XB_TMO], 1u); break; } }
    }
    nloc = mine > 0u ? mine : 1u; nx = cnt > 0u ? cnt : 1u;
}

__device__ __forceinline__ void xcd_barrier(const XcdBarrier& b) {
    asm volatile("s_waitcnt vmcnt(0)" ::: "memory");
    __syncthreads();
    if (threadIdx.x == 0) {
        unsigned* bar = b.bar;
        __builtin_amdgcn_s_waitcnt(0);
        unsigned nloc = b.st[0], nx = b.st[1];
        if (nloc == 0u) { xcd_barrier_complete(bar, b.x, nloc, nx); b.st[0] = nloc; b.st[1] = nx; }
        const unsigned old = xb_add(&bar[XB_XSUB(b.x)], 1u);
        const unsigned gen = old / nloc;
        if (old + 1u == (gen + 1u) * nloc) {
            __builtin_amdgcn_fence(__ATOMIC_RELEASE, "agent");
            asm volatile("s_waitcnt vmcnt(0)" ::: "memory");
            const unsigned og = xb_add(&bar[XB_TOP], 1u);
            const unsigned tg = og / nx;
            if (og + 1u == (tg + 1u) * nx) xb_add(&bar[XB_TOPGEN], 1u);
            else XB_SPIN(xb_ld(&bar[XB_TOPGEN]) == tg, bar);
            __builtin_amdgcn_fence(__ATOMIC_ACQUIRE, "agent");
            xb_add(&bar[XB_XGEN(b.x)], 1u);
            asm volatile("s_waitcnt vmcnt(0)" ::: "memory");
        } else {
            XB_SPIN(xb_ld(&bar[XB_XGEN(b.x)]) == gen, bar);
            __builtin_amdgcn_fence(__ATOMIC_ACQUIRE, "agent");
            asm volatile("s_waitcnt vmcnt(0)" ::: "memory");
        }
    }
    __syncthreads();
}

using pg8::Unit;
__device__ __forceinline__ v4u pack8(f32x4 v0, f32x4 v1) { v4u w; w.x = cvtpk(v0[0], v0[1]); w.y = cvtpk(v0[2], v0[3]); w.z = cvtpk(v1[0], v1[1]); w.w = cvtpk(v1[2], v1[3]); return w; }

struct EpiProj {
    static constexpr bool PERM = true, AFTER_DRAIN = false;
    const float* rstd; bf16* qkv; bf16* z; bf16* qsw; bf16* kvsw; float* ab;
    __device__ __forceinline__ void operator()(const f32x4 (&acc)[2][2][4][2], const Unit& u, int wr, int wc, int fr, int fq) const {
        const int pn = u.pn; bf16* base; int ldc, colt; float sc = 1.f;
        if (pn < 12) { base = qkv; ldc = 3072; colt = pn * 256; }
        else if (pn < 16) { base = z; ldc = 1024; colt = (pn - 12) * 256; }
        else if (pn < 20) { base = qsw; ldc = 1024; colt = (pn - 16) * 256; sc = QSCALE; }
        else if (pn < 22) { base = kvsw; ldc = 512; colt = (pn - 20) * 256; }
        else { base = nullptr; ldc = 0; colt = 0; }
        const int row0 = u.pm * 256 + wr * 64 + fr, col0 = colt + wc * 32 + 8 * fq;
#pragma unroll
        for (int ai = 0; ai < 2; ++ai)
#pragma unroll
            for (int m = 0; m < 4; ++m) {
                const int row = row0 + ai * 128 + m * 16; const float rs = rstd[row] * sc;
                if (base) {
                    bf16* rowp = base + (size_t)row * ldc + col0;
#pragma unroll
                    for (int bj = 0; bj < 2; ++bj) *(v4u*)(rowp + bj * 128) = pack8(acc[ai][bj][m][0] * rs, acc[ai][bj][m][1] * rs);
                } else if (wc == 0) {
                    float* rowp = ab + (size_t)row * 32 + 8 * fq;
                    *(f32x4*)(rowp) = acc[ai][0][m][0] * rs; *(f32x4*)(rowp + 4) = acc[ai][0][m][1] * rs;
                }
            }
    }
};
struct EpiScaleBf16 {
    static constexpr bool PERM = true, AFTER_DRAIN = false;
    const float* rs; int from_sumsq; float sc; bf16* O; int ldc;
    __device__ __forceinline__ void operator()(const f32x4 (&acc)[2][2][4][2], const Unit& u, int wr, int wc, int fr, int fq) const {
        const int row0 = u.pm * 256 + wr * 64 + fr, col0 = u.pn * 256 + wc * 32 + 8 * fq;
#pragma unroll
        for (int ai = 0; ai < 2; ++ai)
#pragma unroll
            for (int m = 0; m < 4; ++m) {
                const int row = row0 + ai * 128 + m * 16; float r = rs[row];
                if (from_sumsq) r = __builtin_amdgcn_rsqf(r * (1.0f / DM) + RMS_EPS);
                r *= sc; bf16* rowp = O + (size_t)row * ldc + col0;
#pragma unroll
                for (int bj = 0; bj < 2; ++bj) *(v4u*)(rowp + bj * 128) = pack8(acc[ai][bj][m][0] * r, acc[ai][bj][m][1] * r);
            }
    }
};
struct EpiRes {
    static constexpr bool PERM = true, AFTER_DRAIN = false;
    const float* res; float* out; bf16* ob; float* sumsq;
    __device__ __forceinline__ void operator()(const f32x4 (&acc)[2][2][4][2], const Unit& u, int wr, int wc, int fr, int fq) const {
        const int row0 = u.pm * 256 + wr * 64 + fr, col0 = u.pn * 256 + wc * 32 + 8 * fq;
#pragma unroll
        for (int ai = 0; ai < 2; ++ai)
#pragma unroll
            for (int m = 0; m < 4; ++m) {
                const int row = row0 + ai * 128 + m * 16; const size_t off = (size_t)row * DM + col0; float ss = 0.f;
#pragma unroll
                for (int bj = 0; bj < 2; ++bj) {
                    const f32x4 r0 = *(const f32x4*)(res + off + bj * 128), r1 = *(const f32x4*)(res + off + bj * 128 + 4);
                    const f32x4 v0 = acc[ai][bj][m][0] + r0, v1 = acc[ai][bj][m][1] + r1;
                    *(f32x4*)(out + off + bj * 128) = v0; *(f32x4*)(out + off + bj * 128 + 4) = v1;
                    if (ob) *(v4u*)(ob + off + bj * 128) = pack8(v0, v1);
                    ss += (v0[0] * v0[0] + v0[1] * v0[1]) + (v0[2] * v0[2] + v0[3] * v0[3]) + (v1[0] * v1[0] + v1[1] * v1[1]) + (v1[2] * v1[2] + v1[3] * v1[3]);
                }
                ss += __shfl_xor(ss, 16); ss += __shfl_xor(ss, 32);
                if (fq == 0) atomicAdd(sumsq + row, ss);
            }
    }
};
struct EpiSwiglu {
    static constexpr bool PERM = true, AFTER_DRAIN = false;
    const float* sumsq; bf16* H;
    __device__ __forceinline__ void operator()(const f32x4 (&acc)[2][2][4][2], const Unit& u, int wr, int wc, int fr, int fq) const {
        const int row0 = u.pm * 256 + wr * 64 + fr, col0 = u.pn * 128 + wc * 32 + 8 * fq;
#pragma unroll
        for (int ai = 0; ai < 2; ++ai)
#pragma unroll
            for (int m = 0; m < 4; ++m) {
                const int row = row0 + ai * 128 + m * 16; const float r = __builtin_amdgcn_rsqf(sumsq[row] * (1.0f / DM) + RMS_EPS);
                f32x4 h[2];
#pragma unroll
                for (int n = 0; n < 2; ++n)
#pragma unroll
                    for (int e = 0; e < 4; ++e) { const float g = acc[ai][0][m][n][e] * r, up = acc[ai][1][m][n][e] * r; h[n][e] = siluf(g) * up; }
                *(v4u*)(H + (size_t)row * DFF + col0) = pack8(h[0], h[1]);
            }
    }
};

struct Frame {
    LAS unsigned char* lds;
    volatile LAS unsigned* MISC;
    gu32* ctl;
    int tid, lane, wave, vcu, G;
    const float* in[23]; float* out; unsigned char* ws;
};
#define WSP(T, off) ((T*)(F.ws + (off)))
#define DOP(T, off) ((T*)((unsigned char*)F.out + (off)))

__device__ __forceinline__ void tr_item(const float* W, int K, int Nsrc, int src_col0, const float* gain, bf16* WT, int dst_row0, int k0, LAS float* scr, int lane) {
#pragma unroll 8
    for (int i = 0; i < 32; ++i) {
        const int kk = 2 * i + (lane >> 5); float v = 0.f;
        if (src_col0 >= 0) { v = W[(size_t)(k0 + kk) * Nsrc + src_col0 + (lane & 31)]; if (gain) v *= gain[k0 + kk]; }
        scr[kk * 33 + (lane & 31)] = v;
    }
    LDS_WAIT(); asm volatile("" ::: "memory");
    const int c = lane & 7;
#pragma unroll
    for (int j = 0; j < 4; ++j) { const int n = (lane >> 3) + 8 * j; const LAS float* s = scr + (8 * c) * 33 + n;
        v4u o; o.x = pk2(s[0 * 33], s[1 * 33]); o.y = pk2(s[2 * 33], s[3 * 33]); o.z = pk2(s[4 * 33], s[5 * 33]); o.w = pk2(s[6 * 33], s[7 * 33]);
        *(GAS v4u*)(WT + (size_t)(dst_row0 + n) * K + k0 + 8 * c) = o; }
    LDS_WAIT(); asm volatile("" ::: "memory");
}
__device__ __forceinline__ int win_src_col(int c) {
    if (c < 4096) return c;
    if (c < 5120) return c - 4096 + 4128;
    if (c < 5376) return c - 5120 + 5152;
    if (c < 5632) return c - 5376 + 5408;
    if (c < 5664) return c - 5632 + 4096;
    return -1;
}
__device__ __forceinline__ void row_to_bf16_rstd(const float* xrow, bf16* orow, float* rstd_out, int lane) {
    const GAS f32x4* xr = (const GAS f32x4*)xrow + lane;
    f32x4 v[8]; float s = 0.f;
#pragma unroll
    for (int j = 0; j < 8; ++j) { v[j] = xr[64 * j]; s += (v[j].x * v[j].x + v[j].y * v[j].y) + (v[j].z * v[j].z + v[j].w * v[j].w); }
    s = wave_sum(s);
    if (lane == 0) *rstd_out = 1.0f / sqrtf(s * (1.0f / DM) + RMS_EPS);
    GAS v2u* o8 = (GAS v2u*)orow + lane;
#pragma unroll
    for (int j = 0; j < 8; ++j) { v2u w; w.x = pk2(v[j].x, v[j].y); w.y = pk2(v[j].z, v[j].w); o8[64 * j] = w; }
}

__device__ __forceinline__ void p0_prologue(Frame& F) {
    LAS float* scr = (LAS float*)(F.lds + RING_OFF + F.wave * 16384);
    const int gw = F.vcu * NWAVES + F.wave, NGW = F.G * NWAVES;
    constexpr int I_IN = 32 * (NINP / 32), I_OUT = 32 * 64, I_Q = 32 * 16, I_KV = 32 * 32, I_O = 8 * 64;
    constexpr int NITEMS = I_IN + I_OUT + I_Q + I_KV + I_O;
    for (int it = gw; it < NITEMS; it += NGW) {
        int r = it;
        if (r < I_IN) { const int nblk = NINP / 32, kb = r / nblk, nb = r % nblk; tr_item(F.in[3], DM, NIN, win_src_col(nb * 32), F.in[2], WSP(bf16, WS_WIN), nb * 32, kb * 64, scr, F.lane); continue; } r -= I_IN;
        if (r < I_OUT) { const int kb = r / 64, nb = r % 64; tr_item(F.in[12], DM, DM, nb * 32, nullptr, WSP(bf16, WS_WOUT), nb * 32, kb * 64, scr, F.lane); continue; } r -= I_OUT;
        if (r < I_Q) { const int kb = r / 16, nb = r % 16; tr_item(F.in[15], DM, 512, nb * 32, F.in[13], WSP(bf16, WS_WQ), nb * 32, kb * 64, scr, F.lane); continue; } r -= I_Q;
        if (r < I_KV) { const int kb = r / 32, nb = r % 32; tr_item(F.in[16], DM, 1024, nb * 32, F.in[14], WSP(bf16, WS_WKV), nb * 32, kb * 64, scr, F.lane); continue; } r -= I_KV;
        { const int kb = r / 64, nb = r % 64; tr_item(F.in[17], 512, DM, nb * 32, nullptr, WSP(bf16, WS_WO), nb * 32, kb * 64, scr, F.lane); }
    }
    for (int m = gw; m < SEQ; m += NGW) row_to_bf16_rstd(F.in[0] + (size_t)m * DM, WSP(bf16, WS_XB) + (size_t)m * DM, WSP(float, WS_RSTD1) + m, F.lane);
    for (int m = gw; m < MEMT; m += NGW) row_to_bf16_rstd(F.in[1] + (size_t)m * DM, WSP(bf16, WS_MEMB) + (size_t)m * DM, WSP(float, WS_RSTDM) + m, F.lane);
}
__device__ __forceinline__ void p4_transposes(Frame& F) {
    LAS float* scr = (LAS float*)(F.lds + RING_OFF + F.wave * 16384);
    const int gw = F.vcu * NWAVES + F.wave, NGW = F.G * NWAVES;
    constexpr int I_GU = 32 * (2 * DFF / 32), I_D = (DFF / 64) * 64;
    for (int it = gw; it < I_GU + I_D; it += NGW) {
        int r = it;
        if (r < I_GU) { const int nblk = 2 * DFF / 32, kb = r / nblk, nb = r % nblk; const int row = nb * 32, t = row / 256, w = row % 256;
            const float* src = (w < 128) ? F.in[19] : F.in[20]; const int sc = 128 * t + (w & 127);
            tr_item(src, DM, DFF, sc, F.in[18], WSP(bf16, WS_WGU), row, kb * 64, scr, F.lane); continue; } r -= I_GU;
        { const int kb = r / 64, nb = r % 64; tr_item(F.in[21], DFF, DM, nb * 32, nullptr, WSP(bf16, WS_WD), nb * 32, kb * 64, scr, F.lane); }
    }
}

__device__ __forceinline__ float softplusf(float x) { return x > 20.f ? x : log1pf(__expf(x)); }
__device__ __forceinline__ void dn_combine(Frame& F) {
    const int gw = F.vcu * NWAVES + F.wave, NGW = F.G * NWAVES, lane = F.lane;
    const bf16* OFp = WSP(bf16, WS_OF); const bf16* OBp = WSP(bf16, WS_OB); const bf16* Z = DOP(bf16, DO_Z); bf16* Y = WSP(bf16, WS_XB); const float* gn = F.in[9];
    for (int t = gw; t < SEQ; t += NGW) {
        const size_t off = (size_t)t * 1024 + 16 * lane;
        const v4u a0 = *(const v4u*)(OFp + off), a1 = *(const v4u*)(OFp + off + 8), b0 = *(const v4u*)(OBp + off), b1 = *(const v4u*)(OBp + off + 8);
        const v4u z0 = *(const v4u*)(Z + off), z1 = *(const v4u*)(Z + off + 8);
        float o[16], zz[16];
#pragma unroll
        for (int i = 0; i < 4; ++i) { o[2 * i] = bflo(a0[i]) + bflo(b0[i]); o[2 * i + 1] = bfhi(a0[i]) + bfhi(b0[i]); o[8 + 2 * i] = bflo(a1[i]) + bflo(b1[i]); o[8 + 2 * i + 1] = bfhi(a1[i]) + bfhi(b1[i]);
            zz[2 * i] = bflo(z0[i]); zz[2 * i + 1] = bfhi(z0[i]); zz[8 + 2 * i] = bflo(z1[i]); zz[8 + 2 * i + 1] = bfhi(z1[i]); }
        float ss = 0.f;
#pragma unroll
        for (int i = 0; i < 16; ++i) ss += o[i] * o[i];
        ss += __shfl_xor(ss, 1); ss += __shfl_xor(ss, 2); ss += __shfl_xor(ss, 4);
        const float rs = 1.0f / sqrtf(ss * (1.0f / 128.0f) + RMS_EPS); const int cb = (16 * lane) & 127;
        float y[16];
#pragma unroll
        for (int i = 0; i < 16; ++i) y[i] = o[i] * rs * gn[cb + i] * siluf(zz[i]);
        v4u w0, w1;
#pragma unroll
        for (int i = 0; i < 4; ++i) { w0[i] = pk2(y[2 * i], y[2 * i + 1]); w1[i] = pk2(y[8 + 2 * i], y[8 + 2 * i + 1]); }
        bf16* yp = Y + (size_t)t * DM + 16 * lane; *(v4u*)yp = w0; *(v4u*)(yp + 8) = w1;
    }
}
__device__ __forceinline__ void final_norm(Frame& F) {
    const int gw = F.vcu * NWAVES + F.wave, NGW = F.G * NWAVES, lane = F.lane;
    const float* ss = (const float*)(F.ws + WS_CTL + CTL_SUMSQ4); const GAS f32x4* g = (const GAS f32x4*)F.in[22] + lane;
    for (int m = gw; m < SEQ; m += NGW) {
        const float r = 1.0f / sqrtf(ss[m] * (1.0f / DM) + RMS_EPS);
        GAS f32x4* o = (GAS f32x4*)(F.out + (size_t)m * DM) + lane;
#pragma unroll
        for (int j = 0; j < 8; ++j) { f32x4 v = o[64 * j]; v = v * r * g[64 * j]; o[64 * j] = v; }
    }
}

__device__ __forceinline__ int t5_bucket(int rel) {
    const int n = rel < 0 ? -rel : rel; int b;
    if (n < 8) b = n; else { int k = (31 - __builtin_clz((unsigned)(n * n))) - 6; b = 8 + k; if (b > 15) b = 15; }
    return (rel > 0 ? 16 : 0) + b;
}
template <int MODE  >
__device__ __forceinline__ void attn_unit(Frame& F, const bf16* Q, int qpitch, const bf16* Kp, const bf16* Vp, int kvpitch, bf16* O, int opitch, int q0, int kt_beg, int kt_end, const LAS float* btab, float sink2) {
    LAS unsigned char* Ks = F.lds + RING_OFF; LAS unsigned char* Vs = Ks + 16384;
    const int lane = F.lane, c = lane & 15, g = lane >> 4, qw0 = q0 + 16 * F.wave, tid = F.tid;
    bf16x8 qf[4];
#pragma unroll
    for (int t = 0; t < 4; ++t) qf[t] = *(const bf16x8*)(Q + (size_t)(qw0 + c) * qpitch + 32 * t + 8 * g);
    f32x4 oacc[8];
#pragma unroll
    for (int i = 0; i < 8; ++i) oacc[i] = (f32x4){0.f, 0.f, 0.f, 0.f};
    float mrun = (MODE == 0) ? sink2 : -1e30f, lsum = (MODE == 0 && g == 0) ? 1.0f : 0.0f;
    for (int kt = kt_beg; kt < kt_end; ++kt) {
        __syncthreads();
#pragma unroll
        for (int i = 0; i < 2; ++i) { const int ci = tid + 512 * i, key = ci >> 4, ch = ci & 15;
            const v4u kv = *(const v4u*)(Kp + (size_t)(64 * kt + key) * kvpitch + ch * 8), vv = *(const v4u*)(Vp + (size_t)(64 * kt + key) * kvpitch + ch * 8);
            *(LAS v4u*)(Ks + key * 256 + ((ch ^ (key & 15)) << 4)) = kv; *(LAS v4u*)(Vs + key * 256 + ((ch ^ ((key & 7) << 1)) << 4)) = vv; }
        __syncthreads();
        bool rel_ok = true;
        if (MODE == 0) rel_ok = (64 * kt <= qw0 + 15 + 128) && (64 * kt + 63 >= qw0 - 128);
        if (!rel_ok) continue;
        f32x4 s[4];
#pragma unroll
        for (int mt = 0; mt < 4; ++mt) s[mt] = (f32x4){0.f, 0.f, 0.f, 0.f};
#pragma unroll
        for (int t = 0; t < 4; ++t)
#pragma unroll
            for (int mt = 0; mt < 4; ++mt) { const bf16x8 kf = *(const LAS bf16x8*)(Ks + (16 * mt + c) * 256 + (((4 * t + g) ^ c) << 4));
                s[mt] = __builtin_amdgcn_mfma_f32_16x16x32_bf16(kf, qf[t], s[mt], 0, 0, 0); }
        float tmax = -INFINITY;
#pragma unroll
        for (int mt = 0; mt < 4; ++mt)
#pragma unroll
            for (int r = 0; r < 4; ++r) {
                if (MODE == 0) { const int rel = (64 * kt + 16 * mt + 4 * g + r) - (qw0 + c); const bool ok = (rel >= -128) && (rel <= 128);
                    const int ri = ok ? rel + 128 : 128; const float bv = btab[ri]; s[mt][r] = ok ? s[mt][r] + bv : -INFINITY; }
                tmax = fmaxf(tmax, s[mt][r]); }
        tmax = fmaxf(tmax, __shfl_xor(tmax, 16)); tmax = fmaxf(tmax, __shfl_xor(tmax, 32));
        const float mnew = fmaxf(mrun, tmax), alpha = __builtin_amdgcn_exp2f(mrun - mnew); mrun = mnew; float ps = 0.f;
#pragma unroll
        for (int mt = 0; mt < 4; ++mt)
#pragma unroll
            for (int r = 0; r < 4; ++r) { const float p = __builtin_amdgcn_exp2f(s[mt][r] - mnew); s[mt][r] = p; ps += p; }
        lsum = lsum * alpha + ps;
#pragma unroll
        for (int i = 0; i < 8; ++i) oacc[i] = oacc[i] * alpha;
        bf16x8 pf[2];
#pragma unroll
        for (int t2 = 0; t2 < 2; ++t2) { v4u w; w.x = cvtpk(s[2 * t2][0], s[2 * t2][1]); w.y = cvtpk(s[2 * t2][2], s[2 * t2][3]); w.z = cvtpk(s[2 * t2 + 1][0], s[2 * t2 + 1][1]); w.w = cvtpk(s[2 * t2 + 1][2], s[2 * t2 + 1][3]);
            pf[t2] = __builtin_bit_cast(bf16x8, w); }
        const int q4 = c >> 2, p4 = c & 3;
#pragma unroll
        for (int t2 = 0; t2 < 2; ++t2)
#pragma unroll
            for (int mo = 0; mo < 8; ++mo) {
                const int k1 = 32 * t2 + 4 * g + q4, k2 = k1 + 16, chn = 2 * mo + (p4 >> 1);
                const s16x4 lo = __builtin_bit_cast(s16x4, __builtin_amdgcn_ds_read_tr16_b64_v4i16((LAS s16x4*)(Vs + k1 * 256 + ((chn ^ ((k1 & 7) << 1)) << 4) + (p4 & 1) * 8)));
                const s16x4 hi = __builtin_bit_cast(s16x4, __builtin_amdgcn_ds_read_tr16_b64_v4i16((LAS s16x4*)(Vs + k2 * 256 + ((chn ^ ((k2 & 7) << 1)) << 4) + (p4 & 1) * 8)));
                const bf16x8 vf = (bf16x8){lo[0], lo[1], lo[2], lo[3], hi[0], hi[1], hi[2], hi[3]};
                oacc[mo] = __builtin_amdgcn_mfma_f32_16x16x32_bf16(vf, pf[t2], oacc[mo], 0, 0, 0); }
    }
    lsum += __shfl_xor(lsum, 16); lsum += __shfl_xor(lsum, 32);
    const float inv = 1.0f / lsum;
#pragma unroll
    for (int mo = 0; mo < 8; ++mo) { v2u w; w.x = cvtpk(oacc[mo][0] * inv, oacc[mo][1] * inv); w.y = cvtpk(oacc[mo][2] * inv, oacc[mo][3] * inv);
        *(v2u*)(O + (size_t)(qw0 + c) * opitch + 16 * mo + 4 * g) = w; }
}
__device__ __forceinline__ void swa_phase(Frame& F) {
    LAS float* btab = (LAS float*)(F.lds + RING_OFF + 32768);
    const bf16* QS = DOP(bf16, DO_QSW); const bf16* KV = DOP(bf16, DO_KVSW); bf16* Y = WSP(bf16, WS_XB);
    for (int u = blockIdx.x; u < SWH * (SEQ / 128); u += F.G) {
        const int h = u & 7, qb = u >> 3, kvh = h >> 2;
        __syncthreads();
        if (F.tid < 257) btab[F.tid] = F.in[11][t5_bucket(F.tid - 128) * 8 + h] * LOG2E;
        __syncthreads();
        int kb = 2 * qb - 2, ke = 2 * qb + 4; if (kb < 0) kb = 0; if (ke > SEQ / 64) ke = SEQ / 64;
        attn_unit<0>(F, QS + h * 128, 1024, KV + kvh * 128, KV + 256 + kvh * 128, 512, Y + 1024 + h * 128, DM, qb * 128, kb, ke, btab, F.in[10][h] * LOG2E);
    }
}
__device__ __forceinline__ void mem_attn_phase(Frame& F) {
    const bf16* QM = WSP(bf16, WS_QM); const bf16* KVm = WSP(bf16, WS_KVM); bf16* OM = WSP(bf16, WS_OM);
    for (int u = blockIdx.x; u < MEMH * (SEQ / 128); u += F.G) {
        const int h = u & 3, qb = u >> 2;
        attn_unit<1>(F, QM + h * 128, 512, KVm + h * 128, KVm + 512 + h * 128, 1024, OM + h * 128, 512, qb * 128, 0, 4, nullptr, 0.f);
    }
}

typedef float f32x16 __attribute__((ext_vector_type(16)));
constexpr int DX_W = 0, DX_Q = 16384, DX_A = 32768, DX_K = 40960, DX_U = 57344, DX_BYTES = 73728;
constexpr size_t WS_GL = 1 * MiB + 128 * 1024;
constexpr int L_RAW = 0, RAW_PITCH = 784, L_MTF = 0, L_MTB = 16384, L_TB = 32768, TB_PITCH = 144, TB_SZ = 9216;
constexpr int L_QB = 69632, L_KB = 86016, L_KT = 102400, L_VT = 120832, L_PART = 139264, L_SC = 143360;
static_assert(L_SC + 2048 <= LDSCTL_OFF, "prep LDS map");
__device__ __forceinline__ unsigned char* dnx_rec(Frame& F, int dir, int hd, int cn) { return F.ws + WS_DNX + (size_t)((dir * 8 + hd) * 256 + cn) * DX_BYTES; }
__device__ __forceinline__ v4u pack8f(const float* v) { v4u w; w.x = cvtpk(v[0], v[1]); w.y = cvtpk(v[2], v[3]); w.z = cvtpk(v[4], v[5]); w.w = cvtpk(v[6], v[7]); return w; }

template <int dir> __device__ __forceinline__ void dn_solve_and_write(LAS unsigned char* lds, int lane) {
    const LAS float* MT = (const LAS float*)(lds + (dir ? L_MTB : L_MTF));
    LAS float* Trow = (LAS float*)(lds + L_TB + dir * 2 * TB_SZ) + lane * 68;
#pragma unroll 1
    for (int jb = 15; jb >= 0; --jb) {
        const int j0 = 4 * jb;
        float a0 = (lane == j0) ? 1.f : 0.f, a1 = (lane == j0 + 1) ? 1.f : 0.f, a2 = (lane == j0 + 2) ? 1.f : 0.f, a3 = (lane == j0 + 3) ? 1.f : 0.f;
        const LAS float* mr = MT + j0 * 64;
#pragma unroll 1
        for (int s4 = jb + 1; s4 < 16; ++s4) {
            const f32x4 tv = *(const LAS f32x4*)(Trow + 4 * s4);
            const f32x4 m0 = *(const LAS f32x4*)(mr + 4 * s4), m1 = *(const LAS f32x4*)(mr + 64 + 4 * s4), m2 = *(const LAS f32x4*)(mr + 128 + 4 * s4), m3 = *(const LAS f32x4*)(mr + 192 + 4 * s4);
            a0 -= (tv[0] * m0[0] + tv[1] * m0[1]) + (tv[2] * m0[2] + tv[3] * m0[3]);
            a1 -= (tv[0] * m1[0] + tv[1] * m1[1]) + (tv[2] * m1[2] + tv[3] * m1[3]);
            a2 -= (tv[0] * m2[0] + tv[1] * m2[1]) + (tv[2] * m2[2] + tv[3] * m2[3]);
            a3 -= (tv[0] * m3[0] + tv[1] * m3[1]) + (tv[2] * m3[2] + tv[3] * m3[3]);
        }
        const f32x4 d0 = *(const LAS f32x4*)(mr + j0), d1 = *(const LAS f32x4*)(mr + 64 + j0), d2 = *(const LAS f32x4*)(mr + 128 + j0);
        const float t3 = a3, t2 = a2 - t3 * d2[3], t1 = a1 - t2 * d1[2] - t3 * d1[3], t0 = a0 - t1 * d0[1] - t2 * d0[2] - t3 * d0[3];
        *(LAS f32x4*)(Trow + j0) = (f32x4){t0, t1, t2, t3};
    }
    f32x4 tr[16];
#pragma unroll
    for (int q = 0; q < 16; ++q) tr[q] = *(const LAS f32x4*)(Trow + 4 * q);
    asm volatile("s_waitcnt lgkmcnt(0)" ::: "memory");
    const LAS float* sc = (const LAS float*)(lds + L_SC);
    const LAS float* cU = sc + (dir ? 384 : 256); const LAS float* cW = sc + (dir ? 448 : 320);
    const int pos = dir ? 63 - lane : lane;
    LAS unsigned char* tu = lds + L_TB + dir * 2 * TB_SZ + pos * TB_PITCH; LAS unsigned char* tw = tu + TB_SZ;
#pragma unroll
    for (int q = 0; q < 8; ++q) {
        float u8[8], w8[8];
#pragma unroll
        for (int e = 0; e < 8; ++e) { const int s = 8 * q + e, sp = dir ? 63 - s : s; const float t = tr[sp >> 2][sp & 3]; u8[e] = t * cU[s]; w8[e] = t * cW[s]; }
        *(LAS v4u*)(tu + q * 16) = pack8f(u8); *(LAS v4u*)(tw + q * 16) = pack8f(w8);
    }
}

__device__ __forceinline__ void dn_prep_unit(Frame& F, int cn, int hd) {
    LAS unsigned char* lds = F.lds; int tid = F.tid, lane = F.lane; const int wave = F.wave;
    asm volatile("" : "+v"(tid), "+v"(lane));
    const bf16* QKV = WSP(bf16, WS_QKV);
    LAS float* sc = (LAS float*)(lds + L_SC);
    __syncthreads();
    for (int ci = tid; ci < 68 * 48; ci += 512) {
        const int row = ci / 48, cc = ci % 48, seg = cc >> 4, ch = (cc & 15) * 8, tok = 64 * cn - 2 + row;
        v4u v = (v4u){0u, 0u, 0u, 0u};
        if (tok >= 0 && tok < SEQ) v = *(const v4u*)(QKV + (size_t)tok * 3072 + seg * 1024 + hd * 128 + ch);
        *(LAS v4u*)(lds + L_RAW + row * RAW_PITCH + (seg * 128 + ch) * 2) = v;
    }
    if (wave == 0) {
        const float* ab = WSP(float, WS_AB) + (size_t)(64 * cn + lane) * 32;
        const float bfv = 1.0f / (1.0f + __expf(-ab[hd])), bbv = 1.0f / (1.0f + __expf(-ab[8 + hd]));
        const float gf = -__expf(F.in[5][hd]) * softplusf(ab[16 + hd] + F.in[7][hd]), gb = -__expf(F.in[6][hd]) * softplusf(ab[24 + hd] + F.in[8][hd]);
        float Gf = gf, Gb = gb;
#pragma unroll
        for (int o = 1; o < 64; o <<= 1) { const float a = __shfl_up(Gf, o), b = __shfl_down(Gb, o); if (lane >= o) Gf += a; if (lane + o < 64) Gb += b; }
        sc[lane] = Gf; sc[64 + lane] = Gb; sc[128 + lane] = bfv; sc[192 + lane] = bbv;
        sc[256 + lane] = bfv; sc[320 + lane] = -bfv * __expf(Gf); sc[384 + lane] = bbv; sc[448 + lane] = -bbv * __expf(Gb);
        float* GL = WSP(float, WS_GL);
        if (lane == 63) GL[(0 * 8 + hd) * 256 + cn] = __expf(Gf);
        if (lane == 0) GL[(1 * 8 + hd) * 256 + cn] = __expf(Gb);
    }
    __syncthreads();
    asm volatile("" : "+v"(tid), "+v"(lane));
    {
        const int t = wave, pos = lane; const float* cw = F.in[4] + hd * 128 + 16 * t;
        float qv[16], kv[16], vv[16];
#pragma unroll
        for (int seg = 0; seg < 3; ++seg) {
            float a[16];
#pragma unroll
            for (int i = 0; i < 16; ++i) a[i] = 0.f;
#pragma unroll
            for (int j = 0; j < 5; ++j) {
                const LAS unsigned char* rp = lds + L_RAW + (pos + j) * RAW_PITCH + (seg * 128 + 16 * t) * 2;
                const v4u r0 = *(const LAS v4u*)rp, r1 = *(const LAS v4u*)(rp + 16);
                const float* w = cw + j * 3072 + seg * 1024;
#pragma unroll
                for (int i = 0; i < 4; ++i) { a[2 * i] += w[2 * i] * bflo(r0[i]); a[2 * i + 1] += w[2 * i + 1] * bfhi(r0[i]); a[8 + 2 * i] += w[8 + 2 * i] * bflo(r1[i]); a[8 + 2 * i + 1] += w[8 + 2 * i + 1] * bfhi(r1[i]); }
            }
#pragma unroll
            for (int i = 0; i < 16; ++i) { const float s = siluf(a[i]); if (seg == 0) qv[i] = s; else if (seg == 1) kv[i] = s; else vv[i] = s; }
        }
        float sq = 0.f, sk = 0.f;
#pragma unroll
        for (int i = 0; i < 16; ++i) { sq += qv[i] * qv[i]; sk += kv[i] * kv[i]; }
        LAS float* part = (LAS float*)(lds + L_PART);
        part[t * 64 + pos] = sq; part[512 + t * 64 + pos] = sk;
        __syncthreads();
        float tq = 0.f, tk = 0.f;
#pragma unroll
        for (int i = 0; i < 8; ++i) { tq += part[i * 64 + pos]; tk += part[512 + i * 64 + pos]; }
        const float rq = (1.0f / sqrtf(tq + 1e-6f)) * 0.08838834764831845f, rk = 1.0f / sqrtf(tk + 1e-6f);
#pragma unroll
        for (int i = 0; i < 16; ++i) { qv[i] *= rq; kv[i] *= rk; }
        *(LAS v4u*)(lds + L_QB + pos * 256 + (((2 * t) ^ (pos & 15)) << 4)) = pack8f(qv); *(LAS v4u*)(lds + L_QB + pos * 256 + (((2 * t + 1) ^ (pos & 15)) << 4)) = pack8f(qv + 8);
        *(LAS v4u*)(lds + L_KB + pos * 256 + (((2 * t) ^ (pos & 15)) << 4)) = pack8f(kv); *(LAS v4u*)(lds + L_KB + pos * 256 + (((2 * t + 1) ^ (pos & 15)) << 4)) = pack8f(kv + 8);
#pragma unroll
        for (int i = 0; i < 16; ++i) { *(LAS unsigned short*)(lds + L_KT + (16 * t + i) * TB_PITCH + pos * 2) = (unsigned short)f2bf(kv[i]); *(LAS unsigned short*)(lds + L_VT + (16 * t + i) * TB_PITCH + pos * 2) = (unsigned short)f2bf(vv[i]); }
        const float ef = __expf(sc[pos]), eb = __expf(sc[64 + pos]); const int mt = pos >> 5;
#pragma unroll
        for (int dir = 0; dir < 2; ++dir) { const float e = dir ? eb : ef; unsigned char* rec = dnx_rec(F, dir, hd, cn) + DX_Q;
#pragma unroll
            for (int lh = 0; lh < 2; ++lh) { float o8[8];
#pragma unroll
                for (int j = 0; j < 8; ++j) o8[j] = qv[8 * (j >> 2) + 4 * lh + (j & 3)] * e;
                *(v4u*)(rec + ((mt * 8 + t) * 64 + 32 * lh + (pos & 31)) * 16) = pack8f(o8); } }
    }
    __syncthreads();
    asm volatile("" : "+v"(tid), "+v"(lane));
    {
        const int r = lane & 31, lh = lane >> 5, x = wave & 3, ta = x >> 1, tb = x & 1;
        const LAS unsigned char* Ab = lds + L_KB + (32 * ta + r) * 256; const LAS unsigned char* Bb = lds + (wave < 4 ? L_KB : L_QB) + (32 * tb + r) * 256;
        f32x16 acc;
#pragma unroll
        for (int i = 0; i < 16; ++i) acc[i] = 0.f;
#pragma unroll
        for (int kk = 0; kk < 8; ++kk) { const int ch = ((2 * kk + lh) ^ (r & 15)) << 4;
            acc = __builtin_amdgcn_mfma_f32_32x32x16_bf16(*(const LAS bf16x8*)(Ab + ch), *(const LAS bf16x8*)(Bb + ch), acc, 0, 0, 0); }
        const int b = 32 * tb + r;
        if (wave < 4) {
            const float Gfb = sc[b], Gbb = sc[64 + b];
#pragma unroll
            for (int q = 0; q < 4; ++q) { const int a0 = 32 * ta + 8 * q + 4 * lh; f32x4 mf, mb;
#pragma unroll
                for (int e = 0; e < 4; ++e) { const int a = a0 + e; const float kkv = acc[4 * q + e];
                    const float vf = sc[128 + a] * kkv * __expf(fminf(sc[a] - Gfb, 0.f)), vb = sc[192 + a] * kkv * __expf(fminf(sc[64 + a] - Gbb, 0.f));
                    mf[e] = (a > b) ? vf : 0.f; mb[3 - e] = (a < b) ? vb : 0.f; }
                *(LAS f32x4*)(lds + L_MTF + (b * 64 + a0) * 4) = mf; *(LAS f32x4*)(lds + L_MTB + ((63 - b) * 64 + 60 - a0) * 4) = mb; }
        } else {
            const float Gfc = sc[b], Gbc = sc[64 + b];
#pragma unroll
            for (int dir = 0; dir < 2; ++dir) { unsigned char* rec = dnx_rec(F, dir, hd, cn) + DX_A;
#pragma unroll
                for (int s2 = 0; s2 < 2; ++s2) { float o8[8];
#pragma unroll
                    for (int j = 0; j < 8; ++j) { const int s = 32 * ta + 16 * s2 + 8 * (j >> 2) + 4 * lh + (j & 3); const float v = acc[8 * s2 + j];
                        const float ev = v * __expf(fminf(dir ? Gbc - sc[64 + s] : Gfc - sc[s], 0.f)); o8[j] = (dir ? (s >= b) : (s <= b)) ? ev : 0.f; }
                    *(v4u*)(rec + ((tb * 4 + 2 * ta + s2) * 64 + lane) * 16) = pack8f(o8); } }
        }
    }
    __syncthreads();
    asm volatile("" : "+v"(tid), "+v"(lane));
    if (wave == 0) dn_solve_and_write<0>(lds, lane);
    else if (wave == 1) dn_solve_and_write<1>(lds, lane);
    else {
        const int r = lane & 31, lh = lane >> 5;
        for (int f = wave - 2; f < 32; f += 6) { const int dir = f >> 4, m = (f >> 2) & 3, t = f & 3; const int dk = 32 * m + r;
            const v2u k0 = *(const LAS v2u*)(lds + L_KT + dk * TB_PITCH + (16 * t + 4 * lh) * 2), k1 = *(const LAS v2u*)(lds + L_KT + dk * TB_PITCH + (16 * t + 8 + 4 * lh) * 2);
            const float Gl = dir ? sc[64] : sc[63]; const LAS float* Gs = sc + (dir ? 64 : 0) + 16 * t + 4 * lh; float o8[8];
            o8[0] = bflo(k0.x) * __expf(Gl - Gs[0]); o8[1] = bfhi(k0.x) * __expf(Gl - Gs[1]); o8[2] = bflo(k0.y) * __expf(Gl - Gs[2]); o8[3] = bfhi(k0.y) * __expf(Gl - Gs[3]);
            o8[4] = bflo(k1.x) * __expf(Gl - Gs[8]); o8[5] = bfhi(k1.x) * __expf(Gl - Gs[9]); o8[6] = bflo(k1.y) * __expf(Gl - Gs[10]); o8[7] = bfhi(k1.y) * __expf(Gl - Gs[11]);
            *(v4u*)(dnx_rec(F, dir, hd, cn) + DX_K + ((m * 4 + t) * 64 + lane) * 16) = pack8f(o8); }
    }
    __syncthreads();
    asm volatile("" : "+v"(tid), "+v"(lane));
    {
        const int dir = wave >> 2, x = wave & 3, r = lane & 31, lh = lane >> 5;
        const LAS unsigned char* Tu = lds + L_TB + (dir ? 2 : 0) * TB_SZ; const LAS unsigned char* Tw = Tu + TB_SZ;
        unsigned char* rec = dnx_rec(F, dir, hd, cn);
#pragma unroll
        for (int mt = 0; mt < 2; ++mt) {
            f32x16 aw, au;
#pragma unroll
            for (int i = 0; i < 16; ++i) { aw[i] = 0.f; au[i] = 0.f; }
#pragma unroll
            for (int kk = 0; kk < 4; ++kk) { const int so = (16 * kk + 8 * lh) * 2;
                aw = __builtin_amdgcn_mfma_f32_32x32x16_bf16(*(const LAS bf16x8*)(lds + L_KT + (32 * x + r) * TB_PITCH + so), *(const LAS bf16x8*)(Tw + (32 * mt + r) * TB_PITCH + so), aw, 0, 0, 0);
                au = __builtin_amdgcn_mfma_f32_32x32x16_bf16(*(const LAS bf16x8*)(Tu + (32 * mt + r) * TB_PITCH + so), *(const LAS bf16x8*)(lds + L_VT + (32 * x + r) * TB_PITCH + so), au, 0, 0, 0); }
            float tmp[16];
#pragma unroll
            for (int i = 0; i < 16; ++i) tmp[i] = aw[i];
            *(v4u*)(rec + DX_W + ((mt * 8 + 2 * x) * 64 + lane) * 16) = pack8f(tmp); *(v4u*)(rec + DX_W + ((mt * 8 + 2 * x + 1) * 64 + lane) * 16) = pack8f(tmp + 8);
#pragma unroll
            for (int i = 0; i < 16; ++i) tmp[i] = au[i];
            *(v4u*)(rec + DX_U + ((x * 2 + mt) * 64 + lane) * 32) = pack8f(tmp); *(v4u*)(rec + DX_U + ((x * 2 + mt) * 64 + lane) * 32 + 16) = pack8f(tmp + 8);
        }
    }
}
__device__ __forceinline__ void dn_prep_phase(Frame& F) {
    for (int u = blockIdx.x; u < 256 * DNH; u += F.G) dn_prep_unit(F, u >> 3, u & 7);
}

constexpr int SCAN_BUF = 57344;
__device__ __forceinline__ bf16x8 cvt8(const f32x16& v, int o) { v4u w; w.x = cvtpk(v[o], v[o + 1]); w.y = cvtpk(v[o + 2], v[o + 3]); w.z = cvtpk(v[o + 4], v[o + 5]); w.w = cvtpk(v[o + 6], v[o + 7]); return __builtin_bit_cast(bf16x8, w); }
__device__ __forceinline__ void dn_scan_phase(Frame& F) {
    const int b = blockIdx.x; if (b >= 16) return;
    const int dir = b >> 3, hd = b & 7, lane = F.lane, wave = F.wave, r = lane & 31, lh = lane >> 5;
    LAS unsigned char* lds = F.lds;
    const float* GL = WSP(float, WS_GL) + (dir * 8 + hd) * 256;
    bf16* O = WSP(bf16, dir ? WS_OB : WS_OF);
    __syncthreads();
    if (wave >= 4) {
        const int lw = wave - 4;
        for (int n = 0; n <= 256; ++n) {
            if (n < 256) { const int cn = dir ? 255 - n : n; const unsigned char* src = dnx_rec(F, dir, hd, cn) + lane * 16; LAS unsigned char* dst = lds + (n & 1) * SCAN_BUF;
#pragma unroll
                for (int i = 0; i < 14; ++i) { const int p = lw + 4 * i; __builtin_amdgcn_global_load_lds((const unsigned*)(src + p * 1024), (LAS unsigned*)(dst + p * 1024), 16, 0, 0); } }
            asm volatile("s_waitcnt vmcnt(0)" ::: "memory");
            __builtin_amdgcn_s_barrier(); asm volatile("" ::: "memory");
        }
    } else {
        const int d = wave;
        f32x16 S[4];
#pragma unroll
        for (int m = 0; m < 4; ++m)
#pragma unroll
            for (int i = 0; i < 16; ++i) S[m][i] = 0.f;
        v4u un[2][2];
        { const int cn = dir ? 255 : 0; const unsigned char* up = dnx_rec(F, dir, hd, cn) + DX_U;
#pragma unroll
          for (int mt = 0; mt < 2; ++mt) { un[mt][0] = *(const v4u*)(up + ((d * 2 + mt) * 64 + lane) * 32); un[mt][1] = *(const v4u*)(up + ((d * 2 + mt) * 64 + lane) * 32 + 16); } }
        __builtin_amdgcn_s_barrier(); asm volatile("" ::: "memory");
        for (int n = 0; n < 256; ++n) {
            const int cn = dir ? 255 - n : n; const LAS unsigned char* buf = lds + (n & 1) * SCAN_BUF + lane * 16; const float gl = GL[cn];
            f32x16 aV[2], aO[2];
#pragma unroll
            for (int mt = 0; mt < 2; ++mt)
#pragma unroll
                for (int i = 0; i < 4; ++i) { aV[mt][2 * i] = bflo(un[mt][0][i]); aV[mt][2 * i + 1] = bfhi(un[mt][0][i]); aV[mt][8 + 2 * i] = bflo(un[mt][1][i]); aV[mt][8 + 2 * i + 1] = bfhi(un[mt][1][i]); }
#pragma unroll
            for (int mt = 0; mt < 2; ++mt)
#pragma unroll
                for (int i = 0; i < 16; ++i) aO[mt][i] = 0.f;
            if (n + 1 < 256) { const int cn1 = dir ? 254 - n : n + 1; const unsigned char* up = dnx_rec(F, dir, hd, cn1) + DX_U;
#pragma unroll
                for (int mt = 0; mt < 2; ++mt) { un[mt][0] = *(const v4u*)(up + ((d * 2 + mt) * 64 + lane) * 32); un[mt][1] = *(const v4u*)(up + ((d * 2 + mt) * 64 + lane) * 32 + 16); } }
#pragma unroll
            for (int t = 0; t < 8; ++t) { const bf16x8 sb = cvt8(S[t >> 1], 8 * (t & 1));
#pragma unroll
                for (int mt = 0; mt < 2; ++mt) {
                    aV[mt] = __builtin_amdgcn_mfma_f32_32x32x16_bf16(*(const LAS bf16x8*)(buf + DX_W + (mt * 8 + t) * 1024), sb, aV[mt], 0, 0, 0);
                    aO[mt] = __builtin_amdgcn_mfma_f32_32x32x16_bf16(*(const LAS bf16x8*)(buf + DX_Q + (mt * 8 + t) * 1024), sb, aO[mt], 0, 0, 0); } }
            bf16x8 vb[4];
#pragma unroll
            for (int t = 0; t < 4; ++t) vb[t] = cvt8(aV[t >> 1], 8 * (t & 1));
#pragma unroll
            for (int m = 0; m < 4; ++m) S[m] = S[m] * gl;
#pragma unroll
            for (int t = 0; t < 4; ++t) {
#pragma unroll
                for (int m = 0; m < 4; ++m) S[m] = __builtin_amdgcn_mfma_f32_32x32x16_bf16(*(const LAS bf16x8*)(buf + DX_K + (m * 4 + t) * 1024), vb[t], S[m], 0, 0, 0);
#pragma unroll
                for (int mt = 0; mt < 2; ++mt) aO[mt] = __builtin_amdgcn_mfma_f32_32x32x16_bf16(*(const LAS bf16x8*)(buf + DX_A + (mt * 4 + t) * 1024), vb[t], aO[mt], 0, 0, 0); }
            bf16* op = O + (size_t)(64 * cn + 4 * lh) * 1024 + hd * 128 + 32 * d + r;
#pragma unroll
            for (int mt = 0; mt < 2; ++mt)
#pragma unroll
                for (int i = 0; i < 16; ++i) op[(size_t)(32 * mt + (i & 3) + 8 * (i >> 2)) * 1024] = (bf16)f2bf(aO[mt][i]);
            asm volatile("s_waitcnt lgkmcnt(0)" ::: "memory");
            __builtin_amdgcn_s_barrier(); asm volatile("" ::: "memory");
        }
    }
    __syncthreads();
}

#ifndef MK_N_LAUNCHES
#define MK_N_LAUNCHES 1
#endif
constexpr int N_PHASES = 12;
struct Args { const float* in[23]; float* out; unsigned char* ws; int ph_lo, ph_hi; };
static_assert(sizeof(Args) == 23 * 8 + 8 + 8 + 8, "Args has no padding");

__global__ void __launch_bounds__(NWAVES * 64, 2) enc_fwd(Args args) {
    extern __shared__ __attribute__((aligned(16))) unsigned char lds[];
    Frame F;
    F.lds = (LAS unsigned char*)lds;
    F.MISC = (volatile LAS unsigned*)(F.lds + MISC_OFF);
    F.tid = threadIdx.x; F.lane = F.tid & 63; F.wave = __builtin_amdgcn_readfirstlane(F.tid >> 6);
    F.G = gridDim.x; { const int bx = blockIdx.x; F.vcu = (F.G % 8 == 0) ? (bx % 8) * (F.G / 8) + bx / 8 : bx; }
#pragma unroll
    for (int i = 0; i < 23; ++i) F.in[i] = args.in[i];
    F.out = args.out; F.ws = args.ws; F.ctl = (gu32*)(args.ws + WS_CTL);
    for (int u = F.tid; u < (LDS_BYTES - LDSCTL_OFF) / 4; u += NWAVES * 64) ((LAS unsigned*)(F.lds + LDSCTL_OFF))[u] = 0u;
    __syncthreads();
    const int lo = args.ph_lo, hi = args.ph_hi;
    XcdBarrier bar; bar.bar = (unsigned*)(F.ctl + CW_BAR); bar.x = 0; bar.st = nullptr;
    if (hi - lo > 1) bar = xcd_barrier_post((unsigned*)(F.ctl + CW_BAR), F.MISC + 8);
#define IN(k) (lo <= (k) && (k) < hi)
#define SEAM(k) do { if (IN(k) && IN((k) + 1)) xcd_barrier(bar); } while (0)
    float* sumsq2 = (float*)(F.ws + WS_CTL + CTL_SUMSQ2); float* sumsq3 = (float*)(F.ws + WS_CTL + CTL_SUMSQ3); float* sumsq4 = (float*)(F.ws + WS_CTL + CTL_SUMSQ4);

    if (IN(0)) { p0_prologue(F); } SEAM(0);
    if (IN(1)) {
        { pg8::Gemm g{WSP(bf16, WS_XB), WSP(bf16, WS_WIN), SEQ, NINP, DM}; pg8::StaticOrder S; S.init(SEQ, NINP, F.G, (int)blockIdx.x);
          EpiProj E{WSP(float, WS_RSTD1), WSP(bf16, WS_QKV), DOP(bf16, DO_Z), DOP(bf16, DO_QSW), DOP(bf16, DO_KVSW), WSP(float, WS_AB)};
          pg8::gemm_phase<EpiProj, pg8::StaticOrder, true, true>(F.lds + RING_OFF, g, S, E); }
        { pg8::Gemm g{WSP(bf16, WS_MEMB), WSP(bf16, WS_WKV), MEMT, 1024, DM}; pg8::StaticOrder S; S.init(MEMT, 1024, F.G, (int)blockIdx.x);
          EpiScaleBf16 E{WSP(float, WS_RSTDM), 0, 1.0f, WSP(bf16, WS_KVM), 1024};
          pg8::gemm_phase<EpiScaleBf16, pg8::StaticOrder, true, true>(F.lds + RING_OFF, g, S, E); }
    } SEAM(1);
    if (IN(2)) { dn_prep_phase(F); swa_phase(F); } SEAM(2);
    if (IN(3)) { dn_scan_phase(F); } SEAM(3);
    if (IN(4)) { dn_combine(F); p4_transposes(F); } SEAM(4);
    if (IN(5)) {
        pg8::Gemm g{WSP(bf16, WS_XB), WSP(bf16, WS_WOUT), SEQ, DM, DM}; pg8::StaticOrder S; S.init(SEQ, DM, F.G, (int)blockIdx.x);
        EpiRes E{F.in[0], F.out, WSP(bf16, WS_H1B), sumsq2};
        pg8::gemm_phase<EpiRes, pg8::StaticOrder, true, true>(F.lds + RING_OFF, g, S, E);
    } SEAM(5);
    if (IN(6)) {
        pg8::Gemm g{WSP(bf16, WS_H1B), WSP(bf16, WS_WQ), SEQ, 512, DM}; pg8::StaticOrder S; S.init(SEQ, 512, F.G, (int)blockIdx.x);
        EpiScaleBf16 E{sumsq2, 1, QSCALE, WSP(bf16, WS_QM), 512};
        pg8::gemm_phase<EpiScaleBf16, pg8::StaticOrder, true, true>(F.lds + RING_OFF, g, S, E);
    } SEAM(6);
    if (IN(7)) { mem_attn_phase(F); } SEAM(7);
    if (IN(8)) {
        pg8::Gemm g{WSP(bf16, WS_OM), WSP(bf16, WS_WO), SEQ, DM, 512}; pg8::StaticOrder S; S.init(SEQ, DM, F.G, (int)blockIdx.x);
        EpiRes E{F.out, F.out, WSP(bf16, WS_XB), sumsq3};
        pg8::gemm_phase<EpiRes, pg8::StaticOrder, true, true>(F.lds + RING_OFF, g, S, E);
    } SEAM(8);
    if (IN(9)) {
        pg8::Gemm g{WSP(bf16, WS_XB), WSP(bf16, WS_WGU), SEQ, 2 * DFF, DM}; pg8::StaticOrder S; S.init(SEQ, 2 * DFF, F.G, (int)blockIdx.x);
        EpiSwiglu E{sumsq3, WSP(bf16, WS_HID)};
        pg8::gemm_phase<EpiSwiglu, pg8::StaticOrder, true, true>(F.lds + RING_OFF, g, S, E);
    } SEAM(9);
    if (IN(10)) {
        pg8::Gemm g{WSP(bf16, WS_HID), WSP(bf16, WS_WD), SEQ, DM, DFF}; pg8::StaticOrder S; S.init(SEQ, DM, F.G, (int)blockIdx.x);
        EpiRes E{F.out, F.out, nullptr, sumsq4};
        pg8::gemm_phase<EpiRes, pg8::StaticOrder, true, true>(F.lds + RING_OFF, g, S, E);
    } SEAM(10);
    if (IN(11)) { final_norm(F); }
#undef IN
#undef SEAM
}

extern "C" void kernel_launch(void* const* d_in, const int* in_sizes, int n_in, void* d_out, int out_size, void* d_ws, size_t ws_size, hipStream_t stream) {
    static int grid = 0;
    if (grid == 0) {
        if (n_in != 23 || out_size != SEQ * DM || ws_size < WS_END) { fprintf(stderr, "kernel_launch: unexpected shapes (n_in %d out %d ws %zu)\n", n_in, out_size, ws_size); grid = -1; return; }
        int dev = 0, cus = 0;
        if (hipGetDevice(&dev) != hipSuccess || hipDeviceGetAttribute(&cus, hipDeviceAttributeMultiprocessorCount, dev) != hipSuccess) { grid = -1; return; }
        if (hipFuncSetAttribute((const void*)enc_fwd, hipFuncAttributeMaxDynamicSharedMemorySize, LDS_BYTES) != hipSuccess) { fprintf(stderr, "kernel_launch: hipFuncSetAttribute failed\n"); grid = -1; return; }
        (void)hipGetLastError();
        grid = cus;
    }
    if (grid < 0) return;
    if (hipMemsetAsync((char*)d_ws + WS_CTL, 0, CTL_ZERO_BYTES, stream) != hipSuccess) return;
    Args a{};
    for (int i = 0; i < 23; ++i) a.in[i] = (const float*)d_in[i];
    a.out = (float*)d_out; a.ws = (unsigned char*)d_ws;
    const int per = (N_PHASES + MK_N_LAUNCHES - 1) / MK_N_LAUNCHES;
    for (int lo = 0; lo < N_PHASES; lo += per) {
        a.ph_lo = lo; a.ph_hi = (lo + per < N_PHASES) ? lo + per : N_PHASES;
        hipLaunchKernelGGL(enc_fwd, dim3(grid), dim3(NWAVES * 64), LDS_BYTES, stream, a);
    }
}
```

```cpp
#include <hip/hip_runtime.h>
#include <cstdio>
#include <cstdint>
namespace pg8 {
__device__ __forceinline__ unsigned cvt_pk_bf16(float lo, float hi) { unsigned r; asm volatile("v_cvt_pk_bf16_f32 %0, %1, %2" : "=v"(r) : "v"(lo), "v"(hi)); return r; }
#define PG8_LAS __attribute__((address_space(3)))
typedef unsigned short bf16_t;
typedef short bf16x8 __attribute__((ext_vector_type(8)));
typedef float f32x4 __attribute__((ext_vector_type(4)));
typedef unsigned u32x4 __attribute__((ext_vector_type(4)));
constexpr int BM = 256, BK = 64, HALF = 128, HTB = HALF * BK * 2  , STAGE_BYTES = 8 * HTB, NXCD = 8, WGM = 8;

__host__ __device__ __forceinline__ int lds_byte(int r, int c) { const int st = (r >> 4) * 2 + (c >> 5), rr = r & 15, cc = c & 31, ob = rr * 64 + cc * 2; return st * 1024 + (ob ^ (((ob >> 9) & 1) << 5)); }
__host__ __device__ __forceinline__ void stage_rc(int b, int& R, int& C) { const int st = b / 1024, sb = b % 1024, swz = sb ^ (((sb >> 9) & 1) << 5); R = (st >> 1) * 16 + swz / 64; C = (st & 1) * 32 + (swz % 64) / 2; }
__host__ __device__ __forceinline__ int perm32(int rho) { const int n = rho >> 4, i = rho & 15; return 8 * (i >> 2) + 4 * n + (i & 3); }

struct Unit { int pm, pn; };
struct Gemm { const bf16_t* A; const bf16_t* Bt; int M, N, K; };

struct StaticOrder {
    int nM, nN, nwg, G, c;
    __host__ __device__ void init(int M, int N, int G_, int c_) { nM = M / BM; nN = N / BM; nwg = nM * nN; G = G_; c = c_; }
    __host__ __device__ bool next(int i, Unit& u) const {
        const long L = (long)i * G + c; if (L >= nwg) return false;
        int wgid = (int)L; { const int q = nwg / NXCD, r = nwg % NXCD, xcd = wgid % NXCD, off = wgid / NXCD; wgid = (xcd < r ? xcd * (q + 1) : r * (q + 1) + (xcd - r) * q) + off; }
        const int nig = WGM * nN, gid = wgid / nig, fm = gid * WGM, gsz = (nM - fm) < WGM ? (nM - fm) : WGM;
        u.pm = fm + ((wgid % nig) % gsz); u.pn = (wgid % nig) / gsz; return true;
    }
    __device__ __forceinline__ void a_ready(const Unit&) const {}
    __device__ __forceinline__ void done(const Unit&) const {}
};

template <class Epi, class Sched, bool ALIGN_EPI = false, bool SP2 = false>
__device__ __forceinline__ void gemm_phase(PG8_LAS unsigned char* lds, const Gemm g, const Sched& S, const Epi& E) {
    const int tid = threadIdx.x, wid = __builtin_amdgcn_readfirstlane(tid >> 6), lane = tid & 63, wr = wid >> 2, wc = wid & 3, fr = lane & 15, fq = lane >> 4;
    const int K = g.K, nt = K / BK;
    unsigned voffA[2], voffB[2];
#pragma unroll
    for (int i = 0; i < 2; ++i) { int R, C; stage_rc(tid * 16 + i * 8192, R, C); const int Rb = Epi::PERM ? ((R & ~31) + perm32(R & 31)) : R;
        voffA[i] = (unsigned)(R * K + C) * 2u; voffB[i] = (unsigned)(Rb * K + C) * 2u; }
    const size_t kstep = (size_t)(BK * 2);
    const size_t hstep = (size_t)HALF * K * 2;
    const size_t tstep = 2 * hstep;
    const unsigned ldsw = (unsigned)wid * 1024u;
    const int aoff = lds_byte(wr * 64 + fr, fq * 8), boff = lds_byte(wc * 32 + fr, fq * 8);
#define PG8_SA(b, h) (((b) * 2 + (h)) * HTB)
#define PG8_SB(b, h) ((4 + (b) * 2 + (h)) * HTB)
#define PG8_STAGE(bufoff, gbase, voff) do { _Pragma("unroll") for (int _i = 0; _i < 2; ++_i) \
        __builtin_amdgcn_global_load_lds((const unsigned*)((const char*)(gbase) + (voff)[_i]), (PG8_LAS unsigned*)(lds + (bufoff) + ldsw + _i * 8192), 16, 0, 0); } while (0)
#define PG8_LDA(dst, b, h) do { _Pragma("unroll") for (int m = 0; m < 4; ++m) _Pragma("unroll") for (int k = 0; k < 2; ++k) dst[m][k] = *(const PG8_LAS bf16x8*)(lds + PG8_SA(b, h) + aoff + m * 2048 + k * 1024); } while (0)
#define PG8_LDB(dst, b, h) do { _Pragma("unroll") for (int n = 0; n < 2; ++n) _Pragma("unroll") for (int k = 0; k < 2; ++k) dst[n][k] = *(const PG8_LAS bf16x8*)(lds + PG8_SB(b, h) + boff + n * 2048 + k * 1024); } while (0)
#define PG8_MMA(ai, bj, At, Bt) do { __builtin_amdgcn_s_setprio(1); _Pragma("unroll") for (int m = 0; m < 4; ++m) _Pragma("unroll") for (int n = 0; n < 2; ++n) _Pragma("unroll") for (int k = 0; k < 2; ++k) \
        acc[ai][bj][m][n] = __builtin_amdgcn_mfma_f32_16x16x32_bf16(Bt[n][k], At[m][k], acc[ai][bj][m][n], 0, 0, 0); __builtin_amdgcn_s_setprio(0); } while (0)
#define PG8_WAIT_V(n) asm volatile("s_waitcnt vmcnt(" #n ")" ::: "memory")
#define PG8_WAIT_L(n) asm volatile("s_waitcnt lgkmcnt(" #n ")" ::: "memory")
#define PG8_BAR __builtin_amdgcn_s_barrier()
#define PG8_SCHED __builtin_amdgcn_sched_barrier(0)
    Unit cur, nxt; int ui = 0;
    if (!S.next(0, cur)) return;
    f32x4 acc[2][2][4][2];
#pragma unroll
    for (int a = 0; a < 2; ++a)
#pragma unroll
        for (int b = 0; b < 2; ++b)
#pragma unroll
            for (int m = 0; m < 4; ++m)
#pragma unroll
                for (int n = 0; n < 2; ++n) acc[a][b][m][n] = (f32x4){0.f, 0.f, 0.f, 0.f};
    bf16x8 At[4][2], B0[2][2], B1[2][2];
    const char* cA = (const char*)g.A + (size_t)cur.pm * tstep; const char* cB = (const char*)g.Bt + (size_t)cur.pn * tstep;
    S.a_ready(cur);
    if constexpr (SP2) {
        PG8_STAGE(PG8_SB(0, 0), cB, voffB); PG8_STAGE(PG8_SB(0, 1), cB + hstep, voffB); PG8_STAGE(PG8_SA(0, 0), cA, voffA); PG8_STAGE(PG8_SA(0, 1), cA + hstep, voffA);
        if (wr == 1) PG8_BAR;
        PG8_WAIT_V(2); PG8_BAR;
        PG8_STAGE(PG8_SB(1, 0), cB + kstep, voffB); PG8_STAGE(PG8_SA(1, 0), cA + kstep, voffA); PG8_STAGE(PG8_SB(1, 1), cB + hstep + kstep, voffB);
        PG8_WAIT_V(6); PG8_BAR;
    } else {
        PG8_STAGE(PG8_SB(0, 0), cB, voffB); PG8_STAGE(PG8_SA(0, 0), cA, voffA); PG8_STAGE(PG8_SB(0, 1), cB + hstep, voffB); PG8_STAGE(PG8_SA(0, 1), cA + hstep, voffA);
        if (wr == 1) PG8_BAR;
        PG8_WAIT_V(4); PG8_BAR;
        PG8_STAGE(PG8_SB(1, 0), cB + kstep, voffB); PG8_STAGE(PG8_SA(1, 0), cA + kstep, voffA); PG8_STAGE(PG8_SB(1, 1), cB + hstep + kstep, voffB);
        PG8_WAIT_V(6); PG8_BAR;
    }
    for (;;) {
        const bool has_next = S.next(ui + 1, nxt);
        const char* nA = has_next ? (const char*)g.A + (size_t)nxt.pm * tstep : cA; const char* nB = has_next ? (const char*)g.Bt + (size_t)nxt.pn * tstep : cB;
        for (int t = 0; t < nt; t += 2) {
            const bool last = (t == nt - 2);
            const char* a1 = cA + (size_t)(t + 1) * kstep;
            const char* a2 = last ? nA : cA + (size_t)(t + 2) * kstep; const char* b2 = last ? nB : cB + (size_t)(t + 2) * kstep;
            const char* a3 = a2 + kstep; const char* b3 = b2 + kstep;
            if (last && has_next) S.a_ready(nxt);
            if constexpr (SP2) {
            PG8_LDB(B0, 0, 0); PG8_LDB(B1, 0, 1); PG8_SCHED; PG8_LDA(At, 0, 0); PG8_STAGE(PG8_SA(1, 1), a1 + hstep, voffA);
            PG8_WAIT_V(8); PG8_WAIT_L(0); PG8_BAR; PG8_MMA(0, 0, At, B0); PG8_MMA(0, 1, At, B1); PG8_BAR; PG8_SCHED;
            PG8_LDA(At, 0, 1); PG8_STAGE(PG8_SB(0, 0), b2, voffB); PG8_STAGE(PG8_SB(0, 1), b2 + hstep, voffB); PG8_STAGE(PG8_SA(0, 0), a2, voffA);
            PG8_WAIT_V(8); PG8_WAIT_L(0); PG8_BAR; PG8_MMA(1, 0, At, B0); PG8_MMA(1, 1, At, B1); PG8_BAR; PG8_SCHED;
            PG8_LDB(B0, 1, 0); PG8_LDB(B1, 1, 1); PG8_SCHED; PG8_LDA(At, 1, 0); PG8_STAGE(PG8_SA(0, 1), a2 + hstep, voffA);
            PG8_WAIT_V(8); PG8_WAIT_L(0); PG8_BAR; PG8_MMA(0, 0, At, B0); PG8_MMA(0, 1, At, B1); PG8_BAR; PG8_SCHED;
            PG8_LDA(At, 1, 1); PG8_STAGE(PG8_SB(1, 0), b3, voffB); PG8_STAGE(PG8_SB(1, 1), b3 + hstep, voffB); PG8_STAGE(PG8_SA(1, 0), a3, voffA);
            PG8_WAIT_V(8); PG8_WAIT_L(0); PG8_BAR; PG8_MMA(1, 0, At, B0); PG8_MMA(1, 1, At, B1); PG8_BAR; PG8_SCHED;
            } else {
            PG8_LDB(B0, 0, 0); PG8_SCHED; PG8_LDA(At, 0, 0); PG8_STAGE(PG8_SA(1, 1), a1 + hstep, voffA);
            PG8_WAIT_L(8); PG8_BAR; PG8_WAIT_L(0); PG8_MMA(0, 0, At, B0); PG8_BAR; PG8_SCHED;
            PG8_LDB(B1, 0, 1); PG8_STAGE(PG8_SB(0, 0), b2, voffB);
            PG8_BAR; PG8_WAIT_L(0); PG8_MMA(0, 1, At, B1); PG8_BAR;
            PG8_LDA(At, 0, 1); PG8_STAGE(PG8_SA(0, 0), a2, voffA);
            PG8_BAR; PG8_WAIT_L(0); PG8_MMA(1, 0, At, B0); PG8_BAR; PG8_SCHED;
            PG8_STAGE(PG8_SB(0, 1), b2 + hstep, voffB);
            PG8_WAIT_V(6); PG8_BAR; PG8_MMA(1, 1, At, B1); PG8_BAR;
            PG8_LDB(B0, 1, 0); PG8_SCHED; PG8_LDA(At, 1, 0); PG8_STAGE(PG8_SA(0, 1), a2 + hstep, voffA);
            PG8_WAIT_L(8); PG8_BAR; PG8_WAIT_L(0); PG8_MMA(0, 0, At, B0); PG8_BAR; PG8_SCHED;
            PG8_LDB(B1, 1, 1); PG8_STAGE(PG8_SB(1, 0), b3, voffB);
            PG8_BAR; PG8_WAIT_L(0); PG8_MMA(0, 1, At, B1); PG8_BAR;
            PG8_LDA(At, 1, 1); PG8_STAGE(PG8_SA(1, 0), a3, voffA);
            PG8_BAR; PG8_WAIT_L(0); PG8_MMA(1, 0, At, B0); PG8_BAR; PG8_SCHED;
            PG8_STAGE(PG8_SB(1, 1), b3 + hstep, voffB);
            PG8_WAIT_V(6); PG8_BAR; PG8_MMA(1, 1, At, B1); PG8_BAR;
            }
        }
        if constexpr (ALIGN_EPI) { if (wr == 0) PG8_BAR; }
        if constexpr (!Epi::AFTER_DRAIN) { E(acc, cur, wr, wc, fr, fq); S.done(cur); }
        if (!has_next) break;
#pragma unroll
        for (int a = 0; a < 2; ++a)
#pragma unroll
            for (int b = 0; b < 2; ++b)
#pragma unroll
                for (int m = 0; m < 4; ++m)
#pragma unroll
                    for (int n = 0; n < 2; ++n) acc[a][b][m][n] = (f32x4){0.f, 0.f, 0.f, 0.f};
        cur = nxt; cA = nA; cB = nB; ++ui;
        if constexpr (ALIGN_EPI) { if (wr == 1) PG8_BAR; }
    }
    PG8_WAIT_V(0);
    if constexpr (!ALIGN_EPI) { if (wr == 0) PG8_BAR; }
    PG8_BAR;
    if constexpr (Epi::AFTER_DRAIN) { E.fused(acc, cur, wr, wc, fr, fq, lds, wid, lane); S.done(cur); }
#undef PG8_SA
#undef PG8_SB
#undef PG8_STAGE
#undef PG8_LDA
#undef PG8_LDB
#undef PG8_MMA
#undef PG8_WAIT_V
#undef PG8_WAIT_L
#undef PG8_BAR
#undef PG8_SCHED
}
}

constexpr int NWAVES = 8;
constexpr int SEQ = 16384, DM = 2048, NIN = 5664, NINP = 5888, DFF = 5632;
constexpr int DNH = 8, HD = 128, SWH = 8, MEMH = 4, MEMT = 256;
constexpr float RMS_EPS = 1e-6f;
constexpr float LOG2E = 1.4426950408889634f;
constexpr float QSCALE = 0.08838834764831845f * 1.4426950408889634f;

constexpr size_t MiB = 1u << 20;
constexpr size_t WS_CTL = 0, CTL_ZERO_BYTES = 1 * MiB;
constexpr size_t CTL_SUMSQ2 = 256 * 1024, CTL_SUMSQ3 = 320 * 1024, CTL_SUMSQ4 = 384 * 1024;
constexpr size_t WS_RSTD1 = 1 * MiB, WS_RSTDM = 1 * MiB + 64 * 1024;
constexpr size_t WS_MEMB = 2 * MiB, WS_KVM = 3 * MiB, WS_AB = 4 * MiB, WS_BG = 6 * MiB;
constexpr size_t WS_WOUT = 8 * MiB, WS_WQ = 16 * MiB, WS_WKV = 18 * MiB, WS_WO = 22 * MiB, WS_WIN = 24 * MiB;
constexpr size_t WS_XB = 48 * MiB;
constexpr size_t WS_QKV = 112 * MiB;
constexpr size_t WS_OF = 112 * MiB, WS_OB = 144 * MiB, WS_H1B = 112 * MiB, WS_QM = 176 * MiB, WS_OM = 192 * MiB;
constexpr size_t WS_DNX = 208 * MiB;
constexpr size_t WS_WGU = 208 * MiB, WS_WD = 252 * MiB, WS_HID = 274 * MiB, WS_END = 496 * MiB;
constexpr size_t DO_Z = 0, DO_QSW = 32 * MiB, DO_KVSW = 64 * MiB;
constexpr int CW_BAR = 4096;

constexpr int RING_OFF = 0, RING_BYTES = 131072;
constexpr int LDS_BYTES = 163840;
constexpr int LDSCTL_OFF = LDS_BYTES - 512, MISC_OFF = LDSCTL_OFF + 320;

#define GAS __attribute__((address_space(1)))
#define LAS __attribute__((address_space(3)))
typedef unsigned short bf16;
typedef unsigned v4u __attribute__((ext_vector_type(4)));
typedef unsigned v2u __attribute__((ext_vector_type(2)));
typedef float f32x4 __attribute__((ext_vector_type(4)));
typedef short bf16x8 __attribute__((ext_vector_type(8)));
typedef short s16x4 __attribute__((ext_vector_type(4)));
typedef GAS unsigned gu32;
#define RLX_AGENT __ATOMIC_RELAXED, __HIP_MEMORY_SCOPE_AGENT
#define LDS_WAIT() asm volatile("s_waitcnt lgkmcnt(0)" ::: "memory")
#define VM_WAIT() asm volatile("s_waitcnt vmcnt(0)" ::: "memory")
__device__ __forceinline__ unsigned f2bf(float f) { unsigned u = __builtin_bit_cast(unsigned, f); return (u + 0x7fffu + ((u >> 16) & 1u)) >> 16; }
__device__ __forceinline__ unsigned pk2(float lo, float hi) { return f2bf(lo) | (f2bf(hi) << 16); }
__device__ __forceinline__ float bf2f(unsigned short b) { return __builtin_bit_cast(float, (unsigned)b << 16); }
__device__ __forceinline__ float bflo(unsigned w) { return __builtin_bit_cast(float, w << 16); }
__device__ __forceinline__ float bfhi(unsigned w) { return __builtin_bit_cast(float, w & 0xffff0000u); }
typedef float f32x2_t __attribute__((ext_vector_type(2))); typedef __bf16 bf16x2_t __attribute__((ext_vector_type(2)));
__device__ __forceinline__ unsigned cvtpk(float lo, float hi) { f32x2_t v = {lo, hi}; bf16x2_t b = __builtin_convertvector(v, bf16x2_t); return __builtin_bit_cast(unsigned, b); }
__device__ __forceinline__ float wave_sum(float v) {
#pragma unroll
    for (int o = 1; o < 64; o <<= 1) v += __shfl_xor(v, o);
    return v;
}
__device__ __forceinline__ float siluf(float x) { return x / (1.0f + __expf(-x)); }
#define XB_TMO      128
#define XB_XCNT(j)  (256  + 64 * (j))
#define XB_XSUB(j)  (1280 + 64 * (j))
#define XB_XGEN(j)  (2304 + 64 * (j))
#define XB_TOP      3328
#define XB_TOPGEN   3392
#define XCD_BAR_WORDS 3456
#define XB_SPIN_CAP (1u << 18)

__device__ __forceinline__ unsigned xb_ld(unsigned* p)              { return __hip_atomic_load(p, __ATOMIC_RELAXED, __HIP_MEMORY_SCOPE_AGENT); }
__device__ __forceinline__ unsigned xb_add(unsigned* p, unsigned v) { return __hip_atomic_fetch_add(p, v, __ATOMIC_RELAXED, __HIP_MEMORY_SCOPE_AGENT); }
__device__ __forceinline__ unsigned xb_xcc_id() { return (unsigned)__builtin_amdgcn_s_getreg((3 << 11) | 20) & 0xFu; }
#define XB_SPIN(cond, bar) do { unsigned _sp = 0; while (cond) { __builtin_amdgcn_s_sleep(1); \
    if ((++_sp & 255u) == 0u) { if (xb_ld(&(bar)[XB_TMO])) break; if (_sp > XB_SPIN_CAP) { atomicAdd(&(bar)[XB_TMO], 1u); break; } } } } while (0)

struct XcdBarrier {
    unsigned* bar; unsigned x;
    volatile LAS unsigned* st;
};

__device__ __forceinline__ XcdBarrier xcd_barrier_post(unsigned* bar, volatile LAS unsigned* st) {
    XcdBarrier b; b.bar = bar; b.x = xb_xcc_id(); b.st = st;
    if (threadIdx.x == 0) (void)xb_add(&bar[XB_XCNT(b.x)], 1u);
    return b;
}
__device__ __forceinline__ void xcd_barrier_complete(unsigned* bar, unsigned x, unsigned& nloc, unsigned& nx) {
    const unsigned G = gridDim.x * gridDim.y * gridDim.z;
    unsigned sum, cnt, mine, sp = 0u;
    for (;;) {
        sum = 0u; cnt = 0u; mine = 0u;
#pragma unroll
        for (unsigned j = 0; j < 16; ++j) { const unsigned c = xb_ld(&bar[XB_XCNT(j)]); sum += c; cnt += (c > 0u) ? 1u : 0u; mine = (j == x) ? c : mine; }
        if (sum == G) break;
        __builtin_amdgcn_s_sleep(1);
        if ((++sp & 255u) == 0u) { if (xb_ld(&bar[XB_TMO])) break; if (sp > XB_SPIN_CAP) { atomicAdd(&bar[XB_TMO], 1u); break; } }
    }
    nloc = mine > 0u ? mine : 1u; nx = cnt > 0u ? cnt : 1u;
}

__device__ __forceinline__ void xcd_barrier(const XcdBarrier& b) {
    asm volatile("s_waitcnt vmcnt(0)" ::: "memory");
    __syncthreads();
    if (threadIdx.x == 0) {
        unsigned* bar = b.bar;
        __builtin_amdgcn_s_waitcnt(0);
        unsigned nloc = b.st[0], nx = b.st[1];
        if (nloc == 0u) { xcd_barrier_complete(bar, b.x, nloc, nx); b.st[0] = nloc; b.st[1] = nx; }
        const unsigned old = xb_add(&bar[XB_XSUB(b.x)], 1u);
        const unsigned gen = old / nloc;
        if (old + 1u == (gen + 1u) * nloc) {
            __builtin_amdgcn_fence(__ATOMIC_RELEASE, "agent");
            asm volatile("s_waitcnt vmcnt(0)" ::: "memory");
            const unsigned og = xb_add(&bar[XB_TOP], 1u);
            const unsigned tg = og / nx;
            if (og + 1u == (tg + 1u) * nx) xb_add(&bar[XB_TOPGEN], 1u);
            else XB_SPIN(xb_ld(&bar[XB_TOPGEN]) == tg, bar);
            __builtin_amdgcn_fence(__ATOMIC_ACQUIRE, "agent");
            xb_add(&bar[XB_XGEN(b.x)], 1u);
            asm volatile("s_waitcnt vmcnt(0)" ::: "memory");
        } else {
            XB_SPIN(xb_ld(&bar[XB_XGEN(b.x)]) == gen, bar);
            __builtin_amdgcn_fence(__ATOMIC_ACQUIRE, "agent");
            asm volatile("s_waitcnt vmcnt(0)" ::: "memory");
        }
    }
    __syncthreads();
}

using pg8::Unit;
__device__ __forceinline__ v4u pack8(f32x4 v0, f32x4 v1) { v4u w; w.x = cvtpk(v0[0], v0[1]); w.y = cvtpk(v0[2], v0[3]); w.z = cvtpk(v1[0], v1[1]); w.w = cvtpk(v1[2], v1[3]); return w; }

struct EpiProj {
    static constexpr bool PERM = true, AFTER_DRAIN = false;
    const float* rstd; bf16* qkv; bf16* z; bf16* qsw; bf16* kvsw; float* ab;
    __device__ __forceinline__ void operator()(const f32x4 (&acc)[2][2][4][2], const Unit& u, int wr, int wc, int fr, int fq) const {
        const int pn = u.pn; bf16* base; int ldc, colt; float sc = 1.f;
        if (pn < 12) { base = qkv; ldc = 3072; colt = pn * 256; }
        else if (pn < 16) { base = z; ldc = 1024; colt = (pn - 12) * 256; }
        else if (pn < 20) { base = qsw; ldc = 1024; colt = (pn - 16) * 256; sc = QSCALE; }
        else if (pn < 22) { base = kvsw; ldc = 512; colt = (pn - 20) * 256; }
        else { base = nullptr; ldc = 0; colt = 0; }
        const int row0 = u.pm * 256 + wr * 64 + fr, col0 = colt + wc * 32 + 8 * fq;
#pragma unroll
        for (int ai = 0; ai < 2; ++ai)
#pragma unroll
            for (int m = 0; m < 4; ++m) {
                const int row = row0 + ai * 128 + m * 16; const float rs = rstd[row] * sc;
                if (base) {
                    bf16* rowp = base + (size_t)row * ldc + col0;
#pragma unroll
                    for (int bj = 0; bj < 2; ++bj) *(v4u*)(rowp + bj * 128) = pack8(acc[ai][bj][m][0] * rs, acc[ai][bj][m][1] * rs);
                } else if (wc == 0) {
                    float* rowp = ab + (size_t)row * 32 + 8 * fq;
                    *(f32x4*)(rowp) = acc[ai][0][m][0] * rs; *(f32x4*)(rowp + 4) = acc[ai][0][m][1] * rs;
                }
            }
    }
};
struct EpiScaleBf16 {
    static constexpr bool PERM = true, AFTER_DRAIN = false;
    const float* rs; int from_sumsq; float sc; bf16* O; int ldc;
    __device__ __forceinline__ void operator()(const f32x4 (&acc)[2][2][4][2], const Unit& u, int wr, int wc, int fr, int fq) const {
        const int row0 = u.pm * 256 + wr * 64 + fr, col0 = u.pn * 256 + wc * 32 + 8 * fq;
#pragma unroll
        for (int ai = 0; ai < 2; ++ai)
#pragma unroll
            for (int m = 0; m < 4; ++m) {
                const int row = row0 + ai * 128 + m * 16; float r = rs[row];
                if (from_sumsq) r = __builtin_amdgcn_rsqf(r * (1.0f / DM) + RMS_EPS);
                r *= sc; bf16* rowp = O + (size_t)row * ldc + col0;
#pragma unroll
                for (int bj = 0; bj < 2; ++bj) *(v4u*)(rowp + bj * 128) = pack8(acc[ai][bj][m][0] * r, acc[ai][bj][m][1] * r);
            }
    }
};
struct EpiRes {
    static constexpr bool PERM = true, AFTER_DRAIN = false;
    const float* res; float* out; bf16* ob; float* sumsq;
    __device__ __forceinline__ void operator()(const f32x4 (&acc)[2][2][4][2], const Unit& u, int wr, int wc, int fr, int fq) const {
        const int row0 = u.pm * 256 + wr * 64 + fr, col0 = u.pn * 256 + wc * 32 + 8 * fq;
#pragma unroll
        for (int ai = 0; ai < 2; ++ai)
#pragma unroll
            for (int m = 0; m < 4; ++m) {
                const int row = row0 + ai * 128 + m * 16; const size_t off = (size_t)row * DM + col0; float ss = 0.f;
#pragma unroll
                for (int bj = 0; bj < 2; ++bj) {
                    const f32x4 r0 = *(const f32x4*)(res + off + bj * 128), r1 = *(const f32x4*)(res + off + bj * 128 + 4);
                    const f32x4 v0 = acc[ai][bj][m][0] + r0, v1 = acc[ai][bj][m][1] + r1;
                    *(f32x4*)(out + off + bj * 128) = v0; *(f32x4*)(out + off + bj * 128 + 4) = v1;
                    if (ob) *(v4u*)(ob + off + bj * 128) = pack8(v0, v1);
                    ss += (v0[0] * v0[0] + v0[1] * v0[1]) + (v0[2] * v0[2] + v0[3] * v0[3]) + (v1[0] * v1[0] + v1[1] * v1[1]) + (v1[2] * v1[2] + v1[3] * v1[3]);
                }
                ss += __shfl_xor(ss, 16); ss += __shfl_xor(ss, 32);
                if (fq == 0) atomicAdd(sumsq + row, ss);
            }
    }
};
struct EpiSwiglu {
    static constexpr bool PERM = true, AFTER_DRAIN = false;
    const float* sumsq; bf16* H;
    __device__ __forceinline__ void operator()(const f32x4 (&acc)[2][2][4][2], const Unit& u, int wr, int wc, int fr, int fq) const {
        const int row0 = u.pm * 256 + wr * 64 + fr, col0 = u.pn * 128 + wc * 32 + 8 * fq;
#pragma unroll
        for (int ai = 0; ai < 2; ++ai)
#pragma unroll
            for (int m = 0; m < 4; ++m) {
                const int row = row0 + ai * 128 + m * 16; const float r = __builtin_amdgcn_rsqf(sumsq[row] * (1.0f / DM) + RMS_EPS);
                f32x4 h[2];
#pragma unroll
                for (int n = 0; n < 2; ++n)
#pragma unroll
                    for (int e = 0; e < 4; ++e) { const float g = acc[ai][0][m][n][e] * r, up = acc[ai][1][m][n][e] * r; h[n][e] = siluf(g) * up; }
                *(v4u*)(H + (size_t)row * DFF + col0) = pack8(h[0], h[1]);
            }
    }
};

struct Frame {
    LAS unsigned char* lds;
    volatile LAS unsigned* MISC;
    gu32* ctl;
    int tid, lane, wave, vcu, G;
    const float* in[23]; float* out; unsigned char* ws;
};
#define WSP(T, off) ((T*)(F.ws + (off)))
#define DOP(T, off) ((T*)((unsigned char*)F.out + (off)))

__device__ __forceinline__ void tr_item(const float* W, int K, int Nsrc, int src_col0, const float* gain, bf16* WT, int dst_row0, int k0, LAS float* scr, int lane) {
#pragma unroll 8
    for (int i = 0; i < 32; ++i) {
        const int kk = 2 * i + (lane >> 5); float v = 0.f;
        if (src_col0 >= 0) { v = W[(size_t)(k0 + kk) * Nsrc + src_col0 + (lane & 31)]; if (gain) v *= gain[k0 + kk]; }
        scr[kk * 33 + (lane & 31)] = v;
    }
    LDS_WAIT(); asm volatile("" ::: "memory");
    const int c = lane & 7;
#pragma unroll
    for (int j = 0; j < 4; ++j) { const int n = (lane >> 3) + 8 * j; const LAS float* s = scr + (8 * c) * 33 + n;
        v4u o; o.x = pk2(s[0 * 33], s[1 * 33]); o.y = pk2(s[2 * 33], s[3 * 33]); o.z = pk2(s[4 * 33], s[5 * 33]); o.w = pk2(s[6 * 33], s[7 * 33]);
        *(GAS v4u*)(WT + (size_t)(dst_row0 + n) * K + k0 + 8 * c) = o; }
    LDS_WAIT(); asm volatile("" ::: "memory");
}
__device__ __forceinline__ int win_src_col(int c) {
    if (c < 4096) return c;
    if (c < 5120) return c - 4096 + 4128;
    if (c < 5376) return c - 5120 + 5152;
    if (c < 5632) return c - 5376 + 5408;
    if (c < 5664) return c - 5632 + 4096;
    return -1;
}
__device__ __forceinline__ void row_to_bf16_rstd(const float* xrow, bf16* orow, float* rstd_out, int lane) {
    const GAS f32x4* xr = (const GAS f32x4*)xrow + lane;
    f32x4 v[8]; float s = 0.f;
#pragma unroll
    for (int j = 0; j < 8; ++j) { v[j] = xr[64 * j]; s += (v[j].x * v[j].x + v[j].y * v[j].y) + (v[j].z * v[j].z + v[j].w * v[j].w); }
    s = wave_sum(s);
    if (lane == 0) *rstd_out = 1.0f / sqrtf(s * (1.0f / DM) + RMS_EPS);
    GAS v2u* o8 = (GAS v2u*)orow + lane;
#pragma unroll
    for (int j = 0; j < 8; ++j) { v2u w; w.x = pk2(v[j].x, v[j].y); w.y = pk2(v[j].z, v[j].w); o8[64 * j] = w; }
}

__device__ __forceinline__ void p0_prologue(Frame& F) {
    LAS float* scr = (LAS float*)(F.lds + RING_OFF + F.wave * 16384);
    const int gw = F.vcu * NWAVES + F.wave, NGW = F.G * NWAVES;
    constexpr int I_IN = 32 * (NINP / 32), I_OUT = 32 * 64, I_Q = 32 * 16, I_KV = 32 * 32, I_O = 8 * 64;
    constexpr int NITEMS = I_IN + I_OUT + I_Q + I_KV + I_O;
    for (int it = gw; it < NITEMS; it += NGW) {
        int r = it;
        if (r < I_IN) { const int nblk = NINP / 32, kb = r / nblk, nb = r % nblk; tr_item(F.in[3], DM, NIN, win_src_col(nb * 32), F.in[2], WSP(bf16, WS_WIN), nb * 32, kb * 64, scr, F.lane); continue; } r -= I_IN;
        if (r < I_OUT) { const int kb = r / 64, nb = r % 64; tr_item(F.in[12], DM, DM, nb * 32, nullptr, WSP(bf16, WS_WOUT), nb * 32, kb * 64, scr, F.lane); continue; } r -= I_OUT;
        if (r < I_Q) { const int kb = r / 16, nb = r % 16; tr_item(F.in[15], DM, 512, nb * 32, F.in[13], WSP(bf16, WS_WQ), nb * 32, kb * 64, scr, F.lane); continue; } r -= I_Q;
        if (r < I_KV) { const int kb = r / 32, nb = r % 32; tr_item(F.in[16], DM, 1024, nb * 32, F.in[14], WSP(bf16, WS_WKV), nb * 32, kb * 64, scr, F.lane); continue; } r -= I_KV;
        { const int kb = r / 64, nb = r % 64; tr_item(F.in[17], 512, DM, nb * 32, nullptr, WSP(bf16, WS_WO), nb * 32, kb * 64, scr, F.lane); }
    }
    for (int m = gw; m < SEQ; m += NGW) row_to_bf16_rstd(F.in[0] + (size_t)m * DM, WSP(bf16, WS_XB) + (size_t)m * DM, WSP(float, WS_RSTD1) + m, F.lane);
    for (int m = gw; m < MEMT; m += NGW) row_to_bf16_rstd(F.in[1] + (size_t)m * DM, WSP(bf16, WS_MEMB) + (size_t)m * DM, WSP(float, WS_RSTDM) + m, F.lane);
}
__device__ __forceinline__ void p4_transposes(Frame& F) {
    LAS float* scr = (LAS float*)(F.lds + RING_OFF + F.wave * 16384);
    const int gw = F.vcu * NWAVES + F.wave, NGW = F.G * NWAVES;
    constexpr int I_GU = 32 * (2 * DFF / 32), I_D = (DFF / 64) * 64;
    for (int it = gw; it < I_GU + I_D; it += NGW) {
        int r = it;
        if (r < I_GU) { const int nblk = 2 * DFF / 32, kb = r / nblk, nb = r % nblk; const int row = nb * 32, t = row / 256, w = row % 256;
            const float* src = (w < 128) ? F.in[19] : F.in[20]; const int sc = 128 * t + (w & 127);
            tr_item(src, DM, DFF, sc, F.in[18], WSP(bf16, WS_WGU), row, kb * 64, scr, F.lane); continue; } r -= I_GU;
        { const int kb = r / 64, nb = r % 64; tr_item(F.in[21], DFF, DM, nb * 32, nullptr, WSP(bf16, WS_WD), nb * 32, kb * 64, scr, F.lane); }
    }
}

__device__ __forceinline__ float softplusf(float x) { return x > 20.f ? x : log1pf(__expf(x)); }
__device__ __forceinline__ void dn_combine(Frame& F) {
    const int gw = F.vcu * NWAVES + F.wave, NGW = F.G * NWAVES, lane = F.lane;
    const bf16* OFp = WSP(bf16, WS_OF); const bf16* OBp = WSP(bf16, WS_OB); const bf16* Z = DOP(bf16, DO_Z); bf16* Y = WSP(bf16, WS_XB); const float* gn = F.in[9];
    for (int t = gw; t < SEQ; t += NGW) {
        const size_t off = (size_t)t * 1024 + 16 * lane;
        const v4u a0 = *(const v4u*)(OFp + off), a1 = *(const v4u*)(OFp + off + 8), b0 = *(const v4u*)(OBp + off), b1 = *(const v4u*)(OBp + off + 8);
        const v4u z0 = *(const v4u*)(Z + off), z1 = *(const v4u*)(Z + off + 8);
        float o[16], zz[16];
#pragma unroll
        for (int i = 0; i < 4; ++i) { o[2 * i] = bflo(a0[i]) + bflo(b0[i]); o[2 * i + 1] = bfhi(a0[i]) + bfhi(b0[i]); o[8 + 2 * i] = bflo(a1[i]) + bflo(b1[i]); o[8 + 2 * i + 1] = bfhi(a1[i]) + bfhi(b1[i]);
            zz[2 * i] = bflo(z0[i]); zz[2 * i + 1] = bfhi(z0[i]); zz[8 + 2 * i] = bflo(z1[i]); zz[8 + 2 * i + 1] = bfhi(z1[i]); }
        float ss = 0.f;
#pragma unroll
        for (int i = 0; i < 16; ++i) ss += o[i] * o[i];
        ss += __shfl_xor(ss, 1); ss += __shfl_xor(ss, 2); ss += __shfl_xor(ss, 4);
        const float rs = 1.0f / sqrtf(ss * (1.0f / 128.0f) + RMS_EPS); const int cb = (16 * lane) & 127;
        float y[16];
#pragma unroll
        for (int i = 0; i < 16; ++i) y[i] = o[i] * rs * gn[cb + i] * siluf(zz[i]);
        v4u w0, w1;
#pragma unroll
        for (int i = 0; i < 4; ++i) { w0[i] = pk2(y[2 * i], y[2 * i + 1]); w1[i] = pk2(y[8 + 2 * i], y[8 + 2 * i + 1]); }
        bf16* yp = Y + (size_t)t * DM + 16 * lane; *(v4u*)yp = w0; *(v4u*)(yp + 8) = w1;
    }
}
__device__ __forceinline__ void final_norm(Frame& F) {
    const int gw = F.vcu * NWAVES + F.wave, NGW = F.G * NWAVES, lane = F.lane;
    const float* ss = (const float*)(F.ws + WS_CTL + CTL_SUMSQ4); const GAS f32x4* g = (const GAS f32x4*)F.in[22] + lane;
    for (int m = gw; m < SEQ; m += NGW) {
        const float r = 1.0f / sqrtf(ss[m] * (1.0f / DM) + RMS_EPS);
        GAS f32x4* o = (GAS f32x4*)(F.out + (size_t)m * DM) + lane;
#pragma unroll
        for (int j = 0; j < 8; ++j) { f32x4 v = o[64 * j]; v = v * r * g[64 * j]; o[64 * j] = v; }
    }
}

__device__ __forceinline__ int t5_bucket(int rel) {
    const int n = rel < 0 ? -rel : rel; int b;
    if (n < 8) b = n; else { int k = (31 - __builtin_clz((unsigned)(n * n))) - 6; b = 8 + k; if (b > 15) b = 15; }
    return (rel > 0 ? 16 : 0) + b;
}
template <int MODE  >
__device__ __forceinline__ void attn_unit(Frame& F, const bf16* Q, int qpitch, const bf16* Kp, const bf16* Vp, int kvpitch, bf16* O, int opitch, int q0, int kt_beg, int kt_end, const LAS float* btab, float sink2) {
    LAS unsigned char* Ks = F.lds + RING_OFF; LAS unsigned char* Vs = Ks + 16384;
    const int lane = F.lane, c = lane & 15, g = lane >> 4, qw0 = q0 + 16 * F.wave, tid = F.tid;
    bf16x8 qf[4];
#pragma unroll
    for (int t = 0; t < 4; ++t) qf[t] = *(const bf16x8*)(Q + (size_t)(qw0 + c) * qpitch + 32 * t + 8 * g);
    f32x4 oacc[8];
#pragma unroll
    for (int i = 0; i < 8; ++i) oacc[i] = (f32x4){0.f, 0.f, 0.f, 0.f};
    float mrun = (MODE == 0) ? sink2 : -1e30f, lsum = (MODE == 0 && g == 0) ? 1.0f : 0.0f;
    for (int kt = kt_beg; kt < kt_end; ++kt) {
        __syncthreads();
#pragma unroll
        for (int i = 0; i < 2; ++i) { const int ci = tid + 512 * i, key = ci >> 4, ch = ci & 15;
            const v4u kv = *(const v4u*)(Kp + (size_t)(64 * kt + key) * kvpitch + ch * 8), vv = *(const v4u*)(Vp + (size_t)(64 * kt + key) * kvpitch + ch * 8);
            *(LAS v4u*)(Ks + key * 256 + ((ch ^ (key & 15)) << 4)) = kv; *(LAS v4u*)(Vs + key * 256 + ((ch ^ ((key & 7) << 1)) << 4)) = vv; }
        __syncthreads();
        bool rel_ok = true;
        if (MODE == 0) rel_ok = (64 * kt <= qw0 + 15 + 128) && (64 * kt + 63 >= qw0 - 128);
        if (!rel_ok) continue;
        f32x4 s[4];
#pragma unroll
        for (int mt = 0; mt < 4; ++mt) s[mt] = (f32x4){0.f, 0.f, 0.f, 0.f};
#pragma unroll
        for (int t = 0; t < 4; ++t)
#pragma unroll
            for (int mt = 0; mt < 4; ++mt) { const bf16x8 kf = *(const LAS bf16x8*)(Ks + (16 * mt + c) * 256 + (((4 * t + g) ^ c) << 4));
                s[mt] = __builtin_amdgcn_mfma_f32_16x16x32_bf16(kf, qf[t], s[mt], 0, 0, 0); }
        float tmax = -INFINITY;
#pragma unroll
        for (int mt = 0; mt < 4; ++mt)
#pragma unroll
            for (int r = 0; r < 4; ++r) {
                if (MODE == 0) { const int rel = (64 * kt + 16 * mt + 4 * g + r) - (qw0 + c); const bool ok = (rel >= -128) && (rel <= 128);
                    const int ri = ok ? rel + 128 : 128; const float bv = btab[ri]; s[mt][r] = ok ? s[mt][r] + bv : -INFINITY; }
                tmax = fmaxf(tmax, s[mt][r]); }
        tmax = fmaxf(tmax, __shfl_xor(tmax, 16)); tmax = fmaxf(tmax, __shfl_xor(tmax, 32));
        const float mnew = fmaxf(mrun, tmax), alpha = __builtin_amdgcn_exp2f(mrun - mnew); mrun = mnew; float ps = 0.f;
#pragma unroll
        for (int mt = 0; mt < 4; ++mt)
#pragma unroll
            for (int r = 0; r < 4; ++r) { const float p = __builtin_amdgcn_exp2f(s[mt][r] - mnew); s[mt][r] = p; ps += p; }
        lsum = lsum * alpha + ps;
#pragma unroll
        for (int i = 0; i < 8; ++i) oacc[i] = oacc[i] * alpha;
        bf16x8 pf[2];
#pragma unroll
        for (int t2 = 0; t2 < 2; ++t2) { v4u w; w.x = cvtpk(s[2 * t2][0], s[2 * t2][1]); w.y = cvtpk(s[2 * t2][2], s[2 * t2][3]); w.z = cvtpk(s[2 * t2 + 1][0], s[2 * t2 + 1][1]); w.w = cvtpk(s[2 * t2 + 1][2], s[2 * t2 + 1][3]);
            pf[t2] = __builtin_bit_cast(bf16x8, w); }
        const int q4 = c >> 2, p4 = c & 3;
#pragma unroll
        for (int t2 = 0; t2 < 2; ++t2)
#pragma unroll
            for (int mo = 0; mo < 8; ++mo) {
                const int k1 = 32 * t2 + 4 * g + q4, k2 = k1 + 16, chn = 2 * mo + (p4 >> 1);
                const s16x4 lo = __builtin_bit_cast(s16x4, __builtin_amdgcn_ds_read_tr16_b64_v4i16((LAS s16x4*)(Vs + k1 * 256 + ((chn ^ ((k1 & 7) << 1)) << 4) + (p4 & 1) * 8)));
                const s16x4 hi = __builtin_bit_cast(s16x4, __builtin_amdgcn_ds_read_tr16_b64_v4i16((LAS s16x4*)(Vs + k2 * 256 + ((chn ^ ((k2 & 7) << 1)) << 4) + (p4 & 1) * 8)));
                const bf16x8 vf = (bf16x8){lo[0], lo[1], lo[2], lo[3], hi[0], hi[1], hi[2], hi[3]};
                oacc[mo] = __builtin_amdgcn_mfma_f32_16x16x32_bf16(vf, pf[t2], oacc[mo], 0, 0, 0); }
    }
    lsum += __shfl_xor(lsum, 16); lsum += __shfl_xor(lsum, 32);
    const float inv = 1.0f / lsum;
#pragma unroll
    for (int mo = 0; mo < 8; ++mo) { v2u w; w.x = cvtpk(oacc[mo][0] * inv, oacc[mo][1] * inv); w.y = cvtpk(oacc[mo][2] * inv, oacc[mo][3] * inv);
        *(v2u*)(O + (size_t)(qw0 + c) * opitch + 16 * mo + 4 * g) = w; }
}
__device__ __forceinline__ void swa_phase(Frame& F) {
    LAS float* btab = (LAS float*)(F.lds + RING_OFF + 32768);
    const bf16* QS = DOP(bf16, DO_QSW); const bf16* KV = DOP(bf16, DO_KVSW); bf16* Y = WSP(bf16, WS_XB);
    for (int u = blockIdx.x; u < SWH * (SEQ / 128); u += F.G) {
        const int h = u & 7, qb = u >> 3, kvh = h >> 2;
        __syncthreads();
        if (F.tid < 257) btab[F.tid] = F.in[11][t5_bucket(F.tid - 128) * 8 + h] * LOG2E;
        __syncthreads();
        int kb = 2 * qb - 2, ke = 2 * qb + 4; if (kb < 0) kb = 0; if (ke > SEQ / 64) ke = SEQ / 64;
        attn_unit<0>(F, QS + h * 128, 1024, KV + kvh * 128, KV + 256 + kvh * 128, 512, Y + 1024 + h * 128, DM, qb * 128, kb, ke, btab, F.in[10][h] * LOG2E);
    }
}
__device__ __forceinline__ void mem_attn_phase(Frame& F) {
    const bf16* QM = WSP(bf16, WS_QM); const bf16* KVm = WSP(bf16, WS_KVM); bf16* OM = WSP(bf16, WS_OM);
    for (int u = blockIdx.x; u < MEMH * (SEQ / 128); u += F.G) {
        const int h = u & 3, qb = u >> 2;
        attn_unit<1>(F, QM + h * 128, 512, KVm + h * 128, KVm + 512 + h * 128, 1024, OM + h * 128, 512, qb * 128, 0, 4, nullptr, 0.f);
    }
}

typedef float f32x16 __attribute__((ext_vector_type(16)));
constexpr int DX_W = 0, DX_K = 16384, DX_U = 32768, DX_Q = 49152, DX_A = 65536, DX_BYTES = 73728;
constexpr size_t WS_GL = 1 * MiB + 128 * 1024;
constexpr int L_RAW = 0, RAW_PITCH = 784, L_MTF = 0, L_MTB = 16384, L_TB = 32768, TB_PITCH = 144, TB_SZ = 9216;
constexpr int L_QB = 69632, L_KB = 86016, L_KT = 102400, L_VT = 120832, L_PART = 139264, L_SC = 143360;
static_assert(L_SC + 2048 <= LDSCTL_OFF, "prep LDS map");
__device__ __forceinline__ unsigned char* dnx_rec(Frame& F, int dir, int hd, int cn) { return F.ws + WS_DNX + (size_t)((dir * 8 + hd) * 256 + cn) * DX_BYTES; }
__device__ __forceinline__ v4u pack8f(const float* v) { v4u w; w.x = cvtpk(v[0], v[1]); w.y = cvtpk(v[2], v[3]); w.z = cvtpk(v[4], v[5]); w.w = cvtpk(v[6], v[7]); return w; }

template <int dir> __device__ __forceinline__ void dn_solve_and_write(LAS unsigned char* lds, int lane) {
    const LAS float* MT = (const LAS float*)(lds + (dir ? L_MTB : L_MTF));
    LAS float* Trow = (LAS float*)(lds + L_TB + dir * 2 * TB_SZ) + lane * 68;
#pragma unroll 1
    for (int jb = 15; jb >= 0; --jb) {
        const int j0 = 4 * jb;
        float a0 = (lane == j0) ? 1.f : 0.f, a1 = (lane == j0 + 1) ? 1.f : 0.f, a2 = (lane == j0 + 2) ? 1.f : 0.f, a3 = (lane == j0 + 3) ? 1.f : 0.f;
        const LAS float* mr = MT + j0 * 64;
#pragma unroll 1
        for (int s4 = jb + 1; s4 < 16; ++s4) {
            const f32x4 tv = *(const LAS f32x4*)(Trow + 4 * s4);
            const f32x4 m0 = *(const LAS f32x4*)(mr + 4 * s4), m1 = *(const LAS f32x4*)(mr + 64 + 4 * s4), m2 = *(const LAS f32x4*)(mr + 128 + 4 * s4), m3 = *(const LAS f32x4*)(mr + 192 + 4 * s4);
            a0 -= (tv[0] * m0[0] + tv[1] * m0[1]) + (tv[2] * m0[2] + tv[3] * m0[3]);
            a1 -= (tv[0] * m1[0] + tv[1] * m1[1]) + (tv[2] * m1[2] + tv[3] * m1[3]);
            a2 -= (tv[0] * m2[0] + tv[1] * m2[1]) + (tv[2] * m2[2] + tv[3] * m2[3]);
            a3 -= (tv[0] * m3[0] + tv[1] * m3[1]) + (tv[2] * m3[2] + tv[3] * m3[3]);
        }
        const f32x4 d0 = *(const LAS f32x4*)(mr + j0), d1 = *(const LAS f32x4*)(mr + 64 + j0), d2 = *(const LAS f32x4*)(mr + 128 + j0);
        const float t3 = a3, t2 = a2 - t3 * d2[3], t1 = a1 - t2 * d1[2] - t3 * d1[3], t0 = a0 - t1 * d0[1] - t2 * d0[2] - t3 * d0[3];
        *(LAS f32x4*)(Trow + j0) = (f32x4){t0, t1, t2, t3};
    }
    f32x4 tr[16];
#pragma unroll
    for (int q = 0; q < 16; ++q) tr[q] = *(const LAS f32x4*)(Trow + 4 * q);
    asm volatile("s_waitcnt lgkmcnt(0)" ::: "memory");
    const LAS float* sc = (const LAS float*)(lds + L_SC);
    const LAS float* cU = sc + (dir ? 384 : 256); const LAS float* cW = sc + (dir ? 448 : 320);
    const int pos = dir ? 63 - lane : lane;
    LAS unsigned char* tu = lds + L_TB + dir * 2 * TB_SZ + pos * TB_PITCH; LAS unsigned char* tw = tu + TB_SZ;
#pragma unroll
    for (int q = 0; q < 8; ++q) {
        float u8[8], w8[8];
#pragma unroll
        for (int e = 0; e < 8; ++e) { const int s = 8 * q + e, sp = dir ? 63 - s : s; const float t = tr[sp >> 2][sp & 3]; u8[e] = t * cU[s]; w8[e] = t * cW[s]; }
        *(LAS v4u*)(tu + q * 16) = pack8f(u8); *(LAS v4u*)(tw + q * 16) = pack8f(w8);
    }
}

__device__ __forceinline__ void dn_prep_unit(Frame& F, int cn, int hd) {
    LAS unsigned char* lds = F.lds; int tid = F.tid, lane = F.lane; const int wave = F.wave;
    asm volatile("" : "+v"(tid), "+v"(lane));
    const bf16* QKV = WSP(bf16, WS_QKV);
    LAS float* sc = (LAS float*)(lds + L_SC);
    __syncthreads();
    for (int ci = tid; ci < 68 * 48; ci += 512) {
        const int row = ci / 48, cc = ci % 48, seg = cc >> 4, ch = (cc & 15) * 8, tok = 64 * cn - 2 + row;
        v4u v = (v4u){0u, 0u, 0u, 0u};
        if (tok >= 0 && tok < SEQ) v = *(const v4u*)(QKV + (size_t)tok * 3072 + seg * 1024 + hd * 128 + ch);
        *(LAS v4u*)(lds + L_RAW + row * RAW_PITCH + (seg * 128 + ch) * 2) = v;
    }
    if (wave == 0) {
        const float* ab = WSP(float, WS_AB) + (size_t)(64 * cn + lane) * 32;
        const float bfv = 1.0f / (1.0f + __expf(-ab[hd])), bbv = 1.0f / (1.0f + __expf(-ab[8 + hd]));
        const float gf = -__expf(F.in[5][hd]) * softplusf(ab[16 + hd] + F.in[7][hd]), gb = -__expf(F.in[6][hd]) * softplusf(ab[24 + hd] + F.in[8][hd]);
        float Gf = gf, Gb = gb;
#pragma unroll
        for (int o = 1; o < 64; o <<= 1) { const float a = __shfl_up(Gf, o), b = __shfl_down(Gb, o); if (lane >= o) Gf += a; if (lane + o < 64) Gb += b; }
        sc[lane] = Gf; sc[64 + lane] = Gb; sc[128 + lane] = bfv; sc[192 + lane] = bbv;
        sc[256 + lane] = bfv; sc[320 + lane] = -bfv * __expf(Gf); sc[384 + lane] = bbv; sc[448 + lane] = -bbv * __expf(Gb);
        float* GL = WSP(float, WS_GL);
        if (lane == 63) GL[(0 * 8 + hd) * 256 + cn] = __expf(Gf);
        if (lane == 0) GL[(1 * 8 + hd) * 256 + cn] = __expf(Gb);
    }
    __syncthreads();
    asm volatile("" : "+v"(tid), "+v"(lane));
    {
        const int t = wave, pos = lane; const float* cw = F.in[4] + hd * 128 + 16 * t;
        float qv[16], kv[16], vv[16];
#pragma unroll
        for (int seg = 0; seg < 3; ++seg) {
            float a[16];
#pragma unroll
            for (int i = 0; i < 16; ++i) a[i] = 0.f;
#pragma unroll
            for (int j = 0; j < 5; ++j) {
                const LAS unsigned char* rp = lds + L_RAW + (pos + j) * RAW_PITCH + (seg * 128 + 16 * t) * 2;
                const v4u r0 = *(const LAS v4u*)rp, r1 = *(const LAS v4u*)(rp + 16);
                const float* w = cw + j * 3072 + seg * 1024;
#pragma unroll
                for (int i = 0; i < 4; ++i) { a[2 * i] += w[2 * i] * bflo(r0[i]); a[2 * i + 1] += w[2 * i + 1] * bfhi(r0[i]); a[8 + 2 * i] += w[8 + 2 * i] * bflo(r1[i]); a[8 + 2 * i + 1] += w[8 + 2 * i + 1] * bfhi(r1[i]); }
            }
#pragma unroll
            for (int i = 0; i < 16; ++i) { const float s = siluf(a[i]); if (seg == 0) qv[i] = s; else if (seg == 1) kv[i] = s; else vv[i] = s; }
        }
        float sq = 0.f, sk = 0.f;
#pragma unroll
        for (int i = 0; i < 16; ++i) { sq += qv[i] * qv[i]; sk += kv[i] * kv[i]; }
        LAS float* part = (LAS float*)(lds + L_PART);
        part[t * 64 + pos] = sq; part[512 + t * 64 + pos] = sk;
        __syncthreads();
        float tq = 0.f, tk = 0.f;
#pragma unroll
        for (int i = 0; i < 8; ++i) { tq += part[i * 64 + pos]; tk += part[512 + i * 64 + pos]; }
        const float rq = (1.0f / sqrtf(tq + 1e-6f)) * 0.08838834764831845f, rk = 1.0f / sqrtf(tk + 1e-6f);
#pragma unroll
        for (int i = 0; i < 16; ++i) { qv[i] *= rq; kv[i] *= rk; }
        *(LAS v4u*)(lds + L_QB + pos * 256 + (((2 * t) ^ (pos & 15)) << 4)) = pack8f(qv); *(LAS v4u*)(lds + L_QB + pos * 256 + (((2 * t + 1) ^ (pos & 15)) << 4)) = pack8f(qv + 8);
        *(LAS v4u*)(lds + L_KB + pos * 256 + (((2 * t) ^ (pos & 15)) << 4)) = pack8f(kv); *(LAS v4u*)(lds + L_KB + pos * 256 + (((2 * t + 1) ^ (pos & 15)) << 4)) = pack8f(kv + 8);
#pragma unroll
        for (int i = 0; i < 16; ++i) { *(LAS unsigned short*)(lds + L_KT + (16 * t + i) * TB_PITCH + pos * 2) = (unsigned short)f2bf(kv[i]); *(LAS unsigned short*)(lds + L_VT + (16 * t + i) * TB_PITCH + pos * 2) = (unsigned short)f2bf(vv[i]); }
        const float ef = __expf(sc[pos]), eb = __expf(sc[64 + pos]); const int mt = pos >> 5;
#pragma unroll
        for (int dir = 0; dir < 2; ++dir) { const float e = dir ? eb : ef; unsigned char* rec = dnx_rec(F, dir, hd, cn) + DX_Q;
#pragma unroll
            for (int lh = 0; lh < 2; ++lh) { float o8[8];
#pragma unroll
                for (int j = 0; j < 8; ++j) o8[j] = qv[8 * (j >> 2) + 4 * lh + (j & 3)] * e;
                *(v4u*)(rec + ((mt * 8 + t) * 64 + 32 * lh + (pos & 31)) * 16) = pack8f(o8); } }
    }
    __syncthreads();
    asm volatile("" : "+v"(tid), "+v"(lane));
    {
        const int r = lane & 31, lh = lane >> 5, x = wave & 3, ta = x >> 1, tb = x & 1;
        const LAS unsigned char* Ab = lds + L_KB + (32 * ta + r) * 256; const LAS unsigned char* Bb = lds + (wave < 4 ? L_KB : L_QB) + (32 * tb + r) * 256;
        f32x16 acc;
#pragma unroll
        for (int i = 0; i < 16; ++i) acc[i] = 0.f;
#pragma unroll
        for (int kk = 0; kk < 8; ++kk) { const int ch = ((2 * kk + lh) ^ (r & 15)) << 4;
            acc = __builtin_amdgcn_mfma_f32_32x32x16_bf16(*(const LAS bf16x8*)(Ab + ch), *(const LAS bf16x8*)(Bb + ch), acc, 0, 0, 0); }
        const int b = 32 * tb + r;
        if (wave < 4) {
            const float Gfb = sc[b], Gbb = sc[64 + b];
#pragma unroll
            for (int q = 0; q < 4; ++q) { const int a0 = 32 * ta + 8 * q + 4 * lh; f32x4 mf, mb;
#pragma unroll
                for (int e = 0; e < 4; ++e) { const int a = a0 + e; const float kkv = acc[4 * q + e];
                    const float vf = sc[128 + a] * kkv * __expf(fminf(sc[a] - Gfb, 0.f)), vb = sc[192 + a] * kkv * __expf(fminf(sc[64 + a] - Gbb, 0.f));
                    mf[e] = (a > b) ? vf : 0.f; mb[3 - e] = (a < b) ? vb : 0.f; }
                *(LAS f32x4*)(lds + L_MTF + (b * 64 + a0) * 4) = mf; *(LAS f32x4*)(lds + L_MTB + ((63 - b) * 64 + 60 - a0) * 4) = mb; }
        } else {
            const float Gfc = sc[b], Gbc = sc[64 + b];
#pragma unroll
            for (int dir = 0; dir < 2; ++dir) { unsigned char* rec = dnx_rec(F, dir, hd, cn) + DX_A;
#pragma unroll
                for (int s2 = 0; s2 < 2; ++s2) { float o8[8];
#pragma unroll
                    for (int j = 0; j < 8; ++j) { const int s = 32 * ta + 16 * s2 + 8 * (j >> 2) + 4 * lh + (j & 3); const float v = acc[8 * s2 + j];
                        const float ev = v * __expf(fminf(dir ? Gbc - sc[64 + s] : Gfc - sc[s], 0.f)); o8[j] = (dir ? (s >= b) : (s <= b)) ? ev : 0.f; }
                    *(v4u*)(rec + ((tb * 4 + 2 * ta + s2) * 64 + lane) * 16) = pack8f(o8); } }
        }
    }
    __syncthreads();
    asm volatile("" : "+v"(tid), "+v"(lane));
    if (wave == 0) dn_solve_and_write<0>(lds, lane);
    else if (wave == 1) dn_solve_and_write<1>(lds, lane);
    else {
        const int r = lane & 31, lh = lane >> 5;
        for (int f = wave - 2; f < 32; f += 6) { const int dir = f >> 4, m = (f >> 2) & 3, t = f & 3; const int dk = 32 * m + r;
            const v2u k0 = *(const LAS v2u*)(lds + L_KT + dk * TB_PITCH + (16 * t + 4 * lh) * 2), k1 = *(const LAS v2u*)(lds + L_KT + dk * TB_PITCH + (16 * t + 8 + 4 * lh) * 2);
            const float Gl = dir ? sc[64] : sc[63]; const LAS float* Gs = sc + (dir ? 64 : 0) + 16 * t + 4 * lh; float o8[8];
            o8[0] = bflo(k0.x) * __expf(Gl - Gs[0]); o8[1] = bfhi(k0.x) * __expf(Gl - Gs[1]); o8[2] = bflo(k0.y) * __expf(Gl - Gs[2]); o8[3] = bfhi(k0.y) * __expf(Gl - Gs[3]);
            o8[4] = bflo(k1.x) * __expf(Gl - Gs[8]); o8[5] = bfhi(k1.x) * __expf(Gl - Gs[9]); o8[6] = bflo(k1.y) * __expf(Gl - Gs[10]); o8[7] = bfhi(k1.y) * __expf(Gl - Gs[11]);
            *(v4u*)(dnx_rec(F, dir, hd, cn) + DX_K + ((m * 4 + t) * 64 + lane) * 16) = pack8f(o8); }
    }
    __syncthreads();
    asm volatile("" : "+v"(tid), "+v"(lane));
    {
        const int dir = wave >> 2, x = wave & 3, r = lane & 31, lh = lane >> 5;
        const LAS unsigned char* Tu = lds + L_TB + (dir ? 2 : 0) * TB_SZ; const LAS unsigned char* Tw = Tu + TB_SZ;
        unsigned char* rec = dnx_rec(F, dir, hd, cn);
#pragma unroll
        for (int mt = 0; mt < 2; ++mt) {
            f32x16 aw, au;
#pragma unroll
            for (int i = 0; i < 16; ++i) { aw[i] = 0.f; au[i] = 0.f; }
#pragma unroll
            for (int kk = 0; kk < 4; ++kk) { const int so = (16 * kk + 8 * lh) * 2;
                aw = __builtin_amdgcn_mfma_f32_32x32x16_bf16(*(const LAS bf16x8*)(lds + L_KT + (32 * x + r) * TB_PITCH + so), *(const LAS bf16x8*)(Tw + (32 * mt + r) * TB_PITCH + so), aw, 0, 0, 0);
                au = __builtin_amdgcn_mfma_f32_32x32x16_bf16(*(const LAS bf16x8*)(Tu + (32 * mt + r) * TB_PITCH + so), *(const LAS bf16x8*)(lds + L_VT + (32 * x + r) * TB_PITCH + so), au, 0, 0, 0); }
            float tmp[16];
#pragma unroll
            for (int i = 0; i < 16; ++i) tmp[i] = aw[i];
            *(v4u*)(rec + DX_W + ((mt * 8 + 2 * x) * 64 + lane) * 16) = pack8f(tmp); *(v4u*)(rec + DX_W + ((mt * 8 + 2 * x + 1) * 64 + lane) * 16) = pack8f(tmp + 8);
#pragma unroll
            for (int i = 0; i < 16; ++i) tmp[i] = au[i];
            *(v4u*)(rec + DX_U + ((x * 2 + mt) * 64 + lane) * 32) = pack8f(tmp); *(v4u*)(rec + DX_U + ((x * 2 + mt) * 64 + lane) * 32 + 16) = pack8f(tmp + 8);
        }
    }
}
__device__ __forceinline__ void dn_prep_phase(Frame& F) {
    for (int u = blockIdx.x; u < 256 * DNH; u += F.G) dn_prep_unit(F, u >> 3, u & 7);
}


constexpr int NSEG = 16, SEGL = 16;
constexpr size_t WS_PF = 176 * MiB, WS_RG = 184 * MiB, WS_SIN = 24 * MiB;
constexpr int SLOT1 = 49152, SLOT3 = 73728, L_GLS = 147456;
#define DN_WAIT(V) asm volatile("s_waitcnt vmcnt(" #V ") lgkmcnt(0)" ::: "memory")
#define DN_BAR() do { __builtin_amdgcn_s_barrier(); asm volatile("" ::: "memory"); } while (0)
__device__ __forceinline__ bf16x8 cvt8(const f32x16& v, int o) { v4u w; w.x = cvtpk(v[o], v[o + 1]); w.y = cvtpk(v[o + 2], v[o + 3]); w.z = cvtpk(v[o + 4], v[o + 5]); w.w = cvtpk(v[o + 6], v[o + 7]); return __builtin_bit_cast(bf16x8, w); }
__device__ __forceinline__ int seg_chunk(int dir, int g, int i) { const int n = SEGL * g + i; return dir ? 255 - n : n; }
__device__ __forceinline__ void u_to_acc(f32x16& a, const LAS unsigned char* up) {
    const v4u u0 = *(const LAS v4u*)up, u1 = *(const LAS v4u*)(up + 16);
#pragma unroll
    for (int i = 0; i < 4; ++i) { a[2 * i] = bflo(u0[i]); a[2 * i + 1] = bfhi(u0[i]); a[8 + 2 * i] = bflo(u1[i]); a[8 + 2 * i + 1] = bfhi(u1[i]); }
}
template <bool OUT>
__device__ __forceinline__ void dn_step(f32x16 (&S)[4], f32x16 (&aV)[2], f32x16 (&aO)[2], const LAS unsigned char* buf, float gl) {
#pragma unroll
    for (int t = 0; t < 8; ++t) { const bf16x8 sb = cvt8(S[t >> 1], 8 * (t & 1));
#pragma unroll
        for (int mt = 0; mt < 2; ++mt) {
            aV[mt] = __builtin_amdgcn_mfma_f32_32x32x16_bf16(*(const LAS bf16x8*)(buf + DX_W + (mt * 8 + t) * 1024), sb, aV[mt], 0, 0, 0);
            if (OUT) aO[mt] = __builtin_amdgcn_mfma_f32_32x32x16_bf16(*(const LAS bf16x8*)(buf + DX_Q + (mt * 8 + t) * 1024), sb, aO[mt], 0, 0, 0); } }
    bf16x8 vb[4];
#pragma unroll
    for (int t = 0; t < 4; ++t) vb[t] = cvt8(aV[t >> 1], 8 * (t & 1));
#pragma unroll
    for (int m = 0; m < 4; ++m) S[m] = S[m] * gl;
#pragma unroll
    for (int t = 0; t < 4; ++t) {
#pragma unroll
        for (int m = 0; m < 4; ++m) S[m] = __builtin_amdgcn_mfma_f32_32x32x16_bf16(*(const LAS bf16x8*)(buf + DX_K + (m * 4 + t) * 1024), vb[t], S[m], 0, 0, 0);
        if (OUT) {
#pragma unroll
            for (int mt = 0; mt < 2; ++mt) aO[mt] = __builtin_amdgcn_mfma_f32_32x32x16_bf16(*(const LAS bf16x8*)(buf + DX_A + (mt * 4 + t) * 1024), vb[t], aO[mt], 0, 0, 0); } }
}

__device__ __forceinline__ void dn_pass1(Frame& F) {
    LAS unsigned char* lds = F.lds; const int lane = F.lane, wave = F.wave, r = lane & 31, lh = lane >> 5, part = wave >> 2, d = wave & 3;
    LAS float* gls = (LAS float*)(lds + L_GLS);
    for (int unit = blockIdx.x; unit < 16 * NSEG; unit += F.G) {
        const int dir = unit >> 7, hd = (unit >> 4) & 7, g = unit & 15;
        DN_WAIT(0); __syncthreads();
        if (F.tid < SEGL) gls[F.tid] = WSP(float, WS_GL)[(dir * 8 + hd) * 256 + seg_chunk(dir, g, F.tid)];
        DN_WAIT(0);
        f32x16 S[4];
#pragma unroll
        for (int m = 0; m < 4; ++m)
#pragma unroll
            for (int i = 0; i < 16; ++i) S[m][i] = (part && (32 * m + (i & 3) + 8 * (i >> 2) + 4 * lh == 32 * d + r)) ? 1.f : 0.f;
#define P1_ISSUE(i) do { const unsigned char* src_ = dnx_rec(F, dir, hd, seg_chunk(dir, g, (i))) + lane * 16; LAS unsigned char* dst_ = lds + ((i) % 3) * SLOT1; \
            _Pragma("unroll") for (int k_ = 0; k_ < 6; ++k_) { const int p_ = wave + 8 * k_; __builtin_amdgcn_global_load_lds((const unsigned*)(src_ + p_ * 1024), (LAS unsigned*)(dst_ + p_ * 1024), 16, 0, 0); } } while (0)
        P1_ISSUE(0); P1_ISSUE(1);
        for (int i = 0; i < SEGL; ++i) {
            if (i + 1 < SEGL) DN_WAIT(6); else DN_WAIT(0);
            DN_BAR();
            if (i + 2 < SEGL) P1_ISSUE(i + 2);
            const LAS unsigned char* buf = lds + (i % 3) * SLOT1 + lane * 16;
            f32x16 aV[2], aO[2];
#pragma unroll
            for (int mt = 0; mt < 2; ++mt) {
                if (part == 0) u_to_acc(aV[mt], lds + (i % 3) * SLOT1 + DX_U + ((d * 2 + mt) * 64 + lane) * 32);
                else {
#pragma unroll
                    for (int e = 0; e < 16; ++e) aV[mt][e] = 0.f; } }
            dn_step<false>(S, aV, aO, buf, gls[i]);
        }
#undef P1_ISSUE
        DN_WAIT(0); DN_BAR();
        if (part == 0) {
            float* rg = (float*)(F.ws + WS_RG) + (size_t)unit * 16384;
#pragma unroll
            for (int m = 0; m < 4; ++m)
#pragma unroll
                for (int q = 0; q < 4; ++q) *(f32x4*)(rg + ((d * 4 + m) * 64 + lane) * 16 + 4 * q) = (f32x4){S[m][4 * q], S[m][4 * q + 1], S[m][4 * q + 2], S[m][4 * q + 3]};
        } else {
#pragma unroll
            for (int m = 0; m < 4; ++m)
#pragma unroll
                for (int i = 0; i < 16; ++i) *(LAS unsigned short*)(lds + (32 * m + (i & 3) + 8 * (i >> 2) + 4 * lh) * 272 + (32 * d + r) * 2) = (unsigned short)f2bf(S[m][i]);
        }
        DN_WAIT(0); DN_BAR();
        if (part == 1) {
            unsigned char* pf = F.ws + WS_PF + (size_t)unit * 32768;
#pragma unroll
            for (int k = 0; k < 8; ++k) { const int f = d * 8 + k, m = f >> 3, t = f & 7;
                const v2u a = *(const LAS v2u*)(lds + (32 * m + r) * 272 + (16 * t + 4 * lh) * 2), b = *(const LAS v2u*)(lds + (32 * m + r) * 272 + (16 * t + 8 + 4 * lh) * 2);
                *(v4u*)(pf + (f * 64 + lane) * 16) = (v4u){a.x, a.y, b.x, b.y}; }
        }
    }
}
__device__ __forceinline__ void dn_fold(Frame& F) {
    const int b = blockIdx.x; if (b >= 16) return;
    LAS unsigned char* lds = F.lds; const int lane = F.lane, wave = F.wave, dir = b >> 3, hd = b & 7;
    const int unit0 = (dir * 8 + hd) * 16;
    __syncthreads();
    if (wave >= 4) {
        const int lw = wave - 4;
        for (int g = 0; g < NSEG; ++g) {
            if (g < NSEG - 1) { const unsigned char* src = F.ws + WS_PF + (size_t)(unit0 + g) * 32768 + lane * 16; LAS unsigned char* dst = lds + (g & 1) * 32768;
#pragma unroll
                for (int k = 0; k < 8; ++k) { const int p = lw + 4 * k; __builtin_amdgcn_global_load_lds((const unsigned*)(src + p * 1024), (LAS unsigned*)(dst + p * 1024), 16, 0, 0); } }
            DN_WAIT(0); DN_BAR();
        }
    } else {
        const int d = wave;
        f32x16 S[4], R[4];
#pragma unroll
        for (int m = 0; m < 4; ++m)
#pragma unroll
            for (int i = 0; i < 16; ++i) S[m][i] = 0.f;
        const float* rg0 = (const float*)(F.ws + WS_RG) + (size_t)unit0 * 16384; float* sin0 = (float*)(F.ws + WS_SIN) + (size_t)unit0 * 16384;
#pragma unroll
        for (int m = 0; m < 4; ++m)
#pragma unroll
            for (int q = 0; q < 4; ++q) { const f32x4 v = *(const f32x4*)(rg0 + ((d * 4 + m) * 64 + lane) * 16 + 4 * q); R[m][4 * q] = v[0]; R[m][4 * q + 1] = v[1]; R[m][4 * q + 2] = v[2]; R[m][4 * q + 3] = v[3]; }
        DN_BAR();
        for (int g = 0; g < NSEG; ++g) {
            float* so = sin0 + (size_t)g * 16384;
#pragma unroll
            for (int m = 0; m < 4; ++m)
#pragma unroll
                for (int q = 0; q < 4; ++q) *(f32x4*)(so + ((d * 4 + m) * 64 + lane) * 16 + 4 * q) = (f32x4){S[m][4 * q], S[m][4 * q + 1], S[m][4 * q + 2], S[m][4 * q + 3]};
            if (g == NSEG - 1) break;
            const LAS unsigned char* buf = lds + (g & 1) * 32768 + lane * 16;
            bf16x8 sb[8];
#pragma unroll
            for (int t = 0; t < 8; ++t) sb[t] = cvt8(S[t >> 1], 8 * (t & 1));
#pragma unroll
            for (int m = 0; m < 4; ++m) { S[m] = R[m];
#pragma unroll
                for (int t = 0; t < 8; ++t) S[m] = __builtin_amdgcn_mfma_f32_32x32x16_bf16(*(const LAS bf16x8*)(buf + (m * 8 + t) * 1024), sb[t], S[m], 0, 0, 0); }
            if (g + 1 < NSEG - 1) { const float* rg = rg0 + (size_t)(g + 1) * 16384;
#pragma unroll
                for (int m = 0; m < 4; ++m)
#pragma unroll
                    for (int q = 0; q < 4; ++q) { const f32x4 v = *(const f32x4*)(rg + ((d * 4 + m) * 64 + lane) * 16 + 4 * q); R[m][4 * q] = v[0]; R[m][4 * q + 1] = v[1]; R[m][4 * q + 2] = v[2]; R[m][4 * q + 3] = v[3]; } }
            asm volatile("s_waitcnt lgkmcnt(0)" ::: "memory");
            DN_BAR();
        }
    }
    __syncthreads();
}
__device__ __forceinline__ void dn_pass3(Frame& F) {
    LAS unsigned char* lds = F.lds; const int lane = F.lane, wave = F.wave, r = lane & 31, lh = lane >> 5;
    LAS float* gls = (LAS float*)(lds + L_GLS);
    for (int unit = blockIdx.x; unit < 16 * NSEG; unit += F.G) {
        const int dir = unit >> 7, hd = (unit >> 4) & 7, g = unit & 15;
        __syncthreads();
        if (F.tid < SEGL) gls[F.tid] = WSP(float, WS_GL)[(dir * 8 + hd) * 256 + seg_chunk(dir, g, F.tid)];
        asm volatile("s_waitcnt lgkmcnt(0)" ::: "memory");
        if (wave >= 4) {
            const int lw = wave - 4;
            for (int i = 0; i <= SEGL; ++i) {
                if (i < SEGL) { const unsigned char* src = dnx_rec(F, dir, hd, seg_chunk(dir, g, i)) + lane * 16; LAS unsigned char* dst = lds + (i & 1) * SLOT3;
#pragma unroll
                    for (int k = 0; k < 18; ++k) { const int p = lw + 4 * k; __builtin_amdgcn_global_load_lds((const unsigned*)(src + p * 1024), (LAS unsigned*)(dst + p * 1024), 16, 0, 0); } }
                DN_WAIT(0); DN_BAR();
            }
        } else {
            const int d = wave;
            f32x16 S[4];
            const float* si = (const float*)(F.ws + WS_SIN) + (size_t)unit * 16384;
#pragma unroll
            for (int m = 0; m < 4; ++m)
#pragma unroll
                for (int q = 0; q < 4; ++q) { const f32x4 v = *(const f32x4*)(si + ((d * 4 + m) * 64 + lane) * 16 + 4 * q); S[m][4 * q] = v[0]; S[m][4 * q + 1] = v[1]; S[m][4 * q + 2] = v[2]; S[m][4 * q + 3] = v[3]; }
            bf16* O = WSP(bf16, dir ? WS_OB : WS_OF);
            DN_BAR();
            for (int i = 0; i < SEGL; ++i) {
                const int cn = seg_chunk(dir, g, i); const LAS unsigned char* slot = lds + (i & 1) * SLOT3;
                f32x16 aV[2], aO[2];
#pragma unroll
                for (int mt = 0; mt < 2; ++mt) { u_to_acc(aV[mt], slot + DX_U + ((d * 2 + mt) * 64 + lane) * 32);
#pragma unroll
                    for (int e = 0; e < 16; ++e) aO[mt][e] = 0.f; }
                dn_step<true>(S, aV, aO, slot + lane * 16, gls[i]);
                bf16* op = O + (size_t)(64 * cn + 4 * lh) * 1024 + hd * 128 + 32 * d + r;
#pragma unroll
                for (int mt = 0; mt < 2; ++mt)
#pragma unroll
                    for (int e = 0; e < 16; ++e) op[(size_t)(32 * mt + (e & 3) + 8 * (e >> 2)) * 1024] = (bf16)f2bf(aO[mt][e]);
                asm volatile("s_waitcnt lgkmcnt(0)" ::: "memory");
                DN_BAR();
            }
        }
    }
    __syncthreads();
}

#ifndef MK_N_LAUNCHES
#define MK_N_LAUNCHES 1
#endif
constexpr int N_PHASES = 14;
struct Args { const float* in[23]; float* out; unsigned char* ws; int ph_lo, ph_hi; };
static_assert(sizeof(Args) == 23 * 8 + 8 + 8 + 8, "Args has no padding");

__global__ void __launch_bounds__(NWAVES * 64, 2) enc_fwd(Args args) {
    extern __shared__ __attribute__((aligned(16))) unsigned char lds[];
    Frame F;
    F.lds = (LAS unsigned char*)lds;
    F.MISC = (volatile LAS unsigned*)(F.lds + MISC_OFF);
    F.tid = threadIdx.x; F.lane = F.tid & 63; F.wave = __builtin_amdgcn_readfirstlane(F.tid >> 6);
    F.G = gridDim.x; { const int bx = blockIdx.x; F.vcu = (F.G % 8 == 0) ? (bx % 8) * (F.G / 8) + bx / 8 : bx; }
#pragma unroll
    for (int i = 0; i < 23; ++i) F.in[i] = args.in[i];
    F.out = args.out; F.ws = args.ws; F.ctl = (gu32*)(args.ws + WS_CTL);
    for (int u = F.tid; u < (LDS_BYTES - LDSCTL_OFF) / 4; u += NWAVES * 64) ((LAS unsigned*)(F.lds + LDSCTL_OFF))[u] = 0u;
    __syncthreads();
    const int lo = args.ph_lo, hi = args.ph_hi;
    XcdBarrier bar; bar.bar = (unsigned*)(F.ctl + CW_BAR); bar.x = 0; bar.st = nullptr;
    if (hi - lo > 1) bar = xcd_barrier_post((unsigned*)(F.ctl + CW_BAR), F.MISC + 8);
#define IN(k) (lo <= (k) && (k) < hi)
#define SEAM(k) do { if (IN(k) && IN((k) + 1)) xcd_barrier(bar); } while (0)
    float* sumsq2 = (float*)(F.ws + WS_CTL + CTL_SUMSQ2); float* sumsq3 = (float*)(F.ws + WS_CTL + CTL_SUMSQ3); float* sumsq4 = (float*)(F.ws + WS_CTL + CTL_SUMSQ4);

    if (IN(0)) { p0_prologue(F); } SEAM(0);
    if (IN(1)) {
        { pg8::Gemm g{WSP(bf16, WS_XB), WSP(bf16, WS_WIN), SEQ, NINP, DM}; pg8::StaticOrder S; S.init(SEQ, NINP, F.G, (int)blockIdx.x);
          EpiProj E{WSP(float, WS_RSTD1), WSP(bf16, WS_QKV), DOP(bf16, DO_Z), DOP(bf16, DO_QSW), DOP(bf16, DO_KVSW), WSP(float, WS_AB)};
          pg8::gemm_phase<EpiProj, pg8::StaticOrder, true, true>(F.lds + RING_OFF, g, S, E); }
        { pg8::Gemm g{WSP(bf16, WS_MEMB), WSP(bf16, WS_WKV), MEMT, 1024, DM}; pg8::StaticOrder S; S.init(MEMT, 1024, F.G, (int)blockIdx.x);
          EpiScaleBf16 E{WSP(float, WS_RSTDM), 0, 1.0f, WSP(bf16, WS_KVM), 1024};
          pg8::gemm_phase<EpiScaleBf16, pg8::StaticOrder, true, true>(F.lds + RING_OFF, g, S, E); }
    } SEAM(1);
    if (IN(2)) { dn_prep_phase(F);
#ifdef REPEAT_PREP
        dn_prep_phase(F);
#endif
        swa_phase(F);
#ifdef REPEAT_SWA
        swa_phase(F);
#endif
    } SEAM(2);
    if (IN(3)) { dn_pass1(F); } SEAM(3);
    if (IN(12)) { dn_fold(F); } if (IN(12) && IN(13)) xcd_barrier(bar);
    if (IN(13)) { dn_pass3(F); } if (IN(13) && IN(4)) xcd_barrier(bar);
    if (IN(4)) { dn_combine(F); p4_transposes(F); } SEAM(4);
    if (IN(5)) {
        pg8::Gemm g{WSP(bf16, WS_XB), WSP(bf16, WS_WOUT), SEQ, DM, DM}; pg8::StaticOrder S; S.init(SEQ, DM, F.G, (int)blockIdx.x);
        EpiRes E{F.in[0], F.out, WSP(bf16, WS_H1B), sumsq2};
        pg8::gemm_phase<EpiRes, pg8::StaticOrder, true, true>(F.lds + RING_OFF, g, S, E);
    } SEAM(5);
    if (IN(6)) {
        pg8::Gemm g{WSP(bf16, WS_H1B), WSP(bf16, WS_WQ), SEQ, 512, DM}; pg8::StaticOrder S; S.init(SEQ, 512, F.G, (int)blockIdx.x);
        EpiScaleBf16 E{sumsq2, 1, QSCALE, WSP(bf16, WS_QM), 512};
        pg8::gemm_phase<EpiScaleBf16, pg8::StaticOrder, true, true>(F.lds + RING_OFF, g, S, E);
    } SEAM(6);
    if (IN(7)) { mem_attn_phase(F); } SEAM(7);
    if (IN(8)) {
        pg8::Gemm g{WSP(bf16, WS_OM), WSP(bf16, WS_WO), SEQ, DM, 512}; pg8::StaticOrder S; S.init(SEQ, DM, F.G, (int)blockIdx.x);
        EpiRes E{F.out, F.out, WSP(bf16, WS_XB), sumsq3};
        pg8::gemm_phase<EpiRes, pg8::StaticOrder, true, true>(F.lds + RING_OFF, g, S, E);
    } SEAM(8);
    if (IN(9)) {
        pg8::Gemm g{WSP(bf16, WS_XB), WSP(bf16, WS_WGU), SEQ, 2 * DFF, DM}; pg8::StaticOrder S; S.init(SEQ, 2 * DFF, F.G, (int)blockIdx.x);
        EpiSwiglu E{sumsq3, WSP(bf16, WS_HID)};
        pg8::gemm_phase<EpiSwiglu, pg8::StaticOrder, true, true>(F.lds + RING_OFF, g, S, E);
    } SEAM(9);
    if (IN(10)) {
        pg8::Gemm g{WSP(bf16, WS_HID), WSP(bf16, WS_WD), SEQ, DM, DFF}; pg8::StaticOrder S; S.init(SEQ, DM, F.G, (int)blockIdx.x);
        EpiRes E{F.out, F.out, nullptr, sumsq4};
        pg8::gemm_phase<EpiRes, pg8::StaticOrder, true, true>(F.lds + RING_OFF, g, S, E);
    } SEAM(10);
    if (IN(11)) { final_norm(F); }
#undef IN
#undef SEAM
}

extern "C" void kernel_launch(void* const* d_in, const int* in_sizes, int n_in, void* d_out, int out_size, void* d_ws, size_t ws_size, hipStream_t stream) {
    static int grid = 0;
    if (grid == 0) {
        if (n_in != 23 || out_size != SEQ * DM || ws_size < WS_END) { fprintf(stderr, "kernel_launch: unexpected shapes (n_in %d out %d ws %zu)\n", n_in, out_size, ws_size); grid = -1; return; }
        int dev = 0, cus = 0;
        if (hipGetDevice(&dev) != hipSuccess || hipDeviceGetAttribute(&cus, hipDeviceAttributeMultiprocessorCount, dev) != hipSuccess) { grid = -1; return; }
        if (hipFuncSetAttribute((const void*)enc_fwd, hipFuncAttributeMaxDynamicSharedMemorySize, LDS_BYTES) != hipSuccess) { fprintf(stderr, "kernel_launch: hipFuncSetAttribute failed\n"); grid = -1; return; }
        (void)hipGetLastError();
        grid = cus;
    }
    if (grid < 0) return;
    if (hipMemsetAsync((char*)d_ws + WS_CTL, 0, CTL_ZERO_BYTES, stream) != hipSuccess) return;
    Args a{};
    for (int i = 0; i < 23; ++i) a.in[i] = (const float*)d_in[i];
    a.out = (float*)d_out; a.ws = (unsigned char*)d_ws;
    const int per = (N_PHASES + MK_N_LAUNCHES - 1) / MK_N_LAUNCHES;
    for (int lo = 0; lo < N_PHASES; lo += per) {
        a.ph_lo = lo; a.ph_hi = (lo + per < N_PHASES) ? lo + per : N_PHASES;
        hipLaunchKernelGGL(enc_fwd, dim3(grid), dim3(NWAVES * 64), LDS_BYTES, stream, a);
    }
}
```

```cpp
#include <hip/hip_runtime.h>
#include <cstdio>
#include <cstdint>
namespace pg8 {
__device__ __forceinline__ unsigned cvt_pk_bf16(float lo, float hi) { unsigned r; asm volatile("v_cvt_pk_bf16_f32 %0, %1, %2" : "=v"(r) : "v"(lo), "v"(hi)); return r; }
#define PG8_LAS __attribute__((address_space(3)))
typedef unsigned short bf16_t;
typedef short bf16x8 __attribute__((ext_vector_type(8)));
typedef float f32x4 __attribute__((ext_vector_type(4)));
typedef unsigned u32x4 __attribute__((ext_vector_type(4)));
constexpr int BM = 256, BK = 64, HALF = 128, HTB = HALF * BK * 2  , STAGE_BYTES = 8 * HTB, NXCD = 8, WGM = 8;

__host__ __device__ __forceinline__ int lds_byte(int r, int c) { const int st = (r >> 4) * 2 + (c >> 5), rr = r & 15, cc = c & 31, ob = rr * 64 + cc * 2; return st * 1024 + (ob ^ (((ob >> 9) & 1) << 5)); }
__host__ __device__ __forceinline__ void stage_rc(int b, int& R, int& C) { const int st = b / 1024, sb = b % 1024, swz = sb ^ (((sb >> 9) & 1) << 5); R = (st >> 1) * 16 + swz / 64; C = (st & 1) * 32 + (swz % 64) / 2; }
__host__ __device__ __forceinline__ int perm32(int rho) { const int n = rho >> 4, i = rho & 15; return 8 * (i >> 2) + 4 * n + (i & 3); }

struct Unit { int pm, pn; };
struct Gemm { const bf16_t* A; const bf16_t* Bt; int M, N, K; };

struct StaticOrder {
    int nM, nN, nwg, G, c;
    __host__ __device__ void init(int M, int N, int G_, int c_) { nM = M / BM; nN = N / BM; nwg = nM * nN; G = G_; c = c_; }
    __host__ __device__ bool next(int i, Unit& u) const {
        const long L = (long)i * G + c; if (L >= nwg) return false;
        int wgid = (int)L; { const int q = nwg / NXCD, r = nwg % NXCD, xcd = wgid % NXCD, off = wgid / NXCD; wgid = (xcd < r ? xcd * (q + 1) : r * (q + 1) + (xcd - r) * q) + off; }
        const int nig = WGM * nN, gid = wgid / nig, fm = gid * WGM, gsz = (nM - fm) < WGM ? (nM - fm) : WGM;
        u.pm = fm + ((wgid % nig) % gsz); u.pn = (wgid % nig) / gsz; return true;
    }
    __device__ __forceinline__ void a_ready(const Unit&) const {}
    __device__ __forceinline__ void done(const Unit&) const {}
};

template <class Epi, class Sched, bool ALIGN_EPI = false, bool SP2 = false>
__device__ __forceinline__ void gemm_phase(PG8_LAS unsigned char* lds, const Gemm g, const Sched& S, const Epi& E) {
    const int tid = threadIdx.x, wid = __builtin_amdgcn_readfirstlane(tid >> 6), lane = tid & 63, wr = wid >> 2, wc = wid & 3, fr = lane & 15, fq = lane >> 4;
    const int K = g.K, nt = K / BK;
    unsigned voffA[2], voffB[2];
#pragma unroll
    for (int i = 0; i < 2; ++i) { int R, C; stage_rc(tid * 16 + i * 8192, R, C); const int Rb = Epi::PERM ? ((R & ~31) + perm32(R & 31)) : R;
        voffA[i] = (unsigned)(R * K + C) * 2u; voffB[i] = (unsigned)(Rb * K + C) * 2u; }
    const size_t kstep = (size_t)(BK * 2);
    const size_t hstep = (size_t)HALF * K * 2;
    const size_t tstep = 2 * hstep;
    const unsigned ldsw = (unsigned)wid * 1024u;
    const int aoff = lds_byte(wr * 64 + fr, fq * 8), boff = lds_byte(wc * 32 + fr, fq * 8);
#define PG8_SA(b, h) (((b) * 2 + (h)) * HTB)
#define PG8_SB(b, h) ((4 + (b) * 2 + (h)) * HTB)
#define PG8_STAGE(bufoff, gbase, voff) do { _Pragma("unroll") for (int _i = 0; _i < 2; ++_i) \
        __builtin_amdgcn_global_load_lds((const unsigned*)((const char*)(gbase) + (voff)[_i]), (PG8_LAS unsigned*)(lds + (bufoff) + ldsw + _i * 8192), 16, 0, 0); } while (0)
#define PG8_LDA(dst, b, h) do { _Pragma("unroll") for (int m = 0; m < 4; ++m) _Pragma("unroll") for (int k = 0; k < 2; ++k) dst[m][k] = *(const PG8_LAS bf16x8*)(lds + PG8_SA(b, h) + aoff + m * 2048 + k * 1024); } while (0)
#define PG8_LDB(dst, b, h) do { _Pragma("unroll") for (int n = 0; n < 2; ++n) _Pragma("unroll") for (int k = 0; k < 2; ++k) dst[n][k] = *(const PG8_LAS bf16x8*)(lds + PG8_SB(b, h) + boff + n * 2048 + k * 1024); } while (0)
#define PG8_MMA(ai, bj, At, Bt) do { __builtin_amdgcn_s_setprio(1); _Pragma("unroll") for (int m = 0; m < 4; ++m) _Pragma("unroll") for (int n = 0; n < 2; ++n) _Pragma("unroll") for (int k = 0; k < 2; ++k) \
        acc[ai][bj][m][n] = __builtin_amdgcn_mfma_f32_16x16x32_bf16(Bt[n][k], At[m][k], acc[ai][bj][m][n], 0, 0, 0); __builtin_amdgcn_s_setprio(0); } while (0)
#define PG8_WAIT_V(n) asm volatile("s_waitcnt vmcnt(" #n ")" ::: "memory")
#define PG8_WAIT_L(n) asm volatile("s_waitcnt lgkmcnt(" #n ")" ::: "memory")
#define PG8_BAR __builtin_amdgcn_s_barrier()
#define PG8_SCHED __builtin_amdgcn_sched_barrier(0)
    Unit cur, nxt; int ui = 0;
    if (!S.next(0, cur)) return;
    f32x4 acc[2][2][4][2];
#pragma unroll
    for (int a = 0; a < 2; ++a)
#pragma unroll
        for (int b = 0; b < 2; ++b)
#pragma unroll
            for (int m = 0; m < 4; ++m)
#pragma unroll
                for (int n = 0; n < 2; ++n) acc[a][b][m][n] = (f32x4){0.f, 0.f, 0.f, 0.f};
    bf16x8 At[4][2], B0[2][2], B1[2][2];
    const char* cA = (const char*)g.A + (size_t)cur.pm * tstep; const char* cB = (const char*)g.Bt + (size_t)cur.pn * tstep;
    S.a_ready(cur);
    if constexpr (SP2) {
        PG8_STAGE(PG8_SB(0, 0), cB, voffB); PG8_STAGE(PG8_SB(0, 1), cB + hstep, voffB); PG8_STAGE(PG8_SA(0, 0), cA, voffA); PG8_STAGE(PG8_SA(0, 1), cA + hstep, voffA);
        if (wr == 1) PG8_BAR;
        PG8_WAIT_V(2); PG8_BAR;
        PG8_STAGE(PG8_SB(1, 0), cB + kstep, voffB); PG8_STAGE(PG8_SA(1, 0), cA + kstep, voffA); PG8_STAGE(PG8_SB(1, 1), cB + hstep + kstep, voffB);
        PG8_WAIT_V(6); PG8_BAR;
    } else {
        PG8_STAGE(PG8_SB(0, 0), cB, voffB); PG8_STAGE(PG8_SA(0, 0), cA, voffA); PG8_STAGE(PG8_SB(0, 1), cB + hstep, voffB); PG8_STAGE(PG8_SA(0, 1), cA + hstep, voffA);
        if (wr == 1) PG8_BAR;
        PG8_WAIT_V(4); PG8_BAR;
        PG8_STAGE(PG8_SB(1, 0), cB + kstep, voffB); PG8_STAGE(PG8_SA(1, 0), cA + kstep, voffA); PG8_STAGE(PG8_SB(1, 1), cB + hstep + kstep, voffB);
        PG8_WAIT_V(6); PG8_BAR;
    }
    for (;;) {
        const bool has_next = S.next(ui + 1, nxt);
        const char* nA = has_next ? (const char*)g.A + (size_t)nxt.pm * tstep : cA; const char* nB = has_next ? (const char*)g.Bt + (size_t)nxt.pn * tstep : cB;
        for (int t = 0; t < nt; t += 2) {
            const bool last = (t == nt - 2);
            const char* a1 = cA + (size_t)(t + 1) * kstep;
            const char* a2 = last ? nA : cA + (size_t)(t + 2) * kstep; const char* b2 = last ? nB : cB + (size_t)(t + 2) * kstep;
            const char* a3 = a2 + kstep; const char* b3 = b2 + kstep;
            if (last && has_next) S.a_ready(nxt);
            if constexpr (SP2) {
            PG8_LDB(B0, 0, 0); PG8_LDB(B1, 0, 1); PG8_SCHED; PG8_LDA(At, 0, 0); PG8_STAGE(PG8_SA(1, 1), a1 + hstep, voffA);
            PG8_WAIT_V(8); PG8_WAIT_L(0); PG8_BAR; PG8_MMA(0, 0, At, B0); PG8_MMA(0, 1, At, B1); PG8_BAR; PG8_SCHED;
            PG8_LDA(At, 0, 1); PG8_STAGE(PG8_SB(0, 0), b2, voffB); PG8_STAGE(PG8_SB(0, 1), b2 + hstep, voffB); PG8_STAGE(PG8_SA(0, 0), a2, voffA);
            PG8_WAIT_V(8); PG8_WAIT_L(0); PG8_BAR; PG8_MMA(1, 0, At, B0); PG8_MMA(1, 1, At, B1); PG8_BAR; PG8_SCHED;
            PG8_LDB(B0, 1, 0); PG8_LDB(B1, 1, 1); PG8_SCHED; PG8_LDA(At, 1, 0); PG8_STAGE(PG8_SA(0, 1), a2 + hstep, voffA);
            PG8_WAIT_V(8); PG8_WAIT_L(0); PG8_BAR; PG8_MMA(0, 0, At, B0); PG8_MMA(0, 1, At, B1); PG8_BAR; PG8_SCHED;
            PG8_LDA(At, 1, 1); PG8_STAGE(PG8_SB(1, 0), b3, voffB); PG8_STAGE(PG8_SB(1, 1), b3 + hstep, voffB); PG8_STAGE(PG8_SA(1, 0), a3, voffA);
            PG8_WAIT_V(8); PG8_WAIT_L(0); PG8_BAR; PG8_MMA(1, 0, At, B0); PG8_MMA(1, 1, At, B1); PG8_BAR; PG8_SCHED;
            } else {
            PG8_LDB(B0, 0, 0); PG8_SCHED; PG8_LDA(At, 0, 0); PG8_STAGE(PG8_SA(1, 1), a1 + hstep, voffA);
            PG8_WAIT_L(8); PG8_BAR; PG8_WAIT_L(0); PG8_MMA(0, 0, At, B0); PG8_BAR; PG8_SCHED;
            PG8_LDB(B1, 0, 1); PG8_STAGE(PG8_SB(0, 0), b2, voffB);
            PG8_BAR; PG8_WAIT_L(0); PG8_MMA(0, 1, At, B1); PG8_BAR;
            PG8_LDA(At, 0, 1); PG8_STAGE(PG8_SA(0, 0), a2, voffA);
            PG8_BAR; PG8_WAIT_L(0); PG8_MMA(1, 0, At, B0); PG8_BAR; PG8_SCHED;
            PG8_STAGE(PG8_SB(0, 1), b2 + hstep, voffB);
            PG8_WAIT_V(6); PG8_BAR; PG8_MMA(1, 1, At, B1); PG8_BAR;
            PG8_LDB(B0, 1, 0); PG8_SCHED; PG8_LDA(At, 1, 0); PG8_STAGE(PG8_SA(0, 1), a2 + hstep, voffA);
            PG8_WAIT_L(8); PG8_BAR; PG8_WAIT_L(0); PG8_MMA(0, 0, At, B0); PG8_BAR; PG8_SCHED;
            PG8_LDB(B1, 1, 1); PG8_STAGE(PG8_SB(1, 0), b3, voffB);
            PG8_BAR; PG8_WAIT_L(0); PG8_MMA(0, 1, At, B1); PG8_BAR;
            PG8_LDA(At, 1, 1); PG8_STAGE(PG8_SA(1, 0), a3, voffA);
            PG8_BAR; PG8_WAIT_L(0); PG8_MMA(1, 0, At, B0); PG8_BAR; PG8_SCHED;
            PG8_STAGE(PG8_SB(1, 1), b3 + hstep, voffB);
            PG8_WAIT_V(6); PG8_BAR; PG8_MMA(1, 1, At, B1); PG8_BAR;
            }
        }
        if constexpr (ALIGN_EPI) { if (wr == 0) PG8_BAR; }
        if constexpr (!Epi::AFTER_DRAIN) { E(acc, cur, wr, wc, fr, fq); S.done(cur); }
        if (!has_next) break;
#pragma unroll
        for (int a = 0; a < 2; ++a)
#pragma unroll
            for (int b = 0; b < 2; ++b)
#pragma unroll
                for (int m = 0; m < 4; ++m)
#pragma unroll
                    for (int n = 0; n < 2; ++n) acc[a][b][m][n] = (f32x4){0.f, 0.f, 0.f, 0.f};
        cur = nxt; cA = nA; cB = nB; ++ui;
        if constexpr (ALIGN_EPI) { if (wr == 1) PG8_BAR; }
    }
    PG8_WAIT_V(0);
    if constexpr (!ALIGN_EPI) { if (wr == 0) PG8_BAR; }
    PG8_BAR;
    if constexpr (Epi::AFTER_DRAIN) { E.fused(acc, cur, wr, wc, fr, fq, lds, wid, lane); S.done(cur); }
#undef PG8_SA
#undef PG8_SB
#undef PG8_STAGE
#undef PG8_LDA
#undef PG8_LDB
#undef PG8_MMA
#undef PG8_WAIT_V
#undef PG8_WAIT_L
#undef PG8_BAR
#undef PG8_SCHED
}
}

constexpr int NWAVES = 8;
constexpr int SEQ = 16384, DM = 2048, NIN = 5664, NINP = 5888, DFF = 5632;
constexpr int DNH = 8, HD = 128, SWH = 8, MEMH = 4, MEMT = 256;
constexpr float RMS_EPS = 1e-6f;
constexpr float LOG2E = 1.4426950408889634f;
constexpr float QSCALE = 0.08838834764831845f * 1.4426950408889634f;

constexpr size_t MiB = 1u << 20;
constexpr size_t WS_CTL = 0, CTL_ZERO_BYTES = 1 * MiB;
constexpr size_t CTL_SUMSQ2 = 256 * 1024, CTL_SUMSQ3 = 320 * 1024, CTL_SUMSQ4 = 384 * 1024;
constexpr size_t WS_RSTD1 = 1 * MiB, WS_RSTDM = 1 * MiB + 64 * 1024;
constexpr size_t WS_MEMB = 2 * MiB, WS_KVM = 3 * MiB, WS_AB = 4 * MiB, WS_BG = 6 * MiB;
constexpr size_t WS_WOUT = 8 * MiB, WS_WQ = 16 * MiB, WS_WKV = 18 * MiB, WS_WO = 22 * MiB, WS_WIN = 24 * MiB;
constexpr size_t WS_XB = 48 * MiB;
constexpr size_t WS_QKV = 112 * MiB;
constexpr size_t WS_OF = 112 * MiB, WS_OB = 144 * MiB, WS_H1B = 112 * MiB, WS_QM = 176 * MiB, WS_OM = 192 * MiB;
constexpr size_t WS_DNX = 208 * MiB;
constexpr size_t WS_WGU = 208 * MiB, WS_WD = 252 * MiB, WS_HID = 274 * MiB, WS_END = 496 * MiB;
constexpr size_t DO_Z = 0, DO_QSW = 32 * MiB, DO_KVSW = 64 * MiB;
constexpr int CW_BAR = 4096;

constexpr int RING_OFF = 0, RING_BYTES = 131072;
constexpr int LDS_BYTES = 163840;
constexpr int LDSCTL_OFF = LDS_BYTES - 512, MISC_OFF = LDSCTL_OFF + 320;

#define GAS __attribute__((address_space(1)))
#define LAS __attribute__((address_space(3)))
typedef unsigned short bf16;
typedef unsigned v4u __attribute__((ext_vector_type(4)));
typedef unsigned v2u __attribute__((ext_vector_type(2)));
typedef float f32x4 __attribute__((ext_vector_type(4)));
typedef short bf16x8 __attribute__((ext_vector_type(8)));
typedef short s16x4 __attribute__((ext_vector_type(4)));
typedef GAS unsigned gu32;
#define RLX_AGENT __ATOMIC_RELAXED, __HIP_MEMORY_SCOPE_AGENT
#define LDS_WAIT() asm volatile("s_waitcnt lgkmcnt(0)" ::: "memory")
#define VM_WAIT() asm volatile("s_waitcnt vmcnt(0)" ::: "memory")
__device__ __forceinline__ unsigned f2bf(float f) { unsigned u = __builtin_bit_cast(unsigned, f); return (u + 0x7fffu + ((u >> 16) & 1u)) >> 16; }
__device__ __forceinline__ unsigned pk2(float lo, float hi) { return f2bf(lo) | (f2bf(hi) << 16); }
__device__ __forceinline__ float bf2f(unsigned short b) { return __builtin_bit_cast(float, (unsigned)b << 16); }
__device__ __forceinline__ float bflo(unsigned w) { return __builtin_bit_cast(float, w << 16); }
__device__ __forceinline__ float bfhi(unsigned w) { return __builtin_bit_cast(float, w & 0xffff0000u); }
typedef float f32x2_t __attribute__((ext_vector_type(2))); typedef __bf16 bf16x2_t __attribute__((ext_vector_type(2)));
__device__ __forceinline__ unsigned cvtpk(float lo, float hi) { f32x2_t v = {lo, hi}; bf16x2_t b = __builtin_convertvector(v, bf16x2_t); return __builtin_bit_cast(unsigned, b); }
__device__ __forceinline__ float wave_sum(float v) {
#pragma unroll
    for (int o = 1; o < 64; o <<= 1) v += __shfl_xor(v, o);
    return v;
}
__device__ __forceinline__ float siluf(float x) { return x * __builtin_amdgcn_rcpf(1.0f + __expf(-x)); }
#define XB_TMO      128
#define XB_XCNT(j)  (256  + 64 * (j))
#define XB_XSUB(j)  (1280 + 64 * (j))
#define XB_XGEN(j)  (2304 + 64 * (j))
#define XB_TOP      3328
#define XB_TOPGEN   3392
#define XCD_BAR_WORDS 3456
#define XB_SPIN_CAP (1u << 18)

__device__ __forceinline__ unsigned xb_ld(unsigned* p)              { return __hip_atomic_load(p, __ATOMIC_RELAXED, __HIP_MEMORY_SCOPE_AGENT); }
__device__ __forceinline__ unsigned xb_add(unsigned* p, unsigned v) { return __hip_atomic_fetch_add(p, v, __ATOMIC_RELAXED, __HIP_MEMORY_SCOPE_AGENT); }
__device__ __forceinline__ unsigned xb_xcc_id() { return (unsigned)__builtin_amdgcn_s_getreg((3 << 11) | 20) & 0xFu; }
#define XB_SPIN(cond, bar) do { unsigned _sp = 0; while (cond) { __builtin_amdgcn_s_sleep(1); \
    if ((++_sp & 255u) == 0u) { if (xb_ld(&(bar)[XB_TMO])) break; if (_sp > XB_SPIN_CAP) { atomicAdd(&(bar)[XB_TMO], 1u); break; } } } } while (0)

struct XcdBarrier {
    unsigned* bar; unsigned x;
    volatile LAS unsigned* st;
};

__device__ __forceinline__ XcdBarrier xcd_barrier_post(unsigned* bar, volatile LAS unsigned* st) {
    XcdBarrier b; b.bar = bar; b.x = xb_xcc_id(); b.st = st;
    if (threadIdx.x == 0) (void)xb_add(&bar[XB_XCNT(b.x)], 1u);
    return b;
}
__device__ __forceinline__ void xcd_barrier_complete(unsigned* bar, unsigned x, unsigned& nloc, unsigned& nx) {
    const unsigned G = gridDim.x * gridDim.y * gridDim.z;
    unsigned sum, cnt, mine, sp = 0u;
    for (;;) {
        sum = 0u; cnt = 0u; mine = 0u;
#pragma unroll
        for (unsigned j = 0; j < 16; ++j) { const unsigned c = xb_ld(&bar[XB_XCNT(j)]); sum += c; cnt += (c > 0u) ? 1u : 0u; mine = (j == x) ? c : mine; }
        if (sum == G) break;
        __builtin_amdgcn_s_sleep(1);
        if ((++sp & 255u) == 0u) { if (xb_ld(&bar[XB_TMO])) break; if (sp > XB_SPIN_CAP) { atomicAdd(&bar[XB_TMO], 1u); break; } }
    }
    nloc = mine > 0u ? mine : 1u; nx = cnt > 0u ? cnt : 1u;
}

__device__ __forceinline__ void xcd_barrier(const XcdBarrier& b) {
    asm volatile("s_waitcnt vmcnt(0)" ::: "memory");
    __syncthreads();
    if (threadIdx.x == 0) {
        unsigned* bar = b.bar;
        __builtin_amdgcn_s_waitcnt(0);
        unsigned nloc = b.st[0], nx = b.st[1];
        if (nloc == 0u) { xcd_barrier_complete(bar, b.x, nloc, nx); b.st[0] = nloc; b.st[1] = nx; }
        const unsigned old = xb_add(&bar[XB_XSUB(b.x)], 1u);
        const unsigned gen = old / nloc;
        if (old + 1u == (gen + 1u) * nloc) {
            __builtin_amdgcn_fence(__ATOMIC_RELEASE, "agent");
            asm volatile("s_waitcnt vmcnt(0)" ::: "memory");
            const unsigned og = xb_add(&bar[XB_TOP], 1u);
            const unsigned tg = og / nx;
            if (og + 1u == (tg + 1u) * nx) xb_add(&bar[XB_TOPGEN], 1u);
            else XB_SPIN(xb_ld(&bar[XB_TOPGEN]) == tg, bar);
            __builtin_amdgcn_fence(__ATOMIC_ACQUIRE, "agent");
            xb_add(&bar[XB_XGEN(b.x)], 1u);
            asm volatile("s_waitcnt vmcnt(0)" ::: "memory");
        } else {
            XB_SPIN(xb_ld(&bar[XB_XGEN(b.x)]) == gen, bar);
            __builtin_amdgcn_fence(__ATOMIC_ACQUIRE, "agent");
            asm volatile("s_waitcnt vmcnt(0)" ::: "memory");
        }
    }
    __syncthreads();
}

using pg8::Unit;
__device__ __forceinline__ v4u pack8(f32x4 v0, f32x4 v1) { v4u w; w.x = cvtpk(v0[0], v0[1]); w.y = cvtpk(v0[2], v0[3]); w.z = cvtpk(v1[0], v1[1]); w.w = cvtpk(v1[2], v1[3]); return w; }

struct EpiProj {
    static constexpr bool PERM = true, AFTER_DRAIN = false;
    const float* rstd; bf16* qkv; bf16* z; bf16* qsw; bf16* kvsw; float* ab;
    __device__ __forceinline__ void operator()(const f32x4 (&acc)[2][2][4][2], const Unit& u, int wr, int wc, int fr, int fq) const {
        const int pn = u.pn; bf16* base; int ldc, colt; float sc = 1.f;
        if (pn < 12) { base = qkv; ldc = 3072; colt = pn * 256; }
        else if (pn < 16) { base = z; ldc = 1024; colt = (pn - 12) * 256; }
        else if (pn < 20) { base = qsw; ldc = 1024; colt = (pn - 16) * 256; sc = QSCALE; }
        else if (pn < 22) { base = kvsw; ldc = 512; colt = (pn - 20) * 256; }
        else { base = nullptr; ldc = 0; colt = 0; }
        const int row0 = u.pm * 256 + wr * 64 + fr, col0 = colt + wc * 32 + 8 * fq;
#pragma unroll
        for (int ai = 0; ai < 2; ++ai)
#pragma unroll
            for (int m = 0; m < 4; ++m) {
                const int row = row0 + ai * 128 + m * 16; const float rs = rstd[row] * sc;
                if (base) {
                    bf16* rowp = base + (size_t)row * ldc + col0;
#pragma unroll
                    for (int bj = 0; bj < 2; ++bj) *(v4u*)(rowp + bj * 128) = pack8(acc[ai][bj][m][0] * rs, acc[ai][bj][m][1] * rs);
                } else if (wc == 0) {
                    float* rowp = ab + (size_t)row * 32 + 8 * fq;
                    *(f32x4*)(rowp) = acc[ai][0][m][0] * rs; *(f32x4*)(rowp + 4) = acc[ai][0][m][1] * rs;
                }
            }
    }
};
struct EpiScaleBf16 {
    static constexpr bool PERM = true, AFTER_DRAIN = false;
    const float* rs; int from_sumsq; float sc; bf16* O; int ldc;
    __device__ __forceinline__ void operator()(const f32x4 (&acc)[2][2][4][2], const Unit& u, int wr, int wc, int fr, int fq) const {
        const int row0 = u.pm * 256 + wr * 64 + fr, col0 = u.pn * 256 + wc * 32 + 8 * fq;
#pragma unroll
        for (int ai = 0; ai < 2; ++ai)
#pragma unroll
            for (int m = 0; m < 4; ++m) {
                const int row = row0 + ai * 128 + m * 16; float r = rs[row];
                if (from_sumsq) r = __builtin_amdgcn_rsqf(r * (1.0f / DM) + RMS_EPS);
                r *= sc; bf16* rowp = O + (size_t)row * ldc + col0;
#pragma unroll
                for (int bj = 0; bj < 2; ++bj) *(v4u*)(rowp + bj * 128) = pack8(acc[ai][bj][m][0] * r, acc[ai][bj][m][1] * r);
            }
    }
};
struct EpiRes {
    static constexpr bool PERM = true, AFTER_DRAIN = false;
    const float* res; float* out; bf16* ob; float* sumsq;
    __device__ __forceinline__ void operator()(const f32x4 (&acc)[2][2][4][2], const Unit& u, int wr, int wc, int fr, int fq) const {
        const int row0 = u.pm * 256 + wr * 64 + fr, col0 = u.pn * 256 + wc * 32 + 8 * fq;
#pragma unroll
        for (int ai = 0; ai < 2; ++ai)
#pragma unroll
            for (int m = 0; m < 4; ++m) {
                const int row = row0 + ai * 128 + m * 16; const size_t off = (size_t)row * DM + col0; float ss = 0.f;
#pragma unroll
                for (int bj = 0; bj < 2; ++bj) {
                    const f32x4 r0 = *(const f32x4*)(res + off + bj * 128), r1 = *(const f32x4*)(res + off + bj * 128 + 4);
                    const f32x4 v0 = acc[ai][bj][m][0] + r0, v1 = acc[ai][bj][m][1] + r1;
                    *(f32x4*)(out + off + bj * 128) = v0; *(f32x4*)(out + off + bj * 128 + 4) = v1;
                    if (ob) *(v4u*)(ob + off + bj * 128) = pack8(v0, v1);
                    ss += (v0[0] * v0[0] + v0[1] * v0[1]) + (v0[2] * v0[2] + v0[3] * v0[3]) + (v1[0] * v1[0] + v1[1] * v1[1]) + (v1[2] * v1[2] + v1[3] * v1[3]);
                }
                ss += __shfl_xor(ss, 16); ss += __shfl_xor(ss, 32);
                if (fq == 0) atomicAdd(sumsq + row, ss);
            }
    }
};
struct EpiSwiglu {
    static constexpr bool PERM = true, AFTER_DRAIN = false;
    const float* sumsq; bf16* H;
    __device__ __forceinline__ void operator()(const f32x4 (&acc)[2][2][4][2], const Unit& u, int wr, int wc, int fr, int fq) const {
        const int row0 = u.pm * 256 + wr * 64 + fr, col0 = u.pn * 128 + wc * 32 + 8 * fq;
#pragma unroll
        for (int ai = 0; ai < 2; ++ai)
#pragma unroll
            for (int m = 0; m < 4; ++m) {
                const int row = row0 + ai * 128 + m * 16; const float r = __builtin_amdgcn_rsqf(sumsq[row] * (1.0f / DM) + RMS_EPS);
                f32x4 h[2];
#pragma unroll
                for (int n = 0; n < 2; ++n)
#pragma unroll
                    for (int e = 0; e < 4; ++e) { const float g = acc[ai][0][m][n][e] * r, up = acc[ai][1][m][n][e] * r; h[n][e] = siluf(g) * up; }
                *(v4u*)(H + (size_t)row * DFF + col0) = pack8(h[0], h[1]);
            }
    }
};

struct Frame {
    LAS unsigned char* lds;
    volatile LAS unsigned* MISC;
    gu32* ctl;
    int tid, lane, wave, vcu, G;
    const float* in[23]; float* out; unsigned char* ws;
};
#define WSP(T, off) ((T*)(F.ws + (off)))
#define DOP(T, off) ((T*)((unsigned char*)F.out + (off)))

__device__ __forceinline__ void tr_item(const float* W, int K, int Nsrc, int src_col0, const float* gain, bf16* WT, int dst_row0, int k0, LAS float* scr, int lane) {
#pragma unroll 8
    for (int i = 0; i < 32; ++i) {
        const int kk = 2 * i + (lane >> 5); float v = 0.f;
        if (src_col0 >= 0) { v = W[(size_t)(k0 + kk) * Nsrc + src_col0 + (lane & 31)]; if (gain) v *= gain[k0 + kk]; }
        scr[kk * 33 + (lane & 31)] = v;
    }
    LDS_WAIT(); asm volatile("" ::: "memory");
    const int c = lane & 7;
#pragma unroll
    for (int j = 0; j < 4; ++j) { const int n = (lane >> 3) + 8 * j; const LAS float* s = scr + (8 * c) * 33 + n;
        v4u o; o.x = pk2(s[0 * 33], s[1 * 33]); o.y = pk2(s[2 * 33], s[3 * 33]); o.z = pk2(s[4 * 33], s[5 * 33]); o.w = pk2(s[6 * 33], s[7 * 33]);
        *(GAS v4u*)(WT + (size_t)(dst_row0 + n) * K + k0 + 8 * c) = o; }
    LDS_WAIT(); asm volatile("" ::: "memory");
}
__device__ __forceinline__ int win_src_col(int c) {
    if (c < 4096) return c;
    if (c < 5120) return c - 4096 + 4128;
    if (c < 5376) return c - 5120 + 5152;
    if (c < 5632) return c - 5376 + 5408;
    if (c < 5664) return c - 5632 + 4096;
    return -1;
}
__device__ __forceinline__ void row_to_bf16_rstd(const float* xrow, bf16* orow, float* rstd_out, int lane) {
    const GAS f32x4* xr = (const GAS f32x4*)xrow + lane;
    f32x4 v[8]; float s = 0.f;
#pragma unroll
    for (int j = 0; j < 8; ++j) { v[j] = xr[64 * j]; s += (v[j].x * v[j].x + v[j].y * v[j].y) + (v[j].z * v[j].z + v[j].w * v[j].w); }
    s = wave_sum(s);
    if (lane == 0) *rstd_out = 1.0f / sqrtf(s * (1.0f / DM) + RMS_EPS);
    GAS v2u* o8 = (GAS v2u*)orow + lane;
#pragma unroll
    for (int j = 0; j < 8; ++j) { v2u w; w.x = pk2(v[j].x, v[j].y); w.y = pk2(v[j].z, v[j].w); o8[64 * j] = w; }
}

__device__ __forceinline__ void p0_prologue(Frame& F) {
    LAS float* scr = (LAS float*)(F.lds + RING_OFF + F.wave * 16384);
    const int gw = F.vcu * NWAVES + F.wave, NGW = F.G * NWAVES;
    constexpr int I_IN = 32 * (NINP / 32), I_OUT = 32 * 64, I_Q = 32 * 16, I_KV = 32 * 32, I_O = 8 * 64;
    constexpr int NITEMS = I_IN + I_OUT + I_Q + I_KV + I_O;
    for (int it = gw; it < NITEMS; it += NGW) {
        int r = it;
        if (r < I_IN) { const int nblk = NINP / 32, kb = r / nblk, nb = r % nblk; tr_item(F.in[3], DM, NIN, win_src_col(nb * 32), F.in[2], WSP(bf16, WS_WIN), nb * 32, kb * 64, scr, F.lane); continue; } r -= I_IN;
        if (r < I_OUT) { const int kb = r / 64, nb = r % 64; tr_item(F.in[12], DM, DM, nb * 32, nullptr, WSP(bf16, WS_WOUT), nb * 32, kb * 64, scr, F.lane); continue; } r -= I_OUT;
        if (r < I_Q) { const int kb = r / 16, nb = r % 16; tr_item(F.in[15], DM, 512, nb * 32, F.in[13], WSP(bf16, WS_WQ), nb * 32, kb * 64, scr, F.lane); continue; } r -= I_Q;
        if (r < I_KV) { const int kb = r / 32, nb = r % 32; tr_item(F.in[16], DM, 1024, nb * 32, F.in[14], WSP(bf16, WS_WKV), nb * 32, kb * 64, scr, F.lane); continue; } r -= I_KV;
        { const int kb = r / 64, nb = r % 64; tr_item(F.in[17], 512, DM, nb * 32, nullptr, WSP(bf16, WS_WO), nb * 32, kb * 64, scr, F.lane); }
    }
    for (int m = gw; m < SEQ; m += NGW) row_to_bf16_rstd(F.in[0] + (size_t)m * DM, WSP(bf16, WS_XB) + (size_t)m * DM, WSP(float, WS_RSTD1) + m, F.lane);
    for (int m = gw; m < MEMT; m += NGW) row_to_bf16_rstd(F.in[1] + (size_t)m * DM, WSP(bf16, WS_MEMB) + (size_t)m * DM, WSP(float, WS_RSTDM) + m, F.lane);
}
__device__ __forceinline__ void p4_transposes(Frame& F) {
    LAS float* scr = (LAS float*)(F.lds + RING_OFF + F.wave * 16384);
    const int gw = F.vcu * NWAVES + F.wave, NGW = F.G * NWAVES;
    constexpr int I_GU = 32 * (2 * DFF / 32), I_D = (DFF / 64) * 64;
    for (int it = gw; it < I_GU + I_D; it += NGW) {
        int r = it;
        if (r < I_GU) { const int nblk = 2 * DFF / 32, kb = r / nblk, nb = r % nblk; const int row = nb * 32, t = row / 256, w = row % 256;
            const float* src = (w < 128) ? F.in[19] : F.in[20]; const int sc = 128 * t + (w & 127);
            tr_item(src, DM, DFF, sc, F.in[18], WSP(bf16, WS_WGU), row, kb * 64, scr, F.lane); continue; } r -= I_GU;
        { const int kb = r / 64, nb = r % 64; tr_item(F.in[21], DFF, DM, nb * 32, nullptr, WSP(bf16, WS_WD), nb * 32, kb * 64, scr, F.lane); }
    }
}

__device__ __forceinline__ float softplusf(float x) { return x > 20.f ? x : log1pf(__expf(x)); }
__device__ __forceinline__ void dn_combine(Frame& F) {
    const int gw = F.vcu * NWAVES + F.wave, NGW = F.G * NWAVES, lane = F.lane;
    const bf16* OFp = WSP(bf16, WS_OF); const bf16* OBp = WSP(bf16, WS_OB); const bf16* Z = DOP(bf16, DO_Z); bf16* Y = WSP(bf16, WS_XB); const float* gn = F.in[9];
    for (int t = gw; t < SEQ; t += NGW) {
        const size_t off = (size_t)t * 1024 + 16 * lane;
        const v4u a0 = *(const v4u*)(OFp + off), a1 = *(const v4u*)(OFp + off + 8), b0 = *(const v4u*)(OBp + off), b1 = *(const v4u*)(OBp + off + 8);
        const v4u z0 = *(const v4u*)(Z + off), z1 = *(const v4u*)(Z + off + 8);
        float o[16], zz[16];
#pragma unroll
        for (int i = 0; i < 4; ++i) { o[2 * i] = bflo(a0[i]) + bflo(b0[i]); o[2 * i + 1] = bfhi(a0[i]) + bfhi(b0[i]); o[8 + 2 * i] = bflo(a1[i]) + bflo(b1[i]); o[8 + 2 * i + 1] = bfhi(a1[i]) + bfhi(b1[i]);
            zz[2 * i] = bflo(z0[i]); zz[2 * i + 1] = bfhi(z0[i]); zz[8 + 2 * i] = bflo(z1[i]); zz[8 + 2 * i + 1] = bfhi(z1[i]); }
        float ss = 0.f;
#pragma unroll
        for (int i = 0; i < 16; ++i) ss += o[i] * o[i];
        ss += __shfl_xor(ss, 1); ss += __shfl_xor(ss, 2); ss += __shfl_xor(ss, 4);
        const float rs = 1.0f / sqrtf(ss * (1.0f / 128.0f) + RMS_EPS); const int cb = (16 * lane) & 127;
        float y[16];
#pragma unroll
        for (int i = 0; i < 16; ++i) y[i] = o[i] * rs * gn[cb + i] * siluf(zz[i]);
        v4u w0, w1;
#pragma unroll
        for (int i = 0; i < 4; ++i) { w0[i] = pk2(y[2 * i], y[2 * i + 1]); w1[i] = pk2(y[8 + 2 * i], y[8 + 2 * i + 1]); }
        bf16* yp = Y + (size_t)t * DM + 16 * lane; *(v4u*)yp = w0; *(v4u*)(yp + 8) = w1;
    }
}
__device__ __forceinline__ void final_norm(Frame& F) {
    const int gw = F.vcu * NWAVES + F.wave, NGW = F.G * NWAVES, lane = F.lane;
    const float* ss = (const float*)(F.ws + WS_CTL + CTL_SUMSQ4); const GAS f32x4* g = (const GAS f32x4*)F.in[22] + lane;
    for (int m = gw; m < SEQ; m += NGW) {
        const float r = 1.0f / sqrtf(ss[m] * (1.0f / DM) + RMS_EPS);
        GAS f32x4* o = (GAS f32x4*)(F.out + (size_t)m * DM) + lane;
#pragma unroll
        for (int j = 0; j < 8; ++j) { f32x4 v = o[64 * j]; v = v * r * g[64 * j]; o[64 * j] = v; }
    }
}

__device__ __forceinline__ int t5_bucket(int rel) {
    const int n = rel < 0 ? -rel : rel; int b;
    if (n < 8) b = n; else { int k = (31 - __builtin_clz((unsigned)(n * n))) - 6; b = 8 + k; if (b > 15) b = 15; }
    return (rel > 0 ? 16 : 0) + b;
}
template <int MODE  >
__device__ __forceinline__ void attn_unit(Frame& F, const bf16* Q, int qpitch, const bf16* Kp, const bf16* Vp, int kvpitch, bf16* O, int opitch, int q0, int kt_beg, int kt_end, const LAS float* btab, float sink2) {
    LAS unsigned char* Ks = F.lds + RING_OFF; LAS unsigned char* Vs = Ks + 16384;
    const int lane = F.lane, c = lane & 15, g = lane >> 4, qw0 = q0 + 16 * F.wave, tid = F.tid;
    bf16x8 qf[4];
#pragma unroll
    for (int t = 0; t < 4; ++t) qf[t] = *(const bf16x8*)(Q + (size_t)(qw0 + c) * qpitch + 32 * t + 8 * g);
    f32x4 oacc[8];
#pragma unroll
    for (int i = 0; i < 8; ++i) oacc[i] = (f32x4){0.f, 0.f, 0.f, 0.f};
    float mrun = (MODE == 0) ? sink2 : -1e30f, lsum = (MODE == 0 && g == 0) ? 1.0f : 0.0f;
    for (int kt = kt_beg; kt < kt_end; ++kt) {
        __syncthreads();
#pragma unroll
        for (int i = 0; i < 2; ++i) { const int ci = tid + 512 * i, key = ci >> 4, ch = ci & 15;
            const v4u kv = *(const v4u*)(Kp + (size_t)(64 * kt + key) * kvpitch + ch * 8), vv = *(const v4u*)(Vp + (size_t)(64 * kt + key) * kvpitch + ch * 8);
            *(LAS v4u*)(Ks + key * 256 + ((ch ^ (key & 15)) << 4)) = kv; *(LAS v4u*)(Vs + key * 256 + ((ch ^ ((key & 7) << 1)) << 4)) = vv; }
        __syncthreads();
        bool rel_ok = true;
        if (MODE == 0) rel_ok = (64 * kt <= qw0 + 15 + 128) && (64 * kt + 63 >= qw0 - 128);
        if (!rel_ok) continue;
        f32x4 s[4];
#pragma unroll
        for (int mt = 0; mt < 4; ++mt) s[mt] = (f32x4){0.f, 0.f, 0.f, 0.f};
#pragma unroll
        for (int t = 0; t < 4; ++t)
#pragma unroll
            for (int mt = 0; mt < 4; ++mt) { const bf16x8 kf = *(const LAS bf16x8*)(Ks + (16 * mt + c) * 256 + (((4 * t + g) ^ c) << 4));
                s[mt] = __builtin_amdgcn_mfma_f32_16x16x32_bf16(kf, qf[t], s[mt], 0, 0, 0); }
        float tmax = -INFINITY;
#pragma unroll
        for (int mt = 0; mt < 4; ++mt)
#pragma unroll
            for (int r = 0; r < 4; ++r) {
                if (MODE == 0) { const int rel = (64 * kt + 16 * mt + 4 * g + r) - (qw0 + c); const bool ok = (rel >= -128) && (rel <= 128);
                    const int ri = ok ? rel + 128 : 128; const float bv = btab[ri]; s[mt][r] = ok ? s[mt][r] + bv : -INFINITY; }
                tmax = fmaxf(tmax, s[mt][r]); }
        tmax = fmaxf(tmax, __shfl_xor(tmax, 16)); tmax = fmaxf(tmax, __shfl_xor(tmax, 32));
        const float mnew = fmaxf(mrun, tmax), alpha = __builtin_amdgcn_exp2f(mrun - mnew); mrun = mnew; float ps = 0.f;
#pragma unroll
        for (int mt = 0; mt < 4; ++mt)
#pragma unroll
            for (int r = 0; r < 4; ++r) { const float p = __builtin_amdgcn_exp2f(s[mt][r] - mnew); s[mt][r] = p; ps += p; }
        lsum = lsum * alpha + ps;
#pragma unroll
        for (int i = 0; i < 8; ++i) oacc[i] = oacc[i] * alpha;
        bf16x8 pf[2];
#pragma unroll
        for (int t2 = 0; t2 < 2; ++t2) { v4u w; w.x = cvtpk(s[2 * t2][0], s[2 * t2][1]); w.y = cvtpk(s[2 * t2][2], s[2 * t2][3]); w.z = cvtpk(s[2 * t2 + 1][0], s[2 * t2 + 1][1]); w.w = cvtpk(s[2 * t2 + 1][2], s[2 * t2 + 1][3]);
            pf[t2] = __builtin_bit_cast(bf16x8, w); }
        const int q4 = c >> 2, p4 = c & 3;
#pragma unroll
        for (int t2 = 0; t2 < 2; ++t2)
#pragma unroll
            for (int mo = 0; mo < 8; ++mo) {
                const int k1 = 32 * t2 + 4 * g + q4, k2 = k1 + 16, chn = 2 * mo + (p4 >> 1);
                const s16x4 lo = __builtin_bit_cast(s16x4, __builtin_amdgcn_ds_read_tr16_b64_v4i16((LAS s16x4*)(Vs + k1 * 256 + ((chn ^ ((k1 & 7) << 1)) << 4) + (p4 & 1) * 8)));
                const s16x4 hi = __builtin_bit_cast(s16x4, __builtin_amdgcn_ds_read_tr16_b64_v4i16((LAS s16x4*)(Vs + k2 * 256 + ((chn ^ ((k2 & 7) << 1)) << 4) + (p4 & 1) * 8)));
                const bf16x8 vf = (bf16x8){lo[0], lo[1], lo[2], lo[3], hi[0], hi[1], hi[2], hi[3]};
                oacc[mo] = __builtin_amdgcn_mfma_f32_16x16x32_bf16(vf, pf[t2], oacc[mo], 0, 0, 0); }
    }
    lsum += __shfl_xor(lsum, 16); lsum += __shfl_xor(lsum, 32);
    const float inv = 1.0f / lsum;
#pragma unroll
    for (int mo = 0; mo < 8; ++mo) { v2u w; w.x = cvtpk(oacc[mo][0] * inv, oacc[mo][1] * inv); w.y = cvtpk(oacc[mo][2] * inv, oacc[mo][3] * inv);
        *(v2u*)(O + (size_t)(qw0 + c) * opitch + 16 * mo + 4 * g) = w; }
}
__device__ __forceinline__ void swa_phase(Frame& F) {
    LAS float* btab = (LAS float*)(F.lds + RING_OFF + 32768);
    const bf16* QS = DOP(bf16, DO_QSW); const bf16* KV = DOP(bf16, DO_KVSW); bf16* Y = WSP(bf16, WS_XB);
    for (int u = blockIdx.x; u < SWH * (SEQ / 128); u += F.G) {
        const int h = u & 7, qb = u >> 3, kvh = h >> 2;
        __syncthreads();
        if (F.tid < 257) btab[F.tid] = F.in[11][t5_bucket(F.tid - 128) * 8 + h] * LOG2E;
        __syncthreads();
        int kb = 2 * qb - 2, ke = 2 * qb + 4; if (kb < 0) kb = 0; if (ke > SEQ / 64) ke = SEQ / 64;
        attn_unit<0>(F, QS + h * 128, 1024, KV + kvh * 128, KV + 256 + kvh * 128, 512, Y + 1024 + h * 128, DM, qb * 128, kb, ke, btab, F.in[10][h] * LOG2E);
    }
}
__device__ __forceinline__ void mem_attn_phase(Frame& F) {
    const bf16* QM = WSP(bf16, WS_QM); const bf16* KVm = WSP(bf16, WS_KVM); bf16* OM = WSP(bf16, WS_OM);
    for (int u = blockIdx.x; u < MEMH * (SEQ / 128); u += F.G) {
        const int h = u & 3, qb = u >> 2;
        attn_unit<1>(F, QM + h * 128, 512, KVm + h * 128, KVm + 512 + h * 128, 1024, OM + h * 128, 512, qb * 128, 0, 4, nullptr, 0.f);
    }
}

typedef float f32x16 __attribute__((ext_vector_type(16)));
constexpr int DX_W = 0, DX_K = 16384, DX_U = 32768, DX_Q = 49152, DX_A = 65536, DX_BYTES = 73728;
constexpr size_t WS_GL = 1 * MiB + 128 * 1024;
constexpr int L_RAW = 0, RAW_PITCH = 784, L_MTF = 0, L_MTB = 16384, L_TB = 32768, TB_PITCH = 144, TB_SZ = 9216;
constexpr int L_QB = 69632, L_KB = 86016, L_KT = 102400, L_VT = 120832, L_PART = 139264, L_SC = 143360;
static_assert(L_SC + 2048 <= LDSCTL_OFF, "prep LDS map");
__device__ __forceinline__ unsigned char* dnx_rec(Frame& F, int dir, int hd, int cn) { return F.ws + WS_DNX + (size_t)((dir * 8 + hd) * 256 + cn) * DX_BYTES; }
__device__ __forceinline__ v4u pack8f(const float* v) { v4u w; w.x = cvtpk(v[0], v[1]); w.y = cvtpk(v[2], v[3]); w.z = cvtpk(v[4], v[5]); w.w = cvtpk(v[6], v[7]); return w; }

__device__ __forceinline__ bf16x8 cvt8(const f32x16& v, int o) { v4u w; w.x = cvtpk(v[o], v[o + 1]); w.y = cvtpk(v[o + 2], v[o + 3]); w.z = cvtpk(v[o + 4], v[o + 5]); w.w = cvtpk(v[o + 6], v[o + 7]); return __builtin_bit_cast(bf16x8, w); }
__device__ __forceinline__ bf16x8 cvt8f(f32x4 a, f32x4 b) { v4u w; w.x = cvtpk(a[0], a[1]); w.y = cvtpk(a[2], a[3]); w.z = cvtpk(b[0], b[1]); w.w = cvtpk(b[2], b[3]); return __builtin_bit_cast(bf16x8, w); }
template <int dir> __device__ __forceinline__ void dn_solve_and_write(LAS unsigned char* lds, int lane) {
    const LAS float* MT = (const LAS float*)(lds + (dir ? L_MTB : L_MTF));
    LAS float* T0 = (LAS float*)(lds + L_TB + dir * 2 * TB_SZ);
    LAS float* Trow = T0 + lane * 68;
    const int blk = lane >> 5, cb = 32 * blk;
#pragma unroll 1
    for (int jr = 7; jr >= 0; --jr) {
        const int j0 = cb + 4 * jr;
        float a0 = (lane == j0) ? 1.f : 0.f, a1 = (lane == j0 + 1) ? 1.f : 0.f, a2 = (lane == j0 + 2) ? 1.f : 0.f, a3 = (lane == j0 + 3) ? 1.f : 0.f;
        const LAS float* mr = MT + j0 * 64;
#pragma unroll 1
        for (int sr = jr + 1; sr < 8; ++sr) {
            const int s0 = cb + 4 * sr;
            const f32x4 tv = *(const LAS f32x4*)(Trow + s0);
            const f32x4 m0 = *(const LAS f32x4*)(mr + s0), m1 = *(const LAS f32x4*)(mr + 64 + s0), m2 = *(const LAS f32x4*)(mr + 128 + s0), m3 = *(const LAS f32x4*)(mr + 192 + s0);
            a0 -= (tv[0] * m0[0] + tv[1] * m0[1]) + (tv[2] * m0[2] + tv[3] * m0[3]);
            a1 -= (tv[0] * m1[0] + tv[1] * m1[1]) + (tv[2] * m1[2] + tv[3] * m1[3]);
            a2 -= (tv[0] * m2[0] + tv[1] * m2[1]) + (tv[2] * m2[2] + tv[3] * m2[3]);
            a3 -= (tv[0] * m3[0] + tv[1] * m3[1]) + (tv[2] * m3[2] + tv[3] * m3[3]);
        }
        const f32x4 d0 = *(const LAS f32x4*)(mr + j0), d1 = *(const LAS f32x4*)(mr + 64 + j0), d2 = *(const LAS f32x4*)(mr + 128 + j0);
        const float t3 = a3, t2 = a2 - t3 * d2[3], t1 = a1 - t2 * d1[2] - t3 * d1[3], t0 = a0 - t1 * d0[1] - t2 * d0[2] - t3 * d0[3];
        *(LAS f32x4*)(Trow + j0) = (f32x4){t0, t1, t2, t3};
    }
    if (blk == 0) {
#pragma unroll
        for (int q = 8; q < 16; ++q) *(LAS f32x4*)(Trow + 4 * q) = (f32x4){0.f, 0.f, 0.f, 0.f}; }
    asm volatile("s_waitcnt lgkmcnt(0)" ::: "memory");
    {
        const int r = lane & 31, lh = lane >> 5;
        f32x16 Y;
#pragma unroll
        for (int e = 0; e < 16; ++e) Y[e] = 0.f;
#pragma unroll
        for (int kk = 0; kk < 2; ++kk) {
            float av[8], bv[8];
#pragma unroll
            for (int jj = 0; jj < 8; ++jj) { const int k = 16 * kk + 8 * lh + jj; av[jj] = MT[k * 64 + 32 + r]; bv[jj] = T0[k * 68 + r]; }
            Y = __builtin_amdgcn_mfma_f32_32x32x16_bf16(cvt8f((f32x4){av[0], av[1], av[2], av[3]}, (f32x4){av[4], av[5], av[6], av[7]}), cvt8f((f32x4){bv[0], bv[1], bv[2], bv[3]}, (f32x4){bv[4], bv[5], bv[6], bv[7]}), Y, 0, 0, 0);
        }
        f32x16 Z;
#pragma unroll
        for (int e = 0; e < 16; ++e) Z[e] = 0.f;
#pragma unroll
        for (int kk = 0; kk < 2; ++kk) {
            const f32x4 t0 = *(const LAS f32x4*)(T0 + (32 + r) * 68 + 32 + 16 * kk + 4 * lh), t1 = *(const LAS f32x4*)(T0 + (32 + r) * 68 + 32 + 16 * kk + 8 + 4 * lh);
            Z = __builtin_amdgcn_mfma_f32_32x32x16_bf16(cvt8f(t0, t1), cvt8(Y, 8 * kk), Z, 0, 0, 0);
        }
#pragma unroll
        for (int e = 0; e < 16; ++e) T0[(32 + (e & 3) + 8 * (e >> 2) + 4 * lh) * 68 + r] = -Z[e];
    }
    asm volatile("s_waitcnt lgkmcnt(0)" ::: "memory");
    f32x4 tr[16];
#pragma unroll
    for (int q = 0; q < 16; ++q) tr[q] = *(const LAS f32x4*)(Trow + 4 * q);
    asm volatile("s_waitcnt lgkmcnt(0)" ::: "memory");
    const LAS float* sc = (const LAS float*)(lds + L_SC);
    const LAS float* cU = sc + (dir ? 384 : 256); const LAS float* cW = sc + (dir ? 448 : 320);
    const int pos = dir ? 63 - lane : lane;
    LAS unsigned char* tu = lds + L_TB + dir * 2 * TB_SZ + pos * TB_PITCH; LAS unsigned char* tw = tu + TB_SZ;
#pragma unroll
    for (int q = 0; q < 8; ++q) {
        float u8[8], w8[8];
#pragma unroll
        for (int e = 0; e < 8; ++e) { const int s = 8 * q + e, sp = dir ? 63 - s : s; const float t = tr[sp >> 2][sp & 3]; u8[e] = t * cU[s]; w8[e] = t * cW[s]; }
        *(LAS v4u*)(tu + q * 16) = pack8f(u8); *(LAS v4u*)(tw + q * 16) = pack8f(w8);
    }
}

struct PrepRegs { v4u raw[7]; };
__device__ __forceinline__ void prep_load(Frame& F, int u, int tid, int lane, PrepRegs& R) {
    const int cn = u >> 3, hd = u & 7; const bf16* QKV = WSP(bf16, WS_QKV);
#pragma unroll
    for (int k = 0; k < 7; ++k) { const int ci = tid + 512 * k; const int row = ci / 48, cc = ci % 48, seg = cc >> 4, ch = (cc & 15) * 8, tok = 64 * cn - 2 + row;
        v4u v = (v4u){0u, 0u, 0u, 0u};
        if (ci < 68 * 48 && tok >= 0 && tok < SEQ) v = *(const v4u*)(QKV + (size_t)tok * 3072 + seg * 1024 + hd * 128 + ch);
        R.raw[k] = v; }
}
__device__ __forceinline__ void dn_prep_unit(Frame& F, int cn, int hd, PrepRegs& PR, int next_u) {
    LAS unsigned char* lds = F.lds; int tid = F.tid, lane = F.lane; const int wave = F.wave;
    asm volatile("" : "+v"(tid), "+v"(lane));
    LAS float* sc = (LAS float*)(lds + L_SC);
    __syncthreads();
    prep_load(F, cn * 8 + hd, tid, lane, PR);
#pragma unroll
    for (int k = 0; k < 7; ++k) { const int ci = tid + 512 * k; const int row = ci / 48, cc = ci % 48, seg = cc >> 4, ch = (cc & 15) * 8;
        if (ci < 68 * 48) *(LAS v4u*)(lds + L_RAW + row * RAW_PITCH + (seg * 128 + ch) * 2) = PR.raw[k]; }
    if (wave == 0) {
        const float* ab = WSP(float, WS_AB) + (size_t)(64 * cn + lane) * 32;
        const float bfv = 1.0f / (1.0f + __expf(-ab[hd])), bbv = 1.0f / (1.0f + __expf(-ab[8 + hd]));
        const float gf = -__expf(F.in[5][hd]) * softplusf(ab[16 + hd] + F.in[7][hd]), gb = -__expf(F.in[6][hd]) * softplusf(ab[24 + hd] + F.in[8][hd]);
        float Gf = gf, Gb = gb;
#pragma unroll
        for (int o = 1; o < 64; o <<= 1) { const float a = __shfl_up(Gf, o), b = __shfl_down(Gb, o); if (lane >= o) Gf += a; if (lane + o < 64) Gb += b; }
        sc[lane] = Gf; sc[64 + lane] = Gb; sc[128 + lane] = bfv; sc[192 + lane] = bbv;
        sc[256 + lane] = bfv; sc[320 + lane] = -bfv * __expf(Gf); sc[384 + lane] = bbv; sc[448 + lane] = -bbv * __expf(Gb);
        float* GL = WSP(float, WS_GL);
        if (lane == 63) GL[(0 * 8 + hd) * 256 + cn] = __expf(Gf);
        if (lane == 0) GL[(1 * 8 + hd) * 256 + cn] = __expf(Gb);
    }
    __syncthreads();
    asm volatile("" : "+v"(tid), "+v"(lane));
    {
        const int t = wave, pos = lane; const float* cw = F.in[4] + hd * 128 + 16 * t;
        float qv[16], kv[16], vv[16];
#pragma unroll
        for (int seg = 0; seg < 3; ++seg) {
            float a[16];
#pragma unroll
            for (int i = 0; i < 16; ++i) a[i] = 0.f;
#pragma unroll
            for (int j = 0; j < 5; ++j) {
                const LAS unsigned char* rp = lds + L_RAW + (pos + j) * RAW_PITCH + (seg * 128 + 16 * t) * 2;
                const v4u r0 = *(const LAS v4u*)rp, r1 = *(const LAS v4u*)(rp + 16);
                const float* w = cw + j * 3072 + seg * 1024;
#pragma unroll
                for (int i = 0; i < 4; ++i) { a[2 * i] += w[2 * i] * bflo(r0[i]); a[2 * i + 1] += w[2 * i + 1] * bfhi(r0[i]); a[8 + 2 * i] += w[8 + 2 * i] * bflo(r1[i]); a[8 + 2 * i + 1] += w[8 + 2 * i + 1] * bfhi(r1[i]); }
            }
#pragma unroll
            for (int i = 0; i < 16; ++i) { const float s = siluf(a[i]); if (seg == 0) qv[i] = s; else if (seg == 1) kv[i] = s; else vv[i] = s; }
        }
        float sq = 0.f, sk = 0.f;
#pragma unroll
        for (int i = 0; i < 16; ++i) { sq += qv[i] * qv[i]; sk += kv[i] * kv[i]; }
        LAS float* part = (LAS float*)(lds + L_PART);
        part[t * 64 + pos] = sq; part[512 + t * 64 + pos] = sk;
        __syncthreads();
        float tq = 0.f, tk = 0.f;
#pragma unroll
        for (int i = 0; i < 8; ++i) { tq += part[i * 64 + pos]; tk += part[512 + i * 64 + pos]; }
        const float rq = (1.0f / sqrtf(tq + 1e-6f)) * 0.08838834764831845f, rk = 1.0f / sqrtf(tk + 1e-6f);
#pragma unroll
        for (int i = 0; i < 16; ++i) { qv[i] *= rq; kv[i] *= rk; }
        *(LAS v4u*)(lds + L_QB + pos * 256 + (((2 * t) ^ (pos & 15)) << 4)) = pack8f(qv); *(LAS v4u*)(lds + L_QB + pos * 256 + (((2 * t + 1) ^ (pos & 15)) << 4)) = pack8f(qv + 8);
        *(LAS v4u*)(lds + L_KB + pos * 256 + (((2 * t) ^ (pos & 15)) << 4)) = pack8f(kv); *(LAS v4u*)(lds + L_KB + pos * 256 + (((2 * t + 1) ^ (pos & 15)) << 4)) = pack8f(kv + 8);
#pragma unroll
        for (int i = 0; i < 16; ++i) { *(LAS unsigned short*)(lds + L_KT + (16 * t + i) * TB_PITCH + pos * 2) = (unsigned short)f2bf(kv[i]); *(LAS unsigned short*)(lds + L_VT + (16 * t + i) * TB_PITCH + pos * 2) = (unsigned short)f2bf(vv[i]); }
        const float ef = __expf(sc[pos]), eb = __expf(sc[64 + pos]); const int mt = pos >> 5;
#pragma unroll
        for (int dir = 0; dir < 2; ++dir) { const float e = dir ? eb : ef; unsigned char* rec = dnx_rec(F, dir, hd, cn) + DX_Q;
#pragma unroll
            for (int lh = 0; lh < 2; ++lh) { float o8[8];
#pragma unroll
                for (int j = 0; j < 8; ++j) o8[j] = qv[8 * (j >> 2) + 4 * lh + (j & 3)] * e;
                *(v4u*)(rec + ((mt * 8 + t) * 64 + 32 * lh + (pos & 31)) * 16) = pack8f(o8); } }
    }
    __syncthreads();
    asm volatile("" : "+v"(tid), "+v"(lane));
    {
        const int r = lane & 31, lh = lane >> 5, x = wave & 3, ta = x >> 1, tb = x & 1;
        const LAS unsigned char* Ab = lds + L_KB + (32 * ta + r) * 256; const LAS unsigned char* Bb = lds + (wave < 4 ? L_KB : L_QB) + (32 * tb + r) * 256;
        f32x16 acc;
#pragma unroll
        for (int i = 0; i < 16; ++i) acc[i] = 0.f;
#pragma unroll
        for (int kk = 0; kk < 8; ++kk) { const int ch = ((2 * kk + lh) ^ (r & 15)) << 4;
            acc = __builtin_amdgcn_mfma_f32_32x32x16_bf16(*(const LAS bf16x8*)(Ab + ch), *(const LAS bf16x8*)(Bb + ch), acc, 0, 0, 0); }
        const int b = 32 * tb + r;
        if (wave < 4) {
            const float Gfb = sc[b], Gbb = sc[64 + b];
#pragma unroll
            for (int q = 0; q < 4; ++q) { const int a0 = 32 * ta + 8 * q + 4 * lh; f32x4 mf, mb;
#pragma unroll
                for (int e = 0; e < 4; ++e) { const int a = a0 + e; const float kkv = acc[4 * q + e];
                    const float vf = sc[128 + a] * kkv * __expf(fminf(sc[a] - Gfb, 0.f)), vb = sc[192 + a] * kkv * __expf(fminf(sc[64 + a] - Gbb, 0.f));
                    mf[e] = (a > b) ? vf : 0.f; mb[3 - e] = (a < b) ? vb : 0.f; }
                *(LAS f32x4*)(lds + L_MTF + (b * 64 + a0) * 4) = mf; *(LAS f32x4*)(lds + L_MTB + ((63 - b) * 64 + 60 - a0) * 4) = mb; }
        } else {
            const float Gfc = sc[b], Gbc = sc[64 + b];
#pragma unroll
            for (int dir = 0; dir < 2; ++dir) { unsigned char* rec = dnx_rec(F, dir, hd, cn) + DX_A;
#pragma unroll
                for (int s2 = 0; s2 < 2; ++s2) { float o8[8];
#pragma unroll
                    for (int j = 0; j < 8; ++j) { const int s = 32 * ta + 16 * s2 + 8 * (j >> 2) + 4 * lh + (j & 3); const float v = acc[8 * s2 + j];
                        const float ev = v * __expf(fminf(dir ? Gbc - sc[64 + s] : Gfc - sc[s], 0.f)); o8[j] = (dir ? (s >= b) : (s <= b)) ? ev : 0.f; }
                    *(v4u*)(rec + ((tb * 4 + 2 * ta + s2) * 64 + lane) * 16) = pack8f(o8); } }
        }
    }
    __syncthreads();
    asm volatile("" : "+v"(tid), "+v"(lane));
    if (wave == 0) dn_solve_and_write<0>(lds, lane);
    else if (wave == 1) dn_solve_and_write<1>(lds, lane);
    else {
        const int r = lane & 31, lh = lane >> 5;
        for (int f = wave - 2; f < 32; f += 6) { const int dir = f >> 4, m = (f >> 2) & 3, t = f & 3; const int dk = 32 * m + r;
            const v2u k0 = *(const LAS v2u*)(lds + L_KT + dk * TB_PITCH + (16 * t + 4 * lh) * 2), k1 = *(const LAS v2u*)(lds + L_KT + dk * TB_PITCH + (16 * t + 8 + 4 * lh) * 2);
            const float Gl = dir ? sc[64] : sc[63]; const LAS float* Gs = sc + (dir ? 64 : 0) + 16 * t + 4 * lh; float o8[8];
            o8[0] = bflo(k0.x) * __expf(Gl - Gs[0]); o8[1] = bfhi(k0.x) * __expf(Gl - Gs[1]); o8[2] = bflo(k0.y) * __expf(Gl - Gs[2]); o8[3] = bfhi(k0.y) * __expf(Gl - Gs[3]);
            o8[4] = bflo(k1.x) * __expf(Gl - Gs[8]); o8[5] = bfhi(k1.x) * __expf(Gl - Gs[9]); o8[6] = bflo(k1.y) * __expf(Gl - Gs[10]); o8[7] = bfhi(k1.y) * __expf(Gl - Gs[11]);
            *(v4u*)(dnx_rec(F, dir, hd, cn) + DX_K + ((m * 4 + t) * 64 + lane) * 16) = pack8f(o8); }
    }
    __syncthreads();
    asm volatile("" : "+v"(tid), "+v"(lane));
    {
        const int dir = wave >> 2, x = wave & 3, r = lane & 31, lh = lane >> 5;
        const LAS unsigned char* Tu = lds + L_TB + (dir ? 2 : 0) * TB_SZ; const LAS unsigned char* Tw = Tu + TB_SZ;
        unsigned char* rec = dnx_rec(F, dir, hd, cn);
#pragma unroll
        for (int mt = 0; mt < 2; ++mt) {
            f32x16 aw, au;
#pragma unroll
            for (int i = 0; i < 16; ++i) { aw[i] = 0.f; au[i] = 0.f; }
#pragma unroll
            for (int kk = 0; kk < 4; ++kk) { const int so = (16 * kk + 8 * lh) * 2;
                aw = __builtin_amdgcn_mfma_f32_32x32x16_bf16(*(const LAS bf16x8*)(lds + L_KT + (32 * x + r) * TB_PITCH + so), *(const LAS bf16x8*)(Tw + (32 * mt + r) * TB_PITCH + so), aw, 0, 0, 0);
                au = __builtin_amdgcn_mfma_f32_32x32x16_bf16(*(const LAS bf16x8*)(Tu + (32 * mt + r) * TB_PITCH + so), *(const LAS bf16x8*)(lds + L_VT + (32 * x + r) * TB_PITCH + so), au, 0, 0, 0); }
            float tmp[16];
#pragma unroll
            for (int i = 0; i < 16; ++i) tmp[i] = aw[i];
            *(v4u*)(rec + DX_W + ((mt * 8 + 2 * x) * 64 + lane) * 16) = pack8f(tmp); *(v4u*)(rec + DX_W + ((mt * 8 + 2 * x + 1) * 64 + lane) * 16) = pack8f(tmp + 8);
#pragma unroll
            for (int i = 0; i < 16; ++i) tmp[i] = au[i];
            *(v4u*)(rec + DX_U + ((x * 2 + mt) * 64 + lane) * 32) = pack8f(tmp); *(v4u*)(rec + DX_U + ((x * 2 + mt) * 64 + lane) * 32 + 16) = pack8f(tmp + 8);
        }
    }
}
__device__ __forceinline__ void dn_prep_phase(Frame& F) {
    PrepRegs PR; int u = blockIdx.x;
    for (; u < 256 * DNH; u += F.G) dn_prep_unit(F, u >> 3, u & 7, PR, u + F.G);
}


constexpr int NSEG = 16, SEGL = 16;
constexpr size_t WS_PF = 176 * MiB, WS_RG = 184 * MiB, WS_SIN = 24 * MiB;
constexpr int SLOT1 = 49152, SLOT3 = 73728, L_GLS = 147456;
#define DN_WAIT(V) asm volatile("s_waitcnt vmcnt(" #V ") lgkmcnt(0)" ::: "memory")
#define DN_BAR() do { __builtin_amdgcn_s_barrier(); asm volatile("" ::: "memory"); } while (0)
__device__ __forceinline__ int seg_chunk(int dir, int g, int i) { const int n = SEGL * g + i; return dir ? 255 - n : n; }
__device__ __forceinline__ void u_to_acc(f32x16& a, const LAS unsigned char* up) {
    const v4u u0 = *(const LAS v4u*)up, u1 = *(const LAS v4u*)(up + 16);
#pragma unroll
    for (int i = 0; i < 4; ++i) { a[2 * i] = bflo(u0[i]); a[2 * i + 1] = bfhi(u0[i]); a[8 + 2 * i] = bflo(u1[i]); a[8 + 2 * i + 1] = bfhi(u1[i]); }
}
template <bool OUT>
__device__ __forceinline__ void dn_step(f32x16 (&S)[4], f32x16 (&aV)[2], f32x16 (&aO)[2], const LAS unsigned char* buf, float gl) {
#pragma unroll
    for (int t = 0; t < 8; ++t) { const bf16x8 sb = cvt8(S[t >> 1], 8 * (t & 1));
#pragma unroll
        for (int mt = 0; mt < 2; ++mt) {
            aV[mt] = __builtin_amdgcn_mfma_f32_32x32x16_bf16(*(const LAS bf16x8*)(buf + DX_W + (mt * 8 + t) * 1024), sb, aV[mt], 0, 0, 0);
            if (OUT) aO[mt] = __builtin_amdgcn_mfma_f32_32x32x16_bf16(*(const LAS bf16x8*)(buf + DX_Q + (mt * 8 + t) * 1024), sb, aO[mt], 0, 0, 0); } }
    bf16x8 vb[4];
#pragma unroll
    for (int t = 0; t < 4; ++t) vb[t] = cvt8(aV[t >> 1], 8 * (t & 1));
#pragma unroll
    for (int m = 0; m < 4; ++m) S[m] = S[m] * gl;
#pragma unroll
    for (int t = 0; t < 4; ++t) {
#pragma unroll
        for (int m = 0; m < 4; ++m) S[m] = __builtin_amdgcn_mfma_f32_32x32x16_bf16(*(const LAS bf16x8*)(buf + DX_K + (m * 4 + t) * 1024), vb[t], S[m], 0, 0, 0);
        if (OUT) {
#pragma unroll
            for (int mt = 0; mt < 2; ++mt) aO[mt] = __builtin_amdgcn_mfma_f32_32x32x16_bf16(*(const LAS bf16x8*)(buf + DX_A + (mt * 4 + t) * 1024), vb[t], aO[mt], 0, 0, 0); } }
}

__device__ __forceinline__ void dn_pass1(Frame& F) {
    LAS unsigned char* lds = F.lds; const int lane = F.lane, wave = F.wave, r = lane & 31, lh = lane >> 5, part = wave >> 2, d = wave & 3;
    LAS float* gls = (LAS float*)(lds + L_GLS);
    for (int unit = blockIdx.x; unit < 16 * NSEG; unit += F.G) {
        const int dir = unit >> 7, hd = (unit >> 4) & 7, g = unit & 15;
        DN_WAIT(0); __syncthreads();
        if (F.tid < SEGL) gls[F.tid] = WSP(float, WS_GL)[(dir * 8 + hd) * 256 + seg_chunk(dir, g, F.tid)];
        DN_WAIT(0);
        f32x16 S[4];
#pragma unroll
        for (int m = 0; m < 4; ++m)
#pragma unroll
            for (int i = 0; i < 16; ++i) S[m][i] = (part && (32 * m + (i & 3) + 8 * (i >> 2) + 4 * lh == 32 * d + r)) ? 1.f : 0.f;
#define P1_ISSUE(i) do { const unsigned char* src_ = dnx_rec(F, dir, hd, seg_chunk(dir, g, (i))) + lane * 16; LAS unsigned char* dst_ = lds + ((i) % 3) * SLOT1; \
            _Pragma("unroll") for (int k_ = 0; k_ < 6; ++k_) { const int p_ = wave + 8 * k_; __builtin_amdgcn_global_load_lds((const unsigned*)(src_ + p_ * 1024), (LAS unsigned*)(dst_ + p_ * 1024), 16, 0, 0); } } while (0)
        P1_ISSUE(0); P1_ISSUE(1);
        for (int i = 0; i < SEGL; ++i) {
            if (i + 1 < SEGL) DN_WAIT(6); else DN_WAIT(0);
            DN_BAR();
            if (i + 2 < SEGL) P1_ISSUE(i + 2);
            const LAS unsigned char* buf = lds + (i % 3) * SLOT1 + lane * 16;
            f32x16 aV[2], aO[2];
#pragma unroll
            for (int mt = 0; mt < 2; ++mt) {
                if (part == 0) u_to_acc(aV[mt], lds + (i % 3) * SLOT1 + DX_U + ((d * 2 + mt) * 64 + lane) * 32);
                else {
#pragma unroll
                    for (int e = 0; e < 16; ++e) aV[mt][e] = 0.f; } }
            dn_step<false>(S, aV, aO, buf, gls[i]);
        }
#undef P1_ISSUE
        DN_WAIT(0); DN_BAR();
        if (part == 0) {
            float* rg = (float*)(F.ws + WS_RG) + (size_t)unit * 16384;
#pragma unroll
            for (int m = 0; m < 4; ++m)
#pragma unroll
                for (int q = 0; q < 4; ++q) *(f32x4*)(rg + ((d * 4 + m) * 64 + lane) * 16 + 4 * q) = (f32x4){S[m][4 * q], S[m][4 * q + 1], S[m][4 * q + 2], S[m][4 * q + 3]};
        } else {
#pragma unroll
            for (int m = 0; m < 4; ++m)
#pragma unroll
                for (int i = 0; i < 16; ++i) *(LAS unsigned short*)(lds + (32 * m + (i & 3) + 8 * (i >> 2) + 4 * lh) * 272 + (32 * d + r) * 2) = (unsigned short)f2bf(S[m][i]);
        }
        DN_WAIT(0); DN_BAR();
        if (part == 1) {
            unsigned char* pf = F.ws + WS_PF + (size_t)unit * 32768;
#pragma unroll
            for (int k = 0; k < 8; ++k) { const int f = d * 8 + k, m = f >> 3, t = f & 7;
                const v2u a = *(const LAS v2u*)(lds + (32 * m + r) * 272 + (16 * t + 4 * lh) * 2), b = *(const LAS v2u*)(lds + (32 * m + r) * 272 + (16 * t + 8 + 4 * lh) * 2);
                *(v4u*)(pf + (f * 64 + lane) * 16) = (v4u){a.x, a.y, b.x, b.y}; }
        }
    }
}
__device__ __forceinline__ void dn_fold(Frame& F) {
    const int b = blockIdx.x; if (b >= 16) return;
    LAS unsigned char* lds = F.lds; const int lane = F.lane, wave = F.wave, dir = b >> 3, hd = b & 7;
    const int unit0 = (dir * 8 + hd) * 16;
    __syncthreads();
    if (wave >= 4) {
        const int lw = wave - 4;
        for (int g = 0; g < NSEG; ++g) {
            if (g < NSEG - 1) { const unsigned char* src = F.ws + WS_PF + (size_t)(unit0 + g) * 32768 + lane * 16; LAS unsigned char* dst = lds + (g & 1) * 32768;
#pragma unroll
                for (int k = 0; k < 8; ++k) { const int p = lw + 4 * k; __builtin_amdgcn_global_load_lds((const unsigned*)(src + p * 1024), (LAS unsigned*)(dst + p * 1024), 16, 0, 0); } }
            DN_WAIT(0); DN_BAR();
        }
    } else {
        const int d = wave;
        f32x16 S[4], R[4];
#pragma unroll
        for (int m = 0; m < 4; ++m)
#pragma unroll
            for (int i = 0; i < 16; ++i) S[m][i] = 0.f;
        const float* rg0 = (const float*)(F.ws + WS_RG) + (size_t)unit0 * 16384; float* sin0 = (float*)(F.ws + WS_SIN) + (size_t)unit0 * 16384;
#pragma unroll
        for (int m = 0; m < 4; ++m)
#pragma unroll
            for (int q = 0; q < 4; ++q) { const f32x4 v = *(const f32x4*)(rg0 + ((d * 4 + m) * 64 + lane) * 16 + 4 * q); R[m][4 * q] = v[0]; R[m][4 * q + 1] = v[1]; R[m][4 * q + 2] = v[2]; R[m][4 * q + 3] = v[3]; }
        DN_BAR();
        for (int g = 0; g < NSEG; ++g) {
            float* so = sin0 + (size_t)g * 16384;
#pragma unroll
            for (int m = 0; m < 4; ++m)
#pragma unroll
                for (int q = 0; q < 4; ++q) *(f32x4*)(so + ((d * 4 + m) * 64 + lane) * 16 + 4 * q) = (f32x4){S[m][4 * q], S[m][4 * q + 1], S[m][4 * q + 2], S[m][4 * q + 3]};
            if (g == NSEG - 1) break;
            const LAS unsigned char* buf = lds + (g & 1) * 32768 + lane * 16;
            bf16x8 sb[8];
#pragma unroll
            for (int t = 0; t < 8; ++t) sb[t] = cvt8(S[t >> 1], 8 * (t & 1));
#pragma unroll
            for (int m = 0; m < 4; ++m) { S[m] = R[m];
#pragma unroll
                for (int t = 0; t < 8; ++t) S[m] = __builtin_amdgcn_mfma_f32_32x32x16_bf16(*(const LAS bf16x8*)(buf + (m * 8 + t) * 1024), sb[t], S[m], 0, 0, 0); }
            if (g + 1 < NSEG - 1) { const float* rg = rg0 + (size_t)(g + 1) * 16384;
#pragma unroll
                for (int m = 0; m < 4; ++m)
#pragma unroll
                    for (int q = 0; q < 4; ++q) { const f32x4 v = *(const f32x4*)(rg + ((d * 4 + m) * 64 + lane) * 16 + 4 * q); R[m][4 * q] = v[0]; R[m][4 * q + 1] = v[1]; R[m][4 * q + 2] = v[2]; R[m][4 * q + 3] = v[3]; } }
            asm volatile("s_waitcnt lgkmcnt(0)" ::: "memory");
            DN_BAR();
        }
    }
    __syncthreads();
}
__device__ __forceinline__ void dn_pass3(Frame& F) {
    LAS unsigned char* lds = F.lds; const int lane = F.lane, wave = F.wave, r = lane & 31, lh = lane >> 5;
    LAS float* gls = (LAS float*)(lds + L_GLS);
    for (int unit = blockIdx.x; unit < 16 * NSEG; unit += F.G) {
        const int dir = unit >> 7, hd = (unit >> 4) & 7, g = unit & 15;
        __syncthreads();
        if (F.tid < SEGL) gls[F.tid] = WSP(float, WS_GL)[(dir * 8 + hd) * 256 + seg_chunk(dir, g, F.tid)];
        asm volatile("s_waitcnt lgkmcnt(0)" ::: "memory");
        if (wave >= 4) {
            const int lw = wave - 4;
            for (int i = 0; i <= SEGL; ++i) {
                if (i < SEGL) { const unsigned char* src = dnx_rec(F, dir, hd, seg_chunk(dir, g, i)) + lane * 16; LAS unsigned char* dst = lds + (i & 1) * SLOT3;
#pragma unroll
                    for (int k = 0; k < 18; ++k) { const int p = lw + 4 * k; __builtin_amdgcn_global_load_lds((const unsigned*)(src + p * 1024), (LAS unsigned*)(dst + p * 1024), 16, 0, 0); } }
                DN_WAIT(0); DN_BAR();
            }
        } else {
            const int d = wave;
            f32x16 S[4];
            const float* si = (const float*)(F.ws + WS_SIN) + (size_t)unit * 16384;
#pragma unroll
            for (int m = 0; m < 4; ++m)
#pragma unroll
                for (int q = 0; q < 4; ++q) { const f32x4 v = *(const f32x4*)(si + ((d * 4 + m) * 64 + lane) * 16 + 4 * q); S[m][4 * q] = v[0]; S[m][4 * q + 1] = v[1]; S[m][4 * q + 2] = v[2]; S[m][4 * q + 3] = v[3]; }
            bf16* O = WSP(bf16, dir ? WS_OB : WS_OF);
            DN_BAR();
            for (int i = 0; i < SEGL; ++i) {
                const int cn = seg_chunk(dir, g, i); const LAS unsigned char* slot = lds + (i & 1) * SLOT3;
                f32x16 aV[2], aO[2];
#pragma unroll
                for (int mt = 0; mt < 2; ++mt) { u_to_acc(aV[mt], slot + DX_U + ((d * 2 + mt) * 64 + lane) * 32);
#pragma unroll
                    for (int e = 0; e < 16; ++e) aO[mt][e] = 0.f; }
                dn_step<true>(S, aV, aO, slot + lane * 16, gls[i]);
                bf16* op = O + (size_t)(64 * cn + 4 * lh) * 1024 + hd * 128 + 32 * d + r;
#pragma unroll
                for (int mt = 0; mt < 2; ++mt)
#pragma unroll
                    for (int e = 0; e < 16; ++e) op[(size_t)(32 * mt + (e & 3) + 8 * (e >> 2)) * 1024] = (bf16)f2bf(aO[mt][e]);
                asm volatile("s_waitcnt lgkmcnt(0)" ::: "memory");
                DN_BAR();
            }
        }
    }
    __syncthreads();
}

#ifndef MK_N_LAUNCHES
#define MK_N_LAUNCHES 1
#endif
constexpr int N_PHASES = 14;
struct Args { const float* in[23]; float* out; unsigned char* ws; int ph_lo, ph_hi; };
static_assert(sizeof(Args) == 23 * 8 + 8 + 8 + 8, "Args has no padding");

__global__ void __launch_bounds__(NWAVES * 64, 2) enc_fwd(Args args) {
    extern __shared__ __attribute__((aligned(16))) unsigned char lds[];
    Frame F;
    F.lds = (LAS unsigned char*)lds;
    F.MISC = (volatile LAS unsigned*)(F.lds + MISC_OFF);
    F.tid = threadIdx.x; F.lane = F.tid & 63; F.wave = __builtin_amdgcn_readfirstlane(F.tid >> 6);
    F.G = gridDim.x; { const int bx = blockIdx.x; F.vcu = (F.G % 8 == 0) ? (bx % 8) * (F.G / 8) + bx / 8 : bx; }
#pragma unroll
    for (int i = 0; i < 23; ++i) F.in[i] = args.in[i];
    F.out = args.out; F.ws = args.ws; F.ctl = (gu32*)(args.ws + WS_CTL);
    for (int u = F.tid; u < (LDS_BYTES - LDSCTL_OFF) / 4; u += NWAVES * 64) ((LAS unsigned*)(F.lds + LDSCTL_OFF))[u] = 0u;
    __syncthreads();
    const int lo = args.ph_lo, hi = args.ph_hi;
    XcdBarrier bar; bar.bar = (unsigned*)(F.ctl + CW_BAR); bar.x = 0; bar.st = nullptr;
    if (hi - lo > 1) bar = xcd_barrier_post((unsigned*)(F.ctl + CW_BAR), F.MISC + 8);
#define IN(k) (lo <= (k) && (k) < hi)
#define SEAM(k) do { if (IN(k) && IN((k) + 1)) xcd_barrier(bar); } while (0)
    float* sumsq2 = (float*)(F.ws + WS_CTL + CTL_SUMSQ2); float* sumsq3 = (float*)(F.ws + WS_CTL + CTL_SUMSQ3); float* sumsq4 = (float*)(F.ws + WS_CTL + CTL_SUMSQ4);

    if (IN(0)) { p0_prologue(F); } SEAM(0);
    if (IN(1)) {
        { pg8::Gemm g{WSP(bf16, WS_XB), WSP(bf16, WS_WIN), SEQ, NINP, DM}; pg8::StaticOrder S; S.init(SEQ, NINP, F.G, (int)blockIdx.x);
          EpiProj E{WSP(float, WS_RSTD1), WSP(bf16, WS_QKV), DOP(bf16, DO_Z), DOP(bf16, DO_QSW), DOP(bf16, DO_KVSW), WSP(float, WS_AB)};
          pg8::gemm_phase<EpiProj, pg8::StaticOrder, true, true>(F.lds + RING_OFF, g, S, E); }
        { pg8::Gemm g{WSP(bf16, WS_MEMB), WSP(bf16, WS_WKV), MEMT, 1024, DM}; pg8::StaticOrder S; S.init(MEMT, 1024, F.G, (int)blockIdx.x);
          EpiScaleBf16 E{WSP(float, WS_RSTDM), 0, 1.0f, WSP(bf16, WS_KVM), 1024};
          pg8::gemm_phase<EpiScaleBf16, pg8::StaticOrder, true, true>(F.lds + RING_OFF, g, S, E); }
    } SEAM(1);
    if (IN(2)) { dn_prep_phase(F);
#ifdef REPEAT_PREP
        dn_prep_phase(F);
#endif
        swa_phase(F);
#ifdef REPEAT_SWA
        swa_phase(F);
#endif
    } SEAM(2);
    if (IN(3)) { dn_pass1(F); } SEAM(3);
    if (IN(12)) { dn_fold(F); } if (IN(12) && IN(13)) xcd_barrier(bar);
    if (IN(13)) { dn_pass3(F); } if (IN(13) && IN(4)) xcd_barrier(bar);
    if (IN(4)) { dn_combine(F); p4_transposes(F); } SEAM(4);
    if (IN(5)) {
        pg8::Gemm g{WSP(bf16, WS_XB), WSP(bf16, WS_WOUT), SEQ, DM, DM}; pg8::StaticOrder S; S.init(SEQ, DM, F.G, (int)blockIdx.x);
        EpiRes E{F.in[0], F.out, WSP(bf16, WS_H1B), sumsq2};
        pg8::gemm_phase<EpiRes, pg8::StaticOrder, true, true>(F.lds + RING_OFF, g, S, E);
    } SEAM(5);
    if (IN(6)) {
        pg8::Gemm g{WSP(bf16, WS_H1B), WSP(bf16, WS_WQ), SEQ, 512, DM}; pg8::StaticOrder S; S.init(SEQ, 512, F.G, (int)blockIdx.x);
        EpiScaleBf16 E{sumsq2, 1, QSCALE, WSP(bf16, WS_QM), 512};
        pg8::gemm_phase<EpiScaleBf16, pg8::StaticOrder, true, true>(F.lds + RING_OFF, g, S, E);
    } SEAM(6);
    if (IN(7)) { mem_attn_phase(F); } SEAM(7);
    if (IN(8)) {
        pg8::Gemm g{WSP(bf16, WS_OM), WSP(bf16, WS_WO), SEQ, DM, 512}; pg8::StaticOrder S; S.init(SEQ, DM, F.G, (int)blockIdx.x);
        EpiRes E{F.out, F.out, WSP(bf16, WS_XB), sumsq3};
        pg8::gemm_phase<EpiRes, pg8::StaticOrder, true, true>(F.lds + RING_OFF, g, S, E);
    } SEAM(8);
    if (IN(9)) {
        pg8::Gemm g{WSP(bf16, WS_XB), WSP(bf16, WS_WGU), SEQ, 2 * DFF, DM}; pg8::StaticOrder S; S.init(SEQ, 2 * DFF, F.G, (int)blockIdx.x);
        EpiSwiglu E{sumsq3, WSP(bf16, WS_HID)};
        pg8::gemm_phase<EpiSwiglu, pg8::StaticOrder, true, true>(F.lds + RING_OFF, g, S, E);
    } SEAM(9);
    if (IN(10)) {
        pg8::Gemm g{WSP(bf16, WS_HID), WSP(bf16, WS_WD), SEQ, DM, DFF}; pg8::StaticOrder S; S.init(SEQ, DM, F.G, (int)blockIdx.x);
        EpiRes E{F.out, F.out, nullptr, sumsq4};
        pg8::gemm_phase<EpiRes, pg8::StaticOrder, true, true>(F.lds + RING_OFF, g, S, E);
    } SEAM(10);
    if (IN(11)) { final_norm(F); }
#undef IN
#undef SEAM
}

extern "C" void kernel_launch(void* const* d_in, const int* in_sizes, int n_in, void* d_out, int out_size, void* d_ws, size_t ws_size, hipStream_t stream) {
    static int grid = 0;
    if (grid == 0) {
        if (n_in != 23 || out_size != SEQ * DM || ws_size < WS_END) { fprintf(stderr, "kernel_launch: unexpected shapes (n_in %d out %d ws %zu)\n", n_in, out_size, ws_size); grid = -1; return; }
        int dev = 0, cus = 0;
        if (hipGetDevice(&dev) != hipSuccess || hipDeviceGetAttribute(&cus, hipDeviceAttributeMultiprocessorCount, dev) != hipSuccess) { grid = -1; return; }
        if (hipFuncSetAttribute((const void*)enc_fwd, hipFuncAttributeMaxDynamicSharedMemorySize, LDS_BYTES) != hipSuccess) { fprintf(stderr, "kernel_launch: hipFuncSetAttribute failed\n"); grid = -1; return; }
        (void)hipGetLastError();
        grid = cus;
    }
    if (grid < 0) return;
    if (hipMemsetAsync((char*)d_ws + WS_CTL, 0, CTL_ZERO_BYTES, stream) != hipSuccess) return;
    Args a{};
    for (int i = 0; i < 23; ++i) a.in[i] = (const float*)d_in[i];
    a.out = (float*)d_out; a.ws = (unsigned char*)d_ws;
    const int per = (N_PHASES + MK_N_LAUNCHES - 1) / MK_N_LAUNCHES;
    for (int lo = 0; lo < N_PHASES; lo += per) {
        a.ph_lo = lo; a.ph_hi = (lo + per < N_PHASES) ? lo + per : N_PHASES;
        hipLaunchKernelGGL(enc_fwd, dim3(grid), dim3(NWAVES * 64), LDS_BYTES, stream, a);
    }
}
```

```cpp
#include <hip/hip_runtime.h>
#include <cstdio>
#include <cstdint>
namespace pg8 {
__device__ __forceinline__ unsigned cvt_pk_bf16(float lo, float hi) { unsigned r; asm volatile("v_cvt_pk_bf16_f32 %0, %1, %2" : "=v"(r) : "v"(lo), "v"(hi)); return r; }
#define PG8_LAS __attribute__((address_space(3)))
typedef unsigned short bf16_t;
typedef short bf16x8 __attribute__((ext_vector_type(8)));
typedef float f32x4 __attribute__((ext_vector_type(4)));
typedef unsigned u32x4 __attribute__((ext_vector_type(4)));
constexpr int BM = 256, BK = 64, HALF = 128, HTB = HALF * BK * 2  , STAGE_BYTES = 8 * HTB, NXCD = 8, WGM = 8;

__host__ __device__ __forceinline__ int lds_byte(int r, int c) { const int st = (r >> 4) * 2 + (c >> 5), rr = r & 15, cc = c & 31, ob = rr * 64 + cc * 2; return st * 1024 + (ob ^ (((ob >> 9) & 1) << 5)); }
__host__ __device__ __forceinline__ void stage_rc(int b, int& R, int& C) { const int st = b / 1024, sb = b % 1024, swz = sb ^ (((sb >> 9) & 1) << 5); R = (st >> 1) * 16 + swz / 64; C = (st & 1) * 32 + (swz % 64) / 2; }
__host__ __device__ __forceinline__ int perm32(int rho) { const int n = rho >> 4, i = rho & 15; return 8 * (i >> 2) + 4 * n + (i & 3); }

struct Unit { int pm, pn; };
struct Gemm { const bf16_t* A; const bf16_t* Bt; int M, N, K; };

struct StaticOrder {
    int nM, nN, nwg, G, c;
    __host__ __device__ void init(int M, int N, int G_, int c_) { nM = M / BM; nN = N / BM; nwg = nM * nN; G = G_; c = c_; }
    __host__ __device__ bool next(int i, Unit& u) const {
        const long L = (long)i * G + c; if (L >= nwg) return false;
        int wgid = (int)L; { const int q = nwg / NXCD, r = nwg % NXCD, xcd = wgid % NXCD, off = wgid / NXCD; wgid = (xcd < r ? xcd * (q + 1) : r * (q + 1) + (xcd - r) * q) + off; }
        const int nig = WGM * nN, gid = wgid / nig, fm = gid * WGM, gsz = (nM - fm) < WGM ? (nM - fm) : WGM;
        u.pm = fm + ((wgid % nig) % gsz); u.pn = (wgid % nig) / gsz; return true;
    }
    __device__ __forceinline__ void a_ready(const Unit&) const {}
    __device__ __forceinline__ void done(const Unit&) const {}
};

template <class Epi, class Sched, bool ALIGN_EPI = false, bool SP2 = false>
__device__ __forceinline__ void gemm_phase(PG8_LAS unsigned char* lds, const Gemm g, const Sched& S, const Epi& E) {
    const int tid = threadIdx.x, wid = __builtin_amdgcn_readfirstlane(tid >> 6), lane = tid & 63, wr = wid >> 2, wc = wid & 3, fr = lane & 15, fq = lane >> 4;
    const int K = g.K, nt = K / BK;
    unsigned voffA[2], voffB[2];
#pragma unroll
    for (int i = 0; i < 2; ++i) { int R, C; stage_rc(tid * 16 + i * 8192, R, C); const int Rb = Epi::PERM ? ((R & ~31) + perm32(R & 31)) : R;
        voffA[i] = (unsigned)(R * K + C) * 2u; voffB[i] = (unsigned)(Rb * K + C) * 2u; }
    const size_t kstep = (size_t)(BK * 2);
    const size_t hstep = (size_t)HALF * K * 2;
    const size_t tstep = 2 * hstep;
    const unsigned ldsw = (unsigned)wid * 1024u;
    const int aoff = lds_byte(wr * 64 + fr, fq * 8), boff = lds_byte(wc * 32 + fr, fq * 8);
#define PG8_SA(b, h) (((b) * 2 + (h)) * HTB)
#define PG8_SB(b, h) ((4 + (b) * 2 + (h)) * HTB)
#define PG8_STAGE(bufoff, gbase, voff) do { _Pragma("unroll") for (int _i = 0; _i < 2; ++_i) \
        __builtin_amdgcn_global_load_lds((const unsigned*)((const char*)(gbase) + (voff)[_i]), (PG8_LAS unsigned*)(lds + (bufoff) + ldsw + _i * 8192), 16, 0, 0); } while (0)
#define PG8_LDA(dst, b, h) do { _Pragma("unroll") for (int m = 0; m < 4; ++m) _Pragma("unroll") for (int k = 0; k < 2; ++k) dst[m][k] = *(const PG8_LAS bf16x8*)(lds + PG8_SA(b, h) + aoff + m * 2048 + k * 1024); } while (0)
#define PG8_LDB(dst, b, h) do { _Pragma("unroll") for (int n = 0; n < 2; ++n) _Pragma("unroll") for (int k = 0; k < 2; ++k) dst[n][k] = *(const PG8_LAS bf16x8*)(lds + PG8_SB(b, h) + boff + n * 2048 + k * 1024); } while (0)
#define PG8_MMA(ai, bj, At, Bt) do { __builtin_amdgcn_s_setprio(1); _Pragma("unroll") for (int m = 0; m < 4; ++m) _Pragma("unroll") for (int n = 0; n < 2; ++n) _Pragma("unroll") for (int k = 0; k < 2; ++k) \
        acc[ai][bj][m][n] = __builtin_amdgcn_mfma_f32_16x16x32_bf16(Bt[n][k], At[m][k], acc[ai][bj][m][n], 0, 0, 0); __builtin_amdgcn_s_setprio(0); } while (0)
#define PG8_WAIT_V(n) asm volatile("s_waitcnt vmcnt(" #n ")" ::: "memory")
#define PG8_WAIT_L(n) asm volatile("s_waitcnt lgkmcnt(" #n ")" ::: "memory")
#define PG8_BAR __builtin_amdgcn_s_barrier()
#define PG8_SCHED __builtin_amdgcn_sched_barrier(0)
    Unit cur, nxt; int ui = 0;
    if (!S.next(0, cur)) return;
    f32x4 acc[2][2][4][2];
#pragma unroll
    for (int a = 0; a < 2; ++a)
#pragma unroll
        for (int b = 0; b < 2; ++b)
#pragma unroll
            for (int m = 0; m < 4; ++m)
#pragma unroll
                for (int n = 0; n < 2; ++n) acc[a][b][m][n] = (f32x4){0.f, 0.f, 0.f, 0.f};
    bf16x8 At[4][2], B0[2][2], B1[2][2];
    const char* cA = (const char*)g.A + (size_t)cur.pm * tstep; const char* cB = (const char*)g.Bt + (size_t)cur.pn * tstep;
    S.a_ready(cur);
    if constexpr (SP2) {
        PG8_STAGE(PG8_SB(0, 0), cB, voffB); PG8_STAGE(PG8_SB(0, 1), cB + hstep, voffB); PG8_STAGE(PG8_SA(0, 0), cA, voffA); PG8_STAGE(PG8_SA(0, 1), cA + hstep, voffA);
        if (wr == 1) PG8_BAR;
        PG8_WAIT_V(2); PG8_BAR;
        PG8_STAGE(PG8_SB(1, 0), cB + kstep, voffB); PG8_STAGE(PG8_SA(1, 0), cA + kstep, voffA); PG8_STAGE(PG8_SB(1, 1), cB + hstep + kstep, voffB);
        PG8_WAIT_V(6); PG8_BAR;
    } else {
        PG8_STAGE(PG8_SB(0, 0), cB, voffB); PG8_STAGE(PG8_SA(0, 0), cA, voffA); PG8_STAGE(PG8_SB(0, 1), cB + hstep, voffB); PG8_STAGE(PG8_SA(0, 1), cA + hstep, voffA);
        if (wr == 1) PG8_BAR;
        PG8_WAIT_V(4); PG8_BAR;
        PG8_STAGE(PG8_SB(1, 0), cB + kstep, voffB); PG8_STAGE(PG8_SA(1, 0), cA + kstep, voffA); PG8_STAGE(PG8_SB(1, 1), cB + hstep + kstep, voffB);
        PG8_WAIT_V(6); PG8_BAR;
    }
    for (;;) {
        const bool has_next = S.next(ui + 1, nxt);
        const char* nA = has_next ? (const char*)g.A + (size_t)nxt.pm * tstep : cA; const char* nB = has_next ? (const char*)g.Bt + (size_t)nxt.pn * tstep : cB;
        for (int t = 0; t < nt; t += 2) {
            const bool last = (t == nt - 2);
            const char* a1 = cA + (size_t)(t + 1) * kstep;
            const char* a2 = last ? nA : cA + (size_t)(t + 2) * kstep; const char* b2 = last ? nB : cB + (size_t)(t + 2) * kstep;
            const char* a3 = a2 + kstep; const char* b3 = b2 + kstep;
            if (last && has_next) S.a_ready(nxt);
            if constexpr (SP2) {
            PG8_LDB(B0, 0, 0); PG8_LDB(B1, 0, 1); PG8_SCHED; PG8_LDA(At, 0, 0); PG8_STAGE(PG8_SA(1, 1), a1 + hstep, voffA);
            PG8_WAIT_V(8); PG8_WAIT_L(0); PG8_BAR; PG8_MMA(0, 0, At, B0); PG8_MMA(0, 1, At, B1); PG8_BAR; PG8_SCHED;
            PG8_LDA(At, 0, 1); PG8_STAGE(PG8_SB(0, 0), b2, voffB); PG8_STAGE(PG8_SB(0, 1), b2 + hstep, voffB); PG8_STAGE(PG8_SA(0, 0), a2, voffA);
            PG8_WAIT_V(8); PG8_WAIT_L(0); PG8_BAR; PG8_MMA(1, 0, At, B0); PG8_MMA(1, 1, At, B1); PG8_BAR; PG8_SCHED;
            PG8_LDB(B0, 1, 0); PG8_LDB(B1, 1, 1); PG8_SCHED; PG8_LDA(At, 1, 0); PG8_STAGE(PG8_SA(0, 1), a2 + hstep, voffA);
            PG8_WAIT_V(8); PG8_WAIT_L(0); PG8_BAR; PG8_MMA(0, 0, At, B0); PG8_MMA(0, 1, At, B1); PG8_BAR; PG8_SCHED;
            PG8_LDA(At, 1, 1); PG8_STAGE(PG8_SB(1, 0), b3, voffB); PG8_STAGE(PG8_SB(1, 1), b3 + hstep, voffB); PG8_STAGE(PG8_SA(1, 0), a3, voffA);
            PG8_WAIT_V(8); PG8_WAIT_L(0); PG8_BAR; PG8_MMA(1, 0, At, B0); PG8_MMA(1, 1, At, B1); PG8_BAR; PG8_SCHED;
            } else {
            PG8_LDB(B0, 0, 0); PG8_SCHED; PG8_LDA(At, 0, 0); PG8_STAGE(PG8_SA(1, 1), a1 + hstep, voffA);
            PG8_WAIT_L(8); PG8_BAR; PG8_WAIT_L(0); PG8_MMA(0, 0, At, B0); PG8_BAR; PG8_SCHED;
            PG8_LDB(B1, 0, 1); PG8_STAGE(PG8_SB(0, 0), b2, voffB);
            PG8_BAR; PG8_WAIT_L(0); PG8_MMA(0, 1, At, B1); PG8_BAR;
            PG8_LDA(At, 0, 1); PG8_STAGE(PG8_SA(0, 0), a2, voffA);
            PG8_BAR; PG8_WAIT_L(0); PG8_MMA(1, 0, At, B0); PG8_BAR; PG8_SCHED;
            PG8_STAGE(PG8_SB(0, 1), b2 + hstep, voffB);
            PG8_WAIT_V(6); PG8_BAR; PG8_MMA(1, 1, At, B1); PG8_BAR;
            PG8_LDB(B0, 1, 0); PG8_SCHED; PG8_LDA(At, 1, 0); PG8_STAGE(PG8_SA(0, 1), a2 + hstep, voffA);
            PG8_WAIT_L(8); PG8_BAR; PG8_WAIT_L(0); PG8_MMA(0, 0, At, B0); PG8_BAR; PG8_SCHED;
            PG8_LDB(B1, 1, 1); PG8_STAGE(PG8_SB(1, 0), b3, voffB);
            PG8_BAR; PG8_WAIT_L(0); PG8_MMA(0, 1, At, B1); PG8_BAR;
            PG8_LDA(At, 1, 1); PG8_STAGE(PG8_SA(1, 0), a3, voffA);
            PG8_BAR; PG8_WAIT_L(0); PG8_MMA(1, 0, At, B0); PG8_BAR; PG8_SCHED;
            PG8_STAGE(PG8_SB(1, 1), b3 + hstep, voffB);
            PG8_WAIT_V(6); PG8_BAR; PG8_MMA(1, 1, At, B1); PG8_BAR;
            }
        }
        if constexpr (ALIGN_EPI) { if (wr == 0) PG8_BAR; }
        if constexpr (!Epi::AFTER_DRAIN) { E(acc, cur, wr, wc, fr, fq); S.done(cur); }
        if (!has_next) break;
#pragma unroll
        for (int a = 0; a < 2; ++a)
#pragma unroll
            for (int b = 0; b < 2; ++b)
#pragma unroll
                for (int m = 0; m < 4; ++m)
#pragma unroll
                    for (int n = 0; n < 2; ++n) acc[a][b][m][n] = (f32x4){0.f, 0.f, 0.f, 0.f};
        cur = nxt; cA = nA; cB = nB; ++ui;
        if constexpr (ALIGN_EPI) { if (wr == 1) PG8_BAR; }
    }
    PG8_WAIT_V(0);
    if constexpr (!ALIGN_EPI) { if (wr == 0) PG8_BAR; }
    PG8_BAR;
    if constexpr (Epi::AFTER_DRAIN) { E.fused(acc, cur, wr, wc, fr, fq, lds, wid, lane); S.done(cur); }
#undef PG8_SA
#undef PG8_SB
#undef PG8_STAGE
#undef PG8_LDA
#undef PG8_LDB
#undef PG8_MMA
#undef PG8_WAIT_V
#undef PG8_WAIT_L
#undef PG8_BAR
#undef PG8_SCHED
}
}

constexpr int NWAVES = 8;
constexpr int SEQ = 16384, DM = 2048, NIN = 5664, NINP = 5888, DFF = 5632;
constexpr int DNH = 8, HD = 128, SWH = 8, MEMH = 4, MEMT = 256;
constexpr float RMS_EPS = 1e-6f;
constexpr float LOG2E = 1.4426950408889634f;
constexpr float QSCALE = 0.08838834764831845f * 1.4426950408889634f;

constexpr size_t MiB = 1u << 20;
constexpr size_t WS_CTL = 0, CTL_ZERO_BYTES = 1 * MiB;
constexpr size_t CTL_SUMSQ2 = 256 * 1024, CTL_SUMSQ3 = 320 * 1024, CTL_SUMSQ4 = 384 * 1024;
constexpr size_t WS_RSTD1 = 1 * MiB, WS_RSTDM = 1 * MiB + 64 * 1024;
constexpr size_t WS_MEMB = 2 * MiB, WS_KVM = 3 * MiB, WS_AB = 4 * MiB, WS_BG = 6 * MiB;
constexpr size_t WS_WOUT = 8 * MiB, WS_WQ = 16 * MiB, WS_WKV = 18 * MiB, WS_WO = 22 * MiB, WS_WIN = 24 * MiB;
constexpr size_t WS_XB = 48 * MiB;
constexpr size_t WS_QKV = 112 * MiB;
constexpr size_t WS_H3B = 112 * MiB;
constexpr size_t WS_OF = 112 * MiB, WS_OB = 144 * MiB, WS_H1B = 112 * MiB, WS_QM = 176 * MiB, WS_OM = 192 * MiB;
constexpr size_t WS_DNX = 208 * MiB;
constexpr size_t WS_WGU = 208 * MiB, WS_WD = 252 * MiB, WS_HID = 274 * MiB, WS_END = 496 * MiB;
constexpr size_t DO_Z = 0, DO_QSW = 32 * MiB, DO_KVSW = 64 * MiB;
constexpr int CW_BAR = 4096;

constexpr int RING_OFF = 0, RING_BYTES = 131072;
constexpr int LDS_BYTES = 163840;
constexpr int LDSCTL_OFF = LDS_BYTES - 512, MISC_OFF = LDSCTL_OFF + 320;

#define GAS __attribute__((address_space(1)))
#define LAS __attribute__((address_space(3)))
typedef unsigned short bf16;
typedef unsigned v4u __attribute__((ext_vector_type(4)));
typedef unsigned v2u __attribute__((ext_vector_type(2)));
typedef float f32x4 __attribute__((ext_vector_type(4)));
typedef short bf16x8 __attribute__((ext_vector_type(8)));
typedef short s16x4 __attribute__((ext_vector_type(4)));
typedef GAS unsigned gu32;
#define RLX_AGENT __ATOMIC_RELAXED, __HIP_MEMORY_SCOPE_AGENT
#define LDS_WAIT() asm volatile("s_waitcnt lgkmcnt(0)" ::: "memory")
#define VM_WAIT() asm volatile("s_waitcnt vmcnt(0)" ::: "memory")
__device__ __forceinline__ unsigned f2bf(float f) { unsigned u = __builtin_bit_cast(unsigned, f); return (u + 0x7fffu + ((u >> 16) & 1u)) >> 16; }
__device__ __forceinline__ unsigned pk2(float lo, float hi) { return f2bf(lo) | (f2bf(hi) << 16); }
__device__ __forceinline__ float bf2f(unsigned short b) { return __builtin_bit_cast(float, (unsigned)b << 16); }
__device__ __forceinline__ float bflo(unsigned w) { return __builtin_bit_cast(float, w << 16); }
__device__ __forceinline__ float bfhi(unsigned w) { return __builtin_bit_cast(float, w & 0xffff0000u); }
typedef float f32x2_t __attribute__((ext_vector_type(2))); typedef __bf16 bf16x2_t __attribute__((ext_vector_type(2)));
__device__ __forceinline__ unsigned cvtpk(float lo, float hi) { f32x2_t v = {lo, hi}; bf16x2_t b = __builtin_convertvector(v, bf16x2_t); return __builtin_bit_cast(unsigned, b); }
__device__ __forceinline__ float wave_sum(float v) {
#pragma unroll
    for (int o = 1; o < 64; o <<= 1) v += __shfl_xor(v, o);
    return v;
}
__device__ __forceinline__ float siluf(float x) { return x * __builtin_amdgcn_rcpf(1.0f + __expf(-x)); }
#define XB_TMO      128
#define XB_XCNT(j)  (256  + 64 * (j))
#define XB_XSUB(j)  (1280 + 64 * (j))
#define XB_XGEN(j)  (2304 + 64 * (j))
#define XB_TOP      3328
#define XB_TOPGEN   3392
#define XCD_BAR_WORDS 3456
#define XB_SPIN_CAP (1u << 18)

__device__ __forceinline__ unsigned xb_ld(unsigned* p)              { return __hip_atomic_load(p, __ATOMIC_RELAXED, __HIP_MEMORY_SCOPE_AGENT); }
__device__ __forceinline__ unsigned xb_add(unsigned* p, unsigned v) { return __hip_atomic_fetch_add(p, v, __ATOMIC_RELAXED, __HIP_MEMORY_SCOPE_AGENT); }
__device__ __forceinline__ unsigned xb_xcc_id() { return (unsigned)__builtin_amdgcn_s_getreg((3 << 11) | 20) & 0xFu; }
#define XB_SPIN(cond, bar) do { unsigned _sp = 0; while (cond) { __builtin_amdgcn_s_sleep(1); \
    if ((++_sp & 255u) == 0u) { if (xb_ld(&(bar)[XB_TMO])) break; if (_sp > XB_SPIN_CAP) { atomicAdd(&(bar)[XB_TMO], 1u); break; } } } } while (0)

struct XcdBarrier {
    unsigned* bar; unsigned x;
    volatile LAS unsigned* st;
};

__device__ __forceinline__ XcdBarrier xcd_barrier_post(unsigned* bar, volatile LAS unsigned* st) {
    XcdBarrier b; b.bar = bar; b.x = xb_xcc_id(); b.st = st;
    if (threadIdx.x == 0) (void)xb_add(&bar[XB_XCNT(b.x)], 1u);
    return b;
}
__device__ __forceinline__ void xcd_barrier_complete(unsigned* bar, unsigned x, unsigned& nloc, unsigned& nx) {
    const unsigned G = gridDim.x * gridDim.y * gridDim.z;
    unsigned sum, cnt, mine, sp = 0u;
    for (;;) {
        sum = 0u; cnt = 0u; mine = 0u;
#pragma unroll
        for (unsigned j = 0; j < 16; ++j) { const unsigned c = xb_ld(&bar[XB_XCNT(j)]); sum += c; cnt += (c > 0u) ? 1u : 0u; mine = (j == x) ? c : mine; }
        if (sum == G) break;
        __builtin_amdgcn_s_sleep(1);
        if ((++sp & 255u) == 0u) { if (xb_ld(&bar[XB_TMO])) break; if (sp > XB_SPIN_CAP) { atomicAdd(&bar[XB_TMO], 1u); break; } }
    }
    nloc = mine > 0u ? mine : 1u; nx = cnt > 0u ? cnt : 1u;
}

__device__ __forceinline__ void xcd_barrier(const XcdBarrier& b) {
    asm volatile("s_waitcnt vmcnt(0)" ::: "memory");
    __syncthreads();
    if (threadIdx.x == 0) {
        unsigned* bar = b.bar;
        __builtin_amdgcn_s_waitcnt(0);
        unsigned nloc = b.st[0], nx = b.st[1];
        if (nloc == 0u) { xcd_barrier_complete(bar, b.x, nloc, nx); b.st[0] = nloc; b.st[1] = nx; }
        const unsigned old = xb_add(&bar[XB_XSUB(b.x)], 1u);
        const unsigned gen = old / nloc;
        if (old + 1u == (gen + 1u) * nloc) {
            __builtin_amdgcn_fence(__ATOMIC_RELEASE, "agent");
            asm volatile("s_waitcnt vmcnt(0)" ::: "memory");
            const unsigned og = xb_add(&bar[XB_TOP], 1u);
            const unsigned tg = og / nx;
            if (og + 1u == (tg + 1u) * nx) xb_add(&bar[XB_TOPGEN], 1u);
            else XB_SPIN(xb_ld(&bar[XB_TOPGEN]) == tg, bar);
            __builtin_amdgcn_fence(__ATOMIC_ACQUIRE, "agent");
            xb_add(&bar[XB_XGEN(b.x)], 1u);
            asm volatile("s_waitcnt vmcnt(0)" ::: "memory");
        } else {
            XB_SPIN(xb_ld(&bar[XB_XGEN(b.x)]) == gen, bar);
            __builtin_amdgcn_fence(__ATOMIC_ACQUIRE, "agent");
            asm volatile("s_waitcnt vmcnt(0)" ::: "memory");
        }
    }
    __syncthreads();
}

using pg8::Unit;
__device__ __forceinline__ v4u pack8(f32x4 v0, f32x4 v1) { v4u w; w.x = cvtpk(v0[0], v0[1]); w.y = cvtpk(v0[2], v0[3]); w.z = cvtpk(v1[0], v1[1]); w.w = cvtpk(v1[2], v1[3]); return w; }

struct EpiProj {
    static constexpr bool PERM = true, AFTER_DRAIN = false;
    const float* rstd; bf16* qkv; bf16* z; bf16* qsw; bf16* kvsw; float* ab;
    __device__ __forceinline__ void operator()(const f32x4 (&acc)[2][2][4][2], const Unit& u, int wr, int wc, int fr, int fq) const {
        const int pn = u.pn; bf16* base; int ldc, colt; float sc = 1.f;
        if (pn < 12) { base = qkv; ldc = 3072; colt = pn * 256; }
        else if (pn < 16) { base = z; ldc = 1024; colt = (pn - 12) * 256; }
        else if (pn < 20) { base = qsw; ldc = 1024; colt = (pn - 16) * 256; sc = QSCALE; }
        else if (pn < 22) { base = kvsw; ldc = 512; colt = (pn - 20) * 256; }
        else { base = nullptr; ldc = 0; colt = 0; }
        const int row0 = u.pm * 256 + wr * 64 + fr, col0 = colt + wc * 32 + 8 * fq;
#pragma unroll
        for (int ai = 0; ai < 2; ++ai)
#pragma unroll
            for (int m = 0; m < 4; ++m) {
                const int row = row0 + ai * 128 + m * 16; const float rs = rstd[row] * sc;
                if (base) {
                    bf16* rowp = base + (size_t)row * ldc + col0;
#pragma unroll
                    for (int bj = 0; bj < 2; ++bj) *(v4u*)(rowp + bj * 128) = pack8(acc[ai][bj][m][0] * rs, acc[ai][bj][m][1] * rs);
                } else if (wc == 0) {
                    float* rowp = ab + (size_t)row * 32 + 8 * fq;
                    *(f32x4*)(rowp) = acc[ai][0][m][0] * rs; *(f32x4*)(rowp + 4) = acc[ai][0][m][1] * rs;
                }
            }
    }
};
struct EpiScaleBf16 {
    static constexpr bool PERM = true, AFTER_DRAIN = false;
    const float* rs; int from_sumsq; float sc; bf16* O; int ldc;
    __device__ __forceinline__ void operator()(const f32x4 (&acc)[2][2][4][2], const Unit& u, int wr, int wc, int fr, int fq) const {
        const int row0 = u.pm * 256 + wr * 64 + fr, col0 = u.pn * 256 + wc * 32 + 8 * fq;
#pragma unroll
        for (int ai = 0; ai < 2; ++ai)
#pragma unroll
            for (int m = 0; m < 4; ++m) {
                const int row = row0 + ai * 128 + m * 16; float r = rs[row];
                if (from_sumsq) r = __builtin_amdgcn_rsqf(r * (1.0f / DM) + RMS_EPS);
                r *= sc; bf16* rowp = O + (size_t)row * ldc + col0;
#pragma unroll
                for (int bj = 0; bj < 2; ++bj) *(v4u*)(rowp + bj * 128) = pack8(acc[ai][bj][m][0] * r, acc[ai][bj][m][1] * r);
            }
    }
};
struct EpiRes {
    static constexpr bool PERM = true, AFTER_DRAIN = false;
    const float* res; float* out; bf16* ob; float* sumsq;
    __device__ __forceinline__ void operator()(const f32x4 (&acc)[2][2][4][2], const Unit& u, int wr, int wc, int fr, int fq) const {
        const int row0 = u.pm * 256 + wr * 64 + fr, col0 = u.pn * 256 + wc * 32 + 8 * fq;
#pragma unroll
        for (int ai = 0; ai < 2; ++ai) {
            f32x4 rr[4][2][2];
#pragma unroll
            for (int m = 0; m < 4; ++m) { const size_t off = (size_t)(row0 + ai * 128 + m * 16) * DM + col0;
#pragma unroll
                for (int bj = 0; bj < 2; ++bj) { rr[m][bj][0] = *(const f32x4*)(res + off + bj * 128); rr[m][bj][1] = *(const f32x4*)(res + off + bj * 128 + 4); } }
            asm volatile("" ::: "memory");
#pragma unroll
            for (int m = 0; m < 4; ++m) {
                const int row = row0 + ai * 128 + m * 16; const size_t off = (size_t)row * DM + col0; float ss = 0.f;
#pragma unroll
                for (int bj = 0; bj < 2; ++bj) {
                    const f32x4 v0 = acc[ai][bj][m][0] + rr[m][bj][0], v1 = acc[ai][bj][m][1] + rr[m][bj][1];
                    if (out) { *(f32x4*)(out + off + bj * 128) = v0; *(f32x4*)(out + off + bj * 128 + 4) = v1; }
                    if (ob) *(v4u*)(ob + off + bj * 128) = pack8(v0, v1);
                    ss += (v0[0] * v0[0] + v0[1] * v0[1]) + (v0[2] * v0[2] + v0[3] * v0[3]) + (v1[0] * v1[0] + v1[1] * v1[1]) + (v1[2] * v1[2] + v1[3] * v1[3]);
                }
                ss += __shfl_xor(ss, 16); ss += __shfl_xor(ss, 32);
                if (fq == 0) atomicAdd(sumsq + row, ss);
            }
            asm volatile("" ::: "memory");
        }
    }
};
struct EpiSwiglu {
    static constexpr bool PERM = true, AFTER_DRAIN = false;
    const float* sumsq; bf16* H;
    __device__ __forceinline__ void operator()(const f32x4 (&acc)[2][2][4][2], const Unit& u, int wr, int wc, int fr, int fq) const {
        const int row0 = u.pm * 256 + wr * 64 + fr, col0 = u.pn * 128 + wc * 32 + 8 * fq;
#pragma unroll
        for (int ai = 0; ai < 2; ++ai)
#pragma unroll
            for (int m = 0; m < 4; ++m) {
                const int row = row0 + ai * 128 + m * 16; const float r = __builtin_amdgcn_rsqf(sumsq[row] * (1.0f / DM) + RMS_EPS);
                f32x4 h[2];
#pragma unroll
                for (int n = 0; n < 2; ++n)
#pragma unroll
                    for (int e = 0; e < 4; ++e) { const float g = acc[ai][0][m][n][e] * r, up = acc[ai][1][m][n][e] * r; h[n][e] = siluf(g) * up; }
                *(v4u*)(H + (size_t)row * DFF + col0) = pack8(h[0], h[1]);
            }
    }
};

struct Frame {
    LAS unsigned char* lds;
    volatile LAS unsigned* MISC;
    gu32* ctl;
    int tid, lane, wave, vcu, G;
    const float* in[23]; float* out; unsigned char* ws;
};
#define WSP(T, off) ((T*)(F.ws + (off)))
#define DOP(T, off) ((T*)((unsigned char*)F.out + (off)))

__device__ __forceinline__ void tr_item(const float* W, int K, int Nsrc, int src_col0, const float* gain, bf16* WT, int dst_row0, int k0, LAS float* scr, int lane) {
    float v[32];
#pragma unroll
    for (int i = 0; i < 32; ++i) { const int kk = 2 * i + (lane >> 5); v[i] = (src_col0 >= 0) ? W[(size_t)(k0 + kk) * Nsrc + src_col0 + (lane & 31)] : 0.f; }
    if (gain) {
#pragma unroll
        for (int i = 0; i < 32; ++i) v[i] *= gain[k0 + 2 * i + (lane >> 5)]; }
#pragma unroll
    for (int i = 0; i < 32; ++i) scr[(2 * i + (lane >> 5)) * 33 + (lane & 31)] = v[i];
    LDS_WAIT(); asm volatile("" ::: "memory");
    const int c = lane & 7;
#pragma unroll
    for (int j = 0; j < 4; ++j) { const int n = (lane >> 3) + 8 * j; const LAS float* s = scr + (8 * c) * 33 + n;
        v4u o; o.x = pk2(s[0 * 33], s[1 * 33]); o.y = pk2(s[2 * 33], s[3 * 33]); o.z = pk2(s[4 * 33], s[5 * 33]); o.w = pk2(s[6 * 33], s[7 * 33]);
        *(GAS v4u*)(WT + (size_t)(dst_row0 + n) * K + k0 + 8 * c) = o; }
    LDS_WAIT(); asm volatile("" ::: "memory");
}
__device__ __forceinline__ int win_src_col(int c) {
    if (c < 4096) return c;
    if (c < 5120) return c - 4096 + 4128;
    if (c < 5376) return c - 5120 + 5152;
    if (c < 5632) return c - 5376 + 5408;
    if (c < 5664) return c - 5632 + 4096;
    return -1;
}
__device__ __forceinline__ void row_to_bf16_rstd(const float* xrow, bf16* orow, float* rstd_out, int lane) {
    const GAS f32x4* xr = (const GAS f32x4*)xrow + lane;
    f32x4 v[8]; float s = 0.f;
#pragma unroll
    for (int j = 0; j < 8; ++j) { v[j] = xr[64 * j]; s += (v[j].x * v[j].x + v[j].y * v[j].y) + (v[j].z * v[j].z + v[j].w * v[j].w); }
    s = wave_sum(s);
    if (lane == 0) *rstd_out = 1.0f / sqrtf(s * (1.0f / DM) + RMS_EPS);
    GAS v2u* o8 = (GAS v2u*)orow + lane;
#pragma unroll
    for (int j = 0; j < 8; ++j) { v2u w; w.x = pk2(v[j].x, v[j].y); w.y = pk2(v[j].z, v[j].w); o8[64 * j] = w; }
}

__device__ __forceinline__ void p0_prologue(Frame& F) {
    LAS float* scr = (LAS float*)(F.lds + RING_OFF + F.wave * 16384);
    const int gw = F.vcu * NWAVES + F.wave, NGW = F.G * NWAVES;
    constexpr int I_IN = 32 * (NINP / 32), I_OUT = 32 * 64, I_Q = 32 * 16, I_KV = 32 * 32, I_O = 8 * 64;
    constexpr int NITEMS = I_IN + I_OUT + I_Q + I_KV + I_O;
    for (int it = gw; it < NITEMS; it += NGW) {
        int r = it;
        if (r < I_IN) { const int nblk = NINP / 32, kb = r / nblk, nb = r % nblk; tr_item(F.in[3], DM, NIN, win_src_col(nb * 32), F.in[2], WSP(bf16, WS_WIN), nb * 32, kb * 64, scr, F.lane); continue; } r -= I_IN;
        if (r < I_OUT) { const int kb = r / 64, nb = r % 64; tr_item(F.in[12], DM, DM, nb * 32, nullptr, WSP(bf16, WS_WOUT), nb * 32, kb * 64, scr, F.lane); continue; } r -= I_OUT;
        if (r < I_Q) { const int kb = r / 16, nb = r % 16; tr_item(F.in[15], DM, 512, nb * 32, F.in[13], WSP(bf16, WS_WQ), nb * 32, kb * 64, scr, F.lane); continue; } r -= I_Q;
        if (r < I_KV) { const int kb = r / 32, nb = r % 32; tr_item(F.in[16], DM, 1024, nb * 32, F.in[14], WSP(bf16, WS_WKV), nb * 32, kb * 64, scr, F.lane); continue; } r -= I_KV;
        { const int kb = r / 64, nb = r % 64; tr_item(F.in[17], 512, DM, nb * 32, nullptr, WSP(bf16, WS_WO), nb * 32, kb * 64, scr, F.lane); }
    }
    for (int m = gw; m < SEQ; m += NGW) row_to_bf16_rstd(F.in[0] + (size_t)m * DM, WSP(bf16, WS_XB) + (size_t)m * DM, WSP(float, WS_RSTD1) + m, F.lane);
    for (int m = gw; m < MEMT; m += NGW) row_to_bf16_rstd(F.in[1] + (size_t)m * DM, WSP(bf16, WS_MEMB) + (size_t)m * DM, WSP(float, WS_RSTDM) + m, F.lane);
}
__device__ __forceinline__ void p4_transposes(Frame& F) {
    LAS float* scr = (LAS float*)(F.lds + RING_OFF + F.wave * 16384);
    const int gw = F.vcu * NWAVES + F.wave, NGW = F.G * NWAVES;
    constexpr int I_GU = 32 * (2 * DFF / 32), I_D = (DFF / 64) * 64;
    for (int it = gw; it < I_GU + I_D; it += NGW) {
        int r = it;
        if (r < I_GU) { const int nblk = 2 * DFF / 32, kb = r / nblk, nb = r % nblk; const int row = nb * 32, t = row / 256, w = row % 256;
            const float* src = (w < 128) ? F.in[19] : F.in[20]; const int sc = 128 * t + (w & 127);
            tr_item(src, DM, DFF, sc, F.in[18], WSP(bf16, WS_WGU), row, kb * 64, scr, F.lane); continue; } r -= I_GU;
        { const int kb = r / 64, nb = r % 64; tr_item(F.in[21], DFF, DM, nb * 32, nullptr, WSP(bf16, WS_WD), nb * 32, kb * 64, scr, F.lane); }
    }
}

__device__ __forceinline__ float softplusf(float x) { return x > 20.f ? x : log1pf(__expf(x)); }
__device__ __forceinline__ void dn_combine(Frame& F) {
    const int gw = F.vcu * NWAVES + F.wave, NGW = F.G * NWAVES, lane = F.lane;
    const bf16* OFp = WSP(bf16, WS_OF); const bf16* OBp = WSP(bf16, WS_OB); const bf16* Z = DOP(bf16, DO_Z); bf16* Y = WSP(bf16, WS_XB); const float* gn = F.in[9];
    for (int t = gw; t < SEQ; t += NGW) {
        const size_t off = (size_t)t * 1024 + 16 * lane;
        const v4u a0 = *(const v4u*)(OFp + off), a1 = *(const v4u*)(OFp + off + 8), b0 = *(const v4u*)(OBp + off), b1 = *(const v4u*)(OBp + off + 8);
        const v4u z0 = *(const v4u*)(Z + off), z1 = *(const v4u*)(Z + off + 8);
        float o[16], zz[16];
#pragma unroll
        for (int i = 0; i < 4; ++i) { o[2 * i] = bflo(a0[i]) + bflo(b0[i]); o[2 * i + 1] = bfhi(a0[i]) + bfhi(b0[i]); o[8 + 2 * i] = bflo(a1[i]) + bflo(b1[i]); o[8 + 2 * i + 1] = bfhi(a1[i]) + bfhi(b1[i]);
            zz[2 * i] = bflo(z0[i]); zz[2 * i + 1] = bfhi(z0[i]); zz[8 + 2 * i] = bflo(z1[i]); zz[8 + 2 * i + 1] = bfhi(z1[i]); }
        float ss = 0.f;
#pragma unroll
        for (int i = 0; i < 16; ++i) ss += o[i] * o[i];
        ss += __shfl_xor(ss, 1); ss += __shfl_xor(ss, 2); ss += __shfl_xor(ss, 4);
        const float rs = 1.0f / sqrtf(ss * (1.0f / 128.0f) + RMS_EPS); const int cb = (16 * lane) & 127;
        float y[16];
#pragma unroll
        for (int i = 0; i < 16; ++i) y[i] = o[i] * rs * gn[cb + i] * siluf(zz[i]);
        v4u w0, w1;
#pragma unroll
        for (int i = 0; i < 4; ++i) { w0[i] = pk2(y[2 * i], y[2 * i + 1]); w1[i] = pk2(y[8 + 2 * i], y[8 + 2 * i + 1]); }
        bf16* yp = Y + (size_t)t * DM + 16 * lane; *(v4u*)yp = w0; *(v4u*)(yp + 8) = w1;
    }
}
__device__ __forceinline__ void final_norm(Frame& F) {
    const int gw = F.vcu * NWAVES + F.wave, NGW = F.G * NWAVES, lane = F.lane;
    const float* ss = (const float*)(F.ws + WS_CTL + CTL_SUMSQ4); const GAS f32x4* g = (const GAS f32x4*)F.in[22]; const bf16* H3 = WSP(bf16, WS_H3B);
    for (int m = gw; m < SEQ; m += NGW) {
        const float r = __builtin_amdgcn_rsqf(ss[m] * (1.0f / DM) + RMS_EPS);
        GAS f32x4* o = (GAS f32x4*)(F.out + (size_t)m * DM); const GAS v4u* hp = (const GAS v4u*)(H3 + (size_t)m * DM);
#pragma unroll
        for (int j = 0; j < 4; ++j) { const v4u w = hp[64 * j + lane]; const int c4 = 2 * (64 * j + lane);
            const f32x4 g0 = g[c4], g1 = g[c4 + 1];
            o[c4] = (f32x4){bflo(w.x) * r * g0[0], bfhi(w.x) * r * g0[1], bflo(w.y) * r * g0[2], bfhi(w.y) * r * g0[3]};
            o[c4 + 1] = (f32x4){bflo(w.z) * r * g1[0], bfhi(w.z) * r * g1[1], bflo(w.w) * r * g1[2], bfhi(w.w) * r * g1[3]}; }
    }
}

__device__ __forceinline__ int t5_bucket(int rel) {
    const int n = rel < 0 ? -rel : rel; int b;
    if (n < 8) b = n; else { int k = (31 - __builtin_clz((unsigned)(n * n))) - 6; b = 8 + k; if (b > 15) b = 15; }
    return (rel > 0 ? 16 : 0) + b;
}
template <int MODE  >
__device__ __forceinline__ void attn_unit(Frame& F, const bf16* Q, int qpitch, const bf16* Kp, const bf16* Vp, int kvpitch, bf16* O, int opitch, int q0, int kt_beg, int kt_end, const LAS float* btab, float sink2) {
    LAS unsigned char* Ks = F.lds + RING_OFF; LAS unsigned char* Vs = Ks + 16384;
    const int lane = F.lane, c = lane & 15, g = lane >> 4, qw0 = q0 + 16 * F.wave, tid = F.tid;
    bf16x8 qf[4];
#pragma unroll
    for (int t = 0; t < 4; ++t) qf[t] = *(const bf16x8*)(Q + (size_t)(qw0 + c) * qpitch + 32 * t + 8 * g);
    f32x4 oacc[8];
#pragma unroll
    for (int i = 0; i < 8; ++i) oacc[i] = (f32x4){0.f, 0.f, 0.f, 0.f};
    float mrun = (MODE == 0) ? sink2 : -1e30f, lsum = (MODE == 0 && g == 0) ? 1.0f : 0.0f;
    v4u kpre[2], vpre[2];
#pragma unroll
    for (int i = 0; i < 2; ++i) { const int ci = tid + 512 * i, key = ci >> 4, ch = ci & 15;
        kpre[i] = *(const v4u*)(Kp + (size_t)(64 * kt_beg + key) * kvpitch + ch * 8); vpre[i] = *(const v4u*)(Vp + (size_t)(64 * kt_beg + key) * kvpitch + ch * 8); }
    for (int kt = kt_beg; kt < kt_end; ++kt) {
        __syncthreads();
#pragma unroll
        for (int i = 0; i < 2; ++i) { const int ci = tid + 512 * i, key = ci >> 4, ch = ci & 15;
            *(LAS v4u*)(Ks + key * 256 + ((ch ^ (key & 15)) << 4)) = kpre[i]; *(LAS v4u*)(Vs + key * 256 + ((ch ^ ((key & 7) << 1)) << 4)) = vpre[i]; }
        if (kt + 1 < kt_end) {
#pragma unroll
            for (int i = 0; i < 2; ++i) { const int ci = tid + 512 * i, key = ci >> 4, ch = ci & 15;
                kpre[i] = *(const v4u*)(Kp + (size_t)(64 * (kt + 1) + key) * kvpitch + ch * 8); vpre[i] = *(const v4u*)(Vp + (size_t)(64 * (kt + 1) + key) * kvpitch + ch * 8); } }
        __syncthreads();
        bool rel_ok = true;
        if (MODE == 0) rel_ok = (64 * kt <= qw0 + 15 + 128) && (64 * kt + 63 >= qw0 - 128);
        if (!rel_ok) continue;
        f32x4 s[4];
#pragma unroll
        for (int mt = 0; mt < 4; ++mt) s[mt] = (f32x4){0.f, 0.f, 0.f, 0.f};
#pragma unroll
        for (int t = 0; t < 4; ++t)
#pragma unroll
            for (int mt = 0; mt < 4; ++mt) { const bf16x8 kf = *(const LAS bf16x8*)(Ks + (16 * mt + c) * 256 + (((4 * t + g) ^ c) << 4));
                s[mt] = __builtin_amdgcn_mfma_f32_16x16x32_bf16(kf, qf[t], s[mt], 0, 0, 0); }
        float tmax = -INFINITY;
#pragma unroll
        for (int mt = 0; mt < 4; ++mt)
#pragma unroll
            for (int r = 0; r < 4; ++r) {
                if (MODE == 0) { const int rel = (64 * kt + 16 * mt + 4 * g + r) - (qw0 + c); const bool ok = (rel >= -128) && (rel <= 128);
                    const int ri = ok ? rel + 128 : 128; const float bv = btab[ri]; s[mt][r] = ok ? s[mt][r] + bv : -INFINITY; }
                tmax = fmaxf(tmax, s[mt][r]); }
        tmax = fmaxf(tmax, __shfl_xor(tmax, 16)); tmax = fmaxf(tmax, __shfl_xor(tmax, 32));
        const float mnew = fmaxf(mrun, tmax), alpha = __builtin_amdgcn_exp2f(mrun - mnew); mrun = mnew; float ps = 0.f;
#pragma unroll
        for (int mt = 0; mt < 4; ++mt)
#pragma unroll
            for (int r = 0; r < 4; ++r) { const float p = __builtin_amdgcn_exp2f(s[mt][r] - mnew); s[mt][r] = p; ps += p; }
        lsum = lsum * alpha + ps;
#pragma unroll
        for (int i = 0; i < 8; ++i) oacc[i] = oacc[i] * alpha;
        bf16x8 pf[2];
#pragma unroll
        for (int t2 = 0; t2 < 2; ++t2) { v4u w; w.x = cvtpk(s[2 * t2][0], s[2 * t2][1]); w.y = cvtpk(s[2 * t2][2], s[2 * t2][3]); w.z = cvtpk(s[2 * t2 + 1][0], s[2 * t2 + 1][1]); w.w = cvtpk(s[2 * t2 + 1][2], s[2 * t2 + 1][3]);
            pf[t2] = __builtin_bit_cast(bf16x8, w); }
        const int q4 = c >> 2, p4 = c & 3;
#pragma unroll
        for (int t2 = 0; t2 < 2; ++t2)
#pragma unroll
            for (int mo = 0; mo < 8; ++mo) {
                const int k1 = 32 * t2 + 4 * g + q4, k2 = k1 + 16, chn = 2 * mo + (p4 >> 1);
                const s16x4 lo = __builtin_bit_cast(s16x4, __builtin_amdgcn_ds_read_tr16_b64_v4i16((LAS s16x4*)(Vs + k1 * 256 + ((chn ^ ((k1 & 7) << 1)) << 4) + (p4 & 1) * 8)));
                const s16x4 hi = __builtin_bit_cast(s16x4, __builtin_amdgcn_ds_read_tr16_b64_v4i16((LAS s16x4*)(Vs + k2 * 256 + ((chn ^ ((k2 & 7) << 1)) << 4) + (p4 & 1) * 8)));
                const bf16x8 vf = (bf16x8){lo[0], lo[1], lo[2], lo[3], hi[0], hi[1], hi[2], hi[3]};
                oacc[mo] = __builtin_amdgcn_mfma_f32_16x16x32_bf16(vf, pf[t2], oacc[mo], 0, 0, 0); }
    }
    lsum += __shfl_xor(lsum, 16); lsum += __shfl_xor(lsum, 32);
    const float inv = 1.0f / lsum;
#pragma unroll
    for (int mo = 0; mo < 8; ++mo) { v2u w; w.x = cvtpk(oacc[mo][0] * inv, oacc[mo][1] * inv); w.y = cvtpk(oacc[mo][2] * inv, oacc[mo][3] * inv);
        *(v2u*)(O + (size_t)(qw0 + c) * opitch + 16 * mo + 4 * g) = w; }
}
__device__ __forceinline__ void swa_phase(Frame& F, int b0, int nb) {
    LAS float* btab = (LAS float*)(F.lds + RING_OFF + 32768);
    const bf16* QS = DOP(bf16, DO_QSW); const bf16* KV = DOP(bf16, DO_KVSW); bf16* Y = WSP(bf16, WS_XB);
    if ((int)blockIdx.x < b0) return;
    for (int u = blockIdx.x - b0; u < SWH * (SEQ / 128); u += nb) {
        const int h = u & 7, qb = u >> 3, kvh = h >> 2;
        __syncthreads();
        if (F.tid < 257) btab[F.tid] = F.in[11][t5_bucket(F.tid - 128) * 8 + h] * LOG2E;
        __syncthreads();
        int kb = 2 * qb - 2, ke = 2 * qb + 4; if (kb < 0) kb = 0; if (ke > SEQ / 64) ke = SEQ / 64;
        attn_unit<0>(F, QS + h * 128, 1024, KV + kvh * 128, KV + 256 + kvh * 128, 512, Y + 1024 + h * 128, DM, qb * 128, kb, ke, btab, F.in[10][h] * LOG2E);
    }
}
__device__ __forceinline__ void mem_attn_phase(Frame& F) {
    const bf16* QM = WSP(bf16, WS_QM); const bf16* KVm = WSP(bf16, WS_KVM); bf16* OM = WSP(bf16, WS_OM);
    for (int u = blockIdx.x; u < MEMH * (SEQ / 128); u += F.G) {
        const int h = u & 3, qb = u >> 2;
        attn_unit<1>(F, QM + h * 128, 512, KVm + h * 128, KVm + 512 + h * 128, 1024, OM + h * 128, 512, qb * 128, 0, 4, nullptr, 0.f);
    }
}

typedef float f32x16 __attribute__((ext_vector_type(16)));
constexpr int DX_W = 0, DX_K = 16384, DX_U = 32768, DX_Q = 49152, DX_A = 65536, DX_BYTES = 73728;
constexpr size_t WS_GL = 1 * MiB + 128 * 1024;
constexpr int L_RAW = 0, RAW_PITCH = 784, L_MTF = 0, L_MTB = 16384, L_TB = 32768, TB_PITCH = 144, TB_SZ = 9216;
constexpr int L_QB = 69632, L_KB = 86016, L_KT = 102400, L_VT = 120832, L_PART = 139264, L_SC = 143360;
static_assert(L_SC + 2048 <= LDSCTL_OFF, "prep LDS map");
__device__ __forceinline__ unsigned char* dnx_rec(Frame& F, int dir, int hd, int cn) { return F.ws + WS_DNX + (size_t)((dir * 8 + hd) * 256 + cn) * DX_BYTES; }
__device__ __forceinline__ v4u pack8f(const float* v) { v4u w; w.x = cvtpk(v[0], v[1]); w.y = cvtpk(v[2], v[3]); w.z = cvtpk(v[4], v[5]); w.w = cvtpk(v[6], v[7]); return w; }

__device__ __forceinline__ bf16x8 cvt8(const f32x16& v, int o) { v4u w; w.x = cvtpk(v[o], v[o + 1]); w.y = cvtpk(v[o + 2], v[o + 3]); w.z = cvtpk(v[o + 4], v[o + 5]); w.w = cvtpk(v[o + 6], v[o + 7]); return __builtin_bit_cast(bf16x8, w); }
__device__ __forceinline__ bf16x8 cvt8f(f32x4 a, f32x4 b) { v4u w; w.x = cvtpk(a[0], a[1]); w.y = cvtpk(a[2], a[3]); w.z = cvtpk(b[0], b[1]); w.w = cvtpk(b[2], b[3]); return __builtin_bit_cast(bf16x8, w); }
template <int dir> __device__ __forceinline__ void dn_solve_and_write(LAS unsigned char* lds, int lane) {
    const LAS float* MT = (const LAS float*)(lds + (dir ? L_MTB : L_MTF));
    LAS float* T0 = (LAS float*)(lds + L_TB + dir * 2 * TB_SZ);
    LAS float* Trow = T0 + lane * 68;
    const int blk = lane >> 5, cb = 32 * blk;
#pragma unroll 1
    for (int jr = 7; jr >= 0; --jr) {
        const int j0 = cb + 4 * jr;
        float a0 = (lane == j0) ? 1.f : 0.f, a1 = (lane == j0 + 1) ? 1.f : 0.f, a2 = (lane == j0 + 2) ? 1.f : 0.f, a3 = (lane == j0 + 3) ? 1.f : 0.f;
        const LAS float* mr = MT + j0 * 64;
#pragma unroll 1
        for (int sr = jr + 1; sr < 8; ++sr) {
            const int s0 = cb + 4 * sr;
            const f32x4 tv = *(const LAS f32x4*)(Trow + s0);
            const f32x4 m0 = *(const LAS f32x4*)(mr + s0), m1 = *(const LAS f32x4*)(mr + 64 + s0), m2 = *(const LAS f32x4*)(mr + 128 + s0), m3 = *(const LAS f32x4*)(mr + 192 + s0);
            a0 -= (tv[0] * m0[0] + tv[1] * m0[1]) + (tv[2] * m0[2] + tv[3] * m0[3]);
            a1 -= (tv[0] * m1[0] + tv[1] * m1[1]) + (tv[2] * m1[2] + tv[3] * m1[3]);
            a2 -= (tv[0] * m2[0] + tv[1] * m2[1]) + (tv[2] * m2[2] + tv[3] * m2[3]);
            a3 -= (tv[0] * m3[0] + tv[1] * m3[1]) + (tv[2] * m3[2] + tv[3] * m3[3]);
        }
        const f32x4 d0 = *(const LAS f32x4*)(mr + j0), d1 = *(const LAS f32x4*)(mr + 64 + j0), d2 = *(const LAS f32x4*)(mr + 128 + j0);
        const float t3 = a3, t2 = a2 - t3 * d2[3], t1 = a1 - t2 * d1[2] - t3 * d1[3], t0 = a0 - t1 * d0[1] - t2 * d0[2] - t3 * d0[3];
        *(LAS f32x4*)(Trow + j0) = (f32x4){t0, t1, t2, t3};
    }
    if (blk == 0) {
#pragma unroll
        for (int q = 8; q < 16; ++q) *(LAS f32x4*)(Trow + 4 * q) = (f32x4){0.f, 0.f, 0.f, 0.f}; }
    asm volatile("s_waitcnt lgkmcnt(0)" ::: "memory");
    {
        const int r = lane & 31, lh = lane >> 5;
        f32x16 Y;
#pragma unroll
        for (int e = 0; e < 16; ++e) Y[e] = 0.f;
#pragma unroll
        for (int kk = 0; kk < 2; ++kk) {
            float av[8], bv[8];
#pragma unroll
            for (int jj = 0; jj < 8; ++jj) { const int k = 16 * kk + 8 * lh + jj; av[jj] = MT[k * 64 + 32 + r]; bv[jj] = T0[k * 68 + r]; }
            Y = __builtin_amdgcn_mfma_f32_32x32x16_bf16(cvt8f((f32x4){av[0], av[1], av[2], av[3]}, (f32x4){av[4], av[5], av[6], av[7]}), cvt8f((f32x4){bv[0], bv[1], bv[2], bv[3]}, (f32x4){bv[4], bv[5], bv[6], bv[7]}), Y, 0, 0, 0);
        }
        f32x16 Z;
#pragma unroll
        for (int e = 0; e < 16; ++e) Z[e] = 0.f;
#pragma unroll
        for (int kk = 0; kk < 2; ++kk) {
            const f32x4 t0 = *(const LAS f32x4*)(T0 + (32 + r) * 68 + 32 + 16 * kk + 4 * lh), t1 = *(const LAS f32x4*)(T0 + (32 + r) * 68 + 32 + 16 * kk + 8 + 4 * lh);
            Z = __builtin_amdgcn_mfma_f32_32x32x16_bf16(cvt8f(t0, t1), cvt8(Y, 8 * kk), Z, 0, 0, 0);
        }
#pragma unroll
        for (int e = 0; e < 16; ++e) T0[(32 + (e & 3) + 8 * (e >> 2) + 4 * lh) * 68 + r] = -Z[e];
    }
    asm volatile("s_waitcnt lgkmcnt(0)" ::: "memory");
    f32x4 tr[16];
#pragma unroll
    for (int q = 0; q < 16; ++q) tr[q] = *(const LAS f32x4*)(Trow + 4 * q);
    asm volatile("s_waitcnt lgkmcnt(0)" ::: "memory");
    const LAS float* sc = (const LAS float*)(lds + L_SC);
    const LAS float* cU = sc + (dir ? 384 : 256); const LAS float* cW = sc + (dir ? 448 : 320);
    const int pos = dir ? 63 - lane : lane;
    LAS unsigned char* tu = lds + L_TB + dir * 2 * TB_SZ + pos * TB_PITCH; LAS unsigned char* tw = tu + TB_SZ;
#pragma unroll
    for (int q = 0; q < 8; ++q) {
        float u8[8], w8[8];
#pragma unroll
        for (int e = 0; e < 8; ++e) { const int s = 8 * q + e, sp = dir ? 63 - s : s; const float t = tr[sp >> 2][sp & 3]; u8[e] = t * cU[s]; w8[e] = t * cW[s]; }
        *(LAS v4u*)(tu + q * 16) = pack8f(u8); *(LAS v4u*)(tw + q * 16) = pack8f(w8);
    }
}

struct PrepRegs { v4u raw[7]; };
__device__ __forceinline__ void prep_load(Frame& F, int u, int tid, int lane, PrepRegs& R) {
    const int cn = u >> 3, hd = u & 7; const bf16* QKV = WSP(bf16, WS_QKV);
#pragma unroll
    for (int k = 0; k < 7; ++k) { const int ci = tid + 512 * k; const int row = ci / 48, cc = ci % 48, seg = cc >> 4, ch = (cc & 15) * 8, tok = 64 * cn - 2 + row;
        v4u v = (v4u){0u, 0u, 0u, 0u};
        if (ci < 68 * 48 && tok >= 0 && tok < SEQ) v = *(const v4u*)(QKV + (size_t)tok * 3072 + seg * 1024 + hd * 128 + ch);
        R.raw[k] = v; }
}
__device__ __forceinline__ void dn_prep_unit(Frame& F, int cn, int hd, PrepRegs& PR, int next_u) {
    LAS unsigned char* lds = F.lds; int tid = F.tid, lane = F.lane; const int wave = F.wave;
    asm volatile("" : "+v"(tid), "+v"(lane));
    LAS float* sc = (LAS float*)(lds + L_SC);
    __syncthreads();
    prep_load(F, cn * 8 + hd, tid, lane, PR);
#pragma unroll
    for (int k = 0; k < 7; ++k) { const int ci = tid + 512 * k; const int row = ci / 48, cc = ci % 48, seg = cc >> 4, ch = (cc & 15) * 8;
        if (ci < 68 * 48) *(LAS v4u*)(lds + L_RAW + row * RAW_PITCH + (seg * 128 + ch) * 2) = PR.raw[k]; }
    if (wave == 0) {
        const float* ab = WSP(float, WS_AB) + (size_t)(64 * cn + lane) * 32;
        const float bfv = 1.0f / (1.0f + __expf(-ab[hd])), bbv = 1.0f / (1.0f + __expf(-ab[8 + hd]));
        const float gf = -__expf(F.in[5][hd]) * softplusf(ab[16 + hd] + F.in[7][hd]), gb = -__expf(F.in[6][hd]) * softplusf(ab[24 + hd] + F.in[8][hd]);
        float Gf = gf, Gb = gb;
#pragma unroll
        for (int o = 1; o < 64; o <<= 1) { const float a = __shfl_up(Gf, o), b = __shfl_down(Gb, o); if (lane >= o) Gf += a; if (lane + o < 64) Gb += b; }
        sc[lane] = Gf; sc[64 + lane] = Gb; sc[128 + lane] = bfv; sc[192 + lane] = bbv;
        sc[256 + lane] = bfv; sc[320 + lane] = -bfv * __expf(Gf); sc[384 + lane] = bbv; sc[448 + lane] = -bbv * __expf(Gb);
        float* GL = WSP(float, WS_GL);
        if (lane == 63) GL[(0 * 8 + hd) * 256 + cn] = __expf(Gf);
        if (lane == 0) GL[(1 * 8 + hd) * 256 + cn] = __expf(Gb);
    }
    __syncthreads();
    asm volatile("" : "+v"(tid), "+v"(lane));
    {
        const int t = wave, pos = lane; const float* cw = F.in[4] + hd * 128 + 16 * t;
        float qv[16], kv[16], vv[16];
#pragma unroll
        for (int seg = 0; seg < 3; ++seg) {
            float a[16];
#pragma unroll
            for (int i = 0; i < 16; ++i) a[i] = 0.f;
#pragma unroll
            for (int j = 0; j < 5; ++j) {
                const LAS unsigned char* rp = lds + L_RAW + (pos + j) * RAW_PITCH + (seg * 128 + 16 * t) * 2;
                const v4u r0 = *(const LAS v4u*)rp, r1 = *(const LAS v4u*)(rp + 16);
                const float* w = cw + j * 3072 + seg * 1024;
#pragma unroll
                for (int i = 0; i < 4; ++i) { a[2 * i] += w[2 * i] * bflo(r0[i]); a[2 * i + 1] += w[2 * i + 1] * bfhi(r0[i]); a[8 + 2 * i] += w[8 + 2 * i] * bflo(r1[i]); a[8 + 2 * i + 1] += w[8 + 2 * i + 1] * bfhi(r1[i]); }
            }
#pragma unroll
            for (int i = 0; i < 16; ++i) { const float s = siluf(a[i]); if (seg == 0) qv[i] = s; else if (seg == 1) kv[i] = s; else vv[i] = s; }
        }
        float sq = 0.f, sk = 0.f;
#pragma unroll
        for (int i = 0; i < 16; ++i) { sq += qv[i] * qv[i]; sk += kv[i] * kv[i]; }
        LAS float* part = (LAS float*)(lds + L_PART);
        part[t * 64 + pos] = sq; part[512 + t * 64 + pos] = sk;
        __syncthreads();
        float tq = 0.f, tk = 0.f;
#pragma unroll
        for (int i = 0; i < 8; ++i) { tq += part[i * 64 + pos]; tk += part[512 + i * 64 + pos]; }
        const float rq = (1.0f / sqrtf(tq + 1e-6f)) * 0.08838834764831845f, rk = 1.0f / sqrtf(tk + 1e-6f);
#pragma unroll
        for (int i = 0; i < 16; ++i) { qv[i] *= rq; kv[i] *= rk; }
        *(LAS v4u*)(lds + L_QB + pos * 256 + (((2 * t) ^ (pos & 15)) << 4)) = pack8f(qv); *(LAS v4u*)(lds + L_QB + pos * 256 + (((2 * t + 1) ^ (pos & 15)) << 4)) = pack8f(qv + 8);
        *(LAS v4u*)(lds + L_KB + pos * 256 + (((2 * t) ^ (pos & 15)) << 4)) = pack8f(kv); *(LAS v4u*)(lds + L_KB + pos * 256 + (((2 * t + 1) ^ (pos & 15)) << 4)) = pack8f(kv + 8);
#pragma unroll
        for (int i = 0; i < 16; ++i) { *(LAS unsigned short*)(lds + L_KT + (16 * t + i) * TB_PITCH + pos * 2) = (unsigned short)f2bf(kv[i]); *(LAS unsigned short*)(lds + L_VT + (16 * t + i) * TB_PITCH + pos * 2) = (unsigned short)f2bf(vv[i]); }
        const float ef = __expf(sc[pos]), eb = __expf(sc[64 + pos]); const int mt = pos >> 5;
#pragma unroll
        for (int dir = 0; dir < 2; ++dir) { const float e = dir ? eb : ef; unsigned char* rec = dnx_rec(F, dir, hd, cn) + DX_Q;
#pragma unroll
            for (int lh = 0; lh < 2; ++lh) { float o8[8];
#pragma unroll
                for (int j = 0; j < 8; ++j) o8[j] = qv[8 * (j >> 2) + 4 * lh + (j & 3)] * e;
                *(v4u*)(rec + ((mt * 8 + t) * 64 + 32 * lh + (pos & 31)) * 16) = pack8f(o8); } }
    }
    __syncthreads();
    asm volatile("" : "+v"(tid), "+v"(lane));
    {
        const int r = lane & 31, lh = lane >> 5, x = wave & 3, ta = x >> 1, tb = x & 1;
        const LAS unsigned char* Ab = lds + L_KB + (32 * ta + r) * 256; const LAS unsigned char* Bb = lds + (wave < 4 ? L_KB : L_QB) + (32 * tb + r) * 256;
        f32x16 acc;
#pragma unroll
        for (int i = 0; i < 16; ++i) acc[i] = 0.f;
#pragma unroll
        for (int kk = 0; kk < 8; ++kk) { const int ch = ((2 * kk + lh) ^ (r & 15)) << 4;
            acc = __builtin_amdgcn_mfma_f32_32x32x16_bf16(*(const LAS bf16x8*)(Ab + ch), *(const LAS bf16x8*)(Bb + ch), acc, 0, 0, 0); }
        const int b = 32 * tb + r;
        if (wave < 4) {
            const float Gfb = sc[b], Gbb = sc[64 + b];
#pragma unroll
            for (int q = 0; q < 4; ++q) { const int a0 = 32 * ta + 8 * q + 4 * lh; f32x4 mf, mb;
#pragma unroll
                for (int e = 0; e < 4; ++e) { const int a = a0 + e; const float kkv = acc[4 * q + e];
                    const float vf = sc[128 + a] * kkv * __expf(fminf(sc[a] - Gfb, 0.f)), vb = sc[192 + a] * kkv * __expf(fminf(sc[64 + a] - Gbb, 0.f));
                    mf[e] = (a > b) ? vf : 0.f; mb[3 - e] = (a < b) ? vb : 0.f; }
                *(LAS f32x4*)(lds + L_MTF + (b * 64 + a0) * 4) = mf; *(LAS f32x4*)(lds + L_MTB + ((63 - b) * 64 + 60 - a0) * 4) = mb; }
        } else {
            const float Gfc = sc[b], Gbc = sc[64 + b];
#pragma unroll
            for (int dir = 0; dir < 2; ++dir) { unsigned char* rec = dnx_rec(F, dir, hd, cn) + DX_A;
#pragma unroll
                for (int s2 = 0; s2 < 2; ++s2) { float o8[8];
#pragma unroll
                    for (int j = 0; j < 8; ++j) { const int s = 32 * ta + 16 * s2 + 8 * (j >> 2) + 4 * lh + (j & 3); const float v = acc[8 * s2 + j];
                        const float ev = v * __expf(fminf(dir ? Gbc - sc[64 + s] : Gfc - sc[s], 0.f)); o8[j] = (dir ? (s >= b) : (s <= b)) ? ev : 0.f; }
                    *(v4u*)(rec + ((tb * 4 + 2 * ta + s2) * 64 + lane) * 16) = pack8f(o8); } }
        }
    }
    __syncthreads();
    asm volatile("" : "+v"(tid), "+v"(lane));
    if (wave == 0) dn_solve_and_write<0>(lds, lane);
    else if (wave == 1) dn_solve_and_write<1>(lds, lane);
    else {
        const int r = lane & 31, lh = lane >> 5;
        for (int f = wave - 2; f < 32; f += 6) { const int dir = f >> 4, m = (f >> 2) & 3, t = f & 3; const int dk = 32 * m + r;
            const v2u k0 = *(const LAS v2u*)(lds + L_KT + dk * TB_PITCH + (16 * t + 4 * lh) * 2), k1 = *(const LAS v2u*)(lds + L_KT + dk * TB_PITCH + (16 * t + 8 + 4 * lh) * 2);
            const float Gl = dir ? sc[64] : sc[63]; const LAS float* Gs = sc + (dir ? 64 : 0) + 16 * t + 4 * lh; float o8[8];
            o8[0] = bflo(k0.x) * __expf(Gl - Gs[0]); o8[1] = bfhi(k0.x) * __expf(Gl - Gs[1]); o8[2] = bflo(k0.y) * __expf(Gl - Gs[2]); o8[3] = bfhi(k0.y) * __expf(Gl - Gs[3]);
            o8[4] = bflo(k1.x) * __expf(Gl - Gs[8]); o8[5] = bfhi(k1.x) * __expf(Gl - Gs[9]); o8[6] = bflo(k1.y) * __expf(Gl - Gs[10]); o8[7] = bfhi(k1.y) * __expf(Gl - Gs[11]);
            *(v4u*)(dnx_rec(F, dir, hd, cn) + DX_K + ((m * 4 + t) * 64 + lane) * 16) = pack8f(o8); }
    }
    __syncthreads();
    asm volatile("" : "+v"(tid), "+v"(lane));
    {
        const int dir = wave >> 2, x = wave & 3, r = lane & 31, lh = lane >> 5;
        const LAS unsigned char* Tu = lds + L_TB + (dir ? 2 : 0) * TB_SZ; const LAS unsigned char* Tw = Tu + TB_SZ;
        unsigned char* rec = dnx_rec(F, dir, hd, cn);
#pragma unroll
        for (int mt = 0; mt < 2; ++mt) {
            f32x16 aw, au;
#pragma unroll
            for (int i = 0; i < 16; ++i) { aw[i] = 0.f; au[i] = 0.f; }
#pragma unroll
            for (int kk = 0; kk < 4; ++kk) { const int so = (16 * kk + 8 * lh) * 2;
                aw = __builtin_amdgcn_mfma_f32_32x32x16_bf16(*(const LAS bf16x8*)(lds + L_KT + (32 * x + r) * TB_PITCH + so), *(const LAS bf16x8*)(Tw + (32 * mt + r) * TB_PITCH + so), aw, 0, 0, 0);
                au = __builtin_amdgcn_mfma_f32_32x32x16_bf16(*(const LAS bf16x8*)(Tu + (32 * mt + r) * TB_PITCH + so), *(const LAS bf16x8*)(lds + L_VT + (32 * x + r) * TB_PITCH + so), au, 0, 0, 0); }
            float tmp[16];
#pragma unroll
            for (int i = 0; i < 16; ++i) tmp[i] = aw[i];
            *(v4u*)(rec + DX_W + ((mt * 8 + 2 * x) * 64 + lane) * 16) = pack8f(tmp); *(v4u*)(rec + DX_W + ((mt * 8 + 2 * x + 1) * 64 + lane) * 16) = pack8f(tmp + 8);
#pragma unroll
            for (int i = 0; i < 16; ++i) tmp[i] = au[i];
            *(v4u*)(rec + DX_U + ((x * 2 + mt) * 64 + lane) * 32) = pack8f(tmp); *(v4u*)(rec + DX_U + ((x * 2 + mt) * 64 + lane) * 32 + 16) = pack8f(tmp + 8);
        }
    }
}
__device__ __forceinline__ void dn_prep_phase(Frame& F) {
    PrepRegs PR; int u = blockIdx.x;
    for (; u < 256 * DNH; u += F.G) dn_prep_unit(F, u >> 3, u & 7, PR, u + F.G);
}


constexpr int NSEG = 16, SEGL = 16;
constexpr size_t WS_PF = 176 * MiB, WS_RG = 184 * MiB, WS_SIN = 24 * MiB;
constexpr int SLOT1 = 49152, SLOT3 = 73728, L_GLS = 147456;
#define DN_WAIT(V) asm volatile("s_waitcnt vmcnt(" #V ") lgkmcnt(0)" ::: "memory")
#define DN_BAR() do { __builtin_amdgcn_s_barrier(); asm volatile("" ::: "memory"); } while (0)
__device__ __forceinline__ int seg_chunk(int dir, int g, int i) { const int n = SEGL * g + i; return dir ? 255 - n : n; }
__device__ __forceinline__ void u_to_acc(f32x16& a, const LAS unsigned char* up) {
    const v4u u0 = *(const LAS v4u*)up, u1 = *(const LAS v4u*)(up + 16);
#pragma unroll
    for (int i = 0; i < 4; ++i) { a[2 * i] = bflo(u0[i]); a[2 * i + 1] = bfhi(u0[i]); a[8 + 2 * i] = bflo(u1[i]); a[8 + 2 * i + 1] = bfhi(u1[i]); }
}
template <bool OUT>
__device__ __forceinline__ void dn_step(f32x16 (&S)[4], f32x16 (&aV)[2], f32x16 (&aO)[2], const LAS unsigned char* buf, float gl) {
#pragma unroll
    for (int t = 0; t < 8; ++t) { const bf16x8 sb = cvt8(S[t >> 1], 8 * (t & 1));
#pragma unroll
        for (int mt = 0; mt < 2; ++mt) {
            aV[mt] = __builtin_amdgcn_mfma_f32_32x32x16_bf16(*(const LAS bf16x8*)(buf + DX_W + (mt * 8 + t) * 1024), sb, aV[mt], 0, 0, 0);
            if (OUT) aO[mt] = __builtin_amdgcn_mfma_f32_32x32x16_bf16(*(const LAS bf16x8*)(buf + DX_Q + (mt * 8 + t) * 1024), sb, aO[mt], 0, 0, 0); } }
    bf16x8 vb[4];
#pragma unroll
    for (int t = 0; t < 4; ++t) vb[t] = cvt8(aV[t >> 1], 8 * (t & 1));
#pragma unroll
    for (int m = 0; m < 4; ++m) S[m] = S[m] * gl;
#pragma unroll
    for (int t = 0; t < 4; ++t) {
#pragma unroll
        for (int m = 0; m < 4; ++m) S[m] = __builtin_amdgcn_mfma_f32_32x32x16_bf16(*(const LAS bf16x8*)(buf + DX_K + (m * 4 + t) * 1024), vb[t], S[m], 0, 0, 0);
        if (OUT) {
#pragma unroll
            for (int mt = 0; mt < 2; ++mt) aO[mt] = __builtin_amdgcn_mfma_f32_32x32x16_bf16(*(const LAS bf16x8*)(buf + DX_A + (mt * 4 + t) * 1024), vb[t], aO[mt], 0, 0, 0); } }
}

__device__ __forceinline__ void dn_pass1(Frame& F) {
    LAS unsigned char* lds = F.lds; const int lane = F.lane, wave = F.wave, r = lane & 31, lh = lane >> 5, part = wave >> 2, d = wave & 3;
    LAS float* gls = (LAS float*)(lds + L_GLS);
    for (int unit = blockIdx.x; unit < 16 * NSEG; unit += F.G) {
        const int dir = unit >> 7, hd = (unit >> 4) & 7, g = unit & 15;
        DN_WAIT(0); __syncthreads();
        if (F.tid < SEGL) gls[F.tid] = WSP(float, WS_GL)[(dir * 8 + hd) * 256 + seg_chunk(dir, g, F.tid)];
        DN_WAIT(0);
        f32x16 S[4];
#pragma unroll
        for (int m = 0; m < 4; ++m)
#pragma unroll
            for (int i = 0; i < 16; ++i) S[m][i] = (part && (32 * m + (i & 3) + 8 * (i >> 2) + 4 * lh == 32 * d + r)) ? 1.f : 0.f;
#define P1_ISSUE(i) do { const unsigned char* src_ = dnx_rec(F, dir, hd, seg_chunk(dir, g, (i))) + lane * 16; LAS unsigned char* dst_ = lds + ((i) % 3) * SLOT1; \
            _Pragma("unroll") for (int k_ = 0; k_ < 6; ++k_) { const int p_ = wave + 8 * k_; __builtin_amdgcn_global_load_lds((const unsigned*)(src_ + p_ * 1024), (LAS unsigned*)(dst_ + p_ * 1024), 16, 0, 0); } } while (0)
        P1_ISSUE(0); P1_ISSUE(1);
        for (int i = 0; i < SEGL; ++i) {
            if (i + 1 < SEGL) DN_WAIT(6); else DN_WAIT(0);
            DN_BAR();
            if (i + 2 < SEGL) P1_ISSUE(i + 2);
            const LAS unsigned char* buf = lds + (i % 3) * SLOT1 + lane * 16;
            f32x16 aV[2], aO[2];
#pragma unroll
            for (int mt = 0; mt < 2; ++mt) {
                if (part == 0) u_to_acc(aV[mt], lds + (i % 3) * SLOT1 + DX_U + ((d * 2 + mt) * 64 + lane) * 32);
                else {
#pragma unroll
                    for (int e = 0; e < 16; ++e) aV[mt][e] = 0.f; } }
            dn_step<false>(S, aV, aO, buf, gls[i]);
        }
#undef P1_ISSUE
        DN_WAIT(0); DN_BAR();
        if (part == 0) {
            float* rg = (float*)(F.ws + WS_RG) + (size_t)unit * 16384;
#pragma unroll
            for (int m = 0; m < 4; ++m)
#pragma unroll
                for (int q = 0; q < 4; ++q) *(f32x4*)(rg + ((d * 4 + m) * 64 + lane) * 16 + 4 * q) = (f32x4){S[m][4 * q], S[m][4 * q + 1], S[m][4 * q + 2], S[m][4 * q + 3]};
        } else {
#pragma unroll
            for (int m = 0; m < 4; ++m)
#pragma unroll
                for (int i = 0; i < 16; ++i) *(LAS unsigned short*)(lds + (32 * m + (i & 3) + 8 * (i >> 2) + 4 * lh) * 272 + (32 * d + r) * 2) = (unsigned short)f2bf(S[m][i]);
        }
        DN_WAIT(0); DN_BAR();
        if (part == 1) {
            unsigned char* pf = F.ws + WS_PF + (size_t)unit * 32768;
#pragma unroll
            for (int k = 0; k < 8; ++k) { const int f = d * 8 + k, m = f >> 3, t = f & 7;
                const v2u a = *(const LAS v2u*)(lds + (32 * m + r) * 272 + (16 * t + 4 * lh) * 2), b = *(const LAS v2u*)(lds + (32 * m + r) * 272 + (16 * t + 8 + 4 * lh) * 2);
                *(v4u*)(pf + (f * 64 + lane) * 16) = (v4u){a.x, a.y, b.x, b.y}; }
        }
    }
}
__device__ __forceinline__ void dn_fold(Frame& F) {
    const int b = blockIdx.x; if (b >= 16) return;
    LAS unsigned char* lds = F.lds; const int lane = F.lane, wave = F.wave, dir = b >> 3, hd = b & 7;
    const int unit0 = (dir * 8 + hd) * 16;
    __syncthreads();
    if (wave >= 4) {
        const int lw = wave - 4;
        for (int g = 0; g < NSEG; ++g) {
            if (g < NSEG - 1) { const unsigned char* src = F.ws + WS_PF + (size_t)(unit0 + g) * 32768 + lane * 16; LAS unsigned char* dst = lds + (g & 1) * 32768;
#pragma unroll
                for (int k = 0; k < 8; ++k) { const int p = lw + 4 * k; __builtin_amdgcn_global_load_lds((const unsigned*)(src + p * 1024), (LAS unsigned*)(dst + p * 1024), 16, 0, 0); } }
            DN_WAIT(0); DN_BAR();
        }
    } else {
        const int d = wave;
        f32x16 S[4], R[4];
#pragma unroll
        for (int m = 0; m < 4; ++m)
#pragma unroll
            for (int i = 0; i < 16; ++i) S[m][i] = 0.f;
        const float* rg0 = (const float*)(F.ws + WS_RG) + (size_t)unit0 * 16384; float* sin0 = (float*)(F.ws + WS_SIN) + (size_t)unit0 * 16384;
#pragma unroll
        for (int m = 0; m < 4; ++m)
#pragma unroll
            for (int q = 0; q < 4; ++q) { const f32x4 v = *(const f32x4*)(rg0 + ((d * 4 + m) * 64 + lane) * 16 + 4 * q); R[m][4 * q] = v[0]; R[m][4 * q + 1] = v[1]; R[m][4 * q + 2] = v[2]; R[m][4 * q + 3] = v[3]; }
        DN_BAR();
        for (int g = 0; g < NSEG; ++g) {
            float* so = sin0 + (size_t)g * 16384;
#pragma unroll
            for (int m = 0; m < 4; ++m)
#pragma unroll
                for (int q = 0; q < 4; ++q) *(f32x4*)(so + ((d * 4 + m) * 64 + lane) * 16 + 4 * q) = (f32x4){S[m][4 * q], S[m][4 * q + 1], S[m][4 * q + 2], S[m][4 * q + 3]};
            if (g == NSEG - 1) break;
            const LAS unsigned char* buf = lds + (g & 1) * 32768 + lane * 16;
            bf16x8 sb[8];
#pragma unroll
            for (int t = 0; t < 8; ++t) sb[t] = cvt8(S[t >> 1], 8 * (t & 1));
#pragma unroll
            for (int m = 0; m < 4; ++m) { S[m] = R[m];
#pragma unroll
                for (int t = 0; t < 8; ++t) S[m] = __builtin_amdgcn_mfma_f32_32x32x16_bf16(*(const LAS bf16x8*)(buf + (m * 8 + t) * 1024), sb[t], S[m], 0, 0, 0); }
            if (g + 1 < NSEG - 1) { const float* rg = rg0 + (size_t)(g + 1) * 16384;
#pragma unroll
                for (int m = 0; m < 4; ++m)
#pragma unroll
                    for (int q = 0; q < 4; ++q) { const f32x4 v = *(const f32x4*)(rg + ((d * 4 + m) * 64 + lane) * 16 + 4 * q); R[m][4 * q] = v[0]; R[m][4 * q + 1] = v[1]; R[m][4 * q + 2] = v[2]; R[m][4 * q + 3] = v[3]; } }
            asm volatile("s_waitcnt lgkmcnt(0)" ::: "memory");
            DN_BAR();
        }
    }
    __syncthreads();
}
__device__ __forceinline__ void dn_pass3(Frame& F) {
    LAS unsigned char* lds = F.lds; const int lane = F.lane, wave = F.wave, r = lane & 31, lh = lane >> 5;
    LAS float* gls = (LAS float*)(lds + L_GLS);
    for (int unit = blockIdx.x; unit < 16 * NSEG; unit += F.G) {
        const int dir = unit >> 7, hd = (unit >> 4) & 7, g = unit & 15;
        __syncthreads();
        if (F.tid < SEGL) gls[F.tid] = WSP(float, WS_GL)[(dir * 8 + hd) * 256 + seg_chunk(dir, g, F.tid)];
        asm volatile("s_waitcnt lgkmcnt(0)" ::: "memory");
        if (wave >= 4) {
            const int lw = wave - 4;
            for (int i = 0; i <= SEGL; ++i) {
                if (i < SEGL) { const unsigned char* src = dnx_rec(F, dir, hd, seg_chunk(dir, g, i)) + lane * 16; LAS unsigned char* dst = lds + (i & 1) * SLOT3;
#pragma unroll
                    for (int k = 0; k < 18; ++k) { const int p = lw + 4 * k; __builtin_amdgcn_global_load_lds((const unsigned*)(src + p * 1024), (LAS unsigned*)(dst + p * 1024), 16, 0, 0); } }
                DN_WAIT(0); DN_BAR();
            }
        } else {
            const int d = wave;
            f32x16 S[4];
            const float* si = (const float*)(F.ws + WS_SIN) + (size_t)unit * 16384;
#pragma unroll
            for (int m = 0; m < 4; ++m)
#pragma unroll
                for (int q = 0; q < 4; ++q) { const f32x4 v = *(const f32x4*)(si + ((d * 4 + m) * 64 + lane) * 16 + 4 * q); S[m][4 * q] = v[0]; S[m][4 * q + 1] = v[1]; S[m][4 * q + 2] = v[2]; S[m][4 * q + 3] = v[3]; }
            bf16* O = WSP(bf16, dir ? WS_OB : WS_OF);
            DN_BAR();
            for (int i = 0; i < SEGL; ++i) {
                const int cn = seg_chunk(dir, g, i); const LAS unsigned char* slot = lds + (i & 1) * SLOT3;
                f32x16 aV[2], aO[2];
#pragma unroll
                for (int mt = 0; mt < 2; ++mt) { u_to_acc(aV[mt], slot + DX_U + ((d * 2 + mt) * 64 + lane) * 32);
#pragma unroll
                    for (int e = 0; e < 16; ++e) aO[mt][e] = 0.f; }
                dn_step<true>(S, aV, aO, slot + lane * 16, gls[i]);
                bf16* op = O + (size_t)(64 * cn + 4 * lh) * 1024 + hd * 128 + 32 * d + r;
#pragma unroll
                for (int mt = 0; mt < 2; ++mt)
#pragma unroll
                    for (int e = 0; e < 16; ++e) op[(size_t)(32 * mt + (e & 3) + 8 * (e >> 2)) * 1024] = (bf16)f2bf(aO[mt][e]);
                asm volatile("s_waitcnt lgkmcnt(0)" ::: "memory");
                DN_BAR();
            }
        }
    }
    __syncthreads();
}

#ifndef MK_N_LAUNCHES
#define MK_N_LAUNCHES 1
#endif
constexpr int N_PHASES = 14;
struct Args { const float* in[23]; float* out; unsigned char* ws; int ph_lo, ph_hi; };
static_assert(sizeof(Args) == 23 * 8 + 8 + 8 + 8, "Args has no padding");

__global__ void __launch_bounds__(NWAVES * 64, 2) enc_fwd(Args args) {
    extern __shared__ __attribute__((aligned(16))) unsigned char lds[];
    Frame F;
    F.lds = (LAS unsigned char*)lds;
    F.MISC = (volatile LAS unsigned*)(F.lds + MISC_OFF);
    F.tid = threadIdx.x; F.lane = F.tid & 63; F.wave = __builtin_amdgcn_readfirstlane(F.tid >> 6);
    F.G = gridDim.x; { const int bx = blockIdx.x; F.vcu = (F.G % 8 == 0) ? (bx % 8) * (F.G / 8) + bx / 8 : bx; }
#pragma unroll
    for (int i = 0; i < 23; ++i) F.in[i] = args.in[i];
    F.out = args.out; F.ws = args.ws; F.ctl = (gu32*)(args.ws + WS_CTL);
    for (int u = F.tid; u < (LDS_BYTES - LDSCTL_OFF) / 4; u += NWAVES * 64) ((LAS unsigned*)(F.lds + LDSCTL_OFF))[u] = 0u;
    __syncthreads();
    const int lo = args.ph_lo, hi = args.ph_hi;
    XcdBarrier bar; bar.bar = (unsigned*)(F.ctl + CW_BAR); bar.x = 0; bar.st = nullptr;
    if (hi - lo > 1) bar = xcd_barrier_post((unsigned*)(F.ctl + CW_BAR), F.MISC + 8);
#define IN(k) (lo <= (k) && (k) < hi)
#define SEAM(k) do { if (IN(k) && IN((k) + 1)) xcd_barrier(bar); } while (0)
    float* sumsq2 = (float*)(F.ws + WS_CTL + CTL_SUMSQ2); float* sumsq3 = (float*)(F.ws + WS_CTL + CTL_SUMSQ3); float* sumsq4 = (float*)(F.ws + WS_CTL + CTL_SUMSQ4);

    if (IN(0)) { p0_prologue(F);
#if defined(REPEAT_PHASE) && REPEAT_PHASE == 0
        p0_prologue(F);
#endif
    } SEAM(0);
    if (IN(1)) {
        { pg8::Gemm g{WSP(bf16, WS_XB), WSP(bf16, WS_WIN), SEQ, NINP, DM}; pg8::StaticOrder S; S.init(SEQ, NINP, F.G, (int)blockIdx.x);
          EpiProj E{WSP(float, WS_RSTD1), WSP(bf16, WS_QKV), DOP(bf16, DO_Z), DOP(bf16, DO_QSW), DOP(bf16, DO_KVSW), WSP(float, WS_AB)};
          pg8::gemm_phase<EpiProj, pg8::StaticOrder, true, true>(F.lds + RING_OFF, g, S, E); }
        { pg8::Gemm g{WSP(bf16, WS_MEMB), WSP(bf16, WS_WKV), MEMT, 1024, DM}; pg8::StaticOrder S; S.init(MEMT, 1024, F.G, (int)blockIdx.x);
          EpiScaleBf16 E{WSP(float, WS_RSTDM), 0, 1.0f, WSP(bf16, WS_KVM), 1024};
          pg8::gemm_phase<EpiScaleBf16, pg8::StaticOrder, true, true>(F.lds + RING_OFF, g, S, E); }
    } SEAM(1);
    if (IN(2)) { dn_prep_phase(F);
#ifdef REPEAT_PREP
        dn_prep_phase(F);
#endif
    } SEAM(2);
    if (IN(3)) { dn_pass1(F);
#if defined(REPEAT_PHASE) && REPEAT_PHASE == 3
        dn_pass1(F);
#endif
    } SEAM(3);
    if (IN(12)) { dn_fold(F); if (F.G > 16) swa_phase(F, 16, F.G - 16); else swa_phase(F, 0, F.G); }
    if (IN(12) && IN(13)) xcd_barrier(bar);
    if (IN(13)) { dn_pass3(F);
#if defined(REPEAT_PHASE) && REPEAT_PHASE == 13
        dn_pass3(F);
#endif
    } if (IN(13) && IN(4)) xcd_barrier(bar);
    if (IN(4)) { dn_combine(F); p4_transposes(F);
#if defined(REPEAT_PHASE) && REPEAT_PHASE == 4
        dn_combine(F); p4_transposes(F);
#endif
    } SEAM(4);
    if (IN(5)) {
        pg8::Gemm g{WSP(bf16, WS_XB), WSP(bf16, WS_WOUT), SEQ, DM, DM}; pg8::StaticOrder S; S.init(SEQ, DM, F.G, (int)blockIdx.x);
        EpiRes E{F.in[0], F.out, WSP(bf16, WS_H1B), sumsq2};
        pg8::gemm_phase<EpiRes, pg8::StaticOrder, true, true>(F.lds + RING_OFF, g, S, E);
    } SEAM(5);
    if (IN(6)) {
        pg8::Gemm g{WSP(bf16, WS_H1B), WSP(bf16, WS_WQ), SEQ, 512, DM}; pg8::StaticOrder S; S.init(SEQ, 512, F.G, (int)blockIdx.x);
        EpiScaleBf16 E{sumsq2, 1, QSCALE, WSP(bf16, WS_QM), 512};
        pg8::gemm_phase<EpiScaleBf16, pg8::StaticOrder, true, true>(F.lds + RING_OFF, g, S, E);
    } SEAM(6);
    if (IN(7)) { mem_attn_phase(F);
#if defined(REPEAT_PHASE) && REPEAT_PHASE == 7
        mem_attn_phase(F);
#endif
    } SEAM(7);
    if (IN(8)) {
        pg8::Gemm g{WSP(bf16, WS_OM), WSP(bf16, WS_WO), SEQ, DM, 512}; pg8::StaticOrder S; S.init(SEQ, DM, F.G, (int)blockIdx.x);
        EpiRes E{F.out, F.out, WSP(bf16, WS_XB), sumsq3};
        pg8::gemm_phase<EpiRes, pg8::StaticOrder, true, true>(F.lds + RING_OFF, g, S, E);
    } SEAM(8);
    if (IN(9)) {
        pg8::Gemm g{WSP(bf16, WS_XB), WSP(bf16, WS_WGU), SEQ, 2 * DFF, DM}; pg8::StaticOrder S; S.init(SEQ, 2 * DFF, F.G, (int)blockIdx.x);
        EpiSwiglu E{sumsq3, WSP(bf16, WS_HID)};
        pg8::gemm_phase<EpiSwiglu, pg8::StaticOrder, true, true>(F.lds + RING_OFF, g, S, E);
#if defined(REPEAT_PHASE) && REPEAT_PHASE == 9
        pg8::gemm_phase<EpiSwiglu, pg8::StaticOrder, true, true>(F.lds + RING_OFF, g, S, E);
#endif
    } SEAM(9);
    if (IN(10)) {
        pg8::Gemm g{WSP(bf16, WS_HID), WSP(bf16, WS_WD), SEQ, DM, DFF}; pg8::StaticOrder S; S.init(SEQ, DM, F.G, (int)blockIdx.x);
        EpiRes E{F.out, nullptr, WSP(bf16, WS_H3B), sumsq4};
        pg8::gemm_phase<EpiRes, pg8::StaticOrder, true, true>(F.lds + RING_OFF, g, S, E);
    } SEAM(10);
    if (IN(11)) { final_norm(F);
#if defined(REPEAT_PHASE) && REPEAT_PHASE == 11
        final_norm(F);
#endif
    }
#undef IN
#undef SEAM
}

extern "C" void kernel_launch(void* const* d_in, const int* in_sizes, int n_in, void* d_out, int out_size, void* d_ws, size_t ws_size, hipStream_t stream) {
    static int grid = 0;
    if (grid == 0) {
        if (n_in != 23 || out_size != SEQ * DM || ws_size < WS_END) { fprintf(stderr, "kernel_launch: unexpected shapes (n_in %d out %d ws %zu)\n", n_in, out_size, ws_size); grid = -1; return; }
        int dev = 0, cus = 0;
        if (hipGetDevice(&dev) != hipSuccess || hipDeviceGetAttribute(&cus, hipDeviceAttributeMultiprocessorCount, dev) != hipSuccess) { grid = -1; return; }
        if (hipFuncSetAttribute((const void*)enc_fwd, hipFuncAttributeMaxDynamicSharedMemorySize, LDS_BYTES) != hipSuccess) { fprintf(stderr, "kernel_launch: hipFuncSetAttribute failed\n"); grid = -1; return; }
        (void)hipGetLastError();
        grid = cus;
    }
    if (grid < 0) return;
    if (hipMemsetAsync((char*)d_ws + WS_CTL, 0, CTL_ZERO_BYTES, stream) != hipSuccess) return;
    Args a{};
    for (int i = 0; i < 23; ++i) a.in[i] = (const float*)d_in[i];
    a.out = (float*)d_out; a.ws = (unsigned char*)d_ws;
    const int per = (N_PHASES + MK_N_LAUNCHES - 1) / MK_N_LAUNCHES;
    for (int lo = 0; lo < N_PHASES; lo += per) {
        a.ph_lo = lo; a.ph_hi = (lo + per < N_PHASES) ? lo + per : N_PHASES;
        hipLaunchKernelGGL(enc_fwd, dim3(grid), dim3(NWAVES * 64), LDS_BYTES, stream, a);
    }
}
```

```cpp
#include <hip/hip_runtime.h>
#include <cstdio>
#include <cstdint>
namespace pg8 {
__device__ __forceinline__ unsigned cvt_pk_bf16(float lo, float hi) { unsigned r; asm volatile("v_cvt_pk_bf16_f32 %0, %1, %2" : "=v"(r) : "v"(lo), "v"(hi)); return r; }
#define PG8_LAS __attribute__((address_space(3)))
typedef unsigned short bf16_t;
typedef short bf16x8 __attribute__((ext_vector_type(8)));
typedef float f32x4 __attribute__((ext_vector_type(4)));
typedef unsigned u32x4 __attribute__((ext_vector_type(4)));
constexpr int BM = 256, BK = 64, HALF = 128, HTB = HALF * BK * 2  , STAGE_BYTES = 8 * HTB, NXCD = 8, WGM = 8;

__host__ __device__ __forceinline__ int lds_byte(int r, int c) { const int st = (r >> 4) * 2 + (c >> 5), rr = r & 15, cc = c & 31, ob = rr * 64 + cc * 2; return st * 1024 + (ob ^ (((ob >> 9) & 1) << 5)); }
__host__ __device__ __forceinline__ void stage_rc(int b, int& R, int& C) { const int st = b / 1024, sb = b % 1024, swz = sb ^ (((sb >> 9) & 1) << 5); R = (st >> 1) * 16 + swz / 64; C = (st & 1) * 32 + (swz % 64) / 2; }
__host__ __device__ __forceinline__ int perm32(int rho) { const int n = rho >> 4, i = rho & 15; return 8 * (i >> 2) + 4 * n + (i & 3); }

struct Unit { int pm, pn; };
struct Gemm { const bf16_t* A; const bf16_t* Bt; int M, N, K; };

struct StaticOrder {
    int nM, nN, nwg, G, c;
    __host__ __device__ void init(int M, int N, int G_, int c_) { nM = M / BM; nN = N / BM; nwg = nM * nN; G = G_; c = c_; }
    __host__ __device__ bool next(int i, Unit& u) const {
        const long L = (long)i * G + c; if (L >= nwg) return false;
        int wgid = (int)L; { const int q = nwg / NXCD, r = nwg % NXCD, xcd = wgid % NXCD, off = wgid / NXCD; wgid = (xcd < r ? xcd * (q + 1) : r * (q + 1) + (xcd - r) * q) + off; }
        const int nig = WGM * nN, gid = wgid / nig, fm = gid * WGM, gsz = (nM - fm) < WGM ? (nM - fm) : WGM;
        u.pm = fm + ((wgid % nig) % gsz); u.pn = (wgid % nig) / gsz; return true;
    }
    __device__ __forceinline__ void a_ready(const Unit&) const {}
    __device__ __forceinline__ void done(const Unit&) const {}
};

template <class Epi, class Sched, bool ALIGN_EPI = false, bool SP2 = false>
__device__ __forceinline__ void gemm_phase(PG8_LAS unsigned char* lds, const Gemm g, const Sched& S, const Epi& E) {
    const int tid = threadIdx.x, wid = __builtin_amdgcn_readfirstlane(tid >> 6), lane = tid & 63, wr = wid >> 2, wc = wid & 3, fr = lane & 15, fq = lane >> 4;
    const int K = g.K, nt = K / BK;
    unsigned voffA[2], voffB[2];
#pragma unroll
    for (int i = 0; i < 2; ++i) { int R, C; stage_rc(tid * 16 + i * 8192, R, C); const int Rb = Epi::PERM ? ((R & ~31) + perm32(R & 31)) : R;
        voffA[i] = (unsigned)(R * K + C) * 2u; voffB[i] = (unsigned)(Rb * K + C) * 2u; }
    const size_t kstep = (size_t)(BK * 2);
    const size_t hstep = (size_t)HALF * K * 2;
    const size_t tstep = 2 * hstep;
    const unsigned ldsw = (unsigned)wid * 1024u;
    const int aoff = lds_byte(wr * 64 + fr, fq * 8), boff = lds_byte(wc * 32 + fr, fq * 8);
#define PG8_SA(b, h) (((b) * 2 + (h)) * HTB)
#define PG8_SB(b, h) ((4 + (b) * 2 + (h)) * HTB)
#define PG8_STAGE(bufoff, gbase, voff) do { _Pragma("unroll") for (int _i = 0; _i < 2; ++_i) \
        __builtin_amdgcn_global_load_lds((const unsigned*)((const char*)(gbase) + (voff)[_i]), (PG8_LAS unsigned*)(lds + (bufoff) + ldsw + _i * 8192), 16, 0, 0); } while (0)
#define PG8_LDA(dst, b, h) do { _Pragma("unroll") for (int m = 0; m < 4; ++m) _Pragma("unroll") for (int k = 0; k < 2; ++k) dst[m][k] = *(const PG8_LAS bf16x8*)(lds + PG8_SA(b, h) + aoff + m * 2048 + k * 1024); } while (0)
#define PG8_LDB(dst, b, h) do { _Pragma("unroll") for (int n = 0; n < 2; ++n) _Pragma("unroll") for (int k = 0; k < 2; ++k) dst[n][k] = *(const PG8_LAS bf16x8*)(lds + PG8_SB(b, h) + boff + n * 2048 + k * 1024); } while (0)
#define PG8_MMA(ai, bj, At, Bt) do { __builtin_amdgcn_s_setprio(1); _Pragma("unroll") for (int m = 0; m < 4; ++m) _Pragma("unroll") for (int n = 0; n < 2; ++n) _Pragma("unroll") for (int k = 0; k < 2; ++k) \
        acc[ai][bj][m][n] = __builtin_amdgcn_mfma_f32_16x16x32_bf16(Bt[n][k], At[m][k], acc[ai][bj][m][n], 0, 0, 0); __builtin_amdgcn_s_setprio(0); } while (0)
#define PG8_WAIT_V(n) asm volatile("s_waitcnt vmcnt(" #n ")" ::: "memory")
#define PG8_WAIT_L(n) asm volatile("s_waitcnt lgkmcnt(" #n ")" ::: "memory")
#define PG8_BAR __builtin_amdgcn_s_barrier()
#define PG8_SCHED __builtin_amdgcn_sched_barrier(0)
    Unit cur, nxt; int ui = 0;
    if (!S.next(0, cur)) return;
    f32x4 acc[2][2][4][2];
#pragma unroll
    for (int a = 0; a < 2; ++a)
#pragma unroll
        for (int b = 0; b < 2; ++b)
#pragma unroll
            for (int m = 0; m < 4; ++m)
#pragma unroll
                for (int n = 0; n < 2; ++n) acc[a][b][m][n] = (f32x4){0.f, 0.f, 0.f, 0.f};
    bf16x8 At[4][2], B0[2][2], B1[2][2];
    const char* cA = (const char*)g.A + (size_t)cur.pm * tstep; const char* cB = (const char*)g.Bt + (size_t)cur.pn * tstep;
    S.a_ready(cur);
    if constexpr (SP2) {
        PG8_STAGE(PG8_SB(0, 0), cB, voffB); PG8_STAGE(PG8_SB(0, 1), cB + hstep, voffB); PG8_STAGE(PG8_SA(0, 0), cA, voffA); PG8_STAGE(PG8_SA(0, 1), cA + hstep, voffA);
        if (wr == 1) PG8_BAR;
        PG8_WAIT_V(2); PG8_BAR;
        PG8_STAGE(PG8_SB(1, 0), cB + kstep, voffB); PG8_STAGE(PG8_SA(1, 0), cA + kstep, voffA); PG8_STAGE(PG8_SB(1, 1), cB + hstep + kstep, voffB);
        PG8_WAIT_V(6); PG8_BAR;
    } else {
        PG8_STAGE(PG8_SB(0, 0), cB, voffB); PG8_STAGE(PG8_SA(0, 0), cA, voffA); PG8_STAGE(PG8_SB(0, 1), cB + hstep, voffB); PG8_STAGE(PG8_SA(0, 1), cA + hstep, voffA);
        if (wr == 1) PG8_BAR;
        PG8_WAIT_V(4); PG8_BAR;
        PG8_STAGE(PG8_SB(1, 0), cB + kstep, voffB); PG8_STAGE(PG8_SA(1, 0), cA + kstep, voffA); PG8_STAGE(PG8_SB(1, 1), cB + hstep + kstep, voffB);
        PG8_WAIT_V(6); PG8_BAR;
    }
    for (;;) {
        const bool has_next = S.next(ui + 1, nxt);
        const char* nA = has_next ? (const char*)g.A + (size_t)nxt.pm * tstep : cA; const char* nB = has_next ? (const char*)g.Bt + (size_t)nxt.pn * tstep : cB;
        for (int t = 0; t < nt; t += 2) {
            const bool last = (t == nt - 2);
            const char* a1 = cA + (size_t)(t + 1) * kstep;
            const char* a2 = last ? nA : cA + (size_t)(t + 2) * kstep; const char* b2 = last ? nB : cB + (size_t)(t + 2) * kstep;
            const char* a3 = a2 + kstep; const char* b3 = b2 + kstep;
            if (last && has_next) S.a_ready(nxt);
            if constexpr (SP2) {
            PG8_LDB(B0, 0, 0); PG8_LDB(B1, 0, 1); PG8_SCHED; PG8_LDA(At, 0, 0); PG8_STAGE(PG8_SA(1, 1), a1 + hstep, voffA);
            PG8_WAIT_V(8); PG8_WAIT_L(0); PG8_BAR; PG8_MMA(0, 0, At, B0); PG8_MMA(0, 1, At, B1); PG8_BAR; PG8_SCHED;
            PG8_LDA(At, 0, 1); PG8_STAGE(PG8_SB(0, 0), b2, voffB); PG8_STAGE(PG8_SB(0, 1), b2 + hstep, voffB); PG8_STAGE(PG8_SA(0, 0), a2, voffA);
            PG8_WAIT_V(8); PG8_WAIT_L(0); PG8_BAR; PG8_MMA(1, 0, At, B0); PG8_MMA(1, 1, At, B1); PG8_BAR; PG8_SCHED;
            PG8_LDB(B0, 1, 0); PG8_LDB(B1, 1, 1); PG8_SCHED; PG8_LDA(At, 1, 0); PG8_STAGE(PG8_SA(0, 1), a2 + hstep, voffA);
            PG8_WAIT_V(8); PG8_WAIT_L(0); PG8_BAR; PG8_MMA(0, 0, At, B0); PG8_MMA(0, 1, At, B1); PG8_BAR; PG8_SCHED;
            PG8_LDA(At, 1, 1); PG8_STAGE(PG8_SB(1, 0), b3, voffB); PG8_STAGE(PG8_SB(1, 1), b3 + hstep, voffB); PG8_STAGE(PG8_SA(1, 0), a3, voffA);
            PG8_WAIT_V(8); PG8_WAIT_L(0); PG8_BAR; PG8_MMA(1, 0, At, B0); PG8_MMA(1, 1, At, B1); PG8_BAR; PG8_SCHED;
            } else {
            PG8_LDB(B0, 0, 0); PG8_SCHED; PG8_LDA(At, 0, 0); PG8_STAGE(PG8_SA(1, 1), a1 + hstep, voffA);
            PG8_WAIT_L(8); PG8_BAR; PG8_WAIT_L(0); PG8_MMA(0, 0, At, B0); PG8_BAR; PG8_SCHED;
            PG8_LDB(B1, 0, 1); PG8_STAGE(PG8_SB(0, 0), b2, voffB);
            PG8_BAR; PG8_WAIT_L(0); PG8_MMA(0, 1, At, B1); PG8_BAR;
            PG8_LDA(At, 0, 1); PG8_STAGE(PG8_SA(0, 0), a2, voffA);
            PG8_BAR; PG8_WAIT_L(0); PG8_MMA(1, 0, At, B0); PG8_BAR; PG8_SCHED;
            PG8_STAGE(PG8_SB(0, 1), b2 + hstep, voffB);
            PG8_WAIT_V(6); PG8_BAR; PG8_MMA(1, 1, At, B1); PG8_BAR;
            PG8_LDB(B0, 1, 0); PG8_SCHED; PG8_LDA(At, 1, 0); PG8_STAGE(PG8_SA(0, 1), a2 + hstep, voffA);
            PG8_WAIT_L(8); PG8_BAR; PG8_WAIT_L(0); PG8_MMA(0, 0, At, B0); PG8_BAR; PG8_SCHED;
            PG8_LDB(B1, 1, 1); PG8_STAGE(PG8_SB(1, 0), b3, voffB);
            PG8_BAR; PG8_WAIT_L(0); PG8_MMA(0, 1, At, B1); PG8_BAR;
            PG8_LDA(At, 1, 1); PG8_STAGE(PG8_SA(1, 0), a3, voffA);
            PG8_BAR; PG8_WAIT_L(0); PG8_MMA(1, 0, At, B0); PG8_BAR; PG8_SCHED;
            PG8_STAGE(PG8_SB(1, 1), b3 + hstep, voffB);
            PG8_WAIT_V(6); PG8_BAR; PG8_MMA(1, 1, At, B1); PG8_BAR;
            }
        }
        if constexpr (ALIGN_EPI) { if (wr == 0) PG8_BAR; }
        if constexpr (!Epi::AFTER_DRAIN) { E(acc, cur, wr, wc, fr, fq); S.done(cur); }
        if (!has_next) break;
#pragma unroll
        for (int a = 0; a < 2; ++a)
#pragma unroll
            for (int b = 0; b < 2; ++b)
#pragma unroll
                for (int m = 0; m < 4; ++m)
#pragma unroll
                    for (int n = 0; n < 2; ++n) acc[a][b][m][n] = (f32x4){0.f, 0.f, 0.f, 0.f};
        cur = nxt; cA = nA; cB = nB; ++ui;
        if constexpr (ALIGN_EPI) { if (wr == 1) PG8_BAR; }
    }
    PG8_WAIT_V(0);
    if constexpr (!ALIGN_EPI) { if (wr == 0) PG8_BAR; }
    PG8_BAR;
    if constexpr (Epi::AFTER_DRAIN) { E.fused(acc, cur, wr, wc, fr, fq, lds, wid, lane); S.done(cur); }
#undef PG8_SA
#undef PG8_SB
#undef PG8_STAGE
#undef PG8_LDA
#undef PG8_LDB
#undef PG8_MMA
#undef PG8_WAIT_V
#undef PG8_WAIT_L
#undef PG8_BAR
#undef PG8_SCHED
}
}

constexpr int NWAVES = 8;
constexpr int SEQ = 16384, DM = 2048, NIN = 5664, NINP = 5888, DFF = 5632;
constexpr int DNH = 8, HD = 128, SWH = 8, MEMH = 4, MEMT = 256;
constexpr float RMS_EPS = 1e-6f;
constexpr float LOG2E = 1.4426950408889634f;
constexpr float QSCALE = 0.08838834764831845f * 1.4426950408889634f;

constexpr size_t MiB = 1u << 20;
constexpr size_t WS_CTL = 0, CTL_ZERO_BYTES = 1 * MiB;
constexpr size_t CTL_SUMSQ2 = 256 * 1024, CTL_SUMSQ3 = 320 * 1024, CTL_SUMSQ4 = 384 * 1024;
constexpr size_t WS_RSTD1 = 1 * MiB, WS_RSTDM = 1 * MiB + 64 * 1024;
constexpr size_t WS_MEMB = 2 * MiB, WS_KVM = 3 * MiB, WS_AB = 4 * MiB, WS_BG = 6 * MiB;
constexpr size_t WS_WOUT = 8 * MiB, WS_WQ = 16 * MiB, WS_WKV = 18 * MiB, WS_WO = 22 * MiB, WS_WIN = 24 * MiB;
constexpr size_t WS_XB = 48 * MiB;
constexpr size_t WS_QKV = 112 * MiB;
constexpr size_t WS_H3B = 112 * MiB;
constexpr size_t WS_OF = 112 * MiB, WS_OB = 144 * MiB, WS_H1B = 112 * MiB, WS_QM = 176 * MiB, WS_OM = 192 * MiB;
constexpr size_t WS_DNX = 208 * MiB;
constexpr size_t WS_WGU = 208 * MiB, WS_WD = 252 * MiB, WS_HID = 274 * MiB, WS_END = 496 * MiB;
constexpr size_t DO_Z = 0, DO_QSW = 32 * MiB, DO_KVSW = 64 * MiB;
constexpr int CW_BAR = 4096;

constexpr int RING_OFF = 0, RING_BYTES = 131072;
constexpr int LDS_BYTES = 163840;
constexpr int LDSCTL_OFF = LDS_BYTES - 512, MISC_OFF = LDSCTL_OFF + 320;

#define GAS __attribute__((address_space(1)))
#define LAS __attribute__((address_space(3)))
typedef unsigned short bf16;
typedef unsigned v4u __attribute__((ext_vector_type(4)));
typedef unsigned v2u __attribute__((ext_vector_type(2)));
typedef float f32x4 __attribute__((ext_vector_type(4)));
typedef short bf16x8 __attribute__((ext_vector_type(8)));
typedef short s16x4 __attribute__((ext_vector_type(4)));
typedef GAS unsigned gu32;
#define RLX_AGENT __ATOMIC_RELAXED, __HIP_MEMORY_SCOPE_AGENT
#define LDS_WAIT() asm volatile("s_waitcnt lgkmcnt(0)" ::: "memory")
#define VM_WAIT() asm volatile("s_waitcnt vmcnt(0)" ::: "memory")
__device__ __forceinline__ unsigned f2bf(float f) { unsigned u = __builtin_bit_cast(unsigned, f); return (u + 0x7fffu + ((u >> 16) & 1u)) >> 16; }
__device__ __forceinline__ unsigned pk2(float lo, float hi) { return f2bf(lo) | (f2bf(hi) << 16); }
__device__ __forceinline__ float bf2f(unsigned short b) { return __builtin_bit_cast(float, (unsigned)b << 16); }
__device__ __forceinline__ float bflo(unsigned w) { return __builtin_bit_cast(float, w << 16); }
__device__ __forceinline__ float bfhi(unsigned w) { return __builtin_bit_cast(float, w & 0xffff0000u); }
typedef float f32x2_t __attribute__((ext_vector_type(2))); typedef __bf16 bf16x2_t __attribute__((ext_vector_type(2)));
__device__ __forceinline__ unsigned cvtpk(float lo, float hi) { f32x2_t v = {lo, hi}; bf16x2_t b = __builtin_convertvector(v, bf16x2_t); return __builtin_bit_cast(unsigned, b); }
__device__ __forceinline__ float wave_sum(float v) {
#pragma unroll
    for (int o = 1; o < 64; o <<= 1) v += __shfl_xor(v, o);
    return v;
}
__device__ __forceinline__ float siluf(float x) { return x * __builtin_amdgcn_rcpf(1.0f + __expf(-x)); }
#define XB_TMO      128
#define XB_XCNT(j)  (256  + 64 * (j))
#define XB_XSUB(j)  (1280 + 64 * (j))
#define XB_XGEN(j)  (2304 + 64 * (j))
#define XB_TOP      3328
#define XB_TOPGEN   3392
#define XCD_BAR_WORDS 3456
#define XB_SPIN_CAP (1u << 18)

__device__ __forceinline__ unsigned xb_ld(unsigned* p)              { return __hip_atomic_load(p, __ATOMIC_RELAXED, __HIP_MEMORY_SCOPE_AGENT); }
__device__ __forceinline__ unsigned xb_add(unsigned* p, unsigned v) { return __hip_atomic_fetch_add(p, v, __ATOMIC_RELAXED, __HIP_MEMORY_SCOPE_AGENT); }
__device__ __forceinline__ unsigned xb_xcc_id() { return (unsigned)__builtin_amdgcn_s_getreg((3 << 11) | 20) & 0xFu; }
#define XB_SPIN(cond, bar) do { unsigned _sp = 0; while (cond) { __builtin_amdgcn_s_sleep(1); \
    if ((++_sp & 255u) == 0u) { if (xb_ld(&(bar)[XB_TMO])) break; if (_sp > XB_SPIN_CAP) { atomicAdd(&(bar)[XB_TMO], 1u); break; } } } } while (0)

struct XcdBarrier {
    unsigned* bar; unsigned x;
    volatile LAS unsigned* st;
};

__device__ __forceinline__ XcdBarrier xcd_barrier_post(unsigned* bar, volatile LAS unsigned* st) {
    XcdBarrier b; b.bar = bar; b.x = xb_xcc_id(); b.st = st;
    if (threadIdx.x == 0) (void)xb_add(&bar[XB_XCNT(b.x)], 1u);
    return b;
}
__device__ __forceinline__ void xcd_barrier_complete(unsigned* bar, unsigned x, unsigned& nloc, unsigned& nx) {
    const unsigned G = gridDim.x * gridDim.y * gridDim.z;
    unsigned sum, cnt, mine, sp = 0u;
    for (;;) {
        sum = 0u; cnt = 0u; mine = 0u;
#pragma unroll
        for (unsigned j = 0; j < 16; ++j) { const unsigned c = xb_ld(&bar[XB_XCNT(j)]); sum += c; cnt += (c > 0u) ? 1u : 0u; mine = (j == x) ? c : mine; }
        if (sum == G) break;
        __builtin_amdgcn_s_sleep(1);
        if ((++sp & 255u) == 0u) { if (xb_ld(&bar[XB_TMO])) break; if (sp > XB_SPIN_CAP) { atomicAdd(&bar[XB_TMO], 1u); break; } }
    }
    nloc = mine > 0u ? mine : 1u; nx = cnt > 0u ? cnt : 1u;
}

__device__ __forceinline__ void xcd_barrier(const XcdBarrier& b) {
    asm volatile("s_waitcnt vmcnt(0)" ::: "memory");
    __syncthreads();
    if (threadIdx.x == 0) {
        unsigned* bar = b.bar;
        __builtin_amdgcn_s_waitcnt(0);
        unsigned nloc = b.st[0], nx = b.st[1];
        if (nloc == 0u) { xcd_barrier_complete(bar, b.x, nloc, nx); b.st[0] = nloc; b.st[1] = nx; }
        const unsigned old = xb_add(&bar[XB_XSUB(b.x)], 1u);
        const unsigned gen = old / nloc;
        if (old + 1u == (gen + 1u) * nloc) {
            __builtin_amdgcn_fence(__ATOMIC_RELEASE, "agent");
            asm volatile("s_waitcnt vmcnt(0)" ::: "memory");
            const unsigned og = xb_add(&bar[XB_TOP], 1u);
            const unsigned tg = og / nx;
            if (og + 1u == (tg + 1u) * nx) xb_add(&bar[XB_TOPGEN], 1u);
            else XB_SPIN(xb_ld(&bar[XB_TOPGEN]) == tg, bar);
            __builtin_amdgcn_fence(__ATOMIC_ACQUIRE, "agent");
            xb_add(&bar[XB_XGEN(b.x)], 1u);
            asm volatile("s_waitcnt vmcnt(0)" ::: "memory");
        } else {
            XB_SPIN(xb_ld(&bar[XB_XGEN(b.x)]) == gen, bar);
            __builtin_amdgcn_fence(__ATOMIC_ACQUIRE, "agent");
            asm volatile("s_waitcnt vmcnt(0)" ::: "memory");
        }
    }
    __syncthreads();
}

using pg8::Unit;
__device__ __forceinline__ v4u pack8(f32x4 v0, f32x4 v1) { v4u w; w.x = cvtpk(v0[0], v0[1]); w.y = cvtpk(v0[2], v0[3]); w.z = cvtpk(v1[0], v1[1]); w.w = cvtpk(v1[2], v1[3]); return w; }

struct EpiProj {
    static constexpr bool PERM = true, AFTER_DRAIN = false;
    const float* rstd; bf16* qkv; bf16* z; bf16* qsw; bf16* kvsw; float* ab;
    __device__ __forceinline__ void operator()(const f32x4 (&acc)[2][2][4][2], const Unit& u, int wr, int wc, int fr, int fq) const {
        const int pn = u.pn; bf16* base; int ldc, colt; float sc = 1.f;
        if (pn < 12) { base = qkv; ldc = 3072; colt = pn * 256; }
        else if (pn < 16) { base = z; ldc = 1024; colt = (pn - 12) * 256; }
        else if (pn < 20) { base = qsw; ldc = 1024; colt = (pn - 16) * 256; sc = QSCALE; }
        else if (pn < 22) { base = kvsw; ldc = 512; colt = (pn - 20) * 256; }
        else { base = nullptr; ldc = 0; colt = 0; }
        const int row0 = u.pm * 256 + wr * 64 + fr, col0 = colt + wc * 32 + 8 * fq;
        float rsv[2][4];
#pragma unroll
        for (int ai = 0; ai < 2; ++ai)
#pragma unroll
            for (int m = 0; m < 4; ++m) rsv[ai][m] = rstd[row0 + ai * 128 + m * 16];
#pragma unroll
        for (int ai = 0; ai < 2; ++ai)
#pragma unroll
            for (int m = 0; m < 4; ++m) {
                const int row = row0 + ai * 128 + m * 16; const float rs = rsv[ai][m] * sc;
                if (base) {
                    bf16* rowp = base + (size_t)row * ldc + col0;
#pragma unroll
                    for (int bj = 0; bj < 2; ++bj) *(v4u*)(rowp + bj * 128) = pack8(acc[ai][bj][m][0] * rs, acc[ai][bj][m][1] * rs);
                } else if (wc == 0) {
                    float* rowp = ab + (size_t)row * 32 + 8 * fq;
                    *(f32x4*)(rowp) = acc[ai][0][m][0] * rs; *(f32x4*)(rowp + 4) = acc[ai][0][m][1] * rs;
                }
            }
    }
};
struct EpiScaleBf16 {
    static constexpr bool PERM = true, AFTER_DRAIN = false;
    const float* rs; int from_sumsq; float sc; bf16* O; int ldc;
    __device__ __forceinline__ void operator()(const f32x4 (&acc)[2][2][4][2], const Unit& u, int wr, int wc, int fr, int fq) const {
        const int row0 = u.pm * 256 + wr * 64 + fr, col0 = u.pn * 256 + wc * 32 + 8 * fq;
        float rsv[2][4];
#pragma unroll
        for (int ai = 0; ai < 2; ++ai)
#pragma unroll
            for (int m = 0; m < 4; ++m) rsv[ai][m] = rs[row0 + ai * 128 + m * 16];
#pragma unroll
        for (int ai = 0; ai < 2; ++ai)
#pragma unroll
            for (int m = 0; m < 4; ++m) {
                const int row = row0 + ai * 128 + m * 16; float r = rsv[ai][m];
                if (from_sumsq) r = __builtin_amdgcn_rsqf(r * (1.0f / DM) + RMS_EPS);
                r *= sc; bf16* rowp = O + (size_t)row * ldc + col0;
#pragma unroll
                for (int bj = 0; bj < 2; ++bj) *(v4u*)(rowp + bj * 128) = pack8(acc[ai][bj][m][0] * r, acc[ai][bj][m][1] * r);
            }
    }
};
struct EpiRes {
    static constexpr bool PERM = true, AFTER_DRAIN = false;
    const float* res; float* out; bf16* ob; float* sumsq;
    __device__ __forceinline__ void operator()(const f32x4 (&acc)[2][2][4][2], const Unit& u, int wr, int wc, int fr, int fq) const {
        const int row0 = u.pm * 256 + wr * 64 + fr, col0 = u.pn * 256 + wc * 32 + 8 * fq;
#pragma unroll
        for (int ai = 0; ai < 2; ++ai) {
            f32x4 rr[4][2][2];
#pragma unroll
            for (int m = 0; m < 4; ++m) { const size_t off = (size_t)(row0 + ai * 128 + m * 16) * DM + col0;
#pragma unroll
                for (int bj = 0; bj < 2; ++bj) { rr[m][bj][0] = *(const f32x4*)(res + off + bj * 128); rr[m][bj][1] = *(const f32x4*)(res + off + bj * 128 + 4); } }
            asm volatile("" ::: "memory");
#pragma unroll
            for (int m = 0; m < 4; ++m) {
                const int row = row0 + ai * 128 + m * 16; const size_t off = (size_t)row * DM + col0; float ss = 0.f;
#pragma unroll
                for (int bj = 0; bj < 2; ++bj) {
                    const f32x4 v0 = acc[ai][bj][m][0] + rr[m][bj][0], v1 = acc[ai][bj][m][1] + rr[m][bj][1];
                    if (out) { *(f32x4*)(out + off + bj * 128) = v0; *(f32x4*)(out + off + bj * 128 + 4) = v1; }
                    if (ob) *(v4u*)(ob + off + bj * 128) = pack8(v0, v1);
                    ss += (v0[0] * v0[0] + v0[1] * v0[1]) + (v0[2] * v0[2] + v0[3] * v0[3]) + (v1[0] * v1[0] + v1[1] * v1[1]) + (v1[2] * v1[2] + v1[3] * v1[3]);
                }
                ss += __shfl_xor(ss, 16); ss += __shfl_xor(ss, 32);
                if (fq == 0) atomicAdd(sumsq + row, ss);
            }
            asm volatile("" ::: "memory");
        }
    }
};
struct EpiSwiglu {
    static constexpr bool PERM = true, AFTER_DRAIN = false;
    const float* sumsq; bf16* H;
    __device__ __forceinline__ void operator()(const f32x4 (&acc)[2][2][4][2], const Unit& u, int wr, int wc, int fr, int fq) const {
        const int row0 = u.pm * 256 + wr * 64 + fr, col0 = u.pn * 128 + wc * 32 + 8 * fq;
        float rsv[2][4];
#pragma unroll
        for (int ai = 0; ai < 2; ++ai)
#pragma unroll
            for (int m = 0; m < 4; ++m) rsv[ai][m] = sumsq[row0 + ai * 128 + m * 16];
#pragma unroll
        for (int ai = 0; ai < 2; ++ai)
#pragma unroll
            for (int m = 0; m < 4; ++m) {
                const int row = row0 + ai * 128 + m * 16; const float r = __builtin_amdgcn_rsqf(rsv[ai][m] * (1.0f / DM) + RMS_EPS);
                f32x4 h[2];
#pragma unroll
                for (int n = 0; n < 2; ++n)
#pragma unroll
                    for (int e = 0; e < 4; ++e) { const float g = acc[ai][0][m][n][e] * r, up = acc[ai][1][m][n][e] * r; h[n][e] = siluf(g) * up; }
                *(v4u*)(H + (size_t)row * DFF + col0) = pack8(h[0], h[1]);
            }
    }
};

struct Frame {
    LAS unsigned char* lds;
    volatile LAS unsigned* MISC;
    gu32* ctl;
    int tid, lane, wave, vcu, G;
    const float* in[23]; float* out; unsigned char* ws;
};
#define WSP(T, off) ((T*)(F.ws + (off)))
#define DOP(T, off) ((T*)((unsigned char*)F.out + (off)))

__device__ __forceinline__ void tr_item(const float* W, int K, int Nsrc, int src_col0, const float* gain, bf16* WT, int dst_row0, int k0, LAS float* scr, int lane) {
    float v[32];
#pragma unroll
    for (int i = 0; i < 32; ++i) { const int kk = 2 * i + (lane >> 5); v[i] = (src_col0 >= 0) ? W[(size_t)(k0 + kk) * Nsrc + src_col0 + (lane & 31)] : 0.f; }
    if (gain) {
#pragma unroll
        for (int i = 0; i < 32; ++i) v[i] *= gain[k0 + 2 * i + (lane >> 5)]; }
#pragma unroll
    for (int i = 0; i < 32; ++i) scr[(2 * i + (lane >> 5)) * 33 + (lane & 31)] = v[i];
    LDS_WAIT(); asm volatile("" ::: "memory");
    const int c = lane & 7;
#pragma unroll
    for (int j = 0; j < 4; ++j) { const int n = (lane >> 3) + 8 * j; const LAS float* s = scr + (8 * c) * 33 + n;
        v4u o; o.x = pk2(s[0 * 33], s[1 * 33]); o.y = pk2(s[2 * 33], s[3 * 33]); o.z = pk2(s[4 * 33], s[5 * 33]); o.w = pk2(s[6 * 33], s[7 * 33]);
        *(GAS v4u*)(WT + (size_t)(dst_row0 + n) * K + k0 + 8 * c) = o; }
    LDS_WAIT(); asm volatile("" ::: "memory");
}
__device__ __forceinline__ int win_src_col(int c) {
    if (c < 4096) return c;
    if (c < 5120) return c - 4096 + 4128;
    if (c < 5376) return c - 5120 + 5152;
    if (c < 5632) return c - 5376 + 5408;
    if (c < 5664) return c - 5632 + 4096;
    return -1;
}
__device__ __forceinline__ void row_to_bf16_rstd(const float* xrow, bf16* orow, float* rstd_out, int lane) {
    const GAS f32x4* xr = (const GAS f32x4*)xrow + lane;
    f32x4 v[8]; float s = 0.f;
#pragma unroll
    for (int j = 0; j < 8; ++j) { v[j] = xr[64 * j]; s += (v[j].x * v[j].x + v[j].y * v[j].y) + (v[j].z * v[j].z + v[j].w * v[j].w); }
    s = wave_sum(s);
    if (lane == 0) *rstd_out = 1.0f / sqrtf(s * (1.0f / DM) + RMS_EPS);
    GAS v2u* o8 = (GAS v2u*)orow + lane;
#pragma unroll
    for (int j = 0; j < 8; ++j) { v2u w; w.x = pk2(v[j].x, v[j].y); w.y = pk2(v[j].z, v[j].w); o8[64 * j] = w; }
}

__device__ __forceinline__ void p0_prologue(Frame& F) {
    LAS float* scr = (LAS float*)(F.lds + RING_OFF + F.wave * 16384);
    const int gw = F.vcu * NWAVES + F.wave, NGW = F.G * NWAVES;
    constexpr int I_IN = 32 * (NINP / 32), I_OUT = 32 * 64, I_Q = 32 * 16, I_KV = 32 * 32, I_O = 8 * 64;
    constexpr int NITEMS = I_IN + I_OUT + I_Q + I_KV + I_O;
    for (int it = gw; it < NITEMS; it += NGW) {
        int r = it;
        if (r < I_IN) { const int nblk = NINP / 32, kb = r / nblk, nb = r % nblk; tr_item(F.in[3], DM, NIN, win_src_col(nb * 32), F.in[2], WSP(bf16, WS_WIN), nb * 32, kb * 64, scr, F.lane); continue; } r -= I_IN;
        if (r < I_OUT) { const int kb = r / 64, nb = r % 64; tr_item(F.in[12], DM, DM, nb * 32, nullptr, WSP(bf16, WS_WOUT), nb * 32, kb * 64, scr, F.lane); continue; } r -= I_OUT;
        if (r < I_Q) { const int kb = r / 16, nb = r % 16; tr_item(F.in[15], DM, 512, nb * 32, F.in[13], WSP(bf16, WS_WQ), nb * 32, kb * 64, scr, F.lane); continue; } r -= I_Q;
        if (r < I_KV) { const int kb = r / 32, nb = r % 32; tr_item(F.in[16], DM, 1024, nb * 32, F.in[14], WSP(bf16, WS_WKV), nb * 32, kb * 64, scr, F.lane); continue; } r -= I_KV;
        { const int kb = r / 64, nb = r % 64; tr_item(F.in[17], 512, DM, nb * 32, nullptr, WSP(bf16, WS_WO), nb * 32, kb * 64, scr, F.lane); }
    }
    for (int m = gw; m < SEQ; m += 2 * NGW) {
        const int m2 = m + NGW; const bool two = m2 < SEQ;
        const GAS f32x4* xa = (const GAS f32x4*)(F.in[0] + (size_t)m * DM) + F.lane; const GAS f32x4* xb_ = (const GAS f32x4*)(F.in[0] + (size_t)(two ? m2 : m) * DM) + F.lane;
        f32x4 va[8], vb[8]; float sa = 0.f, sb = 0.f;
#pragma unroll
        for (int j = 0; j < 8; ++j) { va[j] = xa[64 * j]; vb[j] = xb_[64 * j]; }
#pragma unroll
        for (int j = 0; j < 8; ++j) { sa += (va[j].x * va[j].x + va[j].y * va[j].y) + (va[j].z * va[j].z + va[j].w * va[j].w); sb += (vb[j].x * vb[j].x + vb[j].y * vb[j].y) + (vb[j].z * vb[j].z + vb[j].w * vb[j].w); }
        sa = wave_sum(sa); sb = wave_sum(sb);
        if (F.lane == 0) { WSP(float, WS_RSTD1)[m] = 1.0f / sqrtf(sa * (1.0f / DM) + RMS_EPS); if (two) WSP(float, WS_RSTD1)[m2] = 1.0f / sqrtf(sb * (1.0f / DM) + RMS_EPS); }
        GAS v2u* oa = (GAS v2u*)(WSP(bf16, WS_XB) + (size_t)m * DM) + F.lane; GAS v2u* ob = (GAS v2u*)(WSP(bf16, WS_XB) + (size_t)m2 * DM) + F.lane;
#pragma unroll
        for (int j = 0; j < 8; ++j) { v2u w; w.x = pk2(va[j].x, va[j].y); w.y = pk2(va[j].z, va[j].w); oa[64 * j] = w; }
        if (two) {
#pragma unroll
            for (int j = 0; j < 8; ++j) { v2u w; w.x = pk2(vb[j].x, vb[j].y); w.y = pk2(vb[j].z, vb[j].w); ob[64 * j] = w; } }
    }
    for (int m = gw; m < MEMT; m += NGW) row_to_bf16_rstd(F.in[1] + (size_t)m * DM, WSP(bf16, WS_MEMB) + (size_t)m * DM, WSP(float, WS_RSTDM) + m, F.lane);
}
__device__ __forceinline__ void p4_transposes(Frame& F) {
    LAS float* scr = (LAS float*)(F.lds + RING_OFF + F.wave * 16384);
    const int gw = F.vcu * NWAVES + F.wave, NGW = F.G * NWAVES;
    constexpr int I_GU = 32 * (2 * DFF / 32), I_D = (DFF / 64) * 64;
    for (int it = gw; it < I_GU + I_D; it += NGW) {
        int r = it;
        if (r < I_GU) { const int nblk = 2 * DFF / 32, kb = r / nblk, nb = r % nblk; const int row = nb * 32, t = row / 256, w = row % 256;
            const float* src = (w < 128) ? F.in[19] : F.in[20]; const int sc = 128 * t + (w & 127);
            tr_item(src, DM, DFF, sc, F.in[18], WSP(bf16, WS_WGU), row, kb * 64, scr, F.lane); continue; } r -= I_GU;
        { const int kb = r / 64, nb = r % 64; tr_item(F.in[21], DFF, DM, nb * 32, nullptr, WSP(bf16, WS_WD), nb * 32, kb * 64, scr, F.lane); }
    }
}

__device__ __forceinline__ float softplusf(float x) { return x > 20.f ? x : log1pf(__expf(x)); }
__device__ __forceinline__ void dn_combine(Frame& F) {
    const int gw = F.vcu * NWAVES + F.wave, NGW = F.G * NWAVES, lane = F.lane;
    const bf16* OFp = WSP(bf16, WS_OF); const bf16* OBp = WSP(bf16, WS_OB); const bf16* Z = DOP(bf16, DO_Z); bf16* Y = WSP(bf16, WS_XB); const float* gn = F.in[9];
    const int cb = (16 * lane) & 127; float gv[16];
#pragma unroll
    for (int i = 0; i < 16; ++i) gv[i] = gn[cb + i];
    for (int t0 = gw; t0 < SEQ; t0 += 2 * NGW) {
        v4u a[2][2], b[2][2], z[2][2];
#pragma unroll
        for (int k = 0; k < 2; ++k) { const int t = (t0 + k * NGW < SEQ) ? t0 + k * NGW : t0; const size_t off = (size_t)t * 1024 + 16 * lane;
            a[k][0] = *(const v4u*)(OFp + off); a[k][1] = *(const v4u*)(OFp + off + 8); b[k][0] = *(const v4u*)(OBp + off); b[k][1] = *(const v4u*)(OBp + off + 8);
            z[k][0] = *(const v4u*)(Z + off); z[k][1] = *(const v4u*)(Z + off + 8); }
#pragma unroll
        for (int k = 0; k < 2; ++k) {
            const int t = t0 + k * NGW; if (t >= SEQ) break;
            float o[16], zz[16];
#pragma unroll
            for (int i = 0; i < 4; ++i) { o[2 * i] = bflo(a[k][0][i]) + bflo(b[k][0][i]); o[2 * i + 1] = bfhi(a[k][0][i]) + bfhi(b[k][0][i]); o[8 + 2 * i] = bflo(a[k][1][i]) + bflo(b[k][1][i]); o[8 + 2 * i + 1] = bfhi(a[k][1][i]) + bfhi(b[k][1][i]);
                zz[2 * i] = bflo(z[k][0][i]); zz[2 * i + 1] = bfhi(z[k][0][i]); zz[8 + 2 * i] = bflo(z[k][1][i]); zz[8 + 2 * i + 1] = bfhi(z[k][1][i]); }
            float ss = 0.f;
#pragma unroll
            for (int i = 0; i < 16; ++i) ss += o[i] * o[i];
            ss += __shfl_xor(ss, 1); ss += __shfl_xor(ss, 2); ss += __shfl_xor(ss, 4);
            const float rs = __builtin_amdgcn_rsqf(ss * (1.0f / 128.0f) + RMS_EPS);
            float y[16];
#pragma unroll
            for (int i = 0; i < 16; ++i) y[i] = o[i] * rs * gv[i] * siluf(zz[i]);
            v4u w0, w1;
#pragma unroll
            for (int i = 0; i < 4; ++i) { w0[i] = pk2(y[2 * i], y[2 * i + 1]); w1[i] = pk2(y[8 + 2 * i], y[8 + 2 * i + 1]); }
            bf16* yp = Y + (size_t)t * DM + 16 * lane; *(v4u*)yp = w0; *(v4u*)(yp + 8) = w1;
        }
    }
}
__device__ __forceinline__ void final_norm(Frame& F) {
    const int gw = F.vcu * NWAVES + F.wave, NGW = F.G * NWAVES, lane = F.lane;
    const float* ss = (const float*)(F.ws + WS_CTL + CTL_SUMSQ4); const GAS f32x4* g = (const GAS f32x4*)F.in[22]; const bf16* H3 = WSP(bf16, WS_H3B);
    for (int m0 = gw; m0 < SEQ; m0 += 2 * NGW) {
        v4u w[2][4]; float r[2];
#pragma unroll
        for (int k = 0; k < 2; ++k) { const int m = (m0 + k * NGW < SEQ) ? m0 + k * NGW : m0; const GAS v4u* hp = (const GAS v4u*)(H3 + (size_t)m * DM);
            r[k] = ss[m];
#pragma unroll
            for (int j = 0; j < 4; ++j) w[k][j] = hp[64 * j + lane]; }
#pragma unroll
        for (int k = 0; k < 2; ++k) {
            const int m = m0 + k * NGW; if (m >= SEQ) break;
            const float rr = __builtin_amdgcn_rsqf(r[k] * (1.0f / DM) + RMS_EPS);
            GAS f32x4* o = (GAS f32x4*)(F.out + (size_t)m * DM);
#pragma unroll
            for (int j = 0; j < 4; ++j) { const v4u x = w[k][j]; const int c4 = 2 * (64 * j + lane); const f32x4 g0 = g[c4], g1 = g[c4 + 1];
                o[c4] = (f32x4){bflo(x.x) * rr * g0[0], bfhi(x.x) * rr * g0[1], bflo(x.y) * rr * g0[2], bfhi(x.y) * rr * g0[3]};
                o[c4 + 1] = (f32x4){bflo(x.z) * rr * g1[0], bfhi(x.z) * rr * g1[1], bflo(x.w) * rr * g1[2], bfhi(x.w) * rr * g1[3]}; }
        }
    }
}

__device__ __forceinline__ int t5_bucket(int rel) {
    const int n = rel < 0 ? -rel : rel; int b;
    if (n < 8) b = n; else { int k = (31 - __builtin_clz((unsigned)(n * n))) - 6; b = 8 + k; if (b > 15) b = 15; }
    return (rel > 0 ? 16 : 0) + b;
}
template <int MODE  >
__device__ __forceinline__ void attn_unit(Frame& F, const bf16* Q, int qpitch, const bf16* Kp, const bf16* Vp, int kvpitch, bf16* O, int opitch, int q0, int kt_beg, int kt_end, const LAS float* btab, float sink2) {
    LAS unsigned char* Ks = F.lds + RING_OFF; LAS unsigned char* Vs = Ks + 16384;
    const int lane = F.lane, c = lane & 15, g = lane >> 4, qw0 = q0 + 16 * F.wave, tid = F.tid;
    bf16x8 qf[4];
#pragma unroll
    for (int t = 0; t < 4; ++t) qf[t] = *(const bf16x8*)(Q + (size_t)(qw0 + c) * qpitch + 32 * t + 8 * g);
    f32x4 oacc[8];
#pragma unroll
    for (int i = 0; i < 8; ++i) oacc[i] = (f32x4){0.f, 0.f, 0.f, 0.f};
    float mrun = (MODE == 0) ? sink2 : -1e30f, lsum = (MODE == 0 && g == 0) ? 1.0f : 0.0f;
    v4u kpre[2], vpre[2];
#pragma unroll
    for (int i = 0; i < 2; ++i) { const int ci = tid + 512 * i, key = ci >> 4, ch = ci & 15;
        kpre[i] = *(const v4u*)(Kp + (size_t)(64 * kt_beg + key) * kvpitch + ch * 8); vpre[i] = *(const v4u*)(Vp + (size_t)(64 * kt_beg + key) * kvpitch + ch * 8); }
    for (int kt = kt_beg; kt < kt_end; ++kt) {
        __syncthreads();
#pragma unroll
        for (int i = 0; i < 2; ++i) { const int ci = tid + 512 * i, key = ci >> 4, ch = ci & 15;
            *(LAS v4u*)(Ks + key * 256 + ((ch ^ (key & 15)) << 4)) = kpre[i]; *(LAS v4u*)(Vs + key * 256 + ((ch ^ ((key & 7) << 1)) << 4)) = vpre[i]; }
        if (kt + 1 < kt_end) {
#pragma unroll
            for (int i = 0; i < 2; ++i) { const int ci = tid + 512 * i, key = ci >> 4, ch = ci & 15;
                kpre[i] = *(const v4u*)(Kp + (size_t)(64 * (kt + 1) + key) * kvpitch + ch * 8); vpre[i] = *(const v4u*)(Vp + (size_t)(64 * (kt + 1) + key) * kvpitch + ch * 8); } }
        __syncthreads();
        bool rel_ok = true;
        if (MODE == 0) rel_ok = (64 * kt <= qw0 + 15 + 128) && (64 * kt + 63 >= qw0 - 128);
        if (!rel_ok) continue;
        f32x4 s[4];
#pragma unroll
        for (int mt = 0; mt < 4; ++mt) s[mt] = (f32x4){0.f, 0.f, 0.f, 0.f};
#pragma unroll
        for (int t = 0; t < 4; ++t)
#pragma unroll
            for (int mt = 0; mt < 4; ++mt) { const bf16x8 kf = *(const LAS bf16x8*)(Ks + (16 * mt + c) * 256 + (((4 * t + g) ^ c) << 4));
                s[mt] = __builtin_amdgcn_mfma_f32_16x16x32_bf16(kf, qf[t], s[mt], 0, 0, 0); }
        float tmax = -INFINITY;
#pragma unroll
        for (int mt = 0; mt < 4; ++mt)
#pragma unroll
            for (int r = 0; r < 4; ++r) {
                if (MODE == 0) { const int rel = (64 * kt + 16 * mt + 4 * g + r) - (qw0 + c); const bool ok = (rel >= -128) && (rel <= 128);
                    const int ri = ok ? rel + 128 : 128; const float bv = btab[ri]; s[mt][r] = ok ? s[mt][r] + bv : -INFINITY; }
                tmax = fmaxf(tmax, s[mt][r]); }
        tmax = fmaxf(tmax, __shfl_xor(tmax, 16)); tmax = fmaxf(tmax, __shfl_xor(tmax, 32));
        const float mnew = fmaxf(mrun, tmax), alpha = __builtin_amdgcn_exp2f(mrun - mnew); mrun = mnew; float ps = 0.f;
#pragma unroll
        for (int mt = 0; mt < 4; ++mt)
#pragma unroll
            for (int r = 0; r < 4; ++r) { const float p = __builtin_amdgcn_exp2f(s[mt][r] - mnew); s[mt][r] = p; ps += p; }
        lsum = lsum * alpha + ps;
#pragma unroll
        for (int i = 0; i < 8; ++i) oacc[i] = oacc[i] * alpha;
        bf16x8 pf[2];
#pragma unroll
        for (int t2 = 0; t2 < 2; ++t2) { v4u w; w.x = cvtpk(s[2 * t2][0], s[2 * t2][1]); w.y = cvtpk(s[2 * t2][2], s[2 * t2][3]); w.z = cvtpk(s[2 * t2 + 1][0], s[2 * t2 + 1][1]); w.w = cvtpk(s[2 * t2 + 1][2], s[2 * t2 + 1][3]);
            pf[t2] = __builtin_bit_cast(bf16x8, w); }
        const int q4 = c >> 2, p4 = c & 3;
#pragma unroll
        for (int t2 = 0; t2 < 2; ++t2)
#pragma unroll
            for (int mo = 0; mo < 8; ++mo) {
                const int k1 = 32 * t2 + 4 * g + q4, k2 = k1 + 16, chn = 2 * mo + (p4 >> 1);
                const s16x4 lo = __builtin_bit_cast(s16x4, __builtin_amdgcn_ds_read_tr16_b64_v4i16((LAS s16x4*)(Vs + k1 * 256 + ((chn ^ ((k1 & 7) << 1)) << 4) + (p4 & 1) * 8)));
                const s16x4 hi = __builtin_bit_cast(s16x4, __builtin_amdgcn_ds_read_tr16_b64_v4i16((LAS s16x4*)(Vs + k2 * 256 + ((chn ^ ((k2 & 7) << 1)) << 4) + (p4 & 1) * 8)));
                const bf16x8 vf = (bf16x8){lo[0], lo[1], lo[2], lo[3], hi[0], hi[1], hi[2], hi[3]};
                oacc[mo] = __builtin_amdgcn_mfma_f32_16x16x32_bf16(vf, pf[t2], oacc[mo], 0, 0, 0); }
    }
    lsum += __shfl_xor(lsum, 16); lsum += __shfl_xor(lsum, 32);
    const float inv = 1.0f / lsum;
#pragma unroll
    for (int mo = 0; mo < 8; ++mo) { v2u w; w.x = cvtpk(oacc[mo][0] * inv, oacc[mo][1] * inv); w.y = cvtpk(oacc[mo][2] * inv, oacc[mo][3] * inv);
        *(v2u*)(O + (size_t)(qw0 + c) * opitch + 16 * mo + 4 * g) = w; }
}
__device__ __forceinline__ void swa_phase(Frame& F, int b0, int nb) {
    LAS float* btab = (LAS float*)(F.lds + RING_OFF + 32768);
    const bf16* QS = DOP(bf16, DO_QSW); const bf16* KV = DOP(bf16, DO_KVSW); bf16* Y = WSP(bf16, WS_XB);
    if ((int)blockIdx.x < b0) return;
    for (int u = blockIdx.x - b0; u < SWH * (SEQ / 128); u += nb) {
        const int h = u & 7, qb = u >> 3, kvh = h >> 2;
        __syncthreads();
        if (F.tid < 257) btab[F.tid] = F.in[11][t5_bucket(F.tid - 128) * 8 + h] * LOG2E;
        __syncthreads();
        int kb = 2 * qb - 2, ke = 2 * qb + 4; if (kb < 0) kb = 0; if (ke > SEQ / 64) ke = SEQ / 64;
        attn_unit<0>(F, QS + h * 128, 1024, KV + kvh * 128, KV + 256 + kvh * 128, 512, Y + 1024 + h * 128, DM, qb * 128, kb, ke, btab, F.in[10][h] * LOG2E);
    }
}
__device__ __forceinline__ void mem_attn_phase(Frame& F) {
    const bf16* QM = WSP(bf16, WS_QM); const bf16* KVm = WSP(bf16, WS_KVM); bf16* OM = WSP(bf16, WS_OM);
    for (int u = blockIdx.x; u < MEMH * (SEQ / 128); u += F.G) {
        const int h = u & 3, qb = u >> 2;
        attn_unit<1>(F, QM + h * 128, 512, KVm + h * 128, KVm + 512 + h * 128, 1024, OM + h * 128, 512, qb * 128, 0, 4, nullptr, 0.f);
    }
}

typedef float f32x16 __attribute__((ext_vector_type(16)));
constexpr int DX_W = 0, DX_K = 16384, DX_U = 32768, DX_Q = 49152, DX_A = 65536, DX_BYTES = 73728;
constexpr size_t WS_GL = 1 * MiB + 128 * 1024;
constexpr int L_RAW = 0, RAW_PITCH = 784, L_MTF = 0, L_MTB = 16384, L_TB = 32768, TB_PITCH = 144, TB_SZ = 9216;
constexpr int L_QB = 69632, L_KB = 86016, L_KT = 102400, L_VT = 120832, L_PART = 139264, L_SC = 143360;
static_assert(L_SC + 2048 <= LDSCTL_OFF, "prep LDS map");
__device__ __forceinline__ unsigned char* dnx_rec(Frame& F, int dir, int hd, int cn) { return F.ws + WS_DNX + (size_t)((dir * 8 + hd) * 256 + cn) * DX_BYTES; }
__device__ __forceinline__ v4u pack8f(const float* v) { v4u w; w.x = cvtpk(v[0], v[1]); w.y = cvtpk(v[2], v[3]); w.z = cvtpk(v[4], v[5]); w.w = cvtpk(v[6], v[7]); return w; }

__device__ __forceinline__ bf16x8 cvt8(const f32x16& v, int o) { v4u w; w.x = cvtpk(v[o], v[o + 1]); w.y = cvtpk(v[o + 2], v[o + 3]); w.z = cvtpk(v[o + 4], v[o + 5]); w.w = cvtpk(v[o + 6], v[o + 7]); return __builtin_bit_cast(bf16x8, w); }
__device__ __forceinline__ bf16x8 cvt8f(f32x4 a, f32x4 b) { v4u w; w.x = cvtpk(a[0], a[1]); w.y = cvtpk(a[2], a[3]); w.z = cvtpk(b[0], b[1]); w.w = cvtpk(b[2], b[3]); return __builtin_bit_cast(bf16x8, w); }
template <int dir> __device__ __forceinline__ void dn_solve_and_write(LAS unsigned char* lds, int lane) {
    const LAS float* MT = (const LAS float*)(lds + (dir ? L_MTB : L_MTF));
    LAS float* T0 = (LAS float*)(lds + L_TB + dir * 2 * TB_SZ);
    LAS float* Trow = T0 + lane * 68;
    const int blk = lane >> 5, cb = 32 * blk;
#pragma unroll 1
    for (int jr = 7; jr >= 0; --jr) {
        const int j0 = cb + 4 * jr;
        float a0 = (lane == j0) ? 1.f : 0.f, a1 = (lane == j0 + 1) ? 1.f : 0.f, a2 = (lane == j0 + 2) ? 1.f : 0.f, a3 = (lane == j0 + 3) ? 1.f : 0.f;
        const LAS float* mr = MT + j0 * 64;
#pragma unroll 1
        for (int sr = jr + 1; sr < 8; ++sr) {
            const int s0 = cb + 4 * sr;
            const f32x4 tv = *(const LAS f32x4*)(Trow + s0);
            const f32x4 m0 = *(const LAS f32x4*)(mr + s0), m1 = *(const LAS f32x4*)(mr + 64 + s0), m2 = *(const LAS f32x4*)(mr + 128 + s0), m3 = *(const LAS f32x4*)(mr + 192 + s0);
            a0 -= (tv[0] * m0[0] + tv[1] * m0[1]) + (tv[2] * m0[2] + tv[3] * m0[3]);
            a1 -= (tv[0] * m1[0] + tv[1] * m1[1]) + (tv[2] * m1[2] + tv[3] * m1[3]);
            a2 -= (tv[0] * m2[0] + tv[1] * m2[1]) + (tv[2] * m2[2] + tv[3] * m2[3]);
            a3 -= (tv[0] * m3[0] + tv[1] * m3[1]) + (tv[2] * m3[2] + tv[3] * m3[3]);
        }
        const f32x4 d0 = *(const LAS f32x4*)(mr + j0), d1 = *(const LAS f32x4*)(mr + 64 + j0), d2 = *(const LAS f32x4*)(mr + 128 + j0);
        const float t3 = a3, t2 = a2 - t3 * d2[3], t1 = a1 - t2 * d1[2] - t3 * d1[3], t0 = a0 - t1 * d0[1] - t2 * d0[2] - t3 * d0[3];
        *(LAS f32x4*)(Trow + j0) = (f32x4){t0, t1, t2, t3};
    }
    if (blk == 0) {
#pragma unroll
        for (int q = 8; q < 16; ++q) *(LAS f32x4*)(Trow + 4 * q) = (f32x4){0.f, 0.f, 0.f, 0.f}; }
    asm volatile("s_waitcnt lgkmcnt(0)" ::: "memory");
    {
        const int r = lane & 31, lh = lane >> 5;
        f32x16 Y;
#pragma unroll
        for (int e = 0; e < 16; ++e) Y[e] = 0.f;
#pragma unroll
        for (int kk = 0; kk < 2; ++kk) {
            float av[8], bv[8];
#pragma unroll
            for (int jj = 0; jj < 8; ++jj) { const int k = 16 * kk + 8 * lh + jj; av[jj] = MT[k * 64 + 32 + r]; bv[jj] = T0[k * 68 + r]; }
            Y = __builtin_amdgcn_mfma_f32_32x32x16_bf16(cvt8f((f32x4){av[0], av[1], av[2], av[3]}, (f32x4){av[4], av[5], av[6], av[7]}), cvt8f((f32x4){bv[0], bv[1], bv[2], bv[3]}, (f32x4){bv[4], bv[5], bv[6], bv[7]}), Y, 0, 0, 0);
        }
        f32x16 Z;
#pragma unroll
        for (int e = 0; e < 16; ++e) Z[e] = 0.f;
#pragma unroll
        for (int kk = 0; kk < 2; ++kk) {
            const f32x4 t0 = *(const LAS f32x4*)(T0 + (32 + r) * 68 + 32 + 16 * kk + 4 * lh), t1 = *(const LAS f32x4*)(T0 + (32 + r) * 68 + 32 + 16 * kk + 8 + 4 * lh);
            Z = __builtin_amdgcn_mfma_f32_32x32x16_bf16(cvt8f(t0, t1), cvt8(Y, 8 * kk), Z, 0, 0, 0);
        }
#pragma unroll
        for (int e = 0; e < 16; ++e) T0[(32 + (e & 3) + 8 * (e >> 2) + 4 * lh) * 68 + r] = -Z[e];
    }
    asm volatile("s_waitcnt lgkmcnt(0)" ::: "memory");
    f32x4 tr[16];
#pragma unroll
    for (int q = 0; q < 16; ++q) tr[q] = *(const LAS f32x4*)(Trow + 4 * q);
    asm volatile("s_waitcnt lgkmcnt(0)" ::: "memory");
    const LAS float* sc = (const LAS float*)(lds + L_SC);
    const LAS float* cU = sc + (dir ? 384 : 256); const LAS float* cW = sc + (dir ? 448 : 320);
    const int pos = dir ? 63 - lane : lane;
    LAS unsigned char* tu = lds + L_TB + dir * 2 * TB_SZ + pos * TB_PITCH; LAS unsigned char* tw = tu + TB_SZ;
#pragma unroll
    for (int q = 0; q < 8; ++q) {
        float u8[8], w8[8];
#pragma unroll
        for (int e = 0; e < 8; ++e) { const int s = 8 * q + e, sp = dir ? 63 - s : s; const float t = tr[sp >> 2][sp & 3]; u8[e] = t * cU[s]; w8[e] = t * cW[s]; }
        *(LAS v4u*)(tu + q * 16) = pack8f(u8); *(LAS v4u*)(tw + q * 16) = pack8f(w8);
    }
}

struct PrepRegs { v4u raw[7]; };
__device__ __forceinline__ void prep_load(Frame& F, int u, int tid, int lane, PrepRegs& R) {
    const int cn = u >> 3, hd = u & 7; const bf16* QKV = WSP(bf16, WS_QKV);
#pragma unroll
    for (int k = 0; k < 7; ++k) { const int ci = tid + 512 * k; const int row = ci / 48, cc = ci % 48, seg = cc >> 4, ch = (cc & 15) * 8, tok = 64 * cn - 2 + row;
        v4u v = (v4u){0u, 0u, 0u, 0u};
        if (ci < 68 * 48 && tok >= 0 && tok < SEQ) v = *(const v4u*)(QKV + (size_t)tok * 3072 + seg * 1024 + hd * 128 + ch);
        R.raw[k] = v; }
}
__device__ __forceinline__ void dn_prep_unit(Frame& F, int cn, int hd, PrepRegs& PR, int next_u) {
    LAS unsigned char* lds = F.lds; int tid = F.tid, lane = F.lane; const int wave = F.wave;
    asm volatile("" : "+v"(tid), "+v"(lane));
    LAS float* sc = (LAS float*)(lds + L_SC);
    __syncthreads();
    prep_load(F, cn * 8 + hd, tid, lane, PR);
#pragma unroll
    for (int k = 0; k < 7; ++k) { const int ci = tid + 512 * k; const int row = ci / 48, cc = ci % 48, seg = cc >> 4, ch = (cc & 15) * 8;
        if (ci < 68 * 48) *(LAS v4u*)(lds + L_RAW + row * RAW_PITCH + (seg * 128 + ch) * 2) = PR.raw[k]; }
    if (wave == 0) {
        const float* ab = WSP(float, WS_AB) + (size_t)(64 * cn + lane) * 32;
        const float bfv = 1.0f / (1.0f + __expf(-ab[hd])), bbv = 1.0f / (1.0f + __expf(-ab[8 + hd]));
        const float gf = -__expf(F.in[5][hd]) * softplusf(ab[16 + hd] + F.in[7][hd]), gb = -__expf(F.in[6][hd]) * softplusf(ab[24 + hd] + F.in[8][hd]);
        float Gf = gf, Gb = gb;
#pragma unroll
        for (int o = 1; o < 64; o <<= 1) { const float a = __shfl_up(Gf, o), b = __shfl_down(Gb, o); if (lane >= o) Gf += a; if (lane + o < 64) Gb += b; }
        sc[lane] = Gf; sc[64 + lane] = Gb; sc[128 + lane] = bfv; sc[192 + lane] = bbv;
        sc[256 + lane] = bfv; sc[320 + lane] = -bfv * __expf(Gf); sc[384 + lane] = bbv; sc[448 + lane] = -bbv * __expf(Gb);
        float* GL = WSP(float, WS_GL);
        if (lane == 63) GL[(0 * 8 + hd) * 256 + cn] = __expf(Gf);
        if (lane == 0) GL[(1 * 8 + hd) * 256 + cn] = __expf(Gb);
    }
    __syncthreads();
    asm volatile("" : "+v"(tid), "+v"(lane));
    {
        const int t = wave, pos = lane; const float* cw = F.in[4] + hd * 128 + 16 * t;
        float qv[16], kv[16], vv[16];
#pragma unroll
        for (int seg = 0; seg < 3; ++seg) {
            float a[16];
#pragma unroll
            for (int i = 0; i < 16; ++i) a[i] = 0.f;
#pragma unroll
            for (int j = 0; j < 5; ++j) {
                const LAS unsigned char* rp = lds + L_RAW + (pos + j) * RAW_PITCH + (seg * 128 + 16 * t) * 2;
                const v4u r0 = *(const LAS v4u*)rp, r1 = *(const LAS v4u*)(rp + 16);
                const float* w = cw + j * 3072 + seg * 1024;
#pragma unroll
                for (int i = 0; i < 4; ++i) { a[2 * i] += w[2 * i] * bflo(r0[i]); a[2 * i + 1] += w[2 * i + 1] * bfhi(r0[i]); a[8 + 2 * i] += w[8 + 2 * i] * bflo(r1[i]); a[8 + 2 * i + 1] += w[8 + 2 * i + 1] * bfhi(r1[i]); }
            }
#pragma unroll
            for (int i = 0; i < 16; ++i) { const float s = siluf(a[i]); if (seg == 0) qv[i] = s; else if (seg == 1) kv[i] = s; else vv[i] = s; }
        }
        float sq = 0.f, sk = 0.f;
#pragma unroll
        for (int i = 0; i < 16; ++i) { sq += qv[i] * qv[i]; sk += kv[i] * kv[i]; }
        LAS float* part = (LAS float*)(lds + L_PART);
        part[t * 64 + pos] = sq; part[512 + t * 64 + pos] = sk;
        __syncthreads();
        float tq = 0.f, tk = 0.f;
#pragma unroll
        for (int i = 0; i < 8; ++i) { tq += part[i * 64 + pos]; tk += part[512 + i * 64 + pos]; }
        const float rq = (1.0f / sqrtf(tq + 1e-6f)) * 0.08838834764831845f, rk = 1.0f / sqrtf(tk + 1e-6f);
#pragma unroll
        for (int i = 0; i < 16; ++i) { qv[i] *= rq; kv[i] *= rk; }
        *(LAS v4u*)(lds + L_QB + pos * 256 + (((2 * t) ^ (pos & 15)) << 4)) = pack8f(qv); *(LAS v4u*)(lds + L_QB + pos * 256 + (((2 * t + 1) ^ (pos & 15)) << 4)) = pack8f(qv + 8);
        *(LAS v4u*)(lds + L_KB + pos * 256 + (((2 * t) ^ (pos & 15)) << 4)) = pack8f(kv); *(LAS v4u*)(lds + L_KB + pos * 256 + (((2 * t + 1) ^ (pos & 15)) << 4)) = pack8f(kv + 8);
#pragma unroll
        for (int i = 0; i < 16; ++i) { *(LAS unsigned short*)(lds + L_KT + (16 * t + i) * TB_PITCH + pos * 2) = (unsigned short)f2bf(kv[i]); *(LAS unsigned short*)(lds + L_VT + (16 * t + i) * TB_PITCH + pos * 2) = (unsigned short)f2bf(vv[i]); }
        const float ef = __expf(sc[pos]), eb = __expf(sc[64 + pos]); const int mt = pos >> 5;
#pragma unroll
        for (int dir = 0; dir < 2; ++dir) { const float e = dir ? eb : ef; unsigned char* rec = dnx_rec(F, dir, hd, cn) + DX_Q;
#pragma unroll
            for (int lh = 0; lh < 2; ++lh) { float o8[8];
#pragma unroll
                for (int j = 0; j < 8; ++j) o8[j] = qv[8 * (j >> 2) + 4 * lh + (j & 3)] * e;
                *(v4u*)(rec + ((mt * 8 + t) * 64 + 32 * lh + (pos & 31)) * 16) = pack8f(o8); } }
    }
    __syncthreads();
    asm volatile("" : "+v"(tid), "+v"(lane));
    {
        const int r = lane & 31, lh = lane >> 5, x = wave & 3, ta = x >> 1, tb = x & 1;
        const LAS unsigned char* Ab = lds + L_KB + (32 * ta + r) * 256; const LAS unsigned char* Bb = lds + (wave < 4 ? L_KB : L_QB) + (32 * tb + r) * 256;
        f32x16 acc;
#pragma unroll
        for (int i = 0; i < 16; ++i) acc[i] = 0.f;
#pragma unroll
        for (int kk = 0; kk < 8; ++kk) { const int ch = ((2 * kk + lh) ^ (r & 15)) << 4;
            acc = __builtin_amdgcn_mfma_f32_32x32x16_bf16(*(const LAS bf16x8*)(Ab + ch), *(const LAS bf16x8*)(Bb + ch), acc, 0, 0, 0); }
        const int b = 32 * tb + r;
        if (wave < 4) {
            const float Gfb = sc[b], Gbb = sc[64 + b];
#pragma unroll
            for (int q = 0; q < 4; ++q) { const int a0 = 32 * ta + 8 * q + 4 * lh; f32x4 mf, mb;
#pragma unroll
                for (int e = 0; e < 4; ++e) { const int a = a0 + e; const float kkv = acc[4 * q + e];
                    const float vf = sc[128 + a] * kkv * __expf(fminf(sc[a] - Gfb, 0.f)), vb = sc[192 + a] * kkv * __expf(fminf(sc[64 + a] - Gbb, 0.f));
                    mf[e] = (a > b) ? vf : 0.f; mb[3 - e] = (a < b) ? vb : 0.f; }
                *(LAS f32x4*)(lds + L_MTF + (b * 64 + a0) * 4) = mf; *(LAS f32x4*)(lds + L_MTB + ((63 - b) * 64 + 60 - a0) * 4) = mb; }
        } else {
            const float Gfc = sc[b], Gbc = sc[64 + b];
#pragma unroll
            for (int dir = 0; dir < 2; ++dir) { unsigned char* rec = dnx_rec(F, dir, hd, cn) + DX_A;
#pragma unroll
                for (int s2 = 0; s2 < 2; ++s2) { float o8[8];
#pragma unroll
                    for (int j = 0; j < 8; ++j) { const int s = 32 * ta + 16 * s2 + 8 * (j >> 2) + 4 * lh + (j & 3); const float v = acc[8 * s2 + j];
                        const float ev = v * __expf(fminf(dir ? Gbc - sc[64 + s] : Gfc - sc[s], 0.f)); o8[j] = (dir ? (s >= b) : (s <= b)) ? ev : 0.f; }
                    *(v4u*)(rec + ((tb * 4 + 2 * ta + s2) * 64 + lane) * 16) = pack8f(o8); } }
        }
    }
    __syncthreads();
    asm volatile("" : "+v"(tid), "+v"(lane));
    if (wave == 0) dn_solve_and_write<0>(lds, lane);
    else if (wave == 1) dn_solve_and_write<1>(lds, lane);
    else {
        const int r = lane & 31, lh = lane >> 5;
        for (int f = wave - 2; f < 32; f += 6) { const int dir = f >> 4, m = (f >> 2) & 3, t = f & 3; const int dk = 32 * m + r;
            const v2u k0 = *(const LAS v2u*)(lds + L_KT + dk * TB_PITCH + (16 * t + 4 * lh) * 2), k1 = *(const LAS v2u*)(lds + L_KT + dk * TB_PITCH + (16 * t + 8 + 4 * lh) * 2);
            const float Gl = dir ? sc[64] : sc[63]; const LAS float* Gs = sc + (dir ? 64 : 0) + 16 * t + 4 * lh; float o8[8];
            o8[0] = bflo(k0.x) * __expf(Gl - Gs[0]); o8[1] = bfhi(k0.x) * __expf(Gl - Gs[1]); o8[2] = bflo(k0.y) * __expf(Gl - Gs[2]); o8[3] = bfhi(k0.y) * __expf(Gl - Gs[3]);
            o8[4] = bflo(k1.x) * __expf(Gl - Gs[8]); o8[5] = bfhi(k1.x) * __expf(Gl - Gs[9]); o8[6] = bflo(k1.y) * __expf(Gl - Gs[10]); o8[7] = bfhi(k1.y) * __expf(Gl - Gs[11]);
            *(v4u*)(dnx_rec(F, dir, hd, cn) + DX_K + ((m * 4 + t) * 64 + lane) * 16) = pack8f(o8); }
    }
    __syncthreads();
    asm volatile("" : "+v"(tid), "+v"(lane));
    {
        const int dir = wave >> 2, x = wave & 3, r = lane & 31, lh = lane >> 5;
        const LAS unsigned char* Tu = lds + L_TB + (dir ? 2 : 0) * TB_SZ; const LAS unsigned char* Tw = Tu + TB_SZ;
        unsigned char* rec = dnx_rec(F, dir, hd, cn);
#pragma unroll
        for (int mt = 0; mt < 2; ++mt) {
            f32x16 aw, au;
#pragma unroll
            for (int i = 0; i < 16; ++i) { aw[i] = 0.f; au[i] = 0.f; }
#pragma unroll
            for (int kk = 0; kk < 4; ++kk) { const int so = (16 * kk + 8 * lh) * 2;
                aw = __builtin_amdgcn_mfma_f32_32x32x16_bf16(*(const LAS bf16x8*)(lds + L_KT + (32 * x + r) * TB_PITCH + so), *(const LAS bf16x8*)(Tw + (32 * mt + r) * TB_PITCH + so), aw, 0, 0, 0);
                au = __builtin_amdgcn_mfma_f32_32x32x16_bf16(*(const LAS bf16x8*)(Tu + (32 * mt + r) * TB_PITCH + so), *(const LAS bf16x8*)(lds + L_VT + (32 * x + r) * TB_PITCH + so), au, 0, 0, 0); }
            float tmp[16];
#pragma unroll
            for (int i = 0; i < 16; ++i) tmp[i] = aw[i];
            *(v4u*)(rec + DX_W + ((mt * 8 + 2 * x) * 64 + lane) * 16) = pack8f(tmp); *(v4u*)(rec + DX_W + ((mt * 8 + 2 * x + 1) * 64 + lane) * 16) = pack8f(tmp + 8);
#pragma unroll
            for (int i = 0; i < 16; ++i) tmp[i] = au[i];
            *(v4u*)(rec + DX_U + ((x * 2 + mt) * 64 + lane) * 32) = pack8f(tmp); *(v4u*)(rec + DX_U + ((x * 2 + mt) * 64 + lane) * 32 + 16) = pack8f(tmp + 8);
        }
    }
}
__device__ __forceinline__ void dn_prep_phase(Frame& F) {
    PrepRegs PR; int u = blockIdx.x;
    for (; u < 256 * DNH; u += F.G) dn_prep_unit(F, u >> 3, u & 7, PR, u + F.G);
}


constexpr int NSEG = 16, SEGL = 16;
constexpr size_t WS_PF = 176 * MiB, WS_RG = 184 * MiB, WS_SIN = 24 * MiB;
constexpr int SLOT1 = 49152, SLOT3 = 73728, L_GLS = 147456;
#define DN_WAIT(V) asm volatile("s_waitcnt vmcnt(" #V ") lgkmcnt(0)" ::: "memory")
#define DN_BAR() do { __builtin_amdgcn_s_barrier(); asm volatile("" ::: "memory"); } while (0)
__device__ __forceinline__ int seg_chunk(int dir, int g, int i) { const int n = SEGL * g + i; return dir ? 255 - n : n; }
__device__ __forceinline__ void u_to_acc(f32x16& a, const LAS unsigned char* up) {
    const v4u u0 = *(const LAS v4u*)up, u1 = *(const LAS v4u*)(up + 16);
#pragma unroll
    for (int i = 0; i < 4; ++i) { a[2 * i] = bflo(u0[i]); a[2 * i + 1] = bfhi(u0[i]); a[8 + 2 * i] = bflo(u1[i]); a[8 + 2 * i + 1] = bfhi(u1[i]); }
}
template <bool OUT>
__device__ __forceinline__ void dn_step(f32x16 (&S)[4], f32x16 (&aV)[2], f32x16 (&aO)[2], const LAS unsigned char* buf, float gl) {
#pragma unroll
    for (int t = 0; t < 8; ++t) { const bf16x8 sb = cvt8(S[t >> 1], 8 * (t & 1));
#pragma unroll
        for (int mt = 0; mt < 2; ++mt) {
            aV[mt] = __builtin_amdgcn_mfma_f32_32x32x16_bf16(*(const LAS bf16x8*)(buf + DX_W + (mt * 8 + t) * 1024), sb, aV[mt], 0, 0, 0);
            if (OUT) aO[mt] = __builtin_amdgcn_mfma_f32_32x32x16_bf16(*(const LAS bf16x8*)(buf + DX_Q + (mt * 8 + t) * 1024), sb, aO[mt], 0, 0, 0); } }
    bf16x8 vb[4];
#pragma unroll
    for (int t = 0; t < 4; ++t) vb[t] = cvt8(aV[t >> 1], 8 * (t & 1));
#pragma unroll
    for (int m = 0; m < 4; ++m) S[m] = S[m] * gl;
#pragma unroll
    for (int t = 0; t < 4; ++t) {
#pragma unroll
        for (int m = 0; m < 4; ++m) S[m] = __builtin_amdgcn_mfma_f32_32x32x16_bf16(*(const LAS bf16x8*)(buf + DX_K + (m * 4 + t) * 1024), vb[t], S[m], 0, 0, 0);
        if (OUT) {
#pragma unroll
            for (int mt = 0; mt < 2; ++mt) aO[mt] = __builtin_amdgcn_mfma_f32_32x32x16_bf16(*(const LAS bf16x8*)(buf + DX_A + (mt * 4 + t) * 1024), vb[t], aO[mt], 0, 0, 0); } }
}

__device__ __forceinline__ void dn_pass1(Frame& F) {
    LAS unsigned char* lds = F.lds; const int lane = F.lane, wave = F.wave, r = lane & 31, lh = lane >> 5, part = wave >> 2, d = wave & 3;
    LAS float* gls = (LAS float*)(lds + L_GLS);
    for (int unit = blockIdx.x; unit < 16 * NSEG; unit += F.G) {
        const int dir = unit >> 7, hd = (unit >> 4) & 7, g = unit & 15;
        DN_WAIT(0); __syncthreads();
        if (F.tid < SEGL) gls[F.tid] = WSP(float, WS_GL)[(dir * 8 + hd) * 256 + seg_chunk(dir, g, F.tid)];
        DN_WAIT(0);
        f32x16 S[4];
#pragma unroll
        for (int m = 0; m < 4; ++m)
#pragma unroll
            for (int i = 0; i < 16; ++i) S[m][i] = (part && (32 * m + (i & 3) + 8 * (i >> 2) + 4 * lh == 32 * d + r)) ? 1.f : 0.f;
#define P1_ISSUE(i) do { const unsigned char* src_ = dnx_rec(F, dir, hd, seg_chunk(dir, g, (i))) + lane * 16; LAS unsigned char* dst_ = lds + ((i) % 3) * SLOT1; \
            _Pragma("unroll") for (int k_ = 0; k_ < 6; ++k_) { const int p_ = wave + 8 * k_; __builtin_amdgcn_global_load_lds((const unsigned*)(src_ + p_ * 1024), (LAS unsigned*)(dst_ + p_ * 1024), 16, 0, 0); } } while (0)
        P1_ISSUE(0); P1_ISSUE(1);
        for (int i = 0; i < SEGL; ++i) {
            if (i + 1 < SEGL) DN_WAIT(6); else DN_WAIT(0);
            DN_BAR();
            if (i + 2 < SEGL) P1_ISSUE(i + 2);
            const LAS unsigned char* buf = lds + (i % 3) * SLOT1 + lane * 16;
            f32x16 aV[2], aO[2];
#pragma unroll
            for (int mt = 0; mt < 2; ++mt) {
                if (part == 0) u_to_acc(aV[mt], lds + (i % 3) * SLOT1 + DX_U + ((d * 2 + mt) * 64 + lane) * 32);
                else {
#pragma unroll
                    for (int e = 0; e < 16; ++e) aV[mt][e] = 0.f; } }
            dn_step<false>(S, aV, aO, buf, gls[i]);
        }
#undef P1_ISSUE
        DN_WAIT(0); DN_BAR();
        if (part == 0) {
            float* rg = (float*)(F.ws + WS_RG) + (size_t)unit * 16384;
#pragma unroll
            for (int m = 0; m < 4; ++m)
#pragma unroll
                for (int q = 0; q < 4; ++q) *(f32x4*)(rg + ((d * 4 + m) * 64 + lane) * 16 + 4 * q) = (f32x4){S[m][4 * q], S[m][4 * q + 1], S[m][4 * q + 2], S[m][4 * q + 3]};
        } else {
#pragma unroll
            for (int m = 0; m < 4; ++m)
#pragma unroll
                for (int i = 0; i < 16; ++i) *(LAS unsigned short*)(lds + (32 * m + (i & 3) + 8 * (i >> 2) + 4 * lh) * 272 + (32 * d + r) * 2) = (unsigned short)f2bf(S[m][i]);
        }
        DN_WAIT(0); DN_BAR();
        if (part == 1) {
            unsigned char* pf = F.ws + WS_PF + (size_t)unit * 32768;
#pragma unroll
            for (int k = 0; k < 8; ++k) { const int f = d * 8 + k, m = f >> 3, t = f & 7;
                const v2u a = *(const LAS v2u*)(lds + (32 * m + r) * 272 + (16 * t + 4 * lh) * 2), b = *(const LAS v2u*)(lds + (32 * m + r) * 272 + (16 * t + 8 + 4 * lh) * 2);
                *(v4u*)(pf + (f * 64 + lane) * 16) = (v4u){a.x, a.y, b.x, b.y}; }
        }
    }
}
__device__ __forceinline__ void dn_fold(Frame& F) {
    const int b = blockIdx.x; if (b >= 16) return;
    LAS unsigned char* lds = F.lds; const int lane = F.lane, wave = F.wave, dir = b >> 3, hd = b & 7;
    const int unit0 = (dir * 8 + hd) * 16;
    __syncthreads();
    if (wave >= 4) {
        const int lw = wave - 4;
        for (int g = 0; g < NSEG; ++g) {
            if (g < NSEG - 1) { const unsigned char* src = F.ws + WS_PF + (size_t)(unit0 + g) * 32768 + lane * 16; LAS unsigned char* dst = lds + (g & 1) * 32768;
#pragma unroll
                for (int k = 0; k < 8; ++k) { const int p = lw + 4 * k; __builtin_amdgcn_global_load_lds((const unsigned*)(src + p * 1024), (LAS unsigned*)(dst + p * 1024), 16, 0, 0); } }
            DN_WAIT(0); DN_BAR();
        }
    } else {
        const int d = wave;
        f32x16 S[4], R[4];
#pragma unroll
        for (int m = 0; m < 4; ++m)
#pragma unroll
            for (int i = 0; i < 16; ++i) S[m][i] = 0.f;
        const float* rg0 = (const float*)(F.ws + WS_RG) + (size_t)unit0 * 16384; float* sin0 = (float*)(F.ws + WS_SIN) + (size_t)unit0 * 16384;
#pragma unroll
        for (int m = 0; m < 4; ++m)
#pragma unroll
            for (int q = 0; q < 4; ++q) { const f32x4 v = *(const f32x4*)(rg0 + ((d * 4 + m) * 64 + lane) * 16 + 4 * q); R[m][4 * q] = v[0]; R[m][4 * q + 1] = v[1]; R[m][4 * q + 2] = v[2]; R[m][4 * q + 3] = v[3]; }
        DN_BAR();
        for (int g = 0; g < NSEG; ++g) {
            float* so = sin0 + (size_t)g * 16384;
#pragma unroll
            for (int m = 0; m < 4; ++m)
#pragma unroll
                for (int q = 0; q < 4; ++q) *(f32x4*)(so + ((d * 4 + m) * 64 + lane) * 16 + 4 * q) = (f32x4){S[m][4 * q], S[m][4 * q + 1], S[m][4 * q + 2], S[m][4 * q + 3]};
            if (g == NSEG - 1) break;
            const LAS unsigned char* buf = lds + (g & 1) * 32768 + lane * 16;
            bf16x8 sb[8];
#pragma unroll
            for (int t = 0; t < 8; ++t) sb[t] = cvt8(S[t >> 1], 8 * (t & 1));
#pragma unroll
            for (int m = 0; m < 4; ++m) { S[m] = R[m];
#pragma unroll
                for (int t = 0; t < 8; ++t) S[m] = __builtin_amdgcn_mfma_f32_32x32x16_bf16(*(const LAS bf16x8*)(buf + (m * 8 + t) * 1024), sb[t], S[m], 0, 0, 0); }
            if (g + 1 < NSEG - 1) { const float* rg = rg0 + (size_t)(g + 1) * 16384;
#pragma unroll
                for (int m = 0; m < 4; ++m)
#pragma unroll
                    for (int q = 0; q < 4; ++q) { const f32x4 v = *(const f32x4*)(rg + ((d * 4 + m) * 64 + lane) * 16 + 4 * q); R[m][4 * q] = v[0]; R[m][4 * q + 1] = v[1]; R[m][4 * q + 2] = v[2]; R[m][4 * q + 3] = v[3]; } }
            asm volatile("s_waitcnt lgkmcnt(0)" ::: "memory");
            DN_BAR();
        }
    }
    __syncthreads();
}
__device__ __forceinline__ void dn_pass3(Frame& F) {
    LAS unsigned char* lds = F.lds; const int lane = F.lane, wave = F.wave, r = lane & 31, lh = lane >> 5;
    LAS float* gls = (LAS float*)(lds + L_GLS);
    for (int unit = blockIdx.x; unit < 16 * NSEG; unit += F.G) {
        const int dir = unit >> 7, hd = (unit >> 4) & 7, g = unit & 15;
        __syncthreads();
        if (F.tid < SEGL) gls[F.tid] = WSP(float, WS_GL)[(dir * 8 + hd) * 256 + seg_chunk(dir, g, F.tid)];
        asm volatile("s_waitcnt lgkmcnt(0)" ::: "memory");
        if (wave >= 4) {
            const int lw = wave - 4;
            for (int i = 0; i <= SEGL; ++i) {
                if (i < SEGL) { const unsigned char* src = dnx_rec(F, dir, hd, seg_chunk(dir, g, i)) + lane * 16; LAS unsigned char* dst = lds + (i & 1) * SLOT3;
#pragma unroll
                    for (int k = 0; k < 18; ++k) { const int p = lw + 4 * k; __builtin_amdgcn_global_load_lds((const unsigned*)(src + p * 1024), (LAS unsigned*)(dst + p * 1024), 16, 0, 0); } }
                DN_WAIT(0); DN_BAR();
            }
        } else {
            const int d = wave;
            f32x16 S[4];
            const float* si = (const float*)(F.ws + WS_SIN) + (size_t)unit * 16384;
#pragma unroll
            for (int m = 0; m < 4; ++m)
#pragma unroll
                for (int q = 0; q < 4; ++q) { const f32x4 v = *(const f32x4*)(si + ((d * 4 + m) * 64 + lane) * 16 + 4 * q); S[m][4 * q] = v[0]; S[m][4 * q + 1] = v[1]; S[m][4 * q + 2] = v[2]; S[m][4 * q + 3] = v[3]; }
            bf16* O = WSP(bf16, dir ? WS_OB : WS_OF);
            DN_BAR();
            for (int i = 0; i < SEGL; ++i) {
                const int cn = seg_chunk(dir, g, i); const LAS unsigned char* slot = lds + (i & 1) * SLOT3;
                f32x16 aV[2], aO[2];
#pragma unroll
                for (int mt = 0; mt < 2; ++mt) { u_to_acc(aV[mt], slot + DX_U + ((d * 2 + mt) * 64 + lane) * 32);
#pragma unroll
                    for (int e = 0; e < 16; ++e) aO[mt][e] = 0.f; }
                dn_step<true>(S, aV, aO, slot + lane * 16, gls[i]);
                bf16* op = O + (size_t)(64 * cn + 4 * lh) * 1024 + hd * 128 + 32 * d + r;
#pragma unroll
                for (int mt = 0; mt < 2; ++mt)
#pragma unroll
                    for (int e = 0; e < 16; ++e) op[(size_t)(32 * mt + (e & 3) + 8 * (e >> 2)) * 1024] = (bf16)f2bf(aO[mt][e]);
                asm volatile("s_waitcnt lgkmcnt(0)" ::: "memory");
                DN_BAR();
            }
        }
    }
    __syncthreads();
}

#ifndef MK_N_LAUNCHES
#define MK_N_LAUNCHES 1
#endif
constexpr int N_PHASES = 14;
struct Args { const float* in[23]; float* out; unsigned char* ws; int ph_lo, ph_hi; };
static_assert(sizeof(Args) == 23 * 8 + 8 + 8 + 8, "Args has no padding");

__global__ void __launch_bounds__(NWAVES * 64, 2) enc_fwd(Args args) {
    extern __shared__ __attribute__((aligned(16))) unsigned char lds[];
    Frame F;
    F.lds = (LAS unsigned char*)lds;
    F.MISC = (volatile LAS unsigned*)(F.lds + MISC_OFF);
    F.tid = threadIdx.x; F.lane = F.tid & 63; F.wave = __builtin_amdgcn_readfirstlane(F.tid >> 6);
    F.G = gridDim.x; { const int bx = blockIdx.x; F.vcu = (F.G % 8 == 0) ? (bx % 8) * (F.G / 8) + bx / 8 : bx; }
#pragma unroll
    for (int i = 0; i < 23; ++i) F.in[i] = args.in[i];
    F.out = args.out; F.ws = args.ws; F.ctl = (gu32*)(args.ws + WS_CTL);
    for (int u = F.tid; u < (LDS_BYTES - LDSCTL_OFF) / 4; u += NWAVES * 64) ((LAS unsigned*)(F.lds + LDSCTL_OFF))[u] = 0u;
    __syncthreads();
    const int lo = args.ph_lo, hi = args.ph_hi;
    XcdBarrier bar; bar.bar = (unsigned*)(F.ctl + CW_BAR); bar.x = 0; bar.st = nullptr;
    if (hi - lo > 1) bar = xcd_barrier_post((unsigned*)(F.ctl + CW_BAR), F.MISC + 8);
#define IN(k) (lo <= (k) && (k) < hi)
#define SEAM(k) do { if (IN(k) && IN((k) + 1)) xcd_barrier(bar); } while (0)
    float* sumsq2 = (float*)(F.ws + WS_CTL + CTL_SUMSQ2); float* sumsq3 = (float*)(F.ws + WS_CTL + CTL_SUMSQ3); float* sumsq4 = (float*)(F.ws + WS_CTL + CTL_SUMSQ4);

    if (IN(0)) { p0_prologue(F);
#if defined(REPEAT_PHASE) && REPEAT_PHASE == 0
        p0_prologue(F);
#endif
    } SEAM(0);
    if (IN(1)) {
        { pg8::Gemm g{WSP(bf16, WS_XB), WSP(bf16, WS_WIN), SEQ, NINP, DM}; pg8::StaticOrder S; S.init(SEQ, NINP, F.G, (int)blockIdx.x);
          EpiProj E{WSP(float, WS_RSTD1), WSP(bf16, WS_QKV), DOP(bf16, DO_Z), DOP(bf16, DO_QSW), DOP(bf16, DO_KVSW), WSP(float, WS_AB)};
          pg8::gemm_phase<EpiProj, pg8::StaticOrder, true, true>(F.lds + RING_OFF, g, S, E); }
        { pg8::Gemm g{WSP(bf16, WS_MEMB), WSP(bf16, WS_WKV), MEMT, 1024, DM}; pg8::StaticOrder S; S.init(MEMT, 1024, F.G, (int)blockIdx.x);
          EpiScaleBf16 E{WSP(float, WS_RSTDM), 0, 1.0f, WSP(bf16, WS_KVM), 1024};
          pg8::gemm_phase<EpiScaleBf16, pg8::StaticOrder, true, true>(F.lds + RING_OFF, g, S, E); }
    } SEAM(1);
    if (IN(2)) { dn_prep_phase(F);
#ifdef REPEAT_PREP
        dn_prep_phase(F);
#endif
    } SEAM(2);
    if (IN(3)) { dn_pass1(F);
#if defined(REPEAT_PHASE) && REPEAT_PHASE == 3
        dn_pass1(F);
#endif
    } SEAM(3);
    if (IN(12)) { dn_fold(F); if (F.G > 16) swa_phase(F, 16, F.G - 16); else swa_phase(F, 0, F.G); }
    if (IN(12) && IN(13)) xcd_barrier(bar);
    if (IN(13)) { dn_pass3(F);
#if defined(REPEAT_PHASE) && REPEAT_PHASE == 13
        dn_pass3(F);
#endif
    } if (IN(13) && IN(4)) xcd_barrier(bar);
    if (IN(4)) { dn_combine(F); p4_transposes(F);
#if defined(REPEAT_PHASE) && REPEAT_PHASE == 4
        dn_combine(F); p4_transposes(F);
#endif
    } SEAM(4);
    if (IN(5)) {
        pg8::Gemm g{WSP(bf16, WS_XB), WSP(bf16, WS_WOUT), SEQ, DM, DM}; pg8::StaticOrder S; S.init(SEQ, DM, F.G, (int)blockIdx.x);
        EpiRes E{F.in[0], F.out, WSP(bf16, WS_H1B), sumsq2};
        pg8::gemm_phase<EpiRes, pg8::StaticOrder, true, true>(F.lds + RING_OFF, g, S, E);
    } SEAM(5);
    if (IN(6)) {
        pg8::Gemm g{WSP(bf16, WS_H1B), WSP(bf16, WS_WQ), SEQ, 512, DM}; pg8::StaticOrder S; S.init(SEQ, 512, F.G, (int)blockIdx.x);
        EpiScaleBf16 E{sumsq2, 1, QSCALE, WSP(bf16, WS_QM), 512};
        pg8::gemm_phase<EpiScaleBf16, pg8::StaticOrder, true, true>(F.lds + RING_OFF, g, S, E);
    } SEAM(6);
    if (IN(7)) { mem_attn_phase(F);
#if defined(REPEAT_PHASE) && REPEAT_PHASE == 7
        mem_attn_phase(F);
#endif
    } SEAM(7);
    if (IN(8)) {
        pg8::Gemm g{WSP(bf16, WS_OM), WSP(bf16, WS_WO), SEQ, DM, 512}; pg8::StaticOrder S; S.init(SEQ, DM, F.G, (int)blockIdx.x);
        EpiRes E{F.out, F.out, WSP(bf16, WS_XB), sumsq3};
        pg8::gemm_phase<EpiRes, pg8::StaticOrder, true, true>(F.lds + RING_OFF, g, S, E);
    } SEAM(8);
    if (IN(9)) {
        pg8::Gemm g{WSP(bf16, WS_XB), WSP(bf16, WS_WGU), SEQ, 2 * DFF, DM}; pg8::StaticOrder S; S.init(SEQ, 2 * DFF, F.G, (int)blockIdx.x);
        EpiSwiglu E{sumsq3, WSP(bf16, WS_HID)};
        pg8::gemm_phase<EpiSwiglu, pg8::StaticOrder, true, true>(F.lds + RING_OFF, g, S, E);
#if defined(REPEAT_PHASE) && REPEAT_PHASE == 9
        pg8::gemm_phase<EpiSwiglu, pg8::StaticOrder, true, true>(F.lds + RING_OFF, g, S, E);
#endif
    } SEAM(9);
    if (IN(10)) {
        pg8::Gemm g{WSP(bf16, WS_HID), WSP(bf16, WS_WD), SEQ, DM, DFF}; pg8::StaticOrder S; S.init(SEQ, DM, F.G, (int)blockIdx.x);
        EpiRes E{F.out, nullptr, WSP(bf16, WS_H3B), sumsq4};
        pg8::gemm_phase<EpiRes, pg8::StaticOrder, true, true>(F.lds + RING_OFF, g, S, E);
    } SEAM(10);
    if (IN(11)) { final_norm(F);
#if defined(REPEAT_PHASE) && REPEAT_PHASE == 11
        final_norm(F);
#endif
    }
#undef IN
#undef SEAM
}

extern "C" void kernel_launch(void* const* d_in, const int* in_sizes, int n_in, void* d_out, int out_size, void* d_ws, size_t ws_size, hipStream_t stream) {
    static int grid = 0;
    if (grid == 0) {
        if (n_in != 23 || out_size != SEQ * DM || ws_size < WS_END) { fprintf(stderr, "kernel_launch: unexpected shapes (n_in %d out %d ws %zu)\n", n_in, out_size, ws_size); grid = -1; return; }
        int dev = 0, cus = 0;
        if (hipGetDevice(&dev) != hipSuccess || hipDeviceGetAttribute(&cus, hipDeviceAttributeMultiprocessorCount, dev) != hipSuccess) { grid = -1; return; }
        if (hipFuncSetAttribute((const void*)enc_fwd, hipFuncAttributeMaxDynamicSharedMemorySize, LDS_BYTES) != hipSuccess) { fprintf(stderr, "kernel_launch: hipFuncSetAttribute failed\n"); grid = -1; return; }
        (void)hipGetLastError();
        grid = cus;
    }
    if (grid < 0) return;
    if (hipMemsetAsync((char*)d_ws + WS_CTL, 0, CTL_ZERO_BYTES, stream) != hipSuccess) return;
    Args a{};
    for (int i = 0; i < 23; ++i) a.in[i] = (const float*)d_in[i];
    a.out = (float*)d_out; a.ws = (unsigned char*)d_ws;
    const int per = (N_PHASES + MK_N_LAUNCHES - 1) / MK_N_LAUNCHES;
    for (int lo = 0; lo < N_PHASES; lo += per) {
        a.ph_lo = lo; a.ph_hi = (lo + per < N_PHASES) ? lo + per : N_PHASES;
        hipLaunchKernelGGL(enc_fwd, dim3(grid), dim3(NWAVES * 64), LDS_BYTES, stream, a);
    }
}
```

```cpp
#include <hip/hip_runtime.h>
#include <cstdio>
#include <cstdint>
namespace pg8 {
__device__ __forceinline__ unsigned cvt_pk_bf16(float lo, float hi) { unsigned r; asm volatile("v_cvt_pk_bf16_f32 %0, %1, %2" : "=v"(r) : "v"(lo), "v"(hi)); return r; }
#define PG8_LAS __attribute__((address_space(3)))
typedef unsigned short bf16_t;
typedef short bf16x8 __attribute__((ext_vector_type(8)));
typedef float f32x4 __attribute__((ext_vector_type(4)));
typedef unsigned u32x4 __attribute__((ext_vector_type(4)));
constexpr int BM = 256, BK = 64, HALF = 128, HTB = HALF * BK * 2  , STAGE_BYTES = 8 * HTB, NXCD = 8, WGM = 8;

__host__ __device__ __forceinline__ int lds_byte(int r, int c) { const int st = (r >> 4) * 2 + (c >> 5), rr = r & 15, cc = c & 31, ob = rr * 64 + cc * 2; return st * 1024 + (ob ^ (((ob >> 9) & 1) << 5)); }
__host__ __device__ __forceinline__ void stage_rc(int b, int& R, int& C) { const int st = b / 1024, sb = b % 1024, swz = sb ^ (((sb >> 9) & 1) << 5); R = (st >> 1) * 16 + swz / 64; C = (st & 1) * 32 + (swz % 64) / 2; }
__host__ __device__ __forceinline__ int perm32(int rho) { const int n = rho >> 4, i = rho & 15; return 8 * (i >> 2) + 4 * n + (i & 3); }

struct Unit { int pm, pn; };
struct Gemm { const bf16_t* A; const bf16_t* Bt; int M, N, K; };

struct StaticOrder {
    int nM, nN, nwg, G, c;
    __host__ __device__ void init(int M, int N, int G_, int c_) { nM = M / BM; nN = N / BM; nwg = nM * nN; G = G_; c = c_; }
    __host__ __device__ bool next(int i, Unit& u) const {
        const long L = (long)i * G + c; if (L >= nwg) return false;
        int wgid = (int)L; { const int q = nwg / NXCD, r = nwg % NXCD, xcd = wgid % NXCD, off = wgid / NXCD; wgid = (xcd < r ? xcd * (q + 1) : r * (q + 1) + (xcd - r) * q) + off; }
        const int nig = WGM * nN, gid = wgid / nig, fm = gid * WGM, gsz = (nM - fm) < WGM ? (nM - fm) : WGM;
        u.pm = fm + ((wgid % nig) % gsz); u.pn = (wgid % nig) / gsz; return true;
    }
    __device__ __forceinline__ void a_ready(const Unit&) const {}
    __device__ __forceinline__ void done(const Unit&) const {}
};

template <class Epi, class Sched, bool ALIGN_EPI = false, bool SP2 = false>
__device__ __forceinline__ void gemm_phase(PG8_LAS unsigned char* lds, const Gemm g, const Sched& S, const Epi& E) {
    const int tid = threadIdx.x, wid = __builtin_amdgcn_readfirstlane(tid >> 6), lane = tid & 63, wr = wid >> 2, wc = wid & 3, fr = lane & 15, fq = lane >> 4;
    const int K = g.K, nt = K / BK;
    unsigned voffA[2], voffB[2];
#pragma unroll
    for (int i = 0; i < 2; ++i) { int R, C; stage_rc(tid * 16 + i * 8192, R, C); const int Rb = Epi::PERM ? ((R & ~31) + perm32(R & 31)) : R;
        voffA[i] = (unsigned)(R * K + C) * 2u; voffB[i] = (unsigned)(Rb * K + C) * 2u; }
    const size_t kstep = (size_t)(BK * 2);
    const size_t hstep = (size_t)HALF * K * 2;
    const size_t tstep = 2 * hstep;
    const unsigned ldsw = (unsigned)wid * 1024u;
    const int aoff = lds_byte(wr * 64 + fr, fq * 8), boff = lds_byte(wc * 32 + fr, fq * 8);
#define PG8_SA(b, h) (((b) * 2 + (h)) * HTB)
#define PG8_SB(b, h) ((4 + (b) * 2 + (h)) * HTB)
#define PG8_STAGE(bufoff, gbase, voff) do { _Pragma("unroll") for (int _i = 0; _i < 2; ++_i) \
        __builtin_amdgcn_global_load_lds((const unsigned*)((const char*)(gbase) + (voff)[_i]), (PG8_LAS unsigned*)(lds + (bufoff) + ldsw + _i * 8192), 16, 0, 0); } while (0)
#define PG8_LDA(dst, b, h) do { _Pragma("unroll") for (int m = 0; m < 4; ++m) _Pragma("unroll") for (int k = 0; k < 2; ++k) dst[m][k] = *(const PG8_LAS bf16x8*)(lds + PG8_SA(b, h) + aoff + m * 2048 + k * 1024); } while (0)
#define PG8_LDB(dst, b, h) do { _Pragma("unroll") for (int n = 0; n < 2; ++n) _Pragma("unroll") for (int k = 0; k < 2; ++k) dst[n][k] = *(const PG8_LAS bf16x8*)(lds + PG8_SB(b, h) + boff + n * 2048 + k * 1024); } while (0)
#define PG8_MMA(ai, bj, At, Bt) do { __builtin_amdgcn_s_setprio(1); _Pragma("unroll") for (int m = 0; m < 4; ++m) _Pragma("unroll") for (int n = 0; n < 2; ++n) _Pragma("unroll") for (int k = 0; k < 2; ++k) \
        acc[ai][bj][m][n] = __builtin_amdgcn_mfma_f32_16x16x32_bf16(Bt[n][k], At[m][k], acc[ai][bj][m][n], 0, 0, 0); __builtin_amdgcn_s_setprio(0); } while (0)
#define PG8_WAIT_V(n) asm volatile("s_waitcnt vmcnt(" #n ")" ::: "memory")
#define PG8_WAIT_L(n) asm volatile("s_waitcnt lgkmcnt(" #n ")" ::: "memory")
#define PG8_BAR __builtin_amdgcn_s_barrier()
#define PG8_SCHED __builtin_amdgcn_sched_barrier(0)
    Unit cur, nxt; int ui = 0;
    if (!S.next(0, cur)) return;
    f32x4 acc[2][2][4][2];
#pragma unroll
    for (int a = 0; a < 2; ++a)
#pragma unroll
        for (int b = 0; b < 2; ++b)
#pragma unroll
            for (int m = 0; m < 4; ++m)
#pragma unroll
                for (int n = 0; n < 2; ++n) acc[a][b][m][n] = (f32x4){0.f, 0.f, 0.f, 0.f};
    bf16x8 At[4][2], B0[2][2], B1[2][2];
    const char* cA = (const char*)g.A + (size_t)cur.pm * tstep; const char* cB = (const char*)g.Bt + (size_t)cur.pn * tstep;
    S.a_ready(cur);
    if constexpr (SP2) {
        PG8_STAGE(PG8_SB(0, 0), cB, voffB); PG8_STAGE(PG8_SB(0, 1), cB + hstep, voffB); PG8_STAGE(PG8_SA(0, 0), cA, voffA); PG8_STAGE(PG8_SA(0, 1), cA + hstep, voffA);
        if (wr == 1) PG8_BAR;
        PG8_WAIT_V(2); PG8_BAR;
        PG8_STAGE(PG8_SB(1, 0), cB + kstep, voffB); PG8_STAGE(PG8_SA(1, 0), cA + kstep, voffA); PG8_STAGE(PG8_SB(1, 1), cB + hstep + kstep, voffB);
        PG8_WAIT_V(6); PG8_BAR;
    } else {
        PG8_STAGE(PG8_SB(0, 0), cB, voffB); PG8_STAGE(PG8_SA(0, 0), cA, voffA); PG8_STAGE(PG8_SB(0, 1), cB + hstep, voffB); PG8_STAGE(PG8_SA(0, 1), cA + hstep, voffA);
        if (wr == 1) PG8_BAR;
        PG8_WAIT_V(4); PG8_BAR;
        PG8_STAGE(PG8_SB(1, 0), cB + kstep, voffB); PG8_STAGE(PG8_SA(1, 0), cA + kstep, voffA); PG8_STAGE(PG8_SB(1, 1), cB + hstep + kstep, voffB);
        PG8_WAIT_V(6); PG8_BAR;
    }
    for (;;) {
        const bool has_next = S.next(ui + 1, nxt);
        const char* nA = has_next ? (const char*)g.A + (size_t)nxt.pm * tstep : cA; const char* nB = has_next ? (const char*)g.Bt + (size_t)nxt.pn * tstep : cB;
        for (int t = 0; t < nt; t += 2) {
            const bool last = (t == nt - 2);
            const char* a1 = cA + (size_t)(t + 1) * kstep;
            const char* a2 = last ? nA : cA + (size_t)(t + 2) * kstep; const char* b2 = last ? nB : cB + (size_t)(t + 2) * kstep;
            const char* a3 = a2 + kstep; const char* b3 = b2 + kstep;
            if (last && has_next) S.a_ready(nxt);
            if constexpr (SP2) {
            PG8_LDB(B0, 0, 0); PG8_LDB(B1, 0, 1); PG8_SCHED; PG8_LDA(At, 0, 0); PG8_STAGE(PG8_SA(1, 1), a1 + hstep, voffA);
            PG8_WAIT_V(8); PG8_WAIT_L(0); PG8_BAR; PG8_MMA(0, 0, At, B0); PG8_MMA(0, 1, At, B1); PG8_BAR; PG8_SCHED;
            PG8_LDA(At, 0, 1); PG8_STAGE(PG8_SB(0, 0), b2, voffB); PG8_STAGE(PG8_SB(0, 1), b2 + hstep, voffB); PG8_STAGE(PG8_SA(0, 0), a2, voffA);
            PG8_WAIT_V(8); PG8_WAIT_L(0); PG8_BAR; PG8_MMA(1, 0, At, B0); PG8_MMA(1, 1, At, B1); PG8_BAR; PG8_SCHED;
            PG8_LDB(B0, 1, 0); PG8_LDB(B1, 1, 1); PG8_SCHED; PG8_LDA(At, 1, 0); PG8_STAGE(PG8_SA(0, 1), a2 + hstep, voffA);
            PG8_WAIT_V(8); PG8_WAIT_L(0); PG8_BAR; PG8_MMA(0, 0, At, B0); PG8_MMA(0, 1, At, B1); PG8_BAR; PG8_SCHED;
            PG8_LDA(At, 1, 1); PG8_STAGE(PG8_SB(1, 0), b3, voffB); PG8_STAGE(PG8_SB(1, 1), b3 + hstep, voffB); PG8_STAGE(PG8_SA(1, 0), a3, voffA);
            PG8_WAIT_V(8); PG8_WAIT_L(0); PG8_BAR; PG8_MMA(1, 0, At, B0); PG8_MMA(1, 1, At, B1); PG8_BAR; PG8_SCHED;
            } else {
            PG8_LDB(B0, 0, 0); PG8_SCHED; PG8_LDA(At, 0, 0); PG8_STAGE(PG8_SA(1, 1), a1 + hstep, voffA);
            PG8_WAIT_L(8); PG8_BAR; PG8_WAIT_L(0); PG8_MMA(0, 0, At, B0); PG8_BAR; PG8_SCHED;
            PG8_LDB(B1, 0, 1); PG8_STAGE(PG8_SB(0, 0), b2, voffB);
            PG8_BAR; PG8_WAIT_L(0); PG8_MMA(0, 1, At, B1); PG8_BAR;
            PG8_LDA(At, 0, 1); PG8_STAGE(PG8_SA(0, 0), a2, voffA);
            PG8_BAR; PG8_WAIT_L(0); PG8_MMA(1, 0, At, B0); PG8_BAR; PG8_SCHED;
            PG8_STAGE(PG8_SB(0, 1), b2 + hstep, voffB);
            PG8_WAIT_V(6); PG8_BAR; PG8_MMA(1, 1, At, B1); PG8_BAR;
            PG8_LDB(B0, 1, 0); PG8_SCHED; PG8_LDA(At, 1, 0); PG8_STAGE(PG8_SA(0, 1), a2 + hstep, voffA);
            PG8_WAIT_L(8); PG8_BAR; PG8_WAIT_L(0); PG8_MMA(0, 0, At, B0); PG8_BAR; PG8_SCHED;
            PG8_LDB(B1, 1, 1); PG8_STAGE(PG8_SB(1, 0), b3, voffB);
            PG8_BAR; PG8_WAIT_L(0); PG8_MMA(0, 1, At, B1); PG8_BAR;
            PG8_LDA(At, 1, 1); PG8_STAGE(PG8_SA(1, 0), a3, voffA);
            PG8_BAR; PG8_WAIT_L(0); PG8_MMA(1, 0, At, B0); PG8_BAR; PG8_SCHED;
            PG8_STAGE(PG8_SB(1, 1), b3 + hstep, voffB);
            PG8_WAIT_V(6); PG8_BAR; PG8_MMA(1, 1, At, B1); PG8_BAR;
            }
        }
        if constexpr (ALIGN_EPI) { if (wr == 0) PG8_BAR; }
        if constexpr (!Epi::AFTER_DRAIN) { E(acc, cur, wr, wc, fr, fq); S.done(cur); }
        if (!has_next) break;
#pragma unroll
        for (int a = 0; a < 2; ++a)
#pragma unroll
            for (int b = 0; b < 2; ++b)
#pragma unroll
                for (int m = 0; m < 4; ++m)
#pragma unroll
                    for (int n = 0; n < 2; ++n) acc[a][b][m][n] = (f32x4){0.f, 0.f, 0.f, 0.f};
        cur = nxt; cA = nA; cB = nB; ++ui;
        if constexpr (ALIGN_EPI) { if (wr == 1) PG8_BAR; }
    }
    PG8_WAIT_V(0);
    if constexpr (!ALIGN_EPI) { if (wr == 0) PG8_BAR; }
    PG8_BAR;
    if constexpr (Epi::AFTER_DRAIN) { E.fused(acc, cur, wr, wc, fr, fq, lds, wid, lane); S.done(cur); }
#undef PG8_SA
#undef PG8_SB
#undef PG8_STAGE
#undef PG8_LDA
#undef PG8_LDB
#undef PG8_MMA
#undef PG8_WAIT_V
#undef PG8_WAIT_L
#undef PG8_BAR
#undef PG8_SCHED
}
}

constexpr int NWAVES = 8;
constexpr int SEQ = 16384, DM = 2048, NIN = 5664, NINP = 5888, DFF = 5632;
constexpr int DNH = 8, HD = 128, SWH = 8, MEMH = 4, MEMT = 256;
constexpr float RMS_EPS = 1e-6f;
constexpr float LOG2E = 1.4426950408889634f;
constexpr float QSCALE = 0.08838834764831845f * 1.4426950408889634f;

constexpr size_t MiB = 1u << 20;
constexpr size_t WS_CTL = 0, CTL_ZERO_BYTES = 1 * MiB;
constexpr size_t CTL_SUMSQ2 = 256 * 1024, CTL_SUMSQ3 = 320 * 1024, CTL_SUMSQ4 = 384 * 1024;
constexpr size_t WS_RSTD1 = 1 * MiB, WS_RSTDM = 1 * MiB + 64 * 1024;
constexpr size_t WS_MEMB = 2 * MiB, WS_KVM = 3 * MiB, WS_AB = 4 * MiB, WS_BG = 6 * MiB;
constexpr size_t WS_WOUT = 8 * MiB, WS_WQ = 16 * MiB, WS_WKV = 18 * MiB, WS_WO = 22 * MiB, WS_WIN = 24 * MiB;
constexpr size_t WS_XB = 48 * MiB;
constexpr size_t WS_QKV = 112 * MiB;
constexpr size_t WS_H3B = 112 * MiB;
constexpr size_t WS_OF = 112 * MiB, WS_OB = 144 * MiB, WS_H1B = 112 * MiB, WS_QM = 176 * MiB, WS_OM = 192 * MiB;
constexpr size_t WS_DNX = 208 * MiB;
constexpr size_t WS_WGU = 208 * MiB, WS_WD = 252 * MiB, WS_HID = 274 * MiB, WS_END = 496 * MiB;
constexpr size_t DO_Z = 0, DO_QSW = 32 * MiB, DO_KVSW = 64 * MiB;
constexpr int CW_BAR = 4096;

constexpr int RING_OFF = 0, RING_BYTES = 131072;
constexpr int LDS_BYTES = 163840;
constexpr int LDSCTL_OFF = LDS_BYTES - 512, MISC_OFF = LDSCTL_OFF + 320;

#define GAS __attribute__((address_space(1)))
#define LAS __attribute__((address_space(3)))
typedef unsigned short bf16;
typedef unsigned v4u __attribute__((ext_vector_type(4)));
typedef unsigned v2u __attribute__((ext_vector_type(2)));
typedef float f32x4 __attribute__((ext_vector_type(4)));
typedef short bf16x8 __attribute__((ext_vector_type(8)));
typedef short s16x4 __attribute__((ext_vector_type(4)));
typedef GAS unsigned gu32;
#define RLX_AGENT __ATOMIC_RELAXED, __HIP_MEMORY_SCOPE_AGENT
#define LDS_WAIT() asm volatile("s_waitcnt lgkmcnt(0)" ::: "memory")
#define VM_WAIT() asm volatile("s_waitcnt vmcnt(0)" ::: "memory")
__device__ __forceinline__ unsigned f2bf(float f) { unsigned u = __builtin_bit_cast(unsigned, f); return (u + 0x7fffu + ((u >> 16) & 1u)) >> 16; }
__device__ __forceinline__ unsigned pk2(float lo, float hi) { return f2bf(lo) | (f2bf(hi) << 16); }
__device__ __forceinline__ float bf2f(unsigned short b) { return __builtin_bit_cast(float, (unsigned)b << 16); }
__device__ __forceinline__ float bflo(unsigned w) { return __builtin_bit_cast(float, w << 16); }
__device__ __forceinline__ float bfhi(unsigned w) { return __builtin_bit_cast(float, w & 0xffff0000u); }
typedef float f32x2_t __attribute__((ext_vector_type(2))); typedef __bf16 bf16x2_t __attribute__((ext_vector_type(2)));
__device__ __forceinline__ unsigned cvtpk(float lo, float hi) { f32x2_t v = {lo, hi}; bf16x2_t b = __builtin_convertvector(v, bf16x2_t); return __builtin_bit_cast(unsigned, b); }
__device__ __forceinline__ float wave_sum(float v) {
#pragma unroll
    for (int o = 1; o < 64; o <<= 1) v += __shfl_xor(v, o);
    return v;
}
__device__ __forceinline__ float siluf(float x) { return x * __builtin_amdgcn_rcpf(1.0f + __expf(-x)); }
#define XB_TMO      128
#define XB_XCNT(j)  (256  + 64 * (j))
#define XB_XSUB(j)  (1280 + 64 * (j))
#define XB_XGEN(j)  (2304 + 64 * (j))
#define XB_TOP      3328
#define XB_TOPGEN   3392
#define XCD_BAR_WORDS 3456
#define XB_SPIN_CAP (1u << 18)

__device__ __forceinline__ unsigned xb_ld(unsigned* p)              { return __hip_atomic_load(p, __ATOMIC_RELAXED, __HIP_MEMORY_SCOPE_AGENT); }
__device__ __forceinline__ unsigned xb_add(unsigned* p, unsigned v) { return __hip_atomic_fetch_add(p, v, __ATOMIC_RELAXED, __HIP_MEMORY_SCOPE_AGENT); }
__device__ __forceinline__ unsigned xb_xcc_id() { return (unsigned)__builtin_amdgcn_s_getreg((3 << 11) | 20) & 0xFu; }
#define XB_SPIN(cond, bar) do { unsigned _sp = 0; while (cond) { __builtin_amdgcn_s_sleep(1); \
    if ((++_sp & 255u) == 0u) { if (xb_ld(&(bar)[XB_TMO])) break; if (_sp > XB_SPIN_CAP) { atomicAdd(&(bar)[XB_TMO], 1u); break; } } } } while (0)

struct XcdBarrier {
    unsigned* bar; unsigned x;
    volatile LAS unsigned* st;
};

__device__ __forceinline__ XcdBarrier xcd_barrier_post(unsigned* bar, volatile LAS unsigned* st) {
    XcdBarrier b; b.bar = bar; b.x = xb_xcc_id(); b.st = st;
    if (threadIdx.x == 0) (void)xb_add(&bar[XB_XCNT(b.x)], 1u);
    return b;
}
__device__ __forceinline__ void xcd_barrier_complete(unsigned* bar, unsigned x, unsigned& nloc, unsigned& nx) {
    const unsigned G = gridDim.x * gridDim.y * gridDim.z;
    unsigned sum, cnt, mine, sp = 0u;
    for (;;) {
        sum = 0u; cnt = 0u; mine = 0u;
#pragma unroll
        for (unsigned j = 0; j < 16; ++j) { const unsigned c = xb_ld(&bar[XB_XCNT(j)]); sum += c; cnt += (c > 0u) ? 1u : 0u; mine = (j == x) ? c : mine; }
        if (sum == G) break;
        __builtin_amdgcn_s_sleep(1);
        if ((++sp & 255u) == 0u) { if (xb_ld(&bar[XB_TMO])) break; if (sp > XB_SPIN_CAP) { atomicAdd(&bar[XB_TMO], 1u); break; } }
    }
    nloc = mine > 0u ? mine : 1u; nx = cnt > 0u ? cnt : 1u;
}

__device__ __forceinline__ void xcd_barrier(const XcdBarrier& b) {
    asm volatile("s_waitcnt vmcnt(0)" ::: "memory");
    __syncthreads();
    if (threadIdx.x == 0) {
        unsigned* bar = b.bar;
        __builtin_amdgcn_s_waitcnt(0);
        unsigned nloc = b.st[0], nx = b.st[1];
        if (nloc == 0u) { xcd_barrier_complete(bar, b.x, nloc, nx); b.st[0] = nloc; b.st[1] = nx; }
        const unsigned old = xb_add(&bar[XB_XSUB(b.x)], 1u);
        const unsigned gen = old / nloc;
        if (old + 1u == (gen + 1u) * nloc) {
            __builtin_amdgcn_fence(__ATOMIC_RELEASE, "agent");
            asm volatile("s_waitcnt vmcnt(0)" ::: "memory");
            const unsigned og = xb_add(&bar[XB_TOP], 1u);
            const unsigned tg = og / nx;
            if (og + 1u == (tg + 1u) * nx) xb_add(&bar[XB_TOPGEN], 1u);
            else XB_SPIN(xb_ld(&bar[XB_TOPGEN]) == tg, bar);
            __builtin_amdgcn_fence(__ATOMIC_ACQUIRE, "agent");
            xb_add(&bar[XB_XGEN(b.x)], 1u);
            asm volatile("s_waitcnt vmcnt(0)" ::: "memory");
        } else {
            XB_SPIN(xb_ld(&bar[XB_XGEN(b.x)]) == gen, bar);
            __builtin_amdgcn_fence(__ATOMIC_ACQUIRE, "agent");
            asm volatile("s_waitcnt vmcnt(0)" ::: "memory");
        }
    }
    __syncthreads();
}

using pg8::Unit;
__device__ __forceinline__ v4u pack8(f32x4 v0, f32x4 v1) { v4u w; w.x = cvtpk(v0[0], v0[1]); w.y = cvtpk(v0[2], v0[3]); w.z = cvtpk(v1[0], v1[1]); w.w = cvtpk(v1[2], v1[3]); return w; }

struct EpiProj {
    static constexpr bool PERM = true, AFTER_DRAIN = false;
    const float* rstd; bf16* qkv; bf16* z; bf16* qsw; bf16* kvsw; float* ab;
    __device__ __forceinline__ void operator()(const f32x4 (&acc)[2][2][4][2], const Unit& u, int wr, int wc, int fr, int fq) const {
        const int pn = u.pn; bf16* base; int ldc, colt; float sc = 1.f;
        if (pn < 12) { base = qkv; ldc = 3072; colt = pn * 256; }
        else if (pn < 16) { base = z; ldc = 1024; colt = (pn - 12) * 256; }
        else if (pn < 20) { base = qsw; ldc = 1024; colt = (pn - 16) * 256; sc = QSCALE; }
        else if (pn < 22) { base = kvsw; ldc = 512; colt = (pn - 20) * 256; }
        else { base = nullptr; ldc = 0; colt = 0; }
        const int row0 = u.pm * 256 + wr * 64 + fr, col0 = colt + wc * 32 + 8 * fq;
        float rsv[2][4];
#pragma unroll
        for (int ai = 0; ai < 2; ++ai)
#pragma unroll
            for (int m = 0; m < 4; ++m) rsv[ai][m] = rstd[row0 + ai * 128 + m * 16];
#pragma unroll
        for (int ai = 0; ai < 2; ++ai)
#pragma unroll
            for (int m = 0; m < 4; ++m) {
                const int row = row0 + ai * 128 + m * 16; const float rs = rsv[ai][m] * sc;
                if (base) {
                    bf16* rowp = base + (size_t)row * ldc + col0;
#pragma unroll
                    for (int bj = 0; bj < 2; ++bj) *(v4u*)(rowp + bj * 128) = pack8(acc[ai][bj][m][0] * rs, acc[ai][bj][m][1] * rs);
                } else if (wc == 0) {
                    float* rowp = ab + (size_t)row * 32 + 8 * fq;
                    *(f32x4*)(rowp) = acc[ai][0][m][0] * rs; *(f32x4*)(rowp + 4) = acc[ai][0][m][1] * rs;
                }
            }
    }
};
struct EpiScaleBf16 {
    static constexpr bool PERM = true, AFTER_DRAIN = false;
    const float* rs; int from_sumsq; float sc; bf16* O; int ldc;
    __device__ __forceinline__ void operator()(const f32x4 (&acc)[2][2][4][2], const Unit& u, int wr, int wc, int fr, int fq) const {
        const int row0 = u.pm * 256 + wr * 64 + fr, col0 = u.pn * 256 + wc * 32 + 8 * fq;
        float rsv[2][4];
#pragma unroll
        for (int ai = 0; ai < 2; ++ai)
#pragma unroll
            for (int m = 0; m < 4; ++m) rsv[ai][m] = rs[row0 + ai * 128 + m * 16];
#pragma unroll
        for (int ai = 0; ai < 2; ++ai)
#pragma unroll
            for (int m = 0; m < 4; ++m) {
                const int row = row0 + ai * 128 + m * 16; float r = rsv[ai][m];
                if (from_sumsq) r = __builtin_amdgcn_rsqf(r * (1.0f / DM) + RMS_EPS);
                r *= sc; bf16* rowp = O + (size_t)row * ldc + col0;
#pragma unroll
                for (int bj = 0; bj < 2; ++bj) *(v4u*)(rowp + bj * 128) = pack8(acc[ai][bj][m][0] * r, acc[ai][bj][m][1] * r);
            }
    }
};
struct EpiRes {
    static constexpr bool PERM = true, AFTER_DRAIN = false;
    const float* res; float* out; bf16* ob; float* sumsq;
    __device__ __forceinline__ void operator()(const f32x4 (&acc)[2][2][4][2], const Unit& u, int wr, int wc, int fr, int fq) const {
        const int row0 = u.pm * 256 + wr * 64 + fr, col0 = u.pn * 256 + wc * 32 + 8 * fq;
#pragma unroll
        for (int ai = 0; ai < 2; ++ai) {
            f32x4 rr[4][2][2];
#pragma unroll
            for (int m = 0; m < 4; ++m) { const size_t off = (size_t)(row0 + ai * 128 + m * 16) * DM + col0;
#pragma unroll
                for (int bj = 0; bj < 2; ++bj) { rr[m][bj][0] = *(const f32x4*)(res + off + bj * 128); rr[m][bj][1] = *(const f32x4*)(res + off + bj * 128 + 4); } }
            asm volatile("" ::: "memory");
#pragma unroll
            for (int m = 0; m < 4; ++m) {
                const int row = row0 + ai * 128 + m * 16; const size_t off = (size_t)row * DM + col0; float ss = 0.f;
#pragma unroll
                for (int bj = 0; bj < 2; ++bj) {
                    const f32x4 v0 = acc[ai][bj][m][0] + rr[m][bj][0], v1 = acc[ai][bj][m][1] + rr[m][bj][1];
                    if (out) { *(f32x4*)(out + off + bj * 128) = v0; *(f32x4*)(out + off + bj * 128 + 4) = v1; }
                    if (ob) *(v4u*)(ob + off + bj * 128) = pack8(v0, v1);
                    ss += (v0[0] * v0[0] + v0[1] * v0[1]) + (v0[2] * v0[2] + v0[3] * v0[3]) + (v1[0] * v1[0] + v1[1] * v1[1]) + (v1[2] * v1[2] + v1[3] * v1[3]);
                }
                ss += __shfl_xor(ss, 16); ss += __shfl_xor(ss, 32);
                if (fq == 0) atomicAdd(sumsq + row, ss);
            }
            asm volatile("" ::: "memory");
        }
    }
};
struct EpiSwiglu {
    static constexpr bool PERM = true, AFTER_DRAIN = false;
    const float* sumsq; bf16* H;
    __device__ __forceinline__ void operator()(const f32x4 (&acc)[2][2][4][2], const Unit& u, int wr, int wc, int fr, int fq) const {
        const int row0 = u.pm * 256 + wr * 64 + fr, col0 = u.pn * 128 + wc * 32 + 8 * fq;
        float rsv[2][4];
#pragma unroll
        for (int ai = 0; ai < 2; ++ai)
#pragma unroll
            for (int m = 0; m < 4; ++m) rsv[ai][m] = sumsq[row0 + ai * 128 + m * 16];
#pragma unroll
        for (int ai = 0; ai < 2; ++ai)
#pragma unroll
            for (int m = 0; m < 4; ++m) {
                const int row = row0 + ai * 128 + m * 16; const float r = __builtin_amdgcn_rsqf(rsv[ai][m] * (1.0f / DM) + RMS_EPS);
                f32x4 h[2];
#pragma unroll
                for (int n = 0; n < 2; ++n)
#pragma unroll
                    for (int e = 0; e < 4; ++e) { const float g = acc[ai][0][m][n][e] * r, up = acc[ai][1][m][n][e] * r; h[n][e] = siluf(g) * up; }
                *(v4u*)(H + (size_t)row * DFF + col0) = pack8(h[0], h[1]);
            }
    }
};

struct Frame {
    LAS unsigned char* lds;
    volatile LAS unsigned* MISC;
    gu32* ctl;
    int tid, lane, wave, vcu, G;
    const float* in[23]; float* out; unsigned char* ws;
};
#define WSP(T, off) ((T*)(F.ws + (off)))
#define DOP(T, off) ((T*)((unsigned char*)F.out + (off)))

__device__ __forceinline__ void tr_item(const float* W, int K, int Nsrc, int src_col0, const float* gain, bf16* WT, int dst_row0, int k0, LAS float* scr, int lane) {
    float v[32];
#pragma unroll
    for (int i = 0; i < 32; ++i) { const int kk = 2 * i + (lane >> 5); v[i] = (src_col0 >= 0) ? W[(size_t)(k0 + kk) * Nsrc + src_col0 + (lane & 31)] : 0.f; }
    if (gain) {
#pragma unroll
        for (int i = 0; i < 32; ++i) v[i] *= gain[k0 + 2 * i + (lane >> 5)]; }
#pragma unroll
    for (int i = 0; i < 32; ++i) scr[(2 * i + (lane >> 5)) * 33 + (lane & 31)] = v[i];
    LDS_WAIT(); asm volatile("" ::: "memory");
    const int c = lane & 7;
#pragma unroll
    for (int j = 0; j < 4; ++j) { const int n = (lane >> 3) + 8 * j; const LAS float* s = scr + (8 * c) * 33 + n;
        v4u o; o.x = pk2(s[0 * 33], s[1 * 33]); o.y = pk2(s[2 * 33], s[3 * 33]); o.z = pk2(s[4 * 33], s[5 * 33]); o.w = pk2(s[6 * 33], s[7 * 33]);
        *(GAS v4u*)(WT + (size_t)(dst_row0 + n) * K + k0 + 8 * c) = o; }
    LDS_WAIT(); asm volatile("" ::: "memory");
}
__device__ __forceinline__ int win_src_col(int c) {
    if (c < 4096) return c;
    if (c < 5120) return c - 4096 + 4128;
    if (c < 5376) return c - 5120 + 5152;
    if (c < 5632) return c - 5376 + 5408;
    if (c < 5664) return c - 5632 + 4096;
    return -1;
}
__device__ __forceinline__ void row_to_bf16_rstd(const float* xrow, bf16* orow, float* rstd_out, int lane) {
    const GAS f32x4* xr = (const GAS f32x4*)xrow + lane;
    f32x4 v[8]; float s = 0.f;
#pragma unroll
    for (int j = 0; j < 8; ++j) { v[j] = xr[64 * j]; s += (v[j].x * v[j].x + v[j].y * v[j].y) + (v[j].z * v[j].z + v[j].w * v[j].w); }
    s = wave_sum(s);
    if (lane == 0) *rstd_out = 1.0f / sqrtf(s * (1.0f / DM) + RMS_EPS);
    GAS v2u* o8 = (GAS v2u*)orow + lane;
#pragma unroll
    for (int j = 0; j < 8; ++j) { v2u w; w.x = pk2(v[j].x, v[j].y); w.y = pk2(v[j].z, v[j].w); o8[64 * j] = w; }
}

__device__ __forceinline__ void p0_prologue(Frame& F) {
    LAS float* scr = (LAS float*)(F.lds + RING_OFF + F.wave * 16384);
    const int gw = F.vcu * NWAVES + F.wave, NGW = F.G * NWAVES;
    constexpr int I_IN = 32 * (NINP / 32), I_OUT = 32 * 64, I_Q = 32 * 16, I_KV = 32 * 32, I_O = 8 * 64;
    constexpr int NITEMS = I_IN + I_OUT + I_Q + I_KV + I_O;
    for (int it = gw; it < NITEMS; it += NGW) {
        int r = it;
        if (r < I_IN) { const int nblk = NINP / 32, kb = r / nblk, nb = r % nblk; tr_item(F.in[3], DM, NIN, win_src_col(nb * 32), F.in[2], WSP(bf16, WS_WIN), nb * 32, kb * 64, scr, F.lane); continue; } r -= I_IN;
        if (r < I_OUT) { const int kb = r / 64, nb = r % 64; tr_item(F.in[12], DM, DM, nb * 32, nullptr, WSP(bf16, WS_WOUT), nb * 32, kb * 64, scr, F.lane); continue; } r -= I_OUT;
        if (r < I_Q) { const int kb = r / 16, nb = r % 16; tr_item(F.in[15], DM, 512, nb * 32, F.in[13], WSP(bf16, WS_WQ), nb * 32, kb * 64, scr, F.lane); continue; } r -= I_Q;
        if (r < I_KV) { const int kb = r / 32, nb = r % 32; tr_item(F.in[16], DM, 1024, nb * 32, F.in[14], WSP(bf16, WS_WKV), nb * 32, kb * 64, scr, F.lane); continue; } r -= I_KV;
        { const int kb = r / 64, nb = r % 64; tr_item(F.in[17], 512, DM, nb * 32, nullptr, WSP(bf16, WS_WO), nb * 32, kb * 64, scr, F.lane); }
    }
    for (int m = gw; m < SEQ; m += 2 * NGW) {
        const int m2 = m + NGW; const bool two = m2 < SEQ;
        const GAS f32x4* xa = (const GAS f32x4*)(F.in[0] + (size_t)m * DM) + F.lane; const GAS f32x4* xb_ = (const GAS f32x4*)(F.in[0] + (size_t)(two ? m2 : m) * DM) + F.lane;
        f32x4 va[8], vb[8]; float sa = 0.f, sb = 0.f;
#pragma unroll
        for (int j = 0; j < 8; ++j) { va[j] = xa[64 * j]; vb[j] = xb_[64 * j]; }
#pragma unroll
        for (int j = 0; j < 8; ++j) { sa += (va[j].x * va[j].x + va[j].y * va[j].y) + (va[j].z * va[j].z + va[j].w * va[j].w); sb += (vb[j].x * vb[j].x + vb[j].y * vb[j].y) + (vb[j].z * vb[j].z + vb[j].w * vb[j].w); }
        sa = wave_sum(sa); sb = wave_sum(sb);
        if (F.lane == 0) { WSP(float, WS_RSTD1)[m] = 1.0f / sqrtf(sa * (1.0f / DM) + RMS_EPS); if (two) WSP(float, WS_RSTD1)[m2] = 1.0f / sqrtf(sb * (1.0f / DM) + RMS_EPS); }
        GAS v2u* oa = (GAS v2u*)(WSP(bf16, WS_XB) + (size_t)m * DM) + F.lane; GAS v2u* ob = (GAS v2u*)(WSP(bf16, WS_XB) + (size_t)m2 * DM) + F.lane;
#pragma unroll
        for (int j = 0; j < 8; ++j) { v2u w; w.x = pk2(va[j].x, va[j].y); w.y = pk2(va[j].z, va[j].w); oa[64 * j] = w; }
        if (two) {
#pragma unroll
            for (int j = 0; j < 8; ++j) { v2u w; w.x = pk2(vb[j].x, vb[j].y); w.y = pk2(vb[j].z, vb[j].w); ob[64 * j] = w; } }
    }
    for (int m = gw; m < MEMT; m += NGW) row_to_bf16_rstd(F.in[1] + (size_t)m * DM, WSP(bf16, WS_MEMB) + (size_t)m * DM, WSP(float, WS_RSTDM) + m, F.lane);
}
__device__ __forceinline__ void p4_transposes(Frame& F) {
    LAS float* scr = (LAS float*)(F.lds + RING_OFF + F.wave * 16384);
    const int gw = F.vcu * NWAVES + F.wave, NGW = F.G * NWAVES;
    constexpr int I_GU = 32 * (2 * DFF / 32), I_D = (DFF / 64) * 64;
    for (int it = gw; it < I_GU + I_D; it += NGW) {
        int r = it;
        if (r < I_GU) { const int nblk = 2 * DFF / 32, kb = r / nblk, nb = r % nblk; const int row = nb * 32, t = row / 256, w = row % 256;
            const float* src = (w < 128) ? F.in[19] : F.in[20]; const int sc = 128 * t + (w & 127);
            tr_item(src, DM, DFF, sc, F.in[18], WSP(bf16, WS_WGU), row, kb * 64, scr, F.lane); continue; } r -= I_GU;
        { const int kb = r / 64, nb = r % 64; tr_item(F.in[21], DFF, DM, nb * 32, nullptr, WSP(bf16, WS_WD), nb * 32, kb * 64, scr, F.lane); }
    }
}

__device__ __forceinline__ float softplusf(float x) { return x > 20.f ? x : log1pf(__expf(x)); }
__device__ __forceinline__ void dn_combine(Frame& F) {
    const int gw = F.vcu * NWAVES + F.wave, NGW = F.G * NWAVES, lane = F.lane;
    const bf16* OFp = WSP(bf16, WS_OF); const bf16* OBp = WSP(bf16, WS_OB); const bf16* Z = DOP(bf16, DO_Z); bf16* Y = WSP(bf16, WS_XB); const float* gn = F.in[9];
    const int cb = (16 * lane) & 127; float gv[16];
#pragma unroll
    for (int i = 0; i < 16; ++i) gv[i] = gn[cb + i];
    for (int t0 = gw; t0 < SEQ; t0 += 2 * NGW) {
        v4u a[2][2], b[2][2], z[2][2];
#pragma unroll
        for (int k = 0; k < 2; ++k) { const int t = (t0 + k * NGW < SEQ) ? t0 + k * NGW : t0; const size_t off = (size_t)t * 1024 + 16 * lane;
            a[k][0] = *(const v4u*)(OFp + off); a[k][1] = *(const v4u*)(OFp + off + 8); b[k][0] = *(const v4u*)(OBp + off); b[k][1] = *(const v4u*)(OBp + off + 8);
            z[k][0] = *(const v4u*)(Z + off); z[k][1] = *(const v4u*)(Z + off + 8); }
#pragma unroll
        for (int k = 0; k < 2; ++k) {
            const int t = t0 + k * NGW; if (t >= SEQ) break;
            float o[16], zz[16];
#pragma unroll
            for (int i = 0; i < 4; ++i) { o[2 * i] = bflo(a[k][0][i]) + bflo(b[k][0][i]); o[2 * i + 1] = bfhi(a[k][0][i]) + bfhi(b[k][0][i]); o[8 + 2 * i] = bflo(a[k][1][i]) + bflo(b[k][1][i]); o[8 + 2 * i + 1] = bfhi(a[k][1][i]) + bfhi(b[k][1][i]);
                zz[2 * i] = bflo(z[k][0][i]); zz[2 * i + 1] = bfhi(z[k][0][i]); zz[8 + 2 * i] = bflo(z[k][1][i]); zz[8 + 2 * i + 1] = bfhi(z[k][1][i]); }
            float ss = 0.f;
#pragma unroll
            for (int i = 0; i < 16; ++i) ss += o[i] * o[i];
            ss += __shfl_xor(ss, 1); ss += __shfl_xor(ss, 2); ss += __shfl_xor(ss, 4);
            const float rs = __builtin_amdgcn_rsqf(ss * (1.0f / 128.0f) + RMS_EPS);
            float y[16];
#pragma unroll
            for (int i = 0; i < 16; ++i) y[i] = o[i] * rs * gv[i] * siluf(zz[i]);
            v4u w0, w1;
#pragma unroll
            for (int i = 0; i < 4; ++i) { w0[i] = pk2(y[2 * i], y[2 * i + 1]); w1[i] = pk2(y[8 + 2 * i], y[8 + 2 * i + 1]); }
            bf16* yp = Y + (size_t)t * DM + 16 * lane; *(v4u*)yp = w0; *(v4u*)(yp + 8) = w1;
        }
    }
}
__device__ __forceinline__ void final_norm(Frame& F) {
    const int gw = F.vcu * NWAVES + F.wave, NGW = F.G * NWAVES, lane = F.lane;
    const float* ss = (const float*)(F.ws + WS_CTL + CTL_SUMSQ4); const GAS f32x4* g = (const GAS f32x4*)F.in[22]; const bf16* H3 = WSP(bf16, WS_H3B);
    for (int m0 = gw; m0 < SEQ; m0 += 2 * NGW) {
        v4u w[2][4]; float r[2];
#pragma unroll
        for (int k = 0; k < 2; ++k) { const int m = (m0 + k * NGW < SEQ) ? m0 + k * NGW : m0; const GAS v4u* hp = (const GAS v4u*)(H3 + (size_t)m * DM);
            r[k] = ss[m];
#pragma unroll
            for (int j = 0; j < 4; ++j) w[k][j] = hp[64 * j + lane]; }
#pragma unroll
        for (int k = 0; k < 2; ++k) {
            const int m = m0 + k * NGW; if (m >= SEQ) break;
            const float rr = __builtin_amdgcn_rsqf(r[k] * (1.0f / DM) + RMS_EPS);
            GAS f32x4* o = (GAS f32x4*)(F.out + (size_t)m * DM);
#pragma unroll
            for (int j = 0; j < 4; ++j) { const v4u x = w[k][j]; const int c4 = 2 * (64 * j + lane); const f32x4 g0 = g[c4], g1 = g[c4 + 1];
                o[c4] = (f32x4){bflo(x.x) * rr * g0[0], bfhi(x.x) * rr * g0[1], bflo(x.y) * rr * g0[2], bfhi(x.y) * rr * g0[3]};
                o[c4 + 1] = (f32x4){bflo(x.z) * rr * g1[0], bfhi(x.z) * rr * g1[1], bflo(x.w) * rr * g1[2], bfhi(x.w) * rr * g1[3]}; }
        }
    }
}

__device__ __forceinline__ int t5_bucket(int rel) {
    const int n = rel < 0 ? -rel : rel; int b;
    if (n < 8) b = n; else { int k = (31 - __builtin_clz((unsigned)(n * n))) - 6; b = 8 + k; if (b > 15) b = 15; }
    return (rel > 0 ? 16 : 0) + b;
}
template <int MODE  >
__device__ __forceinline__ void attn_unit(Frame& F, const bf16* Q, int qpitch, const bf16* Kp, const bf16* Vp, int kvpitch, bf16* O, int opitch, int q0, int kt_beg, int kt_end, const LAS float* btab, float sink2) {
    LAS unsigned char* Ks = F.lds + RING_OFF; LAS unsigned char* Vs = Ks + 16384;
    const int lane = F.lane, c = lane & 15, g = lane >> 4, qw0 = q0 + 16 * F.wave, tid = F.tid;
    bf16x8 qf[4];
#pragma unroll
    for (int t = 0; t < 4; ++t) qf[t] = *(const bf16x8*)(Q + (size_t)(qw0 + c) * qpitch + 32 * t + 8 * g);
    f32x4 oacc[8];
#pragma unroll
    for (int i = 0; i < 8; ++i) oacc[i] = (f32x4){0.f, 0.f, 0.f, 0.f};
    float mrun = (MODE == 0) ? sink2 : -1e30f, lsum = (MODE == 0 && g == 0) ? 1.0f : 0.0f;
    v4u kpre[2], vpre[2];
#pragma unroll
    for (int i = 0; i < 2; ++i) { const int ci = tid + 512 * i, key = ci >> 4, ch = ci & 15;
        kpre[i] = *(const v4u*)(Kp + (size_t)(64 * kt_beg + key) * kvpitch + ch * 8); vpre[i] = *(const v4u*)(Vp + (size_t)(64 * kt_beg + key) * kvpitch + ch * 8); }
    for (int kt = kt_beg; kt < kt_end; ++kt) {
        __syncthreads();
#pragma unroll
        for (int i = 0; i < 2; ++i) { const int ci = tid + 512 * i, key = ci >> 4, ch = ci & 15;
            *(LAS v4u*)(Ks + key * 256 + ((ch ^ (key & 15)) << 4)) = kpre[i]; *(LAS v4u*)(Vs + key * 256 + ((ch ^ ((key & 7) << 1)) << 4)) = vpre[i]; }
        if (kt + 1 < kt_end) {
#pragma unroll
            for (int i = 0; i < 2; ++i) { const int ci = tid + 512 * i, key = ci >> 4, ch = ci & 15;
                kpre[i] = *(const v4u*)(Kp + (size_t)(64 * (kt + 1) + key) * kvpitch + ch * 8); vpre[i] = *(const v4u*)(Vp + (size_t)(64 * (kt + 1) + key) * kvpitch + ch * 8); } }
        __syncthreads();
        bool rel_ok = true;
        if (MODE == 0) rel_ok = (64 * kt <= qw0 + 15 + 128) && (64 * kt + 63 >= qw0 - 128);
        if (!rel_ok) continue;
        f32x4 s[4];
#pragma unroll
        for (int mt = 0; mt < 4; ++mt) s[mt] = (f32x4){0.f, 0.f, 0.f, 0.f};
#pragma unroll
        for (int t = 0; t < 4; ++t)
#pragma unroll
            for (int mt = 0; mt < 4; ++mt) { const bf16x8 kf = *(const LAS bf16x8*)(Ks + (16 * mt + c) * 256 + (((4 * t + g) ^ c) << 4));
                s[mt] = __builtin_amdgcn_mfma_f32_16x16x32_bf16(kf, qf[t], s[mt], 0, 0, 0); }
        float tmax = -INFINITY;
#pragma unroll
        for (int mt = 0; mt < 4; ++mt)
#pragma unroll
            for (int r = 0; r < 4; ++r) {
                if (MODE == 0) { const int rel = (64 * kt + 16 * mt + 4 * g + r) - (qw0 + c); const bool ok = (rel >= -128) && (rel <= 128);
                    const int ri = ok ? rel + 128 : 128; const float bv = btab[ri]; s[mt][r] = ok ? s[mt][r] + bv : -INFINITY; }
                tmax = fmaxf(tmax, s[mt][r]); }
        tmax = fmaxf(tmax, __shfl_xor(tmax, 16)); tmax = fmaxf(tmax, __shfl_xor(tmax, 32));
        const float mnew = fmaxf(mrun, tmax), alpha = __builtin_amdgcn_exp2f(mrun - mnew); mrun = mnew; float ps = 0.f;
#pragma unroll
        for (int mt = 0; mt < 4; ++mt)
#pragma unroll
            for (int r = 0; r < 4; ++r) { const float p = __builtin_amdgcn_exp2f(s[mt][r] - mnew); s[mt][r] = p; ps += p; }
        lsum = lsum * alpha + ps;
#pragma unroll
        for (int i = 0; i < 8; ++i) oacc[i] = oacc[i] * alpha;
        bf16x8 pf[2];
#pragma unroll
        for (int t2 = 0; t2 < 2; ++t2) { v4u w; w.x = cvtpk(s[2 * t2][0], s[2 * t2][1]); w.y = cvtpk(s[2 * t2][2], s[2 * t2][3]); w.z = cvtpk(s[2 * t2 + 1][0], s[2 * t2 + 1][1]); w.w = cvtpk(s[2 * t2 + 1][2], s[2 * t2 + 1][3]);
            pf[t2] = __builtin_bit_cast(bf16x8, w); }
        const int q4 = c >> 2, p4 = c & 3;
#pragma unroll
        for (int t2 = 0; t2 < 2; ++t2)
#pragma unroll
            for (int mo = 0; mo < 8; ++mo) {
                const int k1 = 32 * t2 + 4 * g + q4, k2 = k1 + 16, chn = 2 * mo + (p4 >> 1);
                const s16x4 lo = __builtin_bit_cast(s16x4, __builtin_amdgcn_ds_read_tr16_b64_v4i16((LAS s16x4*)(Vs + k1 * 256 + ((chn ^ ((k1 & 7) << 1)) << 4) + (p4 & 1) * 8)));
                const s16x4 hi = __builtin_bit_cast(s16x4, __builtin_amdgcn_ds_read_tr16_b64_v4i16((LAS s16x4*)(Vs + k2 * 256 + ((chn ^ ((k2 & 7) << 1)) << 4) + (p4 & 1) * 8)));
                const bf16x8 vf = (bf16x8){lo[0], lo[1], lo[2], lo[3], hi[0], hi[1], hi[2], hi[3]};
                oacc[mo] = __builtin_amdgcn_mfma_f32_16x16x32_bf16(vf, pf[t2], oacc[mo], 0, 0, 0); }
    }
    lsum += __shfl_xor(lsum, 16); lsum += __shfl_xor(lsum, 32);
    const float inv = 1.0f / lsum;
#pragma unroll
    for (int mo = 0; mo < 8; ++mo) { v2u w; w.x = cvtpk(oacc[mo][0] * inv, oacc[mo][1] * inv); w.y = cvtpk(oacc[mo][2] * inv, oacc[mo][3] * inv);
        *(v2u*)(O + (size_t)(qw0 + c) * opitch + 16 * mo + 4 * g) = w; }
}
__device__ __forceinline__ void swa_phase(Frame& F, int b0, int nb) {
    LAS float* btab = (LAS float*)(F.lds + RING_OFF + 32768);
    const bf16* QS = DOP(bf16, DO_QSW); const bf16* KV = DOP(bf16, DO_KVSW); bf16* Y = WSP(bf16, WS_XB);
    if ((int)blockIdx.x < b0) return;
    for (int u = blockIdx.x - b0; u < SWH * (SEQ / 128); u += nb) {
        const int h = u & 7, qb = u >> 3, kvh = h >> 2;
        __syncthreads();
        if (F.tid < 257) btab[F.tid] = F.in[11][t5_bucket(F.tid - 128) * 8 + h] * LOG2E;
        __syncthreads();
        int kb = 2 * qb - 2, ke = 2 * qb + 4; if (kb < 0) kb = 0; if (ke > SEQ / 64) ke = SEQ / 64;
        attn_unit<0>(F, QS + h * 128, 1024, KV + kvh * 128, KV + 256 + kvh * 128, 512, Y + 1024 + h * 128, DM, qb * 128, kb, ke, btab, F.in[10][h] * LOG2E);
    }
}
__device__ __forceinline__ void mem_attn_phase(Frame& F) {
    const bf16* QM = WSP(bf16, WS_QM); const bf16* KVm = WSP(bf16, WS_KVM); bf16* OM = WSP(bf16, WS_OM);
    for (int u = blockIdx.x; u < MEMH * (SEQ / 128); u += F.G) {
        const int h = u & 3, qb = u >> 2;
        attn_unit<1>(F, QM + h * 128, 512, KVm + h * 128, KVm + 512 + h * 128, 1024, OM + h * 128, 512, qb * 128, 0, 4, nullptr, 0.f);
    }
}

typedef float f32x16 __attribute__((ext_vector_type(16)));
constexpr int DX_W = 0, DX_K = 16384, DX_U = 32768, DX_Q = 49152, DX_A = 65536, DX_BYTES = 73728;
constexpr size_t WS_GL = 1 * MiB + 128 * 1024;
constexpr int L_RAW = 0, RAW_PITCH = 784, L_MTF = 0, L_MTB = 16384, L_TB = 32768, TB_PITCH = 144, TB_SZ = 9216;
constexpr int L_QB = 69632, L_KB = 86016, L_KT = 102400, L_VT = 120832, L_PART = 139264, L_SC = 143360;
constexpr int L_CW = 145408;
static_assert(L_SC + 2048 <= L_CW && L_CW + 7680 <= LDSCTL_OFF, "prep LDS map");
__device__ __forceinline__ unsigned char* dnx_rec(Frame& F, int dir, int hd, int cn) { return F.ws + WS_DNX + (size_t)((dir * 8 + hd) * 256 + cn) * DX_BYTES; }
__device__ __forceinline__ v4u pack8f(const float* v) { v4u w; w.x = cvtpk(v[0], v[1]); w.y = cvtpk(v[2], v[3]); w.z = cvtpk(v[4], v[5]); w.w = cvtpk(v[6], v[7]); return w; }

__device__ __forceinline__ bf16x8 cvt8(const f32x16& v, int o) { v4u w; w.x = cvtpk(v[o], v[o + 1]); w.y = cvtpk(v[o + 2], v[o + 3]); w.z = cvtpk(v[o + 4], v[o + 5]); w.w = cvtpk(v[o + 6], v[o + 7]); return __builtin_bit_cast(bf16x8, w); }
__device__ __forceinline__ bf16x8 cvt8f(f32x4 a, f32x4 b) { v4u w; w.x = cvtpk(a[0], a[1]); w.y = cvtpk(a[2], a[3]); w.z = cvtpk(b[0], b[1]); w.w = cvtpk(b[2], b[3]); return __builtin_bit_cast(bf16x8, w); }
template <int dir> __device__ __forceinline__ void dn_solve_and_write(LAS unsigned char* lds, int lane) {
    const LAS float* MT = (const LAS float*)(lds + (dir ? L_MTB : L_MTF));
    LAS float* T0 = (LAS float*)(lds + L_TB + dir * 2 * TB_SZ);
    LAS float* Trow = T0 + lane * 68;
    const int blk = lane >> 5, cb = 32 * blk;
#pragma unroll 1
    for (int jr = 7; jr >= 0; --jr) {
        const int j0 = cb + 4 * jr;
        float a0 = (lane == j0) ? 1.f : 0.f, a1 = (lane == j0 + 1) ? 1.f : 0.f, a2 = (lane == j0 + 2) ? 1.f : 0.f, a3 = (lane == j0 + 3) ? 1.f : 0.f;
        const LAS float* mr = MT + j0 * 64;
#pragma unroll 1
        for (int sr = jr + 1; sr < 8; ++sr) {
            const int s0 = cb + 4 * sr;
            const f32x4 tv = *(const LAS f32x4*)(Trow + s0);
            const f32x4 m0 = *(const LAS f32x4*)(mr + s0), m1 = *(const LAS f32x4*)(mr + 64 + s0), m2 = *(const LAS f32x4*)(mr + 128 + s0), m3 = *(const LAS f32x4*)(mr + 192 + s0);
            a0 -= (tv[0] * m0[0] + tv[1] * m0[1]) + (tv[2] * m0[2] + tv[3] * m0[3]);
            a1 -= (tv[0] * m1[0] + tv[1] * m1[1]) + (tv[2] * m1[2] + tv[3] * m1[3]);
            a2 -= (tv[0] * m2[0] + tv[1] * m2[1]) + (tv[2] * m2[2] + tv[3] * m2[3]);
            a3 -= (tv[0] * m3[0] + tv[1] * m3[1]) + (tv[2] * m3[2] + tv[3] * m3[3]);
        }
        const f32x4 d0 = *(const LAS f32x4*)(mr + j0), d1 = *(const LAS f32x4*)(mr + 64 + j0), d2 = *(const LAS f32x4*)(mr + 128 + j0);
        const float t3 = a3, t2 = a2 - t3 * d2[3], t1 = a1 - t2 * d1[2] - t3 * d1[3], t0 = a0 - t1 * d0[1] - t2 * d0[2] - t3 * d0[3];
        *(LAS f32x4*)(Trow + j0) = (f32x4){t0, t1, t2, t3};
    }
    if (blk == 0) {
#pragma unroll
        for (int q = 8; q < 16; ++q) *(LAS f32x4*)(Trow + 4 * q) = (f32x4){0.f, 0.f, 0.f, 0.f}; }
    asm volatile("s_waitcnt lgkmcnt(0)" ::: "memory");
    {
        const int r = lane & 31, lh = lane >> 5;
        f32x16 Y;
#pragma unroll
        for (int e = 0; e < 16; ++e) Y[e] = 0.f;
#pragma unroll
        for (int kk = 0; kk < 2; ++kk) {
            float av[8], bv[8];
#pragma unroll
            for (int jj = 0; jj < 8; ++jj) { const int k = 16 * kk + 8 * lh + jj; av[jj] = MT[k * 64 + 32 + r]; bv[jj] = T0[k * 68 + r]; }
            Y = __builtin_amdgcn_mfma_f32_32x32x16_bf16(cvt8f((f32x4){av[0], av[1], av[2], av[3]}, (f32x4){av[4], av[5], av[6], av[7]}), cvt8f((f32x4){bv[0], bv[1], bv[2], bv[3]}, (f32x4){bv[4], bv[5], bv[6], bv[7]}), Y, 0, 0, 0);
        }
        f32x16 Z;
#pragma unroll
        for (int e = 0; e < 16; ++e) Z[e] = 0.f;
#pragma unroll
        for (int kk = 0; kk < 2; ++kk) {
            const f32x4 t0 = *(const LAS f32x4*)(T0 + (32 + r) * 68 + 32 + 16 * kk + 4 * lh), t1 = *(const LAS f32x4*)(T0 + (32 + r) * 68 + 32 + 16 * kk + 8 + 4 * lh);
            Z = __builtin_amdgcn_mfma_f32_32x32x16_bf16(cvt8f(t0, t1), cvt8(Y, 8 * kk), Z, 0, 0, 0);
        }
#pragma unroll
        for (int e = 0; e < 16; ++e) T0[(32 + (e & 3) + 8 * (e >> 2) + 4 * lh) * 68 + r] = -Z[e];
    }
    asm volatile("s_waitcnt lgkmcnt(0)" ::: "memory");
    f32x4 tr[16];
#pragma unroll
    for (int q = 0; q < 16; ++q) tr[q] = *(const LAS f32x4*)(Trow + 4 * q);
    asm volatile("s_waitcnt lgkmcnt(0)" ::: "memory");
    const LAS float* sc = (const LAS float*)(lds + L_SC);
    const LAS float* cU = sc + (dir ? 384 : 256); const LAS float* cW = sc + (dir ? 448 : 320);
    const int pos = dir ? 63 - lane : lane;
    LAS unsigned char* tu = lds + L_TB + dir * 2 * TB_SZ + pos * TB_PITCH; LAS unsigned char* tw = tu + TB_SZ;
#pragma unroll
    for (int q = 0; q < 8; ++q) {
        float u8[8], w8[8];
#pragma unroll
        for (int e = 0; e < 8; ++e) { const int s = 8 * q + e, sp = dir ? 63 - s : s; const float t = tr[sp >> 2][sp & 3]; u8[e] = t * cU[s]; w8[e] = t * cW[s]; }
        *(LAS v4u*)(tu + q * 16) = pack8f(u8); *(LAS v4u*)(tw + q * 16) = pack8f(w8);
    }
}

struct PrepRegs { v4u raw[7]; };
__device__ __forceinline__ void prep_load(Frame& F, int u, int tid, int lane, PrepRegs& R) {
    const int cn = u >> 3, hd = u & 7; const bf16* QKV = WSP(bf16, WS_QKV);
#pragma unroll
    for (int k = 0; k < 7; ++k) { const int ci = tid + 512 * k; const int row = ci / 48, cc = ci % 48, seg = cc >> 4, ch = (cc & 15) * 8, tok = 64 * cn - 2 + row;
        v4u v = (v4u){0u, 0u, 0u, 0u};
        if (ci < 68 * 48 && tok >= 0 && tok < SEQ) v = *(const v4u*)(QKV + (size_t)tok * 3072 + seg * 1024 + hd * 128 + ch);
        R.raw[k] = v; }
}
__device__ __forceinline__ void dn_prep_unit(Frame& F, int cn, int hd, PrepRegs& PR, int next_u) {
    LAS unsigned char* lds = F.lds; int tid = F.tid, lane = F.lane; const int wave = F.wave;
    asm volatile("" : "+v"(tid), "+v"(lane));
    LAS float* sc = (LAS float*)(lds + L_SC);
    __syncthreads();
    float abv[4] = {0.f, 0.f, 0.f, 0.f};
    if (wave == 0) { const float* ab = WSP(float, WS_AB) + (size_t)(64 * cn + lane) * 32; abv[0] = ab[hd]; abv[1] = ab[8 + hd]; abv[2] = ab[16 + hd]; abv[3] = ab[24 + hd]; }
    prep_load(F, cn * 8 + hd, tid, lane, PR);
#pragma unroll
    for (int k = 0; k < 7; ++k) { const int ci = tid + 512 * k; const int row = ci / 48, cc = ci % 48, seg = cc >> 4, ch = (cc & 15) * 8;
        if (ci < 68 * 48) *(LAS v4u*)(lds + L_RAW + row * RAW_PITCH + (seg * 128 + ch) * 2) = PR.raw[k]; }
    if (wave == 0) {
        const float bfv = 1.0f / (1.0f + __expf(-abv[0])), bbv = 1.0f / (1.0f + __expf(-abv[1]));
        const float gf = -__expf(F.in[5][hd]) * softplusf(abv[2] + F.in[7][hd]), gb = -__expf(F.in[6][hd]) * softplusf(abv[3] + F.in[8][hd]);
        float Gf = gf, Gb = gb;
#pragma unroll
        for (int o = 1; o < 64; o <<= 1) { const float a = __shfl_up(Gf, o), b = __shfl_down(Gb, o); if (lane >= o) Gf += a; if (lane + o < 64) Gb += b; }
        sc[lane] = Gf; sc[64 + lane] = Gb; sc[128 + lane] = bfv; sc[192 + lane] = bbv;
        sc[256 + lane] = bfv; sc[320 + lane] = -bfv * __expf(Gf); sc[384 + lane] = bbv; sc[448 + lane] = -bbv * __expf(Gb);
        float* GL = WSP(float, WS_GL);
        if (lane == 63) GL[(0 * 8 + hd) * 256 + cn] = __expf(Gf);
        if (lane == 0) GL[(1 * 8 + hd) * 256 + cn] = __expf(Gb);
    }
    __syncthreads();
    asm volatile("" : "+v"(tid), "+v"(lane));
    {
        const int t = wave, pos = lane; const LAS float* cw = (const LAS float*)(lds + L_CW) + 16 * t;
        float qv[16], kv[16], vv[16];
#pragma unroll
        for (int seg = 0; seg < 3; ++seg) {
            float a[16];
#pragma unroll
            for (int i = 0; i < 16; ++i) a[i] = 0.f;
#pragma unroll
            for (int j = 0; j < 5; ++j) {
                const LAS unsigned char* rp = lds + L_RAW + (pos + j) * RAW_PITCH + (seg * 128 + 16 * t) * 2;
                const v4u r0 = *(const LAS v4u*)rp, r1 = *(const LAS v4u*)(rp + 16);
                const LAS float* w = cw + j * 384 + seg * 128;
#pragma unroll
                for (int i = 0; i < 4; ++i) { a[2 * i] += w[2 * i] * bflo(r0[i]); a[2 * i + 1] += w[2 * i + 1] * bfhi(r0[i]); a[8 + 2 * i] += w[8 + 2 * i] * bflo(r1[i]); a[8 + 2 * i + 1] += w[8 + 2 * i + 1] * bfhi(r1[i]); }
            }
#pragma unroll
            for (int i = 0; i < 16; ++i) { const float s = siluf(a[i]); if (seg == 0) qv[i] = s; else if (seg == 1) kv[i] = s; else vv[i] = s; }
        }
        float sq = 0.f, sk = 0.f;
#pragma unroll
        for (int i = 0; i < 16; ++i) { sq += qv[i] * qv[i]; sk += kv[i] * kv[i]; }
        LAS float* part = (LAS float*)(lds + L_PART);
        part[t * 64 + pos] = sq; part[512 + t * 64 + pos] = sk;
        __syncthreads();
        float tq = 0.f, tk = 0.f;
#pragma unroll
        for (int i = 0; i < 8; ++i) { tq += part[i * 64 + pos]; tk += part[512 + i * 64 + pos]; }
        const float rq = (1.0f / sqrtf(tq + 1e-6f)) * 0.08838834764831845f, rk = 1.0f / sqrtf(tk + 1e-6f);
#pragma unroll
        for (int i = 0; i < 16; ++i) { qv[i] *= rq; kv[i] *= rk; }
        *(LAS v4u*)(lds + L_QB + pos * 256 + (((2 * t) ^ (pos & 15)) << 4)) = pack8f(qv); *(LAS v4u*)(lds + L_QB + pos * 256 + (((2 * t + 1) ^ (pos & 15)) << 4)) = pack8f(qv + 8);
        *(LAS v4u*)(lds + L_KB + pos * 256 + (((2 * t) ^ (pos & 15)) << 4)) = pack8f(kv); *(LAS v4u*)(lds + L_KB + pos * 256 + (((2 * t + 1) ^ (pos & 15)) << 4)) = pack8f(kv + 8);
#pragma unroll
        for (int i = 0; i < 16; ++i) { *(LAS unsigned short*)(lds + L_KT + (16 * t + i) * TB_PITCH + pos * 2) = (unsigned short)f2bf(kv[i]); *(LAS unsigned short*)(lds + L_VT + (16 * t + i) * TB_PITCH + pos * 2) = (unsigned short)f2bf(vv[i]); }
        const float ef = __expf(sc[pos]), eb = __expf(sc[64 + pos]); const int mt = pos >> 5;
#pragma unroll
        for (int dir = 0; dir < 2; ++dir) { const float e = dir ? eb : ef; unsigned char* rec = dnx_rec(F, dir, hd, cn) + DX_Q;
#pragma unroll
            for (int lh = 0; lh < 2; ++lh) { float o8[8];
#pragma unroll
                for (int j = 0; j < 8; ++j) o8[j] = qv[8 * (j >> 2) + 4 * lh + (j & 3)] * e;
                *(v4u*)(rec + ((mt * 8 + t) * 64 + 32 * lh + (pos & 31)) * 16) = pack8f(o8); } }
    }
    __syncthreads();
    asm volatile("" : "+v"(tid), "+v"(lane));
    {
        const int r = lane & 31, lh = lane >> 5, x = wave & 3, ta = x >> 1, tb = x & 1;
        const LAS unsigned char* Ab = lds + L_KB + (32 * ta + r) * 256; const LAS unsigned char* Bb = lds + (wave < 4 ? L_KB : L_QB) + (32 * tb + r) * 256;
        f32x16 acc;
#pragma unroll
        for (int i = 0; i < 16; ++i) acc[i] = 0.f;
#pragma unroll
        for (int kk = 0; kk < 8; ++kk) { const int ch = ((2 * kk + lh) ^ (r & 15)) << 4;
            acc = __builtin_amdgcn_mfma_f32_32x32x16_bf16(*(const LAS bf16x8*)(Ab + ch), *(const LAS bf16x8*)(Bb + ch), acc, 0, 0, 0); }
        const int b = 32 * tb + r;
        if (wave < 4) {
            const float Gfb = sc[b], Gbb = sc[64 + b];
#pragma unroll
            for (int q = 0; q < 4; ++q) { const int a0 = 32 * ta + 8 * q + 4 * lh; f32x4 mf, mb;
#pragma unroll
                for (int e = 0; e < 4; ++e) { const int a = a0 + e; const float kkv = acc[4 * q + e];
                    const float vf = sc[128 + a] * kkv * __expf(fminf(sc[a] - Gfb, 0.f)), vb = sc[192 + a] * kkv * __expf(fminf(sc[64 + a] - Gbb, 0.f));
                    mf[e] = (a > b) ? vf : 0.f; mb[3 - e] = (a < b) ? vb : 0.f; }
                *(LAS f32x4*)(lds + L_MTF + (b * 64 + a0) * 4) = mf; *(LAS f32x4*)(lds + L_MTB + ((63 - b) * 64 + 60 - a0) * 4) = mb; }
        } else {
            const float Gfc = sc[b], Gbc = sc[64 + b];
#pragma unroll
            for (int dir = 0; dir < 2; ++dir) { unsigned char* rec = dnx_rec(F, dir, hd, cn) + DX_A;
#pragma unroll
                for (int s2 = 0; s2 < 2; ++s2) { float o8[8];
#pragma unroll
                    for (int j = 0; j < 8; ++j) { const int s = 32 * ta + 16 * s2 + 8 * (j >> 2) + 4 * lh + (j & 3); const float v = acc[8 * s2 + j];
                        const float ev = v * __expf(fminf(dir ? Gbc - sc[64 + s] : Gfc - sc[s], 0.f)); o8[j] = (dir ? (s >= b) : (s <= b)) ? ev : 0.f; }
                    *(v4u*)(rec + ((tb * 4 + 2 * ta + s2) * 64 + lane) * 16) = pack8f(o8); } }
        }
    }
    __syncthreads();
    asm volatile("" : "+v"(tid), "+v"(lane));
    if (wave == 0) dn_solve_and_write<0>(lds, lane);
    else if (wave == 1) dn_solve_and_write<1>(lds, lane);
    else {
        const int r = lane & 31, lh = lane >> 5;
        for (int f = wave - 2; f < 32; f += 6) { const int dir = f >> 4, m = (f >> 2) & 3, t = f & 3; const int dk = 32 * m + r;
            const v2u k0 = *(const LAS v2u*)(lds + L_KT + dk * TB_PITCH + (16 * t + 4 * lh) * 2), k1 = *(const LAS v2u*)(lds + L_KT + dk * TB_PITCH + (16 * t + 8 + 4 * lh) * 2);
            const float Gl = dir ? sc[64] : sc[63]; const LAS float* Gs = sc + (dir ? 64 : 0) + 16 * t + 4 * lh; float o8[8];
            o8[0] = bflo(k0.x) * __expf(Gl - Gs[0]); o8[1] = bfhi(k0.x) * __expf(Gl - Gs[1]); o8[2] = bflo(k0.y) * __expf(Gl - Gs[2]); o8[3] = bfhi(k0.y) * __expf(Gl - Gs[3]);
            o8[4] = bflo(k1.x) * __expf(Gl - Gs[8]); o8[5] = bfhi(k1.x) * __expf(Gl - Gs[9]); o8[6] = bflo(k1.y) * __expf(Gl - Gs[10]); o8[7] = bfhi(k1.y) * __expf(Gl - Gs[11]);
            *(v4u*)(dnx_rec(F, dir, hd, cn) + DX_K + ((m * 4 + t) * 64 + lane) * 16) = pack8f(o8); }
    }
    __syncthreads();
    asm volatile("" : "+v"(tid), "+v"(lane));
    {
        const int dir = wave >> 2, x = wave & 3, r = lane & 31, lh = lane >> 5;
        const LAS unsigned char* Tu = lds + L_TB + (dir ? 2 : 0) * TB_SZ; const LAS unsigned char* Tw = Tu + TB_SZ;
        unsigned char* rec = dnx_rec(F, dir, hd, cn);
#pragma unroll
        for (int mt = 0; mt < 2; ++mt) {
            f32x16 aw, au;
#pragma unroll
            for (int i = 0; i < 16; ++i) { aw[i] = 0.f; au[i] = 0.f; }
#pragma unroll
            for (int kk = 0; kk < 4; ++kk) { const int so = (16 * kk + 8 * lh) * 2;
                aw = __builtin_amdgcn_mfma_f32_32x32x16_bf16(*(const LAS bf16x8*)(lds + L_KT + (32 * x + r) * TB_PITCH + so), *(const LAS bf16x8*)(Tw + (32 * mt + r) * TB_PITCH + so), aw, 0, 0, 0);
                au = __builtin_amdgcn_mfma_f32_32x32x16_bf16(*(const LAS bf16x8*)(Tu + (32 * mt + r) * TB_PITCH + so), *(const LAS bf16x8*)(lds + L_VT + (32 * x + r) * TB_PITCH + so), au, 0, 0, 0); }
            float tmp[16];
#pragma unroll
            for (int i = 0; i < 16; ++i) tmp[i] = aw[i];
            *(v4u*)(rec + DX_W + ((mt * 8 + 2 * x) * 64 + lane) * 16) = pack8f(tmp); *(v4u*)(rec + DX_W + ((mt * 8 + 2 * x + 1) * 64 + lane) * 16) = pack8f(tmp + 8);
#pragma unroll
            for (int i = 0; i < 16; ++i) tmp[i] = au[i];
            *(v4u*)(rec + DX_U + ((x * 2 + mt) * 64 + lane) * 32) = pack8f(tmp); *(v4u*)(rec + DX_U + ((x * 2 + mt) * 64 + lane) * 32 + 16) = pack8f(tmp + 8);
        }
    }
}
__device__ __forceinline__ void dn_prep_phase(Frame& F) {
    PrepRegs PR; int u = blockIdx.x; int cur_hd = -1;
    for (; u < 256 * DNH; u += F.G) {
        const int hd = u & 7;
        if (hd != cur_hd) {
            __syncthreads();
            for (int i = F.tid; i < 5 * 384; i += NWAVES * 64) { const int j = i / 384, c = i % 384; ((LAS float*)(F.lds + L_CW))[i] = F.in[4][j * 3072 + (c >> 7) * 1024 + hd * 128 + (c & 127)]; }
            cur_hd = hd;
        }
        dn_prep_unit(F, u >> 3, hd, PR, u + F.G);
    }
}


constexpr int NSEG = 16, SEGL = 16;
constexpr size_t WS_PF = 176 * MiB, WS_RG = 184 * MiB, WS_SIN = 24 * MiB;
constexpr int SLOT1 = 49152, SLOT3 = 73728, L_GLS = 147456;
#define DN_WAIT(V) asm volatile("s_waitcnt vmcnt(" #V ") lgkmcnt(0)" ::: "memory")
#define DN_BAR() do { __builtin_amdgcn_s_barrier(); asm volatile("" ::: "memory"); } while (0)
__device__ __forceinline__ int seg_chunk(int dir, int g, int i) { const int n = SEGL * g + i; return dir ? 255 - n : n; }
__device__ __forceinline__ void u_to_acc(f32x16& a, const LAS unsigned char* up) {
    const v4u u0 = *(const LAS v4u*)up, u1 = *(const LAS v4u*)(up + 16);
#pragma unroll
    for (int i = 0; i < 4; ++i) { a[2 * i] = bflo(u0[i]); a[2 * i + 1] = bfhi(u0[i]); a[8 + 2 * i] = bflo(u1[i]); a[8 + 2 * i + 1] = bfhi(u1[i]); }
}
template <bool OUT>
__device__ __forceinline__ void dn_step(f32x16 (&S)[4], f32x16 (&aV)[2], f32x16 (&aO)[2], const LAS unsigned char* buf, float gl) {
#pragma unroll
    for (int t = 0; t < 8; ++t) { const bf16x8 sb = cvt8(S[t >> 1], 8 * (t & 1));
#pragma unroll
        for (int mt = 0; mt < 2; ++mt) {
            aV[mt] = __builtin_amdgcn_mfma_f32_32x32x16_bf16(*(const LAS bf16x8*)(buf + DX_W + (mt * 8 + t) * 1024), sb, aV[mt], 0, 0, 0);
            if (OUT) aO[mt] = __builtin_amdgcn_mfma_f32_32x32x16_bf16(*(const LAS bf16x8*)(buf + DX_Q + (mt * 8 + t) * 1024), sb, aO[mt], 0, 0, 0); } }
    bf16x8 vb[4];
#pragma unroll
    for (int t = 0; t < 4; ++t) vb[t] = cvt8(aV[t >> 1], 8 * (t & 1));
#pragma unroll
    for (int m = 0; m < 4; ++m) S[m] = S[m] * gl;
#pragma unroll
    for (int t = 0; t < 4; ++t) {
#pragma unroll
        for (int m = 0; m < 4; ++m) S[m] = __builtin_amdgcn_mfma_f32_32x32x16_bf16(*(const LAS bf16x8*)(buf + DX_K + (m * 4 + t) * 1024), vb[t], S[m], 0, 0, 0);
        if (OUT) {
#pragma unroll
            for (int mt = 0; mt < 2; ++mt) aO[mt] = __builtin_amdgcn_mfma_f32_32x32x16_bf16(*(const LAS bf16x8*)(buf + DX_A + (mt * 4 + t) * 1024), vb[t], aO[mt], 0, 0, 0); } }
}

__device__ __forceinline__ void dn_pass1(Frame& F) {
    LAS unsigned char* lds = F.lds; const int lane = F.lane, wave = F.wave, r = lane & 31, lh = lane >> 5, part = wave >> 2, d = wave & 3;
    LAS float* gls = (LAS float*)(lds + L_GLS);
    for (int unit = blockIdx.x; unit < 16 * NSEG; unit += F.G) {
        const int dir = unit >> 7, hd = (unit >> 4) & 7, g = unit & 15;
        DN_WAIT(0); __syncthreads();
        if (F.tid < SEGL) gls[F.tid] = WSP(float, WS_GL)[(dir * 8 + hd) * 256 + seg_chunk(dir, g, F.tid)];
        DN_WAIT(0);
        f32x16 S[4];
#pragma unroll
        for (int m = 0; m < 4; ++m)
#pragma unroll
            for (int i = 0; i < 16; ++i) S[m][i] = (part && (32 * m + (i & 3) + 8 * (i >> 2) + 4 * lh == 32 * d + r)) ? 1.f : 0.f;
#define P1_ISSUE(i) do { const unsigned char* src_ = dnx_rec(F, dir, hd, seg_chunk(dir, g, (i))) + lane * 16; LAS unsigned char* dst_ = lds + ((i) % 3) * SLOT1; \
            _Pragma("unroll") for (int k_ = 0; k_ < 6; ++k_) { const int p_ = wave + 8 * k_; __builtin_amdgcn_global_load_lds((const unsigned*)(src_ + p_ * 1024), (LAS unsigned*)(dst_ + p_ * 1024), 16, 0, 0); } } while (0)
        P1_ISSUE(0); P1_ISSUE(1);
        for (int i = 0; i < SEGL; ++i) {
            if (i + 1 < SEGL) DN_WAIT(6); else DN_WAIT(0);
            DN_BAR();
            if (i + 2 < SEGL) P1_ISSUE(i + 2);
            const LAS unsigned char* buf = lds + (i % 3) * SLOT1 + lane * 16;
            f32x16 aV[2], aO[2];
#pragma unroll
            for (int mt = 0; mt < 2; ++mt) {
                if (part == 0) u_to_acc(aV[mt], lds + (i % 3) * SLOT1 + DX_U + ((d * 2 + mt) * 64 + lane) * 32);
                else {
#pragma unroll
                    for (int e = 0; e < 16; ++e) aV[mt][e] = 0.f; } }
            dn_step<false>(S, aV, aO, buf, gls[i]);
        }
#undef P1_ISSUE
        DN_WAIT(0); DN_BAR();
        if (part == 0) {
            float* rg = (float*)(F.ws + WS_RG) + (size_t)unit * 16384;
#pragma unroll
            for (int m = 0; m < 4; ++m)
#pragma unroll
                for (int q = 0; q < 4; ++q) *(f32x4*)(rg + ((d * 4 + m) * 64 + lane) * 16 + 4 * q) = (f32x4){S[m][4 * q], S[m][4 * q + 1], S[m][4 * q + 2], S[m][4 * q + 3]};
        } else {
#pragma unroll
            for (int m = 0; m < 4; ++m)
#pragma unroll
                for (int i = 0; i < 16; ++i) *(LAS unsigned short*)(lds + (32 * m + (i & 3) + 8 * (i >> 2) + 4 * lh) * 272 + (32 * d + r) * 2) = (unsigned short)f2bf(S[m][i]);
        }
        DN_WAIT(0); DN_BAR();
        if (part == 1) {
            unsigned char* pf = F.ws + WS_PF + (size_t)unit * 32768;
#pragma unroll
            for (int k = 0; k < 8; ++k) { const int f = d * 8 + k, m = f >> 3, t = f & 7;
                const v2u a = *(const LAS v2u*)(lds + (32 * m + r) * 272 + (16 * t + 4 * lh) * 2), b = *(const LAS v2u*)(lds + (32 * m + r) * 272 + (16 * t + 8 + 4 * lh) * 2);
                *(v4u*)(pf + (f * 64 + lane) * 16) = (v4u){a.x, a.y, b.x, b.y}; }
        }
    }
}
__device__ __forceinline__ void dn_fold(Frame& F) {
    const int b = blockIdx.x; if (b >= 16) return;
    LAS unsigned char* lds = F.lds; const int lane = F.lane, wave = F.wave, dir = b >> 3, hd = b & 7;
    const int unit0 = (dir * 8 + hd) * 16;
    __syncthreads();
    if (wave >= 4) {
        const int lw = wave - 4;
        for (int g = 0; g < NSEG; ++g) {
            if (g < NSEG - 1) { const unsigned char* src = F.ws + WS_PF + (size_t)(unit0 + g) * 32768 + lane * 16; LAS unsigned char* dst = lds + (g & 1) * 32768;
#pragma unroll
                for (int k = 0; k < 8; ++k) { const int p = lw + 4 * k; __builtin_amdgcn_global_load_lds((const unsigned*)(src + p * 1024), (LAS unsigned*)(dst + p * 1024), 16, 0, 0); } }
            DN_WAIT(0); DN_BAR();
        }
    } else {
        const int d = wave;
        f32x16 S[4], R[4];
#pragma unroll
        for (int m = 0; m < 4; ++m)
#pragma unroll
            for (int i = 0; i < 16; ++i) S[m][i] = 0.f;
        const float* rg0 = (const float*)(F.ws + WS_RG) + (size_t)unit0 * 16384; float* sin0 = (float*)(F.ws + WS_SIN) + (size_t)unit0 * 16384;
#pragma unroll
        for (int m = 0; m < 4; ++m)
#pragma unroll
            for (int q = 0; q < 4; ++q) { const f32x4 v = *(const f32x4*)(rg0 + ((d * 4 + m) * 64 + lane) * 16 + 4 * q); R[m][4 * q] = v[0]; R[m][4 * q + 1] = v[1]; R[m][4 * q + 2] = v[2]; R[m][4 * q + 3] = v[3]; }
        DN_BAR();
        for (int g = 0; g < NSEG; ++g) {
            float* so = sin0 + (size_t)g * 16384;
#pragma unroll
            for (int m = 0; m < 4; ++m)
#pragma unroll
                for (int q = 0; q < 4; ++q) *(f32x4*)(so + ((d * 4 + m) * 64 + lane) * 16 + 4 * q) = (f32x4){S[m][4 * q], S[m][4 * q + 1], S[m][4 * q + 2], S[m][4 * q + 3]};
            if (g == NSEG - 1) break;
            const LAS unsigned char* buf = lds + (g & 1) * 32768 + lane * 16;
            bf16x8 sb[8];
#pragma unroll
            for (int t = 0; t < 8; ++t) sb[t] = cvt8(S[t >> 1], 8 * (t & 1));
#pragma unroll
            for (int m = 0; m < 4; ++m) { S[m] = R[m];
#pragma unroll
                for (int t = 0; t < 8; ++t) S[m] = __builtin_amdgcn_mfma_f32_32x32x16_bf16(*(const LAS bf16x8*)(buf + (m * 8 + t) * 1024), sb[t], S[m], 0, 0, 0); }
            if (g + 1 < NSEG - 1) { const float* rg = rg0 + (size_t)(g + 1) * 16384;
#pragma unroll
                for (int m = 0; m < 4; ++m)
#pragma unroll
                    for (int q = 0; q < 4; ++q) { const f32x4 v = *(const f32x4*)(rg + ((d * 4 + m) * 64 + lane) * 16 + 4 * q); R[m][4 * q] = v[0]; R[m][4 * q + 1] = v[1]; R[m][4 * q + 2] = v[2]; R[m][4 * q + 3] = v[3]; } }
            asm volatile("s_waitcnt lgkmcnt(0)" ::: "memory");
            DN_BAR();
        }
    }
    __syncthreads();
}
__device__ __forceinline__ void dn_pass3(Frame& F) {
    LAS unsigned char* lds = F.lds; const int lane = F.lane, wave = F.wave, r = lane & 31, lh = lane >> 5;
    LAS float* gls = (LAS float*)(lds + L_GLS);
    for (int unit = blockIdx.x; unit < 16 * NSEG; unit += F.G) {
        const int dir = unit >> 7, hd = (unit >> 4) & 7, g = unit & 15;
        __syncthreads();
        if (F.tid < SEGL) gls[F.tid] = WSP(float, WS_GL)[(dir * 8 + hd) * 256 + seg_chunk(dir, g, F.tid)];
        asm volatile("s_waitcnt lgkmcnt(0)" ::: "memory");
        if (wave >= 4) {
            const int lw = wave - 4;
            for (int i = 0; i <= SEGL; ++i) {
                if (i < SEGL) { const unsigned char* src = dnx_rec(F, dir, hd, seg_chunk(dir, g, i)) + lane * 16; LAS unsigned char* dst = lds + (i & 1) * SLOT3;
#pragma unroll
                    for (int k = 0; k < 18; ++k) { const int p = lw + 4 * k; __builtin_amdgcn_global_load_lds((const unsigned*)(src + p * 1024), (LAS unsigned*)(dst + p * 1024), 16, 0, 0); } }
                DN_WAIT(0); DN_BAR();
            }
        } else {
            const int d = wave;
            f32x16 S[4];
            const float* si = (const float*)(F.ws + WS_SIN) + (size_t)unit * 16384;
#pragma unroll
            for (int m = 0; m < 4; ++m)
#pragma unroll
                for (int q = 0; q < 4; ++q) { const f32x4 v = *(const f32x4*)(si + ((d * 4 + m) * 64 + lane) * 16 + 4 * q); S[m][4 * q] = v[0]; S[m][4 * q + 1] = v[1]; S[m][4 * q + 2] = v[2]; S[m][4 * q + 3] = v[3]; }
            bf16* O = WSP(bf16, dir ? WS_OB : WS_OF);
            DN_BAR();
            for (int i = 0; i < SEGL; ++i) {
                const int cn = seg_chunk(dir, g, i); const LAS unsigned char* slot = lds + (i & 1) * SLOT3;
                f32x16 aV[2], aO[2];
#pragma unroll
                for (int mt = 0; mt < 2; ++mt) { u_to_acc(aV[mt], slot + DX_U + ((d * 2 + mt) * 64 + lane) * 32);
#pragma unroll
                    for (int e = 0; e < 16; ++e) aO[mt][e] = 0.f; }
                dn_step<true>(S, aV, aO, slot + lane * 16, gls[i]);
                bf16* op = O + (size_t)(64 * cn + 4 * lh) * 1024 + hd * 128 + 32 * d + r;
#pragma unroll
                for (int mt = 0; mt < 2; ++mt)
#pragma unroll
                    for (int e = 0; e < 16; ++e) op[(size_t)(32 * mt + (e & 3) + 8 * (e >> 2)) * 1024] = (bf16)f2bf(aO[mt][e]);
                asm volatile("s_waitcnt lgkmcnt(0)" ::: "memory");
                DN_BAR();
            }
        }
    }
    __syncthreads();
}

#ifndef MK_N_LAUNCHES
#define MK_N_LAUNCHES 1
#endif
constexpr int N_PHASES = 14;
struct Args { const float* in[23]; float* out; unsigned char* ws; int ph_lo, ph_hi; };
static_assert(sizeof(Args) == 23 * 8 + 8 + 8 + 8, "Args has no padding");

__global__ void __launch_bounds__(NWAVES * 64, 2) enc_fwd(Args args) {
    extern __shared__ __attribute__((aligned(16))) unsigned char lds[];
    Frame F;
    F.lds = (LAS unsigned char*)lds;
    F.MISC = (volatile LAS unsigned*)(F.lds + MISC_OFF);
    F.tid = threadIdx.x; F.lane = F.tid & 63; F.wave = __builtin_amdgcn_readfirstlane(F.tid >> 6);
    F.G = gridDim.x; { const int bx = blockIdx.x; F.vcu = (F.G % 8 == 0) ? (bx % 8) * (F.G / 8) + bx / 8 : bx; }
#pragma unroll
    for (int i = 0; i < 23; ++i) F.in[i] = args.in[i];
    F.out = args.out; F.ws = args.ws; F.ctl = (gu32*)(args.ws + WS_CTL);
    for (int u = F.tid; u < (LDS_BYTES - LDSCTL_OFF) / 4; u += NWAVES * 64) ((LAS unsigned*)(F.lds + LDSCTL_OFF))[u] = 0u;
    __syncthreads();
    const int lo = args.ph_lo, hi = args.ph_hi;
    XcdBarrier bar; bar.bar = (unsigned*)(F.ctl + CW_BAR); bar.x = 0; bar.st = nullptr;
    if (hi - lo > 1) bar = xcd_barrier_post((unsigned*)(F.ctl + CW_BAR), F.MISC + 8);
#define IN(k) (lo <= (k) && (k) < hi)
#define SEAM(k) do { if (IN(k) && IN((k) + 1)) xcd_barrier(bar); } while (0)
    float* sumsq2 = (float*)(F.ws + WS_CTL + CTL_SUMSQ2); float* sumsq3 = (float*)(F.ws + WS_CTL + CTL_SUMSQ3); float* sumsq4 = (float*)(F.ws + WS_CTL + CTL_SUMSQ4);

    if (IN(0)) { p0_prologue(F);
#if defined(REPEAT_PHASE) && REPEAT_PHASE == 0
        p0_prologue(F);
#endif
    } SEAM(0);
    if (IN(1)) {
        { pg8::Gemm g{WSP(bf16, WS_XB), WSP(bf16, WS_WIN), SEQ, NINP, DM}; pg8::StaticOrder S; S.init(SEQ, NINP, F.G, (int)blockIdx.x);
          EpiProj E{WSP(float, WS_RSTD1), WSP(bf16, WS_QKV), DOP(bf16, DO_Z), DOP(bf16, DO_QSW), DOP(bf16, DO_KVSW), WSP(float, WS_AB)};
          pg8::gemm_phase<EpiProj, pg8::StaticOrder, true, true>(F.lds + RING_OFF, g, S, E); }
        { pg8::Gemm g{WSP(bf16, WS_MEMB), WSP(bf16, WS_WKV), MEMT, 1024, DM}; pg8::StaticOrder S; S.init(MEMT, 1024, F.G, (int)blockIdx.x);
          EpiScaleBf16 E{WSP(float, WS_RSTDM), 0, 1.0f, WSP(bf16, WS_KVM), 1024};
          pg8::gemm_phase<EpiScaleBf16, pg8::StaticOrder, true, true>(F.lds + RING_OFF, g, S, E); }
    } SEAM(1);
    if (IN(2)) { dn_prep_phase(F);
#ifdef REPEAT_PREP
        dn_prep_phase(F);
#endif
    } SEAM(2);
    if (IN(3)) { dn_pass1(F);
#if defined(REPEAT_PHASE) && REPEAT_PHASE == 3
        dn_pass1(F);
#endif
    } SEAM(3);
    if (IN(12)) { dn_fold(F); if (F.G > 16) swa_phase(F, 16, F.G - 16); else swa_phase(F, 0, F.G); }
    if (IN(12) && IN(13)) xcd_barrier(bar);
    if (IN(13)) { dn_pass3(F);
#if defined(REPEAT_PHASE) && REPEAT_PHASE == 13
        dn_pass3(F);
#endif
    } if (IN(13) && IN(4)) xcd_barrier(bar);
    if (IN(4)) { dn_combine(F); p4_transposes(F);
#if defined(REPEAT_PHASE) && REPEAT_PHASE == 4
        dn_combine(F); p4_transposes(F);
#endif
    } SEAM(4);
    if (IN(5)) {
        pg8::Gemm g{WSP(bf16, WS_XB), WSP(bf16, WS_WOUT), SEQ, DM, DM}; pg8::StaticOrder S; S.init(SEQ, DM, F.G, (int)blockIdx.x);
        EpiRes E{F.in[0], F.out, WSP(bf16, WS_H1B), sumsq2};
        pg8::gemm_phase<EpiRes, pg8::StaticOrder, true, true>(F.lds + RING_OFF, g, S, E);
    } SEAM(5);
    if (IN(6)) {
        pg8::Gemm g{WSP(bf16, WS_H1B), WSP(bf16, WS_WQ), SEQ, 512, DM}; pg8::StaticOrder S; S.init(SEQ, 512, F.G, (int)blockIdx.x);
        EpiScaleBf16 E{sumsq2, 1, QSCALE, WSP(bf16, WS_QM), 512};
        pg8::gemm_phase<EpiScaleBf16, pg8::StaticOrder, true, true>(F.lds + RING_OFF, g, S, E);
    } SEAM(6);
    if (IN(7)) { mem_attn_phase(F);
#if defined(REPEAT_PHASE) && REPEAT_PHASE == 7
        mem_attn_phase(F);
#endif
    } SEAM(7);
    if (IN(8)) {
        pg8::Gemm g{WSP(bf16, WS_OM), WSP(bf16, WS_WO), SEQ, DM, 512}; pg8::StaticOrder S; S.init(SEQ, DM, F.G, (int)blockIdx.x);
        EpiRes E{F.out, F.out, WSP(bf16, WS_XB), sumsq3};
        pg8::gemm_phase<EpiRes, pg8::StaticOrder, true, true>(F.lds + RING_OFF, g, S, E);
    } SEAM(8);
    if (IN(9)) {
        pg8::Gemm g{WSP(bf16, WS_XB), WSP(bf16, WS_WGU), SEQ, 2 * DFF, DM}; pg8::StaticOrder S; S.init(SEQ, 2 * DFF, F.G, (int)blockIdx.x);
        EpiSwiglu E{sumsq3, WSP(bf16, WS_HID)};
        pg8::gemm_phase<EpiSwiglu, pg8::StaticOrder, true, true>(F.lds + RING_OFF, g, S, E);
#if defined(REPEAT_PHASE) && REPEAT_PHASE == 9
        pg8::gemm_phase<EpiSwiglu, pg8::StaticOrder, true, true>(F.lds + RING_OFF, g, S, E);
#endif
    } SEAM(9);
    if (IN(10)) {
        pg8::Gemm g{WSP(bf16, WS_HID), WSP(bf16, WS_WD), SEQ, DM, DFF}; pg8::StaticOrder S; S.init(SEQ, DM, F.G, (int)blockIdx.x);
        EpiRes E{F.out, nullptr, WSP(bf16, WS_H3B), sumsq4};
        pg8::gemm_phase<EpiRes, pg8::StaticOrder, true, true>(F.lds + RING_OFF, g, S, E);
    } SEAM(10);
    if (IN(11)) { final_norm(F);
#if defined(REPEAT_PHASE) && REPEAT_PHASE == 11
        final_norm(F);
#endif
    }
#undef IN
#undef SEAM
}

extern "C" void kernel_launch(void* const* d_in, const int* in_sizes, int n_in, void* d_out, int out_size, void* d_ws, size_t ws_size, hipStream_t stream) {
    static int grid = 0;
    if (grid == 0) {
        if (n_in != 23 || out_size != SEQ * DM || ws_size < WS_END) { fprintf(stderr, "kernel_launch: unexpected shapes (n_in %d out %d ws %zu)\n", n_in, out_size, ws_size); grid = -1; return; }
        int dev = 0, cus = 0;
        if (hipGetDevice(&dev) != hipSuccess || hipDeviceGetAttribute(&cus, hipDeviceAttributeMultiprocessorCount, dev) != hipSuccess) { grid = -1; return; }
        if (hipFuncSetAttribute((const void*)enc_fwd, hipFuncAttributeMaxDynamicSharedMemorySize, LDS_BYTES) != hipSuccess) { fprintf(stderr, "kernel_launch: hipFuncSetAttribute failed\n"); grid = -1; return; }
        (void)hipGetLastError();
        grid = cus;
    }
    if (grid < 0) return;
    if (hipMemsetAsync((char*)d_ws + WS_CTL, 0, CTL_ZERO_BYTES, stream) != hipSuccess) return;
    Args a{};
    for (int i = 0; i < 23; ++i) a.in[i] = (const float*)d_in[i];
    a.out = (float*)d_out; a.ws = (unsigned char*)d_ws;
    const int per = (N_PHASES + MK_N_LAUNCHES - 1) / MK_N_LAUNCHES;
    for (int lo = 0; lo < N_PHASES; lo += per) {
        a.ph_lo = lo; a.ph_hi = (lo + per < N_PHASES) ? lo + per : N_PHASES;
        hipLaunchKernelGGL(enc_fwd, dim3(grid), dim3(NWAVES * 64), LDS_BYTES, stream, a);
    }
}
```

```cpp
#include <hip/hip_runtime.h>
#include <cstdio>
#include <cstdint>
namespace pg8 {
__device__ __forceinline__ unsigned cvt_pk_bf16(float lo, float hi) { unsigned r; asm volatile("v_cvt_pk_bf16_f32 %0, %1, %2" : "=v"(r) : "v"(lo), "v"(hi)); return r; }
#define PG8_LAS __attribute__((address_space(3)))
typedef unsigned short bf16_t;
typedef short bf16x8 __attribute__((ext_vector_type(8)));
typedef float f32x4 __attribute__((ext_vector_type(4)));
typedef unsigned u32x4 __attribute__((ext_vector_type(4)));
constexpr int BM = 256, BK = 64, HALF = 128, HTB = HALF * BK * 2  , STAGE_BYTES = 8 * HTB, NXCD = 8, WGM = 8;

__host__ __device__ __forceinline__ int lds_byte(int r, int c) { const int st = (r >> 4) * 2 + (c >> 5), rr = r & 15, cc = c & 31, ob = rr * 64 + cc * 2; return st * 1024 + (ob ^ (((ob >> 9) & 1) << 5)); }
__host__ __device__ __forceinline__ void stage_rc(int b, int& R, int& C) { const int st = b / 1024, sb = b % 1024, swz = sb ^ (((sb >> 9) & 1) << 5); R = (st >> 1) * 16 + swz / 64; C = (st & 1) * 32 + (swz % 64) / 2; }
__host__ __device__ __forceinline__ int perm32(int rho) { const int n = rho >> 4, i = rho & 15; return 8 * (i >> 2) + 4 * n + (i & 3); }

struct Unit { int pm, pn; };
struct Gemm { const bf16_t* A; const bf16_t* Bt; int M, N, K; };

struct StaticOrder {
    int nM, nN, nwg, G, c;
    __host__ __device__ void init(int M, int N, int G_, int c_) { nM = M / BM; nN = N / BM; nwg = nM * nN; G = G_; c = c_; }
    __host__ __device__ bool next(int i, Unit& u) const {
        const long L = (long)i * G + c; if (L >= nwg) return false;
        int wgid = (int)L; { const int q = nwg / NXCD, r = nwg % NXCD, xcd = wgid % NXCD, off = wgid / NXCD; wgid = (xcd < r ? xcd * (q + 1) : r * (q + 1) + (xcd - r) * q) + off; }
        const int nig = WGM * nN, gid = wgid / nig, fm = gid * WGM, gsz = (nM - fm) < WGM ? (nM - fm) : WGM;
        u.pm = fm + ((wgid % nig) % gsz); u.pn = (wgid % nig) / gsz; return true;
    }
    __device__ __forceinline__ void a_ready(const Unit&) const {}
    __device__ __forceinline__ void done(const Unit&) const {}
};

template <class Epi, class Sched, bool ALIGN_EPI = false, bool SP2 = false>
__device__ __forceinline__ void gemm_phase(PG8_LAS unsigned char* lds, const Gemm g, const Sched& S, const Epi& E) {
    const int tid = threadIdx.x, wid = __builtin_amdgcn_readfirstlane(tid >> 6), lane = tid & 63, wr = wid >> 2, wc = wid & 3, fr = lane & 15, fq = lane >> 4;
    const int K = g.K, nt = K / BK;
    unsigned voffA[2], voffB[2];
#pragma unroll
    for (int i = 0; i < 2; ++i) { int R, C; stage_rc(tid * 16 + i * 8192, R, C); const int Rb = Epi::PERM ? ((R & ~31) + perm32(R & 31)) : R;
        voffA[i] = (unsigned)(R * K + C) * 2u; voffB[i] = (unsigned)(Rb * K + C) * 2u; }
    const size_t kstep = (size_t)(BK * 2);
    const size_t hstep = (size_t)HALF * K * 2;
    const size_t tstep = 2 * hstep;
    const unsigned ldsw = (unsigned)wid * 1024u;
    const int aoff = lds_byte(wr * 64 + fr, fq * 8), boff = lds_byte(wc * 32 + fr, fq * 8);
#define PG8_SA(b, h) (((b) * 2 + (h)) * HTB)
#define PG8_SB(b, h) ((4 + (b) * 2 + (h)) * HTB)
#define PG8_STAGE(bufoff, gbase, voff) do { _Pragma("unroll") for (int _i = 0; _i < 2; ++_i) \
        __builtin_amdgcn_global_load_lds((const unsigned*)((const char*)(gbase) + (voff)[_i]), (PG8_LAS unsigned*)(lds + (bufoff) + ldsw + _i * 8192), 16, 0, 0); } while (0)
#define PG8_LDA(dst, b, h) do { _Pragma("unroll") for (int m = 0; m < 4; ++m) _Pragma("unroll") for (int k = 0; k < 2; ++k) dst[m][k] = *(const PG8_LAS bf16x8*)(lds + PG8_SA(b, h) + aoff + m * 2048 + k * 1024); } while (0)
#define PG8_LDB(dst, b, h) do { _Pragma("unroll") for (int n = 0; n < 2; ++n) _Pragma("unroll") for (int k = 0; k < 2; ++k) dst[n][k] = *(const PG8_LAS bf16x8*)(lds + PG8_SB(b, h) + boff + n * 2048 + k * 1024); } while (0)
#define PG8_MMA(ai, bj, At, Bt) do { __builtin_amdgcn_s_setprio(1); _Pragma("unroll") for (int m = 0; m < 4; ++m) _Pragma("unroll") for (int n = 0; n < 2; ++n) _Pragma("unroll") for (int k = 0; k < 2; ++k) \
        acc[ai][bj][m][n] = __builtin_amdgcn_mfma_f32_16x16x32_bf16(Bt[n][k], At[m][k], acc[ai][bj][m][n], 0, 0, 0); __builtin_amdgcn_s_setprio(0); } while (0)
#define PG8_WAIT_V(n) asm volatile("s_waitcnt vmcnt(" #n ")" ::: "memory")
#define PG8_WAIT_L(n) asm volatile("s_waitcnt lgkmcnt(" #n ")" ::: "memory")
#define PG8_BAR __builtin_amdgcn_s_barrier()
#define PG8_SCHED __builtin_amdgcn_sched_barrier(0)
    Unit cur, nxt; int ui = 0;
    if (!S.next(0, cur)) return;
    f32x4 acc[2][2][4][2];
#pragma unroll
    for (int a = 0; a < 2; ++a)
#pragma unroll
        for (int b = 0; b < 2; ++b)
#pragma unroll
            for (int m = 0; m < 4; ++m)
#pragma unroll
                for (int n = 0; n < 2; ++n) acc[a][b][m][n] = (f32x4){0.f, 0.f, 0.f, 0.f};
    bf16x8 At[4][2], B0[2][2], B1[2][2];
    const char* cA = (const char*)g.A + (size_t)cur.pm * tstep; const char* cB = (const char*)g.Bt + (size_t)cur.pn * tstep;
    S.a_ready(cur);
    if constexpr (SP2) {
        PG8_STAGE(PG8_SB(0, 0), cB, voffB); PG8_STAGE(PG8_SB(0, 1), cB + hstep, voffB); PG8_STAGE(PG8_SA(0, 0), cA, voffA); PG8_STAGE(PG8_SA(0, 1), cA + hstep, voffA);
        if (wr == 1) PG8_BAR;
        PG8_WAIT_V(2); PG8_BAR;
        PG8_STAGE(PG8_SB(1, 0), cB + kstep, voffB); PG8_STAGE(PG8_SA(1, 0), cA + kstep, voffA); PG8_STAGE(PG8_SB(1, 1), cB + hstep + kstep, voffB);
        PG8_WAIT_V(6); PG8_BAR;
    } else {
        PG8_STAGE(PG8_SB(0, 0), cB, voffB); PG8_STAGE(PG8_SA(0, 0), cA, voffA); PG8_STAGE(PG8_SB(0, 1), cB + hstep, voffB); PG8_STAGE(PG8_SA(0, 1), cA + hstep, voffA);
        if (wr == 1) PG8_BAR;
        PG8_WAIT_V(4); PG8_BAR;
        PG8_STAGE(PG8_SB(1, 0), cB + kstep, voffB); PG8_STAGE(PG8_SA(1, 0), cA + kstep, voffA); PG8_STAGE(PG8_SB(1, 1), cB + hstep + kstep, voffB);
        PG8_WAIT_V(6); PG8_BAR;
    }
    for (;;) {
        const bool has_next = S.next(ui + 1, nxt);
        const char* nA = has_next ? (const char*)g.A + (size_t)nxt.pm * tstep : cA; const char* nB = has_next ? (const char*)g.Bt + (size_t)nxt.pn * tstep : cB;
        for (int t = 0; t < nt; t += 2) {
            const bool last = (t == nt - 2);
            const char* a1 = cA + (size_t)(t + 1) * kstep;
            const char* a2 = last ? nA : cA + (size_t)(t + 2) * kstep; const char* b2 = last ? nB : cB + (size_t)(t + 2) * kstep;
            const char* a3 = a2 + kstep; const char* b3 = b2 + kstep;
            if (last && has_next) S.a_ready(nxt);
            if constexpr (SP2) {
            PG8_LDB(B0, 0, 0); PG8_LDB(B1, 0, 1); PG8_SCHED; PG8_LDA(At, 0, 0); PG8_STAGE(PG8_SA(1, 1), a1 + hstep, voffA);
            PG8_WAIT_V(8); PG8_WAIT_L(0); PG8_BAR; PG8_MMA(0, 0, At, B0); PG8_MMA(0, 1, At, B1); PG8_BAR; PG8_SCHED;
            PG8_LDA(At, 0, 1); PG8_STAGE(PG8_SB(0, 0), b2, voffB); PG8_STAGE(PG8_SB(0, 1), b2 + hstep, voffB); PG8_STAGE(PG8_SA(0, 0), a2, voffA);
            PG8_WAIT_V(8); PG8_WAIT_L(0); PG8_BAR; PG8_MMA(1, 0, At, B0); PG8_MMA(1, 1, At, B1); PG8_BAR; PG8_SCHED;
            PG8_LDB(B0, 1, 0); PG8_LDB(B1, 1, 1); PG8_SCHED; PG8_LDA(At, 1, 0); PG8_STAGE(PG8_SA(0, 1), a2 + hstep, voffA);
            PG8_WAIT_V(8); PG8_WAIT_L(0); PG8_BAR; PG8_MMA(0, 0, At, B0); PG8_MMA(0, 1, At, B1); PG8_BAR; PG8_SCHED;
            PG8_LDA(At, 1, 1); PG8_STAGE(PG8_SB(1, 0), b3, voffB); PG8_STAGE(PG8_SB(1, 1), b3 + hstep, voffB); PG8_STAGE(PG8_SA(1, 0), a3, voffA);
            PG8_WAIT_V(8); PG8_WAIT_L(0); PG8_BAR; PG8_MMA(1, 0, At, B0); PG8_MMA(1, 1, At, B1); PG8_BAR; PG8_SCHED;
            } else {
            PG8_LDB(B0, 0, 0); PG8_SCHED; PG8_LDA(At, 0, 0); PG8_STAGE(PG8_SA(1, 1), a1 + hstep, voffA);
            PG8_WAIT_L(8); PG8_BAR; PG8_WAIT_L(0); PG8_MMA(0, 0, At, B0); PG8_BAR; PG8_SCHED;
            PG8_LDB(B1, 0, 1); PG8_STAGE(PG8_SB(0, 0), b2, voffB);
            PG8_BAR; PG8_WAIT_L(0); PG8_MMA(0, 1, At, B1); PG8_BAR;
            PG8_LDA(At, 0, 1); PG8_STAGE(PG8_SA(0, 0), a2, voffA);
            PG8_BAR; PG8_WAIT_L(0); PG8_MMA(1, 0, At, B0); PG8_BAR; PG8_SCHED;
            PG8_STAGE(PG8_SB(0, 1), b2 + hstep, voffB);
            PG8_WAIT_V(6); PG8_BAR; PG8_MMA(1, 1, At, B1); PG8_BAR;
            PG8_LDB(B0, 1, 0); PG8_SCHED; PG8_LDA(At, 1, 0); PG8_STAGE(PG8_SA(0, 1), a2 + hstep, voffA);
            PG8_WAIT_L(8); PG8_BAR; PG8_WAIT_L(0); PG8_MMA(0, 0, At, B0); PG8_BAR; PG8_SCHED;
            PG8_LDB(B1, 1, 1); PG8_STAGE(PG8_SB(1, 0), b3, voffB);
            PG8_BAR; PG8_WAIT_L(0); PG8_MMA(0, 1, At, B1); PG8_BAR;
            PG8_LDA(At, 1, 1); PG8_STAGE(PG8_SA(1, 0), a3, voffA);
            PG8_BAR; PG8_WAIT_L(0); PG8_MMA(1, 0, At, B0); PG8_BAR; PG8_SCHED;
            PG8_STAGE(PG8_SB(1, 1), b3 + hstep, voffB);
            PG8_WAIT_V(6); PG8_BAR; PG8_MMA(1, 1, At, B1); PG8_BAR;
            }
        }
        if constexpr (ALIGN_EPI) { if (wr == 0) PG8_BAR; }
        if constexpr (!Epi::AFTER_DRAIN) { E(acc, cur, wr, wc, fr, fq); S.done(cur); }
        if (!has_next) break;
#pragma unroll
        for (int a = 0; a < 2; ++a)
#pragma unroll
            for (int b = 0; b < 2; ++b)
#pragma unroll
                for (int m = 0; m < 4; ++m)
#pragma unroll
                    for (int n = 0; n < 2; ++n) acc[a][b][m][n] = (f32x4){0.f, 0.f, 0.f, 0.f};
        cur = nxt; cA = nA; cB = nB; ++ui;
        if constexpr (ALIGN_EPI) { if (wr == 1) PG8_BAR; }
    }
    PG8_WAIT_V(0);
    if constexpr (!ALIGN_EPI) { if (wr == 0) PG8_BAR; }
    PG8_BAR;
    if constexpr (Epi::AFTER_DRAIN) { E.fused(acc, cur, wr, wc, fr, fq, lds, wid, lane); S.done(cur); }
#undef PG8_SA
#undef PG8_SB
#undef PG8_STAGE
#undef PG8_LDA
#undef PG8_LDB
#undef PG8_MMA
#undef PG8_WAIT_V
#undef PG8_WAIT_L
#undef PG8_BAR
#undef PG8_SCHED
}
}

constexpr int NWAVES = 8;
constexpr int SEQ = 16384, DM = 2048, NIN = 5664, NINP = 5888, DFF = 5632;
constexpr int DNH = 8, HD = 128, SWH = 8, MEMH = 4, MEMT = 256;
constexpr float RMS_EPS = 1e-6f;
constexpr float LOG2E = 1.4426950408889634f;
constexpr float QSCALE = 0.08838834764831845f * 1.4426950408889634f;

constexpr size_t MiB = 1u << 20;
constexpr size_t WS_CTL = 0, CTL_ZERO_BYTES = 1 * MiB;
constexpr size_t CTL_SUMSQ2 = 256 * 1024, CTL_SUMSQ3 = 320 * 1024, CTL_SUMSQ4 = 384 * 1024;
constexpr size_t WS_RSTD1 = 1 * MiB, WS_RSTDM = 1 * MiB + 64 * 1024;
constexpr size_t WS_MEMB = 2 * MiB, WS_KVM = 3 * MiB, WS_AB = 4 * MiB, WS_BG = 6 * MiB;
constexpr size_t WS_WOUT = 8 * MiB, WS_WQ = 16 * MiB, WS_WKV = 18 * MiB, WS_WO = 22 * MiB, WS_WIN = 24 * MiB;
constexpr size_t WS_XB = 48 * MiB;
constexpr size_t WS_QKV = 112 * MiB;
constexpr size_t WS_H3B = 112 * MiB;
constexpr size_t WS_OF = 112 * MiB, WS_OB = 144 * MiB, WS_H1B = 112 * MiB, WS_QM = 176 * MiB, WS_OM = 192 * MiB;
constexpr size_t WS_DNX = 208 * MiB;
constexpr size_t WS_WGU = 208 * MiB, WS_WD = 252 * MiB, WS_HID = 274 * MiB, WS_END = 496 * MiB;
constexpr size_t DO_Z = 0, DO_QSW = 32 * MiB, DO_KVSW = 64 * MiB;
constexpr int CW_BAR = 4096;

constexpr int RING_OFF = 0, RING_BYTES = 131072;
constexpr int LDS_BYTES = 163840;
constexpr int LDSCTL_OFF = LDS_BYTES - 512, MISC_OFF = LDSCTL_OFF + 320;

#define GAS __attribute__((address_space(1)))
#define LAS __attribute__((address_space(3)))
typedef unsigned short bf16;
typedef unsigned v4u __attribute__((ext_vector_type(4)));
typedef unsigned v2u __attribute__((ext_vector_type(2)));
typedef float f32x4 __attribute__((ext_vector_type(4)));
typedef short bf16x8 __attribute__((ext_vector_type(8)));
typedef short s16x4 __attribute__((ext_vector_type(4)));
typedef GAS unsigned gu32;
#define RLX_AGENT __ATOMIC_RELAXED, __HIP_MEMORY_SCOPE_AGENT
#define LDS_WAIT() asm volatile("s_waitcnt lgkmcnt(0)" ::: "memory")
#define VM_WAIT() asm volatile("s_waitcnt vmcnt(0)" ::: "memory")
__device__ __forceinline__ unsigned f2bf(float f) { unsigned u = __builtin_bit_cast(unsigned, f); return (u + 0x7fffu + ((u >> 16) & 1u)) >> 16; }
__device__ __forceinline__ unsigned pk2(float lo, float hi) { return f2bf(lo) | (f2bf(hi) << 16); }
__device__ __forceinline__ float bf2f(unsigned short b) { return __builtin_bit_cast(float, (unsigned)b << 16); }
__device__ __forceinline__ float bflo(unsigned w) { return __builtin_bit_cast(float, w << 16); }
__device__ __forceinline__ float bfhi(unsigned w) { return __builtin_bit_cast(float, w & 0xffff0000u); }
typedef float f32x2_t __attribute__((ext_vector_type(2))); typedef __bf16 bf16x2_t __attribute__((ext_vector_type(2)));
__device__ __forceinline__ unsigned cvtpk(float lo, float hi) { f32x2_t v = {lo, hi}; bf16x2_t b = __builtin_convertvector(v, bf16x2_t); return __builtin_bit_cast(unsigned, b); }
__device__ __forceinline__ float wave_sum(float v) {
#pragma unroll
    for (int o = 1; o < 64; o <<= 1) v += __shfl_xor(v, o);
    return v;
}
__device__ __forceinline__ float siluf(float x) { return x * __builtin_amdgcn_rcpf(1.0f + __expf(-x)); }
#define XB_TMO      128
#define XB_XCNT(j)  (256  + 64 * (j))
#define XB_XSUB(j)  (1280 + 64 * (j))
#define XB_XGEN(j)  (2304 + 64 * (j))
#define XB_TOP      3328
#define XB_TOPGEN   3392
#define XCD_BAR_WORDS 3456
#define XB_SPIN_CAP (1u << 18)

__device__ __forceinline__ unsigned xb_ld(unsigned* p)              { return __hip_atomic_load(p, __ATOMIC_RELAXED, __HIP_MEMORY_SCOPE_AGENT); }
__device__ __forceinline__ unsigned xb_add(unsigned* p, unsigned v) { return __hip_atomic_fetch_add(p, v, __ATOMIC_RELAXED, __HIP_MEMORY_SCOPE_AGENT); }
__device__ __forceinline__ unsigned xb_xcc_id() { return (unsigned)__builtin_amdgcn_s_getreg((3 << 11) | 20) & 0xFu; }
#define XB_SPIN(cond, bar) do { unsigned _sp = 0; while (cond) { __builtin_amdgcn_s_sleep(1); \
    if ((++_sp & 255u) == 0u) { if (xb_ld(&(bar)[XB_TMO])) break; if (_sp > XB_SPIN_CAP) { atomicAdd(&(bar)[XB_TMO], 1u); break; } } } } while (0)

struct XcdBarrier {
    unsigned* bar; unsigned x;
    volatile LAS unsigned* st;
};

__device__ __forceinline__ XcdBarrier xcd_barrier_post(unsigned* bar, volatile LAS unsigned* st) {
    XcdBarrier b; b.bar = bar; b.x = xb_xcc_id(); b.st = st;
    if (threadIdx.x == 0) (void)xb_add(&bar[XB_XCNT(b.x)], 1u);
    return b;
}
__device__ __forceinline__ void xcd_barrier_complete(unsigned* bar, unsigned x, unsigned& nloc, unsigned& nx) {
    const unsigned G = gridDim.x * gridDim.y * gridDim.z;
    unsigned sum, cnt, mine, sp = 0u;
    for (;;) {
        sum = 0u; cnt = 0u; mine = 0u;
#pragma unroll
        for (unsigned j = 0; j < 16; ++j) { const unsigned c = xb_ld(&bar[XB_XCNT(j)]); sum += c; cnt += (c > 0u) ? 1u : 0u; mine = (j == x) ? c : mine; }
        if (sum == G) break;
        __builtin_amdgcn_s_sleep(1);
        if ((++sp & 255u) == 0u) { if (xb_ld(&bar[XB_TMO])) break; if (sp > XB_SPIN_CAP) { atomicAdd(&bar[XB_TMO], 1u); break; } }
    }
    nloc = mine > 0u ? mine : 1u; nx = cnt > 0u ? cnt : 1u;
}

__device__ __forceinline__ void xcd_barrier(const XcdBarrier& b) {
    asm volatile("s_waitcnt vmcnt(0)" ::: "memory");
    __syncthreads();
    if (threadIdx.x == 0) {
        unsigned* bar = b.bar;
        __builtin_amdgcn_s_waitcnt(0);
        unsigned nloc = b.st[0], nx = b.st[1];
        if (nloc == 0u) { xcd_barrier_complete(bar, b.x, nloc, nx); b.st[0] = nloc; b.st[1] = nx; }
        const unsigned old = xb_add(&bar[XB_XSUB(b.x)], 1u);
        const unsigned gen = old / nloc;
        if (old + 1u == (gen + 1u) * nloc) {
            __builtin_amdgcn_fence(__ATOMIC_RELEASE, "agent");
            asm volatile("s_waitcnt vmcnt(0)" ::: "memory");
            const unsigned og = xb_add(&bar[XB_TOP], 1u);
            const unsigned tg = og / nx;
            if (og + 1u == (tg + 1u) * nx) xb_add(&bar[XB_TOPGEN], 1u);
            else XB_SPIN(xb_ld(&bar[XB_TOPGEN]) == tg, bar);
            __builtin_amdgcn_fence(__ATOMIC_ACQUIRE, "agent");
            xb_add(&bar[XB_XGEN(b.x)], 1u);
            asm volatile("s_waitcnt vmcnt(0)" ::: "memory");
        } else {
            XB_SPIN(xb_ld(&bar[XB_XGEN(b.x)]) == gen, bar);
            __builtin_amdgcn_fence(__ATOMIC_ACQUIRE, "agent");
            asm volatile("s_waitcnt vmcnt(0)" ::: "memory");
        }
    }
    __syncthreads();
}

using pg8::Unit;
__device__ __forceinline__ v4u pack8(f32x4 v0, f32x4 v1) { v4u w; w.x = cvtpk(v0[0], v0[1]); w.y = cvtpk(v0[2], v0[3]); w.z = cvtpk(v1[0], v1[1]); w.w = cvtpk(v1[2], v1[3]); return w; }

struct EpiProj {
    static constexpr bool PERM = true, AFTER_DRAIN = false;
    const float* rstd; bf16* qkv; bf16* z; bf16* qsw; bf16* kvsw; float* ab;
    __device__ __forceinline__ void operator()(const f32x4 (&acc)[2][2][4][2], const Unit& u, int wr, int wc, int fr, int fq) const {
        const int pn = u.pn; bf16* base; int ldc, colt; float sc = 1.f;
        if (pn < 12) { base = qkv; ldc = 3072; colt = pn * 256; }
        else if (pn < 16) { base = z; ldc = 1024; colt = (pn - 12) * 256; }
        else if (pn < 20) { base = qsw; ldc = 1024; colt = (pn - 16) * 256; sc = QSCALE; }
        else if (pn < 22) { base = kvsw; ldc = 512; colt = (pn - 20) * 256; }
        else { base = nullptr; ldc = 0; colt = 0; }
        const int row0 = u.pm * 256 + wr * 64 + fr, col0 = colt + wc * 32 + 8 * fq;
        float rsv[2][4];
#pragma unroll
        for (int ai = 0; ai < 2; ++ai)
#pragma unroll
            for (int m = 0; m < 4; ++m) rsv[ai][m] = rstd[row0 + ai * 128 + m * 16];
#pragma unroll
        for (int ai = 0; ai < 2; ++ai)
#pragma unroll
            for (int m = 0; m < 4; ++m) {
                const int row = row0 + ai * 128 + m * 16; const float rs = rsv[ai][m] * sc;
                if (base) {
                    bf16* rowp = base + (size_t)row * ldc + col0;
#pragma unroll
                    for (int bj = 0; bj < 2; ++bj) *(v4u*)(rowp + bj * 128) = pack8(acc[ai][bj][m][0] * rs, acc[ai][bj][m][1] * rs);
                } else if (wc == 0) {
                    float* rowp = ab + (size_t)row * 32 + 8 * fq;
                    *(f32x4*)(rowp) = acc[ai][0][m][0] * rs; *(f32x4*)(rowp + 4) = acc[ai][0][m][1] * rs;
                }
            }
    }
};
struct EpiScaleBf16 {
    static constexpr bool PERM = true, AFTER_DRAIN = false;
    const float* rs; int from_sumsq; float sc; bf16* O; int ldc;
    __device__ __forceinline__ void operator()(const f32x4 (&acc)[2][2][4][2], const Unit& u, int wr, int wc, int fr, int fq) const {
        const int row0 = u.pm * 256 + wr * 64 + fr, col0 = u.pn * 256 + wc * 32 + 8 * fq;
        float rsv[2][4];
#pragma unroll
        for (int ai = 0; ai < 2; ++ai)
#pragma unroll
            for (int m = 0; m < 4; ++m) rsv[ai][m] = rs[row0 + ai * 128 + m * 16];
#pragma unroll
        for (int ai = 0; ai < 2; ++ai)
#pragma unroll
            for (int m = 0; m < 4; ++m) {
                const int row = row0 + ai * 128 + m * 16; float r = rsv[ai][m];
                if (from_sumsq) r = __builtin_amdgcn_rsqf(r * (1.0f / DM) + RMS_EPS);
                r *= sc; bf16* rowp = O + (size_t)row * ldc + col0;
#pragma unroll
                for (int bj = 0; bj < 2; ++bj) *(v4u*)(rowp + bj * 128) = pack8(acc[ai][bj][m][0] * r, acc[ai][bj][m][1] * r);
            }
    }
};
struct EpiRes {
    static constexpr bool PERM = true, AFTER_DRAIN = false;
    const float* res; float* out; bf16* ob; float* sumsq;
    __device__ __forceinline__ void operator()(const f32x4 (&acc)[2][2][4][2], const Unit& u, int wr, int wc, int fr, int fq) const {
        const int row0 = u.pm * 256 + wr * 64 + fr, col0 = u.pn * 256 + wc * 32 + 8 * fq;
#pragma unroll
        for (int ai = 0; ai < 2; ++ai) {
            f32x4 rr[4][2][2];
#pragma unroll
            for (int m = 0; m < 4; ++m) { const size_t off = (size_t)(row0 + ai * 128 + m * 16) * DM + col0;
#pragma unroll
                for (int bj = 0; bj < 2; ++bj) { rr[m][bj][0] = *(const f32x4*)(res + off + bj * 128); rr[m][bj][1] = *(const f32x4*)(res + off + bj * 128 + 4); } }
            asm volatile("" ::: "memory");
#pragma unroll
            for (int m = 0; m < 4; ++m) {
                const int row = row0 + ai * 128 + m * 16; const size_t off = (size_t)row * DM + col0; float ss = 0.f;
#pragma unroll
                for (int bj = 0; bj < 2; ++bj) {
                    const f32x4 v0 = acc[ai][bj][m][0] + rr[m][bj][0], v1 = acc[ai][bj][m][1] + rr[m][bj][1];
                    if (out) { *(f32x4*)(out + off + bj * 128) = v0; *(f32x4*)(out + off + bj * 128 + 4) = v1; }
                    if (ob) *(v4u*)(ob + off + bj * 128) = pack8(v0, v1);
                    ss += (v0[0] * v0[0] + v0[1] * v0[1]) + (v0[2] * v0[2] + v0[3] * v0[3]) + (v1[0] * v1[0] + v1[1] * v1[1]) + (v1[2] * v1[2] + v1[3] * v1[3]);
                }
                ss += __shfl_xor(ss, 16); ss += __shfl_xor(ss, 32);
                if (fq == 0) atomicAdd(sumsq + row, ss);
            }
            asm volatile("" ::: "memory");
        }
    }
};
struct EpiSwiglu {
    static constexpr bool PERM = true, AFTER_DRAIN = false;
    const float* sumsq; bf16* H;
    __device__ __forceinline__ void operator()(const f32x4 (&acc)[2][2][4][2], const Unit& u, int wr, int wc, int fr, int fq) const {
        const int row0 = u.pm * 256 + wr * 64 + fr, col0 = u.pn * 128 + wc * 32 + 8 * fq;
        float rsv[2][4];
#pragma unroll
        for (int ai = 0; ai < 2; ++ai)
#pragma unroll
            for (int m = 0; m < 4; ++m) rsv[ai][m] = sumsq[row0 + ai * 128 + m * 16];
#pragma unroll
        for (int ai = 0; ai < 2; ++ai)
#pragma unroll
            for (int m = 0; m < 4; ++m) {
                const int row = row0 + ai * 128 + m * 16; const float r = __builtin_amdgcn_rsqf(rsv[ai][m] * (1.0f / DM) + RMS_EPS);
                f32x4 h[2];
#pragma unroll
                for (int n = 0; n < 2; ++n)
#pragma unroll
                    for (int e = 0; e < 4; ++e) { const float g = acc[ai][0][m][n][e] * r, up = acc[ai][1][m][n][e] * r; h[n][e] = siluf(g) * up; }
                *(v4u*)(H + (size_t)row * DFF + col0) = pack8(h[0], h[1]);
            }
    }
};

struct Frame {
    LAS unsigned char* lds;
    volatile LAS unsigned* MISC;
    gu32* ctl;
    int tid, lane, wave, vcu, G;
    const float* in[23]; float* out; unsigned char* ws;
};
#define WSP(T, off) ((T*)(F.ws + (off)))
#define DOP(T, off) ((T*)((unsigned char*)F.out + (off)))

__device__ __forceinline__ void tr_item(const float* W, int K, int Nsrc, int src_col0, const float* gain, bf16* WT, int dst_row0, int k0, LAS float* scr, int lane) {
    float v[32];
#pragma unroll
    for (int i = 0; i < 32; ++i) { const int kk = 2 * i + (lane >> 5); v[i] = (src_col0 >= 0) ? W[(size_t)(k0 + kk) * Nsrc + src_col0 + (lane & 31)] : 0.f; }
    if (gain) {
#pragma unroll
        for (int i = 0; i < 32; ++i) v[i] *= gain[k0 + 2 * i + (lane >> 5)]; }
#pragma unroll
    for (int i = 0; i < 32; ++i) scr[(2 * i + (lane >> 5)) * 33 + (lane & 31)] = v[i];
    LDS_WAIT(); asm volatile("" ::: "memory");
    const int c = lane & 7;
#pragma unroll
    for (int j = 0; j < 4; ++j) { const int n = (lane >> 3) + 8 * j; const LAS float* s = scr + (8 * c) * 33 + n;
        v4u o; o.x = pk2(s[0 * 33], s[1 * 33]); o.y = pk2(s[2 * 33], s[3 * 33]); o.z = pk2(s[4 * 33], s[5 * 33]); o.w = pk2(s[6 * 33], s[7 * 33]);
        *(GAS v4u*)(WT + (size_t)(dst_row0 + n) * K + k0 + 8 * c) = o; }
    LDS_WAIT(); asm volatile("" ::: "memory");
}
__device__ __forceinline__ int win_src_col(int c) {
    if (c < 4096) return c;
    if (c < 5120) return c - 4096 + 4128;
    if (c < 5376) return c - 5120 + 5152;
    if (c < 5632) return c - 5376 + 5408;
    if (c < 5664) return c - 5632 + 4096;
    return -1;
}
__device__ __forceinline__ void row_to_bf16_rstd(const float* xrow, bf16* orow, float* rstd_out, int lane) {
    const GAS f32x4* xr = (const GAS f32x4*)xrow + lane;
    f32x4 v[8]; float s = 0.f;
#pragma unroll
    for (int j = 0; j < 8; ++j) { v[j] = xr[64 * j]; s += (v[j].x * v[j].x + v[j].y * v[j].y) + (v[j].z * v[j].z + v[j].w * v[j].w); }
    s = wave_sum(s);
    if (lane == 0) *rstd_out = 1.0f / sqrtf(s * (1.0f / DM) + RMS_EPS);
    GAS v2u* o8 = (GAS v2u*)orow + lane;
#pragma unroll
    for (int j = 0; j < 8; ++j) { v2u w; w.x = pk2(v[j].x, v[j].y); w.y = pk2(v[j].z, v[j].w); o8[64 * j] = w; }
}

__device__ __forceinline__ void p0_prologue(Frame& F) {
    LAS float* scr = (LAS float*)(F.lds + RING_OFF + F.wave * 16384);
    const int gw = F.vcu * NWAVES + F.wave, NGW = F.G * NWAVES;
    constexpr int I_IN = 32 * (NINP / 32), I_OUT = 32 * 64, I_Q = 32 * 16, I_KV = 32 * 32, I_O = 8 * 64;
    constexpr int NITEMS = I_IN + I_OUT + I_Q + I_KV + I_O;
    for (int it = gw; it < NITEMS; it += NGW) {
        int r = it;
        if (r < I_IN) { const int nblk = NINP / 32, kb = r / nblk, nb = r % nblk; tr_item(F.in[3], DM, NIN, win_src_col(nb * 32), F.in[2], WSP(bf16, WS_WIN), nb * 32, kb * 64, scr, F.lane); continue; } r -= I_IN;
        if (r < I_OUT) { const int kb = r / 64, nb = r % 64; tr_item(F.in[12], DM, DM, nb * 32, nullptr, WSP(bf16, WS_WOUT), nb * 32, kb * 64, scr, F.lane); continue; } r -= I_OUT;
        if (r < I_Q) { const int kb = r / 16, nb = r % 16; tr_item(F.in[15], DM, 512, nb * 32, F.in[13], WSP(bf16, WS_WQ), nb * 32, kb * 64, scr, F.lane); continue; } r -= I_Q;
        if (r < I_KV) { const int kb = r / 32, nb = r % 32; tr_item(F.in[16], DM, 1024, nb * 32, F.in[14], WSP(bf16, WS_WKV), nb * 32, kb * 64, scr, F.lane); continue; } r -= I_KV;
        { const int kb = r / 64, nb = r % 64; tr_item(F.in[17], 512, DM, nb * 32, nullptr, WSP(bf16, WS_WO), nb * 32, kb * 64, scr, F.lane); }
    }
    for (int m = gw; m < SEQ; m += 2 * NGW) {
        const int m2 = m + NGW; const bool two = m2 < SEQ;
        const GAS f32x4* xa = (const GAS f32x4*)(F.in[0] + (size_t)m * DM) + F.lane; const GAS f32x4* xb_ = (const GAS f32x4*)(F.in[0] + (size_t)(two ? m2 : m) * DM) + F.lane;
        f32x4 va[8], vb[8]; float sa = 0.f, sb = 0.f;
#pragma unroll
        for (int j = 0; j < 8; ++j) { va[j] = xa[64 * j]; vb[j] = xb_[64 * j]; }
#pragma unroll
        for (int j = 0; j < 8; ++j) { sa += (va[j].x * va[j].x + va[j].y * va[j].y) + (va[j].z * va[j].z + va[j].w * va[j].w); sb += (vb[j].x * vb[j].x + vb[j].y * vb[j].y) + (vb[j].z * vb[j].z + vb[j].w * vb[j].w); }
        sa = wave_sum(sa); sb = wave_sum(sb);
        if (F.lane == 0) { WSP(float, WS_RSTD1)[m] = 1.0f / sqrtf(sa * (1.0f / DM) + RMS_EPS); if (two) WSP(float, WS_RSTD1)[m2] = 1.0f / sqrtf(sb * (1.0f / DM) + RMS_EPS); }
        GAS v2u* oa = (GAS v2u*)(WSP(bf16, WS_XB) + (size_t)m * DM) + F.lane; GAS v2u* ob = (GAS v2u*)(WSP(bf16, WS_XB) + (size_t)m2 * DM) + F.lane;
#pragma unroll
        for (int j = 0; j < 8; ++j) { v2u w; w.x = pk2(va[j].x, va[j].y); w.y = pk2(va[j].z, va[j].w); oa[64 * j] = w; }
        if (two) {
#pragma unroll
            for (int j = 0; j < 8; ++j) { v2u w; w.x = pk2(vb[j].x, vb[j].y); w.y = pk2(vb[j].z, vb[j].w); ob[64 * j] = w; } }
    }
    for (int m = gw; m < MEMT; m += NGW) row_to_bf16_rstd(F.in[1] + (size_t)m * DM, WSP(bf16, WS_MEMB) + (size_t)m * DM, WSP(float, WS_RSTDM) + m, F.lane);
}
__device__ __forceinline__ void p4_transposes(Frame& F) {
    LAS float* scr = (LAS float*)(F.lds + RING_OFF + F.wave * 16384);
    const int gw = F.vcu * NWAVES + F.wave, NGW = F.G * NWAVES;
    constexpr int I_GU = 32 * (2 * DFF / 32), I_D = (DFF / 64) * 64;
    for (int it = gw; it < I_GU + I_D; it += NGW) {
        int r = it;
        if (r < I_GU) { const int nblk = 2 * DFF / 32, kb = r / nblk, nb = r % nblk; const int row = nb * 32, t = row / 256, w = row % 256;
            const float* src = (w < 128) ? F.in[19] : F.in[20]; const int sc = 128 * t + (w & 127);
            tr_item(src, DM, DFF, sc, F.in[18], WSP(bf16, WS_WGU), row, kb * 64, scr, F.lane); continue; } r -= I_GU;
        { const int kb = r / 64, nb = r % 64; tr_item(F.in[21], DFF, DM, nb * 32, nullptr, WSP(bf16, WS_WD), nb * 32, kb * 64, scr, F.lane); }
    }
}

__device__ __forceinline__ float softplusf(float x) { return x > 20.f ? x : log1pf(__expf(x)); }
__device__ __forceinline__ void dn_combine(Frame& F) {
    const int gw = F.vcu * NWAVES + F.wave, NGW = F.G * NWAVES, lane = F.lane;
    const bf16* OFp = WSP(bf16, WS_OF); const bf16* OBp = WSP(bf16, WS_OB); const bf16* Z = DOP(bf16, DO_Z); bf16* Y = WSP(bf16, WS_XB); const float* gn = F.in[9];
    const int cb = (16 * lane) & 127; float gv[16];
#pragma unroll
    for (int i = 0; i < 16; ++i) gv[i] = gn[cb + i];
    for (int t0 = gw; t0 < SEQ; t0 += 2 * NGW) {
        v4u a[2][2], b[2][2], z[2][2];
#pragma unroll
        for (int k = 0; k < 2; ++k) { const int t = (t0 + k * NGW < SEQ) ? t0 + k * NGW : t0; const size_t off = (size_t)t * 1024 + 16 * lane;
            a[k][0] = *(const v4u*)(OFp + off); a[k][1] = *(const v4u*)(OFp + off + 8); b[k][0] = *(const v4u*)(OBp + off); b[k][1] = *(const v4u*)(OBp + off + 8);
            z[k][0] = *(const v4u*)(Z + off); z[k][1] = *(const v4u*)(Z + off + 8); }
#pragma unroll
        for (int k = 0; k < 2; ++k) {
            const int t = t0 + k * NGW; if (t >= SEQ) break;
            float o[16], zz[16];
#pragma unroll
            for (int i = 0; i < 4; ++i) { o[2 * i] = bflo(a[k][0][i]) + bflo(b[k][0][i]); o[2 * i + 1] = bfhi(a[k][0][i]) + bfhi(b[k][0][i]); o[8 + 2 * i] = bflo(a[k][1][i]) + bflo(b[k][1][i]); o[8 + 2 * i + 1] = bfhi(a[k][1][i]) + bfhi(b[k][1][i]);
                zz[2 * i] = bflo(z[k][0][i]); zz[2 * i + 1] = bfhi(z[k][0][i]); zz[8 + 2 * i] = bflo(z[k][1][i]); zz[8 + 2 * i + 1] = bfhi(z[k][1][i]); }
            float ss = 0.f;
#pragma unroll
            for (int i = 0; i < 16; ++i) ss += o[i] * o[i];
            ss += __shfl_xor(ss, 1); ss += __shfl_xor(ss, 2); ss += __shfl_xor(ss, 4);
            const float rs = __builtin_amdgcn_rsqf(ss * (1.0f / 128.0f) + RMS_EPS);
            float y[16];
#pragma unroll
            for (int i = 0; i < 16; ++i) y[i] = o[i] * rs * gv[i] * siluf(zz[i]);
            v4u w0, w1;
#pragma unroll
            for (int i = 0; i < 4; ++i) { w0[i] = pk2(y[2 * i], y[2 * i + 1]); w1[i] = pk2(y[8 + 2 * i], y[8 + 2 * i + 1]); }
            bf16* yp = Y + (size_t)t * DM + 16 * lane; *(v4u*)yp = w0; *(v4u*)(yp + 8) = w1;
        }
    }
}
__device__ __forceinline__ void final_norm(Frame& F) {
    const int gw = F.vcu * NWAVES + F.wave, NGW = F.G * NWAVES, lane = F.lane;
    const float* ss = (const float*)(F.ws + WS_CTL + CTL_SUMSQ4); const GAS f32x4* g = (const GAS f32x4*)F.in[22]; const bf16* H3 = WSP(bf16, WS_H3B);
    for (int m0 = gw; m0 < SEQ; m0 += 2 * NGW) {
        v4u w[2][4]; float r[2];
#pragma unroll
        for (int k = 0; k < 2; ++k) { const int m = (m0 + k * NGW < SEQ) ? m0 + k * NGW : m0; const GAS v4u* hp = (const GAS v4u*)(H3 + (size_t)m * DM);
            r[k] = ss[m];
#pragma unroll
            for (int j = 0; j < 4; ++j) w[k][j] = hp[64 * j + lane]; }
#pragma unroll
        for (int k = 0; k < 2; ++k) {
            const int m = m0 + k * NGW; if (m >= SEQ) break;
            const float rr = __builtin_amdgcn_rsqf(r[k] * (1.0f / DM) + RMS_EPS);
            GAS f32x4* o = (GAS f32x4*)(F.out + (size_t)m * DM);
#pragma unroll
            for (int j = 0; j < 4; ++j) { const v4u x = w[k][j]; const int c4 = 2 * (64 * j + lane); const f32x4 g0 = g[c4], g1 = g[c4 + 1];
                o[c4] = (f32x4){bflo(x.x) * rr * g0[0], bfhi(x.x) * rr * g0[1], bflo(x.y) * rr * g0[2], bfhi(x.y) * rr * g0[3]};
                o[c4 + 1] = (f32x4){bflo(x.z) * rr * g1[0], bfhi(x.z) * rr * g1[1], bflo(x.w) * rr * g1[2], bfhi(x.w) * rr * g1[3]}; }
        }
    }
}

__device__ __forceinline__ int t5_bucket(int rel) {
    const int n = rel < 0 ? -rel : rel; int b;
    if (n < 8) b = n; else { int k = (31 - __builtin_clz((unsigned)(n * n))) - 6; b = 8 + k; if (b > 15) b = 15; }
    return (rel > 0 ? 16 : 0) + b;
}
template <int MODE  >
__device__ __forceinline__ void attn_unit(Frame& F, const bf16* Q, int qpitch, const bf16* Kp, const bf16* Vp, int kvpitch, bf16* O, int opitch, int q0, int kt_beg, int kt_end, const LAS float* btab, float sink2) {
    LAS unsigned char* Ks = F.lds + RING_OFF; LAS unsigned char* Vs = Ks + 16384;
    const int lane = F.lane, c = lane & 15, g = lane >> 4, qw0 = q0 + 16 * F.wave, tid = F.tid;
    bf16x8 qf[4];
#pragma unroll
    for (int t = 0; t < 4; ++t) qf[t] = *(const bf16x8*)(Q + (size_t)(qw0 + c) * qpitch + 32 * t + 8 * g);
    f32x4 oacc[8];
#pragma unroll
    for (int i = 0; i < 8; ++i) oacc[i] = (f32x4){0.f, 0.f, 0.f, 0.f};
    float mrun = (MODE == 0) ? sink2 : -1e30f, lsum = (MODE == 0 && g == 0) ? 1.0f : 0.0f;
    v4u kpre[2], vpre[2];
#pragma unroll
    for (int i = 0; i < 2; ++i) { const int ci = tid + 512 * i, key = ci >> 4, ch = ci & 15;
        kpre[i] = *(const v4u*)(Kp + (size_t)(64 * kt_beg + key) * kvpitch + ch * 8); vpre[i] = *(const v4u*)(Vp + (size_t)(64 * kt_beg + key) * kvpitch + ch * 8); }
    for (int kt = kt_beg; kt < kt_end; ++kt) {
        __syncthreads();
#pragma unroll
        for (int i = 0; i < 2; ++i) { const int ci = tid + 512 * i, key = ci >> 4, ch = ci & 15;
            *(LAS v4u*)(Ks + key * 256 + ((ch ^ (key & 15)) << 4)) = kpre[i]; *(LAS v4u*)(Vs + key * 256 + ((ch ^ ((key & 7) << 1)) << 4)) = vpre[i]; }
        if (kt + 1 < kt_end) {
#pragma unroll
            for (int i = 0; i < 2; ++i) { const int ci = tid + 512 * i, key = ci >> 4, ch = ci & 15;
                kpre[i] = *(const v4u*)(Kp + (size_t)(64 * (kt + 1) + key) * kvpitch + ch * 8); vpre[i] = *(const v4u*)(Vp + (size_t)(64 * (kt + 1) + key) * kvpitch + ch * 8); } }
        __syncthreads();
        bool rel_ok = true;
        if (MODE == 0) rel_ok = (64 * kt <= qw0 + 15 + 128) && (64 * kt + 63 >= qw0 - 128);
        if (!rel_ok) continue;
        f32x4 s[4];
#pragma unroll
        for (int mt = 0; mt < 4; ++mt) s[mt] = (f32x4){0.f, 0.f, 0.f, 0.f};
#pragma unroll
        for (int t = 0; t < 4; ++t)
#pragma unroll
            for (int mt = 0; mt < 4; ++mt) { const bf16x8 kf = *(const LAS bf16x8*)(Ks + (16 * mt + c) * 256 + (((4 * t + g) ^ c) << 4));
                s[mt] = __builtin_amdgcn_mfma_f32_16x16x32_bf16(kf, qf[t], s[mt], 0, 0, 0); }
        float tmax = -INFINITY;
#pragma unroll
        for (int mt = 0; mt < 4; ++mt)
#pragma unroll
            for (int r = 0; r < 4; ++r) {
                if (MODE == 0) { const int rel = (64 * kt + 16 * mt + 4 * g + r) - (qw0 + c); const bool ok = (rel >= -128) && (rel <= 128);
                    const int ri = ok ? rel + 128 : 128; const float bv = btab[ri]; s[mt][r] = ok ? s[mt][r] + bv : -INFINITY; }
                tmax = fmaxf(tmax, s[mt][r]); }
        tmax = fmaxf(tmax, __shfl_xor(tmax, 16)); tmax = fmaxf(tmax, __shfl_xor(tmax, 32));
        const float mnew = fmaxf(mrun, tmax), alpha = __builtin_amdgcn_exp2f(mrun - mnew); mrun = mnew; float ps = 0.f;
#pragma unroll
        for (int mt = 0; mt < 4; ++mt)
#pragma unroll
            for (int r = 0; r < 4; ++r) { const float p = __builtin_amdgcn_exp2f(s[mt][r] - mnew); s[mt][r] = p; ps += p; }
        lsum = lsum * alpha + ps;
#pragma unroll
        for (int i = 0; i < 8; ++i) oacc[i] = oacc[i] * alpha;
        bf16x8 pf[2];
#pragma unroll
        for (int t2 = 0; t2 < 2; ++t2) { v4u w; w.x = cvtpk(s[2 * t2][0], s[2 * t2][1]); w.y = cvtpk(s[2 * t2][2], s[2 * t2][3]); w.z = cvtpk(s[2 * t2 + 1][0], s[2 * t2 + 1][1]); w.w = cvtpk(s[2 * t2 + 1][2], s[2 * t2 + 1][3]);
            pf[t2] = __builtin_bit_cast(bf16x8, w); }
        const int q4 = c >> 2, p4 = c & 3;
#pragma unroll
        for (int t2 = 0; t2 < 2; ++t2)
#pragma unroll
            for (int mo = 0; mo < 8; ++mo) {
                const int k1 = 32 * t2 + 4 * g + q4, k2 = k1 + 16, chn = 2 * mo + (p4 >> 1);
                const s16x4 lo = __builtin_bit_cast(s16x4, __builtin_amdgcn_ds_read_tr16_b64_v4i16((LAS s16x4*)(Vs + k1 * 256 + ((chn ^ ((k1 & 7) << 1)) << 4) + (p4 & 1) * 8)));
                const s16x4 hi = __builtin_bit_cast(s16x4, __builtin_amdgcn_ds_read_tr16_b64_v4i16((LAS s16x4*)(Vs + k2 * 256 + ((chn ^ ((k2 & 7) << 1)) << 4) + (p4 & 1) * 8)));
                const bf16x8 vf = (bf16x8){lo[0], lo[1], lo[2], lo[3], hi[0], hi[1], hi[2], hi[3]};
                oacc[mo] = __builtin_amdgcn_mfma_f32_16x16x32_bf16(vf, pf[t2], oacc[mo], 0, 0, 0); }
    }
    lsum += __shfl_xor(lsum, 16); lsum += __shfl_xor(lsum, 32);
    const float inv = 1.0f / lsum;
#pragma unroll
    for (int mo = 0; mo < 8; ++mo) { v2u w; w.x = cvtpk(oacc[mo][0] * inv, oacc[mo][1] * inv); w.y = cvtpk(oacc[mo][2] * inv, oacc[mo][3] * inv);
        *(v2u*)(O + (size_t)(qw0 + c) * opitch + 16 * mo + 4 * g) = w; }
}
__device__ __forceinline__ void swa_phase(Frame& F, int b0, int nb) {
    LAS float* btab = (LAS float*)(F.lds + RING_OFF + 32768);
    const bf16* QS = DOP(bf16, DO_QSW); const bf16* KV = DOP(bf16, DO_KVSW); bf16* Y = WSP(bf16, WS_XB);
    if ((int)blockIdx.x < b0) return;
    for (int u = blockIdx.x - b0; u < SWH * (SEQ / 128); u += nb) {
        const int h = u & 7, qb = u >> 3, kvh = h >> 2;
        __syncthreads();
        if (F.tid < 257) btab[F.tid] = F.in[11][t5_bucket(F.tid - 128) * 8 + h] * LOG2E;
        __syncthreads();
        int kb = 2 * qb - 2, ke = 2 * qb + 4; if (kb < 0) kb = 0; if (ke > SEQ / 64) ke = SEQ / 64;
        attn_unit<0>(F, QS + h * 128, 1024, KV + kvh * 128, KV + 256 + kvh * 128, 512, Y + 1024 + h * 128, DM, qb * 128, kb, ke, btab, F.in[10][h] * LOG2E);
    }
}
__device__ __forceinline__ void mem_attn_phase(Frame& F) {
    const bf16* QM = WSP(bf16, WS_QM); const bf16* KVm = WSP(bf16, WS_KVM); bf16* OM = WSP(bf16, WS_OM);
    for (int u = blockIdx.x; u < MEMH * (SEQ / 128); u += F.G) {
        const int h = u & 3, qb = u >> 2;
        attn_unit<1>(F, QM + h * 128, 512, KVm + h * 128, KVm + 512 + h * 128, 1024, OM + h * 128, 512, qb * 128, 0, 4, nullptr, 0.f);
    }
}

typedef float f32x16 __attribute__((ext_vector_type(16)));
constexpr int DX_W = 0, DX_K = 16384, DX_U = 32768, DX_Q = 49152, DX_A = 65536, DX_BYTES = 73728;
constexpr size_t WS_GL = 1 * MiB + 128 * 1024;
constexpr int L_RAW = 0, RAW_PITCH = 784, L_MTF = 0, L_MTB = 16384, L_TB = 32768, TB_PITCH = 144, TB_SZ = 9216;
constexpr int L_QB = 69632, L_KB = 86016, L_KT = 102400, L_VT = 120832, L_PART = 139264, L_SC = 143360;
constexpr int L_CW = 145408;
static_assert(L_SC + 2048 <= L_CW && L_CW + 7680 <= LDSCTL_OFF, "prep LDS map");
__device__ __forceinline__ unsigned char* dnx_rec(Frame& F, int dir, int hd, int cn) { return F.ws + WS_DNX + (size_t)((dir * 8 + hd) * 256 + cn) * DX_BYTES; }
__device__ __forceinline__ v4u pack8f(const float* v) { v4u w; w.x = cvtpk(v[0], v[1]); w.y = cvtpk(v[2], v[3]); w.z = cvtpk(v[4], v[5]); w.w = cvtpk(v[6], v[7]); return w; }

__device__ __forceinline__ bf16x8 cvt8(const f32x16& v, int o) { v4u w; w.x = cvtpk(v[o], v[o + 1]); w.y = cvtpk(v[o + 2], v[o + 3]); w.z = cvtpk(v[o + 4], v[o + 5]); w.w = cvtpk(v[o + 6], v[o + 7]); return __builtin_bit_cast(bf16x8, w); }
__device__ __forceinline__ bf16x8 cvt8f(f32x4 a, f32x4 b) { v4u w; w.x = cvtpk(a[0], a[1]); w.y = cvtpk(a[2], a[3]); w.z = cvtpk(b[0], b[1]); w.w = cvtpk(b[2], b[3]); return __builtin_bit_cast(bf16x8, w); }
template <int dir> __device__ __forceinline__ void dn_solve_and_write(LAS unsigned char* lds, int lane) {
    const LAS float* MT = (const LAS float*)(lds + (dir ? L_MTB : L_MTF));
    LAS float* T0 = (LAS float*)(lds + L_TB + dir * 2 * TB_SZ);
    LAS float* Trow = T0 + lane * 68;
    const int blk = lane >> 5, cb = 32 * blk;
#pragma unroll 1
    for (int jr = 7; jr >= 0; --jr) {
        const int j0 = cb + 4 * jr;
        float a0 = (lane == j0) ? 1.f : 0.f, a1 = (lane == j0 + 1) ? 1.f : 0.f, a2 = (lane == j0 + 2) ? 1.f : 0.f, a3 = (lane == j0 + 3) ? 1.f : 0.f;
        const LAS float* mr = MT + j0 * 64;
#pragma unroll 1
        for (int sr = jr + 1; sr < 8; ++sr) {
            const int s0 = cb + 4 * sr;
            const f32x4 tv = *(const LAS f32x4*)(Trow + s0);
            const f32x4 m0 = *(const LAS f32x4*)(mr + s0), m1 = *(const LAS f32x4*)(mr + 64 + s0), m2 = *(const LAS f32x4*)(mr + 128 + s0), m3 = *(const LAS f32x4*)(mr + 192 + s0);
            a0 -= (tv[0] * m0[0] + tv[1] * m0[1]) + (tv[2] * m0[2] + tv[3] * m0[3]);
            a1 -= (tv[0] * m1[0] + tv[1] * m1[1]) + (tv[2] * m1[2] + tv[3] * m1[3]);
            a2 -= (tv[0] * m2[0] + tv[1] * m2[1]) + (tv[2] * m2[2] + tv[3] * m2[3]);
            a3 -= (tv[0] * m3[0] + tv[1] * m3[1]) + (tv[2] * m3[2] + tv[3] * m3[3]);
        }
        const f32x4 d0 = *(const LAS f32x4*)(mr + j0), d1 = *(const LAS f32x4*)(mr + 64 + j0), d2 = *(const LAS f32x4*)(mr + 128 + j0);
        const float t3 = a3, t2 = a2 - t3 * d2[3], t1 = a1 - t2 * d1[2] - t3 * d1[3], t0 = a0 - t1 * d0[1] - t2 * d0[2] - t3 * d0[3];
        *(LAS f32x4*)(Trow + j0) = (f32x4){t0, t1, t2, t3};
    }
    if (blk == 0) {
#pragma unroll
        for (int q = 8; q < 16; ++q) *(LAS f32x4*)(Trow + 4 * q) = (f32x4){0.f, 0.f, 0.f, 0.f}; }
    asm volatile("s_waitcnt lgkmcnt(0)" ::: "memory");
    {
        const int r = lane & 31, lh = lane >> 5;
        f32x16 Y;
#pragma unroll
        for (int e = 0; e < 16; ++e) Y[e] = 0.f;
#pragma unroll
        for (int kk = 0; kk < 2; ++kk) {
            float av[8], bv[8];
#pragma unroll
            for (int jj = 0; jj < 8; ++jj) { const int k = 16 * kk + 8 * lh + jj; av[jj] = MT[k * 64 + 32 + r]; bv[jj] = T0[k * 68 + r]; }
            Y = __builtin_amdgcn_mfma_f32_32x32x16_bf16(cvt8f((f32x4){av[0], av[1], av[2], av[3]}, (f32x4){av[4], av[5], av[6], av[7]}), cvt8f((f32x4){bv[0], bv[1], bv[2], bv[3]}, (f32x4){bv[4], bv[5], bv[6], bv[7]}), Y, 0, 0, 0);
        }
        f32x16 Z;
#pragma unroll
        for (int e = 0; e < 16; ++e) Z[e] = 0.f;
#pragma unroll
        for (int kk = 0; kk < 2; ++kk) {
            const f32x4 t0 = *(const LAS f32x4*)(T0 + (32 + r) * 68 + 32 + 16 * kk + 4 * lh), t1 = *(const LAS f32x4*)(T0 + (32 + r) * 68 + 32 + 16 * kk + 8 + 4 * lh);
            Z = __builtin_amdgcn_mfma_f32_32x32x16_bf16(cvt8f(t0, t1), cvt8(Y, 8 * kk), Z, 0, 0, 0);
        }
#pragma unroll
        for (int e = 0; e < 16; ++e) T0[(32 + (e & 3) + 8 * (e >> 2) + 4 * lh) * 68 + r] = -Z[e];
    }
    asm volatile("s_waitcnt lgkmcnt(0)" ::: "memory");
    f32x4 tr[16];
#pragma unroll
    for (int q = 0; q < 16; ++q) tr[q] = *(const LAS f32x4*)(Trow + 4 * q);
    asm volatile("s_waitcnt lgkmcnt(0)" ::: "memory");
    const LAS float* sc = (const LAS float*)(lds + L_SC);
    const LAS float* cU = sc + (dir ? 384 : 256); const LAS float* cW = sc + (dir ? 448 : 320);
    const int pos = dir ? 63 - lane : lane;
    LAS unsigned char* tu = lds + L_TB + dir * 2 * TB_SZ + pos * TB_PITCH; LAS unsigned char* tw = tu + TB_SZ;
#pragma unroll
    for (int q = 0; q < 8; ++q) {
        float u8[8], w8[8];
#pragma unroll
        for (int e = 0; e < 8; ++e) { const int s = 8 * q + e, sp = dir ? 63 - s : s; const float t = tr[sp >> 2][sp & 3]; u8[e] = t * cU[s]; w8[e] = t * cW[s]; }
        *(LAS v4u*)(tu + q * 16) = pack8f(u8); *(LAS v4u*)(tw + q * 16) = pack8f(w8);
    }
}

struct PrepRegs { v4u raw[7]; };
__device__ __forceinline__ void prep_load(Frame& F, int u, int tid, int lane, PrepRegs& R) {
    const int cn = u >> 3, hd = u & 7; const bf16* QKV = WSP(bf16, WS_QKV);
#pragma unroll
    for (int k = 0; k < 7; ++k) { const int ci = tid + 512 * k; const int row = ci / 48, cc = ci % 48, seg = cc >> 4, ch = (cc & 15) * 8, tok = 64 * cn - 2 + row;
        v4u v = (v4u){0u, 0u, 0u, 0u};
        if (ci < 68 * 48 && tok >= 0 && tok < SEQ) v = *(const v4u*)(QKV + (size_t)tok * 3072 + seg * 1024 + hd * 128 + ch);
        R.raw[k] = v; }
}
__device__ __forceinline__ void dn_prep_unit(Frame& F, int cn, int hd, PrepRegs& PR, int next_u) {
    LAS unsigned char* lds = F.lds; int tid = F.tid, lane = F.lane; const int wave = F.wave;
    asm volatile("" : "+v"(tid), "+v"(lane));
    LAS float* sc = (LAS float*)(lds + L_SC);
    __syncthreads();
    float abv[4] = {0.f, 0.f, 0.f, 0.f};
    if (wave == 0) { const float* ab = WSP(float, WS_AB) + (size_t)(64 * cn + lane) * 32; abv[0] = ab[hd]; abv[1] = ab[8 + hd]; abv[2] = ab[16 + hd]; abv[3] = ab[24 + hd]; }
    prep_load(F, cn * 8 + hd, tid, lane, PR);
#pragma unroll
    for (int k = 0; k < 7; ++k) { const int ci = tid + 512 * k; const int row = ci / 48, cc = ci % 48, seg = cc >> 4, ch = (cc & 15) * 8;
        if (ci < 68 * 48) *(LAS v4u*)(lds + L_RAW + row * RAW_PITCH + (seg * 128 + ch) * 2) = PR.raw[k]; }
    if (wave == 0) {
        const float bfv = 1.0f / (1.0f + __expf(-abv[0])), bbv = 1.0f / (1.0f + __expf(-abv[1]));
        const float gf = -__expf(F.in[5][hd]) * softplusf(abv[2] + F.in[7][hd]), gb = -__expf(F.in[6][hd]) * softplusf(abv[3] + F.in[8][hd]);
        float Gf = gf, Gb = gb;
#pragma unroll
        for (int o = 1; o < 64; o <<= 1) { const float a = __shfl_up(Gf, o), b = __shfl_down(Gb, o); if (lane >= o) Gf += a; if (lane + o < 64) Gb += b; }
        sc[lane] = Gf; sc[64 + lane] = Gb; sc[128 + lane] = bfv; sc[192 + lane] = bbv;
        sc[256 + lane] = bfv; sc[320 + lane] = -bfv * __expf(Gf); sc[384 + lane] = bbv; sc[448 + lane] = -bbv * __expf(Gb);
        float* GL = WSP(float, WS_GL);
        if (lane == 63) GL[(0 * 8 + hd) * 256 + cn] = __expf(Gf);
        if (lane == 0) GL[(1 * 8 + hd) * 256 + cn] = __expf(Gb);
    }
    __syncthreads();
    asm volatile("" : "+v"(tid), "+v"(lane));
    {
        const int t = wave, pos = lane; const LAS float* cw = (const LAS float*)(lds + L_CW) + 16 * t;
        float qv[16], kv[16], vv[16];
#pragma unroll
        for (int seg = 0; seg < 3; ++seg) {
            float a[16];
#pragma unroll
            for (int i = 0; i < 16; ++i) a[i] = 0.f;
#pragma unroll
            for (int j = 0; j < 5; ++j) {
                const LAS unsigned char* rp = lds + L_RAW + (pos + j) * RAW_PITCH + (seg * 128 + 16 * t) * 2;
                const v4u r0 = *(const LAS v4u*)rp, r1 = *(const LAS v4u*)(rp + 16);
                const LAS float* w = cw + j * 384 + seg * 128;
#pragma unroll
                for (int i = 0; i < 4; ++i) { a[2 * i] += w[2 * i] * bflo(r0[i]); a[2 * i + 1] += w[2 * i + 1] * bfhi(r0[i]); a[8 + 2 * i] += w[8 + 2 * i] * bflo(r1[i]); a[8 + 2 * i + 1] += w[8 + 2 * i + 1] * bfhi(r1[i]); }
            }
#pragma unroll
            for (int i = 0; i < 16; ++i) { const float s = siluf(a[i]); if (seg == 0) qv[i] = s; else if (seg == 1) kv[i] = s; else vv[i] = s; }
        }
        float sq = 0.f, sk = 0.f;
#pragma unroll
        for (int i = 0; i < 16; ++i) { sq += qv[i] * qv[i]; sk += kv[i] * kv[i]; }
        LAS float* part = (LAS float*)(lds + L_PART);
        part[t * 64 + pos] = sq; part[512 + t * 64 + pos] = sk;
        __syncthreads();
        float tq = 0.f, tk = 0.f;
#pragma unroll
        for (int i = 0; i < 8; ++i) { tq += part[i * 64 + pos]; tk += part[512 + i * 64 + pos]; }
        const float rq = (1.0f / sqrtf(tq + 1e-6f)) * 0.08838834764831845f, rk = 1.0f / sqrtf(tk + 1e-6f);
#pragma unroll
        for (int i = 0; i < 16; ++i) { qv[i] *= rq; kv[i] *= rk; }
        *(LAS v4u*)(lds + L_QB + pos * 256 + (((2 * t) ^ (pos & 15)) << 4)) = pack8f(qv); *(LAS v4u*)(lds + L_QB + pos * 256 + (((2 * t + 1) ^ (pos & 15)) << 4)) = pack8f(qv + 8);
        *(LAS v4u*)(lds + L_KB + pos * 256 + (((2 * t) ^ (pos & 15)) << 4)) = pack8f(kv); *(LAS v4u*)(lds + L_KB + pos * 256 + (((2 * t + 1) ^ (pos & 15)) << 4)) = pack8f(kv + 8);
#pragma unroll
        for (int i = 0; i < 16; ++i) { *(LAS unsigned short*)(lds + L_KT + (16 * t + i) * TB_PITCH + pos * 2) = (unsigned short)f2bf(kv[i]); *(LAS unsigned short*)(lds + L_VT + (16 * t + i) * TB_PITCH + pos * 2) = (unsigned short)f2bf(vv[i]); }
        const float ef = __expf(sc[pos]), eb = __expf(sc[64 + pos]); const int mt = pos >> 5;
#pragma unroll
        for (int dir = 0; dir < 2; ++dir) { const float e = dir ? eb : ef; unsigned char* rec = dnx_rec(F, dir, hd, cn) + DX_Q;
#pragma unroll
            for (int lh = 0; lh < 2; ++lh) { float o8[8];
#pragma unroll
                for (int j = 0; j < 8; ++j) o8[j] = qv[8 * (j >> 2) + 4 * lh + (j & 3)] * e;
                *(v4u*)(rec + ((mt * 8 + t) * 64 + 32 * lh + (pos & 31)) * 16) = pack8f(o8); } }
    }
    __syncthreads();
    asm volatile("" : "+v"(tid), "+v"(lane));
    {
        const int r = lane & 31, lh = lane >> 5, x = wave & 3, ta = x >> 1, tb = x & 1;
        const LAS unsigned char* Ab = lds + L_KB + (32 * ta + r) * 256; const LAS unsigned char* Bb = lds + (wave < 4 ? L_KB : L_QB) + (32 * tb + r) * 256;
        f32x16 acc;
#pragma unroll
        for (int i = 0; i < 16; ++i) acc[i] = 0.f;
#pragma unroll
        for (int kk = 0; kk < 8; ++kk) { const int ch = ((2 * kk + lh) ^ (r & 15)) << 4;
            acc = __builtin_amdgcn_mfma_f32_32x32x16_bf16(*(const LAS bf16x8*)(Ab + ch), *(const LAS bf16x8*)(Bb + ch), acc, 0, 0, 0); }
        const int b = 32 * tb + r;
        if (wave < 4) {
            const float Gfb = sc[b], Gbb = sc[64 + b];
#pragma unroll
            for (int q = 0; q < 4; ++q) { const int a0 = 32 * ta + 8 * q + 4 * lh; f32x4 mf, mb;
#pragma unroll
                for (int e = 0; e < 4; ++e) { const int a = a0 + e; const float kkv = acc[4 * q + e];
                    const float vf = sc[128 + a] * kkv * __expf(fminf(sc[a] - Gfb, 0.f)), vb = sc[192 + a] * kkv * __expf(fminf(sc[64 + a] - Gbb, 0.f));
                    mf[e] = (a > b) ? vf : 0.f; mb[3 - e] = (a < b) ? vb : 0.f; }
                *(LAS f32x4*)(lds + L_MTF + (b * 64 + a0) * 4) = mf; *(LAS f32x4*)(lds + L_MTB + ((63 - b) * 64 + 60 - a0) * 4) = mb; }
        } else {
            const float Gfc = sc[b], Gbc = sc[64 + b];
#pragma unroll
            for (int dir = 0; dir < 2; ++dir) { unsigned char* rec = dnx_rec(F, dir, hd, cn) + DX_A;
#pragma unroll
                for (int s2 = 0; s2 < 2; ++s2) { float o8[8];
#pragma unroll
                    for (int j = 0; j < 8; ++j) { const int s = 32 * ta + 16 * s2 + 8 * (j >> 2) + 4 * lh + (j & 3); const float v = acc[8 * s2 + j];
                        const float ev = v * __expf(fminf(dir ? Gbc - sc[64 + s] : Gfc - sc[s], 0.f)); o8[j] = (dir ? (s >= b) : (s <= b)) ? ev : 0.f; }
                    *(v4u*)(rec + ((tb * 4 + 2 * ta + s2) * 64 + lane) * 16) = pack8f(o8); } }
        }
    }
    __syncthreads();
    asm volatile("" : "+v"(tid), "+v"(lane));
    if (wave == 0) dn_solve_and_write<0>(lds, lane);
    else if (wave == 1) dn_solve_and_write<1>(lds, lane);
    else {
        const int r = lane & 31, lh = lane >> 5;
        for (int f = wave - 2; f < 32; f += 6) { const int dir = f >> 4, m = (f >> 2) & 3, t = f & 3; const int dk = 32 * m + r;
            const v2u k0 = *(const LAS v2u*)(lds + L_KT + dk * TB_PITCH + (16 * t + 4 * lh) * 2), k1 = *(const LAS v2u*)(lds + L_KT + dk * TB_PITCH + (16 * t + 8 + 4 * lh) * 2);
            const float Gl = dir ? sc[64] : sc[63]; const LAS float* Gs = sc + (dir ? 64 : 0) + 16 * t + 4 * lh; float o8[8];
            o8[0] = bflo(k0.x) * __expf(Gl - Gs[0]); o8[1] = bfhi(k0.x) * __expf(Gl - Gs[1]); o8[2] = bflo(k0.y) * __expf(Gl - Gs[2]); o8[3] = bfhi(k0.y) * __expf(Gl - Gs[3]);
            o8[4] = bflo(k1.x) * __expf(Gl - Gs[8]); o8[5] = bfhi(k1.x) * __expf(Gl - Gs[9]); o8[6] = bflo(k1.y) * __expf(Gl - Gs[10]); o8[7] = bfhi(k1.y) * __expf(Gl - Gs[11]);
            *(v4u*)(dnx_rec(F, dir, hd, cn) + DX_K + ((m * 4 + t) * 64 + lane) * 16) = pack8f(o8); }
    }
    __syncthreads();
    asm volatile("" : "+v"(tid), "+v"(lane));
    {
        const int dir = wave >> 2, x = wave & 3, r = lane & 31, lh = lane >> 5;
        const LAS unsigned char* Tu = lds + L_TB + (dir ? 2 : 0) * TB_SZ; const LAS unsigned char* Tw = Tu + TB_SZ;
        unsigned char* rec = dnx_rec(F, dir, hd, cn);
#pragma unroll
        for (int mt = 0; mt < 2; ++mt) {
            f32x16 aw, au;
#pragma unroll
            for (int i = 0; i < 16; ++i) { aw[i] = 0.f; au[i] = 0.f; }
#pragma unroll
            for (int kk = 0; kk < 4; ++kk) { const int so = (16 * kk + 8 * lh) * 2;
                aw = __builtin_amdgcn_mfma_f32_32x32x16_bf16(*(const LAS bf16x8*)(lds + L_KT + (32 * x + r) * TB_PITCH + so), *(const LAS bf16x8*)(Tw + (32 * mt + r) * TB_PITCH + so), aw, 0, 0, 0);
                au = __builtin_amdgcn_mfma_f32_32x32x16_bf16(*(const LAS bf16x8*)(Tu + (32 * mt + r) * TB_PITCH + so), *(const LAS bf16x8*)(lds + L_VT + (32 * x + r) * TB_PITCH + so), au, 0, 0, 0); }
            float tmp[16];
#pragma unroll
            for (int i = 0; i < 16; ++i) tmp[i] = aw[i];
            *(v4u*)(rec + DX_W + ((mt * 8 + 2 * x) * 64 + lane) * 16) = pack8f(tmp); *(v4u*)(rec + DX_W + ((mt * 8 + 2 * x + 1) * 64 + lane) * 16) = pack8f(tmp + 8);
#pragma unroll
            for (int i = 0; i < 16; ++i) tmp[i] = au[i];
            *(v4u*)(rec + DX_U + ((x * 2 + mt) * 64 + lane) * 32) = pack8f(tmp); *(v4u*)(rec + DX_U + ((x * 2 + mt) * 64 + lane) * 32 + 16) = pack8f(tmp + 8);
        }
    }
}
__device__ __forceinline__ void dn_prep_phase(Frame& F) {
    PrepRegs PR; int u = blockIdx.x; int cur_hd = -1;
    for (; u < 256 * DNH; u += F.G) {
        const int hd = u & 7;
        if (hd != cur_hd) {
            __syncthreads();
            for (int i = F.tid; i < 5 * 384; i += NWAVES * 64) { const int j = i / 384, c = i % 384; ((LAS float*)(F.lds + L_CW))[i] = F.in[4][j * 3072 + (c >> 7) * 1024 + hd * 128 + (c & 127)]; }
            cur_hd = hd;
        }
        dn_prep_unit(F, u >> 3, hd, PR, u + F.G);
    }
}


constexpr int NSEG = 16, SEGL = 16;
constexpr size_t WS_PF = 176 * MiB, WS_RG = 184 * MiB, WS_SIN = 24 * MiB;
constexpr int SLOT1 = 49152, SLOT3 = 73728, L_GLS = 147456;
#define DN_WAIT(V) asm volatile("s_waitcnt vmcnt(" #V ") lgkmcnt(0)" ::: "memory")
#define DN_BAR() do { __builtin_amdgcn_s_barrier(); asm volatile("" ::: "memory"); } while (0)
__device__ __forceinline__ int seg_chunk(int dir, int g, int i) { const int n = SEGL * g + i; return dir ? 255 - n : n; }
__device__ __forceinline__ void u_to_acc(f32x16& a, const LAS unsigned char* up) {
    const v4u u0 = *(const LAS v4u*)up, u1 = *(const LAS v4u*)(up + 16);
#pragma unroll
    for (int i = 0; i < 4; ++i) { a[2 * i] = bflo(u0[i]); a[2 * i + 1] = bfhi(u0[i]); a[8 + 2 * i] = bflo(u1[i]); a[8 + 2 * i + 1] = bfhi(u1[i]); }
}
template <bool OUT>
__device__ __forceinline__ void dn_step(f32x16 (&S)[4], f32x16 (&aV)[2], f32x16 (&aO)[2], const LAS unsigned char* buf, float gl) {
#pragma unroll
    for (int t = 0; t < 8; ++t) { const bf16x8 sb = cvt8(S[t >> 1], 8 * (t & 1));
#pragma unroll
        for (int mt = 0; mt < 2; ++mt) {
            aV[mt] = __builtin_amdgcn_mfma_f32_32x32x16_bf16(*(const LAS bf16x8*)(buf + DX_W + (mt * 8 + t) * 1024), sb, aV[mt], 0, 0, 0);
            if (OUT) aO[mt] = __builtin_amdgcn_mfma_f32_32x32x16_bf16(*(const LAS bf16x8*)(buf + DX_Q + (mt * 8 + t) * 1024), sb, aO[mt], 0, 0, 0); } }
    bf16x8 vb[4];
#pragma unroll
    for (int t = 0; t < 4; ++t) vb[t] = cvt8(aV[t >> 1], 8 * (t & 1));
#pragma unroll
    for (int m = 0; m < 4; ++m) S[m] = S[m] * gl;
#pragma unroll
    for (int t = 0; t < 4; ++t) {
#pragma unroll
        for (int m = 0; m < 4; ++m) S[m] = __builtin_amdgcn_mfma_f32_32x32x16_bf16(*(const LAS bf16x8*)(buf + DX_K + (m * 4 + t) * 1024), vb[t], S[m], 0, 0, 0);
        if (OUT) {
#pragma unroll
            for (int mt = 0; mt < 2; ++mt) aO[mt] = __builtin_amdgcn_mfma_f32_32x32x16_bf16(*(const LAS bf16x8*)(buf + DX_A + (mt * 4 + t) * 1024), vb[t], aO[mt], 0, 0, 0); } }
}

__device__ __forceinline__ void dn_pass1(Frame& F) {
    LAS unsigned char* lds = F.lds; const int lane = F.lane, wave = F.wave, r = lane & 31, lh = lane >> 5, part = wave >> 2, d = wave & 3;
    LAS float* gls = (LAS float*)(lds + L_GLS);
    for (int unit = blockIdx.x; unit < 16 * NSEG; unit += F.G) {
        const int dir = unit >> 7, hd = (unit >> 4) & 7, g = unit & 15;
        DN_WAIT(0); __syncthreads();
        if (F.tid < SEGL) gls[F.tid] = WSP(float, WS_GL)[(dir * 8 + hd) * 256 + seg_chunk(dir, g, F.tid)];
        DN_WAIT(0);
        f32x16 S[4];
#pragma unroll
        for (int m = 0; m < 4; ++m)
#pragma unroll
            for (int i = 0; i < 16; ++i) S[m][i] = (part && (32 * m + (i & 3) + 8 * (i >> 2) + 4 * lh == 32 * d + r)) ? 1.f : 0.f;
#define P1_ISSUE(i) do { const unsigned char* src_ = dnx_rec(F, dir, hd, seg_chunk(dir, g, (i))) + lane * 16; LAS unsigned char* dst_ = lds + ((i) % 3) * SLOT1; \
            _Pragma("unroll") for (int k_ = 0; k_ < 6; ++k_) { const int p_ = wave + 8 * k_; __builtin_amdgcn_global_load_lds((const unsigned*)(src_ + p_ * 1024), (LAS unsigned*)(dst_ + p_ * 1024), 16, 0, 0); } } while (0)
        P1_ISSUE(0); P1_ISSUE(1);
        for (int i = 0; i < SEGL; ++i) {
            if (i + 1 < SEGL) DN_WAIT(6); else DN_WAIT(0);
            DN_BAR();
            if (i + 2 < SEGL) P1_ISSUE(i + 2);
            const LAS unsigned char* buf = lds + (i % 3) * SLOT1 + lane * 16;
            f32x16 aV[2], aO[2];
#pragma unroll
            for (int mt = 0; mt < 2; ++mt) {
                if (part == 0) u_to_acc(aV[mt], lds + (i % 3) * SLOT1 + DX_U + ((d * 2 + mt) * 64 + lane) * 32);
                else {
#pragma unroll
                    for (int e = 0; e < 16; ++e) aV[mt][e] = 0.f; } }
            dn_step<false>(S, aV, aO, buf, gls[i]);
        }
#undef P1_ISSUE
        DN_WAIT(0); DN_BAR();
        if (part == 0) {
            float* rg = (float*)(F.ws + WS_RG) + (size_t)unit * 16384;
#pragma unroll
            for (int m = 0; m < 4; ++m)
#pragma unroll
                for (int q = 0; q < 4; ++q) *(f32x4*)(rg + ((d * 4 + m) * 64 + lane) * 16 + 4 * q) = (f32x4){S[m][4 * q], S[m][4 * q + 1], S[m][4 * q + 2], S[m][4 * q + 3]};
        } else {
#pragma unroll
            for (int m = 0; m < 4; ++m)
#pragma unroll
                for (int i = 0; i < 16; ++i) *(LAS unsigned short*)(lds + (32 * m + (i & 3) + 8 * (i >> 2) + 4 * lh) * 272 + (32 * d + r) * 2) = (unsigned short)f2bf(S[m][i]);
        }
        DN_WAIT(0); DN_BAR();
        if (part == 1) {
            unsigned char* pf = F.ws + WS_PF + (size_t)unit * 32768;
#pragma unroll
            for (int k = 0; k < 8; ++k) { const int f = d * 8 + k, m = f >> 3, t = f & 7;
                const v2u a = *(const LAS v2u*)(lds + (32 * m + r) * 272 + (16 * t + 4 * lh) * 2), b = *(const LAS v2u*)(lds + (32 * m + r) * 272 + (16 * t + 8 + 4 * lh) * 2);
                *(v4u*)(pf + (f * 64 + lane) * 16) = (v4u){a.x, a.y, b.x, b.y}; }
        }
    }
}
__device__ __forceinline__ void dn_fold(Frame& F) {
    const int b = blockIdx.x; if (b >= 16) return;
    LAS unsigned char* lds = F.lds; const int lane = F.lane, wave = F.wave, dir = b >> 3, hd = b & 7;
    const int unit0 = (dir * 8 + hd) * 16;
    __syncthreads();
    if (wave >= 4) {
        const int lw = wave - 4;
        for (int g = 0; g < NSEG; ++g) {
            if (g < NSEG - 1) { const unsigned char* src = F.ws + WS_PF + (size_t)(unit0 + g) * 32768 + lane * 16; LAS unsigned char* dst = lds + (g & 1) * 32768;
#pragma unroll
                for (int k = 0; k < 8; ++k) { const int p = lw + 4 * k; __builtin_amdgcn_global_load_lds((const unsigned*)(src + p * 1024), (LAS unsigned*)(dst + p * 1024), 16, 0, 0); } }
            DN_WAIT(0); DN_BAR();
        }
    } else {
        const int d = wave;
        f32x16 S[4], R[4];
#pragma unroll
        for (int m = 0; m < 4; ++m)
#pragma unroll
            for (int i = 0; i < 16; ++i) S[m][i] = 0.f;
        const float* rg0 = (const float*)(F.ws + WS_RG) + (size_t)unit0 * 16384; float* sin0 = (float*)(F.ws + WS_SIN) + (size_t)unit0 * 16384;
#pragma unroll
        for (int m = 0; m < 4; ++m)
#pragma unroll
            for (int q = 0; q < 4; ++q) { const f32x4 v = *(const f32x4*)(rg0 + ((d * 4 + m) * 64 + lane) * 16 + 4 * q); R[m][4 * q] = v[0]; R[m][4 * q + 1] = v[1]; R[m][4 * q + 2] = v[2]; R[m][4 * q + 3] = v[3]; }
        DN_BAR();
        for (int g = 0; g < NSEG; ++g) {
            float* so = sin0 + (size_t)g * 16384;
#pragma unroll
            for (int m = 0; m < 4; ++m)
#pragma unroll
                for (int q = 0; q < 4; ++q) *(f32x4*)(so + ((d * 4 + m) * 64 + lane) * 16 + 4 * q) = (f32x4){S[m][4 * q], S[m][4 * q + 1], S[m][4 * q + 2], S[m][4 * q + 3]};
            if (g == NSEG - 1) break;
            const LAS unsigned char* buf = lds + (g & 1) * 32768 + lane * 16;
            bf16x8 sb[8];
#pragma unroll
            for (int t = 0; t < 8; ++t) sb[t] = cvt8(S[t >> 1], 8 * (t & 1));
#pragma unroll
            for (int m = 0; m < 4; ++m) { S[m] = R[m];
#pragma unroll
                for (int t = 0; t < 8; ++t) S[m] = __builtin_amdgcn_mfma_f32_32x32x16_bf16(*(const LAS bf16x8*)(buf + (m * 8 + t) * 1024), sb[t], S[m], 0, 0, 0); }
            if (g + 1 < NSEG - 1) { const float* rg = rg0 + (size_t)(g + 1) * 16384;
#pragma unroll
                for (int m = 0; m < 4; ++m)
#pragma unroll
                    for (int q = 0; q < 4; ++q) { const f32x4 v = *(const f32x4*)(rg + ((d * 4 + m) * 64 + lane) * 16 + 4 * q); R[m][4 * q] = v[0]; R[m][4 * q + 1] = v[1]; R[m][4 * q + 2] = v[2]; R[m][4 * q + 3] = v[3]; } }
            asm volatile("s_waitcnt lgkmcnt(0)" ::: "memory");
            DN_BAR();
        }
    }
    __syncthreads();
}
__device__ __forceinline__ void dn_pass3(Frame& F) {
    LAS unsigned char* lds = F.lds; const int lane = F.lane, wave = F.wave, r = lane & 31, lh = lane >> 5;
    LAS float* gls = (LAS float*)(lds + L_GLS);
    for (int unit = blockIdx.x; unit < 16 * NSEG; unit += F.G) {
        const int dir = unit >> 7, hd = (unit >> 4) & 7, g = unit & 15;
        __syncthreads();
        if (F.tid < SEGL) gls[F.tid] = WSP(float, WS_GL)[(dir * 8 + hd) * 256 + seg_chunk(dir, g, F.tid)];
        asm volatile("s_waitcnt lgkmcnt(0)" ::: "memory");
        if (wave >= 4) {
            const int lw = wave - 4;
            for (int i = 0; i <= SEGL; ++i) {
                if (i < SEGL) { const unsigned char* src = dnx_rec(F, dir, hd, seg_chunk(dir, g, i)) + lane * 16; LAS unsigned char* dst = lds + (i & 1) * SLOT3;
#pragma unroll
                    for (int k = 0; k < 18; ++k) { const int p = lw + 4 * k; __builtin_amdgcn_global_load_lds((const unsigned*)(src + p * 1024), (LAS unsigned*)(dst + p * 1024), 16, 0, 0); } }
                DN_WAIT(0); DN_BAR();
            }
        } else {
            const int d = wave;
            f32x16 S[4];
            const float* si = (const float*)(F.ws + WS_SIN) + (size_t)unit * 16384;
#pragma unroll
            for (int m = 0; m < 4; ++m)
#pragma unroll
                for (int q = 0; q < 4; ++q) { const f32x4 v = *(const f32x4*)(si + ((d * 4 + m) * 64 + lane) * 16 + 4 * q); S[m][4 * q] = v[0]; S[m][4 * q + 1] = v[1]; S[m][4 * q + 2] = v[2]; S[m][4 * q + 3] = v[3]; }
            bf16* O = WSP(bf16, dir ? WS_OB : WS_OF);
            DN_BAR();
            for (int i = 0; i < SEGL; ++i) {
                const int cn = seg_chunk(dir, g, i); const LAS unsigned char* slot = lds + (i & 1) * SLOT3;
                f32x16 aV[2], aO[2];
#pragma unroll
                for (int mt = 0; mt < 2; ++mt) { u_to_acc(aV[mt], slot + DX_U + ((d * 2 + mt) * 64 + lane) * 32);
#pragma unroll
                    for (int e = 0; e < 16; ++e) aO[mt][e] = 0.f; }
                dn_step<true>(S, aV, aO, slot + lane * 16, gls[i]);
                bf16* op = O + (size_t)(64 * cn + 4 * lh) * 1024 + hd * 128 + 32 * d + r;
#pragma unroll
                for (int mt = 0; mt < 2; ++mt)
#pragma unroll
                    for (int e = 0; e < 16; ++e) op[(size_t)(32 * mt + (e & 3) + 8 * (e >> 2)) * 1024] = (bf16)f2bf(aO[mt][e]);
                asm volatile("s_waitcnt lgkmcnt(0)" ::: "memory");
                DN_BAR();
            }
        }
    }
    __syncthreads();
}

#ifndef MK_N_LAUNCHES
#define MK_N_LAUNCHES 1
#endif
constexpr int N_PHASES = 14;
struct Args { const float* in[23]; float* out; unsigned char* ws; int ph_lo, ph_hi; };
static_assert(sizeof(Args) == 23 * 8 + 8 + 8 + 8, "Args has no padding");

__global__ void __launch_bounds__(NWAVES * 64, 2) enc_fwd(Args args) {
    extern __shared__ __attribute__((aligned(16))) unsigned char lds[];
    Frame F;
    F.lds = (LAS unsigned char*)lds;
    F.MISC = (volatile LAS unsigned*)(F.lds + MISC_OFF);
    F.tid = threadIdx.x; F.lane = F.tid & 63; F.wave = __builtin_amdgcn_readfirstlane(F.tid >> 6);
    F.G = gridDim.x; { const int bx = blockIdx.x; F.vcu = (F.G % 8 == 0) ? (bx % 8) * (F.G / 8) + bx / 8 : bx; }
#pragma unroll
    for (int i = 0; i < 23; ++i) F.in[i] = args.in[i];
    F.out = args.out; F.ws = args.ws; F.ctl = (gu32*)(args.ws + WS_CTL);
    for (int u = F.tid; u < (LDS_BYTES - LDSCTL_OFF) / 4; u += NWAVES * 64) ((LAS unsigned*)(F.lds + LDSCTL_OFF))[u] = 0u;
    __syncthreads();
    const int lo = args.ph_lo, hi = args.ph_hi;
    XcdBarrier bar; bar.bar = (unsigned*)(F.ctl + CW_BAR); bar.x = 0; bar.st = nullptr;
    if (hi - lo > 1) bar = xcd_barrier_post((unsigned*)(F.ctl + CW_BAR), F.MISC + 8);
#define IN(k) (lo <= (k) && (k) < hi)
#define SEAM(k) do { if (IN(k) && IN((k) + 1)) xcd_barrier(bar); } while (0)
    float* sumsq2 = (float*)(F.ws + WS_CTL + CTL_SUMSQ2); float* sumsq3 = (float*)(F.ws + WS_CTL + CTL_SUMSQ3); float* sumsq4 = (float*)(F.ws + WS_CTL + CTL_SUMSQ4);

    if (IN(0)) { p0_prologue(F);
#if defined(REPEAT_PHASE) && REPEAT_PHASE == 0
        p0_prologue(F);
#endif
    } SEAM(0);
    if (IN(1)) {
        { pg8::Gemm g{WSP(bf16, WS_XB), WSP(bf16, WS_WIN), SEQ, NINP, DM}; pg8::StaticOrder S; S.init(SEQ, NINP, F.G, (int)blockIdx.x);
          EpiProj E{WSP(float, WS_RSTD1), WSP(bf16, WS_QKV), DOP(bf16, DO_Z), DOP(bf16, DO_QSW), DOP(bf16, DO_KVSW), WSP(float, WS_AB)};
          pg8::gemm_phase<EpiProj, pg8::StaticOrder, true, true>(F.lds + RING_OFF, g, S, E); }
    } SEAM(1);
    if (IN(2)) { dn_prep_phase(F);
#ifdef REPEAT_PREP
        dn_prep_phase(F);
#endif
    } SEAM(2);
    if (IN(3)) { dn_pass1(F);
#if defined(REPEAT_PHASE) && REPEAT_PHASE == 3
        dn_pass1(F);
#endif
    } SEAM(3);
    if (IN(12)) { dn_fold(F); if (F.G > 16) swa_phase(F, 16, F.G - 16); else swa_phase(F, 0, F.G); }
    if (IN(12) && IN(13)) xcd_barrier(bar);
    if (IN(13)) { dn_pass3(F);
#if defined(REPEAT_PHASE) && REPEAT_PHASE == 13
        dn_pass3(F);
#endif
    } if (IN(13) && IN(4)) xcd_barrier(bar);
    if (IN(4)) { dn_combine(F); p4_transposes(F);
#if defined(REPEAT_PHASE) && REPEAT_PHASE == 4
        dn_combine(F); p4_transposes(F);
#endif
    } SEAM(4);
    if (IN(5)) {
        pg8::Gemm g{WSP(bf16, WS_XB), WSP(bf16, WS_WOUT), SEQ, DM, DM}; pg8::StaticOrder S; S.init(SEQ, DM, F.G, (int)blockIdx.x);
        EpiRes E{F.in[0], F.out, WSP(bf16, WS_H1B), sumsq2};
        pg8::gemm_phase<EpiRes, pg8::StaticOrder, true, true>(F.lds + RING_OFF, g, S, E);
    } SEAM(5);
    if (IN(6)) {
        pg8::Gemm g{WSP(bf16, WS_H1B), WSP(bf16, WS_WQ), SEQ, 512, DM}; pg8::StaticOrder S; S.init(SEQ, 512, F.G, (int)blockIdx.x);
        EpiScaleBf16 E{sumsq2, 1, QSCALE, WSP(bf16, WS_QM), 512};
        pg8::gemm_phase<EpiScaleBf16, pg8::StaticOrder, true, true>(F.lds + RING_OFF, g, S, E);
        { pg8::Gemm g2{WSP(bf16, WS_MEMB), WSP(bf16, WS_WKV), MEMT, 1024, DM}; pg8::StaticOrder S2; S2.init(MEMT, 1024, F.G, (int)((blockIdx.x + F.G - (F.G >> 1)) % F.G));
          EpiScaleBf16 E2{WSP(float, WS_RSTDM), 0, 1.0f, WSP(bf16, WS_KVM), 1024};
          pg8::gemm_phase<EpiScaleBf16, pg8::StaticOrder, true, true>(F.lds + RING_OFF, g2, S2, E2); }
    } SEAM(6);
    if (IN(7)) { mem_attn_phase(F);
#if defined(REPEAT_PHASE) && REPEAT_PHASE == 7
        mem_attn_phase(F);
#endif
    } SEAM(7);
    if (IN(8)) {
        pg8::Gemm g{WSP(bf16, WS_OM), WSP(bf16, WS_WO), SEQ, DM, 512}; pg8::StaticOrder S; S.init(SEQ, DM, F.G, (int)blockIdx.x);
        EpiRes E{F.out, F.out, WSP(bf16, WS_XB), sumsq3};
        pg8::gemm_phase<EpiRes, pg8::StaticOrder, true, true>(F.lds + RING_OFF, g, S, E);
    } SEAM(8);
    if (IN(9)) {
        pg8::Gemm g{WSP(bf16, WS_XB), WSP(bf16, WS_WGU), SEQ, 2 * DFF, DM}; pg8::StaticOrder S; S.init(SEQ, 2 * DFF, F.G, (int)blockIdx.x);
        EpiSwiglu E{sumsq3, WSP(bf16, WS_HID)};
        pg8::gemm_phase<EpiSwiglu, pg8::StaticOrder, true, true>(F.lds + RING_OFF, g, S, E);
#if defined(REPEAT_PHASE) && REPEAT_PHASE == 9
        pg8::gemm_phase<EpiSwiglu, pg8::StaticOrder, true, true>(F.lds + RING_OFF, g, S, E);
#endif
    } SEAM(9);
    if (IN(10)) {
        pg8::Gemm g{WSP(bf16, WS_HID), WSP(bf16, WS_WD), SEQ, DM, DFF}; pg8::StaticOrder S; S.init(SEQ, DM, F.G, (int)blockIdx.x);
        EpiRes E{F.out, nullptr, WSP(bf16, WS_H3B), sumsq4};
        pg8::gemm_phase<EpiRes, pg8::StaticOrder, true, true>(F.lds + RING_OFF, g, S, E);
    } SEAM(10);
    if (IN(11)) { final_norm(F);
#if defined(REPEAT_PHASE) && REPEAT_PHASE == 11
        final_norm(F);
#endif
    }
#undef IN
#undef SEAM
}

extern "C" void kernel_launch(void* const* d_in, const int* in_sizes, int n_in, void* d_out, int out_size, void* d_ws, size_t ws_size, hipStream_t stream) {
    static int grid = 0;
    if (grid == 0) {
        if (n_in != 23 || out_size != SEQ * DM || ws_size < WS_END) { fprintf(stderr, "kernel_launch: unexpected shapes (n_in %d out %d ws %zu)\n", n_in, out_size, ws_size); grid = -1; return; }
        int dev = 0, cus = 0;
        if (hipGetDevice(&dev) != hipSuccess || hipDeviceGetAttribute(&cus, hipDeviceAttributeMultiprocessorCount, dev) != hipSuccess) { grid = -1; return; }
        if (hipFuncSetAttribute((const void*)enc_fwd, hipFuncAttributeMaxDynamicSharedMemorySize, LDS_BYTES) != hipSuccess) { fprintf(stderr, "kernel_launch: hipFuncSetAttribute failed\n"); grid = -1; return; }
        (void)hipGetLastError();
        grid = cus;
    }
    if (grid < 0) return;
    if (hipMemsetAsync((char*)d_ws + WS_CTL, 0, CTL_ZERO_BYTES, stream) != hipSuccess) return;
    Args a{};
    for (int i = 0; i < 23; ++i) a.in[i] = (const float*)d_in[i];
    a.out = (float*)d_out; a.ws = (unsigned char*)d_ws;
    const int per = (N_PHASES + MK_N_LAUNCHES - 1) / MK_N_LAUNCHES;
    for (int lo = 0; lo < N_PHASES; lo += per) {
        a.ph_lo = lo; a.ph_hi = (lo + per < N_PHASES) ? lo + per : N_PHASES;
        hipLaunchKernelGGL(enc_fwd, dim3(grid), dim3(NWAVES * 64), LDS_BYTES, stream, a);
    }
}
```

```cpp
#include <hip/hip_runtime.h>
#include <cstdio>
#include <cstdint>
namespace pg8 {
__device__ __forceinline__ unsigned cvt_pk_bf16(float lo, float hi) { unsigned r; asm volatile("v_cvt_pk_bf16_f32 %0, %1, %2" : "=v"(r) : "v"(lo), "v"(hi)); return r; }
#define PG8_LAS __attribute__((address_space(3)))
typedef unsigned short bf16_t;
typedef short bf16x8 __attribute__((ext_vector_type(8)));
typedef float f32x4 __attribute__((ext_vector_type(4)));
typedef unsigned u32x4 __attribute__((ext_vector_type(4)));
constexpr int BM = 256, BK = 64, HALF = 128, HTB = HALF * BK * 2  , STAGE_BYTES = 8 * HTB, NXCD = 8, WGM = 8;

__host__ __device__ __forceinline__ int lds_byte(int r, int c) { const int st = (r >> 4) * 2 + (c >> 5), rr = r & 15, cc = c & 31, ob = rr * 64 + cc * 2; return st * 1024 + (ob ^ (((ob >> 9) & 1) << 5)); }
__host__ __device__ __forceinline__ void stage_rc(int b, int& R, int& C) { const int st = b / 1024, sb = b % 1024, swz = sb ^ (((sb >> 9) & 1) << 5); R = (st >> 1) * 16 + swz / 64; C = (st & 1) * 32 + (swz % 64) / 2; }
__host__ __device__ __forceinline__ int perm32(int rho) { const int n = rho >> 4, i = rho & 15; return 8 * (i >> 2) + 4 * n + (i & 3); }

struct Unit { int pm, pn; };
struct Gemm { const bf16_t* A; const bf16_t* Bt; int M, N, K; };

struct StaticOrder {
    int nM, nN, nwg, G, c;
    __host__ __device__ void init(int M, int N, int G_, int c_) { nM = M / BM; nN = N / BM; nwg = nM * nN; G = G_; c = c_; }
    __host__ __device__ bool next(int i, Unit& u) const {
        const long L = (long)i * G + c; if (L >= nwg) return false;
        int wgid = (int)L; { const int q = nwg / NXCD, r = nwg % NXCD, xcd = wgid % NXCD, off = wgid / NXCD; wgid = (xcd < r ? xcd * (q + 1) : r * (q + 1) + (xcd - r) * q) + off; }
        const int nig = WGM * nN, gid = wgid / nig, fm = gid * WGM, gsz = (nM - fm) < WGM ? (nM - fm) : WGM;
        u.pm = fm + ((wgid % nig) % gsz); u.pn = (wgid % nig) / gsz; return true;
    }
    __device__ __forceinline__ void a_ready(const Unit&) const {}
    __device__ __forceinline__ void done(const Unit&) const {}
};

template <class Epi, class Sched, bool ALIGN_EPI = false, bool SP2 = false>
__device__ __forceinline__ void gemm_phase(PG8_LAS unsigned char* lds, const Gemm g, const Sched& S, const Epi& E) {
    const int tid = threadIdx.x, wid = __builtin_amdgcn_readfirstlane(tid >> 6), lane = tid & 63, wr = wid >> 2, wc = wid & 3, fr = lane & 15, fq = lane >> 4;
    const int K = g.K, nt = K / BK;
    unsigned voffA[2], voffB[2];
#pragma unroll
    for (int i = 0; i < 2; ++i) { int R, C; stage_rc(tid * 16 + i * 8192, R, C); const int Rb = Epi::PERM ? ((R & ~31) + perm32(R & 31)) : R;
        voffA[i] = (unsigned)(R * K + C) * 2u; voffB[i] = (unsigned)(Rb * K + C) * 2u; }
    const size_t kstep = (size_t)(BK * 2);
    const size_t hstep = (size_t)HALF * K * 2;
    const size_t tstep = 2 * hstep;
    const unsigned ldsw = (unsigned)wid * 1024u;
    const int aoff = lds_byte(wr * 64 + fr, fq * 8), boff = lds_byte(wc * 32 + fr, fq * 8);
#define PG8_SA(b, h) (((b) * 2 + (h)) * HTB)
#define PG8_SB(b, h) ((4 + (b) * 2 + (h)) * HTB)
#define PG8_STAGE(bufoff, gbase, voff) do { _Pragma("unroll") for (int _i = 0; _i < 2; ++_i) \
        __builtin_amdgcn_global_load_lds((const unsigned*)((const char*)(gbase) + (voff)[_i]), (PG8_LAS unsigned*)(lds + (bufoff) + ldsw + _i * 8192), 16, 0, 0); } while (0)
#define PG8_LDA(dst, b, h) do { _Pragma("unroll") for (int m = 0; m < 4; ++m) _Pragma("unroll") for (int k = 0; k < 2; ++k) dst[m][k] = *(const PG8_LAS bf16x8*)(lds + PG8_SA(b, h) + aoff + m * 2048 + k * 1024); } while (0)
#define PG8_LDB(dst, b, h) do { _Pragma("unroll") for (int n = 0; n < 2; ++n) _Pragma("unroll") for (int k = 0; k < 2; ++k) dst[n][k] = *(const PG8_LAS bf16x8*)(lds + PG8_SB(b, h) + boff + n * 2048 + k * 1024); } while (0)
#define PG8_MMA(ai, bj, At, Bt) do { __builtin_amdgcn_s_setprio(1); _Pragma("unroll") for (int m = 0; m < 4; ++m) _Pragma("unroll") for (int n = 0; n < 2; ++n) _Pragma("unroll") for (int k = 0; k < 2; ++k) \
        acc[ai][bj][m][n] = __builtin_amdgcn_mfma_f32_16x16x32_bf16(Bt[n][k], At[m][k], acc[ai][bj][m][n], 0, 0, 0); __builtin_amdgcn_s_setprio(0); } while (0)
#define PG8_WAIT_V(n) asm volatile("s_waitcnt vmcnt(" #n ")" ::: "memory")
#define PG8_WAIT_L(n) asm volatile("s_waitcnt lgkmcnt(" #n ")" ::: "memory")
#define PG8_BAR __builtin_amdgcn_s_barrier()
#define PG8_SCHED __builtin_amdgcn_sched_barrier(0)
    Unit cur, nxt; int ui = 0;
    if (!S.next(0, cur)) return;
    f32x4 acc[2][2][4][2];
#pragma unroll
    for (int a = 0; a < 2; ++a)
#pragma unroll
        for (int b = 0; b < 2; ++b)
#pragma unroll
            for (int m = 0; m < 4; ++m)
#pragma unroll
                for (int n = 0; n < 2; ++n) acc[a][b][m][n] = (f32x4){0.f, 0.f, 0.f, 0.f};
    bf16x8 At[4][2], B0[2][2], B1[2][2];
    const char* cA = (const char*)g.A + (size_t)cur.pm * tstep; const char* cB = (const char*)g.Bt + (size_t)cur.pn * tstep;
    S.a_ready(cur);
    if constexpr (SP2) {
        PG8_STAGE(PG8_SB(0, 0), cB, voffB); PG8_STAGE(PG8_SB(0, 1), cB + hstep, voffB); PG8_STAGE(PG8_SA(0, 0), cA, voffA); PG8_STAGE(PG8_SA(0, 1), cA + hstep, voffA);
        if (wr == 1) PG8_BAR;
        PG8_WAIT_V(2); PG8_BAR;
        PG8_STAGE(PG8_SB(1, 0), cB + kstep, voffB); PG8_STAGE(PG8_SA(1, 0), cA + kstep, voffA); PG8_STAGE(PG8_SB(1, 1), cB + hstep + kstep, voffB);
        PG8_WAIT_V(6); PG8_BAR;
    } else {
        PG8_STAGE(PG8_SB(0, 0), cB, voffB); PG8_STAGE(PG8_SA(0, 0), cA, voffA); PG8_STAGE(PG8_SB(0, 1), cB + hstep, voffB); PG8_STAGE(PG8_SA(0, 1), cA + hstep, voffA);
        if (wr == 1) PG8_BAR;
        PG8_WAIT_V(4); PG8_BAR;
        PG8_STAGE(PG8_SB(1, 0), cB + kstep, voffB); PG8_STAGE(PG8_SA(1, 0), cA + kstep, voffA); PG8_STAGE(PG8_SB(1, 1), cB + hstep + kstep, voffB);
        PG8_WAIT_V(6); PG8_BAR;
    }
    for (;;) {
        const bool has_next = S.next(ui + 1, nxt);
        const char* nA = has_next ? (const char*)g.A + (size_t)nxt.pm * tstep : cA; const char* nB = has_next ? (const char*)g.Bt + (size_t)nxt.pn * tstep : cB;
        for (int t = 0; t < nt; t += 2) {
            const bool last = (t == nt - 2);
            const char* a1 = cA + (size_t)(t + 1) * kstep;
            const char* a2 = last ? nA : cA + (size_t)(t + 2) * kstep; const char* b2 = last ? nB : cB + (size_t)(t + 2) * kstep;
            const char* a3 = a2 + kstep; const char* b3 = b2 + kstep;
            if (last && has_next) S.a_ready(nxt);
            if constexpr (SP2) {
            PG8_LDB(B0, 0, 0); PG8_LDB(B1, 0, 1); PG8_SCHED; PG8_LDA(At, 0, 0); PG8_STAGE(PG8_SA(1, 1), a1 + hstep, voffA);
            PG8_WAIT_V(8); PG8_WAIT_L(0); PG8_BAR; PG8_MMA(0, 0, At, B0); PG8_MMA(0, 1, At, B1); PG8_BAR; PG8_SCHED;
            PG8_LDA(At, 0, 1); PG8_STAGE(PG8_SB(0, 0), b2, voffB); PG8_STAGE(PG8_SB(0, 1), b2 + hstep, voffB); PG8_STAGE(PG8_SA(0, 0), a2, voffA);
            PG8_WAIT_V(8); PG8_WAIT_L(0); PG8_BAR; PG8_MMA(1, 0, At, B0); PG8_MMA(1, 1, At, B1); PG8_BAR; PG8_SCHED;
            PG8_LDB(B0, 1, 0); PG8_LDB(B1, 1, 1); PG8_SCHED; PG8_LDA(At, 1, 0); PG8_STAGE(PG8_SA(0, 1), a2 + hstep, voffA);
            PG8_WAIT_V(8); PG8_WAIT_L(0); PG8_BAR; PG8_MMA(0, 0, At, B0); PG8_MMA(0, 1, At, B1); PG8_BAR; PG8_SCHED;
            PG8_LDA(At, 1, 1); PG8_STAGE(PG8_SB(1, 0), b3, voffB); PG8_STAGE(PG8_SB(1, 1), b3 + hstep, voffB); PG8_STAGE(PG8_SA(1, 0), a3, voffA);
            PG8_WAIT_V(8); PG8_WAIT_L(0); PG8_BAR; PG8_MMA(1, 0, At, B0); PG8_MMA(1, 1, At, B1); PG8_BAR; PG8_SCHED;
            } else {
            PG8_LDB(B0, 0, 0); PG8_SCHED; PG8_LDA(At, 0, 0); PG8_STAGE(PG8_SA(1, 1), a1 + hstep, voffA);
            PG8_WAIT_L(8); PG8_BAR; PG8_WAIT_L(0); PG8_MMA(0, 0, At, B0); PG8_BAR; PG8_SCHED;
            PG8_LDB(B1, 0, 1); PG8_STAGE(PG8_SB(0, 0), b2, voffB);
            PG8_BAR; PG8_WAIT_L(0); PG8_MMA(0, 1, At, B1); PG8_BAR;
            PG8_LDA(At, 0, 1); PG8_STAGE(PG8_SA(0, 0), a2, voffA);
            PG8_BAR; PG8_WAIT_L(0); PG8_MMA(1, 0, At, B0); PG8_BAR; PG8_SCHED;
            PG8_STAGE(PG8_SB(0, 1), b2 + hstep, voffB);
            PG8_WAIT_V(6); PG8_BAR; PG8_MMA(1, 1, At, B1); PG8_BAR;
            PG8_LDB(B0, 1, 0); PG8_SCHED; PG8_LDA(At, 1, 0); PG8_STAGE(PG8_SA(0, 1), a2 + hstep, voffA);
            PG8_WAIT_L(8); PG8_BAR; PG8_WAIT_L(0); PG8_MMA(0, 0, At, B0); PG8_BAR; PG8_SCHED;
            PG8_LDB(B1, 1, 1); PG8_STAGE(PG8_SB(1, 0), b3, voffB);
            PG8_BAR; PG8_WAIT_L(0); PG8_MMA(0, 1, At, B1); PG8_BAR;
            PG8_LDA(At, 1, 1); PG8_STAGE(PG8_SA(1, 0), a3, voffA);
            PG8_BAR; PG8_WAIT_L(0); PG8_MMA(1, 0, At, B0); PG8_BAR; PG8_SCHED;
            PG8_STAGE(PG8_SB(1, 1), b3 + hstep, voffB);
            PG8_WAIT_V(6); PG8_BAR; PG8_MMA(1, 1, At, B1); PG8_BAR;
            }
        }
        if constexpr (ALIGN_EPI) { if (wr == 0) PG8_BAR; }
        if constexpr (!Epi::AFTER_DRAIN) { E(acc, cur, wr, wc, fr, fq); S.done(cur); }
        if (!has_next) break;
#pragma unroll
        for (int a = 0; a < 2; ++a)
#pragma unroll
            for (int b = 0; b < 2; ++b)
#pragma unroll
                for (int m = 0; m < 4; ++m)
#pragma unroll
                    for (int n = 0; n < 2; ++n) acc[a][b][m][n] = (f32x4){0.f, 0.f, 0.f, 0.f};
        cur = nxt; cA = nA; cB = nB; ++ui;
        if constexpr (ALIGN_EPI) { if (wr == 1) PG8_BAR; }
    }
    PG8_WAIT_V(0);
    if constexpr (!ALIGN_EPI) { if (wr == 0) PG8_BAR; }
    PG8_BAR;
    if constexpr (Epi::AFTER_DRAIN) { E.fused(acc, cur, wr, wc, fr, fq, lds, wid, lane); S.done(cur); }
#undef PG8_SA
#undef PG8_SB
#undef PG8_STAGE
#undef PG8_LDA
#undef PG8_LDB
#undef PG8_MMA
#undef PG8_WAIT_V
#undef PG8_WAIT_L
#undef PG8_BAR
#undef PG8_SCHED
}
}

constexpr int NWAVES = 8;
constexpr int SEQ = 16384, DM = 2048, NIN = 5664, NINP = 5888, DFF = 5632;
constexpr int DNH = 8, HD = 128, SWH = 8, MEMH = 4, MEMT = 256;
constexpr float RMS_EPS = 1e-6f;
constexpr float LOG2E = 1.4426950408889634f;
constexpr float QSCALE = 0.08838834764831845f * 1.4426950408889634f;

constexpr size_t MiB = 1u << 20;
constexpr size_t WS_CTL = 0, CTL_ZERO_BYTES = 1 * MiB;
constexpr size_t CTL_SUMSQ2 = 256 * 1024, CTL_SUMSQ3 = 320 * 1024, CTL_SUMSQ4 = 384 * 1024;
constexpr size_t WS_RSTD1 = 1 * MiB, WS_RSTDM = 1 * MiB + 64 * 1024;
constexpr size_t WS_MEMB = 2 * MiB, WS_KVM = 3 * MiB, WS_AB = 4 * MiB, WS_BG = 6 * MiB;
constexpr size_t WS_WOUT = 8 * MiB, WS_WQ = 16 * MiB, WS_WKV = 18 * MiB, WS_WO = 22 * MiB, WS_WIN = 24 * MiB;
constexpr size_t WS_XB = 48 * MiB;
constexpr size_t WS_QKV = 112 * MiB;
constexpr size_t WS_H3B = 112 * MiB;
constexpr size_t WS_OF = 112 * MiB, WS_OB = 144 * MiB, WS_H1B = 112 * MiB, WS_QM = 176 * MiB, WS_OM = 192 * MiB;
constexpr size_t WS_DNX = 208 * MiB;
constexpr size_t WS_WGU = 208 * MiB, WS_WD = 252 * MiB, WS_HID = 274 * MiB, WS_END = 496 * MiB;
constexpr size_t DO_Z = 0, DO_QSW = 32 * MiB, DO_KVSW = 64 * MiB;
constexpr int CW_BAR = 4096, CW_SWAQ = 8192;

constexpr int RING_OFF = 0, RING_BYTES = 131072;
constexpr int LDS_BYTES = 163840;
constexpr int LDSCTL_OFF = LDS_BYTES - 512, MISC_OFF = LDSCTL_OFF + 320;

#define GAS __attribute__((address_space(1)))
#define LAS __attribute__((address_space(3)))
typedef unsigned short bf16;
typedef unsigned v4u __attribute__((ext_vector_type(4)));
typedef unsigned v2u __attribute__((ext_vector_type(2)));
typedef float f32x4 __attribute__((ext_vector_type(4)));
typedef short bf16x8 __attribute__((ext_vector_type(8)));
typedef short s16x4 __attribute__((ext_vector_type(4)));
typedef GAS unsigned gu32;
#define RLX_AGENT __ATOMIC_RELAXED, __HIP_MEMORY_SCOPE_AGENT
#define LDS_WAIT() asm volatile("s_waitcnt lgkmcnt(0)" ::: "memory")
#define VM_WAIT() asm volatile("s_waitcnt vmcnt(0)" ::: "memory")
__device__ __forceinline__ unsigned f2bf(float f) { unsigned u = __builtin_bit_cast(unsigned, f); return (u + 0x7fffu + ((u >> 16) & 1u)) >> 16; }
__device__ __forceinline__ unsigned pk2(float lo, float hi) { return f2bf(lo) | (f2bf(hi) << 16); }
__device__ __forceinline__ float bf2f(unsigned short b) { return __builtin_bit_cast(float, (unsigned)b << 16); }
__device__ __forceinline__ float bflo(unsigned w) { return __builtin_bit_cast(float, w << 16); }
__device__ __forceinline__ float bfhi(unsigned w) { return __builtin_bit_cast(float, w & 0xffff0000u); }
typedef float f32x2_t __attribute__((ext_vector_type(2))); typedef __bf16 bf16x2_t __attribute__((ext_vector_type(2)));
__device__ __forceinline__ unsigned cvtpk(float lo, float hi) { f32x2_t v = {lo, hi}; bf16x2_t b = __builtin_convertvector(v, bf16x2_t); return __builtin_bit_cast(unsigned, b); }
__device__ __forceinline__ float wave_sum(float v) {
#pragma unroll
    for (int o = 1; o < 64; o <<= 1) v += __shfl_xor(v, o);
    return v;
}
__device__ __forceinline__ float siluf(float x) { return x * __builtin_amdgcn_rcpf(1.0f + __expf(-x)); }
#define XB_TMO      128
#define XB_XCNT(j)  (256  + 64 * (j))
#define XB_XSUB(j)  (1280 + 64 * (j))
#define XB_XGEN(j)  (2304 + 64 * (j))
#define XB_TOP      3328
#define XB_TOPGEN   3392
#define XCD_BAR_WORDS 3456
#define XB_SPIN_CAP (1u << 18)

__device__ __forceinline__ unsigned xb_ld(unsigned* p)              { return __hip_atomic_load(p, __ATOMIC_RELAXED, __HIP_MEMORY_SCOPE_AGENT); }
__device__ __forceinline__ unsigned xb_add(unsigned* p, unsigned v) { return __hip_atomic_fetch_add(p, v, __ATOMIC_RELAXED, __HIP_MEMORY_SCOPE_AGENT); }
__device__ __forceinline__ unsigned xb_xcc_id() { return (unsigned)__builtin_amdgcn_s_getreg((3 << 11) | 20) & 0xFu; }
#define XB_SPIN(cond, bar) do { unsigned _sp = 0; while (cond) { __builtin_amdgcn_s_sleep(1); \
    if ((++_sp & 255u) == 0u) { if (xb_ld(&(bar)[XB_TMO])) break; if (_sp > XB_SPIN_CAP) { atomicAdd(&(bar)[XB_TMO], 1u); break; } } } } while (0)

struct XcdBarrier {
    unsigned* bar; unsigned x;
    volatile LAS unsigned* st;
};

__device__ __forceinline__ XcdBarrier xcd_barrier_post(unsigned* bar, volatile LAS unsigned* st) {
    XcdBarrier b; b.bar = bar; b.x = xb_xcc_id(); b.st = st;
    if (threadIdx.x == 0) (void)xb_add(&bar[XB_XCNT(b.x)], 1u);
    return b;
}
__device__ __forceinline__ void xcd_barrier_complete(unsigned* bar, unsigned x, unsigned& nloc, unsigned& nx) {
    const unsigned G = gridDim.x * gridDim.y * gridDim.z;
    unsigned sum, cnt, mine, sp = 0u;
    for (;;) {
        sum = 0u; cnt = 0u; mine = 0u;
#pragma unroll
        for (unsigned j = 0; j < 16; ++j) { const unsigned c = xb_ld(&bar[XB_XCNT(j)]); sum += c; cnt += (c > 0u) ? 1u : 0u; mine = (j == x) ? c : mine; }
        if (sum == G) break;
        __builtin_amdgcn_s_sleep(1);
        if ((++sp & 255u) == 0u) { if (xb_ld(&bar[XB_TMO])) break; if (sp > XB_SPIN_CAP) { atomicAdd(&bar[XB_TMO], 1u); break; } }
    }
    nloc = mine > 0u ? mine : 1u; nx = cnt > 0u ? cnt : 1u;
}

__device__ __forceinline__ void xcd_barrier(const XcdBarrier& b) {
    asm volatile("s_waitcnt vmcnt(0)" ::: "memory");
    __syncthreads();
    if (threadIdx.x == 0) {
        unsigned* bar = b.bar;
        __builtin_amdgcn_s_waitcnt(0);
        unsigned nloc = b.st[0], nx = b.st[1];
        if (nloc == 0u) { xcd_barrier_complete(bar, b.x, nloc, nx); b.st[0] = nloc; b.st[1] = nx; }
        const unsigned old = xb_add(&bar[XB_XSUB(b.x)], 1u);
        const unsigned gen = old / nloc;
        if (old + 1u == (gen + 1u) * nloc) {
            __builtin_amdgcn_fence(__ATOMIC_RELEASE, "agent");
            asm volatile("s_waitcnt vmcnt(0)" ::: "memory");
            const unsigned og = xb_add(&bar[XB_TOP], 1u);
            const unsigned tg = og / nx;
            if (og + 1u == (tg + 1u) * nx) xb_add(&bar[XB_TOPGEN], 1u);
            else XB_SPIN(xb_ld(&bar[XB_TOPGEN]) == tg, bar);
            __builtin_amdgcn_fence(__ATOMIC_ACQUIRE, "agent");
            xb_add(&bar[XB_XGEN(b.x)], 1u);
            asm volatile("s_waitcnt vmcnt(0)" ::: "memory");
        } else {
            XB_SPIN(xb_ld(&bar[XB_XGEN(b.x)]) == gen, bar);
            __builtin_amdgcn_fence(__ATOMIC_ACQUIRE, "agent");
            asm volatile("s_waitcnt vmcnt(0)" ::: "memory");
        }
    }
    __syncthreads();
}

using pg8::Unit;
__device__ __forceinline__ v4u pack8(f32x4 v0, f32x4 v1) { v4u w; w.x = cvtpk(v0[0], v0[1]); w.y = cvtpk(v0[2], v0[3]); w.z = cvtpk(v1[0], v1[1]); w.w = cvtpk(v1[2], v1[3]); return w; }

struct EpiProj {
    static constexpr bool PERM = true, AFTER_DRAIN = false;
    const float* rstd; bf16* qkv; bf16* z; bf16* qsw; bf16* kvsw; float* ab;
    __device__ __forceinline__ void operator()(const f32x4 (&acc)[2][2][4][2], const Unit& u, int wr, int wc, int fr, int fq) const {
        const int pn = u.pn; bf16* base; int ldc, colt; float sc = 1.f;
        if (pn < 12) { base = qkv; ldc = 3072; colt = pn * 256; }
        else if (pn < 16) { base = z; ldc = 1024; colt = (pn - 12) * 256; }
        else if (pn < 20) { base = qsw; ldc = 1024; colt = (pn - 16) * 256; sc = QSCALE; }
        else if (pn < 22) { base = kvsw; ldc = 512; colt = (pn - 20) * 256; }
        else { base = nullptr; ldc = 0; colt = 0; }
        const int row0 = u.pm * 256 + wr * 64 + fr, col0 = colt + wc * 32 + 8 * fq;
        float rsv[2][4];
#pragma unroll
        for (int ai = 0; ai < 2; ++ai)
#pragma unroll
            for (int m = 0; m < 4; ++m) rsv[ai][m] = rstd[row0 + ai * 128 + m * 16];
#pragma unroll
        for (int ai = 0; ai < 2; ++ai)
#pragma unroll
            for (int m = 0; m < 4; ++m) {
                const int row = row0 + ai * 128 + m * 16; const float rs = rsv[ai][m] * sc;
                if (base) {
                    bf16* rowp = base + (size_t)row * ldc + col0;
#pragma unroll
                    for (int bj = 0; bj < 2; ++bj) *(v4u*)(rowp + bj * 128) = pack8(acc[ai][bj][m][0] * rs, acc[ai][bj][m][1] * rs);
                } else if (wc == 0) {
                    float* rowp = ab + (size_t)row * 32 + 8 * fq;
                    *(f32x4*)(rowp) = acc[ai][0][m][0] * rs; *(f32x4*)(rowp + 4) = acc[ai][0][m][1] * rs;
                }
            }
    }
};
struct EpiScaleBf16 {
    static constexpr bool PERM = true, AFTER_DRAIN = false;
    const float* rs; int from_sumsq; float sc; bf16* O; int ldc;
    __device__ __forceinline__ void operator()(const f32x4 (&acc)[2][2][4][2], const Unit& u, int wr, int wc, int fr, int fq) const {
        const int row0 = u.pm * 256 + wr * 64 + fr, col0 = u.pn * 256 + wc * 32 + 8 * fq;
        float rsv[2][4];
#pragma unroll
        for (int ai = 0; ai < 2; ++ai)
#pragma unroll
            for (int m = 0; m < 4; ++m) rsv[ai][m] = rs[row0 + ai * 128 + m * 16];
#pragma unroll
        for (int ai = 0; ai < 2; ++ai)
#pragma unroll
            for (int m = 0; m < 4; ++m) {
                const int row = row0 + ai * 128 + m * 16; float r = rsv[ai][m];
                if (from_sumsq) r = __builtin_amdgcn_rsqf(r * (1.0f / DM) + RMS_EPS);
                r *= sc; bf16* rowp = O + (size_t)row * ldc + col0;
#pragma unroll
                for (int bj = 0; bj < 2; ++bj) *(v4u*)(rowp + bj * 128) = pack8(acc[ai][bj][m][0] * r, acc[ai][bj][m][1] * r);
            }
    }
};
struct EpiRes {
    static constexpr bool PERM = true, AFTER_DRAIN = false;
    const float* res; float* out; bf16* ob; float* sumsq;
    __device__ __forceinline__ void operator()(const f32x4 (&acc)[2][2][4][2], const Unit& u, int wr, int wc, int fr, int fq) const {
        const int row0 = u.pm * 256 + wr * 64 + fr, col0 = u.pn * 256 + wc * 32 + 8 * fq;
#pragma unroll
        for (int ai = 0; ai < 2; ++ai) {
            f32x4 rr[4][2][2];
#pragma unroll
            for (int m = 0; m < 4; ++m) { const size_t off = (size_t)(row0 + ai * 128 + m * 16) * DM + col0;
#pragma unroll
                for (int bj = 0; bj < 2; ++bj) { rr[m][bj][0] = *(const f32x4*)(res + off + bj * 128); rr[m][bj][1] = *(const f32x4*)(res + off + bj * 128 + 4); } }
            asm volatile("" ::: "memory");
#pragma unroll
            for (int m = 0; m < 4; ++m) {
                const int row = row0 + ai * 128 + m * 16; const size_t off = (size_t)row * DM + col0; float ss = 0.f;
#pragma unroll
                for (int bj = 0; bj < 2; ++bj) {
                    const f32x4 v0 = acc[ai][bj][m][0] + rr[m][bj][0], v1 = acc[ai][bj][m][1] + rr[m][bj][1];
                    if (out) { *(f32x4*)(out + off + bj * 128) = v0; *(f32x4*)(out + off + bj * 128 + 4) = v1; }
                    if (ob) *(v4u*)(ob + off + bj * 128) = pack8(v0, v1);
                    ss += (v0[0] * v0[0] + v0[1] * v0[1]) + (v0[2] * v0[2] + v0[3] * v0[3]) + (v1[0] * v1[0] + v1[1] * v1[1]) + (v1[2] * v1[2] + v1[3] * v1[3]);
                }
                ss += __shfl_xor(ss, 16); ss += __shfl_xor(ss, 32);
                if (fq == 0) atomicAdd(sumsq + row, ss);
            }
            asm volatile("" ::: "memory");
        }
    }
};
struct EpiSwiglu {
    static constexpr bool PERM = true, AFTER_DRAIN = false;
    const float* sumsq; bf16* H;
    __device__ __forceinline__ void operator()(const f32x4 (&acc)[2][2][4][2], const Unit& u, int wr, int wc, int fr, int fq) const {
        const int row0 = u.pm * 256 + wr * 64 + fr, col0 = u.pn * 128 + wc * 32 + 8 * fq;
        float rsv[2][4];
#pragma unroll
        for (int ai = 0; ai < 2; ++ai)
#pragma unroll
            for (int m = 0; m < 4; ++m) rsv[ai][m] = sumsq[row0 + ai * 128 + m * 16];
#pragma unroll
        for (int ai = 0; ai < 2; ++ai)
#pragma unroll
            for (int m = 0; m < 4; ++m) {
                const int row = row0 + ai * 128 + m * 16; const float r = __builtin_amdgcn_rsqf(rsv[ai][m] * (1.0f / DM) + RMS_EPS);
                f32x4 h[2];
#pragma unroll
                for (int n = 0; n < 2; ++n)
#pragma unroll
                    for (int e = 0; e < 4; ++e) { const float g = acc[ai][0][m][n][e] * r, up = acc[ai][1][m][n][e] * r; h[n][e] = siluf(g) * up; }
                *(v4u*)(H + (size_t)row * DFF + col0) = pack8(h[0], h[1]);
            }
    }
};

struct Frame {
    LAS unsigned char* lds;
    volatile LAS unsigned* MISC;
    gu32* ctl;
    int tid, lane, wave, vcu, G;
    const float* in[23]; float* out; unsigned char* ws;
};
#define WSP(T, off) ((T*)(F.ws + (off)))
#define DOP(T, off) ((T*)((unsigned char*)F.out + (off)))

__device__ __forceinline__ void tr_item(const float* W, int K, int Nsrc, int src_col0, const float* gain, bf16* WT, int dst_row0, int k0, LAS float* scr, int lane) {
    float v[32];
#pragma unroll
    for (int i = 0; i < 32; ++i) { const int kk = 2 * i + (lane >> 5); v[i] = (src_col0 >= 0) ? W[(size_t)(k0 + kk) * Nsrc + src_col0 + (lane & 31)] : 0.f; }
    if (gain) {
#pragma unroll
        for (int i = 0; i < 32; ++i) v[i] *= gain[k0 + 2 * i + (lane >> 5)]; }
#pragma unroll
    for (int i = 0; i < 32; ++i) scr[(2 * i + (lane >> 5)) * 33 + (lane & 31)] = v[i];
    LDS_WAIT(); asm volatile("" ::: "memory");
    const int c = lane & 7;
#pragma unroll
    for (int j = 0; j < 4; ++j) { const int n = (lane >> 3) + 8 * j; const LAS float* s = scr + (8 * c) * 33 + n;
        v4u o; o.x = pk2(s[0 * 33], s[1 * 33]); o.y = pk2(s[2 * 33], s[3 * 33]); o.z = pk2(s[4 * 33], s[5 * 33]); o.w = pk2(s[6 * 33], s[7 * 33]);
        *(GAS v4u*)(WT + (size_t)(dst_row0 + n) * K + k0 + 8 * c) = o; }
    LDS_WAIT(); asm volatile("" ::: "memory");
}
__device__ __forceinline__ int win_src_col(int c) {
    if (c < 4096) return c;
    if (c < 5120) return c - 4096 + 4128;
    if (c < 5376) return c - 5120 + 5152;
    if (c < 5632) return c - 5376 + 5408;
    if (c < 5664) return c - 5632 + 4096;
    return -1;
}
__device__ __forceinline__ void row_to_bf16_rstd(const float* xrow, bf16* orow, float* rstd_out, int lane) {
    const GAS f32x4* xr = (const GAS f32x4*)xrow + lane;
    f32x4 v[8]; float s = 0.f;
#pragma unroll
    for (int j = 0; j < 8; ++j) { v[j] = xr[64 * j]; s += (v[j].x * v[j].x + v[j].y * v[j].y) + (v[j].z * v[j].z + v[j].w * v[j].w); }
    s = wave_sum(s);
    if (lane == 0) *rstd_out = 1.0f / sqrtf(s * (1.0f / DM) + RMS_EPS);
    GAS v2u* o8 = (GAS v2u*)orow + lane;
#pragma unroll
    for (int j = 0; j < 8; ++j) { v2u w; w.x = pk2(v[j].x, v[j].y); w.y = pk2(v[j].z, v[j].w); o8[64 * j] = w; }
}

__device__ __forceinline__ void p0_prologue(Frame& F) {
    LAS float* scr = (LAS float*)(F.lds + RING_OFF + F.wave * 16384);
    const int gw = F.vcu * NWAVES + F.wave, NGW = F.G * NWAVES;
    constexpr int I_IN = 32 * (NINP / 32), I_OUT = 32 * 64, I_Q = 32 * 16, I_KV = 32 * 32, I_O = 8 * 64;
    constexpr int NITEMS = I_IN + I_OUT + I_Q + I_KV + I_O;
    for (int it = gw; it < NITEMS; it += NGW) {
        int r = it;
        if (r < I_IN) { const int nblk = NINP / 32, kb = r / nblk, nb = r % nblk; tr_item(F.in[3], DM, NIN, win_src_col(nb * 32), F.in[2], WSP(bf16, WS_WIN), nb * 32, kb * 64, scr, F.lane); continue; } r -= I_IN;
        if (r < I_OUT) { const int kb = r / 64, nb = r % 64; tr_item(F.in[12], DM, DM, nb * 32, nullptr, WSP(bf16, WS_WOUT), nb * 32, kb * 64, scr, F.lane); continue; } r -= I_OUT;
        if (r < I_Q) { const int kb = r / 16, nb = r % 16; tr_item(F.in[15], DM, 512, nb * 32, F.in[13], WSP(bf16, WS_WQ), nb * 32, kb * 64, scr, F.lane); continue; } r -= I_Q;
        if (r < I_KV) { const int kb = r / 32, nb = r % 32; tr_item(F.in[16], DM, 1024, nb * 32, F.in[14], WSP(bf16, WS_WKV), nb * 32, kb * 64, scr, F.lane); continue; } r -= I_KV;
        { const int kb = r / 64, nb = r % 64; tr_item(F.in[17], 512, DM, nb * 32, nullptr, WSP(bf16, WS_WO), nb * 32, kb * 64, scr, F.lane); }
    }
    for (int m = gw; m < SEQ; m += 2 * NGW) {
        const int m2 = m + NGW; const bool two = m2 < SEQ;
        const GAS f32x4* xa = (const GAS f32x4*)(F.in[0] + (size_t)m * DM) + F.lane; const GAS f32x4* xb_ = (const GAS f32x4*)(F.in[0] + (size_t)(two ? m2 : m) * DM) + F.lane;
        f32x4 va[8], vb[8]; float sa = 0.f, sb = 0.f;
#pragma unroll
        for (int j = 0; j < 8; ++j) { va[j] = xa[64 * j]; vb[j] = xb_[64 * j]; }
#pragma unroll
        for (int j = 0; j < 8; ++j) { sa += (va[j].x * va[j].x + va[j].y * va[j].y) + (va[j].z * va[j].z + va[j].w * va[j].w); sb += (vb[j].x * vb[j].x + vb[j].y * vb[j].y) + (vb[j].z * vb[j].z + vb[j].w * vb[j].w); }
        sa = wave_sum(sa); sb = wave_sum(sb);
        if (F.lane == 0) { WSP(float, WS_RSTD1)[m] = 1.0f / sqrtf(sa * (1.0f / DM) + RMS_EPS); if (two) WSP(float, WS_RSTD1)[m2] = 1.0f / sqrtf(sb * (1.0f / DM) + RMS_EPS); }
        GAS v2u* oa = (GAS v2u*)(WSP(bf16, WS_XB) + (size_t)m * DM) + F.lane; GAS v2u* ob = (GAS v2u*)(WSP(bf16, WS_XB) + (size_t)m2 * DM) + F.lane;
#pragma unroll
        for (int j = 0; j < 8; ++j) { v2u w; w.x = pk2(va[j].x, va[j].y); w.y = pk2(va[j].z, va[j].w); oa[64 * j] = w; }
        if (two) {
#pragma unroll
            for (int j = 0; j < 8; ++j) { v2u w; w.x = pk2(vb[j].x, vb[j].y); w.y = pk2(vb[j].z, vb[j].w); ob[64 * j] = w; } }
    }
    for (int m = gw; m < MEMT; m += NGW) row_to_bf16_rstd(F.in[1] + (size_t)m * DM, WSP(bf16, WS_MEMB) + (size_t)m * DM, WSP(float, WS_RSTDM) + m, F.lane);
}
__device__ __forceinline__ void p4_transposes(Frame& F, int b0, int nb) {
    if ((int)blockIdx.x < b0 || (int)blockIdx.x >= b0 + nb) return;
    LAS float* scr = (LAS float*)(F.lds + RING_OFF + F.wave * 16384);
    const int gw = ((int)blockIdx.x - b0) * NWAVES + F.wave, NGW = nb * NWAVES;
    constexpr int I_GU = 32 * (2 * DFF / 32), I_D = (DFF / 64) * 64;
    for (int it = gw; it < I_GU + I_D; it += NGW) {
        int r = it;
        if (r < I_GU) { const int nblk = 2 * DFF / 32, kb = r / nblk, nb = r % nblk; const int row = nb * 32, t = row / 256, w = row % 256;
            const float* src = (w < 128) ? F.in[19] : F.in[20]; const int sc = 128 * t + (w & 127);
            tr_item(src, DM, DFF, sc, F.in[18], WSP(bf16, WS_WGU), row, kb * 64, scr, F.lane); continue; } r -= I_GU;
        { const int kb = r / 64, nb = r % 64; tr_item(F.in[21], DFF, DM, nb * 32, nullptr, WSP(bf16, WS_WD), nb * 32, kb * 64, scr, F.lane); }
    }
}

__device__ __forceinline__ float softplusf(float x) { return x > 20.f ? x : log1pf(__expf(x)); }
__device__ __forceinline__ void dn_combine(Frame& F) {
    const int gw = F.vcu * NWAVES + F.wave, NGW = F.G * NWAVES, lane = F.lane;
    const bf16* OFp = WSP(bf16, WS_OF); const bf16* OBp = WSP(bf16, WS_OB); const bf16* Z = DOP(bf16, DO_Z); bf16* Y = WSP(bf16, WS_XB); const float* gn = F.in[9];
    const int cb = (16 * lane) & 127; float gv[16];
#pragma unroll
    for (int i = 0; i < 16; ++i) gv[i] = gn[cb + i];
    for (int t0 = gw; t0 < SEQ; t0 += 2 * NGW) {
        v4u a[2][2], b[2][2], z[2][2];
#pragma unroll
        for (int k = 0; k < 2; ++k) { const int t = (t0 + k * NGW < SEQ) ? t0 + k * NGW : t0; const size_t off = (size_t)t * 1024 + 16 * lane;
            a[k][0] = *(const v4u*)(OFp + off); a[k][1] = *(const v4u*)(OFp + off + 8); b[k][0] = *(const v4u*)(OBp + off); b[k][1] = *(const v4u*)(OBp + off + 8);
            z[k][0] = *(const v4u*)(Z + off); z[k][1] = *(const v4u*)(Z + off + 8); }
#pragma unroll
        for (int k = 0; k < 2; ++k) {
            const int t = t0 + k * NGW; if (t >= SEQ) break;
            float o[16], zz[16];
#pragma unroll
            for (int i = 0; i < 4; ++i) { o[2 * i] = bflo(a[k][0][i]) + bflo(b[k][0][i]); o[2 * i + 1] = bfhi(a[k][0][i]) + bfhi(b[k][0][i]); o[8 + 2 * i] = bflo(a[k][1][i]) + bflo(b[k][1][i]); o[8 + 2 * i + 1] = bfhi(a[k][1][i]) + bfhi(b[k][1][i]);
                zz[2 * i] = bflo(z[k][0][i]); zz[2 * i + 1] = bfhi(z[k][0][i]); zz[8 + 2 * i] = bflo(z[k][1][i]); zz[8 + 2 * i + 1] = bfhi(z[k][1][i]); }
            float ss = 0.f;
#pragma unroll
            for (int i = 0; i < 16; ++i) ss += o[i] * o[i];
            ss += __shfl_xor(ss, 1); ss += __shfl_xor(ss, 2); ss += __shfl_xor(ss, 4);
            const float rs = __builtin_amdgcn_rsqf(ss * (1.0f / 128.0f) + RMS_EPS);
            float y[16];
#pragma unroll
            for (int i = 0; i < 16; ++i) y[i] = o[i] * rs * gv[i] * siluf(zz[i]);
            v4u w0, w1;
#pragma unroll
            for (int i = 0; i < 4; ++i) { w0[i] = pk2(y[2 * i], y[2 * i + 1]); w1[i] = pk2(y[8 + 2 * i], y[8 + 2 * i + 1]); }
            bf16* yp = Y + (size_t)t * DM + 16 * lane; *(v4u*)yp = w0; *(v4u*)(yp + 8) = w1;
        }
    }
}
__device__ __forceinline__ void final_norm(Frame& F) {
    const int gw = F.vcu * NWAVES + F.wave, NGW = F.G * NWAVES, lane = F.lane;
    const float* ss = (const float*)(F.ws + WS_CTL + CTL_SUMSQ4); const GAS f32x4* g = (const GAS f32x4*)F.in[22]; const bf16* H3 = WSP(bf16, WS_H3B);
    for (int m0 = gw; m0 < SEQ; m0 += 2 * NGW) {
        v4u w[2][4]; float r[2];
#pragma unroll
        for (int k = 0; k < 2; ++k) { const int m = (m0 + k * NGW < SEQ) ? m0 + k * NGW : m0; const GAS v4u* hp = (const GAS v4u*)(H3 + (size_t)m * DM);
            r[k] = ss[m];
#pragma unroll
            for (int j = 0; j < 4; ++j) w[k][j] = hp[64 * j + lane]; }
#pragma unroll
        for (int k = 0; k < 2; ++k) {
            const int m = m0 + k * NGW; if (m >= SEQ) break;
            const float rr = __builtin_amdgcn_rsqf(r[k] * (1.0f / DM) + RMS_EPS);
            GAS f32x4* o = (GAS f32x4*)(F.out + (size_t)m * DM);
#pragma unroll
            for (int j = 0; j < 4; ++j) { const v4u x = w[k][j]; const int c4 = 2 * (64 * j + lane); const f32x4 g0 = g[c4], g1 = g[c4 + 1];
                o[c4] = (f32x4){bflo(x.x) * rr * g0[0], bfhi(x.x) * rr * g0[1], bflo(x.y) * rr * g0[2], bfhi(x.y) * rr * g0[3]};
                o[c4 + 1] = (f32x4){bflo(x.z) * rr * g1[0], bfhi(x.z) * rr * g1[1], bflo(x.w) * rr * g1[2], bfhi(x.w) * rr * g1[3]}; }
        }
    }
}

__device__ __forceinline__ int t5_bucket(int rel) {
    const int n = rel < 0 ? -rel : rel; int b;
    if (n < 8) b = n; else { int k = (31 - __builtin_clz((unsigned)(n * n))) - 6; b = 8 + k; if (b > 15) b = 15; }
    return (rel > 0 ? 16 : 0) + b;
}
template <int MODE  >
__device__ __forceinline__ void attn_unit(Frame& F, const bf16* Q, int qpitch, const bf16* Kp, const bf16* Vp, int kvpitch, bf16* O, int opitch, int q0, int kt_beg, int kt_end, const LAS float* btab, float sink2) {
    LAS unsigned char* Ks = F.lds + RING_OFF; LAS unsigned char* Vs = Ks + 16384;
    const int lane = F.lane, c = lane & 15, g = lane >> 4, qw0 = q0 + 16 * F.wave, tid = F.tid;
    bf16x8 qf[4];
#pragma unroll
    for (int t = 0; t < 4; ++t) qf[t] = *(const bf16x8*)(Q + (size_t)(qw0 + c) * qpitch + 32 * t + 8 * g);
    f32x4 oacc[8];
#pragma unroll
    for (int i = 0; i < 8; ++i) oacc[i] = (f32x4){0.f, 0.f, 0.f, 0.f};
    float mrun = (MODE == 0) ? sink2 : -1e30f, lsum = (MODE == 0 && g == 0) ? 1.0f : 0.0f;
    v4u kpre[2], vpre[2];
#pragma unroll
    for (int i = 0; i < 2; ++i) { const int ci = tid + 512 * i, key = ci >> 4, ch = ci & 15;
        kpre[i] = *(const v4u*)(Kp + (size_t)(64 * kt_beg + key) * kvpitch + ch * 8); vpre[i] = *(const v4u*)(Vp + (size_t)(64 * kt_beg + key) * kvpitch + ch * 8); }
    for (int kt = kt_beg; kt < kt_end; ++kt) {
        __syncthreads();
#pragma unroll
        for (int i = 0; i < 2; ++i) { const int ci = tid + 512 * i, key = ci >> 4, ch = ci & 15;
            *(LAS v4u*)(Ks + key * 256 + ((ch ^ (key & 15)) << 4)) = kpre[i]; *(LAS v4u*)(Vs + key * 256 + ((ch ^ ((key & 7) << 1)) << 4)) = vpre[i]; }
        if (kt + 1 < kt_end) {
#pragma unroll
            for (int i = 0; i < 2; ++i) { const int ci = tid + 512 * i, key = ci >> 4, ch = ci & 15;
                kpre[i] = *(const v4u*)(Kp + (size_t)(64 * (kt + 1) + key) * kvpitch + ch * 8); vpre[i] = *(const v4u*)(Vp + (size_t)(64 * (kt + 1) + key) * kvpitch + ch * 8); } }
        __syncthreads();
        bool rel_ok = true;
        if (MODE == 0) rel_ok = (64 * kt <= qw0 + 15 + 128) && (64 * kt + 63 >= qw0 - 128);
        if (!rel_ok) continue;
        f32x4 s[4];
#pragma unroll
        for (int mt = 0; mt < 4; ++mt) s[mt] = (f32x4){0.f, 0.f, 0.f, 0.f};
#pragma unroll
        for (int t = 0; t < 4; ++t)
#pragma unroll
            for (int mt = 0; mt < 4; ++mt) { const bf16x8 kf = *(const LAS bf16x8*)(Ks + (16 * mt + c) * 256 + (((4 * t + g) ^ c) << 4));
                s[mt] = __builtin_amdgcn_mfma_f32_16x16x32_bf16(kf, qf[t], s[mt], 0, 0, 0); }
        float tmax = -INFINITY;
#pragma unroll
        for (int mt = 0; mt < 4; ++mt)
#pragma unroll
            for (int r = 0; r < 4; ++r) {
                if (MODE == 0) { const int rel = (64 * kt + 16 * mt + 4 * g + r) - (qw0 + c); const bool ok = (rel >= -128) && (rel <= 128);
                    const int ri = ok ? rel + 128 : 128; const float bv = btab[ri]; s[mt][r] = ok ? s[mt][r] + bv : -INFINITY; }
                tmax = fmaxf(tmax, s[mt][r]); }
        tmax = fmaxf(tmax, __shfl_xor(tmax, 16)); tmax = fmaxf(tmax, __shfl_xor(tmax, 32));
        const float mnew = fmaxf(mrun, tmax), alpha = __builtin_amdgcn_exp2f(mrun - mnew); mrun = mnew; float ps = 0.f;
#pragma unroll
        for (int mt = 0; mt < 4; ++mt)
#pragma unroll
            for (int r = 0; r < 4; ++r) { const float p = __builtin_amdgcn_exp2f(s[mt][r] - mnew); s[mt][r] = p; ps += p; }
        lsum = lsum * alpha + ps;
#pragma unroll
        for (int i = 0; i < 8; ++i) oacc[i] = oacc[i] * alpha;
        bf16x8 pf[2];
#pragma unroll
        for (int t2 = 0; t2 < 2; ++t2) { v4u w; w.x = cvtpk(s[2 * t2][0], s[2 * t2][1]); w.y = cvtpk(s[2 * t2][2], s[2 * t2][3]); w.z = cvtpk(s[2 * t2 + 1][0], s[2 * t2 + 1][1]); w.w = cvtpk(s[2 * t2 + 1][2], s[2 * t2 + 1][3]);
            pf[t2] = __builtin_bit_cast(bf16x8, w); }
        const int q4 = c >> 2, p4 = c & 3;
#pragma unroll
        for (int t2 = 0; t2 < 2; ++t2)
#pragma unroll
            for (int mo = 0; mo < 8; ++mo) {
                const int k1 = 32 * t2 + 4 * g + q4, k2 = k1 + 16, chn = 2 * mo + (p4 >> 1);
                const s16x4 lo = __builtin_bit_cast(s16x4, __builtin_amdgcn_ds_read_tr16_b64_v4i16((LAS s16x4*)(Vs + k1 * 256 + ((chn ^ ((k1 & 7) << 1)) << 4) + (p4 & 1) * 8)));
                const s16x4 hi = __builtin_bit_cast(s16x4, __builtin_amdgcn_ds_read_tr16_b64_v4i16((LAS s16x4*)(Vs + k2 * 256 + ((chn ^ ((k2 & 7) << 1)) << 4) + (p4 & 1) * 8)));
                const bf16x8 vf = (bf16x8){lo[0], lo[1], lo[2], lo[3], hi[0], hi[1], hi[2], hi[3]};
                oacc[mo] = __builtin_amdgcn_mfma_f32_16x16x32_bf16(vf, pf[t2], oacc[mo], 0, 0, 0); }
    }
    lsum += __shfl_xor(lsum, 16); lsum += __shfl_xor(lsum, 32);
    const float inv = 1.0f / lsum;
#pragma unroll
    for (int mo = 0; mo < 8; ++mo) { v2u w; w.x = cvtpk(oacc[mo][0] * inv, oacc[mo][1] * inv); w.y = cvtpk(oacc[mo][2] * inv, oacc[mo][3] * inv);
        *(v2u*)(O + (size_t)(qw0 + c) * opitch + 16 * mo + 4 * g) = w; }
}
__device__ __forceinline__ void swa_phase(Frame& F, int b0, int nb) {
    LAS float* btab = (LAS float*)(F.lds + RING_OFF + 32768);
    const bf16* QS = DOP(bf16, DO_QSW); const bf16* KV = DOP(bf16, DO_KVSW); bf16* Y = WSP(bf16, WS_XB);
    (void)b0; (void)nb;
    unsigned* qctr = (unsigned*)(F.ctl + CW_SWAQ);
    for (;;) {
        __syncthreads();
        if (F.tid == 0) F.MISC[12] = __hip_atomic_fetch_add(qctr, 1u, __ATOMIC_RELAXED, __HIP_MEMORY_SCOPE_AGENT);
        __syncthreads();
        const int u = (int)F.MISC[12];
        if (u >= SWH * (SEQ / 128)) break;
        const int h = u & 7, qb = u >> 3, kvh = h >> 2;
        __syncthreads();
        if (F.tid < 257) btab[F.tid] = F.in[11][t5_bucket(F.tid - 128) * 8 + h] * LOG2E;
        __syncthreads();
        int kb = 2 * qb - 2, ke = 2 * qb + 4; if (kb < 0) kb = 0; if (ke > SEQ / 64) ke = SEQ / 64;
        attn_unit<0>(F, QS + h * 128, 1024, KV + kvh * 128, KV + 256 + kvh * 128, 512, Y + 1024 + h * 128, DM, qb * 128, kb, ke, btab, F.in[10][h] * LOG2E);
    }
}
__device__ __forceinline__ void mem_attn_phase(Frame& F) {
    const bf16* QM = WSP(bf16, WS_QM); const bf16* KVm = WSP(bf16, WS_KVM); bf16* OM = WSP(bf16, WS_OM);
    for (int u = blockIdx.x; u < MEMH * (SEQ / 128); u += F.G) {
        const int h = u & 3, qb = u >> 2;
        attn_unit<1>(F, QM + h * 128, 512, KVm + h * 128, KVm + 512 + h * 128, 1024, OM + h * 128, 512, qb * 128, 0, 4, nullptr, 0.f);
    }
}

typedef float f32x16 __attribute__((ext_vector_type(16)));
constexpr int DX_W = 0, DX_K = 16384, DX_U = 32768, DX_Q = 49152, DX_A = 65536, DX_BYTES = 73728;
constexpr size_t WS_GL = 1 * MiB + 128 * 1024;
constexpr int L_RAW = 0, RAW_PITCH = 784, L_MTF = 0, L_MTB = 16384, L_TB = 32768, TB_PITCH = 144, TB_SZ = 9216;
constexpr int L_QB = 69632, L_KB = 86016, L_KT = 102400, L_VT = 120832, L_PART = 139264, L_SC = 143360;
constexpr int L_CW = 145408;
static_assert(L_SC + 2048 <= L_CW && L_CW + 7680 <= LDSCTL_OFF, "prep LDS map");
__device__ __forceinline__ unsigned char* dnx_rec(Frame& F, int dir, int hd, int cn) { return F.ws + WS_DNX + (size_t)((dir * 8 + hd) * 256 + cn) * DX_BYTES; }
__device__ __forceinline__ v4u pack8f(const float* v) { v4u w; w.x = cvtpk(v[0], v[1]); w.y = cvtpk(v[2], v[3]); w.z = cvtpk(v[4], v[5]); w.w = cvtpk(v[6], v[7]); return w; }

__device__ __forceinline__ bf16x8 cvt8(const f32x16& v, int o) { v4u w; w.x = cvtpk(v[o], v[o + 1]); w.y = cvtpk(v[o + 2], v[o + 3]); w.z = cvtpk(v[o + 4], v[o + 5]); w.w = cvtpk(v[o + 6], v[o + 7]); return __builtin_bit_cast(bf16x8, w); }
__device__ __forceinline__ bf16x8 cvt8f(f32x4 a, f32x4 b) { v4u w; w.x = cvtpk(a[0], a[1]); w.y = cvtpk(a[2], a[3]); w.z = cvtpk(b[0], b[1]); w.w = cvtpk(b[2], b[3]); return __builtin_bit_cast(bf16x8, w); }
template <int dir> __device__ __forceinline__ void dn_solve_and_write(LAS unsigned char* lds, int lane) {
    const LAS float* MT = (const LAS float*)(lds + (dir ? L_MTB : L_MTF));
    LAS float* T0 = (LAS float*)(lds + L_TB + dir * 2 * TB_SZ);
    LAS float* Trow = T0 + lane * 68;
    const int blk = lane >> 5, cb = 32 * blk;
#pragma unroll 1
    for (int jr = 7; jr >= 0; --jr) {
        const int j0 = cb + 4 * jr;
        float a0 = (lane == j0) ? 1.f : 0.f, a1 = (lane == j0 + 1) ? 1.f : 0.f, a2 = (lane == j0 + 2) ? 1.f : 0.f, a3 = (lane == j0 + 3) ? 1.f : 0.f;
        const LAS float* mr = MT + j0 * 64;
#pragma unroll 1
        for (int sr = jr + 1; sr < 8; ++sr) {
            const int s0 = cb + 4 * sr;
            const f32x4 tv = *(const LAS f32x4*)(Trow + s0);
            const f32x4 m0 = *(const LAS f32x4*)(mr + s0), m1 = *(const LAS f32x4*)(mr + 64 + s0), m2 = *(const LAS f32x4*)(mr + 128 + s0), m3 = *(const LAS f32x4*)(mr + 192 + s0);
            a0 -= (tv[0] * m0[0] + tv[1] * m0[1]) + (tv[2] * m0[2] + tv[3] * m0[3]);
            a1 -= (tv[0] * m1[0] + tv[1] * m1[1]) + (tv[2] * m1[2] + tv[3] * m1[3]);
            a2 -= (tv[0] * m2[0] + tv[1] * m2[1]) + (tv[2] * m2[2] + tv[3] * m2[3]);
            a3 -= (tv[0] * m3[0] + tv[1] * m3[1]) + (tv[2] * m3[2] + tv[3] * m3[3]);
        }
        const f32x4 d0 = *(const LAS f32x4*)(mr + j0), d1 = *(const LAS f32x4*)(mr + 64 + j0), d2 = *(const LAS f32x4*)(mr + 128 + j0);
        const float t3 = a3, t2 = a2 - t3 * d2[3], t1 = a1 - t2 * d1[2] - t3 * d1[3], t0 = a0 - t1 * d0[1] - t2 * d0[2] - t3 * d0[3];
        *(LAS f32x4*)(Trow + j0) = (f32x4){t0, t1, t2, t3};
    }
    if (blk == 0) {
#pragma unroll
        for (int q = 8; q < 16; ++q) *(LAS f32x4*)(Trow + 4 * q) = (f32x4){0.f, 0.f, 0.f, 0.f}; }
    asm volatile("s_waitcnt lgkmcnt(0)" ::: "memory");
    {
        const int r = lane & 31, lh = lane >> 5;
        f32x16 Y;
#pragma unroll
        for (int e = 0; e < 16; ++e) Y[e] = 0.f;
#pragma unroll
        for (int kk = 0; kk < 2; ++kk) {
            float av[8], bv[8];
#pragma unroll
            for (int jj = 0; jj < 8; ++jj) { const int k = 16 * kk + 8 * lh + jj; av[jj] = MT[k * 64 + 32 + r]; bv[jj] = T0[k * 68 + r]; }
            Y = __builtin_amdgcn_mfma_f32_32x32x16_bf16(cvt8f((f32x4){av[0], av[1], av[2], av[3]}, (f32x4){av[4], av[5], av[6], av[7]}), cvt8f((f32x4){bv[0], bv[1], bv[2], bv[3]}, (f32x4){bv[4], bv[5], bv[6], bv[7]}), Y, 0, 0, 0);
        }
        f32x16 Z;
#pragma unroll
        for (int e = 0; e < 16; ++e) Z[e] = 0.f;
#pragma unroll
        for (int kk = 0; kk < 2; ++kk) {
            const f32x4 t0 = *(const LAS f32x4*)(T0 + (32 + r) * 68 + 32 + 16 * kk + 4 * lh), t1 = *(const LAS f32x4*)(T0 + (32 + r) * 68 + 32 + 16 * kk + 8 + 4 * lh);
            Z = __builtin_amdgcn_mfma_f32_32x32x16_bf16(cvt8f(t0, t1), cvt8(Y, 8 * kk), Z, 0, 0, 0);
        }
#pragma unroll
        for (int e = 0; e < 16; ++e) T0[(32 + (e & 3) + 8 * (e >> 2) + 4 * lh) * 68 + r] = -Z[e];
    }
    asm volatile("s_waitcnt lgkmcnt(0)" ::: "memory");
    f32x4 tr[16];
#pragma unroll
    for (int q = 0; q < 16; ++q) tr[q] = *(const LAS f32x4*)(Trow + 4 * q);
    asm volatile("s_waitcnt lgkmcnt(0)" ::: "memory");
    const LAS float* sc = (const LAS float*)(lds + L_SC);
    const LAS float* cU = sc + (dir ? 384 : 256); const LAS float* cW = sc + (dir ? 448 : 320);
    const int pos = dir ? 63 - lane : lane;
    LAS unsigned char* tu = lds + L_TB + dir * 2 * TB_SZ + pos * TB_PITCH; LAS unsigned char* tw = tu + TB_SZ;
#pragma unroll
    for (int q = 0; q < 8; ++q) {
        float u8[8], w8[8];
#pragma unroll
        for (int e = 0; e < 8; ++e) { const int s = 8 * q + e, sp = dir ? 63 - s : s; const float t = tr[sp >> 2][sp & 3]; u8[e] = t * cU[s]; w8[e] = t * cW[s]; }
        *(LAS v4u*)(tu + q * 16) = pack8f(u8); *(LAS v4u*)(tw + q * 16) = pack8f(w8);
    }
}

struct PrepRegs { v4u raw[7]; };
__device__ __forceinline__ void prep_load(Frame& F, int u, int tid, int lane, PrepRegs& R) {
    const int cn = u >> 3, hd = u & 7; const bf16* QKV = WSP(bf16, WS_QKV);
#pragma unroll
    for (int k = 0; k < 7; ++k) { const int ci = tid + 512 * k; const int row = ci / 48, cc = ci % 48, seg = cc >> 4, ch = (cc & 15) * 8, tok = 64 * cn - 2 + row;
        v4u v = (v4u){0u, 0u, 0u, 0u};
        if (ci < 68 * 48 && tok >= 0 && tok < SEQ) v = *(const v4u*)(QKV + (size_t)tok * 3072 + seg * 1024 + hd * 128 + ch);
        R.raw[k] = v; }
}
#define DNX_ST(ptr, val) do { const v4u v_ = (val); if (MASK & 32) *(v4u*)(ptr) = v_; else asm volatile("" :: "v"(v_)); } while (0)
template <int MASK> __device__ __forceinline__ void dn_prep_unit(Frame& F, int cn, int hd, PrepRegs& PR, int next_u) {
    LAS unsigned char* lds = F.lds; int tid = F.tid, lane = F.lane; const int wave = F.wave;
    asm volatile("" : "+v"(tid), "+v"(lane));
    LAS float* sc = (LAS float*)(lds + L_SC);
    __syncthreads();
    if (MASK & 1) {
    float abv[4] = {0.f, 0.f, 0.f, 0.f};
    if (wave == 0) { const float* ab = WSP(float, WS_AB) + (size_t)(64 * cn + lane) * 32; abv[0] = ab[hd]; abv[1] = ab[8 + hd]; abv[2] = ab[16 + hd]; abv[3] = ab[24 + hd]; }
    prep_load(F, cn * 8 + hd, tid, lane, PR);
#pragma unroll
    for (int k = 0; k < 7; ++k) { const int ci = tid + 512 * k; const int row = ci / 48, cc = ci % 48, seg = cc >> 4, ch = (cc & 15) * 8;
        if (ci < 68 * 48) *(LAS v4u*)(lds + L_RAW + row * RAW_PITCH + (seg * 128 + ch) * 2) = PR.raw[k]; }
    if (wave == 0) {
        const float bfv = 1.0f / (1.0f + __expf(-abv[0])), bbv = 1.0f / (1.0f + __expf(-abv[1]));
        const float gf = -__expf(F.in[5][hd]) * softplusf(abv[2] + F.in[7][hd]), gb = -__expf(F.in[6][hd]) * softplusf(abv[3] + F.in[8][hd]);
        float Gf = gf, Gb = gb;
#pragma unroll
        for (int o = 1; o < 64; o <<= 1) { const float a = __shfl_up(Gf, o), b = __shfl_down(Gb, o); if (lane >= o) Gf += a; if (lane + o < 64) Gb += b; }
        sc[lane] = Gf; sc[64 + lane] = Gb; sc[128 + lane] = bfv; sc[192 + lane] = bbv;
        sc[256 + lane] = bfv; sc[320 + lane] = -bfv * __expf(Gf); sc[384 + lane] = bbv; sc[448 + lane] = -bbv * __expf(Gb);
        float* GL = WSP(float, WS_GL);
        if (MASK & 32) { if (lane == 63) GL[(0 * 8 + hd) * 256 + cn] = __expf(Gf);
        if (lane == 0) GL[(1 * 8 + hd) * 256 + cn] = __expf(Gb); }
    }
    }
    __syncthreads();
    asm volatile("" : "+v"(tid), "+v"(lane));
    if (MASK & 2) {
        const int t = wave, pos = lane; const LAS float* cw = (const LAS float*)(lds + L_CW) + 16 * t;
        float qv[16], kv[16], vv[16];
#pragma unroll
        for (int seg = 0; seg < 3; ++seg) {
            float a[16];
#pragma unroll
            for (int i = 0; i < 16; ++i) a[i] = 0.f;
#pragma unroll
            for (int j = 0; j < 5; ++j) {
                const LAS unsigned char* rp = lds + L_RAW + (pos + j) * RAW_PITCH + (seg * 128 + 16 * t) * 2;
                const v4u r0 = *(const LAS v4u*)rp, r1 = *(const LAS v4u*)(rp + 16);
                const LAS float* w = cw + j * 384 + seg * 128;
#pragma unroll
                for (int i = 0; i < 4; ++i) { a[2 * i] += w[2 * i] * bflo(r0[i]); a[2 * i + 1] += w[2 * i + 1] * bfhi(r0[i]); a[8 + 2 * i] += w[8 + 2 * i] * bflo(r1[i]); a[8 + 2 * i + 1] += w[8 + 2 * i + 1] * bfhi(r1[i]); }
            }
#pragma unroll
            for (int i = 0; i < 16; ++i) { const float s = siluf(a[i]); if (seg == 0) qv[i] = s; else if (seg == 1) kv[i] = s; else vv[i] = s; }
        }
        float sq = 0.f, sk = 0.f;
#pragma unroll
        for (int i = 0; i < 16; ++i) { sq += qv[i] * qv[i]; sk += kv[i] * kv[i]; }
        LAS float* part = (LAS float*)(lds + L_PART);
        part[t * 64 + pos] = sq; part[512 + t * 64 + pos] = sk;
        __syncthreads();
        float tq = 0.f, tk = 0.f;
#pragma unroll
        for (int i = 0; i < 8; ++i) { tq += part[i * 64 + pos]; tk += part[512 + i * 64 + pos]; }
        const float rq = (1.0f / sqrtf(tq + 1e-6f)) * 0.08838834764831845f, rk = 1.0f / sqrtf(tk + 1e-6f);
#pragma unroll
        for (int i = 0; i < 16; ++i) { qv[i] *= rq; kv[i] *= rk; }
        *(LAS v4u*)(lds + L_QB + pos * 256 + (((2 * t) ^ (pos & 15)) << 4)) = pack8f(qv); *(LAS v4u*)(lds + L_QB + pos * 256 + (((2 * t + 1) ^ (pos & 15)) << 4)) = pack8f(qv + 8);
        *(LAS v4u*)(lds + L_KB + pos * 256 + (((2 * t) ^ (pos & 15)) << 4)) = pack8f(kv); *(LAS v4u*)(lds + L_KB + pos * 256 + (((2 * t + 1) ^ (pos & 15)) << 4)) = pack8f(kv + 8);
#pragma unroll
        for (int i = 0; i < 16; ++i) { *(LAS unsigned short*)(lds + L_KT + (16 * t + i) * TB_PITCH + pos * 2) = (unsigned short)f2bf(kv[i]); *(LAS unsigned short*)(lds + L_VT + (16 * t + i) * TB_PITCH + pos * 2) = (unsigned short)f2bf(vv[i]); }
        const float ef = __expf(sc[pos]), eb = __expf(sc[64 + pos]); const int mt = pos >> 5;
#pragma unroll
        for (int dir = 0; dir < 2; ++dir) { const float e = dir ? eb : ef; unsigned char* rec = dnx_rec(F, dir, hd, cn) + DX_Q;
#pragma unroll
            for (int lh = 0; lh < 2; ++lh) { float o8[8];
#pragma unroll
                for (int j = 0; j < 8; ++j) o8[j] = qv[8 * (j >> 2) + 4 * lh + (j & 3)] * e;
                DNX_ST(rec + ((mt * 8 + t) * 64 + 32 * lh + (pos & 31)) * 16, pack8f(o8)); } }
    }
    __syncthreads();
    asm volatile("" : "+v"(tid), "+v"(lane));
    if (MASK & 4) {
        const int r = lane & 31, lh = lane >> 5, x = wave & 3, ta = x >> 1, tb = x & 1;
        const LAS unsigned char* Ab = lds + L_KB + (32 * ta + r) * 256; const LAS unsigned char* Bb = lds + (wave < 4 ? L_KB : L_QB) + (32 * tb + r) * 256;
        f32x16 acc;
#pragma unroll
        for (int i = 0; i < 16; ++i) acc[i] = 0.f;
#pragma unroll
        for (int kk = 0; kk < 8; ++kk) { const int ch = ((2 * kk + lh) ^ (r & 15)) << 4;
            acc = __builtin_amdgcn_mfma_f32_32x32x16_bf16(*(const LAS bf16x8*)(Ab + ch), *(const LAS bf16x8*)(Bb + ch), acc, 0, 0, 0); }
        const int b = 32 * tb + r;
        if (wave < 4) {
            const float Gfb = sc[b], Gbb = sc[64 + b];
#pragma unroll
            for (int q = 0; q < 4; ++q) { const int a0 = 32 * ta + 8 * q + 4 * lh; f32x4 mf, mb;
#pragma unroll
                for (int e = 0; e < 4; ++e) { const int a = a0 + e; const float kkv = acc[4 * q + e];
                    const float vf = sc[128 + a] * kkv * __expf(fminf(sc[a] - Gfb, 0.f)), vb = sc[192 + a] * kkv * __expf(fminf(sc[64 + a] - Gbb, 0.f));
                    mf[e] = (a > b) ? vf : 0.f; mb[3 - e] = (a < b) ? vb : 0.f; }
                *(LAS f32x4*)(lds + L_MTF + (b * 64 + a0) * 4) = mf; *(LAS f32x4*)(lds + L_MTB + ((63 - b) * 64 + 60 - a0) * 4) = mb; }
        } else {
            const float Gfc = sc[b], Gbc = sc[64 + b];
#pragma unroll
            for (int dir = 0; dir < 2; ++dir) { unsigned char* rec = dnx_rec(F, dir, hd, cn) + DX_A;
#pragma unroll
                for (int s2 = 0; s2 < 2; ++s2) { float o8[8];
#pragma unroll
                    for (int j = 0; j < 8; ++j) { const int s = 32 * ta + 16 * s2 + 8 * (j >> 2) + 4 * lh + (j & 3); const float v = acc[8 * s2 + j];
                        const float ev = v * __expf(fminf(dir ? Gbc - sc[64 + s] : Gfc - sc[s], 0.f)); o8[j] = (dir ? (s >= b) : (s <= b)) ? ev : 0.f; }
                    DNX_ST(rec + ((tb * 4 + 2 * ta + s2) * 64 + lane) * 16, pack8f(o8)); } }
        }
    }
    __syncthreads();
    asm volatile("" : "+v"(tid), "+v"(lane));
    if (!(MASK & 8)) {} else if (wave == 0) dn_solve_and_write<0>(lds, lane);
    else if (wave == 1) dn_solve_and_write<1>(lds, lane);
    else {
        const int r = lane & 31, lh = lane >> 5;
        for (int f = wave - 2; f < 32; f += 6) { const int dir = f >> 4, m = (f >> 2) & 3, t = f & 3; const int dk = 32 * m + r;
            const v2u k0 = *(const LAS v2u*)(lds + L_KT + dk * TB_PITCH + (16 * t + 4 * lh) * 2), k1 = *(const LAS v2u*)(lds + L_KT + dk * TB_PITCH + (16 * t + 8 + 4 * lh) * 2);
            const float Gl = dir ? sc[64] : sc[63]; const LAS float* Gs = sc + (dir ? 64 : 0) + 16 * t + 4 * lh; float o8[8];
            o8[0] = bflo(k0.x) * __expf(Gl - Gs[0]); o8[1] = bfhi(k0.x) * __expf(Gl - Gs[1]); o8[2] = bflo(k0.y) * __expf(Gl - Gs[2]); o8[3] = bfhi(k0.y) * __expf(Gl - Gs[3]);
            o8[4] = bflo(k1.x) * __expf(Gl - Gs[8]); o8[5] = bfhi(k1.x) * __expf(Gl - Gs[9]); o8[6] = bflo(k1.y) * __expf(Gl - Gs[10]); o8[7] = bfhi(k1.y) * __expf(Gl - Gs[11]);
            DNX_ST(dnx_rec(F, dir, hd, cn) + DX_K + ((m * 4 + t) * 64 + lane) * 16, pack8f(o8)); }
    }
    __syncthreads();
    asm volatile("" : "+v"(tid), "+v"(lane));
    if (MASK & 16) {
        const int dir = wave >> 2, x = wave & 3, r = lane & 31, lh = lane >> 5;
        const LAS unsigned char* Tu = lds + L_TB + (dir ? 2 : 0) * TB_SZ; const LAS unsigned char* Tw = Tu + TB_SZ;
        unsigned char* rec = dnx_rec(F, dir, hd, cn);
#pragma unroll
        for (int mt = 0; mt < 2; ++mt) {
            f32x16 aw, au;
#pragma unroll
            for (int i = 0; i < 16; ++i) { aw[i] = 0.f; au[i] = 0.f; }
#pragma unroll
            for (int kk = 0; kk < 4; ++kk) { const int so = (16 * kk + 8 * lh) * 2;
                aw = __builtin_amdgcn_mfma_f32_32x32x16_bf16(*(const LAS bf16x8*)(lds + L_KT + (32 * x + r) * TB_PITCH + so), *(const LAS bf16x8*)(Tw + (32 * mt + r) * TB_PITCH + so), aw, 0, 0, 0);
                au = __builtin_amdgcn_mfma_f32_32x32x16_bf16(*(const LAS bf16x8*)(Tu + (32 * mt + r) * TB_PITCH + so), *(const LAS bf16x8*)(lds + L_VT + (32 * x + r) * TB_PITCH + so), au, 0, 0, 0); }
            float tmp[16];
#pragma unroll
            for (int i = 0; i < 16; ++i) tmp[i] = aw[i];
            DNX_ST(rec + DX_W + ((mt * 8 + 2 * x) * 64 + lane) * 16, pack8f(tmp)); DNX_ST(rec + DX_W + ((mt * 8 + 2 * x + 1) * 64 + lane) * 16, pack8f(tmp + 8));
#pragma unroll
            for (int i = 0; i < 16; ++i) tmp[i] = au[i];
            DNX_ST(rec + DX_U + ((x * 2 + mt) * 64 + lane) * 32, pack8f(tmp)); DNX_ST(rec + DX_U + ((x * 2 + mt) * 64 + lane) * 32 + 16, pack8f(tmp + 8));
        }
    }
}
#undef DNX_ST
template <int MASK> __device__ __forceinline__ void dn_prep_phase(Frame& F) {
    PrepRegs PR; int u = blockIdx.x; int cur_hd = -1;
    for (; u < 256 * DNH; u += F.G) {
        const int hd = u & 7;
        if (hd != cur_hd) {
            __syncthreads();
            for (int i = F.tid; i < 5 * 384; i += NWAVES * 64) { const int j = i / 384, c = i % 384; ((LAS float*)(F.lds + L_CW))[i] = F.in[4][j * 3072 + (c >> 7) * 1024 + hd * 128 + (c & 127)]; }
            cur_hd = hd;
        }
        dn_prep_unit<MASK>(F, u >> 3, hd, PR, u + F.G);
    }
}


constexpr int NSEG = 16, SEGL = 16;
constexpr size_t WS_PF = 176 * MiB, WS_RG = 184 * MiB, WS_SIN = 24 * MiB;
constexpr int SLOT1 = 49152, SLOT3 = 73728, L_GLS = 147456;
#define DN_WAIT(V) asm volatile("s_waitcnt vmcnt(" #V ") lgkmcnt(0)" ::: "memory")
#define DN_BAR() do { __builtin_amdgcn_s_barrier(); asm volatile("" ::: "memory"); } while (0)
__device__ __forceinline__ int seg_chunk(int dir, int g, int i) { const int n = SEGL * g + i; return dir ? 255 - n : n; }
__device__ __forceinline__ void u_to_acc(f32x16& a, const LAS unsigned char* up) {
    const v4u u0 = *(const LAS v4u*)up, u1 = *(const LAS v4u*)(up + 16);
#pragma unroll
    for (int i = 0; i < 4; ++i) { a[2 * i] = bflo(u0[i]); a[2 * i + 1] = bfhi(u0[i]); a[8 + 2 * i] = bflo(u1[i]); a[8 + 2 * i + 1] = bfhi(u1[i]); }
}
template <bool OUT>
__device__ __forceinline__ void dn_step(f32x16 (&S)[4], f32x16 (&aV)[2], f32x16 (&aO)[2], const LAS unsigned char* buf, float gl) {
#pragma unroll
    for (int t = 0; t < 8; ++t) { const bf16x8 sb = cvt8(S[t >> 1], 8 * (t & 1));
#pragma unroll
        for (int mt = 0; mt < 2; ++mt) {
            aV[mt] = __builtin_amdgcn_mfma_f32_32x32x16_bf16(*(const LAS bf16x8*)(buf + DX_W + (mt * 8 + t) * 1024), sb, aV[mt], 0, 0, 0);
            if (OUT) aO[mt] = __builtin_amdgcn_mfma_f32_32x32x16_bf16(*(const LAS bf16x8*)(buf + DX_Q + (mt * 8 + t) * 1024), sb, aO[mt], 0, 0, 0); } }
    bf16x8 vb[4];
#pragma unroll
    for (int t = 0; t < 4; ++t) vb[t] = cvt8(aV[t >> 1], 8 * (t & 1));
#pragma unroll
    for (int m = 0; m < 4; ++m) S[m] = S[m] * gl;
#pragma unroll
    for (int t = 0; t < 4; ++t) {
#pragma unroll
        for (int m = 0; m < 4; ++m) S[m] = __builtin_amdgcn_mfma_f32_32x32x16_bf16(*(const LAS bf16x8*)(buf + DX_K + (m * 4 + t) * 1024), vb[t], S[m], 0, 0, 0);
        if (OUT) {
#pragma unroll
            for (int mt = 0; mt < 2; ++mt) aO[mt] = __builtin_amdgcn_mfma_f32_32x32x16_bf16(*(const LAS bf16x8*)(buf + DX_A + (mt * 4 + t) * 1024), vb[t], aO[mt], 0, 0, 0); } }
}

__device__ __forceinline__ void dn_pass1(Frame& F) {
    LAS unsigned char* lds = F.lds; const int lane = F.lane, wave = F.wave, r = lane & 31, lh = lane >> 5, part = wave >> 2, d = wave & 3;
    LAS float* gls = (LAS float*)(lds + L_GLS);
    for (int unit = blockIdx.x; unit < 16 * NSEG; unit += F.G) {
        const int dir = unit >> 7, hd = (unit >> 4) & 7, g = unit & 15;
        DN_WAIT(0); __syncthreads();
        if (F.tid < SEGL) gls[F.tid] = WSP(float, WS_GL)[(dir * 8 + hd) * 256 + seg_chunk(dir, g, F.tid)];
        DN_WAIT(0);
        f32x16 S[4];
#pragma unroll
        for (int m = 0; m < 4; ++m)
#pragma unroll
            for (int i = 0; i < 16; ++i) S[m][i] = (part && (32 * m + (i & 3) + 8 * (i >> 2) + 4 * lh == 32 * d + r)) ? 1.f : 0.f;
#define P1_ISSUE(i) do { const unsigned char* src_ = dnx_rec(F, dir, hd, seg_chunk(dir, g, (i))) + lane * 16; LAS unsigned char* dst_ = lds + ((i) % 3) * SLOT1; \
            _Pragma("unroll") for (int k_ = 0; k_ < 6; ++k_) { const int p_ = wave + 8 * k_; __builtin_amdgcn_global_load_lds((const unsigned*)(src_ + p_ * 1024), (LAS unsigned*)(dst_ + p_ * 1024), 16, 0, 0); } } while (0)
        P1_ISSUE(0); P1_ISSUE(1);
        for (int i = 0; i < SEGL; ++i) {
            if (i + 1 < SEGL) DN_WAIT(6); else DN_WAIT(0);
            DN_BAR();
            if (i + 2 < SEGL) P1_ISSUE(i + 2);
            const LAS unsigned char* buf = lds + (i % 3) * SLOT1 + lane * 16;
            f32x16 aV[2], aO[2];
#pragma unroll
            for (int mt = 0; mt < 2; ++mt) {
                if (part == 0) u_to_acc(aV[mt], lds + (i % 3) * SLOT1 + DX_U + ((d * 2 + mt) * 64 + lane) * 32);
                else {
#pragma unroll
                    for (int e = 0; e < 16; ++e) aV[mt][e] = 0.f; } }
            dn_step<false>(S, aV, aO, buf, gls[i]);
        }
#undef P1_ISSUE
        DN_WAIT(0); DN_BAR();
        if (part == 0) {
            float* rg = (float*)(F.ws + WS_RG) + (size_t)unit * 16384;
#pragma unroll
            for (int m = 0; m < 4; ++m)
#pragma unroll
                for (int q = 0; q < 4; ++q) *(f32x4*)(rg + ((d * 4 + m) * 64 + lane) * 16 + 4 * q) = (f32x4){S[m][4 * q], S[m][4 * q + 1], S[m][4 * q + 2], S[m][4 * q + 3]};
        } else {
#pragma unroll
            for (int m = 0; m < 4; ++m)
#pragma unroll
                for (int i = 0; i < 16; ++i) *(LAS unsigned short*)(lds + (32 * m + (i & 3) + 8 * (i >> 2) + 4 * lh) * 272 + (32 * d + r) * 2) = (unsigned short)f2bf(S[m][i]);
        }
        DN_WAIT(0); DN_BAR();
        if (part == 1) {
            unsigned char* pf = F.ws + WS_PF + (size_t)unit * 32768;
#pragma unroll
            for (int k = 0; k < 8; ++k) { const int f = d * 8 + k, m = f >> 3, t = f & 7;
                const v2u a = *(const LAS v2u*)(lds + (32 * m + r) * 272 + (16 * t + 4 * lh) * 2), b = *(const LAS v2u*)(lds + (32 * m + r) * 272 + (16 * t + 8 + 4 * lh) * 2);
                *(v4u*)(pf + (f * 64 + lane) * 16) = (v4u){a.x, a.y, b.x, b.y}; }
        }
    }
}
__device__ __forceinline__ void dn_fold(Frame& F) {
    const int b = blockIdx.x; if (b >= 16) return;
    LAS unsigned char* lds = F.lds; const int lane = F.lane, wave = F.wave, dir = b >> 3, hd = b & 7;
    const int unit0 = (dir * 8 + hd) * 16;
    __syncthreads();
    if (wave >= 4) {
        const int lw = wave - 4;
        for (int g = 0; g < NSEG; ++g) {
            if (g < NSEG - 1) { const unsigned char* src = F.ws + WS_PF + (size_t)(unit0 + g) * 32768 + lane * 16; LAS unsigned char* dst = lds + (g & 1) * 32768;
#pragma unroll
                for (int k = 0; k < 8; ++k) { const int p = lw + 4 * k; __builtin_amdgcn_global_load_lds((const unsigned*)(src + p * 1024), (LAS unsigned*)(dst + p * 1024), 16, 0, 0); } }
            DN_WAIT(0); DN_BAR();
        }
    } else {
        const int d = wave;
        f32x16 S[4], R[4];
#pragma unroll
        for (int m = 0; m < 4; ++m)
#pragma unroll
            for (int i = 0; i < 16; ++i) S[m][i] = 0.f;
        const float* rg0 = (const float*)(F.ws + WS_RG) + (size_t)unit0 * 16384; float* sin0 = (float*)(F.ws + WS_SIN) + (size_t)unit0 * 16384;
#pragma unroll
        for (int m = 0; m < 4; ++m)
#pragma unroll
            for (int q = 0; q < 4; ++q) { const f32x4 v = *(const f32x4*)(rg0 + ((d * 4 + m) * 64 + lane) * 16 + 4 * q); R[m][4 * q] = v[0]; R[m][4 * q + 1] = v[1]; R[m][4 * q + 2] = v[2]; R[m][4 * q + 3] = v[3]; }
        DN_BAR();
        for (int g = 0; g < NSEG; ++g) {
            float* so = sin0 + (size_t)g * 16384;
#pragma unroll
            for (int m = 0; m < 4; ++m)
#pragma unroll
                for (int q = 0; q < 4; ++q) *(f32x4*)(so + ((d * 4 + m) * 64 + lane) * 16 + 4 * q) = (f32x4){S[m][4 * q], S[m][4 * q + 1], S[m][4 * q + 2], S[m][4 * q + 3]};
            if (g == NSEG - 1) break;
            const LAS unsigned char* buf = lds + (g & 1) * 32768 + lane * 16;
            bf16x8 sb[8];
#pragma unroll
            for (int t = 0; t < 8; ++t) sb[t] = cvt8(S[t >> 1], 8 * (t & 1));
#pragma unroll
            for (int m = 0; m < 4; ++m) { S[m] = R[m];
#pragma unroll
                for (int t = 0; t < 8; ++t) S[m] = __builtin_amdgcn_mfma_f32_32x32x16_bf16(*(const LAS bf16x8*)(buf + (m * 8 + t) * 1024), sb[t], S[m], 0, 0, 0); }
            if (g + 1 < NSEG - 1) { const float* rg = rg0 + (size_t)(g + 1) * 16384;
#pragma unroll
                for (int m = 0; m < 4; ++m)
#pragma unroll
                    for (int q = 0; q < 4; ++q) { const f32x4 v = *(const f32x4*)(rg + ((d * 4 + m) * 64 + lane) * 16 + 4 * q); R[m][4 * q] = v[0]; R[m][4 * q + 1] = v[1]; R[m][4 * q + 2] = v[2]; R[m][4 * q + 3] = v[3]; } }
            asm volatile("s_waitcnt lgkmcnt(0)" ::: "memory");
            DN_BAR();
        }
    }
    __syncthreads();
}
__device__ __forceinline__ void dn_pass3(Frame& F) {
    LAS unsigned char* lds = F.lds; const int lane = F.lane, wave = F.wave, r = lane & 31, lh = lane >> 5;
    LAS float* gls = (LAS float*)(lds + L_GLS);
    for (int unit = blockIdx.x; unit < 16 * NSEG; unit += F.G) {
        const int dir = unit >> 7, hd = (unit >> 4) & 7, g = unit & 15;
        __syncthreads();
        if (F.tid < SEGL) gls[F.tid] = WSP(float, WS_GL)[(dir * 8 + hd) * 256 + seg_chunk(dir, g, F.tid)];
        asm volatile("s_waitcnt lgkmcnt(0)" ::: "memory");
        if (wave >= 4) {
            const int lw = wave - 4;
            for (int i = 0; i <= SEGL; ++i) {
                if (i < SEGL) { const unsigned char* src = dnx_rec(F, dir, hd, seg_chunk(dir, g, i)) + lane * 16; LAS unsigned char* dst = lds + (i & 1) * SLOT3;
#pragma unroll
                    for (int k = 0; k < 18; ++k) { const int p = lw + 4 * k; __builtin_amdgcn_global_load_lds((const unsigned*)(src + p * 1024), (LAS unsigned*)(dst + p * 1024), 16, 0, 0); } }
                DN_WAIT(0); DN_BAR();
            }
        } else {
            const int d = wave;
            f32x16 S[4];
            const float* si = (const float*)(F.ws + WS_SIN) + (size_t)unit * 16384;
#pragma unroll
            for (int m = 0; m < 4; ++m)
#pragma unroll
                for (int q = 0; q < 4; ++q) { const f32x4 v = *(const f32x4*)(si + ((d * 4 + m) * 64 + lane) * 16 + 4 * q); S[m][4 * q] = v[0]; S[m][4 * q + 1] = v[1]; S[m][4 * q + 2] = v[2]; S[m][4 * q + 3] = v[3]; }
            bf16* O = WSP(bf16, dir ? WS_OB : WS_OF);
            DN_BAR();
            for (int i = 0; i < SEGL; ++i) {
                const int cn = seg_chunk(dir, g, i); const LAS unsigned char* slot = lds + (i & 1) * SLOT3;
                f32x16 aV[2], aO[2];
#pragma unroll
                for (int mt = 0; mt < 2; ++mt) { u_to_acc(aV[mt], slot + DX_U + ((d * 2 + mt) * 64 + lane) * 32);
#pragma unroll
                    for (int e = 0; e < 16; ++e) aO[mt][e] = 0.f; }
                dn_step<true>(S, aV, aO, slot + lane * 16, gls[i]);
                bf16* op = O + (size_t)(64 * cn + 4 * lh) * 1024 + hd * 128 + 32 * d + r;
#pragma unroll
                for (int mt = 0; mt < 2; ++mt)
#pragma unroll
                    for (int e = 0; e < 16; ++e) op[(size_t)(32 * mt + (e & 3) + 8 * (e >> 2)) * 1024] = (bf16)f2bf(aO[mt][e]);
                asm volatile("s_waitcnt lgkmcnt(0)" ::: "memory");
                DN_BAR();
            }
        }
    }
    __syncthreads();
}

#ifndef MK_N_LAUNCHES
#define MK_N_LAUNCHES 1
#endif
constexpr int N_PHASES = 14;
struct Args { const float* in[23]; float* out; unsigned char* ws; int ph_lo, ph_hi; };
static_assert(sizeof(Args) == 23 * 8 + 8 + 8 + 8, "Args has no padding");

__global__ void __launch_bounds__(NWAVES * 64, 2) enc_fwd(Args args) {
    extern __shared__ __attribute__((aligned(16))) unsigned char lds[];
    Frame F;
    F.lds = (LAS unsigned char*)lds;
    F.MISC = (volatile LAS unsigned*)(F.lds + MISC_OFF);
    F.tid = threadIdx.x; F.lane = F.tid & 63; F.wave = __builtin_amdgcn_readfirstlane(F.tid >> 6);
    F.G = gridDim.x; { const int bx = blockIdx.x; F.vcu = (F.G % 8 == 0) ? (bx % 8) * (F.G / 8) + bx / 8 : bx; }
#pragma unroll
    for (int i = 0; i < 23; ++i) F.in[i] = args.in[i];
    F.out = args.out; F.ws = args.ws; F.ctl = (gu32*)(args.ws + WS_CTL);
    for (int u = F.tid; u < (LDS_BYTES - LDSCTL_OFF) / 4; u += NWAVES * 64) ((LAS unsigned*)(F.lds + LDSCTL_OFF))[u] = 0u;
    __syncthreads();
    const int lo = args.ph_lo, hi = args.ph_hi;
    XcdBarrier bar; bar.bar = (unsigned*)(F.ctl + CW_BAR); bar.x = 0; bar.st = nullptr;
    if (hi - lo > 1) bar = xcd_barrier_post((unsigned*)(F.ctl + CW_BAR), F.MISC + 8);
#define IN(k) (lo <= (k) && (k) < hi)
#define SEAM(k) do { if (IN(k) && IN((k) + 1)) xcd_barrier(bar); } while (0)
    float* sumsq2 = (float*)(F.ws + WS_CTL + CTL_SUMSQ2); float* sumsq3 = (float*)(F.ws + WS_CTL + CTL_SUMSQ3); float* sumsq4 = (float*)(F.ws + WS_CTL + CTL_SUMSQ4);

    if (IN(0)) { p0_prologue(F);
#if defined(REPEAT_PHASE) && REPEAT_PHASE == 0
        p0_prologue(F);
#endif
    } SEAM(0);
    if (IN(1)) {
        { pg8::Gemm g{WSP(bf16, WS_XB), WSP(bf16, WS_WIN), SEQ, NINP, DM}; pg8::StaticOrder S; S.init(SEQ, NINP, F.G, (int)blockIdx.x);
          EpiProj E{WSP(float, WS_RSTD1), WSP(bf16, WS_QKV), DOP(bf16, DO_Z), DOP(bf16, DO_QSW), DOP(bf16, DO_KVSW), WSP(float, WS_AB)};
          pg8::gemm_phase<EpiProj, pg8::StaticOrder, true, true>(F.lds + RING_OFF, g, S, E);
#if defined(REPEAT_PHASE) && REPEAT_PHASE == 1
          pg8::gemm_phase<EpiProj, pg8::StaticOrder, true, true>(F.lds + RING_OFF, g, S, E);
#endif
          }
    } SEAM(1);
    if (IN(2)) { dn_prep_phase<63>(F);
#if defined(REPEAT_PHASE) && REPEAT_PHASE == 2
        dn_prep_phase<63>(F);
#endif
#if defined(REPEAT_PHASE) && REPEAT_PHASE >= 1000 && REPEAT_PHASE < 1064
        dn_prep_phase<REPEAT_PHASE - 1000>(F);
#endif
    } SEAM(2);
    if (IN(3)) { dn_pass1(F);
#if defined(REPEAT_PHASE) && REPEAT_PHASE == 3
        dn_pass1(F);
#endif
    } SEAM(3);
    if (IN(12)) { dn_fold(F); swa_phase(F, 0, F.G); }
#if defined(REPEAT_PHASE) && REPEAT_PHASE == 12
    if (IN(12)) { dn_fold(F); swa_phase(F, 0, F.G); }
#endif
#if defined(REPEAT_PHASE) && REPEAT_PHASE == 112
    if (IN(12)) { dn_fold(F); }
#endif
#if defined(REPEAT_PHASE) && REPEAT_PHASE == 212
    if (IN(12)) { swa_phase(F, 0, F.G); }
#endif
    if (IN(12) && IN(13)) xcd_barrier(bar);
    if (IN(13)) { dn_pass3(F);
#if defined(REPEAT_PHASE) && REPEAT_PHASE == 13
        dn_pass3(F);
#endif
    } if (IN(13) && IN(4)) xcd_barrier(bar);
    if (IN(4)) { dn_combine(F);
#if defined(REPEAT_PHASE) && REPEAT_PHASE == 4
        dn_combine(F);
#endif
    } SEAM(4);
    if (IN(5)) {
        pg8::Gemm g{WSP(bf16, WS_XB), WSP(bf16, WS_WOUT), SEQ, DM, DM}; pg8::StaticOrder S; S.init(SEQ, DM, F.G, (int)blockIdx.x);
        EpiRes E{F.in[0], F.out, WSP(bf16, WS_H1B), sumsq2};
        pg8::gemm_phase<EpiRes, pg8::StaticOrder, true, true>(F.lds + RING_OFF, g, S, E);
#if defined(REPEAT_PHASE) && REPEAT_PHASE == 5
        { EpiRes E2{F.in[0], nullptr, nullptr, (float*)(F.ws + WS_CTL + 448 * 1024)}; pg8::gemm_phase<EpiRes, pg8::StaticOrder, true, true>(F.lds + RING_OFF, g, S, E2); }
#endif
    } SEAM(5);
    if (IN(6)) {
        pg8::Gemm g{WSP(bf16, WS_H1B), WSP(bf16, WS_WQ), SEQ, 512, DM}; pg8::StaticOrder S; S.init(SEQ, 512, F.G, (int)blockIdx.x);
        EpiScaleBf16 E{sumsq2, 1, QSCALE, WSP(bf16, WS_QM), 512};
        pg8::gemm_phase<EpiScaleBf16, pg8::StaticOrder, true, true>(F.lds + RING_OFF, g, S, E);
        { pg8::Gemm g2{WSP(bf16, WS_MEMB), WSP(bf16, WS_WKV), MEMT, 1024, DM}; pg8::StaticOrder S2; S2.init(MEMT, 1024, F.G, (int)((blockIdx.x + F.G - (F.G >> 1)) % F.G));
          EpiScaleBf16 E2{WSP(float, WS_RSTDM), 0, 1.0f, WSP(bf16, WS_KVM), 1024};
          pg8::gemm_phase<EpiScaleBf16, pg8::StaticOrder, true, true>(F.lds + RING_OFF, g2, S2, E2); }
        { const int nbusy = (F.G >> 1) + 4; if (F.G >= nbusy + 32) p4_transposes(F, nbusy, F.G - nbusy); else p4_transposes(F, 0, F.G); }
#if defined(REPEAT_PHASE) && REPEAT_PHASE == 6
        pg8::gemm_phase<EpiScaleBf16, pg8::StaticOrder, true, true>(F.lds + RING_OFF, g, S, E);
#endif
    } SEAM(6);
    if (IN(7)) { mem_attn_phase(F);
#if defined(REPEAT_PHASE) && REPEAT_PHASE == 7
        mem_attn_phase(F);
#endif
    } SEAM(7);
    if (IN(8)) {
        pg8::Gemm g{WSP(bf16, WS_OM), WSP(bf16, WS_WO), SEQ, DM, 512}; pg8::StaticOrder S; S.init(SEQ, DM, F.G, (int)blockIdx.x);
        EpiRes E{F.out, F.out, WSP(bf16, WS_XB), sumsq3};
        pg8::gemm_phase<EpiRes, pg8::StaticOrder, true, true>(F.lds + RING_OFF, g, S, E);
#if defined(REPEAT_PHASE) && REPEAT_PHASE == 8
        { EpiRes E2{F.out, nullptr, nullptr, (float*)(F.ws + WS_CTL + 448 * 1024)}; pg8::gemm_phase<EpiRes, pg8::StaticOrder, true, true>(F.lds + RING_OFF, g, S, E2); }
#endif
    } SEAM(8);
    if (IN(9)) {
        pg8::Gemm g{WSP(bf16, WS_XB), WSP(bf16, WS_WGU), SEQ, 2 * DFF, DM}; pg8::StaticOrder S; S.init(SEQ, 2 * DFF, F.G, (int)blockIdx.x);
        EpiSwiglu E{sumsq3, WSP(bf16, WS_HID)};
        pg8::gemm_phase<EpiSwiglu, pg8::StaticOrder, true, true>(F.lds + RING_OFF, g, S, E);
#if defined(REPEAT_PHASE) && REPEAT_PHASE == 9
        pg8::gemm_phase<EpiSwiglu, pg8::StaticOrder, true, true>(F.lds + RING_OFF, g, S, E);
#endif
    } SEAM(9);
    if (IN(10)) {
        pg8::Gemm g{WSP(bf16, WS_HID), WSP(bf16, WS_WD), SEQ, DM, DFF}; pg8::StaticOrder S; S.init(SEQ, DM, F.G, (int)blockIdx.x);
        EpiRes E{F.out, nullptr, WSP(bf16, WS_H3B), sumsq4};
        pg8::gemm_phase<EpiRes, pg8::StaticOrder, true, true>(F.lds + RING_OFF, g, S, E);
#if defined(REPEAT_PHASE) && REPEAT_PHASE == 10
        { EpiRes E2{F.out, nullptr, nullptr, (float*)(F.ws + WS_CTL + 448 * 1024)}; pg8::gemm_phase<EpiRes, pg8::StaticOrder, true, true>(F.lds + RING_OFF, g, S, E2); }
#endif
    } SEAM(10);
#if defined(REPEAT_PHASE) && REPEAT_PHASE == 99
    for (int k_ = 0; k_ < 10; ++k_) xcd_barrier(bar);
#endif
    if (IN(11)) { final_norm(F);
#if defined(REPEAT_PHASE) && REPEAT_PHASE == 11
        final_norm(F);
#endif
    }
#undef IN
#undef SEAM
}

extern "C" void kernel_launch(void* const* d_in, const int* in_sizes, int n_in, void* d_out, int out_size, void* d_ws, size_t ws_size, hipStream_t stream) {
    static int grid = 0;
    if (grid == 0) {
        if (n_in != 23 || out_size != SEQ * DM || ws_size < WS_END) { fprintf(stderr, "kernel_launch: unexpected shapes (n_in %d out %d ws %zu)\n", n_in, out_size, ws_size); grid = -1; return; }
        int dev = 0, cus = 0;
        if (hipGetDevice(&dev) != hipSuccess || hipDeviceGetAttribute(&cus, hipDeviceAttributeMultiprocessorCount, dev) != hipSuccess) { grid = -1; return; }
        if (hipFuncSetAttribute((const void*)enc_fwd, hipFuncAttributeMaxDynamicSharedMemorySize, LDS_BYTES) != hipSuccess) { fprintf(stderr, "kernel_launch: hipFuncSetAttribute failed\n"); grid = -1; return; }
        (void)hipGetLastError();
        grid = cus;
    }
    if (grid < 0) return;
    if (hipMemsetAsync((char*)d_ws + WS_CTL, 0, CTL_ZERO_BYTES, stream) != hipSuccess) return;
    Args a{};
    for (int i = 0; i < 23; ++i) a.in[i] = (const float*)d_in[i];
    a.out = (float*)d_out; a.ws = (unsigned char*)d_ws;
    const int per = (N_PHASES + MK_N_LAUNCHES - 1) / MK_N_LAUNCHES;
    for (int lo = 0; lo < N_PHASES; lo += per) {
        a.ph_lo = lo; a.ph_hi = (lo + per < N_PHASES) ? lo + per : N_PHASES;
        hipLaunchKernelGGL(enc_fwd, dim3(grid), dim3(NWAVES * 64), LDS_BYTES, stream, a);
    }
}
```

```cpp
#include <hip/hip_runtime.h>
#include <cstdio>
#include <cstdint>
namespace pg8 {
__device__ __forceinline__ unsigned cvt_pk_bf16(float lo, float hi) { unsigned r; asm volatile("v_cvt_pk_bf16_f32 %0, %1, %2" : "=v"(r) : "v"(lo), "v"(hi)); return r; }
#define PG8_LAS __attribute__((address_space(3)))
typedef unsigned short bf16_t;
typedef short bf16x8 __attribute__((ext_vector_type(8)));
typedef float f32x4 __attribute__((ext_vector_type(4)));
typedef unsigned u32x4 __attribute__((ext_vector_type(4)));
constexpr int BM = 256, BK = 64, HALF = 128, HTB = HALF * BK * 2  , STAGE_BYTES = 8 * HTB, NXCD = 8, WGM = 8;

__host__ __device__ __forceinline__ int lds_byte(int r, int c) { const int st = (r >> 4) * 2 + (c >> 5), rr = r & 15, cc = c & 31, ob = rr * 64 + cc * 2; return st * 1024 + (ob ^ (((ob >> 9) & 1) << 5)); }
__host__ __device__ __forceinline__ void stage_rc(int b, int& R, int& C) { const int st = b / 1024, sb = b % 1024, swz = sb ^ (((sb >> 9) & 1) << 5); R = (st >> 1) * 16 + swz / 64; C = (st & 1) * 32 + (swz % 64) / 2; }
__host__ __device__ __forceinline__ int perm32(int rho) { const int n = rho >> 4, i = rho & 15; return 8 * (i >> 2) + 4 * n + (i & 3); }

struct Unit { int pm, pn; };
struct Gemm { const bf16_t* A; const bf16_t* Bt; int M, N, K; };

struct StaticOrder {
    int nM, nN, nwg, G, c;
    __host__ __device__ void init(int M, int N, int G_, int c_) { nM = M / BM; nN = N / BM; nwg = nM * nN; G = G_; c = c_; }
    __host__ __device__ bool next(int i, Unit& u) const {
        const long L = (long)i * G + c; if (L >= nwg) return false;
        int wgid = (int)L; { const int q = nwg / NXCD, r = nwg % NXCD, xcd = wgid % NXCD, off = wgid / NXCD; wgid = (xcd < r ? xcd * (q + 1) : r * (q + 1) + (xcd - r) * q) + off; }
        const int nig = WGM * nN, gid = wgid / nig, fm = gid * WGM, gsz = (nM - fm) < WGM ? (nM - fm) : WGM;
        u.pm = fm + ((wgid % nig) % gsz); u.pn = (wgid % nig) / gsz; return true;
    }
    __device__ __forceinline__ void a_ready(const Unit&) const {}
    __device__ __forceinline__ void done(const Unit&) const {}
};

template <class Epi, class Sched, bool ALIGN_EPI = false, bool SP2 = false>
__device__ __forceinline__ void gemm_phase(PG8_LAS unsigned char* lds, const Gemm g, const Sched& S, const Epi& E) {
    const int tid = threadIdx.x, wid = __builtin_amdgcn_readfirstlane(tid >> 6), lane = tid & 63, wr = wid >> 2, wc = wid & 3, fr = lane & 15, fq = lane >> 4;
    const int K = g.K, nt = K / BK;
    unsigned voffA[2], voffB[2];
#pragma unroll
    for (int i = 0; i < 2; ++i) { int R, C; stage_rc(tid * 16 + i * 8192, R, C); const int Rb = Epi::PERM ? ((R & ~31) + perm32(R & 31)) : R;
        voffA[i] = (unsigned)(R * K + C) * 2u; voffB[i] = (unsigned)(Rb * K + C) * 2u; }
    const size_t kstep = (size_t)(BK * 2);
    const size_t hstep = (size_t)HALF * K * 2;
    const size_t tstep = 2 * hstep;
    const unsigned ldsw = (unsigned)wid * 1024u;
    const int aoff = lds_byte(wr * 64 + fr, fq * 8), boff = lds_byte(wc * 32 + fr, fq * 8);
#define PG8_SA(b, h) (((b) * 2 + (h)) * HTB)
#define PG8_SB(b, h) ((4 + (b) * 2 + (h)) * HTB)
#define PG8_STAGE(bufoff, gbase, voff) do { _Pragma("unroll") for (int _i = 0; _i < 2; ++_i) \
        __builtin_amdgcn_global_load_lds((const unsigned*)((const char*)(gbase) + (voff)[_i]), (PG8_LAS unsigned*)(lds + (bufoff) + ldsw + _i * 8192), 16, 0, 0); } while (0)
#define PG8_LDA(dst, b, h) do { _Pragma("unroll") for (int m = 0; m < 4; ++m) _Pragma("unroll") for (int k = 0; k < 2; ++k) dst[m][k] = *(const PG8_LAS bf16x8*)(lds + PG8_SA(b, h) + aoff + m * 2048 + k * 1024); } while (0)
#define PG8_LDB(dst, b, h) do { _Pragma("unroll") for (int n = 0; n < 2; ++n) _Pragma("unroll") for (int k = 0; k < 2; ++k) dst[n][k] = *(const PG8_LAS bf16x8*)(lds + PG8_SB(b, h) + boff + n * 2048 + k * 1024); } while (0)
#define PG8_MMA(ai, bj, At, Bt) do { __builtin_amdgcn_s_setprio(1); _Pragma("unroll") for (int m = 0; m < 4; ++m) _Pragma("unroll") for (int n = 0; n < 2; ++n) _Pragma("unroll") for (int k = 0; k < 2; ++k) \
        acc[ai][bj][m][n] = __builtin_amdgcn_mfma_f32_16x16x32_bf16(Bt[n][k], At[m][k], acc[ai][bj][m][n], 0, 0, 0); __builtin_amdgcn_s_setprio(0); } while (0)
#define PG8_WAIT_V(n) asm volatile("s_waitcnt vmcnt(" #n ")" ::: "memory")
#define PG8_WAIT_L(n) asm volatile("s_waitcnt lgkmcnt(" #n ")" ::: "memory")
#define PG8_BAR __builtin_amdgcn_s_barrier()
#define PG8_SCHED __builtin_amdgcn_sched_barrier(0)
    Unit cur, nxt; int ui = 0;
    if (!S.next(0, cur)) return;
    f32x4 acc[2][2][4][2];
#pragma unroll
    for (int a = 0; a < 2; ++a)
#pragma unroll
        for (int b = 0; b < 2; ++b)
#pragma unroll
            for (int m = 0; m < 4; ++m)
#pragma unroll
                for (int n = 0; n < 2; ++n) acc[a][b][m][n] = (f32x4){0.f, 0.f, 0.f, 0.f};
    bf16x8 At[4][2], B0[2][2], B1[2][2];
    const char* cA = (const char*)g.A + (size_t)cur.pm * tstep; const char* cB = (const char*)g.Bt + (size_t)cur.pn * tstep;
    S.a_ready(cur);
    if constexpr (SP2) {
        PG8_STAGE(PG8_SB(0, 0), cB, voffB); PG8_STAGE(PG8_SB(0, 1), cB + hstep, voffB); PG8_STAGE(PG8_SA(0, 0), cA, voffA); PG8_STAGE(PG8_SA(0, 1), cA + hstep, voffA);
        if (wr == 1) PG8_BAR;
        PG8_WAIT_V(2); PG8_BAR;
        PG8_STAGE(PG8_SB(1, 0), cB + kstep, voffB); PG8_STAGE(PG8_SA(1, 0), cA + kstep, voffA); PG8_STAGE(PG8_SB(1, 1), cB + hstep + kstep, voffB);
        PG8_WAIT_V(6); PG8_BAR;
    } else {
        PG8_STAGE(PG8_SB(0, 0), cB, voffB); PG8_STAGE(PG8_SA(0, 0), cA, voffA); PG8_STAGE(PG8_SB(0, 1), cB + hstep, voffB); PG8_STAGE(PG8_SA(0, 1), cA + hstep, voffA);
        if (wr == 1) PG8_BAR;
        PG8_WAIT_V(4); PG8_BAR;
        PG8_STAGE(PG8_SB(1, 0), cB + kstep, voffB); PG8_STAGE(PG8_SA(1, 0), cA + kstep, voffA); PG8_STAGE(PG8_SB(1, 1), cB + hstep + kstep, voffB);
        PG8_WAIT_V(6); PG8_BAR;
    }
    for (;;) {
        const bool has_next = S.next(ui + 1, nxt);
        const char* nA = has_next ? (const char*)g.A + (size_t)nxt.pm * tstep : cA; const char* nB = has_next ? (const char*)g.Bt + (size_t)nxt.pn * tstep : cB;
        for (int t = 0; t < nt; t += 2) {
            const bool last = (t == nt - 2);
            const char* a1 = cA + (size_t)(t + 1) * kstep;
            const char* a2 = last ? nA : cA + (size_t)(t + 2) * kstep; const char* b2 = last ? nB : cB + (size_t)(t + 2) * kstep;
            const char* a3 = a2 + kstep; const char* b3 = b2 + kstep;
            if (last && has_next) S.a_ready(nxt);
            if constexpr (SP2) {
            PG8_LDB(B0, 0, 0); PG8_LDB(B1, 0, 1); PG8_SCHED; PG8_LDA(At, 0, 0); PG8_STAGE(PG8_SA(1, 1), a1 + hstep, voffA);
            PG8_WAIT_V(8); PG8_WAIT_L(0); PG8_BAR; PG8_MMA(0, 0, At, B0); PG8_MMA(0, 1, At, B1); PG8_BAR; PG8_SCHED;
            PG8_LDA(At, 0, 1); PG8_STAGE(PG8_SB(0, 0), b2, voffB); PG8_STAGE(PG8_SB(0, 1), b2 + hstep, voffB); PG8_STAGE(PG8_SA(0, 0), a2, voffA);
            PG8_WAIT_V(8); PG8_WAIT_L(0); PG8_BAR; PG8_MMA(1, 0, At, B0); PG8_MMA(1, 1, At, B1); PG8_BAR; PG8_SCHED;
            PG8_LDB(B0, 1, 0); PG8_LDB(B1, 1, 1); PG8_SCHED; PG8_LDA(At, 1, 0); PG8_STAGE(PG8_SA(0, 1), a2 + hstep, voffA);
            PG8_WAIT_V(8); PG8_WAIT_L(0); PG8_BAR; PG8_MMA(0, 0, At, B0); PG8_MMA(0, 1, At, B1); PG8_BAR; PG8_SCHED;
            PG8_LDA(At, 1, 1); PG8_STAGE(PG8_SB(1, 0), b3, voffB); PG8_STAGE(PG8_SB(1, 1), b3 + hstep, voffB); PG8_STAGE(PG8_SA(1, 0), a3, voffA);
            PG8_WAIT_V(8); PG8_WAIT_L(0); PG8_BAR; PG8_MMA(1, 0, At, B0); PG8_MMA(1, 1, At, B1); PG8_BAR; PG8_SCHED;
            } else {
            PG8_LDB(B0, 0, 0); PG8_SCHED; PG8_LDA(At, 0, 0); PG8_STAGE(PG8_SA(1, 1), a1 + hstep, voffA);
            PG8_WAIT_L(8); PG8_BAR; PG8_WAIT_L(0); PG8_MMA(0, 0, At, B0); PG8_BAR; PG8_SCHED;
            PG8_LDB(B1, 0, 1); PG8_STAGE(PG8_SB(0, 0), b2, voffB);
            PG8_BAR; PG8_WAIT_L(0); PG8_MMA(0, 1, At, B1); PG8_BAR;
            PG8_LDA(At, 0, 1); PG8_STAGE(PG8_SA(0, 0), a2, voffA);
            PG8_BAR; PG8_WAIT_L(0); PG8_MMA(1, 0, At, B0); PG8_BAR; PG8_SCHED;
            PG8_STAGE(PG8_SB(0, 1), b2 + hstep, voffB);
            PG8_WAIT_V(6); PG8_BAR; PG8_MMA(1, 1, At, B1); PG8_BAR;
            PG8_LDB(B0, 1, 0); PG8_SCHED; PG8_LDA(At, 1, 0); PG8_STAGE(PG8_SA(0, 1), a2 + hstep, voffA);
            PG8_WAIT_L(8); PG8_BAR; PG8_WAIT_L(0); PG8_MMA(0, 0, At, B0); PG8_BAR; PG8_SCHED;
            PG8_LDB(B1, 1, 1); PG8_STAGE(PG8_SB(1, 0), b3, voffB);
            PG8_BAR; PG8_WAIT_L(0); PG8_MMA(0, 1, At, B1); PG8_BAR;
            PG8_LDA(At, 1, 1); PG8_STAGE(PG8_SA(1, 0), a3, voffA);
            PG8_BAR; PG8_WAIT_L(0); PG8_MMA(1, 0, At, B0); PG8_BAR; PG8_SCHED;
            PG8_STAGE(PG8_SB(1, 1), b3 + hstep, voffB);
            PG8_WAIT_V(6); PG8_BAR; PG8_MMA(1, 1, At, B1); PG8_BAR;
            }
        }
        if constexpr (ALIGN_EPI) { if (wr == 0) PG8_BAR; }
        if constexpr (!Epi::AFTER_DRAIN) { E(acc, cur, wr, wc, fr, fq); S.done(cur); }
        if (!has_next) break;
#pragma unroll
        for (int a = 0; a < 2; ++a)
#pragma unroll
            for (int b = 0; b < 2; ++b)
#pragma unroll
                for (int m = 0; m < 4; ++m)
#pragma unroll
                    for (int n = 0; n < 2; ++n) acc[a][b][m][n] = (f32x4){0.f, 0.f, 0.f, 0.f};
        cur = nxt; cA = nA; cB = nB; ++ui;
        if constexpr (ALIGN_EPI) { if (wr == 1) PG8_BAR; }
    }
    PG8_WAIT_V(0);
    if constexpr (!ALIGN_EPI) { if (wr == 0) PG8_BAR; }
    PG8_BAR;
    if constexpr (Epi::AFTER_DRAIN) { E.fused(acc, cur, wr, wc, fr, fq, lds, wid, lane); S.done(cur); }
#undef PG8_SA
#undef PG8_SB
#undef PG8_STAGE
#undef PG8_LDA
#undef PG8_LDB
#undef PG8_MMA
#undef PG8_WAIT_V
#undef PG8_WAIT_L
#undef PG8_BAR
#undef PG8_SCHED
}
}

constexpr int NWAVES = 8;
constexpr int SEQ = 16384, DM = 2048, NIN = 5664, NINP = 5888, DFF = 5632;
constexpr int DNH = 8, HD = 128, SWH = 8, MEMH = 4, MEMT = 256;
constexpr float RMS_EPS = 1e-6f;
constexpr float LOG2E = 1.4426950408889634f;
constexpr float QSCALE = 0.08838834764831845f * 1.4426950408889634f;

constexpr size_t MiB = 1u << 20;
constexpr size_t WS_CTL = 0, CTL_ZERO_BYTES = 1 * MiB;
constexpr size_t CTL_SUMSQ2 = 256 * 1024, CTL_SUMSQ3 = 320 * 1024, CTL_SUMSQ4 = 384 * 1024;
constexpr size_t WS_RSTD1 = 1 * MiB, WS_RSTDM = 1 * MiB + 64 * 1024;
constexpr size_t WS_MEMB = 2 * MiB, WS_KVM = 3 * MiB, WS_AB = 4 * MiB, WS_BG = 6 * MiB;
constexpr size_t WS_WOUT = 8 * MiB, WS_WQ = 16 * MiB, WS_WKV = 18 * MiB, WS_WO = 22 * MiB, WS_WIN = 24 * MiB;
constexpr size_t WS_XB = 48 * MiB;
constexpr size_t WS_QKV = 112 * MiB;
constexpr size_t WS_H3B = 112 * MiB;
constexpr size_t WS_OF = 112 * MiB, WS_OB = 144 * MiB, WS_H1B = 112 * MiB, WS_QM = 176 * MiB, WS_OM = 192 * MiB;
constexpr size_t WS_DNX = 208 * MiB;
constexpr size_t WS_WGU = 208 * MiB, WS_WD = 252 * MiB, WS_HID = 274 * MiB, WS_END = 496 * MiB;
constexpr size_t DO_Z = 0, DO_QSW = 32 * MiB, DO_KVSW = 64 * MiB;
constexpr int CW_BAR = 4096, CW_SWAQ = 8192;

constexpr int RING_OFF = 0, RING_BYTES = 131072;
constexpr int LDS_BYTES = 163840;
constexpr int LDSCTL_OFF = LDS_BYTES - 512, MISC_OFF = LDSCTL_OFF + 320;

#define GAS __attribute__((address_space(1)))
#define LAS __attribute__((address_space(3)))
typedef unsigned short bf16;
typedef unsigned v4u __attribute__((ext_vector_type(4)));
typedef unsigned v2u __attribute__((ext_vector_type(2)));
typedef float f32x4 __attribute__((ext_vector_type(4)));
typedef short bf16x8 __attribute__((ext_vector_type(8)));
typedef short s16x4 __attribute__((ext_vector_type(4)));
typedef GAS unsigned gu32;
#define RLX_AGENT __ATOMIC_RELAXED, __HIP_MEMORY_SCOPE_AGENT
#define LDS_WAIT() asm volatile("s_waitcnt lgkmcnt(0)" ::: "memory")
#define VM_WAIT() asm volatile("s_waitcnt vmcnt(0)" ::: "memory")
__device__ __forceinline__ unsigned f2bf(float f) { unsigned u = __builtin_bit_cast(unsigned, f); return (u + 0x7fffu + ((u >> 16) & 1u)) >> 16; }
__device__ __forceinline__ unsigned pk2(float lo, float hi) { return f2bf(lo) | (f2bf(hi) << 16); }
__device__ __forceinline__ float bf2f(unsigned short b) { return __builtin_bit_cast(float, (unsigned)b << 16); }
__device__ __forceinline__ float bflo(unsigned w) { return __builtin_bit_cast(float, w << 16); }
__device__ __forceinline__ float bfhi(unsigned w) { return __builtin_bit_cast(float, w & 0xffff0000u); }
typedef float f32x2_t __attribute__((ext_vector_type(2))); typedef __bf16 bf16x2_t __attribute__((ext_vector_type(2)));
__device__ __forceinline__ unsigned cvtpk(float lo, float hi) { f32x2_t v = {lo, hi}; bf16x2_t b = __builtin_convertvector(v, bf16x2_t); return __builtin_bit_cast(unsigned, b); }
__device__ __forceinline__ float wave_sum(float v) {
#pragma unroll
    for (int o = 1; o < 64; o <<= 1) v += __shfl_xor(v, o);
    return v;
}
__device__ __forceinline__ float siluf(float x) { return x * __builtin_amdgcn_rcpf(1.0f + __expf(-x)); }
#define XB_TMO      128
#define XB_XCNT(j)  (256  + 64 * (j))
#define XB_XSUB(j)  (1280 + 64 * (j))
#define XB_XGEN(j)  (2304 + 64 * (j))
#define XB_TOP      3328
#define XB_TOPGEN   3392
#define XCD_BAR_WORDS 3456
#define XB_SPIN_CAP (1u << 18)

__device__ __forceinline__ unsigned xb_ld(unsigned* p)              { return __hip_atomic_load(p, __ATOMIC_RELAXED, __HIP_MEMORY_SCOPE_AGENT); }
__device__ __forceinline__ unsigned xb_add(unsigned* p, unsigned v) { return __hip_atomic_fetch_add(p, v, __ATOMIC_RELAXED, __HIP_MEMORY_SCOPE_AGENT); }
__device__ __forceinline__ unsigned xb_xcc_id() { return (unsigned)__builtin_amdgcn_s_getreg((3 << 11) | 20) & 0xFu; }
#define XB_SPIN(cond, bar) do { unsigned _sp = 0; while (cond) { __builtin_amdgcn_s_sleep(1); \
    if ((++_sp & 255u) == 0u) { if (xb_ld(&(bar)[XB_TMO])) break; if (_sp > XB_SPIN_CAP) { atomicAdd(&(bar)[XB_TMO], 1u); break; } } } } while (0)

struct XcdBarrier {
    unsigned* bar; unsigned x;
    volatile LAS unsigned* st;
};

__device__ __forceinline__ XcdBarrier xcd_barrier_post(unsigned* bar, volatile LAS unsigned* st) {
    XcdBarrier b; b.bar = bar; b.x = xb_xcc_id(); b.st = st;
    if (threadIdx.x == 0) (void)xb_add(&bar[XB_XCNT(b.x)], 1u);
    return b;
}
__device__ __forceinline__ void xcd_barrier_complete(unsigned* bar, unsigned x, unsigned& nloc, unsigned& nx) {
    const unsigned G = gridDim.x * gridDim.y * gridDim.z;
    unsigned sum, cnt, mine, sp = 0u;
    for (;;) {
        sum = 0u; cnt = 0u; mine = 0u;
#pragma unroll
        for (unsigned j = 0; j < 16; ++j) { const unsigned c = xb_ld(&bar[XB_XCNT(j)]); sum += c; cnt += (c > 0u) ? 1u : 0u; mine = (j == x) ? c : mine; }
        if (sum == G) break;
        __builtin_amdgcn_s_sleep(1);
        if ((++sp & 255u) == 0u) { if (xb_ld(&bar[XB_TMO])) break; if (sp > XB_SPIN_CAP) { atomicAdd(&bar[XB_TMO], 1u); break; } }
    }
    nloc = mine > 0u ? mine : 1u; nx = cnt > 0u ? cnt : 1u;
}

__device__ __forceinline__ void xcd_barrier(const XcdBarrier& b) {
    asm volatile("s_waitcnt vmcnt(0)" ::: "memory");
    __syncthreads();
    if (threadIdx.x == 0) {
        unsigned* bar = b.bar;
        __builtin_amdgcn_s_waitcnt(0);
        unsigned nloc = b.st[0], nx = b.st[1];
        if (nloc == 0u) { xcd_barrier_complete(bar, b.x, nloc, nx); b.st[0] = nloc; b.st[1] = nx; }
        const unsigned old = xb_add(&bar[XB_XSUB(b.x)], 1u);
        const unsigned gen = old / nloc;
        if (old + 1u == (gen + 1u) * nloc) {
            __builtin_amdgcn_fence(__ATOMIC_RELEASE, "agent");
            asm volatile("s_waitcnt vmcnt(0)" ::: "memory");
            const unsigned og = xb_add(&bar[XB_TOP], 1u);
            const unsigned tg = og / nx;
            if (og + 1u == (tg + 1u) * nx) xb_add(&bar[XB_TOPGEN], 1u);
            else XB_SPIN(xb_ld(&bar[XB_TOPGEN]) == tg, bar);
            __builtin_amdgcn_fence(__ATOMIC_ACQUIRE, "agent");
            xb_add(&bar[XB_XGEN(b.x)], 1u);
            asm volatile("s_waitcnt vmcnt(0)" ::: "memory");
        } else {
            XB_SPIN(xb_ld(&bar[XB_XGEN(b.x)]) == gen, bar);
            __builtin_amdgcn_fence(__ATOMIC_ACQUIRE, "agent");
            asm volatile("s_waitcnt vmcnt(0)" ::: "memory");
        }
    }
    __syncthreads();
}

using pg8::Unit;
__device__ __forceinline__ v4u pack8(f32x4 v0, f32x4 v1) { v4u w; w.x = cvtpk(v0[0], v0[1]); w.y = cvtpk(v0[2], v0[3]); w.z = cvtpk(v1[0], v1[1]); w.w = cvtpk(v1[2], v1[3]); return w; }

struct EpiProj {
    static constexpr bool PERM = true, AFTER_DRAIN = false;
    const float* rstd; bf16* qkv; bf16* z; bf16* qsw; bf16* kvsw; float* ab;
    __device__ __forceinline__ void operator()(const f32x4 (&acc)[2][2][4][2], const Unit& u, int wr, int wc, int fr, int fq) const {
        const int pn = u.pn; bf16* base; int ldc, colt; float sc = 1.f;
        if (pn < 12) { base = qkv; ldc = 3072; colt = pn * 256; }
        else if (pn < 16) { base = z; ldc = 1024; colt = (pn - 12) * 256; }
        else if (pn < 20) { base = qsw; ldc = 1024; colt = (pn - 16) * 256; sc = QSCALE; }
        else if (pn < 22) { base = kvsw; ldc = 512; colt = (pn - 20) * 256; }
        else { base = nullptr; ldc = 0; colt = 0; }
        const int row0 = u.pm * 256 + wr * 64 + fr, col0 = colt + wc * 32 + 8 * fq;
        float rsv[2][4];
#pragma unroll
        for (int ai = 0; ai < 2; ++ai)
#pragma unroll
            for (int m = 0; m < 4; ++m) rsv[ai][m] = rstd[row0 + ai * 128 + m * 16];
#pragma unroll
        for (int ai = 0; ai < 2; ++ai)
#pragma unroll
            for (int m = 0; m < 4; ++m) {
                const int row = row0 + ai * 128 + m * 16; const float rs = rsv[ai][m] * sc;
                if (base) {
                    bf16* rowp = base + (size_t)row * ldc + col0;
#pragma unroll
                    for (int bj = 0; bj < 2; ++bj) *(v4u*)(rowp + bj * 128) = pack8(acc[ai][bj][m][0] * rs, acc[ai][bj][m][1] * rs);
                } else if (wc == 0) {
                    float* rowp = ab + (size_t)row * 32 + 8 * fq;
                    *(f32x4*)(rowp) = acc[ai][0][m][0] * rs; *(f32x4*)(rowp + 4) = acc[ai][0][m][1] * rs;
                }
            }
    }
};
struct EpiScaleBf16 {
    static constexpr bool PERM = true, AFTER_DRAIN = false;
    const float* rs; int from_sumsq; float sc; bf16* O; int ldc;
    __device__ __forceinline__ void operator()(const f32x4 (&acc)[2][2][4][2], const Unit& u, int wr, int wc, int fr, int fq) const {
        const int row0 = u.pm * 256 + wr * 64 + fr, col0 = u.pn * 256 + wc * 32 + 8 * fq;
        float rsv[2][4];
#pragma unroll
        for (int ai = 0; ai < 2; ++ai)
#pragma unroll
            for (int m = 0; m < 4; ++m) rsv[ai][m] = rs[row0 + ai * 128 + m * 16];
#pragma unroll
        for (int ai = 0; ai < 2; ++ai)
#pragma unroll
            for (int m = 0; m < 4; ++m) {
                const int row = row0 + ai * 128 + m * 16; float r = rsv[ai][m];
                if (from_sumsq) r = __builtin_amdgcn_rsqf(r * (1.0f / DM) + RMS_EPS);
                r *= sc; bf16* rowp = O + (size_t)row * ldc + col0;
#pragma unroll
                for (int bj = 0; bj < 2; ++bj) *(v4u*)(rowp + bj * 128) = pack8(acc[ai][bj][m][0] * r, acc[ai][bj][m][1] * r);
            }
    }
};
struct EpiRes {
    static constexpr bool PERM = true, AFTER_DRAIN = false;
    const float* res; const bf16* resb; float* out; bf16* ob; float* sumsq;
    __device__ __forceinline__ void operator()(const f32x4 (&acc)[2][2][4][2], const Unit& u, int wr, int wc, int fr, int fq) const {
        const int row0 = u.pm * 256 + wr * 64 + fr, col0 = u.pn * 256 + wc * 32 + 8 * fq;
#pragma unroll
        for (int ai = 0; ai < 2; ++ai) {
            f32x4 rr[4][2][2];
            if (resb) {
                v4u rb[4][2];
#pragma unroll
                for (int m = 0; m < 4; ++m) { const size_t off = (size_t)(row0 + ai * 128 + m * 16) * DM + col0;
#pragma unroll
                    for (int bj = 0; bj < 2; ++bj) rb[m][bj] = *(const v4u*)(resb + off + bj * 128); }
#pragma unroll
                for (int m = 0; m < 4; ++m)
#pragma unroll
                    for (int bj = 0; bj < 2; ++bj) { const v4u w = rb[m][bj]; rr[m][bj][0] = (f32x4){bflo(w.x), bfhi(w.x), bflo(w.y), bfhi(w.y)}; rr[m][bj][1] = (f32x4){bflo(w.z), bfhi(w.z), bflo(w.w), bfhi(w.w)}; }
            } else {
#pragma unroll
                for (int m = 0; m < 4; ++m) { const size_t off = (size_t)(row0 + ai * 128 + m * 16) * DM + col0;
#pragma unroll
                    for (int bj = 0; bj < 2; ++bj) { rr[m][bj][0] = *(const f32x4*)(res + off + bj * 128); rr[m][bj][1] = *(const f32x4*)(res + off + bj * 128 + 4); } }
            }
            asm volatile("" ::: "memory");
#pragma unroll
            for (int m = 0; m < 4; ++m) {
                const int row = row0 + ai * 128 + m * 16; const size_t off = (size_t)row * DM + col0; float ss = 0.f;
#pragma unroll
                for (int bj = 0; bj < 2; ++bj) {
                    const f32x4 v0 = acc[ai][bj][m][0] + rr[m][bj][0], v1 = acc[ai][bj][m][1] + rr[m][bj][1];
                    if (out) { *(f32x4*)(out + off + bj * 128) = v0; *(f32x4*)(out + off + bj * 128 + 4) = v1; }
                    if (ob) *(v4u*)(ob + off + bj * 128) = pack8(v0, v1);
                    ss += (v0[0] * v0[0] + v0[1] * v0[1]) + (v0[2] * v0[2] + v0[3] * v0[3]) + (v1[0] * v1[0] + v1[1] * v1[1]) + (v1[2] * v1[2] + v1[3] * v1[3]);
                }
                ss += __shfl_xor(ss, 16); ss += __shfl_xor(ss, 32);
                if (fq == 0) atomicAdd(sumsq + row, ss);
            }
            asm volatile("" ::: "memory");
        }
    }
};
struct EpiSwiglu {
    static constexpr bool PERM = true, AFTER_DRAIN = false;
    const float* sumsq; bf16* H;
    __device__ __forceinline__ void operator()(const f32x4 (&acc)[2][2][4][2], const Unit& u, int wr, int wc, int fr, int fq) const {
        const int row0 = u.pm * 256 + wr * 64 + fr, col0 = u.pn * 128 + wc * 32 + 8 * fq;
        float rsv[2][4];
#pragma unroll
        for (int ai = 0; ai < 2; ++ai)
#pragma unroll
            for (int m = 0; m < 4; ++m) rsv[ai][m] = sumsq[row0 + ai * 128 + m * 16];
#pragma unroll
        for (int ai = 0; ai < 2; ++ai)
#pragma unroll
            for (int m = 0; m < 4; ++m) {
                const int row = row0 + ai * 128 + m * 16; const float r = __builtin_amdgcn_rsqf(rsv[ai][m] * (1.0f / DM) + RMS_EPS);
                f32x4 h[2];
#pragma unroll
                for (int n = 0; n < 2; ++n)
#pragma unroll
                    for (int e = 0; e < 4; ++e) { const float g = acc[ai][0][m][n][e] * r, up = acc[ai][1][m][n][e] * r; h[n][e] = siluf(g) * up; }
                *(v4u*)(H + (size_t)row * DFF + col0) = pack8(h[0], h[1]);
            }
    }
};

struct Frame {
    LAS unsigned char* lds;
    volatile LAS unsigned* MISC;
    gu32* ctl;
    int tid, lane, wave, vcu, G;
    const float* in[23]; float* out; unsigned char* ws;
};
#define WSP(T, off) ((T*)(F.ws + (off)))
#define DOP(T, off) ((T*)((unsigned char*)F.out + (off)))

__device__ __forceinline__ void tr_item(const float* W, int K, int Nsrc, int src_col0, const float* gain, bf16* WT, int dst_row0, int k0, LAS float* scr, int lane) {
    float v[32];
#pragma unroll
    for (int i = 0; i < 32; ++i) { const int kk = 2 * i + (lane >> 5); v[i] = (src_col0 >= 0) ? W[(size_t)(k0 + kk) * Nsrc + src_col0 + (lane & 31)] : 0.f; }
    if (gain) {
#pragma unroll
        for (int i = 0; i < 32; ++i) v[i] *= gain[k0 + 2 * i + (lane >> 5)]; }
#pragma unroll
    for (int i = 0; i < 32; ++i) scr[(2 * i + (lane >> 5)) * 33 + (lane & 31)] = v[i];
    LDS_WAIT(); asm volatile("" ::: "memory");
    const int c = lane & 7;
#pragma unroll
    for (int j = 0; j < 4; ++j) { const int n = (lane >> 3) + 8 * j; const LAS float* s = scr + (8 * c) * 33 + n;
        v4u o; o.x = pk2(s[0 * 33], s[1 * 33]); o.y = pk2(s[2 * 33], s[3 * 33]); o.z = pk2(s[4 * 33], s[5 * 33]); o.w = pk2(s[6 * 33], s[7 * 33]);
        *(GAS v4u*)(WT + (size_t)(dst_row0 + n) * K + k0 + 8 * c) = o; }
    LDS_WAIT(); asm volatile("" ::: "memory");
}
__device__ __forceinline__ int win_src_col(int c) {
    if (c < 4096) return c;
    if (c < 5120) return c - 4096 + 4128;
    if (c < 5376) return c - 5120 + 5152;
    if (c < 5632) return c - 5376 + 5408;
    if (c < 5664) return c - 5632 + 4096;
    return -1;
}
__device__ __forceinline__ void row_to_bf16_rstd(const float* xrow, bf16* orow, float* rstd_out, int lane) {
    const GAS f32x4* xr = (const GAS f32x4*)xrow + lane;
    f32x4 v[8]; float s = 0.f;
#pragma unroll
    for (int j = 0; j < 8; ++j) { v[j] = xr[64 * j]; s += (v[j].x * v[j].x + v[j].y * v[j].y) + (v[j].z * v[j].z + v[j].w * v[j].w); }
    s = wave_sum(s);
    if (lane == 0) *rstd_out = 1.0f / sqrtf(s * (1.0f / DM) + RMS_EPS);
    GAS v2u* o8 = (GAS v2u*)orow + lane;
#pragma unroll
    for (int j = 0; j < 8; ++j) { v2u w; w.x = pk2(v[j].x, v[j].y); w.y = pk2(v[j].z, v[j].w); o8[64 * j] = w; }
}

__device__ __forceinline__ void p0_prologue(Frame& F) {
    LAS float* scr = (LAS float*)(F.lds + RING_OFF + F.wave * 16384);
    const int gw = F.vcu * NWAVES + F.wave, NGW = F.G * NWAVES;
    constexpr int I_IN = 32 * (NINP / 32), I_OUT = 32 * 64, I_Q = 32 * 16, I_KV = 32 * 32, I_O = 8 * 64;
    constexpr int NITEMS = I_IN + I_OUT + I_Q + I_KV + I_O;
    for (int it = gw; it < NITEMS; it += NGW) {
        int r = it;
        if (r < I_IN) { const int nblk = NINP / 32, kb = r / nblk, nb = r % nblk; tr_item(F.in[3], DM, NIN, win_src_col(nb * 32), F.in[2], WSP(bf16, WS_WIN), nb * 32, kb * 64, scr, F.lane); continue; } r -= I_IN;
        if (r < I_OUT) { const int kb = r / 64, nb = r % 64; tr_item(F.in[12], DM, DM, nb * 32, nullptr, WSP(bf16, WS_WOUT), nb * 32, kb * 64, scr, F.lane); continue; } r -= I_OUT;
        if (r < I_Q) { const int kb = r / 16, nb = r % 16; tr_item(F.in[15], DM, 512, nb * 32, F.in[13], WSP(bf16, WS_WQ), nb * 32, kb * 64, scr, F.lane); continue; } r -= I_Q;
        if (r < I_KV) { const int kb = r / 32, nb = r % 32; tr_item(F.in[16], DM, 1024, nb * 32, F.in[14], WSP(bf16, WS_WKV), nb * 32, kb * 64, scr, F.lane); continue; } r -= I_KV;
        { const int kb = r / 64, nb = r % 64; tr_item(F.in[17], 512, DM, nb * 32, nullptr, WSP(bf16, WS_WO), nb * 32, kb * 64, scr, F.lane); }
    }
    for (int m = gw; m < SEQ; m += 2 * NGW) {
        const int m2 = m + NGW; const bool two = m2 < SEQ;
        const GAS f32x4* xa = (const GAS f32x4*)(F.in[0] + (size_t)m * DM) + F.lane; const GAS f32x4* xb_ = (const GAS f32x4*)(F.in[0] + (size_t)(two ? m2 : m) * DM) + F.lane;
        f32x4 va[8], vb[8]; float sa = 0.f, sb = 0.f;
#pragma unroll
        for (int j = 0; j < 8; ++j) { va[j] = xa[64 * j]; vb[j] = xb_[64 * j]; }
#pragma unroll
        for (int j = 0; j < 8; ++j) { sa += (va[j].x * va[j].x + va[j].y * va[j].y) + (va[j].z * va[j].z + va[j].w * va[j].w); sb += (vb[j].x * vb[j].x + vb[j].y * vb[j].y) + (vb[j].z * vb[j].z + vb[j].w * vb[j].w); }
        sa = wave_sum(sa); sb = wave_sum(sb);
        if (F.lane == 0) { WSP(float, WS_RSTD1)[m] = 1.0f / sqrtf(sa * (1.0f / DM) + RMS_EPS); if (two) WSP(float, WS_RSTD1)[m2] = 1.0f / sqrtf(sb * (1.0f / DM) + RMS_EPS); }
        GAS v2u* oa = (GAS v2u*)(WSP(bf16, WS_XB) + (size_t)m * DM) + F.lane; GAS v2u* ob = (GAS v2u*)(WSP(bf16, WS_XB) + (size_t)m2 * DM) + F.lane;
#pragma unroll
        for (int j = 0; j < 8; ++j) { v2u w; w.x = pk2(va[j].x, va[j].y); w.y = pk2(va[j].z, va[j].w); oa[64 * j] = w; }
        if (two) {
#pragma unroll
            for (int j = 0; j < 8; ++j) { v2u w; w.x = pk2(vb[j].x, vb[j].y); w.y = pk2(vb[j].z, vb[j].w); ob[64 * j] = w; } }
    }
    for (int m = gw; m < MEMT; m += NGW) row_to_bf16_rstd(F.in[1] + (size_t)m * DM, WSP(bf16, WS_MEMB) + (size_t)m * DM, WSP(float, WS_RSTDM) + m, F.lane);
}
__device__ __forceinline__ void p4_transposes(Frame& F, int b0, int nb) {
    if ((int)blockIdx.x < b0 || (int)blockIdx.x >= b0 + nb) return;
    LAS float* scr = (LAS float*)(F.lds + RING_OFF + F.wave * 16384);
    const int gw = ((int)blockIdx.x - b0) * NWAVES + F.wave, NGW = nb * NWAVES;
    constexpr int I_GU = 32 * (2 * DFF / 32), I_D = (DFF / 64) * 64;
    for (int it = gw; it < I_GU + I_D; it += NGW) {
        int r = it;
        if (r < I_GU) { const int nblk = 2 * DFF / 32, kb = r / nblk, nb = r % nblk; const int row = nb * 32, t = row / 256, w = row % 256;
            const float* src = (w < 128) ? F.in[19] : F.in[20]; const int sc = 128 * t + (w & 127);
            tr_item(src, DM, DFF, sc, F.in[18], WSP(bf16, WS_WGU), row, kb * 64, scr, F.lane); continue; } r -= I_GU;
        { const int kb = r / 64, nb = r % 64; tr_item(F.in[21], DFF, DM, nb * 32, nullptr, WSP(bf16, WS_WD), nb * 32, kb * 64, scr, F.lane); }
    }
}

__device__ __forceinline__ float softplusf(float x) { return x > 20.f ? x : log1pf(__expf(x)); }
__device__ __forceinline__ void dn_combine(Frame& F) {
    const int gw = F.vcu * NWAVES + F.wave, NGW = F.G * NWAVES, lane = F.lane;
    const bf16* OFp = WSP(bf16, WS_OF); const bf16* OBp = WSP(bf16, WS_OB); const bf16* Z = DOP(bf16, DO_Z); bf16* Y = WSP(bf16, WS_XB); const float* gn = F.in[9];
    const int cb = (16 * lane) & 127; float gv[16];
#pragma unroll
    for (int i = 0; i < 16; ++i) gv[i] = gn[cb + i];
    for (int t0 = gw; t0 < SEQ; t0 += 2 * NGW) {
        v4u a[2][2], b[2][2], z[2][2];
#pragma unroll
        for (int k = 0; k < 2; ++k) { const int t = (t0 + k * NGW < SEQ) ? t0 + k * NGW : t0; const size_t off = (size_t)t * 1024 + 16 * lane;
            a[k][0] = *(const v4u*)(OFp + off); a[k][1] = *(const v4u*)(OFp + off + 8); b[k][0] = *(const v4u*)(OBp + off); b[k][1] = *(const v4u*)(OBp + off + 8);
            z[k][0] = *(const v4u*)(Z + off); z[k][1] = *(const v4u*)(Z + off + 8); }
#pragma unroll
        for (int k = 0; k < 2; ++k) {
            const int t = t0 + k * NGW; if (t >= SEQ) break;
            float o[16], zz[16];
#pragma unroll
            for (int i = 0; i < 4; ++i) { o[2 * i] = bflo(a[k][0][i]) + bflo(b[k][0][i]); o[2 * i + 1] = bfhi(a[k][0][i]) + bfhi(b[k][0][i]); o[8 + 2 * i] = bflo(a[k][1][i]) + bflo(b[k][1][i]); o[8 + 2 * i + 1] = bfhi(a[k][1][i]) + bfhi(b[k][1][i]);
                zz[2 * i] = bflo(z[k][0][i]); zz[2 * i + 1] = bfhi(z[k][0][i]); zz[8 + 2 * i] = bflo(z[k][1][i]); zz[8 + 2 * i + 1] = bfhi(z[k][1][i]); }
            float ss = 0.f;
#pragma unroll
            for (int i = 0; i < 16; ++i) ss += o[i] * o[i];
            ss += __shfl_xor(ss, 1); ss += __shfl_xor(ss, 2); ss += __shfl_xor(ss, 4);
            const float rs = __builtin_amdgcn_rsqf(ss * (1.0f / 128.0f) + RMS_EPS);
            float y[16];
#pragma unroll
            for (int i = 0; i < 16; ++i) y[i] = o[i] * rs * gv[i] * siluf(zz[i]);
            v4u w0, w1;
#pragma unroll
            for (int i = 0; i < 4; ++i) { w0[i] = pk2(y[2 * i], y[2 * i + 1]); w1[i] = pk2(y[8 + 2 * i], y[8 + 2 * i + 1]); }
            bf16* yp = Y + (size_t)t * DM + 16 * lane; *(v4u*)yp = w0; *(v4u*)(yp + 8) = w1;
        }
    }
}
__device__ __forceinline__ void final_norm(Frame& F) {
    const int gw = F.vcu * NWAVES + F.wave, NGW = F.G * NWAVES, lane = F.lane;
    const float* ss = (const float*)(F.ws + WS_CTL + CTL_SUMSQ4); const GAS f32x4* g = (const GAS f32x4*)F.in[22]; const bf16* H3 = WSP(bf16, WS_H3B);
    for (int m0 = gw; m0 < SEQ; m0 += 2 * NGW) {
        v4u w[2][4]; float r[2];
#pragma unroll
        for (int k = 0; k < 2; ++k) { const int m = (m0 + k * NGW < SEQ) ? m0 + k * NGW : m0; const GAS v4u* hp = (const GAS v4u*)(H3 + (size_t)m * DM);
            r[k] = ss[m];
#pragma unroll
            for (int j = 0; j < 4; ++j) w[k][j] = hp[64 * j + lane]; }
#pragma unroll
        for (int k = 0; k < 2; ++k) {
            const int m = m0 + k * NGW; if (m >= SEQ) break;
            const float rr = __builtin_amdgcn_rsqf(r[k] * (1.0f / DM) + RMS_EPS);
            GAS f32x4* o = (GAS f32x4*)(F.out + (size_t)m * DM);
#pragma unroll
            for (int j = 0; j < 4; ++j) { const v4u x = w[k][j]; const int c4 = 2 * (64 * j + lane); const f32x4 g0 = g[c4], g1 = g[c4 + 1];
                o[c4] = (f32x4){bflo(x.x) * rr * g0[0], bfhi(x.x) * rr * g0[1], bflo(x.y) * rr * g0[2], bfhi(x.y) * rr * g0[3]};
                o[c4 + 1] = (f32x4){bflo(x.z) * rr * g1[0], bfhi(x.z) * rr * g1[1], bflo(x.w) * rr * g1[2], bfhi(x.w) * rr * g1[3]}; }
        }
    }
}

__device__ __forceinline__ int t5_bucket(int rel) {
    const int n = rel < 0 ? -rel : rel; int b;
    if (n < 8) b = n; else { int k = (31 - __builtin_clz((unsigned)(n * n))) - 6; b = 8 + k; if (b > 15) b = 15; }
    return (rel > 0 ? 16 : 0) + b;
}
template <int MODE  >
__device__ __forceinline__ void attn_unit(Frame& F, const bf16* Q, int qpitch, const bf16* Kp, const bf16* Vp, int kvpitch, bf16* O, int opitch, int q0, int kt_beg, int kt_end, const LAS float* btab, float sink2) {
    LAS unsigned char* Ks = F.lds + RING_OFF; LAS unsigned char* Vs = Ks + 16384;
    const int lane = F.lane, c = lane & 15, g = lane >> 4, qw0 = q0 + 16 * F.wave, tid = F.tid;
    bf16x8 qf[4];
#pragma unroll
    for (int t = 0; t < 4; ++t) qf[t] = *(const bf16x8*)(Q + (size_t)(qw0 + c) * qpitch + 32 * t + 8 * g);
    f32x4 oacc[8];
#pragma unroll
    for (int i = 0; i < 8; ++i) oacc[i] = (f32x4){0.f, 0.f, 0.f, 0.f};
    float mrun = (MODE == 0) ? sink2 : -1e30f, lsum = (MODE == 0 && g == 0) ? 1.0f : 0.0f;
    v4u kpre[2], vpre[2];
#pragma unroll
    for (int i = 0; i < 2; ++i) { const int ci = tid + 512 * i, key = ci >> 4, ch = ci & 15;
        kpre[i] = *(const v4u*)(Kp + (size_t)(64 * kt_beg + key) * kvpitch + ch * 8); vpre[i] = *(const v4u*)(Vp + (size_t)(64 * kt_beg + key) * kvpitch + ch * 8); }
    for (int kt = kt_beg; kt < kt_end; ++kt) {
        __syncthreads();
#pragma unroll
        for (int i = 0; i < 2; ++i) { const int ci = tid + 512 * i, key = ci >> 4, ch = ci & 15;
            *(LAS v4u*)(Ks + key * 256 + ((ch ^ (key & 15)) << 4)) = kpre[i]; *(LAS v4u*)(Vs + key * 256 + ((ch ^ ((key & 7) << 1)) << 4)) = vpre[i]; }
        if (kt + 1 < kt_end) {
#pragma unroll
            for (int i = 0; i < 2; ++i) { const int ci = tid + 512 * i, key = ci >> 4, ch = ci & 15;
                kpre[i] = *(const v4u*)(Kp + (size_t)(64 * (kt + 1) + key) * kvpitch + ch * 8); vpre[i] = *(const v4u*)(Vp + (size_t)(64 * (kt + 1) + key) * kvpitch + ch * 8); } }
        __syncthreads();
        bool rel_ok = true;
        if (MODE == 0) rel_ok = (64 * kt <= qw0 + 15 + 128) && (64 * kt + 63 >= qw0 - 128);
        if (!rel_ok) continue;
        f32x4 s[4];
#pragma unroll
        for (int mt = 0; mt < 4; ++mt) s[mt] = (f32x4){0.f, 0.f, 0.f, 0.f};
#pragma unroll
        for (int t = 0; t < 4; ++t)
#pragma unroll
            for (int mt = 0; mt < 4; ++mt) { const bf16x8 kf = *(const LAS bf16x8*)(Ks + (16 * mt + c) * 256 + (((4 * t + g) ^ c) << 4));
                s[mt] = __builtin_amdgcn_mfma_f32_16x16x32_bf16(kf, qf[t], s[mt], 0, 0, 0); }
        float tmax = -INFINITY;
#pragma unroll
        for (int mt = 0; mt < 4; ++mt)
#pragma unroll
            for (int r = 0; r < 4; ++r) {
                if (MODE == 0) { const int rel = (64 * kt + 16 * mt + 4 * g + r) - (qw0 + c); const bool ok = (rel >= -128) && (rel <= 128);
                    const int ri = ok ? rel + 128 : 128; const float bv = btab[ri]; s[mt][r] = ok ? s[mt][r] + bv : -INFINITY; }
                tmax = fmaxf(tmax, s[mt][r]); }
        tmax = fmaxf(tmax, __shfl_xor(tmax, 16)); tmax = fmaxf(tmax, __shfl_xor(tmax, 32));
        const float mnew = fmaxf(mrun, tmax), alpha = __builtin_amdgcn_exp2f(mrun - mnew); mrun = mnew; float ps = 0.f;
#pragma unroll
        for (int mt = 0; mt < 4; ++mt)
#pragma unroll
            for (int r = 0; r < 4; ++r) { const float p = __builtin_amdgcn_exp2f(s[mt][r] - mnew); s[mt][r] = p; ps += p; }
        lsum = lsum * alpha + ps;
#pragma unroll
        for (int i = 0; i < 8; ++i) oacc[i] = oacc[i] * alpha;
        bf16x8 pf[2];
#pragma unroll
        for (int t2 = 0; t2 < 2; ++t2) { v4u w; w.x = cvtpk(s[2 * t2][0], s[2 * t2][1]); w.y = cvtpk(s[2 * t2][2], s[2 * t2][3]); w.z = cvtpk(s[2 * t2 + 1][0], s[2 * t2 + 1][1]); w.w = cvtpk(s[2 * t2 + 1][2], s[2 * t2 + 1][3]);
            pf[t2] = __builtin_bit_cast(bf16x8, w); }
        const int q4 = c >> 2, p4 = c & 3;
#pragma unroll
        for (int t2 = 0; t2 < 2; ++t2)
#pragma unroll
            for (int mo = 0; mo < 8; ++mo) {
                const int k1 = 32 * t2 + 4 * g + q4, k2 = k1 + 16, chn = 2 * mo + (p4 >> 1);
                const s16x4 lo = __builtin_bit_cast(s16x4, __builtin_amdgcn_ds_read_tr16_b64_v4i16((LAS s16x4*)(Vs + k1 * 256 + ((chn ^ ((k1 & 7) << 1)) << 4) + (p4 & 1) * 8)));
                const s16x4 hi = __builtin_bit_cast(s16x4, __builtin_amdgcn_ds_read_tr16_b64_v4i16((LAS s16x4*)(Vs + k2 * 256 + ((chn ^ ((k2 & 7) << 1)) << 4) + (p4 & 1) * 8)));
                const bf16x8 vf = (bf16x8){lo[0], lo[1], lo[2], lo[3], hi[0], hi[1], hi[2], hi[3]};
                oacc[mo] = __builtin_amdgcn_mfma_f32_16x16x32_bf16(vf, pf[t2], oacc[mo], 0, 0, 0); }
    }
    lsum += __shfl_xor(lsum, 16); lsum += __shfl_xor(lsum, 32);
    const float inv = 1.0f / lsum;
#pragma unroll
    for (int mo = 0; mo < 8; ++mo) { v2u w; w.x = cvtpk(oacc[mo][0] * inv, oacc[mo][1] * inv); w.y = cvtpk(oacc[mo][2] * inv, oacc[mo][3] * inv);
        *(v2u*)(O + (size_t)(qw0 + c) * opitch + 16 * mo + 4 * g) = w; }
}
__device__ __forceinline__ void swa_phase(Frame& F, int b0, int nb) {
    LAS float* btab = (LAS float*)(F.lds + RING_OFF + 32768);
    const bf16* QS = DOP(bf16, DO_QSW); const bf16* KV = DOP(bf16, DO_KVSW); bf16* Y = WSP(bf16, WS_XB);
    (void)b0; (void)nb;
    unsigned* qctr = (unsigned*)(F.ctl + CW_SWAQ);
    for (;;) {
        __syncthreads();
        if (F.tid == 0) F.MISC[12] = __hip_atomic_fetch_add(qctr, 1u, __ATOMIC_RELAXED, __HIP_MEMORY_SCOPE_AGENT);
        __syncthreads();
        const int u = (int)F.MISC[12];
        if (u >= SWH * (SEQ / 128)) break;
        const int h = u & 7, qb = u >> 3, kvh = h >> 2;
        __syncthreads();
        if (F.tid < 257) btab[F.tid] = F.in[11][t5_bucket(F.tid - 128) * 8 + h] * LOG2E;
        __syncthreads();
        int kb = 2 * qb - 2, ke = 2 * qb + 4; if (kb < 0) kb = 0; if (ke > SEQ / 64) ke = SEQ / 64;
        attn_unit<0>(F, QS + h * 128, 1024, KV + kvh * 128, KV + 256 + kvh * 128, 512, Y + 1024 + h * 128, DM, qb * 128, kb, ke, btab, F.in[10][h] * LOG2E);
    }
}
__device__ __forceinline__ void mem_attn_phase(Frame& F) {
    const bf16* QM = WSP(bf16, WS_QM); const bf16* KVm = WSP(bf16, WS_KVM); bf16* OM = WSP(bf16, WS_OM);
    for (int u = blockIdx.x; u < MEMH * (SEQ / 128); u += F.G) {
        const int h = u & 3, qb = u >> 2;
        attn_unit<1>(F, QM + h * 128, 512, KVm + h * 128, KVm + 512 + h * 128, 1024, OM + h * 128, 512, qb * 128, 0, 4, nullptr, 0.f);
    }
}

typedef float f32x16 __attribute__((ext_vector_type(16)));
constexpr int DX_W = 0, DX_K = 16384, DX_U = 32768, DX_Q = 49152, DX_A = 65536, DX_BYTES = 73728;
constexpr size_t WS_GL = 1 * MiB + 128 * 1024;
constexpr int L_RAW = 0, RAW_PITCH = 784, L_MTF = 0, L_MTB = 16384, L_TB = 32768, TB_PITCH = 144, TB_SZ = 9216;
constexpr int L_QB = 69632, L_KB = 86016, L_KT = 102400, L_VT = 120832, L_PART = 139264, L_SC = 143360;
constexpr int L_CW = 145408;
static_assert(L_SC + 2048 <= L_CW && L_CW + 7680 <= LDSCTL_OFF, "prep LDS map");
__device__ __forceinline__ unsigned char* dnx_rec(Frame& F, int dir, int hd, int cn) { return F.ws + WS_DNX + (size_t)((dir * 8 + hd) * 256 + cn) * DX_BYTES; }
__device__ __forceinline__ v4u pack8f(const float* v) { v4u w; w.x = cvtpk(v[0], v[1]); w.y = cvtpk(v[2], v[3]); w.z = cvtpk(v[4], v[5]); w.w = cvtpk(v[6], v[7]); return w; }

__device__ __forceinline__ bf16x8 cvt8(const f32x16& v, int o) { v4u w; w.x = cvtpk(v[o], v[o + 1]); w.y = cvtpk(v[o + 2], v[o + 3]); w.z = cvtpk(v[o + 4], v[o + 5]); w.w = cvtpk(v[o + 6], v[o + 7]); return __builtin_bit_cast(bf16x8, w); }
__device__ __forceinline__ bf16x8 cvt8f(f32x4 a, f32x4 b) { v4u w; w.x = cvtpk(a[0], a[1]); w.y = cvtpk(a[2], a[3]); w.z = cvtpk(b[0], b[1]); w.w = cvtpk(b[2], b[3]); return __builtin_bit_cast(bf16x8, w); }
template <int dir> __device__ __forceinline__ void dn_solve_and_write(LAS unsigned char* lds, int lane) {
    const LAS float* MT = (const LAS float*)(lds + (dir ? L_MTB : L_MTF));
    LAS float* T0 = (LAS float*)(lds + L_TB + dir * 2 * TB_SZ);
    LAS float* Trow = T0 + lane * 68;
    const int blk = lane >> 5, cb = 32 * blk;
#pragma unroll 1
    for (int jr = 7; jr >= 0; --jr) {
        const int j0 = cb + 4 * jr;
        float a0 = (lane == j0) ? 1.f : 0.f, a1 = (lane == j0 + 1) ? 1.f : 0.f, a2 = (lane == j0 + 2) ? 1.f : 0.f, a3 = (lane == j0 + 3) ? 1.f : 0.f;
        const LAS float* mr = MT + j0 * 64;
#pragma unroll 1
        for (int sr = jr + 1; sr < 8; ++sr) {
            const int s0 = cb + 4 * sr;
            const f32x4 tv = *(const LAS f32x4*)(Trow + s0);
            const f32x4 m0 = *(const LAS f32x4*)(mr + s0), m1 = *(const LAS f32x4*)(mr + 64 + s0), m2 = *(const LAS f32x4*)(mr + 128 + s0), m3 = *(const LAS f32x4*)(mr + 192 + s0);
            a0 -= (tv[0] * m0[0] + tv[1] * m0[1]) + (tv[2] * m0[2] + tv[3] * m0[3]);
            a1 -= (tv[0] * m1[0] + tv[1] * m1[1]) + (tv[2] * m1[2] + tv[3] * m1[3]);
            a2 -= (tv[0] * m2[0] + tv[1] * m2[1]) + (tv[2] * m2[2] + tv[3] * m2[3]);
            a3 -= (tv[0] * m3[0] + tv[1] * m3[1]) + (tv[2] * m3[2] + tv[3] * m3[3]);
        }
        const f32x4 d0 = *(const LAS f32x4*)(mr + j0), d1 = *(const LAS f32x4*)(mr + 64 + j0), d2 = *(const LAS f32x4*)(mr + 128 + j0);
        const float t3 = a3, t2 = a2 - t3 * d2[3], t1 = a1 - t2 * d1[2] - t3 * d1[3], t0 = a0 - t1 * d0[1] - t2 * d0[2] - t3 * d0[3];
        *(LAS f32x4*)(Trow + j0) = (f32x4){t0, t1, t2, t3};
    }
    if (blk == 0) {
#pragma unroll
        for (int q = 8; q < 16; ++q) *(LAS f32x4*)(Trow + 4 * q) = (f32x4){0.f, 0.f, 0.f, 0.f}; }
    asm volatile("s_waitcnt lgkmcnt(0)" ::: "memory");
    {
        const int r = lane & 31, lh = lane >> 5;
        f32x16 Y;
#pragma unroll
        for (int e = 0; e < 16; ++e) Y[e] = 0.f;
#pragma unroll
        for (int kk = 0; kk < 2; ++kk) {
            float av[8], bv[8];
#pragma unroll
            for (int jj = 0; jj < 8; ++jj) { const int k = 16 * kk + 8 * lh + jj; av[jj] = MT[k * 64 + 32 + r]; bv[jj] = T0[k * 68 + r]; }
            Y = __builtin_amdgcn_mfma_f32_32x32x16_bf16(cvt8f((f32x4){av[0], av[1], av[2], av[3]}, (f32x4){av[4], av[5], av[6], av[7]}), cvt8f((f32x4){bv[0], bv[1], bv[2], bv[3]}, (f32x4){bv[4], bv[5], bv[6], bv[7]}), Y, 0, 0, 0);
        }
        f32x16 Z;
#pragma unroll
        for (int e = 0; e < 16; ++e) Z[e] = 0.f;
#pragma unroll
        for (int kk = 0; kk < 2; ++kk) {
            const f32x4 t0 = *(const LAS f32x4*)(T0 + (32 + r) * 68 + 32 + 16 * kk + 4 * lh), t1 = *(const LAS f32x4*)(T0 + (32 + r) * 68 + 32 + 16 * kk + 8 + 4 * lh);
            Z = __builtin_amdgcn_mfma_f32_32x32x16_bf16(cvt8f(t0, t1), cvt8(Y, 8 * kk), Z, 0, 0, 0);
        }
#pragma unroll
        for (int e = 0; e < 16; ++e) T0[(32 + (e & 3) + 8 * (e >> 2) + 4 * lh) * 68 + r] = -Z[e];
    }
    asm volatile("s_waitcnt lgkmcnt(0)" ::: "memory");
    f32x4 tr[16];
#pragma unroll
    for (int q = 0; q < 16; ++q) tr[q] = *(const LAS f32x4*)(Trow + 4 * q);
    asm volatile("s_waitcnt lgkmcnt(0)" ::: "memory");
    const LAS float* sc = (const LAS float*)(lds + L_SC);
    const LAS float* cU = sc + (dir ? 384 : 256); const LAS float* cW = sc + (dir ? 448 : 320);
    const int pos = dir ? 63 - lane : lane;
    LAS unsigned char* tu = lds + L_TB + dir * 2 * TB_SZ + pos * TB_PITCH; LAS unsigned char* tw = tu + TB_SZ;
#pragma unroll
    for (int q = 0; q < 8; ++q) {
        float u8[8], w8[8];
#pragma unroll
        for (int e = 0; e < 8; ++e) { const int s = 8 * q + e, sp = dir ? 63 - s : s; const float t = tr[sp >> 2][sp & 3]; u8[e] = t * cU[s]; w8[e] = t * cW[s]; }
        *(LAS v4u*)(tu + q * 16) = pack8f(u8); *(LAS v4u*)(tw + q * 16) = pack8f(w8);
    }
}

struct PrepRegs { v4u raw[7]; };
__device__ __forceinline__ void prep_load(Frame& F, int u, int tid, int lane, PrepRegs& R) {
    const int cn = u >> 3, hd = u & 7; const bf16* QKV = WSP(bf16, WS_QKV);
#pragma unroll
    for (int k = 0; k < 7; ++k) { const int ci = tid + 512 * k; const int row = ci / 48, cc = ci % 48, seg = cc >> 4, ch = (cc & 15) * 8, tok = 64 * cn - 2 + row;
        v4u v = (v4u){0u, 0u, 0u, 0u};
        if (ci < 68 * 48 && tok >= 0 && tok < SEQ) v = *(const v4u*)(QKV + (size_t)tok * 3072 + seg * 1024 + hd * 128 + ch);
        R.raw[k] = v; }
}
#define DNX_ST(ptr, val) do { const v4u v_ = (val); if (MASK & 32) *(v4u*)(ptr) = v_; else asm volatile("" :: "v"(v_)); } while (0)
template <int MASK> __device__ __forceinline__ void dn_prep_unit(Frame& F, int cn, int hd, PrepRegs& PR, int next_u) {
    LAS unsigned char* lds = F.lds; int tid = F.tid, lane = F.lane; const int wave = F.wave;
    asm volatile("" : "+v"(tid), "+v"(lane));
    LAS float* sc = (LAS float*)(lds + L_SC);
    __syncthreads();
    if (MASK & 1) {
    float abv[4] = {0.f, 0.f, 0.f, 0.f};
    if (wave == 0) { const float* ab = WSP(float, WS_AB) + (size_t)(64 * cn + lane) * 32; abv[0] = ab[hd]; abv[1] = ab[8 + hd]; abv[2] = ab[16 + hd]; abv[3] = ab[24 + hd]; }
    prep_load(F, cn * 8 + hd, tid, lane, PR);
#pragma unroll
    for (int k = 0; k < 7; ++k) { const int ci = tid + 512 * k; const int row = ci / 48, cc = ci % 48, seg = cc >> 4, ch = (cc & 15) * 8;
        if (ci < 68 * 48) *(LAS v4u*)(lds + L_RAW + row * RAW_PITCH + (seg * 128 + ch) * 2) = PR.raw[k]; }
    if (wave == 0) {
        const float bfv = 1.0f / (1.0f + __expf(-abv[0])), bbv = 1.0f / (1.0f + __expf(-abv[1]));
        const float gf = -__expf(F.in[5][hd]) * softplusf(abv[2] + F.in[7][hd]), gb = -__expf(F.in[6][hd]) * softplusf(abv[3] + F.in[8][hd]);
        float Gf = gf, Gb = gb;
#pragma unroll
        for (int o = 1; o < 64; o <<= 1) { const float a = __shfl_up(Gf, o), b = __shfl_down(Gb, o); if (lane >= o) Gf += a; if (lane + o < 64) Gb += b; }
        sc[lane] = Gf; sc[64 + lane] = Gb; sc[128 + lane] = bfv; sc[192 + lane] = bbv;
        sc[256 + lane] = bfv; sc[320 + lane] = -bfv * __expf(Gf); sc[384 + lane] = bbv; sc[448 + lane] = -bbv * __expf(Gb);
        float* GL = WSP(float, WS_GL);
        if (MASK & 32) { if (lane == 63) GL[(0 * 8 + hd) * 256 + cn] = __expf(Gf);
        if (lane == 0) GL[(1 * 8 + hd) * 256 + cn] = __expf(Gb); }
    }
    }
    __syncthreads();
    asm volatile("" : "+v"(tid), "+v"(lane));
    if (MASK & 2) {
        const int t = wave, pos = lane; const LAS float* cw = (const LAS float*)(lds + L_CW) + 16 * t;
        float qv[16], kv[16], vv[16];
#pragma unroll
        for (int seg = 0; seg < 3; ++seg) {
            float a[16];
#pragma unroll
            for (int i = 0; i < 16; ++i) a[i] = 0.f;
#pragma unroll
            for (int j = 0; j < 5; ++j) {
                const LAS unsigned char* rp = lds + L_RAW + (pos + j) * RAW_PITCH + (seg * 128 + 16 * t) * 2;
                const v4u r0 = *(const LAS v4u*)rp, r1 = *(const LAS v4u*)(rp + 16);
                const LAS float* w = cw + j * 384 + seg * 128;
#pragma unroll
                for (int i = 0; i < 4; ++i) { a[2 * i] += w[2 * i] * bflo(r0[i]); a[2 * i + 1] += w[2 * i + 1] * bfhi(r0[i]); a[8 + 2 * i] += w[8 + 2 * i] * bflo(r1[i]); a[8 + 2 * i + 1] += w[8 + 2 * i + 1] * bfhi(r1[i]); }
            }
#pragma unroll
            for (int i = 0; i < 16; ++i) { const float s = siluf(a[i]); if (seg == 0) qv[i] = s; else if (seg == 1) kv[i] = s; else vv[i] = s; }
        }
        float sq = 0.f, sk = 0.f;
#pragma unroll
        for (int i = 0; i < 16; ++i) { sq += qv[i] * qv[i]; sk += kv[i] * kv[i]; }
        LAS float* part = (LAS float*)(lds + L_PART);
        part[t * 64 + pos] = sq; part[512 + t * 64 + pos] = sk;
        __syncthreads();
        float tq = 0.f, tk = 0.f;
#pragma unroll
        for (int i = 0; i < 8; ++i) { tq += part[i * 64 + pos]; tk += part[512 + i * 64 + pos]; }
        const float rq = (1.0f / sqrtf(tq + 1e-6f)) * 0.08838834764831845f, rk = 1.0f / sqrtf(tk + 1e-6f);
#pragma unroll
        for (int i = 0; i < 16; ++i) { qv[i] *= rq; kv[i] *= rk; }
        *(LAS v4u*)(lds + L_QB + pos * 256 + (((2 * t) ^ (pos & 15)) << 4)) = pack8f(qv); *(LAS v4u*)(lds + L_QB + pos * 256 + (((2 * t + 1) ^ (pos & 15)) << 4)) = pack8f(qv + 8);
        *(LAS v4u*)(lds + L_KB + pos * 256 + (((2 * t) ^ (pos & 15)) << 4)) = pack8f(kv); *(LAS v4u*)(lds + L_KB + pos * 256 + (((2 * t + 1) ^ (pos & 15)) << 4)) = pack8f(kv + 8);
#pragma unroll
        for (int i = 0; i < 16; ++i) { *(LAS unsigned short*)(lds + L_KT + (16 * t + i) * TB_PITCH + pos * 2) = (unsigned short)f2bf(kv[i]); *(LAS unsigned short*)(lds + L_VT + (16 * t + i) * TB_PITCH + pos * 2) = (unsigned short)f2bf(vv[i]); }
        const float ef = __expf(sc[pos]), eb = __expf(sc[64 + pos]); const int mt = pos >> 5;
#pragma unroll
        for (int dir = 0; dir < 2; ++dir) { const float e = dir ? eb : ef; unsigned char* rec = dnx_rec(F, dir, hd, cn) + DX_Q;
#pragma unroll
            for (int lh = 0; lh < 2; ++lh) { float o8[8];
#pragma unroll
                for (int j = 0; j < 8; ++j) o8[j] = qv[8 * (j >> 2) + 4 * lh + (j & 3)] * e;
                DNX_ST(rec + ((mt * 8 + t) * 64 + 32 * lh + (pos & 31)) * 16, pack8f(o8)); } }
    }
    __syncthreads();
    asm volatile("" : "+v"(tid), "+v"(lane));
    if (MASK & 4) {
        const int r = lane & 31, lh = lane >> 5, x = wave & 3, ta = x >> 1, tb = x & 1;
        const LAS unsigned char* Ab = lds + L_KB + (32 * ta + r) * 256; const LAS unsigned char* Bb = lds + (wave < 4 ? L_KB : L_QB) + (32 * tb + r) * 256;
        f32x16 acc;
#pragma unroll
        for (int i = 0; i < 16; ++i) acc[i] = 0.f;
#pragma unroll
        for (int kk = 0; kk < 8; ++kk) { const int ch = ((2 * kk + lh) ^ (r & 15)) << 4;
            acc = __builtin_amdgcn_mfma_f32_32x32x16_bf16(*(const LAS bf16x8*)(Ab + ch), *(const LAS bf16x8*)(Bb + ch), acc, 0, 0, 0); }
        const int b = 32 * tb + r;
        if (wave < 4) {
            const float Gfb = sc[b], Gbb = sc[64 + b];
#pragma unroll
            for (int q = 0; q < 4; ++q) { const int a0 = 32 * ta + 8 * q + 4 * lh; f32x4 mf, mb;
#pragma unroll
                for (int e = 0; e < 4; ++e) { const int a = a0 + e; const float kkv = acc[4 * q + e];
                    const float vf = sc[128 + a] * kkv * __expf(fminf(sc[a] - Gfb, 0.f)), vb = sc[192 + a] * kkv * __expf(fminf(sc[64 + a] - Gbb, 0.f));
                    mf[e] = (a > b) ? vf : 0.f; mb[3 - e] = (a < b) ? vb : 0.f; }
                *(LAS f32x4*)(lds + L_MTF + (b * 64 + a0) * 4) = mf; *(LAS f32x4*)(lds + L_MTB + ((63 - b) * 64 + 60 - a0) * 4) = mb; }
        } else {
            const float Gfc = sc[b], Gbc = sc[64 + b];
#pragma unroll
            for (int dir = 0; dir < 2; ++dir) { unsigned char* rec = dnx_rec(F, dir, hd, cn) + DX_A;
#pragma unroll
                for (int s2 = 0; s2 < 2; ++s2) { float o8[8];
#pragma unroll
                    for (int j = 0; j < 8; ++j) { const int s = 32 * ta + 16 * s2 + 8 * (j >> 2) + 4 * lh + (j & 3); const float v = acc[8 * s2 + j];
                        const float ev = v * __expf(fminf(dir ? Gbc - sc[64 + s] : Gfc - sc[s], 0.f)); o8[j] = (dir ? (s >= b) : (s <= b)) ? ev : 0.f; }
                    DNX_ST(rec + ((tb * 4 + 2 * ta + s2) * 64 + lane) * 16, pack8f(o8)); } }
        }
    }
    __syncthreads();
    asm volatile("" : "+v"(tid), "+v"(lane));
    if (!(MASK & 8)) {} else if (wave == 0) dn_solve_and_write<0>(lds, lane);
    else if (wave == 1) dn_solve_and_write<1>(lds, lane);
    else {
        const int r = lane & 31, lh = lane >> 5;
        for (int f = wave - 2; f < 32; f += 6) { const int dir = f >> 4, m = (f >> 2) & 3, t = f & 3; const int dk = 32 * m + r;
            const v2u k0 = *(const LAS v2u*)(lds + L_KT + dk * TB_PITCH + (16 * t + 4 * lh) * 2), k1 = *(const LAS v2u*)(lds + L_KT + dk * TB_PITCH + (16 * t + 8 + 4 * lh) * 2);
            const float Gl = dir ? sc[64] : sc[63]; const LAS float* Gs = sc + (dir ? 64 : 0) + 16 * t + 4 * lh; float o8[8];
            o8[0] = bflo(k0.x) * __expf(Gl - Gs[0]); o8[1] = bfhi(k0.x) * __expf(Gl - Gs[1]); o8[2] = bflo(k0.y) * __expf(Gl - Gs[2]); o8[3] = bfhi(k0.y) * __expf(Gl - Gs[3]);
            o8[4] = bflo(k1.x) * __expf(Gl - Gs[8]); o8[5] = bfhi(k1.x) * __expf(Gl - Gs[9]); o8[6] = bflo(k1.y) * __expf(Gl - Gs[10]); o8[7] = bfhi(k1.y) * __expf(Gl - Gs[11]);
            DNX_ST(dnx_rec(F, dir, hd, cn) + DX_K + ((m * 4 + t) * 64 + lane) * 16, pack8f(o8)); }
    }
    __syncthreads();
    asm volatile("" : "+v"(tid), "+v"(lane));
    if (MASK & 16) {
        const int dir = wave >> 2, x = wave & 3, r = lane & 31, lh = lane >> 5;
        const LAS unsigned char* Tu = lds + L_TB + (dir ? 2 : 0) * TB_SZ; const LAS unsigned char* Tw = Tu + TB_SZ;
        unsigned char* rec = dnx_rec(F, dir, hd, cn);
#pragma unroll
        for (int mt = 0; mt < 2; ++mt) {
            f32x16 aw, au;
#pragma unroll
            for (int i = 0; i < 16; ++i) { aw[i] = 0.f; au[i] = 0.f; }
#pragma unroll
            for (int kk = 0; kk < 4; ++kk) { const int so = (16 * kk + 8 * lh) * 2;
                aw = __builtin_amdgcn_mfma_f32_32x32x16_bf16(*(const LAS bf16x8*)(lds + L_KT + (32 * x + r) * TB_PITCH + so), *(const LAS bf16x8*)(Tw + (32 * mt + r) * TB_PITCH + so), aw, 0, 0, 0);
                au = __builtin_amdgcn_mfma_f32_32x32x16_bf16(*(const LAS bf16x8*)(Tu + (32 * mt + r) * TB_PITCH + so), *(const LAS bf16x8*)(lds + L_VT + (32 * x + r) * TB_PITCH + so), au, 0, 0, 0); }
            float tmp[16];
#pragma unroll
            for (int i = 0; i < 16; ++i) tmp[i] = aw[i];
            DNX_ST(rec + DX_W + ((mt * 8 + 2 * x) * 64 + lane) * 16, pack8f(tmp)); DNX_ST(rec + DX_W + ((mt * 8 + 2 * x + 1) * 64 + lane) * 16, pack8f(tmp + 8));
#pragma unroll
            for (int i = 0; i < 16; ++i) tmp[i] = au[i];
            DNX_ST(rec + DX_U + ((x * 2 + mt) * 64 + lane) * 32, pack8f(tmp)); DNX_ST(rec + DX_U + ((x * 2 + mt) * 64 + lane) * 32 + 16, pack8f(tmp + 8));
        }
    }
}
#undef DNX_ST
template <int MASK> __device__ __forceinline__ void dn_prep_phase(Frame& F) {
    PrepRegs PR; int u = blockIdx.x; int cur_hd = -1;
    for (; u < 256 * DNH; u += F.G) {
        const int hd = u & 7;
        if (hd != cur_hd) {
            __syncthreads();
            for (int i = F.tid; i < 5 * 384; i += NWAVES * 64) { const int j = i / 384, c = i % 384; ((LAS float*)(F.lds + L_CW))[i] = F.in[4][j * 3072 + (c >> 7) * 1024 + hd * 128 + (c & 127)]; }
            cur_hd = hd;
        }
        dn_prep_unit<MASK>(F, u >> 3, hd, PR, u + F.G);
    }
}


constexpr int NSEG = 16, SEGL = 16;
constexpr size_t WS_PF = 176 * MiB, WS_RG = 184 * MiB, WS_SIN = 24 * MiB;
constexpr int SLOT1 = 49152, SLOT3 = 73728, L_GLS = 147456;
#define DN_WAIT(V) asm volatile("s_waitcnt vmcnt(" #V ") lgkmcnt(0)" ::: "memory")
#define DN_BAR() do { __builtin_amdgcn_s_barrier(); asm volatile("" ::: "memory"); } while (0)
__device__ __forceinline__ int seg_chunk(int dir, int g, int i) { const int n = SEGL * g + i; return dir ? 255 - n : n; }
__device__ __forceinline__ void u_to_acc(f32x16& a, const LAS unsigned char* up) {
    const v4u u0 = *(const LAS v4u*)up, u1 = *(const LAS v4u*)(up + 16);
#pragma unroll
    for (int i = 0; i < 4; ++i) { a[2 * i] = bflo(u0[i]); a[2 * i + 1] = bfhi(u0[i]); a[8 + 2 * i] = bflo(u1[i]); a[8 + 2 * i + 1] = bfhi(u1[i]); }
}
template <bool OUT>
__device__ __forceinline__ void dn_step(f32x16 (&S)[4], f32x16 (&aV)[2], f32x16 (&aO)[2], const LAS unsigned char* buf, float gl) {
#pragma unroll
    for (int t = 0; t < 8; ++t) { const bf16x8 sb = cvt8(S[t >> 1], 8 * (t & 1));
#pragma unroll
        for (int mt = 0; mt < 2; ++mt) {
            aV[mt] = __builtin_amdgcn_mfma_f32_32x32x16_bf16(*(const LAS bf16x8*)(buf + DX_W + (mt * 8 + t) * 1024), sb, aV[mt], 0, 0, 0);
            if (OUT) aO[mt] = __builtin_amdgcn_mfma_f32_32x32x16_bf16(*(const LAS bf16x8*)(buf + DX_Q + (mt * 8 + t) * 1024), sb, aO[mt], 0, 0, 0); } }
    bf16x8 vb[4];
#pragma unroll
    for (int t = 0; t < 4; ++t) vb[t] = cvt8(aV[t >> 1], 8 * (t & 1));
#pragma unroll
    for (int m = 0; m < 4; ++m) S[m] = S[m] * gl;
#pragma unroll
    for (int t = 0; t < 4; ++t) {
#pragma unroll
        for (int m = 0; m < 4; ++m) S[m] = __builtin_amdgcn_mfma_f32_32x32x16_bf16(*(const LAS bf16x8*)(buf + DX_K + (m * 4 + t) * 1024), vb[t], S[m], 0, 0, 0);
        if (OUT) {
#pragma unroll
            for (int mt = 0; mt < 2; ++mt) aO[mt] = __builtin_amdgcn_mfma_f32_32x32x16_bf16(*(const LAS bf16x8*)(buf + DX_A + (mt * 4 + t) * 1024), vb[t], aO[mt], 0, 0, 0); } }
}

__device__ __forceinline__ void dn_pass1(Frame& F) {
    LAS unsigned char* lds = F.lds; const int lane = F.lane, wave = F.wave, r = lane & 31, lh = lane >> 5, part = wave >> 2, d = wave & 3;
    LAS float* gls = (LAS float*)(lds + L_GLS);
    for (int unit = blockIdx.x; unit < 16 * NSEG; unit += F.G) {
        const int dir = unit >> 7, hd = (unit >> 4) & 7, g = unit & 15;
        DN_WAIT(0); __syncthreads();
        if (F.tid < SEGL) gls[F.tid] = WSP(float, WS_GL)[(dir * 8 + hd) * 256 + seg_chunk(dir, g, F.tid)];
        DN_WAIT(0);
        f32x16 S[4];
#pragma unroll
        for (int m = 0; m < 4; ++m)
#pragma unroll
            for (int i = 0; i < 16; ++i) S[m][i] = (part && (32 * m + (i & 3) + 8 * (i >> 2) + 4 * lh == 32 * d + r)) ? 1.f : 0.f;
#define P1_ISSUE(i) do { const unsigned char* src_ = dnx_rec(F, dir, hd, seg_chunk(dir, g, (i))) + lane * 16; LAS unsigned char* dst_ = lds + ((i) % 3) * SLOT1; \
            _Pragma("unroll") for (int k_ = 0; k_ < 6; ++k_) { const int p_ = wave + 8 * k_; __builtin_amdgcn_global_load_lds((const unsigned*)(src_ + p_ * 1024), (LAS unsigned*)(dst_ + p_ * 1024), 16, 0, 0); } } while (0)
        P1_ISSUE(0); P1_ISSUE(1);
        for (int i = 0; i < SEGL; ++i) {
            if (i + 1 < SEGL) DN_WAIT(6); else DN_WAIT(0);
            DN_BAR();
            if (i + 2 < SEGL) P1_ISSUE(i + 2);
            const LAS unsigned char* buf = lds + (i % 3) * SLOT1 + lane * 16;
            f32x16 aV[2], aO[2];
#pragma unroll
            for (int mt = 0; mt < 2; ++mt) {
                if (part == 0) u_to_acc(aV[mt], lds + (i % 3) * SLOT1 + DX_U + ((d * 2 + mt) * 64 + lane) * 32);
                else {
#pragma unroll
                    for (int e = 0; e < 16; ++e) aV[mt][e] = 0.f; } }
            dn_step<false>(S, aV, aO, buf, gls[i]);
        }
#undef P1_ISSUE
        DN_WAIT(0); DN_BAR();
        if (part == 0) {
            float* rg = (float*)(F.ws + WS_RG) + (size_t)unit * 16384;
#pragma unroll
            for (int m = 0; m < 4; ++m)
#pragma unroll
                for (int q = 0; q < 4; ++q) *(f32x4*)(rg + ((d * 4 + m) * 64 + lane) * 16 + 4 * q) = (f32x4){S[m][4 * q], S[m][4 * q + 1], S[m][4 * q + 2], S[m][4 * q + 3]};
        } else {
#pragma unroll
            for (int m = 0; m < 4; ++m)
#pragma unroll
                for (int i = 0; i < 16; ++i) *(LAS unsigned short*)(lds + (32 * m + (i & 3) + 8 * (i >> 2) + 4 * lh) * 272 + (32 * d + r) * 2) = (unsigned short)f2bf(S[m][i]);
        }
        DN_WAIT(0); DN_BAR();
        if (part == 1) {
            unsigned char* pf = F.ws + WS_PF + (size_t)unit * 32768;
#pragma unroll
            for (int k = 0; k < 8; ++k) { const int f = d * 8 + k, m = f >> 3, t = f & 7;
                const v2u a = *(const LAS v2u*)(lds + (32 * m + r) * 272 + (16 * t + 4 * lh) * 2), b = *(const LAS v2u*)(lds + (32 * m + r) * 272 + (16 * t + 8 + 4 * lh) * 2);
                *(v4u*)(pf + (f * 64 + lane) * 16) = (v4u){a.x, a.y, b.x, b.y}; }
        }
    }
}
__device__ __forceinline__ void dn_fold(Frame& F) {
    const int b = blockIdx.x; if (b >= 16) return;
    LAS unsigned char* lds = F.lds; const int lane = F.lane, wave = F.wave, dir = b >> 3, hd = b & 7;
    const int unit0 = (dir * 8 + hd) * 16;
    __syncthreads();
    if (wave >= 4) {
        const int lw = wave - 4;
        for (int g = 0; g < NSEG; ++g) {
            if (g < NSEG - 1) { const unsigned char* src = F.ws + WS_PF + (size_t)(unit0 + g) * 32768 + lane * 16; LAS unsigned char* dst = lds + (g & 1) * 32768;
#pragma unroll
                for (int k = 0; k < 8; ++k) { const int p = lw + 4 * k; __builtin_amdgcn_global_load_lds((const unsigned*)(src + p * 1024), (LAS unsigned*)(dst + p * 1024), 16, 0, 0); } }
            DN_WAIT(0); DN_BAR();
        }
    } else {
        const int d = wave;
        f32x16 S[4], R[4];
#pragma unroll
        for (int m = 0; m < 4; ++m)
#pragma unroll
            for (int i = 0; i < 16; ++i) S[m][i] = 0.f;
        const float* rg0 = (const float*)(F.ws + WS_RG) + (size_t)unit0 * 16384; float* sin0 = (float*)(F.ws + WS_SIN) + (size_t)unit0 * 16384;
#pragma unroll
        for (int m = 0; m < 4; ++m)
#pragma unroll
            for (int q = 0; q < 4; ++q) { const f32x4 v = *(const f32x4*)(rg0 + ((d * 4 + m) * 64 + lane) * 16 + 4 * q); R[m][4 * q] = v[0]; R[m][4 * q + 1] = v[1]; R[m][4 * q + 2] = v[2]; R[m][4 * q + 3] = v[3]; }
        DN_BAR();
        for (int g = 0; g < NSEG; ++g) {
            float* so = sin0 + (size_t)g * 16384;
#pragma unroll
            for (int m = 0; m < 4; ++m)
#pragma unroll
                for (int q = 0; q < 4; ++q) *(f32x4*)(so + ((d * 4 + m) * 64 + lane) * 16 + 4 * q) = (f32x4){S[m][4 * q], S[m][4 * q + 1], S[m][4 * q + 2], S[m][4 * q + 3]};
            if (g == NSEG - 1) break;
            const LAS unsigned char* buf = lds + (g & 1) * 32768 + lane * 16;
            bf16x8 sb[8];
#pragma unroll
            for (int t = 0; t < 8; ++t) sb[t] = cvt8(S[t >> 1], 8 * (t & 1));
#pragma unroll
            for (int m = 0; m < 4; ++m) { S[m] = R[m];
#pragma unroll
                for (int t = 0; t < 8; ++t) S[m] = __builtin_amdgcn_mfma_f32_32x32x16_bf16(*(const LAS bf16x8*)(buf + (m * 8 + t) * 1024), sb[t], S[m], 0, 0, 0); }
            if (g + 1 < NSEG - 1) { const float* rg = rg0 + (size_t)(g + 1) * 16384;
#pragma unroll
                for (int m = 0; m < 4; ++m)
#pragma unroll
                    for (int q = 0; q < 4; ++q) { const f32x4 v = *(const f32x4*)(rg + ((d * 4 + m) * 64 + lane) * 16 + 4 * q); R[m][4 * q] = v[0]; R[m][4 * q + 1] = v[1]; R[m][4 * q + 2] = v[2]; R[m][4 * q + 3] = v[3]; } }
            asm volatile("s_waitcnt lgkmcnt(0)" ::: "memory");
            DN_BAR();
        }
    }
    __syncthreads();
}
__device__ __forceinline__ void dn_pass3(Frame& F) {
    LAS unsigned char* lds = F.lds; const int lane = F.lane, wave = F.wave, r = lane & 31, lh = lane >> 5;
    LAS float* gls = (LAS float*)(lds + L_GLS);
    for (int unit = blockIdx.x; unit < 16 * NSEG; unit += F.G) {
        const int dir = unit >> 7, hd = (unit >> 4) & 7, g = unit & 15;
        __syncthreads();
        if (F.tid < SEGL) gls[F.tid] = WSP(float, WS_GL)[(dir * 8 + hd) * 256 + seg_chunk(dir, g, F.tid)];
        asm volatile("s_waitcnt lgkmcnt(0)" ::: "memory");
        if (wave >= 4) {
            const int lw = wave - 4;
            for (int i = 0; i <= SEGL; ++i) {
                if (i < SEGL) { const unsigned char* src = dnx_rec(F, dir, hd, seg_chunk(dir, g, i)) + lane * 16; LAS unsigned char* dst = lds + (i & 1) * SLOT3;
#pragma unroll
                    for (int k = 0; k < 18; ++k) { const int p = lw + 4 * k; __builtin_amdgcn_global_load_lds((const unsigned*)(src + p * 1024), (LAS unsigned*)(dst + p * 1024), 16, 0, 0); } }
                DN_WAIT(0); DN_BAR();
            }
        } else {
            const int d = wave;
            f32x16 S[4];
            const float* si = (const float*)(F.ws + WS_SIN) + (size_t)unit * 16384;
#pragma unroll
            for (int m = 0; m < 4; ++m)
#pragma unroll
                for (int q = 0; q < 4; ++q) { const f32x4 v = *(const f32x4*)(si + ((d * 4 + m) * 64 + lane) * 16 + 4 * q); S[m][4 * q] = v[0]; S[m][4 * q + 1] = v[1]; S[m][4 * q + 2] = v[2]; S[m][4 * q + 3] = v[3]; }
            bf16* O = WSP(bf16, dir ? WS_OB : WS_OF);
            DN_BAR();
            for (int i = 0; i < SEGL; ++i) {
                const int cn = seg_chunk(dir, g, i); const LAS unsigned char* slot = lds + (i & 1) * SLOT3;
                f32x16 aV[2], aO[2];
#pragma unroll
                for (int mt = 0; mt < 2; ++mt) { u_to_acc(aV[mt], slot + DX_U + ((d * 2 + mt) * 64 + lane) * 32);
#pragma unroll
                    for (int e = 0; e < 16; ++e) aO[mt][e] = 0.f; }
                dn_step<true>(S, aV, aO, slot + lane * 16, gls[i]);
                bf16* op = O + (size_t)(64 * cn + 4 * lh) * 1024 + hd * 128 + 32 * d + r;
#pragma unroll
                for (int mt = 0; mt < 2; ++mt)
#pragma unroll
                    for (int e = 0; e < 16; ++e) op[(size_t)(32 * mt + (e & 3) + 8 * (e >> 2)) * 1024] = (bf16)f2bf(aO[mt][e]);
                asm volatile("s_waitcnt lgkmcnt(0)" ::: "memory");
                DN_BAR();
            }
        }
    }
    __syncthreads();
}

#ifndef MK_N_LAUNCHES
#define MK_N_LAUNCHES 1
#endif
constexpr int N_PHASES = 14;
struct Args { const float* in[23]; float* out; unsigned char* ws; int ph_lo, ph_hi; };
static_assert(sizeof(Args) == 23 * 8 + 8 + 8 + 8, "Args has no padding");

__global__ void __launch_bounds__(NWAVES * 64, 2) enc_fwd(Args args) {
    extern __shared__ __attribute__((aligned(16))) unsigned char lds[];
    Frame F;
    F.lds = (LAS unsigned char*)lds;
    F.MISC = (volatile LAS unsigned*)(F.lds + MISC_OFF);
    F.tid = threadIdx.x; F.lane = F.tid & 63; F.wave = __builtin_amdgcn_readfirstlane(F.tid >> 6);
    F.G = gridDim.x; { const int bx = blockIdx.x; F.vcu = (F.G % 8 == 0) ? (bx % 8) * (F.G / 8) + bx / 8 : bx; }
#pragma unroll
    for (int i = 0; i < 23; ++i) F.in[i] = args.in[i];
    F.out = args.out; F.ws = args.ws; F.ctl = (gu32*)(args.ws + WS_CTL);
    for (int u = F.tid; u < (LDS_BYTES - LDSCTL_OFF) / 4; u += NWAVES * 64) ((LAS unsigned*)(F.lds + LDSCTL_OFF))[u] = 0u;
    __syncthreads();
    const int lo = args.ph_lo, hi = args.ph_hi;
    XcdBarrier bar; bar.bar = (unsigned*)(F.ctl + CW_BAR); bar.x = 0; bar.st = nullptr;
    if (hi - lo > 1) bar = xcd_barrier_post((unsigned*)(F.ctl + CW_BAR), F.MISC + 8);
#define IN(k) (lo <= (k) && (k) < hi)
#define SEAM(k) do { if (IN(k) && IN((k) + 1)) xcd_barrier(bar); } while (0)
    float* sumsq2 = (float*)(F.ws + WS_CTL + CTL_SUMSQ2); float* sumsq3 = (float*)(F.ws + WS_CTL + CTL_SUMSQ3); float* sumsq4 = (float*)(F.ws + WS_CTL + CTL_SUMSQ4);

    if (IN(0)) { p0_prologue(F);
#if defined(REPEAT_PHASE) && REPEAT_PHASE == 0
        p0_prologue(F);
#endif
    } SEAM(0);
    if (IN(1)) {
        { pg8::Gemm g{WSP(bf16, WS_XB), WSP(bf16, WS_WIN), SEQ, NINP, DM}; pg8::StaticOrder S; S.init(SEQ, NINP, F.G, (int)blockIdx.x);
          EpiProj E{WSP(float, WS_RSTD1), WSP(bf16, WS_QKV), DOP(bf16, DO_Z), DOP(bf16, DO_QSW), DOP(bf16, DO_KVSW), WSP(float, WS_AB)};
          pg8::gemm_phase<EpiProj, pg8::StaticOrder, true, true>(F.lds + RING_OFF, g, S, E);
#if defined(REPEAT_PHASE) && REPEAT_PHASE == 1
          pg8::gemm_phase<EpiProj, pg8::StaticOrder, true, true>(F.lds + RING_OFF, g, S, E);
#endif
          }
    } SEAM(1);
    if (IN(2)) { dn_prep_phase<63>(F);
#if defined(REPEAT_PHASE) && REPEAT_PHASE == 2
        dn_prep_phase<63>(F);
#endif
#if defined(REPEAT_PHASE) && REPEAT_PHASE >= 1000 && REPEAT_PHASE < 1064
        dn_prep_phase<REPEAT_PHASE - 1000>(F);
#endif
    } SEAM(2);
    if (IN(3)) { dn_pass1(F);
#if defined(REPEAT_PHASE) && REPEAT_PHASE == 3
        dn_pass1(F);
#endif
    } SEAM(3);
    if (IN(12)) { dn_fold(F); swa_phase(F, 0, F.G); }
#if defined(REPEAT_PHASE) && REPEAT_PHASE == 12
    if (IN(12)) { dn_fold(F); swa_phase(F, 0, F.G); }
#endif
#if defined(REPEAT_PHASE) && REPEAT_PHASE == 112
    if (IN(12)) { dn_fold(F); }
#endif
#if defined(REPEAT_PHASE) && REPEAT_PHASE == 212
    if (IN(12)) { swa_phase(F, 0, F.G); }
#endif
    if (IN(12) && IN(13)) xcd_barrier(bar);
    if (IN(13)) { dn_pass3(F);
#if defined(REPEAT_PHASE) && REPEAT_PHASE == 13
        dn_pass3(F);
#endif
    } if (IN(13) && IN(4)) xcd_barrier(bar);
    if (IN(4)) { dn_combine(F);
#if defined(REPEAT_PHASE) && REPEAT_PHASE == 4
        dn_combine(F);
#endif
    } SEAM(4);
    if (IN(5)) {
        pg8::Gemm g{WSP(bf16, WS_XB), WSP(bf16, WS_WOUT), SEQ, DM, DM}; pg8::StaticOrder S; S.init(SEQ, DM, F.G, (int)blockIdx.x);
        EpiRes E{F.in[0], nullptr, nullptr, WSP(bf16, WS_H1B), sumsq2};
        pg8::gemm_phase<EpiRes, pg8::StaticOrder, true, true>(F.lds + RING_OFF, g, S, E);
#if defined(REPEAT_PHASE) && REPEAT_PHASE == 5
        { EpiRes E2{F.in[0], nullptr, nullptr, nullptr, (float*)(F.ws + WS_CTL + 448 * 1024)}; pg8::gemm_phase<EpiRes, pg8::StaticOrder, true, true>(F.lds + RING_OFF, g, S, E2); }
#endif
    } SEAM(5);
    if (IN(6)) {
        pg8::Gemm g{WSP(bf16, WS_H1B), WSP(bf16, WS_WQ), SEQ, 512, DM}; pg8::StaticOrder S; S.init(SEQ, 512, F.G, (int)blockIdx.x);
        EpiScaleBf16 E{sumsq2, 1, QSCALE, WSP(bf16, WS_QM), 512};
        pg8::gemm_phase<EpiScaleBf16, pg8::StaticOrder, true, true>(F.lds + RING_OFF, g, S, E);
        { pg8::Gemm g2{WSP(bf16, WS_MEMB), WSP(bf16, WS_WKV), MEMT, 1024, DM}; pg8::StaticOrder S2; S2.init(MEMT, 1024, F.G, (int)((blockIdx.x + F.G - (F.G >> 1)) % F.G));
          EpiScaleBf16 E2{WSP(float, WS_RSTDM), 0, 1.0f, WSP(bf16, WS_KVM), 1024};
          pg8::gemm_phase<EpiScaleBf16, pg8::StaticOrder, true, true>(F.lds + RING_OFF, g2, S2, E2); }
        { const int nbusy = (F.G >> 1) + 4; if (F.G >= nbusy + 32) p4_transposes(F, nbusy, F.G - nbusy); else p4_transposes(F, 0, F.G); }
#if defined(REPEAT_PHASE) && REPEAT_PHASE == 6
        pg8::gemm_phase<EpiScaleBf16, pg8::StaticOrder, true, true>(F.lds + RING_OFF, g, S, E);
#endif
    } SEAM(6);
    if (IN(7)) { mem_attn_phase(F);
#if defined(REPEAT_PHASE) && REPEAT_PHASE == 7
        mem_attn_phase(F);
#endif
    } SEAM(7);
    if (IN(8)) {
        pg8::Gemm g{WSP(bf16, WS_OM), WSP(bf16, WS_WO), SEQ, DM, 512}; pg8::StaticOrder S; S.init(SEQ, DM, F.G, (int)blockIdx.x);
        EpiRes E{nullptr, WSP(bf16, WS_H1B), nullptr, WSP(bf16, WS_XB), sumsq3};
        pg8::gemm_phase<EpiRes, pg8::StaticOrder, true, true>(F.lds + RING_OFF, g, S, E);
#if defined(REPEAT_PHASE) && REPEAT_PHASE == 8
        { EpiRes E2{nullptr, WSP(bf16, WS_H1B), nullptr, nullptr, (float*)(F.ws + WS_CTL + 448 * 1024)}; pg8::gemm_phase<EpiRes, pg8::StaticOrder, true, true>(F.lds + RING_OFF, g, S, E2); }
#endif
    } SEAM(8);
    if (IN(9)) {
        pg8::Gemm g{WSP(bf16, WS_XB), WSP(bf16, WS_WGU), SEQ, 2 * DFF, DM}; pg8::StaticOrder S; S.init(SEQ, 2 * DFF, F.G, (int)blockIdx.x);
        EpiSwiglu E{sumsq3, WSP(bf16, WS_HID)};
        pg8::gemm_phase<EpiSwiglu, pg8::StaticOrder, true, true>(F.lds + RING_OFF, g, S, E);
#if defined(REPEAT_PHASE) && REPEAT_PHASE == 9
        pg8::gemm_phase<EpiSwiglu, pg8::StaticOrder, true, true>(F.lds + RING_OFF, g, S, E);
#endif
    } SEAM(9);
    if (IN(10)) {
        pg8::Gemm g{WSP(bf16, WS_HID), WSP(bf16, WS_WD), SEQ, DM, DFF}; pg8::StaticOrder S; S.init(SEQ, DM, F.G, (int)blockIdx.x);
        EpiRes E{nullptr, WSP(bf16, WS_XB), nullptr, WSP(bf16, WS_H3B), sumsq4};
        pg8::gemm_phase<EpiRes, pg8::StaticOrder, true, true>(F.lds + RING_OFF, g, S, E);
#if defined(REPEAT_PHASE) && REPEAT_PHASE == 10
        { EpiRes E2{nullptr, WSP(bf16, WS_XB), nullptr, nullptr, (float*)(F.ws + WS_CTL + 448 * 1024)}; pg8::gemm_phase<EpiRes, pg8::StaticOrder, true, true>(F.lds + RING_OFF, g, S, E2); }
#endif
    } SEAM(10);
#if defined(REPEAT_PHASE) && REPEAT_PHASE == 99
    for (int k_ = 0; k_ < 10; ++k_) xcd_barrier(bar);
#endif
    if (IN(11)) { final_norm(F);
#if defined(REPEAT_PHASE) && REPEAT_PHASE == 11
        final_norm(F);
#endif
    }
#undef IN
#undef SEAM
}

extern "C" void kernel_launch(void* const* d_in, const int* in_sizes, int n_in, void* d_out, int out_size, void* d_ws, size_t ws_size, hipStream_t stream) {
    static int grid = 0;
    if (grid == 0) {
        if (n_in != 23 || out_size != SEQ * DM || ws_size < WS_END) { fprintf(stderr, "kernel_launch: unexpected shapes (n_in %d out %d ws %zu)\n", n_in, out_size, ws_size); grid = -1; return; }
        int dev = 0, cus = 0;
        if (hipGetDevice(&dev) != hipSuccess || hipDeviceGetAttribute(&cus, hipDeviceAttributeMultiprocessorCount, dev) != hipSuccess) { grid = -1; return; }
        if (hipFuncSetAttribute((const void*)enc_fwd, hipFuncAttributeMaxDynamicSharedMemorySize, LDS_BYTES) != hipSuccess) { fprintf(stderr, "kernel_launch: hipFuncSetAttribute failed\n"); grid = -1; return; }
        (void)hipGetLastError();
        grid = cus;
    }
    if (grid < 0) return;
    if (hipMemsetAsync((char*)d_ws + WS_CTL, 0, CTL_ZERO_BYTES, stream) != hipSuccess) return;
    Args a{};
    for (int i = 0; i < 23; ++i) a.in[i] = (const float*)d_in[i];
    a.out = (float*)d_out; a.ws = (unsigned char*)d_ws;
    const int per = (N_PHASES + MK_N_LAUNCHES - 1) / MK_N_LAUNCHES;
    for (int lo = 0; lo < N_PHASES; lo += per) {
        a.ph_lo = lo; a.ph_hi = (lo + per < N_PHASES) ? lo + per : N_PHASES;
        hipLaunchKernelGGL(enc_fwd, dim3(grid), dim3(NWAVES * 64), LDS_BYTES, stream, a);
    }
}
```

```cpp
#include <hip/hip_runtime.h>
#include <cstdio>
#include <cstdint>
namespace pg8 {
__device__ __forceinline__ unsigned cvt_pk_bf16(float lo, float hi) { unsigned r; asm volatile("v_cvt_pk_bf16_f32 %0, %1, %2" : "=v"(r) : "v"(lo), "v"(hi)); return r; }
#define PG8_LAS __attribute__((address_space(3)))
typedef unsigned short bf16_t;
typedef short bf16x8 __attribute__((ext_vector_type(8)));
typedef float f32x4 __attribute__((ext_vector_type(4)));
typedef unsigned u32x4 __attribute__((ext_vector_type(4)));
constexpr int BM = 256, BK = 64, HALF = 128, HTB = HALF * BK * 2  , STAGE_BYTES = 8 * HTB, NXCD = 8, WGM = 8;

__host__ __device__ __forceinline__ int lds_byte(int r, int c) { const int st = (r >> 4) * 2 + (c >> 5), rr = r & 15, cc = c & 31, ob = rr * 64 + cc * 2; return st * 1024 + (ob ^ (((ob >> 9) & 1) << 5)); }
__host__ __device__ __forceinline__ void stage_rc(int b, int& R, int& C) { const int st = b / 1024, sb = b % 1024, swz = sb ^ (((sb >> 9) & 1) << 5); R = (st >> 1) * 16 + swz / 64; C = (st & 1) * 32 + (swz % 64) / 2; }
__host__ __device__ __forceinline__ int perm32(int rho) { const int n = rho >> 4, i = rho & 15; return 8 * (i >> 2) + 4 * n + (i & 3); }

struct Unit { int pm, pn; };
struct Gemm { const bf16_t* A; const bf16_t* Bt; int M, N, K; };

struct StaticOrder {
    int nM, nN, nwg, G, c;
    __host__ __device__ void init(int M, int N, int G_, int c_) { nM = M / BM; nN = N / BM; nwg = nM * nN; G = G_; c = c_; }
    __host__ __device__ bool next(int i, Unit& u) const {
        const long L = (long)i * G + c; if (L >= nwg) return false;
        int wgid = (int)L; { const int q = nwg / NXCD, r = nwg % NXCD, xcd = wgid % NXCD, off = wgid / NXCD; wgid = (xcd < r ? xcd * (q + 1) : r * (q + 1) + (xcd - r) * q) + off; }
        const int nig = WGM * nN, gid = wgid / nig, fm = gid * WGM, gsz = (nM - fm) < WGM ? (nM - fm) : WGM;
        u.pm = fm + ((wgid % nig) % gsz); u.pn = (wgid % nig) / gsz; return true;
    }
    __device__ __forceinline__ void a_ready(const Unit&) const {}
    __device__ __forceinline__ void done(const Unit&) const {}
};

template <class Epi, class Sched, bool ALIGN_EPI = false, bool SP2 = false>
__device__ __forceinline__ void gemm_phase(PG8_LAS unsigned char* lds, const Gemm g, const Sched& S, const Epi& E) {
    const int tid = threadIdx.x, wid = __builtin_amdgcn_readfirstlane(tid >> 6), lane = tid & 63, wr = wid >> 2, wc = wid & 3, fr = lane & 15, fq = lane >> 4;
    const int K = g.K, nt = K / BK;
    unsigned voffA[2], voffB[2];
#pragma unroll
    for (int i = 0; i < 2; ++i) { int R, C; stage_rc(tid * 16 + i * 8192, R, C); const int Rb = Epi::PERM ? ((R & ~31) + perm32(R & 31)) : R;
        voffA[i] = (unsigned)(R * K + C) * 2u; voffB[i] = (unsigned)(Rb * K + C) * 2u; }
    const size_t kstep = (size_t)(BK * 2);
    const size_t hstep = (size_t)HALF * K * 2;
    const size_t tstep = 2 * hstep;
    const unsigned ldsw = (unsigned)wid * 1024u;
    const int aoff = lds_byte(wr * 64 + fr, fq * 8), boff = lds_byte(wc * 32 + fr, fq * 8);
#define PG8_SA(b, h) (((b) * 2 + (h)) * HTB)
#define PG8_SB(b, h) ((4 + (b) * 2 + (h)) * HTB)
#define PG8_STAGE(bufoff, gbase, voff) do { _Pragma("unroll") for (int _i = 0; _i < 2; ++_i) \
        __builtin_amdgcn_global_load_lds((const unsigned*)((const char*)(gbase) + (voff)[_i]), (PG8_LAS unsigned*)(lds + (bufoff) + ldsw + _i * 8192), 16, 0, 0); } while (0)
#define PG8_LDA(dst, b, h) do { _Pragma("unroll") for (int m = 0; m < 4; ++m) _Pragma("unroll") for (int k = 0; k < 2; ++k) dst[m][k] = *(const PG8_LAS bf16x8*)(lds + PG8_SA(b, h) + aoff + m * 2048 + k * 1024); } while (0)
#define PG8_LDB(dst, b, h) do { _Pragma("unroll") for (int n = 0; n < 2; ++n) _Pragma("unroll") for (int k = 0; k < 2; ++k) dst[n][k] = *(const PG8_LAS bf16x8*)(lds + PG8_SB(b, h) + boff + n * 2048 + k * 1024); } while (0)
#define PG8_MMA(ai, bj, At, Bt) do { __builtin_amdgcn_s_setprio(1); _Pragma("unroll") for (int m = 0; m < 4; ++m) _Pragma("unroll") for (int n = 0; n < 2; ++n) _Pragma("unroll") for (int k = 0; k < 2; ++k) \
        acc[ai][bj][m][n] = __builtin_amdgcn_mfma_f32_16x16x32_bf16(Bt[n][k], At[m][k], acc[ai][bj][m][n], 0, 0, 0); __builtin_amdgcn_s_setprio(0); } while (0)
#define PG8_WAIT_V(n) asm volatile("s_waitcnt vmcnt(" #n ")" ::: "memory")
#define PG8_WAIT_L(n) asm volatile("s_waitcnt lgkmcnt(" #n ")" ::: "memory")
#define PG8_BAR __builtin_amdgcn_s_barrier()
#define PG8_SCHED __builtin_amdgcn_sched_barrier(0)
    Unit cur, nxt; int ui = 0;
    if (!S.next(0, cur)) return;
    f32x4 acc[2][2][4][2];
#pragma unroll
    for (int a = 0; a < 2; ++a)
#pragma unroll
        for (int b = 0; b < 2; ++b)
#pragma unroll
            for (int m = 0; m < 4; ++m)
#pragma unroll
                for (int n = 0; n < 2; ++n) acc[a][b][m][n] = (f32x4){0.f, 0.f, 0.f, 0.f};
    bf16x8 At[4][2], B0[2][2], B1[2][2];
    const char* cA = (const char*)g.A + (size_t)cur.pm * tstep; const char* cB = (const char*)g.Bt + (size_t)cur.pn * tstep;
    S.a_ready(cur);
    if constexpr (SP2) {
        PG8_STAGE(PG8_SB(0, 0), cB, voffB); PG8_STAGE(PG8_SB(0, 1), cB + hstep, voffB); PG8_STAGE(PG8_SA(0, 0), cA, voffA); PG8_STAGE(PG8_SA(0, 1), cA + hstep, voffA);
        if (wr == 1) PG8_BAR;
        PG8_WAIT_V(2); PG8_BAR;
        PG8_STAGE(PG8_SB(1, 0), cB + kstep, voffB); PG8_STAGE(PG8_SA(1, 0), cA + kstep, voffA); PG8_STAGE(PG8_SB(1, 1), cB + hstep + kstep, voffB);
        PG8_WAIT_V(6); PG8_BAR;
    } else {
        PG8_STAGE(PG8_SB(0, 0), cB, voffB); PG8_STAGE(PG8_SA(0, 0), cA, voffA); PG8_STAGE(PG8_SB(0, 1), cB + hstep, voffB); PG8_STAGE(PG8_SA(0, 1), cA + hstep, voffA);
        if (wr == 1) PG8_BAR;
        PG8_WAIT_V(4); PG8_BAR;
        PG8_STAGE(PG8_SB(1, 0), cB + kstep, voffB); PG8_STAGE(PG8_SA(1, 0), cA + kstep, voffA); PG8_STAGE(PG8_SB(1, 1), cB + hstep + kstep, voffB);
        PG8_WAIT_V(6); PG8_BAR;
    }
    for (;;) {
        const bool has_next = S.next(ui + 1, nxt);
        const char* nA = has_next ? (const char*)g.A + (size_t)nxt.pm * tstep : cA; const char* nB = has_next ? (const char*)g.Bt + (size_t)nxt.pn * tstep : cB;
        for (int t = 0; t < nt; t += 2) {
            const bool last = (t == nt - 2);
            const char* a1 = cA + (size_t)(t + 1) * kstep;
            const char* a2 = last ? nA : cA + (size_t)(t + 2) * kstep; const char* b2 = last ? nB : cB + (size_t)(t + 2) * kstep;
            const char* a3 = a2 + kstep; const char* b3 = b2 + kstep;
            if (last && has_next) S.a_ready(nxt);
            if constexpr (SP2) {
            PG8_LDB(B0, 0, 0); PG8_LDB(B1, 0, 1); PG8_SCHED; PG8_LDA(At, 0, 0); PG8_STAGE(PG8_SA(1, 1), a1 + hstep, voffA);
            PG8_WAIT_V(8); PG8_WAIT_L(0); PG8_BAR; PG8_MMA(0, 0, At, B0); PG8_MMA(0, 1, At, B1); PG8_BAR; PG8_SCHED;
            PG8_LDA(At, 0, 1); PG8_STAGE(PG8_SB(0, 0), b2, voffB); PG8_STAGE(PG8_SB(0, 1), b2 + hstep, voffB); PG8_STAGE(PG8_SA(0, 0), a2, voffA);
            PG8_WAIT_V(8); PG8_WAIT_L(0); PG8_BAR; PG8_MMA(1, 0, At, B0); PG8_MMA(1, 1, At, B1); PG8_BAR; PG8_SCHED;
            PG8_LDB(B0, 1, 0); PG8_LDB(B1, 1, 1); PG8_SCHED; PG8_LDA(At, 1, 0); PG8_STAGE(PG8_SA(0, 1), a2 + hstep, voffA);
            PG8_WAIT_V(8); PG8_WAIT_L(0); PG8_BAR; PG8_MMA(0, 0, At, B0); PG8_MMA(0, 1, At, B1); PG8_BAR; PG8_SCHED;
            PG8_LDA(At, 1, 1); PG8_STAGE(PG8_SB(1, 0), b3, voffB); PG8_STAGE(PG8_SB(1, 1), b3 + hstep, voffB); PG8_STAGE(PG8_SA(1, 0), a3, voffA);
            PG8_WAIT_V(8); PG8_WAIT_L(0); PG8_BAR; PG8_MMA(1, 0, At, B0); PG8_MMA(1, 1, At, B1); PG8_BAR; PG8_SCHED;
            } else {
            PG8_LDB(B0, 0, 0); PG8_SCHED; PG8_LDA(At, 0, 0); PG8_STAGE(PG8_SA(1, 1), a1 + hstep, voffA);
            PG8_WAIT_L(8); PG8_BAR; PG8_WAIT_L(0); PG8_MMA(0, 0, At, B0); PG8_BAR; PG8_SCHED;
            PG8_LDB(B1, 0, 1); PG8_STAGE(PG8_SB(0, 0), b2, voffB);
            PG8_BAR; PG8_WAIT_L(0); PG8_MMA(0, 1, At, B1); PG8_BAR;
            PG8_LDA(At, 0, 1); PG8_STAGE(PG8_SA(0, 0), a2, voffA);
            PG8_BAR; PG8_WAIT_L(0); PG8_MMA(1, 0, At, B0); PG8_BAR; PG8_SCHED;
            PG8_STAGE(PG8_SB(0, 1), b2 + hstep, voffB);
            PG8_WAIT_V(6); PG8_BAR; PG8_MMA(1, 1, At, B1); PG8_BAR;
            PG8_LDB(B0, 1, 0); PG8_SCHED; PG8_LDA(At, 1, 0); PG8_STAGE(PG8_SA(0, 1), a2 + hstep, voffA);
            PG8_WAIT_L(8); PG8_BAR; PG8_WAIT_L(0); PG8_MMA(0, 0, At, B0); PG8_BAR; PG8_SCHED;
            PG8_LDB(B1, 1, 1); PG8_STAGE(PG8_SB(1, 0), b3, voffB);
            PG8_BAR; PG8_WAIT_L(0); PG8_MMA(0, 1, At, B1); PG8_BAR;
            PG8_LDA(At, 1, 1); PG8_STAGE(PG8_SA(1, 0), a3, voffA);
            PG8_BAR; PG8_WAIT_L(0); PG8_MMA(1, 0, At, B0); PG8_BAR; PG8_SCHED;
            PG8_STAGE(PG8_SB(1, 1), b3 + hstep, voffB);
            PG8_WAIT_V(6); PG8_BAR; PG8_MMA(1, 1, At, B1); PG8_BAR;
            }
        }
        if constexpr (ALIGN_EPI) { if (wr == 0) PG8_BAR; }
        if constexpr (!Epi::AFTER_DRAIN) { E(acc, cur, wr, wc, fr, fq); S.done(cur); }
        if (!has_next) break;
#pragma unroll
        for (int a = 0; a < 2; ++a)
#pragma unroll
            for (int b = 0; b < 2; ++b)
#pragma unroll
                for (int m = 0; m < 4; ++m)
#pragma unroll
                    for (int n = 0; n < 2; ++n) acc[a][b][m][n] = (f32x4){0.f, 0.f, 0.f, 0.f};
        cur = nxt; cA = nA; cB = nB; ++ui;
        if constexpr (ALIGN_EPI) { if (wr == 1) PG8_BAR; }
    }
    PG8_WAIT_V(0);
    if constexpr (!ALIGN_EPI) { if (wr == 0) PG8_BAR; }
    PG8_BAR;
    if constexpr (Epi::AFTER_DRAIN) { E.fused(acc, cur, wr, wc, fr, fq, lds, wid, lane); S.done(cur); }
#undef PG8_SA
#undef PG8_SB
#undef PG8_STAGE
#undef PG8_LDA
#undef PG8_LDB
#undef PG8_MMA
#undef PG8_WAIT_V
#undef PG8_WAIT_L
#undef PG8_BAR
#undef PG8_SCHED
}
}

constexpr int NWAVES = 8;
constexpr int SEQ = 16384, DM = 2048, NIN = 5664, NINP = 5888, DFF = 5632;
constexpr int DNH = 8, HD = 128, SWH = 8, MEMH = 4, MEMT = 256;
constexpr float RMS_EPS = 1e-6f;
constexpr float LOG2E = 1.4426950408889634f;
constexpr float QSCALE = 0.08838834764831845f * 1.4426950408889634f;

constexpr size_t MiB = 1u << 20;
constexpr size_t WS_CTL = 0, CTL_ZERO_BYTES = 1 * MiB;
constexpr size_t CTL_SUMSQ2 = 256 * 1024, CTL_SUMSQ3 = 320 * 1024, CTL_SUMSQ4 = 384 * 1024;
constexpr size_t WS_RSTD1 = 1 * MiB, WS_RSTDM = 1 * MiB + 64 * 1024;
constexpr size_t WS_MEMB = 2 * MiB, WS_KVM = 3 * MiB, WS_AB = 4 * MiB, WS_BG = 6 * MiB;
constexpr size_t WS_WOUT = 8 * MiB, WS_WQ = 16 * MiB, WS_WKV = 18 * MiB, WS_WO = 22 * MiB, WS_WIN = 24 * MiB;
constexpr size_t WS_XB = 48 * MiB;
constexpr size_t WS_QKV = 112 * MiB;
constexpr size_t WS_H3B = 112 * MiB;
constexpr size_t WS_OF = 112 * MiB, WS_OB = 144 * MiB, WS_H1B = 112 * MiB, WS_QM = 176 * MiB, WS_OM = 192 * MiB;
constexpr size_t WS_DNX = 208 * MiB;
constexpr size_t WS_WGU = 208 * MiB, WS_WD = 252 * MiB, WS_HID = 274 * MiB, WS_END = 496 * MiB;
constexpr size_t DO_Z = 0, DO_QSW = 32 * MiB, DO_KVSW = 64 * MiB;
constexpr int CW_BAR = 4096, CW_SWAQ = 8192;

constexpr int RING_OFF = 0, RING_BYTES = 131072;
constexpr int LDS_BYTES = 163840;
constexpr int LDSCTL_OFF = LDS_BYTES - 512, MISC_OFF = LDSCTL_OFF + 320;

#define GAS __attribute__((address_space(1)))
#define LAS __attribute__((address_space(3)))
typedef unsigned short bf16;
typedef unsigned v4u __attribute__((ext_vector_type(4)));
typedef unsigned v2u __attribute__((ext_vector_type(2)));
typedef float f32x4 __attribute__((ext_vector_type(4)));
typedef short bf16x8 __attribute__((ext_vector_type(8)));
typedef short s16x4 __attribute__((ext_vector_type(4)));
typedef GAS unsigned gu32;
#define RLX_AGENT __ATOMIC_RELAXED, __HIP_MEMORY_SCOPE_AGENT
#define LDS_WAIT() asm volatile("s_waitcnt lgkmcnt(0)" ::: "memory")
#define VM_WAIT() asm volatile("s_waitcnt vmcnt(0)" ::: "memory")
__device__ __forceinline__ unsigned f2bf(float f) { unsigned u = __builtin_bit_cast(unsigned, f); return (u + 0x7fffu + ((u >> 16) & 1u)) >> 16; }
__device__ __forceinline__ unsigned pk2(float lo, float hi) { return f2bf(lo) | (f2bf(hi) << 16); }
__device__ __forceinline__ float bf2f(unsigned short b) { return __builtin_bit_cast(float, (unsigned)b << 16); }
__device__ __forceinline__ float bflo(unsigned w) { return __builtin_bit_cast(float, w << 16); }
__device__ __forceinline__ float bfhi(unsigned w) { return __builtin_bit_cast(float, w & 0xffff0000u); }
typedef float f32x2_t __attribute__((ext_vector_type(2))); typedef __bf16 bf16x2_t __attribute__((ext_vector_type(2)));
__device__ __forceinline__ unsigned cvtpk(float lo, float hi) { f32x2_t v = {lo, hi}; bf16x2_t b = __builtin_convertvector(v, bf16x2_t); return __builtin_bit_cast(unsigned, b); }
__device__ __forceinline__ float wave_sum(float v) {
#pragma unroll
    for (int o = 1; o < 64; o <<= 1) v += __shfl_xor(v, o);
    return v;
}
__device__ __forceinline__ float siluf(float x) { return x * __builtin_amdgcn_rcpf(1.0f + __expf(-x)); }
#define XB_TMO      128
#define XB_XCNT(j)  (256  + 64 * (j))
#define XB_XSUB(j)  (1280 + 64 * (j))
#define XB_XGEN(j)  (2304 + 64 * (j))
#define XB_TOP      3328
#define XB_TOPGEN   3392
#define XCD_BAR_WORDS 3456
#define XB_SPIN_CAP (1u << 18)

__device__ __forceinline__ unsigned xb_ld(unsigned* p)              { return __hip_atomic_load(p, __ATOMIC_RELAXED, __HIP_MEMORY_SCOPE_AGENT); }
__device__ __forceinline__ unsigned xb_add(unsigned* p, unsigned v) { return __hip_atomic_fetch_add(p, v, __ATOMIC_RELAXED, __HIP_MEMORY_SCOPE_AGENT); }
__device__ __forceinline__ unsigned xb_xcc_id() { return (unsigned)__builtin_amdgcn_s_getreg((3 << 11) | 20) & 0xFu; }
#define XB_SPIN(cond, bar) do { unsigned _sp = 0; while (cond) { __builtin_amdgcn_s_sleep(1); \
    if ((++_sp & 255u) == 0u) { if (xb_ld(&(bar)[XB_TMO])) break; if (_sp > XB_SPIN_CAP) { atomicAdd(&(bar)[XB_TMO], 1u); break; } } } } while (0)

struct XcdBarrier {
    unsigned* bar; unsigned x;
    volatile LAS unsigned* st;
};

__device__ __forceinline__ XcdBarrier xcd_barrier_post(unsigned* bar, volatile LAS unsigned* st) {
    XcdBarrier b; b.bar = bar; b.x = xb_xcc_id(); b.st = st;
    if (threadIdx.x == 0) (void)xb_add(&bar[XB_XCNT(b.x)], 1u);
    return b;
}
__device__ __forceinline__ void xcd_barrier_complete(unsigned* bar, unsigned x, unsigned& nloc, unsigned& nx) {
    const unsigned G = gridDim.x * gridDim.y * gridDim.z;
    unsigned sum, cnt, mine, sp = 0u;
    for (;;) {
        sum = 0u; cnt = 0u; mine = 0u;
#pragma unroll
        for (unsigned j = 0; j < 16; ++j) { const unsigned c = xb_ld(&bar[XB_XCNT(j)]); sum += c; cnt += (c > 0u) ? 1u : 0u; mine = (j == x) ? c : mine; }
        if (sum == G) break;
        __builtin_amdgcn_s_sleep(1);
        if ((++sp & 255u) == 0u) { if (xb_ld(&bar[XB_TMO])) break; if (sp > XB_SPIN_CAP) { atomicAdd(&bar[XB_TMO], 1u); break; } }
    }
    nloc = mine > 0u ? mine : 1u; nx = cnt > 0u ? cnt : 1u;
}

__device__ __forceinline__ void xcd_barrier(const XcdBarrier& b) {
    asm volatile("s_waitcnt vmcnt(0)" ::: "memory");
    __syncthreads();
    if (threadIdx.x == 0) {
        unsigned* bar = b.bar;
        __builtin_amdgcn_s_waitcnt(0);
        unsigned nloc = b.st[0], nx = b.st[1];
        if (nloc == 0u) { xcd_barrier_complete(bar, b.x, nloc, nx); b.st[0] = nloc; b.st[1] = nx; }
        const unsigned old = xb_add(&bar[XB_XSUB(b.x)], 1u);
        const unsigned gen = old / nloc;
        if (old + 1u == (gen + 1u) * nloc) {
            __builtin_amdgcn_fence(__ATOMIC_RELEASE, "agent");
            asm volatile("s_waitcnt vmcnt(0)" ::: "memory");
            const unsigned og = xb_add(&bar[XB_TOP], 1u);
            const unsigned tg = og / nx;
            if (og + 1u == (tg + 1u) * nx) xb_add(&bar[XB_TOPGEN], 1u);
            else XB_SPIN(xb_ld(&bar[XB_TOPGEN]) == tg, bar);
            __builtin_amdgcn_fence(__ATOMIC_ACQUIRE, "agent");
            xb_add(&bar[XB_XGEN(b.x)], 1u);
            asm volatile("s_waitcnt vmcnt(0)" ::: "memory");
        } else {
            XB_SPIN(xb_ld(&bar[XB_XGEN(b.x)]) == gen, bar);
            __builtin_amdgcn_fence(__ATOMIC_ACQUIRE, "agent");
            asm volatile("s_waitcnt vmcnt(0)" ::: "memory");
        }
    }
    __syncthreads();
}

using pg8::Unit;
__device__ __forceinline__ v4u pack8(f32x4 v0, f32x4 v1) { v4u w; w.x = cvtpk(v0[0], v0[1]); w.y = cvtpk(v0[2], v0[3]); w.z = cvtpk(v1[0], v1[1]); w.w = cvtpk(v1[2], v1[3]); return w; }

struct EpiProj {
    static constexpr bool PERM = true, AFTER_DRAIN = false;
    const float* rstd; bf16* qkv; bf16* z; bf16* qsw; bf16* kvsw; float* ab;
    __device__ __forceinline__ void operator()(const f32x4 (&acc)[2][2][4][2], const Unit& u, int wr, int wc, int fr, int fq) const {
        const int pn = u.pn; bf16* base; int ldc, colt; float sc = 1.f;
        if (pn < 12) { base = qkv; ldc = 3072; colt = pn * 256; }
        else if (pn < 16) { base = z; ldc = 1024; colt = (pn - 12) * 256; }
        else if (pn < 20) { base = qsw; ldc = 1024; colt = (pn - 16) * 256; sc = QSCALE; }
        else if (pn < 22) { base = kvsw; ldc = 512; colt = (pn - 20) * 256; }
        else { base = nullptr; ldc = 0; colt = 0; }
        const int row0 = u.pm * 256 + wr * 64 + fr, col0 = colt + wc * 32 + 8 * fq;
        float rsv[2][4];
#pragma unroll
        for (int ai = 0; ai < 2; ++ai)
#pragma unroll
            for (int m = 0; m < 4; ++m) rsv[ai][m] = rstd[row0 + ai * 128 + m * 16];
#pragma unroll
        for (int ai = 0; ai < 2; ++ai)
#pragma unroll
            for (int m = 0; m < 4; ++m) {
                const int row = row0 + ai * 128 + m * 16; const float rs = rsv[ai][m] * sc;
                if (base) {
                    bf16* rowp = base + (size_t)row * ldc + col0;
#pragma unroll
                    for (int bj = 0; bj < 2; ++bj) *(v4u*)(rowp + bj * 128) = pack8(acc[ai][bj][m][0] * rs, acc[ai][bj][m][1] * rs);
                } else if (wc == 0) {
                    float* rowp = ab + (size_t)row * 32 + 8 * fq;
                    *(f32x4*)(rowp) = acc[ai][0][m][0] * rs; *(f32x4*)(rowp + 4) = acc[ai][0][m][1] * rs;
                }
            }
    }
};
struct EpiScaleBf16 {
    static constexpr bool PERM = true, AFTER_DRAIN = false;
    const float* rs; int from_sumsq; float sc; bf16* O; int ldc;
    __device__ __forceinline__ void operator()(const f32x4 (&acc)[2][2][4][2], const Unit& u, int wr, int wc, int fr, int fq) const {
        const int row0 = u.pm * 256 + wr * 64 + fr, col0 = u.pn * 256 + wc * 32 + 8 * fq;
        float rsv[2][4];
#pragma unroll
        for (int ai = 0; ai < 2; ++ai)
#pragma unroll
            for (int m = 0; m < 4; ++m) rsv[ai][m] = rs[row0 + ai * 128 + m * 16];
#pragma unroll
        for (int ai = 0; ai < 2; ++ai)
#pragma unroll
            for (int m = 0; m < 4; ++m) {
                const int row = row0 + ai * 128 + m * 16; float r = rsv[ai][m];
                if (from_sumsq) r = __builtin_amdgcn_rsqf(r * (1.0f / DM) + RMS_EPS);
                r *= sc; bf16* rowp = O + (size_t)row * ldc + col0;
#pragma unroll
                for (int bj = 0; bj < 2; ++bj) *(v4u*)(rowp + bj * 128) = pack8(acc[ai][bj][m][0] * r, acc[ai][bj][m][1] * r);
            }
    }
};
struct EpiRes {
    static constexpr bool PERM = true, AFTER_DRAIN = false;
    const float* res; const bf16* resb; float* out; bf16* ob; float* sumsq;
    __device__ __forceinline__ void operator()(const f32x4 (&acc)[2][2][4][2], const Unit& u, int wr, int wc, int fr, int fq) const {
        const int row0 = u.pm * 256 + wr * 64 + fr, col0 = u.pn * 256 + wc * 32 + 8 * fq;
#pragma unroll
        for (int ai = 0; ai < 2; ++ai) {
            f32x4 rr[4][2][2];
            if (resb) {
                v4u rb[4][2];
#pragma unroll
                for (int m = 0; m < 4; ++m) { const size_t off = (size_t)(row0 + ai * 128 + m * 16) * DM + col0;
#pragma unroll
                    for (int bj = 0; bj < 2; ++bj) rb[m][bj] = *(const v4u*)(resb + off + bj * 128); }
#pragma unroll
                for (int m = 0; m < 4; ++m)
#pragma unroll
                    for (int bj = 0; bj < 2; ++bj) { const v4u w = rb[m][bj]; rr[m][bj][0] = (f32x4){bflo(w.x), bfhi(w.x), bflo(w.y), bfhi(w.y)}; rr[m][bj][1] = (f32x4){bflo(w.z), bfhi(w.z), bflo(w.w), bfhi(w.w)}; }
            } else {
#pragma unroll
                for (int m = 0; m < 4; ++m) { const size_t off = (size_t)(row0 + ai * 128 + m * 16) * DM + col0;
#pragma unroll
                    for (int bj = 0; bj < 2; ++bj) { rr[m][bj][0] = *(const f32x4*)(res + off + bj * 128); rr[m][bj][1] = *(const f32x4*)(res + off + bj * 128 + 4); } }
            }
            asm volatile("" ::: "memory");
#pragma unroll
            for (int m = 0; m < 4; ++m) {
                const int row = row0 + ai * 128 + m * 16; const size_t off = (size_t)row * DM + col0; float ss = 0.f;
#pragma unroll
                for (int bj = 0; bj < 2; ++bj) {
                    const f32x4 v0 = acc[ai][bj][m][0] + rr[m][bj][0], v1 = acc[ai][bj][m][1] + rr[m][bj][1];
                    if (out) { *(f32x4*)(out + off + bj * 128) = v0; *(f32x4*)(out + off + bj * 128 + 4) = v1; }
                    if (ob) *(v4u*)(ob + off + bj * 128) = pack8(v0, v1);
                    ss += (v0[0] * v0[0] + v0[1] * v0[1]) + (v0[2] * v0[2] + v0[3] * v0[3]) + (v1[0] * v1[0] + v1[1] * v1[1]) + (v1[2] * v1[2] + v1[3] * v1[3]);
                }
                ss += __shfl_xor(ss, 16); ss += __shfl_xor(ss, 32);
                if (fq == 0) atomicAdd(sumsq + row, ss);
            }
            asm volatile("" ::: "memory");
        }
    }
};
struct EpiSwiglu {
    static constexpr bool PERM = true, AFTER_DRAIN = false;
    const float* sumsq; bf16* H;
    __device__ __forceinline__ void operator()(const f32x4 (&acc)[2][2][4][2], const Unit& u, int wr, int wc, int fr, int fq) const {
        const int row0 = u.pm * 256 + wr * 64 + fr, col0 = u.pn * 128 + wc * 32 + 8 * fq;
        float rsv[2][4];
#pragma unroll
        for (int ai = 0; ai < 2; ++ai)
#pragma unroll
            for (int m = 0; m < 4; ++m) rsv[ai][m] = sumsq[row0 + ai * 128 + m * 16];
#pragma unroll
        for (int ai = 0; ai < 2; ++ai)
#pragma unroll
            for (int m = 0; m < 4; ++m) {
                const int row = row0 + ai * 128 + m * 16; const float r = __builtin_amdgcn_rsqf(rsv[ai][m] * (1.0f / DM) + RMS_EPS);
                f32x4 h[2];
#pragma unroll
                for (int n = 0; n < 2; ++n)
#pragma unroll
                    for (int e = 0; e < 4; ++e) { const float g = acc[ai][0][m][n][e] * r, up = acc[ai][1][m][n][e] * r; h[n][e] = siluf(g) * up; }
                *(v4u*)(H + (size_t)row * DFF + col0) = pack8(h[0], h[1]);
            }
    }
};

struct Frame {
    LAS unsigned char* lds;
    volatile LAS unsigned* MISC;
    gu32* ctl;
    int tid, lane, wave, vcu, G;
    const float* in[23]; float* out; unsigned char* ws;
};
#define WSP(T, off) ((T*)(F.ws + (off)))
#define DOP(T, off) ((T*)((unsigned char*)F.out + (off)))

__device__ __forceinline__ void tr_item(const float* W, int K, int Nsrc, int src_col0, const float* gain, bf16* WT, int dst_row0, int k0, LAS float* scr, int lane) {
    float v[32];
#pragma unroll
    for (int i = 0; i < 32; ++i) { const int kk = 2 * i + (lane >> 5); v[i] = (src_col0 >= 0) ? W[(size_t)(k0 + kk) * Nsrc + src_col0 + (lane & 31)] : 0.f; }
    if (gain) {
#pragma unroll
        for (int i = 0; i < 32; ++i) v[i] *= gain[k0 + 2 * i + (lane >> 5)]; }
#pragma unroll
    for (int i = 0; i < 32; ++i) scr[(2 * i + (lane >> 5)) * 33 + (lane & 31)] = v[i];
    LDS_WAIT(); asm volatile("" ::: "memory");
    const int c = lane & 7;
#pragma unroll
    for (int j = 0; j < 4; ++j) { const int n = (lane >> 3) + 8 * j; const LAS float* s = scr + (8 * c) * 33 + n;
        v4u o; o.x = pk2(s[0 * 33], s[1 * 33]); o.y = pk2(s[2 * 33], s[3 * 33]); o.z = pk2(s[4 * 33], s[5 * 33]); o.w = pk2(s[6 * 33], s[7 * 33]);
        *(GAS v4u*)(WT + (size_t)(dst_row0 + n) * K + k0 + 8 * c) = o; }
    LDS_WAIT(); asm volatile("" ::: "memory");
}
__device__ __forceinline__ int win_src_col(int c) {
    if (c < 4096) return c;
    if (c < 5120) return c - 4096 + 4128;
    if (c < 5376) return c - 5120 + 5152;
    if (c < 5632) return c - 5376 + 5408;
    if (c < 5664) return c - 5632 + 4096;
    return -1;
}
__device__ __forceinline__ void row_to_bf16_rstd(const float* xrow, bf16* orow, float* rstd_out, int lane) {
    const GAS f32x4* xr = (const GAS f32x4*)xrow + lane;
    f32x4 v[8]; float s = 0.f;
#pragma unroll
    for (int j = 0; j < 8; ++j) { v[j] = xr[64 * j]; s += (v[j].x * v[j].x + v[j].y * v[j].y) + (v[j].z * v[j].z + v[j].w * v[j].w); }
    s = wave_sum(s);
    if (lane == 0) *rstd_out = 1.0f / sqrtf(s * (1.0f / DM) + RMS_EPS);
    GAS v2u* o8 = (GAS v2u*)orow + lane;
#pragma unroll
    for (int j = 0; j < 8; ++j) { v2u w; w.x = pk2(v[j].x, v[j].y); w.y = pk2(v[j].z, v[j].w); o8[64 * j] = w; }
}

__device__ __forceinline__ void p0_prologue(Frame& F) {
    LAS float* scr = (LAS float*)(F.lds + RING_OFF + F.wave * 16384);
    const int gw = F.vcu * NWAVES + F.wave, NGW = F.G * NWAVES;
    constexpr int I_IN = 32 * (NINP / 32), I_KV = 32 * 32;
    for (int it = gw; it < I_IN + I_KV; it += NGW) {
        int r = it;
        if (r < I_IN) { const int nblk = NINP / 32, kb = r / nblk, nb = r % nblk; tr_item(F.in[3], DM, NIN, win_src_col(nb * 32), F.in[2], WSP(bf16, WS_WIN), nb * 32, kb * 64, scr, F.lane); continue; } r -= I_IN;
        { const int kb = r / 32, nb = r % 32; tr_item(F.in[16], DM, 1024, nb * 32, F.in[14], WSP(bf16, WS_WKV), nb * 32, kb * 64, scr, F.lane); }
    }
    for (int m = gw; m < SEQ; m += 2 * NGW) {
        const int m2 = m + NGW; const bool two = m2 < SEQ;
        const GAS f32x4* xa = (const GAS f32x4*)(F.in[0] + (size_t)m * DM) + F.lane; const GAS f32x4* xb_ = (const GAS f32x4*)(F.in[0] + (size_t)(two ? m2 : m) * DM) + F.lane;
        f32x4 va[8], vb[8]; float sa = 0.f, sb = 0.f;
#pragma unroll
        for (int j = 0; j < 8; ++j) { va[j] = xa[64 * j]; vb[j] = xb_[64 * j]; }
#pragma unroll
        for (int j = 0; j < 8; ++j) { sa += (va[j].x * va[j].x + va[j].y * va[j].y) + (va[j].z * va[j].z + va[j].w * va[j].w); sb += (vb[j].x * vb[j].x + vb[j].y * vb[j].y) + (vb[j].z * vb[j].z + vb[j].w * vb[j].w); }
        sa = wave_sum(sa); sb = wave_sum(sb);
        if (F.lane == 0) { WSP(float, WS_RSTD1)[m] = 1.0f / sqrtf(sa * (1.0f / DM) + RMS_EPS); if (two) WSP(float, WS_RSTD1)[m2] = 1.0f / sqrtf(sb * (1.0f / DM) + RMS_EPS); }
        GAS v2u* oa = (GAS v2u*)(WSP(bf16, WS_XB) + (size_t)m * DM) + F.lane; GAS v2u* ob = (GAS v2u*)(WSP(bf16, WS_XB) + (size_t)m2 * DM) + F.lane;
#pragma unroll
        for (int j = 0; j < 8; ++j) { v2u w; w.x = pk2(va[j].x, va[j].y); w.y = pk2(va[j].z, va[j].w); oa[64 * j] = w; }
        if (two) {
#pragma unroll
            for (int j = 0; j < 8; ++j) { v2u w; w.x = pk2(vb[j].x, vb[j].y); w.y = pk2(vb[j].z, vb[j].w); ob[64 * j] = w; } }
    }
    for (int m = gw; m < MEMT; m += NGW) row_to_bf16_rstd(F.in[1] + (size_t)m * DM, WSP(bf16, WS_MEMB) + (size_t)m * DM, WSP(float, WS_RSTDM) + m, F.lane);
}
__device__ __forceinline__ void p1_late_transposes(Frame& F, int b0, int nb) {
    if ((int)blockIdx.x < b0 || (int)blockIdx.x >= b0 + nb) return;
    LAS float* scr = (LAS float*)(F.lds + RING_OFF + F.wave * 16384);
    const int gw = ((int)blockIdx.x - b0) * NWAVES + F.wave, NGW = nb * NWAVES;
    constexpr int I_OUT = 32 * 64, I_Q = 32 * 16, I_O = 8 * 64;
    for (int it = gw; it < I_OUT + I_Q + I_O; it += NGW) {
        int r = it;
        if (r < I_OUT) { const int kb = r / 64, nb2 = r % 64; tr_item(F.in[12], DM, DM, nb2 * 32, nullptr, WSP(bf16, WS_WOUT), nb2 * 32, kb * 64, scr, F.lane); continue; } r -= I_OUT;
        if (r < I_Q) { const int kb = r / 16, nb2 = r % 16; tr_item(F.in[15], DM, 512, nb2 * 32, F.in[13], WSP(bf16, WS_WQ), nb2 * 32, kb * 64, scr, F.lane); continue; } r -= I_Q;
        { const int kb = r / 64, nb2 = r % 64; tr_item(F.in[17], 512, DM, nb2 * 32, nullptr, WSP(bf16, WS_WO), nb2 * 32, kb * 64, scr, F.lane); }
    }
}
__device__ __forceinline__ void p4_transposes(Frame& F, int b0, int nb) {
    if ((int)blockIdx.x < b0 || (int)blockIdx.x >= b0 + nb) return;
    LAS float* scr = (LAS float*)(F.lds + RING_OFF + F.wave * 16384);
    const int gw = ((int)blockIdx.x - b0) * NWAVES + F.wave, NGW = nb * NWAVES;
    constexpr int I_GU = 32 * (2 * DFF / 32), I_D = (DFF / 64) * 64;
    for (int it = gw; it < I_GU + I_D; it += NGW) {
        int r = it;
        if (r < I_GU) { const int nblk = 2 * DFF / 32, kb = r / nblk, nb = r % nblk; const int row = nb * 32, t = row / 256, w = row % 256;
            const float* src = (w < 128) ? F.in[19] : F.in[20]; const int sc = 128 * t + (w & 127);
            tr_item(src, DM, DFF, sc, F.in[18], WSP(bf16, WS_WGU), row, kb * 64, scr, F.lane); continue; } r -= I_GU;
        { const int kb = r / 64, nb = r % 64; tr_item(F.in[21], DFF, DM, nb * 32, nullptr, WSP(bf16, WS_WD), nb * 32, kb * 64, scr, F.lane); }
    }
}

__device__ __forceinline__ float softplusf(float x) { return x > 20.f ? x : log1pf(__expf(x)); }
__device__ __forceinline__ void dn_combine(Frame& F) {
    const int gw = F.vcu * NWAVES + F.wave, NGW = F.G * NWAVES, lane = F.lane;
    const bf16* OFp = WSP(bf16, WS_OF); const bf16* OBp = WSP(bf16, WS_OB); const bf16* Z = DOP(bf16, DO_Z); bf16* Y = WSP(bf16, WS_XB); const float* gn = F.in[9];
    const int cb = (16 * lane) & 127; float gv[16];
#pragma unroll
    for (int i = 0; i < 16; ++i) gv[i] = gn[cb + i];
    for (int t0 = gw; t0 < SEQ; t0 += 2 * NGW) {
        v4u a[2][2], b[2][2], z[2][2];
#pragma unroll
        for (int k = 0; k < 2; ++k) { const int t = (t0 + k * NGW < SEQ) ? t0 + k * NGW : t0; const size_t off = (size_t)t * 1024 + 16 * lane;
            a[k][0] = *(const v4u*)(OFp + off); a[k][1] = *(const v4u*)(OFp + off + 8); b[k][0] = *(const v4u*)(OBp + off); b[k][1] = *(const v4u*)(OBp + off + 8);
            z[k][0] = *(const v4u*)(Z + off); z[k][1] = *(const v4u*)(Z + off + 8); }
#pragma unroll
        for (int k = 0; k < 2; ++k) {
            const int t = t0 + k * NGW; if (t >= SEQ) break;
            float o[16], zz[16];
#pragma unroll
            for (int i = 0; i < 4; ++i) { o[2 * i] = bflo(a[k][0][i]) + bflo(b[k][0][i]); o[2 * i + 1] = bfhi(a[k][0][i]) + bfhi(b[k][0][i]); o[8 + 2 * i] = bflo(a[k][1][i]) + bflo(b[k][1][i]); o[8 + 2 * i + 1] = bfhi(a[k][1][i]) + bfhi(b[k][1][i]);
                zz[2 * i] = bflo(z[k][0][i]); zz[2 * i + 1] = bfhi(z[k][0][i]); zz[8 + 2 * i] = bflo(z[k][1][i]); zz[8 + 2 * i + 1] = bfhi(z[k][1][i]); }
            float ss = 0.f;
#pragma unroll
            for (int i = 0; i < 16; ++i) ss += o[i] * o[i];
            ss += __shfl_xor(ss, 1); ss += __shfl_xor(ss, 2); ss += __shfl_xor(ss, 4);
            const float rs = __builtin_amdgcn_rsqf(ss * (1.0f / 128.0f) + RMS_EPS);
            float y[16];
#pragma unroll
            for (int i = 0; i < 16; ++i) y[i] = o[i] * rs * gv[i] * siluf(zz[i]);
            v4u w0, w1;
#pragma unroll
            for (int i = 0; i < 4; ++i) { w0[i] = pk2(y[2 * i], y[2 * i + 1]); w1[i] = pk2(y[8 + 2 * i], y[8 + 2 * i + 1]); }
            bf16* yp = Y + (size_t)t * DM + 16 * lane; *(v4u*)yp = w0; *(v4u*)(yp + 8) = w1;
        }
    }
}
__device__ __forceinline__ void final_norm(Frame& F) {
    const int gw = F.vcu * NWAVES + F.wave, NGW = F.G * NWAVES, lane = F.lane;
    const float* ss = (const float*)(F.ws + WS_CTL + CTL_SUMSQ4); const GAS f32x4* g = (const GAS f32x4*)F.in[22]; const bf16* H3 = WSP(bf16, WS_H3B);
    for (int m0 = gw; m0 < SEQ; m0 += 2 * NGW) {
        v4u w[2][4]; float r[2];
#pragma unroll
        for (int k = 0; k < 2; ++k) { const int m = (m0 + k * NGW < SEQ) ? m0 + k * NGW : m0; const GAS v4u* hp = (const GAS v4u*)(H3 + (size_t)m * DM);
            r[k] = ss[m];
#pragma unroll
            for (int j = 0; j < 4; ++j) w[k][j] = hp[64 * j + lane]; }
#pragma unroll
        for (int k = 0; k < 2; ++k) {
            const int m = m0 + k * NGW; if (m >= SEQ) break;
            const float rr = __builtin_amdgcn_rsqf(r[k] * (1.0f / DM) + RMS_EPS);
            GAS f32x4* o = (GAS f32x4*)(F.out + (size_t)m * DM);
#pragma unroll
            for (int j = 0; j < 4; ++j) { const v4u x = w[k][j]; const int c4 = 2 * (64 * j + lane); const f32x4 g0 = g[c4], g1 = g[c4 + 1];
                o[c4] = (f32x4){bflo(x.x) * rr * g0[0], bfhi(x.x) * rr * g0[1], bflo(x.y) * rr * g0[2], bfhi(x.y) * rr * g0[3]};
                o[c4 + 1] = (f32x4){bflo(x.z) * rr * g1[0], bfhi(x.z) * rr * g1[1], bflo(x.w) * rr * g1[2], bfhi(x.w) * rr * g1[3]}; }
        }
    }
}

__device__ __forceinline__ int t5_bucket(int rel) {
    const int n = rel < 0 ? -rel : rel; int b;
    if (n < 8) b = n; else { int k = (31 - __builtin_clz((unsigned)(n * n))) - 6; b = 8 + k; if (b > 15) b = 15; }
    return (rel > 0 ? 16 : 0) + b;
}
template <int MODE  >
__device__ __forceinline__ void attn_unit(Frame& F, const bf16* Q, int qpitch, const bf16* Kp, const bf16* Vp, int kvpitch, bf16* O, int opitch, int q0, int kt_beg, int kt_end, const LAS float* btab, float sink2) {
    LAS unsigned char* Ks = F.lds + RING_OFF; LAS unsigned char* Vs = Ks + 16384;
    const int lane = F.lane, c = lane & 15, g = lane >> 4, qw0 = q0 + 16 * F.wave, tid = F.tid;
    bf16x8 qf[4];
#pragma unroll
    for (int t = 0; t < 4; ++t) qf[t] = *(const bf16x8*)(Q + (size_t)(qw0 + c) * qpitch + 32 * t + 8 * g);
    f32x4 oacc[8];
#pragma unroll
    for (int i = 0; i < 8; ++i) oacc[i] = (f32x4){0.f, 0.f, 0.f, 0.f};
    float mrun = (MODE == 0) ? sink2 : -1e30f, lsum = (MODE == 0 && g == 0) ? 1.0f : 0.0f;
    v4u kpre[2], vpre[2];
#pragma unroll
    for (int i = 0; i < 2; ++i) { const int ci = tid + 512 * i, key = ci >> 4, ch = ci & 15;
        kpre[i] = *(const v4u*)(Kp + (size_t)(64 * kt_beg + key) * kvpitch + ch * 8); vpre[i] = *(const v4u*)(Vp + (size_t)(64 * kt_beg + key) * kvpitch + ch * 8); }
    for (int kt = kt_beg; kt < kt_end; ++kt) {
        __syncthreads();
#pragma unroll
        for (int i = 0; i < 2; ++i) { const int ci = tid + 512 * i, key = ci >> 4, ch = ci & 15;
            *(LAS v4u*)(Ks + key * 256 + ((ch ^ (key & 15)) << 4)) = kpre[i]; *(LAS v4u*)(Vs + key * 256 + ((ch ^ ((key & 7) << 1)) << 4)) = vpre[i]; }
        if (kt + 1 < kt_end) {
#pragma unroll
            for (int i = 0; i < 2; ++i) { const int ci = tid + 512 * i, key = ci >> 4, ch = ci & 15;
                kpre[i] = *(const v4u*)(Kp + (size_t)(64 * (kt + 1) + key) * kvpitch + ch * 8); vpre[i] = *(const v4u*)(Vp + (size_t)(64 * (kt + 1) + key) * kvpitch + ch * 8); } }
        __syncthreads();
        bool rel_ok = true;
        if (MODE == 0) rel_ok = (64 * kt <= qw0 + 15 + 128) && (64 * kt + 63 >= qw0 - 128);
        if (!rel_ok) continue;
        f32x4 s[4];
#pragma unroll
        for (int mt = 0; mt < 4; ++mt) s[mt] = (f32x4){0.f, 0.f, 0.f, 0.f};
#pragma unroll
        for (int t = 0; t < 4; ++t)
#pragma unroll
            for (int mt = 0; mt < 4; ++mt) { const bf16x8 kf = *(const LAS bf16x8*)(Ks + (16 * mt + c) * 256 + (((4 * t + g) ^ c) << 4));
                s[mt] = __builtin_amdgcn_mfma_f32_16x16x32_bf16(kf, qf[t], s[mt], 0, 0, 0); }
        float tmax = -INFINITY;
#pragma unroll
        for (int mt = 0; mt < 4; ++mt)
#pragma unroll
            for (int r = 0; r < 4; ++r) {
                if (MODE == 0) { const int rel = (64 * kt + 16 * mt + 4 * g + r) - (qw0 + c); const bool ok = (rel >= -128) && (rel <= 128);
                    const int ri = ok ? rel + 128 : 128; const float bv = btab[ri]; s[mt][r] = ok ? s[mt][r] + bv : -INFINITY; }
                tmax = fmaxf(tmax, s[mt][r]); }
        tmax = fmaxf(tmax, __shfl_xor(tmax, 16)); tmax = fmaxf(tmax, __shfl_xor(tmax, 32));
        const float mnew = fmaxf(mrun, tmax), alpha = __builtin_amdgcn_exp2f(mrun - mnew); mrun = mnew; float ps = 0.f;
#pragma unroll
        for (int mt = 0; mt < 4; ++mt)
#pragma unroll
            for (int r = 0; r < 4; ++r) { const float p = __builtin_amdgcn_exp2f(s[mt][r] - mnew); s[mt][r] = p; ps += p; }
        lsum = lsum * alpha + ps;
#pragma unroll
        for (int i = 0; i < 8; ++i) oacc[i] = oacc[i] * alpha;
        bf16x8 pf[2];
#pragma unroll
        for (int t2 = 0; t2 < 2; ++t2) { v4u w; w.x = cvtpk(s[2 * t2][0], s[2 * t2][1]); w.y = cvtpk(s[2 * t2][2], s[2 * t2][3]); w.z = cvtpk(s[2 * t2 + 1][0], s[2 * t2 + 1][1]); w.w = cvtpk(s[2 * t2 + 1][2], s[2 * t2 + 1][3]);
            pf[t2] = __builtin_bit_cast(bf16x8, w); }
        const int q4 = c >> 2, p4 = c & 3;
#pragma unroll
        for (int t2 = 0; t2 < 2; ++t2)
#pragma unroll
            for (int mo = 0; mo < 8; ++mo) {
                const int k1 = 32 * t2 + 4 * g + q4, k2 = k1 + 16, chn = 2 * mo + (p4 >> 1);
                const s16x4 lo = __builtin_bit_cast(s16x4, __builtin_amdgcn_ds_read_tr16_b64_v4i16((LAS s16x4*)(Vs + k1 * 256 + ((chn ^ ((k1 & 7) << 1)) << 4) + (p4 & 1) * 8)));
                const s16x4 hi = __builtin_bit_cast(s16x4, __builtin_amdgcn_ds_read_tr16_b64_v4i16((LAS s16x4*)(Vs + k2 * 256 + ((chn ^ ((k2 & 7) << 1)) << 4) + (p4 & 1) * 8)));
                const bf16x8 vf = (bf16x8){lo[0], lo[1], lo[2], lo[3], hi[0], hi[1], hi[2], hi[3]};
                oacc[mo] = __builtin_amdgcn_mfma_f32_16x16x32_bf16(vf, pf[t2], oacc[mo], 0, 0, 0); }
    }
    lsum += __shfl_xor(lsum, 16); lsum += __shfl_xor(lsum, 32);
    const float inv = 1.0f / lsum;
#pragma unroll
    for (int mo = 0; mo < 8; ++mo) { v2u w; w.x = cvtpk(oacc[mo][0] * inv, oacc[mo][1] * inv); w.y = cvtpk(oacc[mo][2] * inv, oacc[mo][3] * inv);
        *(v2u*)(O + (size_t)(qw0 + c) * opitch + 16 * mo + 4 * g) = w; }
}
__device__ __forceinline__ void swa_phase(Frame& F, int b0, int nb) {
    LAS float* btab = (LAS float*)(F.lds + RING_OFF + 32768);
    const bf16* QS = DOP(bf16, DO_QSW); const bf16* KV = DOP(bf16, DO_KVSW); bf16* Y = WSP(bf16, WS_XB);
    (void)b0; (void)nb;
    unsigned* qctr = (unsigned*)(F.ctl + CW_SWAQ);
    for (;;) {
        __syncthreads();
        if (F.tid == 0) F.MISC[12] = __hip_atomic_fetch_add(qctr, 1u, __ATOMIC_RELAXED, __HIP_MEMORY_SCOPE_AGENT);
        __syncthreads();
        const int u = (int)F.MISC[12];
        if (u >= SWH * (SEQ / 128)) break;
        const int h = u & 7, qb = u >> 3, kvh = h >> 2;
        __syncthreads();
        if (F.tid < 257) btab[F.tid] = F.in[11][t5_bucket(F.tid - 128) * 8 + h] * LOG2E;
        __syncthreads();
        int kb = 2 * qb - 2, ke = 2 * qb + 4; if (kb < 0) kb = 0; if (ke > SEQ / 64) ke = SEQ / 64;
        attn_unit<0>(F, QS + h * 128, 1024, KV + kvh * 128, KV + 256 + kvh * 128, 512, Y + 1024 + h * 128, DM, qb * 128, kb, ke, btab, F.in[10][h] * LOG2E);
    }
}
__device__ __forceinline__ void mem_attn_phase(Frame& F) {
    const bf16* QM = WSP(bf16, WS_QM); const bf16* KVm = WSP(bf16, WS_KVM); bf16* OM = WSP(bf16, WS_OM);
    for (int u = blockIdx.x; u < MEMH * (SEQ / 128); u += F.G) {
        const int h = u & 3, qb = u >> 2;
        attn_unit<1>(F, QM + h * 128, 512, KVm + h * 128, KVm + 512 + h * 128, 1024, OM + h * 128, 512, qb * 128, 0, 4, nullptr, 0.f);
    }
}

typedef float f32x16 __attribute__((ext_vector_type(16)));
constexpr int DX_W = 0, DX_K = 16384, DX_U = 32768, DX_Q = 49152, DX_A = 65536, DX_BYTES = 73728;
constexpr size_t WS_GL = 1 * MiB + 128 * 1024;
constexpr int L_RAW = 0, RAW_PITCH = 784, L_MTF = 0, L_MTB = 16384, L_TB = 32768, TB_PITCH = 144, TB_SZ = 9216;
constexpr int L_QB = 69632, L_KB = 86016, L_KT = 102400, L_VT = 120832, L_PART = 139264, L_SC = 143360;
constexpr int L_CW = 145408;
static_assert(L_SC + 2048 <= L_CW && L_CW + 7680 <= LDSCTL_OFF, "prep LDS map");
__device__ __forceinline__ unsigned char* dnx_rec(Frame& F, int dir, int hd, int cn) { return F.ws + WS_DNX + (size_t)((dir * 8 + hd) * 256 + cn) * DX_BYTES; }
__device__ __forceinline__ v4u pack8f(const float* v) { v4u w; w.x = cvtpk(v[0], v[1]); w.y = cvtpk(v[2], v[3]); w.z = cvtpk(v[4], v[5]); w.w = cvtpk(v[6], v[7]); return w; }

__device__ __forceinline__ bf16x8 cvt8(const f32x16& v, int o) { v4u w; w.x = cvtpk(v[o], v[o + 1]); w.y = cvtpk(v[o + 2], v[o + 3]); w.z = cvtpk(v[o + 4], v[o + 5]); w.w = cvtpk(v[o + 6], v[o + 7]); return __builtin_bit_cast(bf16x8, w); }
__device__ __forceinline__ bf16x8 cvt8f(f32x4 a, f32x4 b) { v4u w; w.x = cvtpk(a[0], a[1]); w.y = cvtpk(a[2], a[3]); w.z = cvtpk(b[0], b[1]); w.w = cvtpk(b[2], b[3]); return __builtin_bit_cast(bf16x8, w); }
template <int dir> __device__ __forceinline__ void dn_solve_and_write(LAS unsigned char* lds, int lane) {
    const LAS float* MT = (const LAS float*)(lds + (dir ? L_MTB : L_MTF));
    LAS float* T0 = (LAS float*)(lds + L_TB + dir * 2 * TB_SZ);
    LAS float* Trow = T0 + lane * 68;
    const int blk = lane >> 5, cb = 32 * blk;
#pragma unroll 1
    for (int jr = 7; jr >= 0; --jr) {
        const int j0 = cb + 4 * jr;
        float a0 = (lane == j0) ? 1.f : 0.f, a1 = (lane == j0 + 1) ? 1.f : 0.f, a2 = (lane == j0 + 2) ? 1.f : 0.f, a3 = (lane == j0 + 3) ? 1.f : 0.f;
        const LAS float* mr = MT + j0 * 64;
#pragma unroll 1
        for (int sr = jr + 1; sr < 8; ++sr) {
            const int s0 = cb + 4 * sr;
            const f32x4 tv = *(const LAS f32x4*)(Trow + s0);
            const f32x4 m0 = *(const LAS f32x4*)(mr + s0), m1 = *(const LAS f32x4*)(mr + 64 + s0), m2 = *(const LAS f32x4*)(mr + 128 + s0), m3 = *(const LAS f32x4*)(mr + 192 + s0);
            a0 -= (tv[0] * m0[0] + tv[1] * m0[1]) + (tv[2] * m0[2] + tv[3] * m0[3]);
            a1 -= (tv[0] * m1[0] + tv[1] * m1[1]) + (tv[2] * m1[2] + tv[3] * m1[3]);
            a2 -= (tv[0] * m2[0] + tv[1] * m2[1]) + (tv[2] * m2[2] + tv[3] * m2[3]);
            a3 -= (tv[0] * m3[0] + tv[1] * m3[1]) + (tv[2] * m3[2] + tv[3] * m3[3]);
        }
        const f32x4 d0 = *(const LAS f32x4*)(mr + j0), d1 = *(const LAS f32x4*)(mr + 64 + j0), d2 = *(const LAS f32x4*)(mr + 128 + j0);
        const float t3 = a3, t2 = a2 - t3 * d2[3], t1 = a1 - t2 * d1[2] - t3 * d1[3], t0 = a0 - t1 * d0[1] - t2 * d0[2] - t3 * d0[3];
        *(LAS f32x4*)(Trow + j0) = (f32x4){t0, t1, t2, t3};
    }
    if (blk == 0) {
#pragma unroll
        for (int q = 8; q < 16; ++q) *(LAS f32x4*)(Trow + 4 * q) = (f32x4){0.f, 0.f, 0.f, 0.f}; }
    asm volatile("s_waitcnt lgkmcnt(0)" ::: "memory");
    {
        const int r = lane & 31, lh = lane >> 5;
        f32x16 Y;
#pragma unroll
        for (int e = 0; e < 16; ++e) Y[e] = 0.f;
#pragma unroll
        for (int kk = 0; kk < 2; ++kk) {
            float av[8], bv[8];
#pragma unroll
            for (int jj = 0; jj < 8; ++jj) { const int k = 16 * kk + 8 * lh + jj; av[jj] = MT[k * 64 + 32 + r]; bv[jj] = T0[k * 68 + r]; }
            Y = __builtin_amdgcn_mfma_f32_32x32x16_bf16(cvt8f((f32x4){av[0], av[1], av[2], av[3]}, (f32x4){av[4], av[5], av[6], av[7]}), cvt8f((f32x4){bv[0], bv[1], bv[2], bv[3]}, (f32x4){bv[4], bv[5], bv[6], bv[7]}), Y, 0, 0, 0);
        }
        f32x16 Z;
#pragma unroll
        for (int e = 0; e < 16; ++e) Z[e] = 0.f;
#pragma unroll
        for (int kk = 0; kk < 2; ++kk) {
            const f32x4 t0 = *(const LAS f32x4*)(T0 + (32 + r) * 68 + 32 + 16 * kk + 4 * lh), t1 = *(const LAS f32x4*)(T0 + (32 + r) * 68 + 32 + 16 * kk + 8 + 4 * lh);
            Z = __builtin_amdgcn_mfma_f32_32x32x16_bf16(cvt8f(t0, t1), cvt8(Y, 8 * kk), Z, 0, 0, 0);
        }
#pragma unroll
        for (int e = 0; e < 16; ++e) T0[(32 + (e & 3) + 8 * (e >> 2) + 4 * lh) * 68 + r] = -Z[e];
    }
    asm volatile("s_waitcnt lgkmcnt(0)" ::: "memory");
    f32x4 tr[16];
#pragma unroll
    for (int q = 0; q < 16; ++q) tr[q] = *(const LAS f32x4*)(Trow + 4 * q);
    asm volatile("s_waitcnt lgkmcnt(0)" ::: "memory");
    const LAS float* sc = (const LAS float*)(lds + L_SC);
    const LAS float* cU = sc + (dir ? 384 : 256); const LAS float* cW = sc + (dir ? 448 : 320);
    const int pos = dir ? 63 - lane : lane;
    LAS unsigned char* tu = lds + L_TB + dir * 2 * TB_SZ + pos * TB_PITCH; LAS unsigned char* tw = tu + TB_SZ;
#pragma unroll
    for (int q = 0; q < 8; ++q) {
        float u8[8], w8[8];
#pragma unroll
        for (int e = 0; e < 8; ++e) { const int s = 8 * q + e, sp = dir ? 63 - s : s; const float t = tr[sp >> 2][sp & 3]; u8[e] = t * cU[s]; w8[e] = t * cW[s]; }
        *(LAS v4u*)(tu + q * 16) = pack8f(u8); *(LAS v4u*)(tw + q * 16) = pack8f(w8);
    }
}

struct PrepRegs { v4u raw[7]; };
__device__ __forceinline__ void prep_load(Frame& F, int u, int tid, int lane, PrepRegs& R) {
    const int cn = u >> 3, hd = u & 7; const bf16* QKV = WSP(bf16, WS_QKV);
#pragma unroll
    for (int k = 0; k < 7; ++k) { const int ci = tid + 512 * k; const int row = ci / 48, cc = ci % 48, seg = cc >> 4, ch = (cc & 15) * 8, tok = 64 * cn - 2 + row;
        v4u v = (v4u){0u, 0u, 0u, 0u};
        if (ci < 68 * 48 && tok >= 0 && tok < SEQ) v = *(const v4u*)(QKV + (size_t)tok * 3072 + seg * 1024 + hd * 128 + ch);
        R.raw[k] = v; }
}
#define DNX_ST(ptr, val) do { const v4u v_ = (val); if (MASK & 32) *(v4u*)(ptr) = v_; else asm volatile("" :: "v"(v_)); } while (0)
template <int MASK> __device__ __forceinline__ void dn_prep_unit(Frame& F, int cn, int hd, PrepRegs& PR, int next_u) {
    LAS unsigned char* lds = F.lds; int tid = F.tid, lane = F.lane; const int wave = F.wave;
    asm volatile("" : "+v"(tid), "+v"(lane));
    LAS float* sc = (LAS float*)(lds + L_SC);
    __syncthreads();
    if (MASK & 1) {
    float abv[4] = {0.f, 0.f, 0.f, 0.f};
    if (wave == 0) { const float* ab = WSP(float, WS_AB) + (size_t)(64 * cn + lane) * 32; abv[0] = ab[hd]; abv[1] = ab[8 + hd]; abv[2] = ab[16 + hd]; abv[3] = ab[24 + hd]; }
    prep_load(F, cn * 8 + hd, tid, lane, PR);
#pragma unroll
    for (int k = 0; k < 7; ++k) { const int ci = tid + 512 * k; const int row = ci / 48, cc = ci % 48, seg = cc >> 4, ch = (cc & 15) * 8;
        if (ci < 68 * 48) *(LAS v4u*)(lds + L_RAW + row * RAW_PITCH + (seg * 128 + ch) * 2) = PR.raw[k]; }
    if (wave == 0) {
        const float bfv = 1.0f / (1.0f + __expf(-abv[0])), bbv = 1.0f / (1.0f + __expf(-abv[1]));
        const float gf = -__expf(F.in[5][hd]) * softplusf(abv[2] + F.in[7][hd]), gb = -__expf(F.in[6][hd]) * softplusf(abv[3] + F.in[8][hd]);
        float Gf = gf, Gb = gb;
#pragma unroll
        for (int o = 1; o < 64; o <<= 1) { const float a = __shfl_up(Gf, o), b = __shfl_down(Gb, o); if (lane >= o) Gf += a; if (lane + o < 64) Gb += b; }
        sc[lane] = Gf; sc[64 + lane] = Gb; sc[128 + lane] = bfv; sc[192 + lane] = bbv;
        sc[256 + lane] = bfv; sc[320 + lane] = -bfv * __expf(Gf); sc[384 + lane] = bbv; sc[448 + lane] = -bbv * __expf(Gb);
        float* GL = WSP(float, WS_GL);
        if (MASK & 32) { if (lane == 63) GL[(0 * 8 + hd) * 256 + cn] = __expf(Gf);
        if (lane == 0) GL[(1 * 8 + hd) * 256 + cn] = __expf(Gb); }
    }
    }
    __syncthreads();
    asm volatile("" : "+v"(tid), "+v"(lane));
    if (MASK & 2) {
        const int t = wave, pos = lane; const LAS float* cw = (const LAS float*)(lds + L_CW) + 16 * t;
        float qv[16], kv[16], vv[16];
#pragma unroll
        for (int seg = 0; seg < 3; ++seg) {
            float a[16];
#pragma unroll
            for (int i = 0; i < 16; ++i) a[i] = 0.f;
#pragma unroll
            for (int j = 0; j < 5; ++j) {
                const LAS unsigned char* rp = lds + L_RAW + (pos + j) * RAW_PITCH + (seg * 128 + 16 * t) * 2;
                const v4u r0 = *(const LAS v4u*)rp, r1 = *(const LAS v4u*)(rp + 16);
                const LAS float* w = cw + j * 384 + seg * 128;
#pragma unroll
                for (int i = 0; i < 4; ++i) { a[2 * i] += w[2 * i] * bflo(r0[i]); a[2 * i + 1] += w[2 * i + 1] * bfhi(r0[i]); a[8 + 2 * i] += w[8 + 2 * i] * bflo(r1[i]); a[8 + 2 * i + 1] += w[8 + 2 * i + 1] * bfhi(r1[i]); }
            }
#pragma unroll
            for (int i = 0; i < 16; ++i) { const float s = siluf(a[i]); if (seg == 0) qv[i] = s; else if (seg == 1) kv[i] = s; else vv[i] = s; }
        }
        float sq = 0.f, sk = 0.f;
#pragma unroll
        for (int i = 0; i < 16; ++i) { sq += qv[i] * qv[i]; sk += kv[i] * kv[i]; }
        LAS float* part = (LAS float*)(lds + L_PART);
        part[t * 64 + pos] = sq; part[512 + t * 64 + pos] = sk;
        __syncthreads();
        float tq = 0.f, tk = 0.f;
#pragma unroll
        for (int i = 0; i < 8; ++i) { tq += part[i * 64 + pos]; tk += part[512 + i * 64 + pos]; }
        const float rq = (1.0f / sqrtf(tq + 1e-6f)) * 0.08838834764831845f, rk = 1.0f / sqrtf(tk + 1e-6f);
#pragma unroll
        for (int i = 0; i < 16; ++i) { qv[i] *= rq; kv[i] *= rk; }
        *(LAS v4u*)(lds + L_QB + pos * 256 + (((2 * t) ^ (pos & 15)) << 4)) = pack8f(qv); *(LAS v4u*)(lds + L_QB + pos * 256 + (((2 * t + 1) ^ (pos & 15)) << 4)) = pack8f(qv + 8);
        *(LAS v4u*)(lds + L_KB + pos * 256 + (((2 * t) ^ (pos & 15)) << 4)) = pack8f(kv); *(LAS v4u*)(lds + L_KB + pos * 256 + (((2 * t + 1) ^ (pos & 15)) << 4)) = pack8f(kv + 8);
#pragma unroll
        for (int i = 0; i < 16; ++i) { const unsigned w = cvtpk(kv[i], vv[i]); *(LAS unsigned short*)(lds + L_KT + (16 * t + i) * TB_PITCH + pos * 2) = (unsigned short)w; *(LAS unsigned short*)(lds + L_VT + (16 * t + i) * TB_PITCH + pos * 2) = (unsigned short)(w >> 16); }
        const float ef = __expf(sc[pos]), eb = __expf(sc[64 + pos]); const int mt = pos >> 5;
#pragma unroll
        for (int dir = 0; dir < 2; ++dir) { const float e = dir ? eb : ef; unsigned char* rec = dnx_rec(F, dir, hd, cn) + DX_Q;
#pragma unroll
            for (int lh = 0; lh < 2; ++lh) { float o8[8];
#pragma unroll
                for (int j = 0; j < 8; ++j) o8[j] = qv[8 * (j >> 2) + 4 * lh + (j & 3)] * e;
                DNX_ST(rec + ((mt * 8 + t) * 64 + 32 * lh + (pos & 31)) * 16, pack8f(o8)); } }
    }
    __syncthreads();
    asm volatile("" : "+v"(tid), "+v"(lane));
    if (MASK & 4) {
        const int r = lane & 31, lh = lane >> 5, x = wave & 3, ta = x >> 1, tb = x & 1;
        const LAS unsigned char* Ab = lds + L_KB + (32 * ta + r) * 256; const LAS unsigned char* Bb = lds + (wave < 4 ? L_KB : L_QB) + (32 * tb + r) * 256;
        f32x16 acc;
#pragma unroll
        for (int i = 0; i < 16; ++i) acc[i] = 0.f;
#pragma unroll
        for (int kk = 0; kk < 8; ++kk) { const int ch = ((2 * kk + lh) ^ (r & 15)) << 4;
            acc = __builtin_amdgcn_mfma_f32_32x32x16_bf16(*(const LAS bf16x8*)(Ab + ch), *(const LAS bf16x8*)(Bb + ch), acc, 0, 0, 0); }
        const int b = 32 * tb + r;
        if (wave < 4) {
            const float Gfb = sc[b], Gbb = sc[64 + b];
#pragma unroll
            for (int q = 0; q < 4; ++q) { const int a0 = 32 * ta + 8 * q + 4 * lh; f32x4 mf, mb;
#pragma unroll
                for (int e = 0; e < 4; ++e) { const int a = a0 + e; const float kkv = acc[4 * q + e];
                    const float vf = sc[128 + a] * kkv * __expf(fminf(sc[a] - Gfb, 0.f)), vb = sc[192 + a] * kkv * __expf(fminf(sc[64 + a] - Gbb, 0.f));
                    mf[e] = (a > b) ? vf : 0.f; mb[3 - e] = (a < b) ? vb : 0.f; }
                *(LAS f32x4*)(lds + L_MTF + (b * 64 + a0) * 4) = mf; *(LAS f32x4*)(lds + L_MTB + ((63 - b) * 64 + 60 - a0) * 4) = mb; }
        } else {
            const float Gfc = sc[b], Gbc = sc[64 + b];
#pragma unroll
            for (int dir = 0; dir < 2; ++dir) { unsigned char* rec = dnx_rec(F, dir, hd, cn) + DX_A;
#pragma unroll
                for (int s2 = 0; s2 < 2; ++s2) { float o8[8];
#pragma unroll
                    for (int j = 0; j < 8; ++j) { const int s = 32 * ta + 16 * s2 + 8 * (j >> 2) + 4 * lh + (j & 3); const float v = acc[8 * s2 + j];
                        const float ev = v * __expf(fminf(dir ? Gbc - sc[64 + s] : Gfc - sc[s], 0.f)); o8[j] = (dir ? (s >= b) : (s <= b)) ? ev : 0.f; }
                    DNX_ST(rec + ((tb * 4 + 2 * ta + s2) * 64 + lane) * 16, pack8f(o8)); } }
        }
    }
    __syncthreads();
    asm volatile("" : "+v"(tid), "+v"(lane));
    if (!(MASK & 8)) {} else if (wave == 0) dn_solve_and_write<0>(lds, lane);
    else if (wave == 1) dn_solve_and_write<1>(lds, lane);
    else {
        const int r = lane & 31, lh = lane >> 5;
        for (int f = wave - 2; f < 32; f += 6) { const int dir = f >> 4, m = (f >> 2) & 3, t = f & 3; const int dk = 32 * m + r;
            const v2u k0 = *(const LAS v2u*)(lds + L_KT + dk * TB_PITCH + (16 * t + 4 * lh) * 2), k1 = *(const LAS v2u*)(lds + L_KT + dk * TB_PITCH + (16 * t + 8 + 4 * lh) * 2);
            const float Gl = dir ? sc[64] : sc[63]; const LAS float* Gs = sc + (dir ? 64 : 0) + 16 * t + 4 * lh; float o8[8];
            o8[0] = bflo(k0.x) * __expf(Gl - Gs[0]); o8[1] = bfhi(k0.x) * __expf(Gl - Gs[1]); o8[2] = bflo(k0.y) * __expf(Gl - Gs[2]); o8[3] = bfhi(k0.y) * __expf(Gl - Gs[3]);
            o8[4] = bflo(k1.x) * __expf(Gl - Gs[8]); o8[5] = bfhi(k1.x) * __expf(Gl - Gs[9]); o8[6] = bflo(k1.y) * __expf(Gl - Gs[10]); o8[7] = bfhi(k1.y) * __expf(Gl - Gs[11]);
            DNX_ST(dnx_rec(F, dir, hd, cn) + DX_K + ((m * 4 + t) * 64 + lane) * 16, pack8f(o8)); }
    }
    __syncthreads();
    asm volatile("" : "+v"(tid), "+v"(lane));
    if (MASK & 16) {
        const int dir = wave >> 2, x = wave & 3, r = lane & 31, lh = lane >> 5;
        const LAS unsigned char* Tu = lds + L_TB + (dir ? 2 : 0) * TB_SZ; const LAS unsigned char* Tw = Tu + TB_SZ;
        unsigned char* rec = dnx_rec(F, dir, hd, cn);
#pragma unroll
        for (int mt = 0; mt < 2; ++mt) {
            f32x16 aw, au;
#pragma unroll
            for (int i = 0; i < 16; ++i) { aw[i] = 0.f; au[i] = 0.f; }
#pragma unroll
            for (int kk = 0; kk < 4; ++kk) { const int so = (16 * kk + 8 * lh) * 2;
                aw = __builtin_amdgcn_mfma_f32_32x32x16_bf16(*(const LAS bf16x8*)(lds + L_KT + (32 * x + r) * TB_PITCH + so), *(const LAS bf16x8*)(Tw + (32 * mt + r) * TB_PITCH + so), aw, 0, 0, 0);
                au = __builtin_amdgcn_mfma_f32_32x32x16_bf16(*(const LAS bf16x8*)(Tu + (32 * mt + r) * TB_PITCH + so), *(const LAS bf16x8*)(lds + L_VT + (32 * x + r) * TB_PITCH + so), au, 0, 0, 0); }
            float tmp[16];
#pragma unroll
            for (int i = 0; i < 16; ++i) tmp[i] = aw[i];
            DNX_ST(rec + DX_W + ((mt * 8 + 2 * x) * 64 + lane) * 16, pack8f(tmp)); DNX_ST(rec + DX_W + ((mt * 8 + 2 * x + 1) * 64 + lane) * 16, pack8f(tmp + 8));
#pragma unroll
            for (int i = 0; i < 16; ++i) tmp[i] = au[i];
            DNX_ST(rec + DX_U + ((x * 2 + mt) * 64 + lane) * 32, pack8f(tmp)); DNX_ST(rec + DX_U + ((x * 2 + mt) * 64 + lane) * 32 + 16, pack8f(tmp + 8));
        }
    }
}
#undef DNX_ST
template <int MASK> __device__ __forceinline__ void dn_prep_phase(Frame& F) {
    PrepRegs PR; int u = blockIdx.x; int cur_hd = -1;
    for (; u < 256 * DNH; u += F.G) {
        const int hd = u & 7;
        if (hd != cur_hd) {
            __syncthreads();
            for (int i = F.tid; i < 5 * 384; i += NWAVES * 64) { const int j = i / 384, c = i % 384; ((LAS float*)(F.lds + L_CW))[i] = F.in[4][j * 3072 + (c >> 7) * 1024 + hd * 128 + (c & 127)]; }
            cur_hd = hd;
        }
        dn_prep_unit<MASK>(F, u >> 3, hd, PR, u + F.G);
    }
}


constexpr int NSEG = 16, SEGL = 16;
constexpr size_t WS_PF = 176 * MiB, WS_RG = 184 * MiB, WS_SIN = 24 * MiB;
constexpr int SLOT1 = 49152, SLOT3 = 73728, L_GLS = 147456;
#define DN_WAIT(V) asm volatile("s_waitcnt vmcnt(" #V ") lgkmcnt(0)" ::: "memory")
#define DN_BAR() do { __builtin_amdgcn_s_barrier(); asm volatile("" ::: "memory"); } while (0)
__device__ __forceinline__ int seg_chunk(int dir, int g, int i) { const int n = SEGL * g + i; return dir ? 255 - n : n; }
__device__ __forceinline__ void u_to_acc(f32x16& a, const LAS unsigned char* up) {
    const v4u u0 = *(const LAS v4u*)up, u1 = *(const LAS v4u*)(up + 16);
#pragma unroll
    for (int i = 0; i < 4; ++i) { a[2 * i] = bflo(u0[i]); a[2 * i + 1] = bfhi(u0[i]); a[8 + 2 * i] = bflo(u1[i]); a[8 + 2 * i + 1] = bfhi(u1[i]); }
}
template <bool OUT>
__device__ __forceinline__ void dn_step(f32x16 (&S)[4], f32x16 (&aV)[2], f32x16 (&aO)[2], const LAS unsigned char* buf, float gl) {
#pragma unroll
    for (int t = 0; t < 8; ++t) { const bf16x8 sb = cvt8(S[t >> 1], 8 * (t & 1));
#pragma unroll
        for (int mt = 0; mt < 2; ++mt) {
            aV[mt] = __builtin_amdgcn_mfma_f32_32x32x16_bf16(*(const LAS bf16x8*)(buf + DX_W + (mt * 8 + t) * 1024), sb, aV[mt], 0, 0, 0);
            if (OUT) aO[mt] = __builtin_amdgcn_mfma_f32_32x32x16_bf16(*(const LAS bf16x8*)(buf + DX_Q + (mt * 8 + t) * 1024), sb, aO[mt], 0, 0, 0); } }
    bf16x8 vb[4];
#pragma unroll
    for (int t = 0; t < 4; ++t) vb[t] = cvt8(aV[t >> 1], 8 * (t & 1));
#pragma unroll
    for (int m = 0; m < 4; ++m) S[m] = S[m] * gl;
#pragma unroll
    for (int t = 0; t < 4; ++t) {
#pragma unroll
        for (int m = 0; m < 4; ++m) S[m] = __builtin_amdgcn_mfma_f32_32x32x16_bf16(*(const LAS bf16x8*)(buf + DX_K + (m * 4 + t) * 1024), vb[t], S[m], 0, 0, 0);
        if (OUT) {
#pragma unroll
            for (int mt = 0; mt < 2; ++mt) aO[mt] = __builtin_amdgcn_mfma_f32_32x32x16_bf16(*(const LAS bf16x8*)(buf + DX_A + (mt * 4 + t) * 1024), vb[t], aO[mt], 0, 0, 0); } }
}

__device__ __forceinline__ void dn_pass1(Frame& F) {
    LAS unsigned char* lds = F.lds; const int lane = F.lane, wave = F.wave, r = lane & 31, lh = lane >> 5, part = wave >> 2, d = wave & 3;
    LAS float* gls = (LAS float*)(lds + L_GLS);
    for (int unit = blockIdx.x; unit < 16 * NSEG; unit += F.G) {
        const int dir = unit >> 7, hd = (unit >> 4) & 7, g = unit & 15;
        DN_WAIT(0); __syncthreads();
        if (F.tid < SEGL) gls[F.tid] = WSP(float, WS_GL)[(dir * 8 + hd) * 256 + seg_chunk(dir, g, F.tid)];
        DN_WAIT(0);
        f32x16 S[4];
#pragma unroll
        for (int m = 0; m < 4; ++m)
#pragma unroll
            for (int i = 0; i < 16; ++i) S[m][i] = (part && (32 * m + (i & 3) + 8 * (i >> 2) + 4 * lh == 32 * d + r)) ? 1.f : 0.f;
#define P1_ISSUE(i) do { const unsigned char* src_ = dnx_rec(F, dir, hd, seg_chunk(dir, g, (i))) + lane * 16; LAS unsigned char* dst_ = lds + ((i) % 3) * SLOT1; \
            _Pragma("unroll") for (int k_ = 0; k_ < 6; ++k_) { const int p_ = wave + 8 * k_; __builtin_amdgcn_global_load_lds((const unsigned*)(src_ + p_ * 1024), (LAS unsigned*)(dst_ + p_ * 1024), 16, 0, 0); } } while (0)
        P1_ISSUE(0); P1_ISSUE(1);
        for (int i = 0; i < SEGL; ++i) {
            if (i + 1 < SEGL) DN_WAIT(6); else DN_WAIT(0);
            DN_BAR();
            if (i + 2 < SEGL) P1_ISSUE(i + 2);
            const LAS unsigned char* buf = lds + (i % 3) * SLOT1 + lane * 16;
            f32x16 aV[2], aO[2];
#pragma unroll
            for (int mt = 0; mt < 2; ++mt) {
                if (part == 0) u_to_acc(aV[mt], lds + (i % 3) * SLOT1 + DX_U + ((d * 2 + mt) * 64 + lane) * 32);
                else {
#pragma unroll
                    for (int e = 0; e < 16; ++e) aV[mt][e] = 0.f; } }
            dn_step<false>(S, aV, aO, buf, gls[i]);
        }
#undef P1_ISSUE
        DN_WAIT(0); DN_BAR();
        if (part == 0) {
            float* rg = (float*)(F.ws + WS_RG) + (size_t)unit * 16384;
#pragma unroll
            for (int m = 0; m < 4; ++m)
#pragma unroll
                for (int q = 0; q < 4; ++q) *(f32x4*)(rg + ((d * 4 + m) * 64 + lane) * 16 + 4 * q) = (f32x4){S[m][4 * q], S[m][4 * q + 1], S[m][4 * q + 2], S[m][4 * q + 3]};
        } else {
#pragma unroll
            for (int m = 0; m < 4; ++m)
#pragma unroll
                for (int i = 0; i < 16; ++i) *(LAS unsigned short*)(lds + (32 * m + (i & 3) + 8 * (i >> 2) + 4 * lh) * 272 + (32 * d + r) * 2) = (unsigned short)f2bf(S[m][i]);
        }
        DN_WAIT(0); DN_BAR();
        if (part == 1) {
            unsigned char* pf = F.ws + WS_PF + (size_t)unit * 32768;
#pragma unroll
            for (int k = 0; k < 8; ++k) { const int f = d * 8 + k, m = f >> 3, t = f & 7;
                const v2u a = *(const LAS v2u*)(lds + (32 * m + r) * 272 + (16 * t + 4 * lh) * 2), b = *(const LAS v2u*)(lds + (32 * m + r) * 272 + (16 * t + 8 + 4 * lh) * 2);
                *(v4u*)(pf + (f * 64 + lane) * 16) = (v4u){a.x, a.y, b.x, b.y}; }
        }
    }
}
__device__ __forceinline__ void dn_fold(Frame& F) {
    const int b = blockIdx.x; if (b >= 16) return;
    LAS unsigned char* lds = F.lds; const int lane = F.lane, wave = F.wave, dir = b >> 3, hd = b & 7;
    const int unit0 = (dir * 8 + hd) * 16;
    __syncthreads();
    if (wave >= 4) {
        const int lw = wave - 4;
        for (int g = 0; g < NSEG; ++g) {
            if (g < NSEG - 1) { const unsigned char* src = F.ws + WS_PF + (size_t)(unit0 + g) * 32768 + lane * 16; LAS unsigned char* dst = lds + (g & 1) * 32768;
#pragma unroll
                for (int k = 0; k < 8; ++k) { const int p = lw + 4 * k; __builtin_amdgcn_global_load_lds((const unsigned*)(src + p * 1024), (LAS unsigned*)(dst + p * 1024), 16, 0, 0); } }
            DN_WAIT(0); DN_BAR();
        }
    } else {
        const int d = wave;
        f32x16 S[4], R[4];
#pragma unroll
        for (int m = 0; m < 4; ++m)
#pragma unroll
            for (int i = 0; i < 16; ++i) S[m][i] = 0.f;
        const float* rg0 = (const float*)(F.ws + WS_RG) + (size_t)unit0 * 16384; float* sin0 = (float*)(F.ws + WS_SIN) + (size_t)unit0 * 16384;
#pragma unroll
        for (int m = 0; m < 4; ++m)
#pragma unroll
            for (int q = 0; q < 4; ++q) { const f32x4 v = *(const f32x4*)(rg0 + ((d * 4 + m) * 64 + lane) * 16 + 4 * q); R[m][4 * q] = v[0]; R[m][4 * q + 1] = v[1]; R[m][4 * q + 2] = v[2]; R[m][4 * q + 3] = v[3]; }
        DN_BAR();
        for (int g = 0; g < NSEG; ++g) {
            float* so = sin0 + (size_t)g * 16384;
#pragma unroll
            for (int m = 0; m < 4; ++m)
#pragma unroll
                for (int q = 0; q < 4; ++q) *(f32x4*)(so + ((d * 4 + m) * 64 + lane) * 16 + 4 * q) = (f32x4){S[m][4 * q], S[m][4 * q + 1], S[m][4 * q + 2], S[m][4 * q + 3]};
            if (g == NSEG - 1) break;
            const LAS unsigned char* buf = lds + (g & 1) * 32768 + lane * 16;
            bf16x8 sb[8];
#pragma unroll
            for (int t = 0; t < 8; ++t) sb[t] = cvt8(S[t >> 1], 8 * (t & 1));
#pragma unroll
            for (int m = 0; m < 4; ++m) { S[m] = R[m];
#pragma unroll
                for (int t = 0; t < 8; ++t) S[m] = __builtin_amdgcn_mfma_f32_32x32x16_bf16(*(const LAS bf16x8*)(buf + (m * 8 + t) * 1024), sb[t], S[m], 0, 0, 0); }
            if (g + 1 < NSEG - 1) { const float* rg = rg0 + (size_t)(g + 1) * 16384;
#pragma unroll
                for (int m = 0; m < 4; ++m)
#pragma unroll
                    for (int q = 0; q < 4; ++q) { const f32x4 v = *(const f32x4*)(rg + ((d * 4 + m) * 64 + lane) * 16 + 4 * q); R[m][4 * q] = v[0]; R[m][4 * q + 1] = v[1]; R[m][4 * q + 2] = v[2]; R[m][4 * q + 3] = v[3]; } }
            asm volatile("s_waitcnt lgkmcnt(0)" ::: "memory");
            DN_BAR();
        }
    }
    __syncthreads();
}
__device__ __forceinline__ void dn_pass3(Frame& F) {
    LAS unsigned char* lds = F.lds; const int lane = F.lane, wave = F.wave, r = lane & 31, lh = lane >> 5;
    LAS float* gls = (LAS float*)(lds + L_GLS);
    for (int unit = blockIdx.x; unit < 16 * NSEG; unit += F.G) {
        const int dir = unit >> 7, hd = (unit >> 4) & 7, g = unit & 15;
        __syncthreads();
        if (F.tid < SEGL) gls[F.tid] = WSP(float, WS_GL)[(dir * 8 + hd) * 256 + seg_chunk(dir, g, F.tid)];
        asm volatile("s_waitcnt lgkmcnt(0)" ::: "memory");
        if (wave >= 4) {
            const int lw = wave - 4;
            for (int i = 0; i <= SEGL; ++i) {
                if (i < SEGL) { const unsigned char* src = dnx_rec(F, dir, hd, seg_chunk(dir, g, i)) + lane * 16; LAS unsigned char* dst = lds + (i & 1) * SLOT3;
#pragma unroll
                    for (int k = 0; k < 18; ++k) { const int p = lw + 4 * k; __builtin_amdgcn_global_load_lds((const unsigned*)(src + p * 1024), (LAS unsigned*)(dst + p * 1024), 16, 0, 0); } }
                DN_WAIT(0); DN_BAR();
            }
        } else {
            const int d = wave;
            f32x16 S[4];
            const float* si = (const float*)(F.ws + WS_SIN) + (size_t)unit * 16384;
#pragma unroll
            for (int m = 0; m < 4; ++m)
#pragma unroll
                for (int q = 0; q < 4; ++q) { const f32x4 v = *(const f32x4*)(si + ((d * 4 + m) * 64 + lane) * 16 + 4 * q); S[m][4 * q] = v[0]; S[m][4 * q + 1] = v[1]; S[m][4 * q + 2] = v[2]; S[m][4 * q + 3] = v[3]; }
            bf16* O = WSP(bf16, dir ? WS_OB : WS_OF);
            DN_BAR();
            for (int i = 0; i < SEGL; ++i) {
                const int cn = seg_chunk(dir, g, i); const LAS unsigned char* slot = lds + (i & 1) * SLOT3;
                f32x16 aV[2], aO[2];
#pragma unroll
                for (int mt = 0; mt < 2; ++mt) { u_to_acc(aV[mt], slot + DX_U + ((d * 2 + mt) * 64 + lane) * 32);
#pragma unroll
                    for (int e = 0; e < 16; ++e) aO[mt][e] = 0.f; }
                dn_step<true>(S, aV, aO, slot + lane * 16, gls[i]);
                bf16* op = O + (size_t)(64 * cn + 4 * lh) * 1024 + hd * 128 + 32 * d + r;
#pragma unroll
                for (int mt = 0; mt < 2; ++mt)
#pragma unroll
                    for (int e = 0; e < 16; ++e) op[(size_t)(32 * mt + (e & 3) + 8 * (e >> 2)) * 1024] = (bf16)f2bf(aO[mt][e]);
                asm volatile("s_waitcnt lgkmcnt(0)" ::: "memory");
                DN_BAR();
            }
        }
    }
    __syncthreads();
}

#ifndef MK_N_LAUNCHES
#define MK_N_LAUNCHES 1
#endif
constexpr int N_PHASES = 14;
struct Args { const float* in[23]; float* out; unsigned char* ws; int ph_lo, ph_hi; };
static_assert(sizeof(Args) == 23 * 8 + 8 + 8 + 8, "Args has no padding");

__global__ void __launch_bounds__(NWAVES * 64, 2) enc_fwd(Args args) {
    extern __shared__ __attribute__((aligned(16))) unsigned char lds[];
    Frame F;
    F.lds = (LAS unsigned char*)lds;
    F.MISC = (volatile LAS unsigned*)(F.lds + MISC_OFF);
    F.tid = threadIdx.x; F.lane = F.tid & 63; F.wave = __builtin_amdgcn_readfirstlane(F.tid >> 6);
    F.G = gridDim.x; { const int bx = blockIdx.x; F.vcu = (F.G % 8 == 0) ? (bx % 8) * (F.G / 8) + bx / 8 : bx; }
#pragma unroll
    for (int i = 0; i < 23; ++i) F.in[i] = args.in[i];
    F.out = args.out; F.ws = args.ws; F.ctl = (gu32*)(args.ws + WS_CTL);
    for (int u = F.tid; u < (LDS_BYTES - LDSCTL_OFF) / 4; u += NWAVES * 64) ((LAS unsigned*)(F.lds + LDSCTL_OFF))[u] = 0u;
    __syncthreads();
    const int lo = args.ph_lo, hi = args.ph_hi;
    XcdBarrier bar; bar.bar = (unsigned*)(F.ctl + CW_BAR); bar.x = 0; bar.st = nullptr;
    if (hi - lo > 1) bar = xcd_barrier_post((unsigned*)(F.ctl + CW_BAR), F.MISC + 8);
#define IN(k) (lo <= (k) && (k) < hi)
#define SEAM(k) do { if (IN(k) && IN((k) + 1)) xcd_barrier(bar); } while (0)
    float* sumsq2 = (float*)(F.ws + WS_CTL + CTL_SUMSQ2); float* sumsq3 = (float*)(F.ws + WS_CTL + CTL_SUMSQ3); float* sumsq4 = (float*)(F.ws + WS_CTL + CTL_SUMSQ4);

    if (IN(0)) { p0_prologue(F);
#if defined(REPEAT_PHASE) && REPEAT_PHASE == 0
        p0_prologue(F);
#endif
    } SEAM(0);
    if (IN(1)) {
        { pg8::Gemm g{WSP(bf16, WS_XB), WSP(bf16, WS_WIN), SEQ, NINP, DM}; pg8::StaticOrder S; S.init(SEQ, NINP, F.G, (int)blockIdx.x);
          EpiProj E{WSP(float, WS_RSTD1), WSP(bf16, WS_QKV), DOP(bf16, DO_Z), DOP(bf16, DO_QSW), DOP(bf16, DO_KVSW), WSP(float, WS_AB)};
          pg8::gemm_phase<EpiProj, pg8::StaticOrder, true, true>(F.lds + RING_OFF, g, S, E);
#if defined(REPEAT_PHASE) && REPEAT_PHASE == 1
          pg8::gemm_phase<EpiProj, pg8::StaticOrder, true, true>(F.lds + RING_OFF, g, S, E);
#endif
          }
        { const int nwg = (SEQ / 256) * (NINP / 256), rem = nwg % F.G; if (rem) p1_late_transposes(F, rem, F.G - rem); else p1_late_transposes(F, 0, F.G); }
    } SEAM(1);
    if (IN(2)) { dn_prep_phase<63>(F);
#if defined(REPEAT_PHASE) && REPEAT_PHASE == 2
        dn_prep_phase<63>(F);
#endif
#if defined(REPEAT_PHASE) && REPEAT_PHASE >= 1000 && REPEAT_PHASE < 1064
        dn_prep_phase<REPEAT_PHASE - 1000>(F);
#endif
    } SEAM(2);
    if (IN(3)) { dn_pass1(F);
#if defined(REPEAT_PHASE) && REPEAT_PHASE == 3
        dn_pass1(F);
#endif
    } SEAM(3);
    if (IN(12)) { dn_fold(F); swa_phase(F, 0, F.G); }
#if defined(REPEAT_PHASE) && REPEAT_PHASE == 12
    if (IN(12)) { dn_fold(F); swa_phase(F, 0, F.G); }
#endif
#if defined(REPEAT_PHASE) && REPEAT_PHASE == 112
    if (IN(12)) { dn_fold(F); }
#endif
#if defined(REPEAT_PHASE) && REPEAT_PHASE == 212
    if (IN(12)) { swa_phase(F, 0, F.G); }
#endif
    if (IN(12) && IN(13)) xcd_barrier(bar);
    if (IN(13)) { dn_pass3(F);
#if defined(REPEAT_PHASE) && REPEAT_PHASE == 13
        dn_pass3(F);
#endif
    } if (IN(13) && IN(4)) xcd_barrier(bar);
    if (IN(4)) { dn_combine(F);
#if defined(REPEAT_PHASE) && REPEAT_PHASE == 4
        dn_combine(F);
#endif
    } SEAM(4);
    if (IN(5)) {
        pg8::Gemm g{WSP(bf16, WS_XB), WSP(bf16, WS_WOUT), SEQ, DM, DM}; pg8::StaticOrder S; S.init(SEQ, DM, F.G, (int)blockIdx.x);
        EpiRes E{F.in[0], nullptr, nullptr, WSP(bf16, WS_H1B), sumsq2};
        pg8::gemm_phase<EpiRes, pg8::StaticOrder, true, true>(F.lds + RING_OFF, g, S, E);
#if defined(REPEAT_PHASE) && REPEAT_PHASE == 5
        { EpiRes E2{F.in[0], nullptr, nullptr, nullptr, (float*)(F.ws + WS_CTL + 448 * 1024)}; pg8::gemm_phase<EpiRes, pg8::StaticOrder, true, true>(F.lds + RING_OFF, g, S, E2); }
#endif
    } SEAM(5);
    if (IN(6)) {
        pg8::Gemm g{WSP(bf16, WS_H1B), WSP(bf16, WS_WQ), SEQ, 512, DM}; pg8::StaticOrder S; S.init(SEQ, 512, F.G, (int)blockIdx.x);
        EpiScaleBf16 E{sumsq2, 1, QSCALE, WSP(bf16, WS_QM), 512};
        pg8::gemm_phase<EpiScaleBf16, pg8::StaticOrder, true, true>(F.lds + RING_OFF, g, S, E);
        { pg8::Gemm g2{WSP(bf16, WS_MEMB), WSP(bf16, WS_WKV), MEMT, 1024, DM}; pg8::StaticOrder S2; S2.init(MEMT, 1024, F.G, (int)((blockIdx.x + F.G - (F.G >> 1)) % F.G));
          EpiScaleBf16 E2{WSP(float, WS_RSTDM), 0, 1.0f, WSP(bf16, WS_KVM), 1024};
          pg8::gemm_phase<EpiScaleBf16, pg8::StaticOrder, true, true>(F.lds + RING_OFF, g2, S2, E2); }
        { const int nbusy = (F.G >> 1) + 4; if (F.G >= nbusy + 32) p4_transposes(F, nbusy, F.G - nbusy); else p4_transposes(F, 0, F.G); }
#if defined(REPEAT_PHASE) && REPEAT_PHASE == 6
        pg8::gemm_phase<EpiScaleBf16, pg8::StaticOrder, true, true>(F.lds + RING_OFF, g, S, E);
#endif
    } SEAM(6);
    if (IN(7)) { mem_attn_phase(F);
#if defined(REPEAT_PHASE) && REPEAT_PHASE == 7
        mem_attn_phase(F);
#endif
    } SEAM(7);
    if (IN(8)) {
        pg8::Gemm g{WSP(bf16, WS_OM), WSP(bf16, WS_WO), SEQ, DM, 512}; pg8::StaticOrder S; S.init(SEQ, DM, F.G, (int)blockIdx.x);
        EpiRes E{nullptr, WSP(bf16, WS_H1B), nullptr, WSP(bf16, WS_XB), sumsq3};
        pg8::gemm_phase<EpiRes, pg8::StaticOrder, true, true>(F.lds + RING_OFF, g, S, E);
#if defined(REPEAT_PHASE) && REPEAT_PHASE == 8
        { EpiRes E2{nullptr, WSP(bf16, WS_H1B), nullptr, nullptr, (float*)(F.ws + WS_CTL + 448 * 1024)}; pg8::gemm_phase<EpiRes, pg8::StaticOrder, true, true>(F.lds + RING_OFF, g, S, E2); }
#endif
    } SEAM(8);
    if (IN(9)) {
        pg8::Gemm g{WSP(bf16, WS_XB), WSP(bf16, WS_WGU), SEQ, 2 * DFF, DM}; pg8::StaticOrder S; S.init(SEQ, 2 * DFF, F.G, (int)blockIdx.x);
        EpiSwiglu E{sumsq3, WSP(bf16, WS_HID)};
        pg8::gemm_phase<EpiSwiglu, pg8::StaticOrder, true, true>(F.lds + RING_OFF, g, S, E);
#if defined(REPEAT_PHASE) && REPEAT_PHASE == 9
        pg8::gemm_phase<EpiSwiglu, pg8::StaticOrder, true, true>(F.lds + RING_OFF, g, S, E);
#endif
    } SEAM(9);
    if (IN(10)) {
        pg8::Gemm g{WSP(bf16, WS_HID), WSP(bf16, WS_WD), SEQ, DM, DFF}; pg8::StaticOrder S; S.init(SEQ, DM, F.G, (int)blockIdx.x);
        EpiRes E{nullptr, WSP(bf16, WS_XB), nullptr, WSP(bf16, WS_H3B), sumsq4};
        pg8::gemm_phase<EpiRes, pg8::StaticOrder, true, true>(F.lds + RING_OFF, g, S, E);
#if defined(REPEAT_PHASE) && REPEAT_PHASE == 10
        { EpiRes E2{nullptr, WSP(bf16, WS_XB), nullptr, nullptr, (float*)(F.ws + WS_CTL + 448 * 1024)}; pg8::gemm_phase<EpiRes, pg8::StaticOrder, true, true>(F.lds + RING_OFF, g, S, E2); }
#endif
    } SEAM(10);
#if defined(REPEAT_PHASE) && REPEAT_PHASE == 99
    for (int k_ = 0; k_ < 10; ++k_) xcd_barrier(bar);
#endif
    if (IN(11)) { final_norm(F);
#if defined(REPEAT_PHASE) && REPEAT_PHASE == 11
        final_norm(F);
#endif
    }
#undef IN
#undef SEAM
}

extern "C" void kernel_launch(void* const* d_in, const int* in_sizes, int n_in, void* d_out, int out_size, void* d_ws, size_t ws_size, hipStream_t stream) {
    static int grid = 0;
    if (grid == 0) {
        if (n_in != 23 || out_size != SEQ * DM || ws_size < WS_END) { fprintf(stderr, "kernel_launch: unexpected shapes (n_in %d out %d ws %zu)\n", n_in, out_size, ws_size); grid = -1; return; }
        int dev = 0, cus = 0;
        if (hipGetDevice(&dev) != hipSuccess || hipDeviceGetAttribute(&cus, hipDeviceAttributeMultiprocessorCount, dev) != hipSuccess) { grid = -1; return; }
        if (hipFuncSetAttribute((const void*)enc_fwd, hipFuncAttributeMaxDynamicSharedMemorySize, LDS_BYTES) != hipSuccess) { fprintf(stderr, "kernel_launch: hipFuncSetAttribute failed\n"); grid = -1; return; }
        (void)hipGetLastError();
        grid = cus;
    }
    if (grid < 0) return;
    if (hipMemsetAsync((char*)d_ws + WS_CTL, 0, CTL_ZERO_BYTES, stream) != hipSuccess) return;
    Args a{};
    for (int i = 0; i < 23; ++i) a.in[i] = (const float*)d_in[i];
    a.out = (float*)d_out; a.ws = (unsigned char*)d_ws;
    const int per = (N_PHASES + MK_N_LAUNCHES - 1) / MK_N_LAUNCHES;
    for (int lo = 0; lo < N_PHASES; lo += per) {
        a.ph_lo = lo; a.ph_hi = (lo + per < N_PHASES) ? lo + per : N_PHASES;
        hipLaunchKernelGGL(enc_fwd, dim3(grid), dim3(NWAVES * 64), LDS_BYTES, stream, a);
    }
}
```

```cpp
#include <hip/hip_runtime.h>
#include <cstdio>
#include <cstdint>
namespace pg8 {
__device__ __forceinline__ unsigned cvt_pk_bf16(float lo, float hi) { unsigned r; asm volatile("v_cvt_pk_bf16_f32 %0, %1, %2" : "=v"(r) : "v"(lo), "v"(hi)); return r; }
#define PG8_LAS __attribute__((address_space(3)))
typedef unsigned short bf16_t;
typedef short bf16x8 __attribute__((ext_vector_type(8)));
typedef float f32x4 __attribute__((ext_vector_type(4)));
typedef unsigned u32x4 __attribute__((ext_vector_type(4)));
constexpr int BM = 256, BK = 64, HALF = 128, HTB = HALF * BK * 2  , STAGE_BYTES = 8 * HTB, NXCD = 8, WGM = 8;

__host__ __device__ __forceinline__ int lds_byte(int r, int c) { const int st = (r >> 4) * 2 + (c >> 5), rr = r & 15, cc = c & 31, ob = rr * 64 + cc * 2; return st * 1024 + (ob ^ (((ob >> 9) & 1) << 5)); }
__host__ __device__ __forceinline__ void stage_rc(int b, int& R, int& C) { const int st = b / 1024, sb = b % 1024, swz = sb ^ (((sb >> 9) & 1) << 5); R = (st >> 1) * 16 + swz / 64; C = (st & 1) * 32 + (swz % 64) / 2; }
__host__ __device__ __forceinline__ int perm32(int rho) { const int n = rho >> 4, i = rho & 15; return 8 * (i >> 2) + 4 * n + (i & 3); }

struct Unit { int pm, pn; };
struct Gemm { const bf16_t* A; const bf16_t* Bt; int M, N, K; };

struct StaticOrder {
    int nM, nN, nwg, G, c;
    __host__ __device__ void init(int M, int N, int G_, int c_) { nM = M / BM; nN = N / BM; nwg = nM * nN; G = G_; c = c_; }
    __host__ __device__ bool next(int i, Unit& u) const {
        const long L = (long)i * G + c; if (L >= nwg) return false;
        int wgid = (int)L; { const int q = nwg / NXCD, r = nwg % NXCD, xcd = wgid % NXCD, off = wgid / NXCD; wgid = (xcd < r ? xcd * (q + 1) : r * (q + 1) + (xcd - r) * q) + off; }
        const int nig = WGM * nN, gid = wgid / nig, fm = gid * WGM, gsz = (nM - fm) < WGM ? (nM - fm) : WGM;
        u.pm = fm + ((wgid % nig) % gsz); u.pn = (wgid % nig) / gsz; return true;
    }
    __device__ __forceinline__ void a_ready(const Unit&) const {}
    __device__ __forceinline__ void done(const Unit&) const {}
};

template <class Epi, class Sched, bool ALIGN_EPI = false, bool SP2 = false>
__device__ __forceinline__ void gemm_phase(PG8_LAS unsigned char* lds, const Gemm g, const Sched& S, const Epi& E) {
    const int tid = threadIdx.x, wid = __builtin_amdgcn_readfirstlane(tid >> 6), lane = tid & 63, wr = wid >> 2, wc = wid & 3, fr = lane & 15, fq = lane >> 4;
    const int K = g.K, nt = K / BK;
    unsigned voffA[2], voffB[2];
#pragma unroll
    for (int i = 0; i < 2; ++i) { int R, C; stage_rc(tid * 16 + i * 8192, R, C); const int Rb = Epi::PERM ? ((R & ~31) + perm32(R & 31)) : R;
        voffA[i] = (unsigned)(R * K + C) * 2u; voffB[i] = (unsigned)(Rb * K + C) * 2u; }
    const size_t kstep = (size_t)(BK * 2);
    const size_t hstep = (size_t)HALF * K * 2;
    const size_t tstep = 2 * hstep;
    const unsigned ldsw = (unsigned)wid * 1024u;
    const int aoff = lds_byte(wr * 64 + fr, fq * 8), boff = lds_byte(wc * 32 + fr, fq * 8);
#define PG8_SA(b, h) (((b) * 2 + (h)) * HTB)
#define PG8_SB(b, h) ((4 + (b) * 2 + (h)) * HTB)
#define PG8_STAGE(bufoff, gbase, voff) do { _Pragma("unroll") for (int _i = 0; _i < 2; ++_i) \
        __builtin_amdgcn_global_load_lds((const unsigned*)((const char*)(gbase) + (voff)[_i]), (PG8_LAS unsigned*)(lds + (bufoff) + ldsw + _i * 8192), 16, 0, 0); } while (0)
#define PG8_LDA(dst, b, h) do { _Pragma("unroll") for (int m = 0; m < 4; ++m) _Pragma("unroll") for (int k = 0; k < 2; ++k) dst[m][k] = *(const PG8_LAS bf16x8*)(lds + PG8_SA(b, h) + aoff + m * 2048 + k * 1024); } while (0)
#define PG8_LDB(dst, b, h) do { _Pragma("unroll") for (int n = 0; n < 2; ++n) _Pragma("unroll") for (int k = 0; k < 2; ++k) dst[n][k] = *(const PG8_LAS bf16x8*)(lds + PG8_SB(b, h) + boff + n * 2048 + k * 1024); } while (0)
#define PG8_MMA(ai, bj, At, Bt) do { __builtin_amdgcn_s_setprio(1); _Pragma("unroll") for (int m = 0; m < 4; ++m) _Pragma("unroll") for (int n = 0; n < 2; ++n) _Pragma("unroll") for (int k = 0; k < 2; ++k) \
        acc[ai][bj][m][n] = __builtin_amdgcn_mfma_f32_16x16x32_bf16(Bt[n][k], At[m][k], acc[ai][bj][m][n], 0, 0, 0); __builtin_amdgcn_s_setprio(0); } while (0)
#define PG8_WAIT_V(n) asm volatile("s_waitcnt vmcnt(" #n ")" ::: "memory")
#define PG8_WAIT_L(n) asm volatile("s_waitcnt lgkmcnt(" #n ")" ::: "memory")
#define PG8_BAR __builtin_amdgcn_s_barrier()
#define PG8_SCHED __builtin_amdgcn_sched_barrier(0)
    Unit cur, nxt; int ui = 0;
    if (!S.next(0, cur)) return;
    f32x4 acc[2][2][4][2];
#pragma unroll
    for (int a = 0; a < 2; ++a)
#pragma unroll
        for (int b = 0; b < 2; ++b)
#pragma unroll
            for (int m = 0; m < 4; ++m)
#pragma unroll
                for (int n = 0; n < 2; ++n) acc[a][b][m][n] = (f32x4){0.f, 0.f, 0.f, 0.f};
    bf16x8 At[4][2], B0[2][2], B1[2][2];
    const char* cA = (const char*)g.A + (size_t)cur.pm * tstep; const char* cB = (const char*)g.Bt + (size_t)cur.pn * tstep;
    S.a_ready(cur);
    if constexpr (SP2) {
        PG8_STAGE(PG8_SB(0, 0), cB, voffB); PG8_STAGE(PG8_SB(0, 1), cB + hstep, voffB); PG8_STAGE(PG8_SA(0, 0), cA, voffA); PG8_STAGE(PG8_SA(0, 1), cA + hstep, voffA);
        if (wr == 1) PG8_BAR;
        PG8_WAIT_V(2); PG8_BAR;
        PG8_STAGE(PG8_SB(1, 0), cB + kstep, voffB); PG8_STAGE(PG8_SA(1, 0), cA + kstep, voffA); PG8_STAGE(PG8_SB(1, 1), cB + hstep + kstep, voffB);
        PG8_WAIT_V(6); PG8_BAR;
    } else {
        PG8_STAGE(PG8_SB(0, 0), cB, voffB); PG8_STAGE(PG8_SA(0, 0), cA, voffA); PG8_STAGE(PG8_SB(0, 1), cB + hstep, voffB); PG8_STAGE(PG8_SA(0, 1), cA + hstep, voffA);
        if (wr == 1) PG8_BAR;
        PG8_WAIT_V(4); PG8_BAR;
        PG8_STAGE(PG8_SB(1, 0), cB + kstep, voffB); PG8_STAGE(PG8_SA(1, 0), cA + kstep, voffA); PG8_STAGE(PG8_SB(1, 1), cB + hstep + kstep, voffB);
        PG8_WAIT_V(6); PG8_BAR;
    }
    for (;;) {
        const bool has_next = S.next(ui + 1, nxt);
        const char* nA = has_next ? (const char*)g.A + (size_t)nxt.pm * tstep : cA; const char* nB = has_next ? (const char*)g.Bt + (size_t)nxt.pn * tstep : cB;
        for (int t = 0; t < nt; t += 2) {
            const bool last = (t == nt - 2);
            const char* a1 = cA + (size_t)(t + 1) * kstep;
            const char* a2 = last ? nA : cA + (size_t)(t + 2) * kstep; const char* b2 = last ? nB : cB + (size_t)(t + 2) * kstep;
            const char* a3 = a2 + kstep; const char* b3 = b2 + kstep;
            if (last && has_next) S.a_ready(nxt);
            if constexpr (SP2) {
            PG8_LDB(B0, 0, 0); PG8_LDB(B1, 0, 1); PG8_SCHED; PG8_LDA(At, 0, 0); PG8_STAGE(PG8_SA(1, 1), a1 + hstep, voffA);
            PG8_WAIT_V(8); PG8_WAIT_L(0); PG8_BAR; PG8_MMA(0, 0, At, B0); PG8_MMA(0, 1, At, B1); PG8_BAR; PG8_SCHED;
            PG8_LDA(At, 0, 1); PG8_STAGE(PG8_SB(0, 0), b2, voffB); PG8_STAGE(PG8_SB(0, 1), b2 + hstep, voffB); PG8_STAGE(PG8_SA(0, 0), a2, voffA);
            PG8_WAIT_V(8); PG8_WAIT_L(0); PG8_BAR; PG8_MMA(1, 0, At, B0); PG8_MMA(1, 1, At, B1); PG8_BAR; PG8_SCHED;
            PG8_LDB(B0, 1, 0); PG8_LDB(B1, 1, 1); PG8_SCHED; PG8_LDA(At, 1, 0); PG8_STAGE(PG8_SA(0, 1), a2 + hstep, voffA);
            PG8_WAIT_V(8); PG8_WAIT_L(0); PG8_BAR; PG8_MMA(0, 0, At, B0); PG8_MMA(0, 1, At, B1); PG8_BAR; PG8_SCHED;
            PG8_LDA(At, 1, 1); PG8_STAGE(PG8_SB(1, 0), b3, voffB); PG8_STAGE(PG8_SB(1, 1), b3 + hstep, voffB); PG8_STAGE(PG8_SA(1, 0), a3, voffA);
            PG8_WAIT_V(8); PG8_WAIT_L(0); PG8_BAR; PG8_MMA(1, 0, At, B0); PG8_MMA(1, 1, At, B1); PG8_BAR; PG8_SCHED;
            } else {
            PG8_LDB(B0, 0, 0); PG8_SCHED; PG8_LDA(At, 0, 0); PG8_STAGE(PG8_SA(1, 1), a1 + hstep, voffA);
            PG8_WAIT_L(8); PG8_BAR; PG8_WAIT_L(0); PG8_MMA(0, 0, At, B0); PG8_BAR; PG8_SCHED;
            PG8_LDB(B1, 0, 1); PG8_STAGE(PG8_SB(0, 0), b2, voffB);
            PG8_BAR; PG8_WAIT_L(0); PG8_MMA(0, 1, At, B1); PG8_BAR;
            PG8_LDA(At, 0, 1); PG8_STAGE(PG8_SA(0, 0), a2, voffA);
            PG8_BAR; PG8_WAIT_L(0); PG8_MMA(1, 0, At, B0); PG8_BAR; PG8_SCHED;
            PG8_STAGE(PG8_SB(0, 1), b2 + hstep, voffB);
            PG8_WAIT_V(6); PG8_BAR; PG8_MMA(1, 1, At, B1); PG8_BAR;
            PG8_LDB(B0, 1, 0); PG8_SCHED; PG8_LDA(At, 1, 0); PG8_STAGE(PG8_SA(0, 1), a2 + hstep, voffA);
            PG8_WAIT_L(8); PG8_BAR; PG8_WAIT_L(0); PG8_MMA(0, 0, At, B0); PG8_BAR; PG8_SCHED;
            PG8_LDB(B1, 1, 1); PG8_STAGE(PG8_SB(1, 0), b3, voffB);
            PG8_BAR; PG8_WAIT_L(0); PG8_MMA(0, 1, At, B1); PG8_BAR;
            PG8_LDA(At, 1, 1); PG8_STAGE(PG8_SA(1, 0), a3, voffA);
            PG8_BAR; PG8_WAIT_L(0); PG8_MMA(1, 0, At, B0); PG8_BAR; PG8_SCHED;
            PG8_STAGE(PG8_SB(1, 1), b3 + hstep, voffB);
            PG8_WAIT_V(6); PG8_BAR; PG8_MMA(1, 1, At, B1); PG8_BAR;
            }
        }
        if constexpr (ALIGN_EPI) { if (wr == 0) PG8_BAR; }
        if constexpr (!Epi::AFTER_DRAIN) { E(acc, cur, wr, wc, fr, fq); S.done(cur); }
        if (!has_next) break;
#pragma unroll
        for (int a = 0; a < 2; ++a)
#pragma unroll
            for (int b = 0; b < 2; ++b)
#pragma unroll
                for (int m = 0; m < 4; ++m)
#pragma unroll
                    for (int n = 0; n < 2; ++n) acc[a][b][m][n] = (f32x4){0.f, 0.f, 0.f, 0.f};
        cur = nxt; cA = nA; cB = nB; ++ui;
        if constexpr (ALIGN_EPI) { if (wr == 1) PG8_BAR; }
    }
    PG8_WAIT_V(0);
    if constexpr (!ALIGN_EPI) { if (wr == 0) PG8_BAR; }
    PG8_BAR;
    if constexpr (Epi::AFTER_DRAIN) { E.fused(acc, cur, wr, wc, fr, fq, lds, wid, lane); S.done(cur); }
#undef PG8_SA
#undef PG8_SB
#undef PG8_STAGE
#undef PG8_LDA
#undef PG8_LDB
#undef PG8_MMA
#undef PG8_WAIT_V
#undef PG8_WAIT_L
#undef PG8_BAR
#undef PG8_SCHED
}
}

constexpr int NWAVES = 8;
constexpr int SEQ = 16384, DM = 2048, NIN = 5664, NINP = 5888, DFF = 5632;
constexpr int DNH = 8, HD = 128, SWH = 8, MEMH = 4, MEMT = 256;
constexpr float RMS_EPS = 1e-6f;
constexpr float LOG2E = 1.4426950408889634f;
constexpr float QSCALE = 0.08838834764831845f * 1.4426950408889634f;

constexpr size_t MiB = 1u << 20;
constexpr size_t WS_CTL = 0, CTL_ZERO_BYTES = 1 * MiB;
constexpr size_t CTL_SUMSQ2 = 256 * 1024, CTL_SUMSQ3 = 320 * 1024, CTL_SUMSQ4 = 384 * 1024;
constexpr size_t WS_RSTD1 = 1 * MiB, WS_RSTDM = 1 * MiB + 64 * 1024;
constexpr size_t WS_MEMB = 2 * MiB, WS_KVM = 3 * MiB, WS_AB = 4 * MiB, WS_BG = 6 * MiB;
constexpr size_t WS_WOUT = 8 * MiB, WS_WQ = 16 * MiB, WS_WKV = 18 * MiB, WS_WO = 22 * MiB, WS_WIN = 24 * MiB;
constexpr size_t WS_XB = 48 * MiB;
constexpr size_t WS_QKV = 112 * MiB;
constexpr size_t WS_H3B = 112 * MiB;
constexpr size_t WS_OF = 112 * MiB, WS_OB = 144 * MiB, WS_H1B = 112 * MiB, WS_QM = 176 * MiB, WS_OM = 192 * MiB;
constexpr size_t WS_DNX = 208 * MiB;
constexpr size_t WS_WGU = 208 * MiB, WS_WD = 252 * MiB, WS_HID = 274 * MiB, WS_END = 496 * MiB;
constexpr size_t DO_Z = 0, DO_QSW = 32 * MiB, DO_KVSW = 64 * MiB;
constexpr int CW_BAR = 4096, CW_SWAQ = 8192;

constexpr int RING_OFF = 0, RING_BYTES = 131072;
constexpr int LDS_BYTES = 163840;
constexpr int LDSCTL_OFF = LDS_BYTES - 512, MISC_OFF = LDSCTL_OFF + 320;

#define GAS __attribute__((address_space(1)))
#define LAS __attribute__((address_space(3)))
typedef unsigned short bf16;
typedef unsigned v4u __attribute__((ext_vector_type(4)));
typedef unsigned v2u __attribute__((ext_vector_type(2)));
typedef float f32x4 __attribute__((ext_vector_type(4)));
typedef short bf16x8 __attribute__((ext_vector_type(8)));
typedef short s16x4 __attribute__((ext_vector_type(4)));
typedef GAS unsigned gu32;
#define RLX_AGENT __ATOMIC_RELAXED, __HIP_MEMORY_SCOPE_AGENT
#define LDS_WAIT() asm volatile("s_waitcnt lgkmcnt(0)" ::: "memory")
#define VM_WAIT() asm volatile("s_waitcnt vmcnt(0)" ::: "memory")
__device__ __forceinline__ unsigned f2bf(float f) { unsigned u = __builtin_bit_cast(unsigned, f); return (u + 0x7fffu + ((u >> 16) & 1u)) >> 16; }
__device__ __forceinline__ unsigned pk2(float lo, float hi) { return f2bf(lo) | (f2bf(hi) << 16); }
__device__ __forceinline__ float bf2f(unsigned short b) { return __builtin_bit_cast(float, (unsigned)b << 16); }
__device__ __forceinline__ float bflo(unsigned w) { return __builtin_bit_cast(float, w << 16); }
__device__ __forceinline__ float bfhi(unsigned w) { return __builtin_bit_cast(float, w & 0xffff0000u); }
typedef float f32x2_t __attribute__((ext_vector_type(2))); typedef __bf16 bf16x2_t __attribute__((ext_vector_type(2)));
__device__ __forceinline__ unsigned cvtpk(float lo, float hi) { f32x2_t v = {lo, hi}; bf16x2_t b = __builtin_convertvector(v, bf16x2_t); return __builtin_bit_cast(unsigned, b); }
__device__ __forceinline__ float wave_sum(float v) {
#pragma unroll
    for (int o = 1; o < 64; o <<= 1) v += __shfl_xor(v, o);
    return v;
}
__device__ __forceinline__ float siluf(float x) { return x * __builtin_amdgcn_rcpf(1.0f + __expf(-x)); }
#define XB_TMO      128
#define XB_XCNT(j)  (256  + 64 * (j))
#define XB_XSUB(j)  (1280 + 64 * (j))
#define XB_XGEN(j)  (2304 + 64 * (j))
#define XB_TOP      3328
#define XB_TOPGEN   3392
#define XCD_BAR_WORDS 3456
#define XB_SPIN_CAP (1u << 18)

__device__ __forceinline__ unsigned xb_ld(unsigned* p)              { return __hip_atomic_load(p, __ATOMIC_RELAXED, __HIP_MEMORY_SCOPE_AGENT); }
__device__ __forceinline__ unsigned xb_add(unsigned* p, unsigned v) { return __hip_atomic_fetch_add(p, v, __ATOMIC_RELAXED, __HIP_MEMORY_SCOPE_AGENT); }
__device__ __forceinline__ unsigned xb_xcc_id() { return (unsigned)__builtin_amdgcn_s_getreg((3 << 11) | 20) & 0xFu; }
#define XB_SPIN(cond, bar) do { unsigned _sp = 0; while (cond) { __builtin_amdgcn_s_sleep(1); \
    if ((++_sp & 255u) == 0u) { if (xb_ld(&(bar)[XB_TMO])) break; if (_sp > XB_SPIN_CAP) { atomicAdd(&(bar)[XB_TMO], 1u); break; } } } } while (0)

struct XcdBarrier {
    unsigned* bar; unsigned x;
    volatile LAS unsigned* st;
};

__device__ __forceinline__ XcdBarrier xcd_barrier_post(unsigned* bar, volatile LAS unsigned* st) {
    XcdBarrier b; b.bar = bar; b.x = xb_xcc_id(); b.st = st;
    if (threadIdx.x == 0) (void)xb_add(&bar[XB_XCNT(b.x)], 1u);
    return b;
}
__device__ __forceinline__ void xcd_barrier_complete(unsigned* bar, unsigned x, unsigned& nloc, unsigned& nx) {
    const unsigned G = gridDim.x * gridDim.y * gridDim.z;
    unsigned sum, cnt, mine, sp = 0u;
    for (;;) {
        sum = 0u; cnt = 0u; mine = 0u;
#pragma unroll
        for (unsigned j = 0; j < 16; ++j) { const unsigned c = xb_ld(&bar[XB_XCNT(j)]); sum += c; cnt += (c > 0u) ? 1u : 0u; mine = (j == x) ? c : mine; }
        if (sum == G) break;
        __builtin_amdgcn_s_sleep(1);
        if ((++sp & 255u) == 0u) { if (xb_ld(&bar[XB_TMO])) break; if (sp > XB_SPIN_CAP) { atomicAdd(&bar[XB_TMO], 1u); break; } }
    }
    nloc = mine > 0u ? mine : 1u; nx = cnt > 0u ? cnt : 1u;
}

__device__ __forceinline__ void xcd_barrier(const XcdBarrier& b) {
    asm volatile("s_waitcnt vmcnt(0)" ::: "memory");
    __syncthreads();
    if (threadIdx.x == 0) {
        unsigned* bar = b.bar;
        __builtin_amdgcn_s_waitcnt(0);
        unsigned nloc = b.st[0], nx = b.st[1];
        if (nloc == 0u) { xcd_barrier_complete(bar, b.x, nloc, nx); b.st[0] = nloc; b.st[1] = nx; }
        const unsigned old = xb_add(&bar[XB_XSUB(b.x)], 1u);
        const unsigned gen = old / nloc;
        if (old + 1u == (gen + 1u) * nloc) {
            __builtin_amdgcn_fence(__ATOMIC_RELEASE, "agent");
            asm volatile("s_waitcnt vmcnt(0)" ::: "memory");
            const unsigned og = xb_add(&bar[XB_TOP], 1u);
            const unsigned tg = og / nx;
            if (og + 1u == (tg + 1u) * nx) xb_add(&bar[XB_TOPGEN], 1u);
            else XB_SPIN(xb_ld(&bar[XB_TOPGEN]) == tg, bar);
            __builtin_amdgcn_fence(__ATOMIC_ACQUIRE, "agent");
            xb_add(&bar[XB_XGEN(b.x)], 1u);
            asm volatile("s_waitcnt vmcnt(0)" ::: "memory");
        } else {
            XB_SPIN(xb_ld(&bar[XB_XGEN(b.x)]) == gen, bar);
            __builtin_amdgcn_fence(__ATOMIC_ACQUIRE, "agent");
            asm volatile("s_waitcnt vmcnt(0)" ::: "memory");
        }
    }
    __syncthreads();
}

using pg8::Unit;
__device__ __forceinline__ v4u pack8(f32x4 v0, f32x4 v1) { v4u w; w.x = cvtpk(v0[0], v0[1]); w.y = cvtpk(v0[2], v0[3]); w.z = cvtpk(v1[0], v1[1]); w.w = cvtpk(v1[2], v1[3]); return w; }

struct EpiProj {
    static constexpr bool PERM = true, AFTER_DRAIN = false;
    const float* rstd; bf16* qkv; bf16* z; bf16* qsw; bf16* kvsw; float* ab;
    __device__ __forceinline__ void operator()(const f32x4 (&acc)[2][2][4][2], const Unit& u, int wr, int wc, int fr, int fq) const {
        const int pn = u.pn; bf16* base; int ldc, colt; float sc = 1.f;
        if (pn < 12) { base = qkv; ldc = 3072; colt = pn * 256; }
        else if (pn < 16) { base = z; ldc = 1024; colt = (pn - 12) * 256; }
        else if (pn < 20) { base = qsw; ldc = 1024; colt = (pn - 16) * 256; sc = QSCALE; }
        else if (pn < 22) { base = kvsw; ldc = 512; colt = (pn - 20) * 256; }
        else { base = nullptr; ldc = 0; colt = 0; }
        const int row0 = u.pm * 256 + wr * 64 + fr, col0 = colt + wc * 32 + 8 * fq;
        float rsv[2][4];
#pragma unroll
        for (int ai = 0; ai < 2; ++ai)
#pragma unroll
            for (int m = 0; m < 4; ++m) rsv[ai][m] = rstd[row0 + ai * 128 + m * 16];
#pragma unroll
        for (int ai = 0; ai < 2; ++ai)
#pragma unroll
            for (int m = 0; m < 4; ++m) {
                const int row = row0 + ai * 128 + m * 16; const float rs = rsv[ai][m] * sc;
                if (base) {
                    bf16* rowp = base + (size_t)row * ldc + col0;
#pragma unroll
                    for (int bj = 0; bj < 2; ++bj) *(v4u*)(rowp + bj * 128) = pack8(acc[ai][bj][m][0] * rs, acc[ai][bj][m][1] * rs);
                } else if (wc == 0) {
                    float* rowp = ab + (size_t)row * 32 + 8 * fq;
                    *(f32x4*)(rowp) = acc[ai][0][m][0] * rs; *(f32x4*)(rowp + 4) = acc[ai][0][m][1] * rs;
                }
            }
    }
};
struct EpiScaleBf16 {
    static constexpr bool PERM = true, AFTER_DRAIN = false;
    const float* rs; int from_sumsq; float sc; bf16* O; int ldc;
    __device__ __forceinline__ void operator()(const f32x4 (&acc)[2][2][4][2], const Unit& u, int wr, int wc, int fr, int fq) const {
        const int row0 = u.pm * 256 + wr * 64 + fr, col0 = u.pn * 256 + wc * 32 + 8 * fq;
        float rsv[2][4];
#pragma unroll
        for (int ai = 0; ai < 2; ++ai)
#pragma unroll
            for (int m = 0; m < 4; ++m) rsv[ai][m] = rs[row0 + ai * 128 + m * 16];
#pragma unroll
        for (int ai = 0; ai < 2; ++ai)
#pragma unroll
            for (int m = 0; m < 4; ++m) {
                const int row = row0 + ai * 128 + m * 16; float r = rsv[ai][m];
                if (from_sumsq) r = __builtin_amdgcn_rsqf(r * (1.0f / DM) + RMS_EPS);
                r *= sc; bf16* rowp = O + (size_t)row * ldc + col0;
#pragma unroll
                for (int bj = 0; bj < 2; ++bj) *(v4u*)(rowp + bj * 128) = pack8(acc[ai][bj][m][0] * r, acc[ai][bj][m][1] * r);
            }
    }
};
struct EpiRes {
    static constexpr bool PERM = true, AFTER_DRAIN = false;
    const float* res; const bf16* resb; float* out; bf16* ob; float* sumsq;
    __device__ __forceinline__ void operator()(const f32x4 (&acc)[2][2][4][2], const Unit& u, int wr, int wc, int fr, int fq) const {
        const int row0 = u.pm * 256 + wr * 64 + fr, col0 = u.pn * 256 + wc * 32 + 8 * fq;
#pragma unroll
        for (int ai = 0; ai < 2; ++ai) {
            f32x4 rr[4][2][2];
            if (resb) {
                v4u rb[4][2];
#pragma unroll
                for (int m = 0; m < 4; ++m) { const size_t off = (size_t)(row0 + ai * 128 + m * 16) * DM + col0;
#pragma unroll
                    for (int bj = 0; bj < 2; ++bj) rb[m][bj] = *(const v4u*)(resb + off + bj * 128); }
#pragma unroll
                for (int m = 0; m < 4; ++m)
#pragma unroll
                    for (int bj = 0; bj < 2; ++bj) { const v4u w = rb[m][bj]; rr[m][bj][0] = (f32x4){bflo(w.x), bfhi(w.x), bflo(w.y), bfhi(w.y)}; rr[m][bj][1] = (f32x4){bflo(w.z), bfhi(w.z), bflo(w.w), bfhi(w.w)}; }
            } else {
#pragma unroll
                for (int m = 0; m < 4; ++m) { const size_t off = (size_t)(row0 + ai * 128 + m * 16) * DM + col0;
#pragma unroll
                    for (int bj = 0; bj < 2; ++bj) { rr[m][bj][0] = *(const f32x4*)(res + off + bj * 128); rr[m][bj][1] = *(const f32x4*)(res + off + bj * 128 + 4); } }
            }
            asm volatile("" ::: "memory");
#pragma unroll
            for (int m = 0; m < 4; ++m) {
                const int row = row0 + ai * 128 + m * 16; const size_t off = (size_t)row * DM + col0; float ss = 0.f;
#pragma unroll
                for (int bj = 0; bj < 2; ++bj) {
                    const f32x4 v0 = acc[ai][bj][m][0] + rr[m][bj][0], v1 = acc[ai][bj][m][1] + rr[m][bj][1];
                    if (out) { *(f32x4*)(out + off + bj * 128) = v0; *(f32x4*)(out + off + bj * 128 + 4) = v1; }
                    if (ob) *(v4u*)(ob + off + bj * 128) = pack8(v0, v1);
                    ss += (v0[0] * v0[0] + v0[1] * v0[1]) + (v0[2] * v0[2] + v0[3] * v0[3]) + (v1[0] * v1[0] + v1[1] * v1[1]) + (v1[2] * v1[2] + v1[3] * v1[3]);
                }
                ss += __shfl_xor(ss, 16); ss += __shfl_xor(ss, 32);
                if (fq == 0) atomicAdd(sumsq + row, ss);
            }
            asm volatile("" ::: "memory");
        }
    }
};
struct EpiSwiglu {
    static constexpr bool PERM = true, AFTER_DRAIN = false;
    const float* sumsq; bf16* H;
    __device__ __forceinline__ void operator()(const f32x4 (&acc)[2][2][4][2], const Unit& u, int wr, int wc, int fr, int fq) const {
        const int row0 = u.pm * 256 + wr * 64 + fr, col0 = u.pn * 128 + wc * 32 + 8 * fq;
        float rsv[2][4];
#pragma unroll
        for (int ai = 0; ai < 2; ++ai)
#pragma unroll
            for (int m = 0; m < 4; ++m) rsv[ai][m] = sumsq[row0 + ai * 128 + m * 16];
#pragma unroll
        for (int ai = 0; ai < 2; ++ai)
#pragma unroll
            for (int m = 0; m < 4; ++m) {
                const int row = row0 + ai * 128 + m * 16; const float r = __builtin_amdgcn_rsqf(rsv[ai][m] * (1.0f / DM) + RMS_EPS);
                f32x4 h[2];
#pragma unroll
                for (int n = 0; n < 2; ++n)
#pragma unroll
                    for (int e = 0; e < 4; ++e) { const float g = acc[ai][0][m][n][e] * r, up = acc[ai][1][m][n][e] * r; h[n][e] = siluf(g) * up; }
                *(v4u*)(H + (size_t)row * DFF + col0) = pack8(h[0], h[1]);
            }
    }
};

struct Frame {
    LAS unsigned char* lds;
    volatile LAS unsigned* MISC;
    gu32* ctl;
    int tid, lane, wave, vcu, G;
    const float* in[23]; float* out; unsigned char* ws;
};
#define WSP(T, off) ((T*)(F.ws + (off)))
#define DOP(T, off) ((T*)((unsigned char*)F.out + (off)))

__device__ __forceinline__ void tr_item(const float* W, int K, int Nsrc, int src_col0, const float* gain, bf16* WT, int dst_row0, int k0, LAS float* scr, int lane) {
    float v[32];
#pragma unroll
    for (int i = 0; i < 32; ++i) { const int kk = 2 * i + (lane >> 5); v[i] = (src_col0 >= 0) ? W[(size_t)(k0 + kk) * Nsrc + src_col0 + (lane & 31)] : 0.f; }
    if (gain) {
#pragma unroll
        for (int i = 0; i < 32; ++i) v[i] *= gain[k0 + 2 * i + (lane >> 5)]; }
#pragma unroll
    for (int i = 0; i < 32; ++i) scr[(2 * i + (lane >> 5)) * 33 + (lane & 31)] = v[i];
    LDS_WAIT(); asm volatile("" ::: "memory");
    const int c = lane & 7;
#pragma unroll
    for (int j = 0; j < 4; ++j) { const int n = (lane >> 3) + 8 * j; const LAS float* s = scr + (8 * c) * 33 + n;
        v4u o; o.x = pk2(s[0 * 33], s[1 * 33]); o.y = pk2(s[2 * 33], s[3 * 33]); o.z = pk2(s[4 * 33], s[5 * 33]); o.w = pk2(s[6 * 33], s[7 * 33]);
        *(GAS v4u*)(WT + (size_t)(dst_row0 + n) * K + k0 + 8 * c) = o; }
    LDS_WAIT(); asm volatile("" ::: "memory");
}
__device__ __forceinline__ int win_src_col(int c) {
    if (c < 4096) return c;
    if (c < 5120) return c - 4096 + 4128;
    if (c < 5376) return c - 5120 + 5152;
    if (c < 5632) return c - 5376 + 5408;
    if (c < 5664) return c - 5632 + 4096;
    return -1;
}
__device__ __forceinline__ void row_to_bf16_rstd(const float* xrow, bf16* orow, float* rstd_out, int lane) {
    const GAS f32x4* xr = (const GAS f32x4*)xrow + lane;
    f32x4 v[8]; float s = 0.f;
#pragma unroll
    for (int j = 0; j < 8; ++j) { v[j] = xr[64 * j]; s += (v[j].x * v[j].x + v[j].y * v[j].y) + (v[j].z * v[j].z + v[j].w * v[j].w); }
    s = wave_sum(s);
    if (lane == 0) *rstd_out = 1.0f / sqrtf(s * (1.0f / DM) + RMS_EPS);
    GAS v2u* o8 = (GAS v2u*)orow + lane;
#pragma unroll
    for (int j = 0; j < 8; ++j) { v2u w; w.x = pk2(v[j].x, v[j].y); w.y = pk2(v[j].z, v[j].w); o8[64 * j] = w; }
}

__device__ __forceinline__ void p0_prologue(Frame& F) {
    LAS float* scr = (LAS float*)(F.lds + RING_OFF + F.wave * 16384);
    const int gw = F.vcu * NWAVES + F.wave, NGW = F.G * NWAVES;
    constexpr int I_IN = 32 * (NINP / 32), I_KV = 32 * 32;
    for (int it = gw; it < I_IN + I_KV; it += NGW) {
        int r = it;
        if (r < I_IN) { const int nblk = NINP / 32, kb = r / nblk, nb = r % nblk; tr_item(F.in[3], DM, NIN, win_src_col(nb * 32), F.in[2], WSP(bf16, WS_WIN), nb * 32, kb * 64, scr, F.lane); continue; } r -= I_IN;
        { const int kb = r / 32, nb = r % 32; tr_item(F.in[16], DM, 1024, nb * 32, F.in[14], WSP(bf16, WS_WKV), nb * 32, kb * 64, scr, F.lane); }
    }
    for (int m = gw; m < SEQ; m += 2 * NGW) {
        const int m2 = m + NGW; const bool two = m2 < SEQ;
        const GAS f32x4* xa = (const GAS f32x4*)(F.in[0] + (size_t)m * DM) + F.lane; const GAS f32x4* xb_ = (const GAS f32x4*)(F.in[0] + (size_t)(two ? m2 : m) * DM) + F.lane;
        f32x4 va[8], vb[8]; float sa = 0.f, sb = 0.f;
#pragma unroll
        for (int j = 0; j < 8; ++j) { va[j] = xa[64 * j]; vb[j] = xb_[64 * j]; }
#pragma unroll
        for (int j = 0; j < 8; ++j) { sa += (va[j].x * va[j].x + va[j].y * va[j].y) + (va[j].z * va[j].z + va[j].w * va[j].w); sb += (vb[j].x * vb[j].x + vb[j].y * vb[j].y) + (vb[j].z * vb[j].z + vb[j].w * vb[j].w); }
        sa = wave_sum(sa); sb = wave_sum(sb);
        if (F.lane == 0) { WSP(float, WS_RSTD1)[m] = 1.0f / sqrtf(sa * (1.0f / DM) + RMS_EPS); if (two) WSP(float, WS_RSTD1)[m2] = 1.0f / sqrtf(sb * (1.0f / DM) + RMS_EPS); }
        GAS v2u* oa = (GAS v2u*)(WSP(bf16, WS_XB) + (size_t)m * DM) + F.lane; GAS v2u* ob = (GAS v2u*)(WSP(bf16, WS_XB) + (size_t)m2 * DM) + F.lane;
#pragma unroll
        for (int j = 0; j < 8; ++j) { v2u w; w.x = pk2(va[j].x, va[j].y); w.y = pk2(va[j].z, va[j].w); oa[64 * j] = w; }
        if (two) {
#pragma unroll
            for (int j = 0; j < 8; ++j) { v2u w; w.x = pk2(vb[j].x, vb[j].y); w.y = pk2(vb[j].z, vb[j].w); ob[64 * j] = w; } }
    }
    for (int m = gw; m < MEMT; m += NGW) row_to_bf16_rstd(F.in[1] + (size_t)m * DM, WSP(bf16, WS_MEMB) + (size_t)m * DM, WSP(float, WS_RSTDM) + m, F.lane);
}
__device__ __forceinline__ void p1_late_transposes(Frame& F, int b0, int nb) {
    if ((int)blockIdx.x < b0 || (int)blockIdx.x >= b0 + nb) return;
    LAS float* scr = (LAS float*)(F.lds + RING_OFF + F.wave * 16384);
    const int gw = ((int)blockIdx.x - b0) * NWAVES + F.wave, NGW = nb * NWAVES;
    constexpr int I_OUT = 32 * 64, I_Q = 32 * 16, I_O = 8 * 64;
    for (int it = gw; it < I_OUT + I_Q + I_O; it += NGW) {
        int r = it;
        if (r < I_OUT) { const int kb = r / 64, nb2 = r % 64; tr_item(F.in[12], DM, DM, nb2 * 32, nullptr, WSP(bf16, WS_WOUT), nb2 * 32, kb * 64, scr, F.lane); continue; } r -= I_OUT;
        if (r < I_Q) { const int kb = r / 16, nb2 = r % 16; tr_item(F.in[15], DM, 512, nb2 * 32, F.in[13], WSP(bf16, WS_WQ), nb2 * 32, kb * 64, scr, F.lane); continue; } r -= I_Q;
        { const int kb = r / 64, nb2 = r % 64; tr_item(F.in[17], 512, DM, nb2 * 32, nullptr, WSP(bf16, WS_WO), nb2 * 32, kb * 64, scr, F.lane); }
    }
}
__device__ __forceinline__ void p4_transposes(Frame& F, int b0, int nb) {
    if ((int)blockIdx.x < b0 || (int)blockIdx.x >= b0 + nb) return;
    LAS float* scr = (LAS float*)(F.lds + RING_OFF + F.wave * 16384);
    const int gw = ((int)blockIdx.x - b0) * NWAVES + F.wave, NGW = nb * NWAVES;
    constexpr int I_GU = 32 * (2 * DFF / 32), I_D = (DFF / 64) * 64;
    for (int it = gw; it < I_GU + I_D; it += NGW) {
        int r = it;
        if (r < I_GU) { const int nblk = 2 * DFF / 32, kb = r / nblk, nb = r % nblk; const int row = nb * 32, t = row / 256, w = row % 256;
            const float* src = (w < 128) ? F.in[19] : F.in[20]; const int sc = 128 * t + (w & 127);
            tr_item(src, DM, DFF, sc, F.in[18], WSP(bf16, WS_WGU), row, kb * 64, scr, F.lane); continue; } r -= I_GU;
        { const int kb = r / 64, nb = r % 64; tr_item(F.in[21], DFF, DM, nb * 32, nullptr, WSP(bf16, WS_WD), nb * 32, kb * 64, scr, F.lane); }
    }
}

__device__ __forceinline__ float softplusf(float x) { return x > 20.f ? x : log1pf(__expf(x)); }
__device__ __forceinline__ void dn_combine(Frame& F) {
    const int gw = F.vcu * NWAVES + F.wave, NGW = F.G * NWAVES, lane = F.lane;
    const bf16* OFp = WSP(bf16, WS_OF); const bf16* OBp = WSP(bf16, WS_OB); const bf16* Z = DOP(bf16, DO_Z); bf16* Y = WSP(bf16, WS_XB); const float* gn = F.in[9];
    const int cb = (16 * lane) & 127; float gv[16];
#pragma unroll
    for (int i = 0; i < 16; ++i) gv[i] = gn[cb + i];
    for (int t0 = gw; t0 < SEQ; t0 += 2 * NGW) {
        v4u a[2][2], b[2][2], z[2][2];
#pragma unroll
        for (int k = 0; k < 2; ++k) { const int t = (t0 + k * NGW < SEQ) ? t0 + k * NGW : t0; const size_t off = (size_t)t * 1024 + 16 * lane;
            a[k][0] = *(const v4u*)(OFp + off); a[k][1] = *(const v4u*)(OFp + off + 8); b[k][0] = *(const v4u*)(OBp + off); b[k][1] = *(const v4u*)(OBp + off + 8);
            z[k][0] = *(const v4u*)(Z + off); z[k][1] = *(const v4u*)(Z + off + 8); }
#pragma unroll
        for (int k = 0; k < 2; ++k) {
            const int t = t0 + k * NGW; if (t >= SEQ) break;
            float o[16], zz[16];
#pragma unroll
            for (int i = 0; i < 4; ++i) { o[2 * i] = bflo(a[k][0][i]) + bflo(b[k][0][i]); o[2 * i + 1] = bfhi(a[k][0][i]) + bfhi(b[k][0][i]); o[8 + 2 * i] = bflo(a[k][1][i]) + bflo(b[k][1][i]); o[8 + 2 * i + 1] = bfhi(a[k][1][i]) + bfhi(b[k][1][i]);
                zz[2 * i] = bflo(z[k][0][i]); zz[2 * i + 1] = bfhi(z[k][0][i]); zz[8 + 2 * i] = bflo(z[k][1][i]); zz[8 + 2 * i + 1] = bfhi(z[k][1][i]); }
            float ss = 0.f;
#pragma unroll
            for (int i = 0; i < 16; ++i) ss += o[i] * o[i];
            ss += __shfl_xor(ss, 1); ss += __shfl_xor(ss, 2); ss += __shfl_xor(ss, 4);
            const float rs = __builtin_amdgcn_rsqf(ss * (1.0f / 128.0f) + RMS_EPS);
            float y[16];
#pragma unroll
            for (int i = 0; i < 16; ++i) y[i] = o[i] * rs * gv[i] * siluf(zz[i]);
            v4u w0, w1;
#pragma unroll
            for (int i = 0; i < 4; ++i) { w0[i] = pk2(y[2 * i], y[2 * i + 1]); w1[i] = pk2(y[8 + 2 * i], y[8 + 2 * i + 1]); }
            bf16* yp = Y + (size_t)t * DM + 16 * lane; *(v4u*)yp = w0; *(v4u*)(yp + 8) = w1;
        }
    }
}
__device__ __forceinline__ void final_norm(Frame& F) {
    const int gw = F.vcu * NWAVES + F.wave, NGW = F.G * NWAVES, lane = F.lane;
    const float* ss = (const float*)(F.ws + WS_CTL + CTL_SUMSQ4); const GAS f32x4* g = (const GAS f32x4*)F.in[22]; const bf16* H3 = WSP(bf16, WS_H3B);
    for (int m0 = gw; m0 < SEQ; m0 += 2 * NGW) {
        v4u w[2][4]; float r[2];
#pragma unroll
        for (int k = 0; k < 2; ++k) { const int m = (m0 + k * NGW < SEQ) ? m0 + k * NGW : m0; const GAS v4u* hp = (const GAS v4u*)(H3 + (size_t)m * DM);
            r[k] = ss[m];
#pragma unroll
            for (int j = 0; j < 4; ++j) w[k][j] = hp[64 * j + lane]; }
#pragma unroll
        for (int k = 0; k < 2; ++k) {
            const int m = m0 + k * NGW; if (m >= SEQ) break;
            const float rr = __builtin_amdgcn_rsqf(r[k] * (1.0f / DM) + RMS_EPS);
            GAS f32x4* o = (GAS f32x4*)(F.out + (size_t)m * DM);
#pragma unroll
            for (int j = 0; j < 4; ++j) { const v4u x = w[k][j]; const int c4 = 2 * (64 * j + lane); const f32x4 g0 = g[c4], g1 = g[c4 + 1];
                o[c4] = (f32x4){bflo(x.x) * rr * g0[0], bfhi(x.x) * rr * g0[1], bflo(x.y) * rr * g0[2], bfhi(x.y) * rr * g0[3]};
                o[c4 + 1] = (f32x4){bflo(x.z) * rr * g1[0], bfhi(x.z) * rr * g1[1], bflo(x.w) * rr * g1[2], bfhi(x.w) * rr * g1[3]}; }
        }
    }
}

__device__ __forceinline__ int t5_bucket(int rel) {
    const int n = rel < 0 ? -rel : rel; int b;
    if (n < 8) b = n; else { int k = (31 - __builtin_clz((unsigned)(n * n))) - 6; b = 8 + k; if (b > 15) b = 15; }
    return (rel > 0 ? 16 : 0) + b;
}
template <int MODE  >
__device__ __forceinline__ void attn_unit(Frame& F, const bf16* Q, int qpitch, const bf16* Kp, const bf16* Vp, int kvpitch, bf16* O, int opitch, int q0, int kt_beg, int kt_end, const LAS float* btab, float sink2) {
    LAS unsigned char* Ks = F.lds + RING_OFF; LAS unsigned char* Vs = Ks + 16384;
    const int lane = F.lane, c = lane & 15, g = lane >> 4, qw0 = q0 + 16 * F.wave, tid = F.tid;
    bf16x8 qf[4];
#pragma unroll
    for (int t = 0; t < 4; ++t) qf[t] = *(const bf16x8*)(Q + (size_t)(qw0 + c) * qpitch + 32 * t + 8 * g);
    f32x4 oacc[8];
#pragma unroll
    for (int i = 0; i < 8; ++i) oacc[i] = (f32x4){0.f, 0.f, 0.f, 0.f};
    float mrun = (MODE == 0) ? sink2 : -1e30f, lsum = (MODE == 0 && g == 0) ? 1.0f : 0.0f;
    v4u kpre[2], vpre[2];
#pragma unroll
    for (int i = 0; i < 2; ++i) { const int ci = tid + 512 * i, key = ci >> 4, ch = ci & 15;
        kpre[i] = *(const v4u*)(Kp + (size_t)(64 * kt_beg + key) * kvpitch + ch * 8); vpre[i] = *(const v4u*)(Vp + (size_t)(64 * kt_beg + key) * kvpitch + ch * 8); }
    for (int kt = kt_beg; kt < kt_end; ++kt) {
        __syncthreads();
#pragma unroll
        for (int i = 0; i < 2; ++i) { const int ci = tid + 512 * i, key = ci >> 4, ch = ci & 15;
            *(LAS v4u*)(Ks + key * 256 + ((ch ^ (key & 15)) << 4)) = kpre[i]; *(LAS v4u*)(Vs + key * 256 + ((ch ^ ((key & 7) << 1)) << 4)) = vpre[i]; }
        if (kt + 1 < kt_end) {
#pragma unroll
            for (int i = 0; i < 2; ++i) { const int ci = tid + 512 * i, key = ci >> 4, ch = ci & 15;
                kpre[i] = *(const v4u*)(Kp + (size_t)(64 * (kt + 1) + key) * kvpitch + ch * 8); vpre[i] = *(const v4u*)(Vp + (size_t)(64 * (kt + 1) + key) * kvpitch + ch * 8); } }
        __syncthreads();
        bool rel_ok = true;
        if (MODE == 0) rel_ok = (64 * kt <= qw0 + 15 + 128) && (64 * kt + 63 >= qw0 - 128);
        if (!rel_ok) continue;
        f32x4 s[4];
#pragma unroll
        for (int mt = 0; mt < 4; ++mt) s[mt] = (f32x4){0.f, 0.f, 0.f, 0.f};
#pragma unroll
        for (int t = 0; t < 4; ++t)
#pragma unroll
            for (int mt = 0; mt < 4; ++mt) { const bf16x8 kf = *(const LAS bf16x8*)(Ks + (16 * mt + c) * 256 + (((4 * t + g) ^ c) << 4));
                s[mt] = __builtin_amdgcn_mfma_f32_16x16x32_bf16(kf, qf[t], s[mt], 0, 0, 0); }
        float tmax = -INFINITY;
#pragma unroll
        for (int mt = 0; mt < 4; ++mt)
#pragma unroll
            for (int r = 0; r < 4; ++r) {
                if (MODE == 0) { const int rel = (64 * kt + 16 * mt + 4 * g + r) - (qw0 + c); const bool ok = (rel >= -128) && (rel <= 128);
                    const int ri = ok ? rel + 128 : 128; const float bv = btab[ri]; s[mt][r] = ok ? s[mt][r] + bv : -INFINITY; }
                tmax = fmaxf(tmax, s[mt][r]); }
        tmax = fmaxf(tmax, __shfl_xor(tmax, 16)); tmax = fmaxf(tmax, __shfl_xor(tmax, 32));
        const float mnew = fmaxf(mrun, tmax), alpha = __builtin_amdgcn_exp2f(mrun - mnew); mrun = mnew; float ps = 0.f;
#pragma unroll
        for (int mt = 0; mt < 4; ++mt)
#pragma unroll
            for (int r = 0; r < 4; ++r) { const float p = __builtin_amdgcn_exp2f(s[mt][r] - mnew); s[mt][r] = p; ps += p; }
        lsum = lsum * alpha + ps;
#pragma unroll
        for (int i = 0; i < 8; ++i) oacc[i] = oacc[i] * alpha;
        bf16x8 pf[2];
#pragma unroll
        for (int t2 = 0; t2 < 2; ++t2) { v4u w; w.x = cvtpk(s[2 * t2][0], s[2 * t2][1]); w.y = cvtpk(s[2 * t2][2], s[2 * t2][3]); w.z = cvtpk(s[2 * t2 + 1][0], s[2 * t2 + 1][1]); w.w = cvtpk(s[2 * t2 + 1][2], s[2 * t2 + 1][3]);
            pf[t2] = __builtin_bit_cast(bf16x8, w); }
        const int q4 = c >> 2, p4 = c & 3;
#pragma unroll
        for (int t2 = 0; t2 < 2; ++t2)
#pragma unroll
            for (int mo = 0; mo < 8; ++mo) {
                const int k1 = 32 * t2 + 4 * g + q4, k2 = k1 + 16, chn = 2 * mo + (p4 >> 1);
                const s16x4 lo = __builtin_bit_cast(s16x4, __builtin_amdgcn_ds_read_tr16_b64_v4i16((LAS s16x4*)(Vs + k1 * 256 + ((chn ^ ((k1 & 7) << 1)) << 4) + (p4 & 1) * 8)));
                const s16x4 hi = __builtin_bit_cast(s16x4, __builtin_amdgcn_ds_read_tr16_b64_v4i16((LAS s16x4*)(Vs + k2 * 256 + ((chn ^ ((k2 & 7) << 1)) << 4) + (p4 & 1) * 8)));
                const bf16x8 vf = (bf16x8){lo[0], lo[1], lo[2], lo[3], hi[0], hi[1], hi[2], hi[3]};
                oacc[mo] = __builtin_amdgcn_mfma_f32_16x16x32_bf16(vf, pf[t2], oacc[mo], 0, 0, 0); }
    }
    lsum += __shfl_xor(lsum, 16); lsum += __shfl_xor(lsum, 32);
    const float inv = 1.0f / lsum;
#pragma unroll
    for (int mo = 0; mo < 8; ++mo) { v2u w; w.x = cvtpk(oacc[mo][0] * inv, oacc[mo][1] * inv); w.y = cvtpk(oacc[mo][2] * inv, oacc[mo][3] * inv);
        *(v2u*)(O + (size_t)(qw0 + c) * opitch + 16 * mo + 4 * g) = w; }
}
__device__ __forceinline__ void swa_phase(Frame& F, int b0, int nb) {
    LAS float* btab = (LAS float*)(F.lds + RING_OFF + 32768);
    const bf16* QS = DOP(bf16, DO_QSW); const bf16* KV = DOP(bf16, DO_KVSW); bf16* Y = WSP(bf16, WS_XB);
    (void)b0; (void)nb;
    unsigned* qctr = (unsigned*)(F.ctl + CW_SWAQ);
    for (;;) {
        __syncthreads();
        if (F.tid == 0) F.MISC[12] = __hip_atomic_fetch_add(qctr, 1u, __ATOMIC_RELAXED, __HIP_MEMORY_SCOPE_AGENT);
        __syncthreads();
        const int u = (int)F.MISC[12];
        if (u >= SWH * (SEQ / 128)) break;
        const int h = u & 7, qb = u >> 3, kvh = h >> 2;
        __syncthreads();
        if (F.tid < 257) btab[F.tid] = F.in[11][t5_bucket(F.tid - 128) * 8 + h] * LOG2E;
        __syncthreads();
        int kb = 2 * qb - 2, ke = 2 * qb + 4; if (kb < 0) kb = 0; if (ke > SEQ / 64) ke = SEQ / 64;
        attn_unit<0>(F, QS + h * 128, 1024, KV + kvh * 128, KV + 256 + kvh * 128, 512, Y + 1024 + h * 128, DM, qb * 128, kb, ke, btab, F.in[10][h] * LOG2E);
    }
}
__device__ __forceinline__ void mem_attn_phase(Frame& F) {
    const bf16* QM = WSP(bf16, WS_QM); const bf16* KVm = WSP(bf16, WS_KVM); bf16* OM = WSP(bf16, WS_OM);
    for (int u = blockIdx.x; u < MEMH * (SEQ / 128); u += F.G) {
        const int h = u & 3, qb = u >> 2;
        attn_unit<1>(F, QM + h * 128, 512, KVm + h * 128, KVm + 512 + h * 128, 1024, OM + h * 128, 512, qb * 128, 0, 4, nullptr, 0.f);
    }
}

typedef float f32x16 __attribute__((ext_vector_type(16)));
constexpr int DX_W = 0, DX_K = 16384, DX_U = 32768, DX_Q = 49152, DX_A = 65536, DX_BYTES = 73728;
constexpr size_t WS_GL = 1 * MiB + 128 * 1024;
constexpr int L_RAW = 0, RAW_PITCH = 784, L_MTF = 0, L_MTB = 16384, L_TB = 32768, TB_PITCH = 144, TB_SZ = 9216;
constexpr int L_QB = 69632, L_KB = 86016, L_KT = 102400, L_VT = 120832, L_PART = 139264, L_SC = 143360;
constexpr int L_CW = 145408;
static_assert(L_SC + 2048 <= L_CW && L_CW + 7680 <= LDSCTL_OFF, "prep LDS map");
__device__ __forceinline__ unsigned char* dnx_rec(Frame& F, int dir, int hd, int cn) { return F.ws + WS_DNX + (size_t)((dir * 8 + hd) * 256 + cn) * DX_BYTES; }
__device__ __forceinline__ v4u pack8f(const float* v) { v4u w; w.x = cvtpk(v[0], v[1]); w.y = cvtpk(v[2], v[3]); w.z = cvtpk(v[4], v[5]); w.w = cvtpk(v[6], v[7]); return w; }

__device__ __forceinline__ bf16x8 cvt8(const f32x16& v, int o) { v4u w; w.x = cvtpk(v[o], v[o + 1]); w.y = cvtpk(v[o + 2], v[o + 3]); w.z = cvtpk(v[o + 4], v[o + 5]); w.w = cvtpk(v[o + 6], v[o + 7]); return __builtin_bit_cast(bf16x8, w); }
__device__ __forceinline__ bf16x8 cvt8f(f32x4 a, f32x4 b) { v4u w; w.x = cvtpk(a[0], a[1]); w.y = cvtpk(a[2], a[3]); w.z = cvtpk(b[0], b[1]); w.w = cvtpk(b[2], b[3]); return __builtin_bit_cast(bf16x8, w); }
template <int dir> __device__ __forceinline__ void dn_solve_and_write(LAS unsigned char* lds, int lane) {
    const LAS float* MT = (const LAS float*)(lds + (dir ? L_MTB : L_MTF));
    LAS float* T0 = (LAS float*)(lds + L_TB + dir * 2 * TB_SZ);
    LAS float* Trow = T0 + lane * 68;
    const int blk = lane >> 5, cb = 32 * blk;
#pragma unroll 1
    for (int jr = 7; jr >= 0; --jr) {
        const int j0 = cb + 4 * jr;
        float a0 = (lane == j0) ? 1.f : 0.f, a1 = (lane == j0 + 1) ? 1.f : 0.f, a2 = (lane == j0 + 2) ? 1.f : 0.f, a3 = (lane == j0 + 3) ? 1.f : 0.f;
        const LAS float* mr = MT + j0 * 64;
#pragma unroll 4
        for (int sr = jr + 1; sr < 8; ++sr) {
            const int s0 = cb + 4 * sr;
            const f32x4 tv = *(const LAS f32x4*)(Trow + s0);
            const f32x4 m0 = *(const LAS f32x4*)(mr + s0), m1 = *(const LAS f32x4*)(mr + 64 + s0), m2 = *(const LAS f32x4*)(mr + 128 + s0), m3 = *(const LAS f32x4*)(mr + 192 + s0);
            a0 -= (tv[0] * m0[0] + tv[1] * m0[1]) + (tv[2] * m0[2] + tv[3] * m0[3]);
            a1 -= (tv[0] * m1[0] + tv[1] * m1[1]) + (tv[2] * m1[2] + tv[3] * m1[3]);
            a2 -= (tv[0] * m2[0] + tv[1] * m2[1]) + (tv[2] * m2[2] + tv[3] * m2[3]);
            a3 -= (tv[0] * m3[0] + tv[1] * m3[1]) + (tv[2] * m3[2] + tv[3] * m3[3]);
        }
        const f32x4 d0 = *(const LAS f32x4*)(mr + j0), d1 = *(const LAS f32x4*)(mr + 64 + j0), d2 = *(const LAS f32x4*)(mr + 128 + j0);
        const float t3 = a3, t2 = a2 - t3 * d2[3], t1 = a1 - t2 * d1[2] - t3 * d1[3], t0 = a0 - t1 * d0[1] - t2 * d0[2] - t3 * d0[3];
        *(LAS f32x4*)(Trow + j0) = (f32x4){t0, t1, t2, t3};
    }
    if (blk == 0) {
#pragma unroll
        for (int q = 8; q < 16; ++q) *(LAS f32x4*)(Trow + 4 * q) = (f32x4){0.f, 0.f, 0.f, 0.f}; }
    asm volatile("s_waitcnt lgkmcnt(0)" ::: "memory");
    {
        const int r = lane & 31, lh = lane >> 5;
        f32x16 Y;
#pragma unroll
        for (int e = 0; e < 16; ++e) Y[e] = 0.f;
#pragma unroll
        for (int kk = 0; kk < 2; ++kk) {
            float av[8], bv[8];
#pragma unroll
            for (int jj = 0; jj < 8; ++jj) { const int k = 16 * kk + 8 * lh + jj; av[jj] = MT[k * 64 + 32 + r]; bv[jj] = T0[k * 68 + r]; }
            Y = __builtin_amdgcn_mfma_f32_32x32x16_bf16(cvt8f((f32x4){av[0], av[1], av[2], av[3]}, (f32x4){av[4], av[5], av[6], av[7]}), cvt8f((f32x4){bv[0], bv[1], bv[2], bv[3]}, (f32x4){bv[4], bv[5], bv[6], bv[7]}), Y, 0, 0, 0);
        }
        f32x16 Z;
#pragma unroll
        for (int e = 0; e < 16; ++e) Z[e] = 0.f;
#pragma unroll
        for (int kk = 0; kk < 2; ++kk) {
            const f32x4 t0 = *(const LAS f32x4*)(T0 + (32 + r) * 68 + 32 + 16 * kk + 4 * lh), t1 = *(const LAS f32x4*)(T0 + (32 + r) * 68 + 32 + 16 * kk + 8 + 4 * lh);
            Z = __builtin_amdgcn_mfma_f32_32x32x16_bf16(cvt8f(t0, t1), cvt8(Y, 8 * kk), Z, 0, 0, 0);
        }
#pragma unroll
        for (int e = 0; e < 16; ++e) T0[(32 + (e & 3) + 8 * (e >> 2) + 4 * lh) * 68 + r] = -Z[e];
    }
    asm volatile("s_waitcnt lgkmcnt(0)" ::: "memory");
    f32x4 tr[16];
#pragma unroll
    for (int q = 0; q < 16; ++q) tr[q] = *(const LAS f32x4*)(Trow + 4 * q);
    asm volatile("s_waitcnt lgkmcnt(0)" ::: "memory");
    const LAS float* sc = (const LAS float*)(lds + L_SC);
    const LAS float* cU = sc + (dir ? 384 : 256); const LAS float* cW = sc + (dir ? 448 : 320);
    const int pos = dir ? 63 - lane : lane;
    LAS unsigned char* tu = lds + L_TB + dir * 2 * TB_SZ + pos * TB_PITCH; LAS unsigned char* tw = tu + TB_SZ;
#pragma unroll
    for (int q = 0; q < 8; ++q) {
        float u8[8], w8[8];
#pragma unroll
        for (int e = 0; e < 8; ++e) { const int s = 8 * q + e, sp = dir ? 63 - s : s; const float t = tr[sp >> 2][sp & 3]; u8[e] = t * cU[s]; w8[e] = t * cW[s]; }
        *(LAS v4u*)(tu + q * 16) = pack8f(u8); *(LAS v4u*)(tw + q * 16) = pack8f(w8);
    }
}

struct PrepRegs { v4u raw[7]; float ab[4]; };
__device__ __forceinline__ void prep_load(Frame& F, int u, int tid, int lane, PrepRegs& R) {
    const int cn = u >> 3, hd = u & 7; const bf16* QKV = WSP(bf16, WS_QKV);
#pragma unroll
    for (int k = 0; k < 7; ++k) { const int ci = tid + 512 * k; const int row = ci / 48, cc = ci % 48, seg = cc >> 4, ch = (cc & 15) * 8, tok = 64 * cn - 2 + row;
        v4u v = (v4u){0u, 0u, 0u, 0u};
        if (ci < 68 * 48 && tok >= 0 && tok < SEQ) v = *(const v4u*)(QKV + (size_t)tok * 3072 + seg * 1024 + hd * 128 + ch);
        R.raw[k] = v; }
    if (tid < 64) { const float* ab = WSP(float, WS_AB) + (size_t)(64 * cn + lane) * 32; R.ab[0] = ab[hd]; R.ab[1] = ab[8 + hd]; R.ab[2] = ab[16 + hd]; R.ab[3] = ab[24 + hd]; }
}
#define DNX_ST(ptr, val) do { const v4u v_ = (val); if (MASK & 32) *(v4u*)(ptr) = v_; else asm volatile("" :: "v"(v_)); } while (0)
template <int MASK> __device__ __forceinline__ void dn_prep_unit(Frame& F, int cn, int hd, PrepRegs& PR, int next_u) {
    LAS unsigned char* lds = F.lds; int tid = F.tid, lane = F.lane; const int wave = F.wave;
    asm volatile("" : "+v"(tid), "+v"(lane));
    LAS float* sc = (LAS float*)(lds + L_SC);
    __syncthreads();
    if (MASK & 1) {
    const float abv[4] = {PR.ab[0], PR.ab[1], PR.ab[2], PR.ab[3]};
#pragma unroll
    for (int k = 0; k < 7; ++k) { const int ci = tid + 512 * k; const int row = ci / 48, cc = ci % 48, seg = cc >> 4, ch = (cc & 15) * 8;
        if (ci < 68 * 48) *(LAS v4u*)(lds + L_RAW + row * RAW_PITCH + (seg * 128 + ch) * 2) = PR.raw[k]; }
    if (wave == 0) {
        const float bfv = 1.0f / (1.0f + __expf(-abv[0])), bbv = 1.0f / (1.0f + __expf(-abv[1]));
        const float gf = -__expf(F.in[5][hd]) * softplusf(abv[2] + F.in[7][hd]), gb = -__expf(F.in[6][hd]) * softplusf(abv[3] + F.in[8][hd]);
        float Gf = gf, Gb = gb;
#pragma unroll
        for (int o = 1; o < 64; o <<= 1) { const float a = __shfl_up(Gf, o), b = __shfl_down(Gb, o); if (lane >= o) Gf += a; if (lane + o < 64) Gb += b; }
        sc[lane] = Gf; sc[64 + lane] = Gb; sc[128 + lane] = bfv; sc[192 + lane] = bbv;
        sc[256 + lane] = bfv; sc[320 + lane] = -bfv * __expf(Gf); sc[384 + lane] = bbv; sc[448 + lane] = -bbv * __expf(Gb);
        float* GL = WSP(float, WS_GL);
        if (MASK & 32) { if (lane == 63) GL[(0 * 8 + hd) * 256 + cn] = __expf(Gf);
        if (lane == 0) GL[(1 * 8 + hd) * 256 + cn] = __expf(Gb); }
    }
    }
    __syncthreads();
    asm volatile("" : "+v"(tid), "+v"(lane));
    if (MASK & 2) {
        const int t = wave, pos = lane; const LAS float* cw = (const LAS float*)(lds + L_CW) + 16 * t;
        float qv[16], kv[16], vv[16];
#pragma unroll
        for (int seg = 0; seg < 3; ++seg) {
            float a[16];
#pragma unroll
            for (int i = 0; i < 16; ++i) a[i] = 0.f;
#pragma unroll
            for (int j = 0; j < 5; ++j) {
                const LAS unsigned char* rp = lds + L_RAW + (pos + j) * RAW_PITCH + (seg * 128 + 16 * t) * 2;
                const v4u r0 = *(const LAS v4u*)rp, r1 = *(const LAS v4u*)(rp + 16);
                const LAS float* w = cw + j * 384 + seg * 128;
#pragma unroll
                for (int i = 0; i < 4; ++i) { a[2 * i] += w[2 * i] * bflo(r0[i]); a[2 * i + 1] += w[2 * i + 1] * bfhi(r0[i]); a[8 + 2 * i] += w[8 + 2 * i] * bflo(r1[i]); a[8 + 2 * i + 1] += w[8 + 2 * i + 1] * bfhi(r1[i]); }
            }
#pragma unroll
            for (int i = 0; i < 16; ++i) { const float s = siluf(a[i]); if (seg == 0) qv[i] = s; else if (seg == 1) kv[i] = s; else vv[i] = s; }
        }
        float sq = 0.f, sk = 0.f;
#pragma unroll
        for (int i = 0; i < 16; ++i) { sq += qv[i] * qv[i]; sk += kv[i] * kv[i]; }
        LAS float* part = (LAS float*)(lds + L_PART);
        part[t * 64 + pos] = sq; part[512 + t * 64 + pos] = sk;
        __syncthreads();
        float tq = 0.f, tk = 0.f;
#pragma unroll
        for (int i = 0; i < 8; ++i) { tq += part[i * 64 + pos]; tk += part[512 + i * 64 + pos]; }
        const float rq = (1.0f / sqrtf(tq + 1e-6f)) * 0.08838834764831845f, rk = 1.0f / sqrtf(tk + 1e-6f);
#pragma unroll
        for (int i = 0; i < 16; ++i) { qv[i] *= rq; kv[i] *= rk; }
        *(LAS v4u*)(lds + L_QB + pos * 256 + (((2 * t) ^ (pos & 15)) << 4)) = pack8f(qv); *(LAS v4u*)(lds + L_QB + pos * 256 + (((2 * t + 1) ^ (pos & 15)) << 4)) = pack8f(qv + 8);
        *(LAS v4u*)(lds + L_KB + pos * 256 + (((2 * t) ^ (pos & 15)) << 4)) = pack8f(kv); *(LAS v4u*)(lds + L_KB + pos * 256 + (((2 * t + 1) ^ (pos & 15)) << 4)) = pack8f(kv + 8);
#pragma unroll
        for (int i = 0; i < 16; ++i) { const unsigned w = cvtpk(kv[i], vv[i]); *(LAS unsigned short*)(lds + L_KT + (16 * t + i) * TB_PITCH + pos * 2) = (unsigned short)w; *(LAS unsigned short*)(lds + L_VT + (16 * t + i) * TB_PITCH + pos * 2) = (unsigned short)(w >> 16); }
        const float ef = __expf(sc[pos]), eb = __expf(sc[64 + pos]); const int mt = pos >> 5;
#pragma unroll
        for (int dir = 0; dir < 2; ++dir) { const float e = dir ? eb : ef; unsigned char* rec = dnx_rec(F, dir, hd, cn) + DX_Q;
#pragma unroll
            for (int lh = 0; lh < 2; ++lh) { float o8[8];
#pragma unroll
                for (int j = 0; j < 8; ++j) o8[j] = qv[8 * (j >> 2) + 4 * lh + (j & 3)] * e;
                DNX_ST(rec + ((mt * 8 + t) * 64 + 32 * lh + (pos & 31)) * 16, pack8f(o8)); } }
    }
    __syncthreads();
    asm volatile("" : "+v"(tid), "+v"(lane));
    if (MASK & 4) {
        const int r = lane & 31, lh = lane >> 5, x = wave & 3, ta = x >> 1, tb = x & 1;
        const LAS unsigned char* Ab = lds + L_KB + (32 * ta + r) * 256; const LAS unsigned char* Bb = lds + (wave < 4 ? L_KB : L_QB) + (32 * tb + r) * 256;
        f32x16 acc;
#pragma unroll
        for (int i = 0; i < 16; ++i) acc[i] = 0.f;
#pragma unroll
        for (int kk = 0; kk < 8; ++kk) { const int ch = ((2 * kk + lh) ^ (r & 15)) << 4;
            acc = __builtin_amdgcn_mfma_f32_32x32x16_bf16(*(const LAS bf16x8*)(Ab + ch), *(const LAS bf16x8*)(Bb + ch), acc, 0, 0, 0); }
        const int b = 32 * tb + r;
        if (wave < 4) {
            const float Gfb = sc[b], Gbb = sc[64 + b];
#pragma unroll
            for (int q = 0; q < 4; ++q) { const int a0 = 32 * ta + 8 * q + 4 * lh; f32x4 mf, mb;
#pragma unroll
                for (int e = 0; e < 4; ++e) { const int a = a0 + e; const float kkv = acc[4 * q + e];
                    const float vf = sc[128 + a] * kkv * __expf(fminf(sc[a] - Gfb, 0.f)), vb = sc[192 + a] * kkv * __expf(fminf(sc[64 + a] - Gbb, 0.f));
                    mf[e] = (a > b) ? vf : 0.f; mb[3 - e] = (a < b) ? vb : 0.f; }
                *(LAS f32x4*)(lds + L_MTF + (b * 64 + a0) * 4) = mf; *(LAS f32x4*)(lds + L_MTB + ((63 - b) * 64 + 60 - a0) * 4) = mb; }
        } else {
            const float Gfc = sc[b], Gbc = sc[64 + b];
#pragma unroll
            for (int dir = 0; dir < 2; ++dir) { unsigned char* rec = dnx_rec(F, dir, hd, cn) + DX_A;
#pragma unroll
                for (int s2 = 0; s2 < 2; ++s2) { float o8[8];
#pragma unroll
                    for (int j = 0; j < 8; ++j) { const int s = 32 * ta + 16 * s2 + 8 * (j >> 2) + 4 * lh + (j & 3); const float v = acc[8 * s2 + j];
                        const float ev = v * __expf(fminf(dir ? Gbc - sc[64 + s] : Gfc - sc[s], 0.f)); o8[j] = (dir ? (s >= b) : (s <= b)) ? ev : 0.f; }
                    DNX_ST(rec + ((tb * 4 + 2 * ta + s2) * 64 + lane) * 16, pack8f(o8)); } }
        }
    }
    __syncthreads();
    asm volatile("" : "+v"(tid), "+v"(lane));
    if ((MASK & 1) && next_u < 256 * DNH) prep_load(F, next_u, tid, lane, PR);
    if (!(MASK & 8)) {} else if (wave == 0) dn_solve_and_write<0>(lds, lane);
    else if (wave == 1) dn_solve_and_write<1>(lds, lane);
    else {
        const int r = lane & 31, lh = lane >> 5;
        for (int f = wave - 2; f < 32; f += 6) { const int dir = f >> 4, m = (f >> 2) & 3, t = f & 3; const int dk = 32 * m + r;
            const v2u k0 = *(const LAS v2u*)(lds + L_KT + dk * TB_PITCH + (16 * t + 4 * lh) * 2), k1 = *(const LAS v2u*)(lds + L_KT + dk * TB_PITCH + (16 * t + 8 + 4 * lh) * 2);
            const float Gl = dir ? sc[64] : sc[63]; const LAS float* Gs = sc + (dir ? 64 : 0) + 16 * t + 4 * lh; float o8[8];
            o8[0] = bflo(k0.x) * __expf(Gl - Gs[0]); o8[1] = bfhi(k0.x) * __expf(Gl - Gs[1]); o8[2] = bflo(k0.y) * __expf(Gl - Gs[2]); o8[3] = bfhi(k0.y) * __expf(Gl - Gs[3]);
            o8[4] = bflo(k1.x) * __expf(Gl - Gs[8]); o8[5] = bfhi(k1.x) * __expf(Gl - Gs[9]); o8[6] = bflo(k1.y) * __expf(Gl - Gs[10]); o8[7] = bfhi(k1.y) * __expf(Gl - Gs[11]);
            DNX_ST(dnx_rec(F, dir, hd, cn) + DX_K + ((m * 4 + t) * 64 + lane) * 16, pack8f(o8)); }
    }
    __syncthreads();
    asm volatile("" : "+v"(tid), "+v"(lane));
    if (MASK & 16) {
        const int dir = wave >> 2, x = wave & 3, r = lane & 31, lh = lane >> 5;
        const LAS unsigned char* Tu = lds + L_TB + (dir ? 2 : 0) * TB_SZ; const LAS unsigned char* Tw = Tu + TB_SZ;
        unsigned char* rec = dnx_rec(F, dir, hd, cn);
#pragma unroll
        for (int mt = 0; mt < 2; ++mt) {
            f32x16 aw, au;
#pragma unroll
            for (int i = 0; i < 16; ++i) { aw[i] = 0.f; au[i] = 0.f; }
#pragma unroll
            for (int kk = 0; kk < 4; ++kk) { const int so = (16 * kk + 8 * lh) * 2;
                aw = __builtin_amdgcn_mfma_f32_32x32x16_bf16(*(const LAS bf16x8*)(lds + L_KT + (32 * x + r) * TB_PITCH + so), *(const LAS bf16x8*)(Tw + (32 * mt + r) * TB_PITCH + so), aw, 0, 0, 0);
                au = __builtin_amdgcn_mfma_f32_32x32x16_bf16(*(const LAS bf16x8*)(Tu + (32 * mt + r) * TB_PITCH + so), *(const LAS bf16x8*)(lds + L_VT + (32 * x + r) * TB_PITCH + so), au, 0, 0, 0); }
            float tmp[16];
#pragma unroll
            for (int i = 0; i < 16; ++i) tmp[i] = aw[i];
            DNX_ST(rec + DX_W + ((mt * 8 + 2 * x) * 64 + lane) * 16, pack8f(tmp)); DNX_ST(rec + DX_W + ((mt * 8 + 2 * x + 1) * 64 + lane) * 16, pack8f(tmp + 8));
#pragma unroll
            for (int i = 0; i < 16; ++i) tmp[i] = au[i];
            DNX_ST(rec + DX_U + ((x * 2 + mt) * 64 + lane) * 32, pack8f(tmp)); DNX_ST(rec + DX_U + ((x * 2 + mt) * 64 + lane) * 32 + 16, pack8f(tmp + 8));
        }
    }
}
#undef DNX_ST
template <int MASK> __device__ __forceinline__ void dn_prep_phase(Frame& F) {
    PrepRegs PR; int u = blockIdx.x; int cur_hd = -1;
    if (u < 256 * DNH) prep_load(F, u, F.tid, F.lane, PR);
    for (; u < 256 * DNH; u += F.G) {
        const int hd = u & 7;
        if (hd != cur_hd) {
            __syncthreads();
            for (int i = F.tid; i < 5 * 384; i += NWAVES * 64) { const int j = i / 384, c = i % 384; ((LAS float*)(F.lds + L_CW))[i] = F.in[4][j * 3072 + (c >> 7) * 1024 + hd * 128 + (c & 127)]; }
            cur_hd = hd;
        }
        dn_prep_unit<MASK>(F, u >> 3, hd, PR, u + F.G);
    }
}


constexpr int NSEG = 16, SEGL = 16;
constexpr size_t WS_PF = 176 * MiB, WS_RG = 184 * MiB, WS_SIN = 24 * MiB;
constexpr int SLOT1 = 49152, SLOT3 = 73728, L_GLS = 147456;
#define DN_WAIT(V) asm volatile("s_waitcnt vmcnt(" #V ") lgkmcnt(0)" ::: "memory")
#define DN_BAR() do { __builtin_amdgcn_s_barrier(); asm volatile("" ::: "memory"); } while (0)
__device__ __forceinline__ int seg_chunk(int dir, int g, int i) { const int n = SEGL * g + i; return dir ? 255 - n : n; }
__device__ __forceinline__ void u_to_acc(f32x16& a, const LAS unsigned char* up) {
    const v4u u0 = *(const LAS v4u*)up, u1 = *(const LAS v4u*)(up + 16);
#pragma unroll
    for (int i = 0; i < 4; ++i) { a[2 * i] = bflo(u0[i]); a[2 * i + 1] = bfhi(u0[i]); a[8 + 2 * i] = bflo(u1[i]); a[8 + 2 * i + 1] = bfhi(u1[i]); }
}
template <bool OUT>
__device__ __forceinline__ void dn_step(f32x16 (&S)[4], f32x16 (&aV)[2], f32x16 (&aO)[2], const LAS unsigned char* buf, float gl) {
#pragma unroll
    for (int t = 0; t < 8; ++t) { const bf16x8 sb = cvt8(S[t >> 1], 8 * (t & 1));
#pragma unroll
        for (int mt = 0; mt < 2; ++mt) {
            aV[mt] = __builtin_amdgcn_mfma_f32_32x32x16_bf16(*(const LAS bf16x8*)(buf + DX_W + (mt * 8 + t) * 1024), sb, aV[mt], 0, 0, 0);
            if (OUT) aO[mt] = __builtin_amdgcn_mfma_f32_32x32x16_bf16(*(const LAS bf16x8*)(buf + DX_Q + (mt * 8 + t) * 1024), sb, aO[mt], 0, 0, 0); } }
    bf16x8 vb[4];
#pragma unroll
    for (int t = 0; t < 4; ++t) vb[t] = cvt8(aV[t >> 1], 8 * (t & 1));
#pragma unroll
    for (int m = 0; m < 4; ++m) S[m] = S[m] * gl;
#pragma unroll
    for (int t = 0; t < 4; ++t) {
#pragma unroll
        for (int m = 0; m < 4; ++m) S[m] = __builtin_amdgcn_mfma_f32_32x32x16_bf16(*(const LAS bf16x8*)(buf + DX_K + (m * 4 + t) * 1024), vb[t], S[m], 0, 0, 0);
        if (OUT) {
#pragma unroll
            for (int mt = 0; mt < 2; ++mt) aO[mt] = __builtin_amdgcn_mfma_f32_32x32x16_bf16(*(const LAS bf16x8*)(buf + DX_A + (mt * 4 + t) * 1024), vb[t], aO[mt], 0, 0, 0); } }
}

__device__ __forceinline__ void dn_pass1(Frame& F) {
    LAS unsigned char* lds = F.lds; const int lane = F.lane, wave = F.wave, r = lane & 31, lh = lane >> 5, part = wave >> 2, d = wave & 3;
    LAS float* gls = (LAS float*)(lds + L_GLS);
    for (int unit = blockIdx.x; unit < 16 * NSEG; unit += F.G) {
        const int dir = unit >> 7, hd = (unit >> 4) & 7, g = unit & 15;
        DN_WAIT(0); __syncthreads();
        if (F.tid < SEGL) gls[F.tid] = WSP(float, WS_GL)[(dir * 8 + hd) * 256 + seg_chunk(dir, g, F.tid)];
        DN_WAIT(0);
        f32x16 S[4];
#pragma unroll
        for (int m = 0; m < 4; ++m)
#pragma unroll
            for (int i = 0; i < 16; ++i) S[m][i] = (part && (32 * m + (i & 3) + 8 * (i >> 2) + 4 * lh == 32 * d + r)) ? 1.f : 0.f;
#define P1_ISSUE(i) do { const unsigned char* src_ = dnx_rec(F, dir, hd, seg_chunk(dir, g, (i))) + lane * 16; LAS unsigned char* dst_ = lds + ((i) % 3) * SLOT1; \
            _Pragma("unroll") for (int k_ = 0; k_ < 6; ++k_) { const int p_ = wave + 8 * k_; __builtin_amdgcn_global_load_lds((const unsigned*)(src_ + p_ * 1024), (LAS unsigned*)(dst_ + p_ * 1024), 16, 0, 0); } } while (0)
        P1_ISSUE(0); P1_ISSUE(1);
        for (int i = 0; i < SEGL; ++i) {
            if (i + 1 < SEGL) DN_WAIT(6); else DN_WAIT(0);
            DN_BAR();
            if (i + 2 < SEGL) P1_ISSUE(i + 2);
            const LAS unsigned char* buf = lds + (i % 3) * SLOT1 + lane * 16;
            f32x16 aV[2], aO[2];
#pragma unroll
            for (int mt = 0; mt < 2; ++mt) {
                if (part == 0) u_to_acc(aV[mt], lds + (i % 3) * SLOT1 + DX_U + ((d * 2 + mt) * 64 + lane) * 32);
                else {
#pragma unroll
                    for (int e = 0; e < 16; ++e) aV[mt][e] = 0.f; } }
            dn_step<false>(S, aV, aO, buf, gls[i]);
        }
#undef P1_ISSUE
        DN_WAIT(0); DN_BAR();
        if (part == 0) {
            float* rg = (float*)(F.ws + WS_RG) + (size_t)unit * 16384;
#pragma unroll
            for (int m = 0; m < 4; ++m)
#pragma unroll
                for (int q = 0; q < 4; ++q) *(f32x4*)(rg + ((d * 4 + m) * 64 + lane) * 16 + 4 * q) = (f32x4){S[m][4 * q], S[m][4 * q + 1], S[m][4 * q + 2], S[m][4 * q + 3]};
        } else {
#pragma unroll
            for (int m = 0; m < 4; ++m)
#pragma unroll
                for (int i = 0; i < 16; ++i) *(LAS unsigned short*)(lds + (32 * m + (i & 3) + 8 * (i >> 2) + 4 * lh) * 272 + (32 * d + r) * 2) = (unsigned short)f2bf(S[m][i]);
        }
        DN_WAIT(0); DN_BAR();
        if (part == 1) {
            unsigned char* pf = F.ws + WS_PF + (size_t)unit * 32768;
#pragma unroll
            for (int k = 0; k < 8; ++k) { const int f = d * 8 + k, m = f >> 3, t = f & 7;
                const v2u a = *(const LAS v2u*)(lds + (32 * m + r) * 272 + (16 * t + 4 * lh) * 2), b = *(const LAS v2u*)(lds + (32 * m + r) * 272 + (16 * t + 8 + 4 * lh) * 2);
                *(v4u*)(pf + (f * 64 + lane) * 16) = (v4u){a.x, a.y, b.x, b.y}; }
        }
    }
}
__device__ __forceinline__ void dn_fold(Frame& F) {
    const int b = blockIdx.x; if (b >= 16) return;
    LAS unsigned char* lds = F.lds; const int lane = F.lane, wave = F.wave, dir = b >> 3, hd = b & 7;
    const int unit0 = (dir * 8 + hd) * 16;
    __syncthreads();
    if (wave >= 4) {
        const int lw = wave - 4;
        for (int g = 0; g < NSEG; ++g) {
            if (g < NSEG - 1) { const unsigned char* src = F.ws + WS_PF + (size_t)(unit0 + g) * 32768 + lane * 16; LAS unsigned char* dst = lds + (g & 1) * 32768;
#pragma unroll
                for (int k = 0; k < 8; ++k) { const int p = lw + 4 * k; __builtin_amdgcn_global_load_lds((const unsigned*)(src + p * 1024), (LAS unsigned*)(dst + p * 1024), 16, 0, 0); } }
            DN_WAIT(0); DN_BAR();
        }
    } else {
        const int d = wave;
        f32x16 S[4], R[4];
#pragma unroll
        for (int m = 0; m < 4; ++m)
#pragma unroll
            for (int i = 0; i < 16; ++i) S[m][i] = 0.f;
        const float* rg0 = (const float*)(F.ws + WS_RG) + (size_t)unit0 * 16384; float* sin0 = (float*)(F.ws + WS_SIN) + (size_t)unit0 * 16384;
#pragma unroll
        for (int m = 0; m < 4; ++m)
#pragma unroll
            for (int q = 0; q < 4; ++q) { const f32x4 v = *(const f32x4*)(rg0 + ((d * 4 + m) * 64 + lane) * 16 + 4 * q); R[m][4 * q] = v[0]; R[m][4 * q + 1] = v[1]; R[m][4 * q + 2] = v[2]; R[m][4 * q + 3] = v[3]; }
        DN_BAR();
        for (int g = 0; g < NSEG; ++g) {
            float* so = sin0 + (size_t)g * 16384;
#pragma unroll
            for (int m = 0; m < 4; ++m)
#pragma unroll
                for (int q = 0; q < 4; ++q) *(f32x4*)(so + ((d * 4 + m) * 64 + lane) * 16 + 4 * q) = (f32x4){S[m][4 * q], S[m][4 * q + 1], S[m][4 * q + 2], S[m][4 * q + 3]};
            if (g == NSEG - 1) break;
            const LAS unsigned char* buf = lds + (g & 1) * 32768 + lane * 16;
            bf16x8 sb[8];
#pragma unroll
            for (int t = 0; t < 8; ++t) sb[t] = cvt8(S[t >> 1], 8 * (t & 1));
#pragma unroll
            for (int m = 0; m < 4; ++m) { S[m] = R[m];
#pragma unroll
                for (int t = 0; t < 8; ++t) S[m] = __builtin_amdgcn_mfma_f32_32x32x16_bf16(*(const LAS bf16x8*)(buf + (m * 8 + t) * 1024), sb[t], S[m], 0, 0, 0); }
            if (g + 1 < NSEG - 1) { const float* rg = rg0 + (size_t)(g + 1) * 16384;
#pragma unroll
                for (int m = 0; m < 4; ++m)
#pragma unroll
                    for (int q = 0; q < 4; ++q) { const f32x4 v = *(const f32x4*)(rg + ((d * 4 + m) * 64 + lane) * 16 + 4 * q); R[m][4 * q] = v[0]; R[m][4 * q + 1] = v[1]; R[m][4 * q + 2] = v[2]; R[m][4 * q + 3] = v[3]; } }
            asm volatile("s_waitcnt lgkmcnt(0)" ::: "memory");
            DN_BAR();
        }
    }
    __syncthreads();
}
__device__ __forceinline__ void dn_pass3(Frame& F) {
    LAS unsigned char* lds = F.lds; const int lane = F.lane, wave = F.wave, r = lane & 31, lh = lane >> 5;
    LAS float* gls = (LAS float*)(lds + L_GLS);
    for (int unit = blockIdx.x; unit < 16 * NSEG; unit += F.G) {
        const int dir = unit >> 7, hd = (unit >> 4) & 7, g = unit & 15;
        __syncthreads();
        if (F.tid < SEGL) gls[F.tid] = WSP(float, WS_GL)[(dir * 8 + hd) * 256 + seg_chunk(dir, g, F.tid)];
        asm volatile("s_waitcnt lgkmcnt(0)" ::: "memory");
        if (wave >= 4) {
            const int lw = wave - 4;
            for (int i = 0; i <= SEGL; ++i) {
                if (i < SEGL) { const unsigned char* src = dnx_rec(F, dir, hd, seg_chunk(dir, g, i)) + lane * 16; LAS unsigned char* dst = lds + (i & 1) * SLOT3;
#pragma unroll
                    for (int k = 0; k < 18; ++k) { const int p = lw + 4 * k; __builtin_amdgcn_global_load_lds((const unsigned*)(src + p * 1024), (LAS unsigned*)(dst + p * 1024), 16, 0, 0); } }
                DN_WAIT(0); DN_BAR();
            }
        } else {
            const int d = wave;
            f32x16 S[4];
            const float* si = (const float*)(F.ws + WS_SIN) + (size_t)unit * 16384;
#pragma unroll
            for (int m = 0; m < 4; ++m)
#pragma unroll
                for (int q = 0; q < 4; ++q) { const f32x4 v = *(const f32x4*)(si + ((d * 4 + m) * 64 + lane) * 16 + 4 * q); S[m][4 * q] = v[0]; S[m][4 * q + 1] = v[1]; S[m][4 * q + 2] = v[2]; S[m][4 * q + 3] = v[3]; }
            bf16* O = WSP(bf16, dir ? WS_OB : WS_OF);
            DN_BAR();
            for (int i = 0; i < SEGL; ++i) {
                const int cn = seg_chunk(dir, g, i); const LAS unsigned char* slot = lds + (i & 1) * SLOT3;
                f32x16 aV[2], aO[2];
#pragma unroll
                for (int mt = 0; mt < 2; ++mt) { u_to_acc(aV[mt], slot + DX_U + ((d * 2 + mt) * 64 + lane) * 32);
#pragma unroll
                    for (int e = 0; e < 16; ++e) aO[mt][e] = 0.f; }
                dn_step<true>(S, aV, aO, slot + lane * 16, gls[i]);
                bf16* op = O + (size_t)(64 * cn + 4 * lh) * 1024 + hd * 128 + 32 * d + r;
#pragma unroll
                for (int mt = 0; mt < 2; ++mt)
#pragma unroll
                    for (int e = 0; e < 16; ++e) op[(size_t)(32 * mt + (e & 3) + 8 * (e >> 2)) * 1024] = (bf16)f2bf(aO[mt][e]);
                asm volatile("s_waitcnt lgkmcnt(0)" ::: "memory");
                DN_BAR();
            }
        }
    }
    __syncthreads();
}

#ifndef MK_N_LAUNCHES
#define MK_N_LAUNCHES 1
#endif
constexpr int N_PHASES = 14;
struct Args { const float* in[23]; float* out; unsigned char* ws; int ph_lo, ph_hi; };
static_assert(sizeof(Args) == 23 * 8 + 8 + 8 + 8, "Args has no padding");

__global__ void __launch_bounds__(NWAVES * 64, 2) enc_fwd(Args args) {
    extern __shared__ __attribute__((aligned(16))) unsigned char lds[];
    Frame F;
    F.lds = (LAS unsigned char*)lds;
    F.MISC = (volatile LAS unsigned*)(F.lds + MISC_OFF);
    F.tid = threadIdx.x; F.lane = F.tid & 63; F.wave = __builtin_amdgcn_readfirstlane(F.tid >> 6);
    F.G = gridDim.x; { const int bx = blockIdx.x; F.vcu = (F.G % 8 == 0) ? (bx % 8) * (F.G / 8) + bx / 8 : bx; }
#pragma unroll
    for (int i = 0; i < 23; ++i) F.in[i] = args.in[i];
    F.out = args.out; F.ws = args.ws; F.ctl = (gu32*)(args.ws + WS_CTL);
    for (int u = F.tid; u < (LDS_BYTES - LDSCTL_OFF) / 4; u += NWAVES * 64) ((LAS unsigned*)(F.lds + LDSCTL_OFF))[u] = 0u;
    __syncthreads();
    const int lo = args.ph_lo, hi = args.ph_hi;
    XcdBarrier bar; bar.bar = (unsigned*)(F.ctl + CW_BAR); bar.x = 0; bar.st = nullptr;
    if (hi - lo > 1) bar = xcd_barrier_post((unsigned*)(F.ctl + CW_BAR), F.MISC + 8);
#define IN(k) (lo <= (k) && (k) < hi)
#define SEAM(k) do { if (IN(k) && IN((k) + 1)) xcd_barrier(bar); } while (0)
    float* sumsq2 = (float*)(F.ws + WS_CTL + CTL_SUMSQ2); float* sumsq3 = (float*)(F.ws + WS_CTL + CTL_SUMSQ3); float* sumsq4 = (float*)(F.ws + WS_CTL + CTL_SUMSQ4);

    if (IN(0)) { p0_prologue(F);
#if defined(REPEAT_PHASE) && REPEAT_PHASE == 0
        p0_prologue(F);
#endif
    } SEAM(0);
    if (IN(1)) {
        { pg8::Gemm g{WSP(bf16, WS_XB), WSP(bf16, WS_WIN), SEQ, NINP, DM}; pg8::StaticOrder S; S.init(SEQ, NINP, F.G, (int)blockIdx.x);
          EpiProj E{WSP(float, WS_RSTD1), WSP(bf16, WS_QKV), DOP(bf16, DO_Z), DOP(bf16, DO_QSW), DOP(bf16, DO_KVSW), WSP(float, WS_AB)};
          pg8::gemm_phase<EpiProj, pg8::StaticOrder, true, true>(F.lds + RING_OFF, g, S, E);
#if defined(REPEAT_PHASE) && REPEAT_PHASE == 1
          pg8::gemm_phase<EpiProj, pg8::StaticOrder, true, true>(F.lds + RING_OFF, g, S, E);
#endif
          }
        { const int nwg = (SEQ / 256) * (NINP / 256), rem = nwg % F.G; if (rem) p1_late_transposes(F, rem, F.G - rem); else p1_late_transposes(F, 0, F.G); }
    } SEAM(1);
    if (IN(2)) { dn_prep_phase<63>(F);
#if defined(REPEAT_PHASE) && REPEAT_PHASE == 2
        dn_prep_phase<63>(F);
#endif
#if defined(REPEAT_PHASE) && REPEAT_PHASE >= 1000 && REPEAT_PHASE < 1064
        dn_prep_phase<REPEAT_PHASE - 1000>(F);
#endif
    } SEAM(2);
    if (IN(3)) { dn_pass1(F);
#if defined(REPEAT_PHASE) && REPEAT_PHASE == 3
        dn_pass1(F);
#endif
    } SEAM(3);
    if (IN(12)) { dn_fold(F); swa_phase(F, 0, F.G); }
#if defined(REPEAT_PHASE) && REPEAT_PHASE == 12
    if (IN(12)) { dn_fold(F); swa_phase(F, 0, F.G); }
#endif
#if defined(REPEAT_PHASE) && REPEAT_PHASE == 112
    if (IN(12)) { dn_fold(F); }
#endif
#if defined(REPEAT_PHASE) && REPEAT_PHASE == 212
    if (IN(12)) { swa_phase(F, 0, F.G); }
#endif
    if (IN(12) && IN(13)) xcd_barrier(bar);
    if (IN(13)) { dn_pass3(F);
#if defined(REPEAT_PHASE) && REPEAT_PHASE == 13
        dn_pass3(F);
#endif
    } if (IN(13) && IN(4)) xcd_barrier(bar);
    if (IN(4)) { dn_combine(F);
#if defined(REPEAT_PHASE) && REPEAT_PHASE == 4
        dn_combine(F);
#endif
    } SEAM(4);
    if (IN(5)) {
        pg8::Gemm g{WSP(bf16, WS_XB), WSP(bf16, WS_WOUT), SEQ, DM, DM}; pg8::StaticOrder S; S.init(SEQ, DM, F.G, (int)blockIdx.x);
        EpiRes E{F.in[0], nullptr, nullptr, WSP(bf16, WS_H1B), sumsq2};
        pg8::gemm_phase<EpiRes, pg8::StaticOrder, true, true>(F.lds + RING_OFF, g, S, E);
#if defined(REPEAT_PHASE) && REPEAT_PHASE == 5
        { EpiRes E2{F.in[0], nullptr, nullptr, nullptr, (float*)(F.ws + WS_CTL + 448 * 1024)}; pg8::gemm_phase<EpiRes, pg8::StaticOrder, true, true>(F.lds + RING_OFF, g, S, E2); }
#endif
    } SEAM(5);
    if (IN(6)) {
        pg8::Gemm g{WSP(bf16, WS_H1B), WSP(bf16, WS_WQ), SEQ, 512, DM}; pg8::StaticOrder S; S.init(SEQ, 512, F.G, (int)blockIdx.x);
        EpiScaleBf16 E{sumsq2, 1, QSCALE, WSP(bf16, WS_QM), 512};
        pg8::gemm_phase<EpiScaleBf16, pg8::StaticOrder, true, true>(F.lds + RING_OFF, g, S, E);
        { pg8::Gemm g2{WSP(bf16, WS_MEMB), WSP(bf16, WS_WKV), MEMT, 1024, DM}; pg8::StaticOrder S2; S2.init(MEMT, 1024, F.G, (int)((blockIdx.x + F.G - (F.G >> 1)) % F.G));
          EpiScaleBf16 E2{WSP(float, WS_RSTDM), 0, 1.0f, WSP(bf16, WS_KVM), 1024};
          pg8::gemm_phase<EpiScaleBf16, pg8::StaticOrder, true, true>(F.lds + RING_OFF, g2, S2, E2); }
        { const int nbusy = (F.G >> 1) + 4; if (F.G >= nbusy + 32) p4_transposes(F, nbusy, F.G - nbusy); else p4_transposes(F, 0, F.G); }
#if defined(REPEAT_PHASE) && REPEAT_PHASE == 6
        pg8::gemm_phase<EpiScaleBf16, pg8::StaticOrder, true, true>(F.lds + RING_OFF, g, S, E);
#endif
    } SEAM(6);
    if (IN(7)) { mem_attn_phase(F);
#if defined(REPEAT_PHASE) && REPEAT_PHASE == 7
        mem_attn_phase(F);
#endif
    } SEAM(7);
    if (IN(8)) {
        pg8::Gemm g{WSP(bf16, WS_OM), WSP(bf16, WS_WO), SEQ, DM, 512}; pg8::StaticOrder S; S.init(SEQ, DM, F.G, (int)blockIdx.x);
        EpiRes E{nullptr, WSP(bf16, WS_H1B), nullptr, WSP(bf16, WS_XB), sumsq3};
        pg8::gemm_phase<EpiRes, pg8::StaticOrder, true, true>(F.lds + RING_OFF, g, S, E);
#if defined(REPEAT_PHASE) && REPEAT_PHASE == 8
        { EpiRes E2{nullptr, WSP(bf16, WS_H1B), nullptr, nullptr, (float*)(F.ws + WS_CTL + 448 * 1024)}; pg8::gemm_phase<EpiRes, pg8::StaticOrder, true, true>(F.lds + RING_OFF, g, S, E2); }
#endif
    } SEAM(8);
    if (IN(9)) {
        pg8::Gemm g{WSP(bf16, WS_XB), WSP(bf16, WS_WGU), SEQ, 2 * DFF, DM}; pg8::StaticOrder S; S.init(SEQ, 2 * DFF, F.G, (int)blockIdx.x);
        EpiSwiglu E{sumsq3, WSP(bf16, WS_HID)};
        pg8::gemm_phase<EpiSwiglu, pg8::StaticOrder, true, true>(F.lds + RING_OFF, g, S, E);
#if defined(REPEAT_PHASE) && REPEAT_PHASE == 9
        pg8::gemm_phase<EpiSwiglu, pg8::StaticOrder, true, true>(F.lds + RING_OFF, g, S, E);
#endif
    } SEAM(9);
    if (IN(10)) {
        pg8::Gemm g{WSP(bf16, WS_HID), WSP(bf16, WS_WD), SEQ, DM, DFF}; pg8::StaticOrder S; S.init(SEQ, DM, F.G, (int)blockIdx.x);
        EpiRes E{nullptr, WSP(bf16, WS_XB), nullptr, WSP(bf16, WS_H3B), sumsq4};
        pg8::gemm_phase<EpiRes, pg8::StaticOrder, true, true>(F.lds + RING_OFF, g, S, E);
#if defined(REPEAT_PHASE) && REPEAT_PHASE == 10
        { EpiRes E2{nullptr, WSP(bf16, WS_XB), nullptr, nullptr, (float*)(F.ws + WS_CTL + 448 * 1024)}; pg8::gemm_phase<EpiRes, pg8::StaticOrder, true, true>(F.lds + RING_OFF, g, S, E2); }
#endif
    } SEAM(10);
#if defined(REPEAT_PHASE) && REPEAT_PHASE == 99
    for (int k_ = 0; k_ < 10; ++k_) xcd_barrier(bar);
#endif
    if (IN(11)) { final_norm(F);
#if defined(REPEAT_PHASE) && REPEAT_PHASE == 11
        final_norm(F);
#endif
    }
#undef IN
#undef SEAM
}

extern "C" void kernel_launch(void* const* d_in, const int* in_sizes, int n_in, void* d_out, int out_size, void* d_ws, size_t ws_size, hipStream_t stream) {
    static int grid = 0;
    if (grid == 0) {
        if (n_in != 23 || out_size != SEQ * DM || ws_size < WS_END) { fprintf(stderr, "kernel_launch: unexpected shapes (n_in %d out %d ws %zu)\n", n_in, out_size, ws_size); grid = -1; return; }
        int dev = 0, cus = 0;
        if (hipGetDevice(&dev) != hipSuccess || hipDeviceGetAttribute(&cus, hipDeviceAttributeMultiprocessorCount, dev) != hipSuccess) { grid = -1; return; }
        if (hipFuncSetAttribute((const void*)enc_fwd, hipFuncAttributeMaxDynamicSharedMemorySize, LDS_BYTES) != hipSuccess) { fprintf(stderr, "kernel_launch: hipFuncSetAttribute failed\n"); grid = -1; return; }
        (void)hipGetLastError();
        grid = cus;
    }
    if (grid < 0) return;
    if (hipMemsetAsync((char*)d_ws + WS_CTL, 0, CTL_ZERO_BYTES, stream) != hipSuccess) return;
    Args a{};
    for (int i = 0; i < 23; ++i) a.in[i] = (const float*)d_in[i];
    a.out = (float*)d_out; a.ws = (unsigned char*)d_ws;
    const int per = (N_PHASES + MK_N_LAUNCHES - 1) / MK_N_LAUNCHES;
    for (int lo = 0; lo < N_PHASES; lo += per) {
        a.ph_lo = lo; a.ph_hi = (lo + per < N_PHASES) ? lo + per : N_PHASES;
        hipLaunchKernelGGL(enc_fwd, dim3(grid), dim3(NWAVES * 64), LDS_BYTES, stream, a);
    }
}
```

```cpp
#include <hip/hip_runtime.h>
#include <cstdio>
#include <cstdint>
namespace pg8 {
__device__ __forceinline__ unsigned cvt_pk_bf16(float lo, float hi) { unsigned r; asm volatile("v_cvt_pk_bf16_f32 %0, %1, %2" : "=v"(r) : "v"(lo), "v"(hi)); return r; }
#define PG8_LAS __attribute__((address_space(3)))
typedef unsigned short bf16_t;
typedef short bf16x8 __attribute__((ext_vector_type(8)));
typedef float f32x4 __attribute__((ext_vector_type(4)));
typedef unsigned u32x4 __attribute__((ext_vector_type(4)));
constexpr int BM = 256, BK = 64, HALF = 128, HTB = HALF * BK * 2  , STAGE_BYTES = 8 * HTB, NXCD = 8, WGM = 8;

__host__ __device__ __forceinline__ int lds_byte(int r, int c) { const int st = (r >> 4) * 2 + (c >> 5), rr = r & 15, cc = c & 31, ob = rr * 64 + cc * 2; return st * 1024 + (ob ^ (((ob >> 9) & 1) << 5)); }
__host__ __device__ __forceinline__ void stage_rc(int b, int& R, int& C) { const int st = b / 1024, sb = b % 1024, swz = sb ^ (((sb >> 9) & 1) << 5); R = (st >> 1) * 16 + swz / 64; C = (st & 1) * 32 + (swz % 64) / 2; }
__host__ __device__ __forceinline__ int perm32(int rho) { const int n = rho >> 4, i = rho & 15; return 8 * (i >> 2) + 4 * n + (i & 3); }

struct Unit { int pm, pn; };
struct Gemm { const bf16_t* A; const bf16_t* Bt; int M, N, K; };

struct StaticOrder {
    int nM, nN, nwg, G, c;
    __host__ __device__ void init(int M, int N, int G_, int c_) { nM = M / BM; nN = N / BM; nwg = nM * nN; G = G_; c = c_; }
    __host__ __device__ bool next(int i, Unit& u) const {
        const long L = (long)i * G + c; if (L >= nwg) return false;
        int wgid = (int)L; { const int q = nwg / NXCD, r = nwg % NXCD, xcd = wgid % NXCD, off = wgid / NXCD; wgid = (xcd < r ? xcd * (q + 1) : r * (q + 1) + (xcd - r) * q) + off; }
        const int nig = WGM * nN, gid = wgid / nig, fm = gid * WGM, gsz = (nM - fm) < WGM ? (nM - fm) : WGM;
        u.pm = fm + ((wgid % nig) % gsz); u.pn = (wgid % nig) / gsz; return true;
    }
    __device__ __forceinline__ void a_ready(const Unit&) const {}
    __device__ __forceinline__ void done(const Unit&) const {}
};

template <class Epi, class Sched, bool ALIGN_EPI = false, bool SP2 = false>
__device__ __forceinline__ void gemm_phase(PG8_LAS unsigned char* lds, const Gemm g, const Sched& S, const Epi& E) {
    const int tid = threadIdx.x, wid = __builtin_amdgcn_readfirstlane(tid >> 6), lane = tid & 63, wr = wid >> 2, wc = wid & 3, fr = lane & 15, fq = lane >> 4;
    const int K = g.K, nt = K / BK;
    unsigned voffA[2], voffB[2];
#pragma unroll
    for (int i = 0; i < 2; ++i) { int R, C; stage_rc(tid * 16 + i * 8192, R, C); const int Rb = Epi::PERM ? ((R & ~31) + perm32(R & 31)) : R;
        voffA[i] = (unsigned)(R * K + C) * 2u; voffB[i] = (unsigned)(Rb * K + C) * 2u; }
    const size_t kstep = (size_t)(BK * 2);
    const size_t hstep = (size_t)HALF * K * 2;
    const size_t tstep = 2 * hstep;
    const unsigned ldsw = (unsigned)wid * 1024u;
    const int aoff = lds_byte(wr * 64 + fr, fq * 8), boff = lds_byte(wc * 32 + fr, fq * 8);
#define PG8_SA(b, h) (((b) * 2 + (h)) * HTB)
#define PG8_SB(b, h) ((4 + (b) * 2 + (h)) * HTB)
#define PG8_STAGE(bufoff, gbase, voff) do { _Pragma("unroll") for (int _i = 0; _i < 2; ++_i) \
        __builtin_amdgcn_global_load_lds((const unsigned*)((const char*)(gbase) + (voff)[_i]), (PG8_LAS unsigned*)(lds + (bufoff) + ldsw + _i * 8192), 16, 0, 0); } while (0)
#define PG8_LDA(dst, b, h) do { _Pragma("unroll") for (int m = 0; m < 4; ++m) _Pragma("unroll") for (int k = 0; k < 2; ++k) dst[m][k] = *(const PG8_LAS bf16x8*)(lds + PG8_SA(b, h) + aoff + m * 2048 + k * 1024); } while (0)
#define PG8_LDB(dst, b, h) do { _Pragma("unroll") for (int n = 0; n < 2; ++n) _Pragma("unroll") for (int k = 0; k < 2; ++k) dst[n][k] = *(const PG8_LAS bf16x8*)(lds + PG8_SB(b, h) + boff + n * 2048 + k * 1024); } while (0)
#define PG8_MMA(ai, bj, At, Bt) do { __builtin_amdgcn_s_setprio(1); _Pragma("unroll") for (int m = 0; m < 4; ++m) _Pragma("unroll") for (int n = 0; n < 2; ++n) _Pragma("unroll") for (int k = 0; k < 2; ++k) \
        acc[ai][bj][m][n] = __builtin_amdgcn_mfma_f32_16x16x32_bf16(Bt[n][k], At[m][k], acc[ai][bj][m][n], 0, 0, 0); __builtin_amdgcn_s_setprio(0); } while (0)
#define PG8_WAIT_V(n) asm volatile("s_waitcnt vmcnt(" #n ")" ::: "memory")
#define PG8_WAIT_L(n) asm volatile("s_waitcnt lgkmcnt(" #n ")" ::: "memory")
#define PG8_BAR __builtin_amdgcn_s_barrier()
#define PG8_SCHED __builtin_amdgcn_sched_barrier(0)
    Unit cur, nxt; int ui = 0;
    if (!S.next(0, cur)) return;
    f32x4 acc[2][2][4][2];
#pragma unroll
    for (int a = 0; a < 2; ++a)
#pragma unroll
        for (int b = 0; b < 2; ++b)
#pragma unroll
            for (int m = 0; m < 4; ++m)
#pragma unroll
                for (int n = 0; n < 2; ++n) acc[a][b][m][n] = (f32x4){0.f, 0.f, 0.f, 0.f};
    bf16x8 At[4][2], B0[2][2], B1[2][2];
    const char* cA = (const char*)g.A + (size_t)cur.pm * tstep; const char* cB = (const char*)g.Bt + (size_t)cur.pn * tstep;
    S.a_ready(cur);
    if constexpr (SP2) {
        PG8_STAGE(PG8_SB(0, 0), cB, voffB); PG8_STAGE(PG8_SB(0, 1), cB + hstep, voffB); PG8_STAGE(PG8_SA(0, 0), cA, voffA); PG8_STAGE(PG8_SA(0, 1), cA + hstep, voffA);
        if (wr == 1) PG8_BAR;
        PG8_WAIT_V(2); PG8_BAR;
        PG8_STAGE(PG8_SB(1, 0), cB + kstep, voffB); PG8_STAGE(PG8_SA(1, 0), cA + kstep, voffA); PG8_STAGE(PG8_SB(1, 1), cB + hstep + kstep, voffB);
        PG8_WAIT_V(6); PG8_BAR;
    } else {
        PG8_STAGE(PG8_SB(0, 0), cB, voffB); PG8_STAGE(PG8_SA(0, 0), cA, voffA); PG8_STAGE(PG8_SB(0, 1), cB + hstep, voffB); PG8_STAGE(PG8_SA(0, 1), cA + hstep, voffA);
        if (wr == 1) PG8_BAR;
        PG8_WAIT_V(4); PG8_BAR;
        PG8_STAGE(PG8_SB(1, 0), cB + kstep, voffB); PG8_STAGE(PG8_SA(1, 0), cA + kstep, voffA); PG8_STAGE(PG8_SB(1, 1), cB + hstep + kstep, voffB);
        PG8_WAIT_V(6); PG8_BAR;
    }
    for (;;) {
        const bool has_next = S.next(ui + 1, nxt);
        const char* nA = has_next ? (const char*)g.A + (size_t)nxt.pm * tstep : cA; const char* nB = has_next ? (const char*)g.Bt + (size_t)nxt.pn * tstep : cB;
        for (int t = 0; t < nt; t += 2) {
            const bool last = (t == nt - 2);
            const char* a1 = cA + (size_t)(t + 1) * kstep;
            const char* a2 = last ? nA : cA + (size_t)(t + 2) * kstep; const char* b2 = last ? nB : cB + (size_t)(t + 2) * kstep;
            const char* a3 = a2 + kstep; const char* b3 = b2 + kstep;
            if (last && has_next) S.a_ready(nxt);
            if constexpr (SP2) {
            PG8_LDB(B0, 0, 0); PG8_LDB(B1, 0, 1); PG8_SCHED; PG8_LDA(At, 0, 0); PG8_STAGE(PG8_SA(1, 1), a1 + hstep, voffA);
            PG8_WAIT_V(8); PG8_WAIT_L(0); PG8_BAR; PG8_MMA(0, 0, At, B0); PG8_MMA(0, 1, At, B1); PG8_BAR; PG8_SCHED;
            PG8_LDA(At, 0, 1); PG8_STAGE(PG8_SB(0, 0), b2, voffB); PG8_STAGE(PG8_SB(0, 1), b2 + hstep, voffB); PG8_STAGE(PG8_SA(0, 0), a2, voffA);
            PG8_WAIT_V(8); PG8_WAIT_L(0); PG8_BAR; PG8_MMA(1, 0, At, B0); PG8_MMA(1, 1, At, B1); PG8_BAR; PG8_SCHED;
            PG8_LDB(B0, 1, 0); PG8_LDB(B1, 1, 1); PG8_SCHED; PG8_LDA(At, 1, 0); PG8_STAGE(PG8_SA(0, 1), a2 + hstep, voffA);
            PG8_WAIT_V(8); PG8_WAIT_L(0); PG8_BAR; PG8_MMA(0, 0, At, B0); PG8_MMA(0, 1, At, B1); PG8_BAR; PG8_SCHED;
            PG8_LDA(At, 1, 1); PG8_STAGE(PG8_SB(1, 0), b3, voffB); PG8_STAGE(PG8_SB(1, 1), b3 + hstep, voffB); PG8_STAGE(PG8_SA(1, 0), a3, voffA);
            PG8_WAIT_V(8); PG8_WAIT_L(0); PG8_BAR; PG8_MMA(1, 0, At, B0); PG8_MMA(1, 1, At, B1); PG8_BAR; PG8_SCHED;
            } else {
            PG8_LDB(B0, 0, 0); PG8_SCHED; PG8_LDA(At, 0, 0); PG8_STAGE(PG8_SA(1, 1), a1 + hstep, voffA);
            PG8_WAIT_L(8); PG8_BAR; PG8_WAIT_L(0); PG8_MMA(0, 0, At, B0); PG8_BAR; PG8_SCHED;
            PG8_LDB(B1, 0, 1); PG8_STAGE(PG8_SB(0, 0), b2, voffB);
            PG8_BAR; PG8_WAIT_L(0); PG8_MMA(0, 1, At, B1); PG8_BAR;
            PG8_LDA(At, 0, 1); PG8_STAGE(PG8_SA(0, 0), a2, voffA);
            PG8_BAR; PG8_WAIT_L(0); PG8_MMA(1, 0, At, B0); PG8_BAR; PG8_SCHED;
            PG8_STAGE(PG8_SB(0, 1), b2 + hstep, voffB);
            PG8_WAIT_V(6); PG8_BAR; PG8_MMA(1, 1, At, B1); PG8_BAR;
            PG8_LDB(B0, 1, 0); PG8_SCHED; PG8_LDA(At, 1, 0); PG8_STAGE(PG8_SA(0, 1), a2 + hstep, voffA);
            PG8_WAIT_L(8); PG8_BAR; PG8_WAIT_L(0); PG8_MMA(0, 0, At, B0); PG8_BAR; PG8_SCHED;
            PG8_LDB(B1, 1, 1); PG8_STAGE(PG8_SB(1, 0), b3, voffB);
            PG8_BAR; PG8_WAIT_L(0); PG8_MMA(0, 1, At, B1); PG8_BAR;
            PG8_LDA(At, 1, 1); PG8_STAGE(PG8_SA(1, 0), a3, voffA);
            PG8_BAR; PG8_WAIT_L(0); PG8_MMA(1, 0, At, B0); PG8_BAR; PG8_SCHED;
            PG8_STAGE(PG8_SB(1, 1), b3 + hstep, voffB);
            PG8_WAIT_V(6); PG8_BAR; PG8_MMA(1, 1, At, B1); PG8_BAR;
            }
        }
        if constexpr (ALIGN_EPI) { if (wr == 0) PG8_BAR; }
        if constexpr (!Epi::AFTER_DRAIN) { E(acc, cur, wr, wc, fr, fq); S.done(cur); }
        if (!has_next) break;
#pragma unroll
        for (int a = 0; a < 2; ++a)
#pragma unroll
            for (int b = 0; b < 2; ++b)
#pragma unroll
                for (int m = 0; m < 4; ++m)
#pragma unroll
                    for (int n = 0; n < 2; ++n) acc[a][b][m][n] = (f32x4){0.f, 0.f, 0.f, 0.f};
        cur = nxt; cA = nA; cB = nB; ++ui;
        if constexpr (ALIGN_EPI) { if (wr == 1) PG8_BAR; }
    }
    PG8_WAIT_V(0);
    if constexpr (!ALIGN_EPI) { if (wr == 0) PG8_BAR; }
    PG8_BAR;
    if constexpr (Epi::AFTER_DRAIN) { E.fused(acc, cur, wr, wc, fr, fq, lds, wid, lane); S.done(cur); }
#undef PG8_SA
#undef PG8_SB
#undef PG8_STAGE
#undef PG8_LDA
#undef PG8_LDB
#undef PG8_MMA
#undef PG8_WAIT_V
#undef PG8_WAIT_L
#undef PG8_BAR
#undef PG8_SCHED
}
}

constexpr int NWAVES = 8;
constexpr int SEQ = 16384, DM = 2048, NIN = 5664, NINP = 5888, DFF = 5632;
constexpr int DNH = 8, HD = 128, SWH = 8, MEMH = 4, MEMT = 256;
constexpr float RMS_EPS = 1e-6f;
constexpr float LOG2E = 1.4426950408889634f;
constexpr float QSCALE = 0.08838834764831845f * 1.4426950408889634f;

constexpr size_t MiB = 1u << 20;
constexpr size_t WS_CTL = 0, CTL_ZERO_BYTES = 1 * MiB;
constexpr size_t CTL_SUMSQ2 = 256 * 1024, CTL_SUMSQ3 = 320 * 1024, CTL_SUMSQ4 = 384 * 1024;
constexpr size_t WS_RSTD1 = 1 * MiB, WS_RSTDM = 1 * MiB + 64 * 1024;
constexpr size_t WS_MEMB = 2 * MiB, WS_KVM = 3 * MiB, WS_AB = 4 * MiB, WS_BG = 6 * MiB;
constexpr size_t WS_WOUT = 8 * MiB, WS_WQ = 16 * MiB, WS_WKV = 18 * MiB, WS_WO = 22 * MiB, WS_WIN = 24 * MiB;
constexpr size_t WS_XB = 48 * MiB;
constexpr size_t WS_QKV = 112 * MiB;
constexpr size_t WS_H3B = 112 * MiB;
constexpr size_t WS_OF = 112 * MiB, WS_OB = 144 * MiB, WS_H1B = 112 * MiB, WS_QM = 176 * MiB, WS_OM = 192 * MiB;
constexpr size_t WS_DNX = 208 * MiB;
constexpr size_t WS_WGU = 208 * MiB, WS_WD = 252 * MiB, WS_HID = 274 * MiB, WS_END = 496 * MiB;
constexpr size_t DO_Z = 0, DO_QSW = 32 * MiB, DO_KVSW = 64 * MiB;
constexpr int CW_BAR = 4096, CW_SWAQ = 8192, CW_FOLDDONE = 8256, CW_TRQ = 8320;

constexpr int RING_OFF = 0, RING_BYTES = 131072;
constexpr int LDS_BYTES = 163840;
constexpr int LDSCTL_OFF = LDS_BYTES - 512, MISC_OFF = LDSCTL_OFF + 320;

#define GAS __attribute__((address_space(1)))
#define LAS __attribute__((address_space(3)))
typedef unsigned short bf16;
typedef unsigned v4u __attribute__((ext_vector_type(4)));
typedef unsigned v2u __attribute__((ext_vector_type(2)));
typedef float f32x4 __attribute__((ext_vector_type(4)));
typedef short bf16x8 __attribute__((ext_vector_type(8)));
typedef short s16x4 __attribute__((ext_vector_type(4)));
typedef GAS unsigned gu32;
#define RLX_AGENT __ATOMIC_RELAXED, __HIP_MEMORY_SCOPE_AGENT
#define LDS_WAIT() asm volatile("s_waitcnt lgkmcnt(0)" ::: "memory")
#define VM_WAIT() asm volatile("s_waitcnt vmcnt(0)" ::: "memory")
__device__ __forceinline__ unsigned f2bf(float f) { unsigned u = __builtin_bit_cast(unsigned, f); return (u + 0x7fffu + ((u >> 16) & 1u)) >> 16; }
__device__ __forceinline__ unsigned pk2(float lo, float hi) { return f2bf(lo) | (f2bf(hi) << 16); }
__device__ __forceinline__ float bf2f(unsigned short b) { return __builtin_bit_cast(float, (unsigned)b << 16); }
__device__ __forceinline__ float bflo(unsigned w) { return __builtin_bit_cast(float, w << 16); }
__device__ __forceinline__ float bfhi(unsigned w) { return __builtin_bit_cast(float, w & 0xffff0000u); }
typedef float f32x2_t __attribute__((ext_vector_type(2))); typedef __bf16 bf16x2_t __attribute__((ext_vector_type(2)));
__device__ __forceinline__ unsigned cvtpk(float lo, float hi) { f32x2_t v = {lo, hi}; bf16x2_t b = __builtin_convertvector(v, bf16x2_t); return __builtin_bit_cast(unsigned, b); }
__device__ __forceinline__ float wave_sum(float v) {
#pragma unroll
    for (int o = 1; o < 64; o <<= 1) v += __shfl_xor(v, o);
    return v;
}
__device__ __forceinline__ float siluf(float x) { return x * __builtin_amdgcn_rcpf(1.0f + __expf(-x)); }
#define XB_TMO      128
#define XB_XCNT(j)  (256  + 64 * (j))
#define XB_XSUB(j)  (1280 + 64 * (j))
#define XB_XGEN(j)  (2304 + 64 * (j))
#define XB_TOP      3328
#define XB_TOPGEN   3392
#define XCD_BAR_WORDS 3456
#define XB_SPIN_CAP (1u << 18)

__device__ __forceinline__ unsigned xb_ld(unsigned* p)              { return __hip_atomic_load(p, __ATOMIC_RELAXED, __HIP_MEMORY_SCOPE_AGENT); }
__device__ __forceinline__ unsigned xb_add(unsigned* p, unsigned v) { return __hip_atomic_fetch_add(p, v, __ATOMIC_RELAXED, __HIP_MEMORY_SCOPE_AGENT); }
__device__ __forceinline__ unsigned xb_xcc_id() { return (unsigned)__builtin_amdgcn_s_getreg((3 << 11) | 20) & 0xFu; }
#define XB_SPIN(cond, bar) do { unsigned _sp = 0; while (cond) { __builtin_amdgcn_s_sleep(1); \
    if ((++_sp & 255u) == 0u) { if (xb_ld(&(bar)[XB_TMO])) break; if (_sp > XB_SPIN_CAP) { atomicAdd(&(bar)[XB_TMO], 1u); break; } } } } while (0)

struct XcdBarrier {
    unsigned* bar; unsigned x;
    volatile LAS unsigned* st;
};

__device__ __forceinline__ XcdBarrier xcd_barrier_post(unsigned* bar, volatile LAS unsigned* st) {
    XcdBarrier b; b.bar = bar; b.x = xb_xcc_id(); b.st = st;
    if (threadIdx.x == 0) (void)xb_add(&bar[XB_XCNT(b.x)], 1u);
    return b;
}
__device__ __forceinline__ void xcd_barrier_complete(unsigned* bar, unsigned x, unsigned& nloc, unsigned& nx) {
    const unsigned G = gridDim.x * gridDim.y * gridDim.z;
    unsigned sum, cnt, mine, sp = 0u;
    for (;;) {
        sum = 0u; cnt = 0u; mine = 0u;
#pragma unroll
        for (unsigned j = 0; j < 16; ++j) { const unsigned c = xb_ld(&bar[XB_XCNT(j)]); sum += c; cnt += (c > 0u) ? 1u : 0u; mine = (j == x) ? c : mine; }
        if (sum == G) break;
        __builtin_amdgcn_s_sleep(1);
        if ((++sp & 255u) == 0u) { if (xb_ld(&bar[XB_TMO])) break; if (sp > XB_SPIN_CAP) { atomicAdd(&bar[XB_TMO], 1u); break; } }
    }
    nloc = mine > 0u ? mine : 1u; nx = cnt > 0u ? cnt : 1u;
}

__device__ __forceinline__ void xcd_barrier(const XcdBarrier& b) {
    asm volatile("s_waitcnt vmcnt(0)" ::: "memory");
    __syncthreads();
    if (threadIdx.x == 0) {
        unsigned* bar = b.bar;
        __builtin_amdgcn_s_waitcnt(0);
        unsigned nloc = b.st[0], nx = b.st[1];
        if (nloc == 0u) { xcd_barrier_complete(bar, b.x, nloc, nx); b.st[0] = nloc; b.st[1] = nx; }
        const unsigned old = xb_add(&bar[XB_XSUB(b.x)], 1u);
        const unsigned gen = old / nloc;
        if (old + 1u == (gen + 1u) * nloc) {
            __builtin_amdgcn_fence(__ATOMIC_RELEASE, "agent");
            asm volatile("s_waitcnt vmcnt(0)" ::: "memory");
            const unsigned og = xb_add(&bar[XB_TOP], 1u);
            const unsigned tg = og / nx;
            if (og + 1u == (tg + 1u) * nx) xb_add(&bar[XB_TOPGEN], 1u);
            else XB_SPIN(xb_ld(&bar[XB_TOPGEN]) == tg, bar);
            __builtin_amdgcn_fence(__ATOMIC_ACQUIRE, "agent");
            xb_add(&bar[XB_XGEN(b.x)], 1u);
            asm volatile("s_waitcnt vmcnt(0)" ::: "memory");
        } else {
            XB_SPIN(xb_ld(&bar[XB_XGEN(b.x)]) == gen, bar);
            __builtin_amdgcn_fence(__ATOMIC_ACQUIRE, "agent");
            asm volatile("s_waitcnt vmcnt(0)" ::: "memory");
        }
    }
    __syncthreads();
}

using pg8::Unit;
__device__ __forceinline__ v4u pack8(f32x4 v0, f32x4 v1) { v4u w; w.x = cvtpk(v0[0], v0[1]); w.y = cvtpk(v0[2], v0[3]); w.z = cvtpk(v1[0], v1[1]); w.w = cvtpk(v1[2], v1[3]); return w; }

struct EpiProj {
    static constexpr bool PERM = true, AFTER_DRAIN = false;
    const float* rstd; bf16* qkv; bf16* z; bf16* qsw; bf16* kvsw; float* ab;
    __device__ __forceinline__ void operator()(const f32x4 (&acc)[2][2][4][2], const Unit& u, int wr, int wc, int fr, int fq) const {
        const int pn = u.pn; bf16* base; int ldc, colt; float sc = 1.f;
        if (pn < 12) { base = qkv; ldc = 3072; colt = pn * 256; }
        else if (pn < 16) { base = z; ldc = 1024; colt = (pn - 12) * 256; }
        else if (pn < 20) { base = qsw; ldc = 1024; colt = (pn - 16) * 256; sc = QSCALE; }
        else if (pn < 22) { base = kvsw; ldc = 512; colt = (pn - 20) * 256; }
        else { base = nullptr; ldc = 0; colt = 0; }
        const int row0 = u.pm * 256 + wr * 64 + fr, col0 = colt + wc * 32 + 8 * fq;
        float rsv[2][4];
#pragma unroll
        for (int ai = 0; ai < 2; ++ai)
#pragma unroll
            for (int m = 0; m < 4; ++m) rsv[ai][m] = rstd[row0 + ai * 128 + m * 16];
#pragma unroll
        for (int ai = 0; ai < 2; ++ai)
#pragma unroll
            for (int m = 0; m < 4; ++m) {
                const int row = row0 + ai * 128 + m * 16; const float rs = rsv[ai][m] * sc;
                if (base) {
                    bf16* rowp = base + (size_t)row * ldc + col0;
#pragma unroll
                    for (int bj = 0; bj < 2; ++bj) *(v4u*)(rowp + bj * 128) = pack8(acc[ai][bj][m][0] * rs, acc[ai][bj][m][1] * rs);
                } else if (wc == 0) {
                    float* rowp = ab + (size_t)row * 32 + 8 * fq;
                    *(f32x4*)(rowp) = acc[ai][0][m][0] * rs; *(f32x4*)(rowp + 4) = acc[ai][0][m][1] * rs;
                }
            }
    }
};
struct EpiScaleBf16 {
    static constexpr bool PERM = true, AFTER_DRAIN = false;
    const float* rs; int from_sumsq; float sc; bf16* O; int ldc;
    __device__ __forceinline__ void operator()(const f32x4 (&acc)[2][2][4][2], const Unit& u, int wr, int wc, int fr, int fq) const {
        const int row0 = u.pm * 256 + wr * 64 + fr, col0 = u.pn * 256 + wc * 32 + 8 * fq;
        float rsv[2][4];
#pragma unroll
        for (int ai = 0; ai < 2; ++ai)
#pragma unroll
            for (int m = 0; m < 4; ++m) rsv[ai][m] = rs[row0 + ai * 128 + m * 16];
#pragma unroll
        for (int ai = 0; ai < 2; ++ai)
#pragma unroll
            for (int m = 0; m < 4; ++m) {
                const int row = row0 + ai * 128 + m * 16; float r = rsv[ai][m];
                if (from_sumsq) r = __builtin_amdgcn_rsqf(r * (1.0f / DM) + RMS_EPS);
                r *= sc; bf16* rowp = O + (size_t)row * ldc + col0;
#pragma unroll
                for (int bj = 0; bj < 2; ++bj) *(v4u*)(rowp + bj * 128) = pack8(acc[ai][bj][m][0] * r, acc[ai][bj][m][1] * r);
            }
    }
};
struct EpiRes {
    static constexpr bool PERM = true, AFTER_DRAIN = false;
    const float* res; const bf16* resb; float* out; bf16* ob; float* sumsq; LAS float* part;
    __device__ __forceinline__ void tail(const f32x4 (&acc)[2][2][4][2], const f32x4 (&rr)[4][2][2], int ai, int row0, int col0, int fq, int prow0, int wc) const {
#pragma unroll
        for (int m = 0; m < 4; ++m) {
            const int row = row0 + ai * 128 + m * 16; const size_t off = (size_t)row * DM + col0; float ss = 0.f;
#pragma unroll
            for (int bj = 0; bj < 2; ++bj) {
                const f32x4 v0 = acc[ai][bj][m][0] + rr[m][bj][0], v1 = acc[ai][bj][m][1] + rr[m][bj][1];
                if (out) { *(f32x4*)(out + off + bj * 128) = v0; *(f32x4*)(out + off + bj * 128 + 4) = v1; }
                if (ob) *(v4u*)(ob + off + bj * 128) = pack8(v0, v1);
                ss += (v0[0] * v0[0] + v0[1] * v0[1]) + (v0[2] * v0[2] + v0[3] * v0[3]) + (v1[0] * v1[0] + v1[1] * v1[1]) + (v1[2] * v1[2] + v1[3] * v1[3]);
            }
            ss += __shfl_xor(ss, 16); ss += __shfl_xor(ss, 32);
            if (fq == 0) part[(prow0 + ai * 128 + m * 16) * 4 + wc] = ss;
        }
    }
    __device__ __forceinline__ void finish(const Unit& u) const {
        asm volatile("s_waitcnt lgkmcnt(0)" ::: "memory"); __builtin_amdgcn_s_barrier(); asm volatile("" ::: "memory");
        const int tid = threadIdx.x, lane = tid & 63, w = tid >> 6;
        if (lane < 32) { const int r = 32 * w + lane; const f32x4 v = *(const LAS f32x4*)(part + r * 4); atomicAdd(sumsq + u.pm * 256 + r, (v[0] + v[1]) + (v[2] + v[3])); }
        asm volatile("s_waitcnt lgkmcnt(0)" ::: "memory"); __builtin_amdgcn_s_barrier(); asm volatile("" ::: "memory");
    }
    __device__ __forceinline__ void operator()(const f32x4 (&acc)[2][2][4][2], const Unit& u, int wr, int wc, int fr, int fq) const {
        const int row0 = u.pm * 256 + wr * 64 + fr, col0 = u.pn * 256 + wc * 32 + 8 * fq, prow0 = wr * 64 + fr;
        if (resb) {
#pragma unroll
            for (int ai = 0; ai < 2; ++ai) {
                v4u rb[4][2]; f32x4 rr[4][2][2];
#pragma unroll
                for (int m = 0; m < 4; ++m) { const size_t off = (size_t)(row0 + ai * 128 + m * 16) * DM + col0;
#pragma unroll
                    for (int bj = 0; bj < 2; ++bj) rb[m][bj] = *(const v4u*)(resb + off + bj * 128); }
                asm volatile("" ::: "memory");
#pragma unroll
                for (int m = 0; m < 4; ++m)
#pragma unroll
                    for (int bj = 0; bj < 2; ++bj) { const v4u w = rb[m][bj]; rr[m][bj][0] = (f32x4){bflo(w.x), bfhi(w.x), bflo(w.y), bfhi(w.y)}; rr[m][bj][1] = (f32x4){bflo(w.z), bfhi(w.z), bflo(w.w), bfhi(w.w)}; }
                tail(acc, rr, ai, row0, col0, fq, prow0, wc);
                asm volatile("" ::: "memory");
            }
        } else {
#pragma unroll
            for (int ai = 0; ai < 2; ++ai) {
                f32x4 rr[4][2][2];
#pragma unroll
                for (int m = 0; m < 4; ++m) { const size_t off = (size_t)(row0 + ai * 128 + m * 16) * DM + col0;
#pragma unroll
                    for (int bj = 0; bj < 2; ++bj) { rr[m][bj][0] = *(const f32x4*)(res + off + bj * 128); rr[m][bj][1] = *(const f32x4*)(res + off + bj * 128 + 4); } }
                asm volatile("" ::: "memory");
                tail(acc, rr, ai, row0, col0, fq, prow0, wc);
                asm volatile("" ::: "memory");
            }
        }
        finish(u);
    }
};
struct EpiSwiglu {
    static constexpr bool PERM = true, AFTER_DRAIN = false;
    const float* sumsq; bf16* H;
    __device__ __forceinline__ void operator()(const f32x4 (&acc)[2][2][4][2], const Unit& u, int wr, int wc, int fr, int fq) const {
        const int row0 = u.pm * 256 + wr * 64 + fr, col0 = u.pn * 128 + wc * 32 + 8 * fq;
        float rsv[2][4];
#pragma unroll
        for (int ai = 0; ai < 2; ++ai)
#pragma unroll
            for (int m = 0; m < 4; ++m) rsv[ai][m] = sumsq[row0 + ai * 128 + m * 16];
#pragma unroll
        for (int ai = 0; ai < 2; ++ai)
#pragma unroll
            for (int m = 0; m < 4; ++m) {
                const int row = row0 + ai * 128 + m * 16; const float r = __builtin_amdgcn_rsqf(rsv[ai][m] * (1.0f / DM) + RMS_EPS);
                f32x4 h[2];
#pragma unroll
                for (int n = 0; n < 2; ++n)
#pragma unroll
                    for (int e = 0; e < 4; ++e) { const float g = acc[ai][0][m][n][e] * r, up = acc[ai][1][m][n][e] * r; h[n][e] = siluf(g) * up; }
                *(v4u*)(H + (size_t)row * DFF + col0) = pack8(h[0], h[1]);
            }
    }
};

struct Frame {
    LAS unsigned char* lds;
    volatile LAS unsigned* MISC;
    gu32* ctl;
    int tid, lane, wave, vcu, G;
    const float* in[23]; float* out; unsigned char* ws;
};
#define WSP(T, off) ((T*)(F.ws + (off)))
#define DOP(T, off) ((T*)((unsigned char*)F.out + (off)))

struct TrDesc { const float* W; const float* gain; bf16* WT; int K, Nsrc, src_col0, dst_row0, k0; };
constexpr int TR_SCR = 8704, TR_WAVE = 2 * TR_SCR;
__device__ __forceinline__ void tr_store(const TrDesc& D, const LAS float* scr, int lane) {
    const int c = lane & 7;
#pragma unroll
    for (int j = 0; j < 4; ++j) { const int n = (lane >> 3) + 8 * j; const LAS float* s = scr + (8 * c) * 33 + n;
        v4u o; o.x = pk2(s[0 * 33], s[1 * 33]); o.y = pk2(s[2 * 33], s[3 * 33]); o.z = pk2(s[4 * 33], s[5 * 33]); o.w = pk2(s[6 * 33], s[7 * 33]);
        *(GAS v4u*)(D.WT + (size_t)(D.dst_row0 + n) * D.K + D.k0 + 8 * c) = o; }
}
__device__ __forceinline__ void tr_pair(const TrDesc& A, const TrDesc& B, bool hasB, LAS float* scr, int lane) {
    const bool second = lane >= 32; const TrDesc& D = second ? B : A;
    const bool live = (!second || hasB) && D.src_col0 >= 0;
    LAS float* s = second ? (LAS float*)((LAS unsigned char*)scr + TR_SCR) : scr;
    const float* src = D.W + (size_t)D.k0 * D.Nsrc + (live ? D.src_col0 : 0) + (lane & 31);
    float v[64];
#pragma unroll
    for (int i = 0; i < 64; ++i) v[i] = live ? src[(size_t)i * D.Nsrc] : 0.f;
    if (D.gain) {
#pragma unroll
        for (int i = 0; i < 64; ++i) v[i] *= D.gain[D.k0 + i]; }
#pragma unroll
    for (int i = 0; i < 64; ++i) s[i * 33 + (lane & 31)] = v[i];
    LDS_WAIT(); asm volatile("" ::: "memory");
    tr_store(A, scr, lane); if (hasB) tr_store(B, (const LAS float*)((const LAS unsigned char*)scr + TR_SCR), lane);
    LDS_WAIT(); asm volatile("" ::: "memory");
}
__device__ __forceinline__ int win_src_col(int c) {
    if (c < 4096) return c;
    if (c < 5120) return c - 4096 + 4128;
    if (c < 5376) return c - 5120 + 5152;
    if (c < 5632) return c - 5376 + 5408;
    if (c < 5664) return c - 5632 + 4096;
    return -1;
}
__device__ __forceinline__ void row_to_bf16_rstd(const float* xrow, bf16* orow, float* rstd_out, int lane) {
    const GAS f32x4* xr = (const GAS f32x4*)xrow + lane;
    f32x4 v[8]; float s = 0.f;
#pragma unroll
    for (int j = 0; j < 8; ++j) { v[j] = xr[64 * j]; s += (v[j].x * v[j].x + v[j].y * v[j].y) + (v[j].z * v[j].z + v[j].w * v[j].w); }
    s = wave_sum(s);
    if (lane == 0) *rstd_out = 1.0f / sqrtf(s * (1.0f / DM) + RMS_EPS);
    GAS v2u* o8 = (GAS v2u*)orow + lane;
#pragma unroll
    for (int j = 0; j < 8; ++j) { v2u w; w.x = pk2(v[j].x, v[j].y); w.y = pk2(v[j].z, v[j].w); o8[64 * j] = w; }
}

__device__ __forceinline__ void p0_prologue(Frame& F) {
    LAS float* scr = (LAS float*)(F.lds + RING_OFF + F.wave * TR_WAVE);
    const int gw = F.vcu * NWAVES + F.wave, NGW = F.G * NWAVES;
    constexpr int I_IN = 32 * (NINP / 32), I_KV = 32 * 32;
    auto desc0 = [&](int r) { TrDesc D;
        if (r < I_IN) { const int nblk = NINP / 32, kb = r / nblk, nb = r % nblk; D = TrDesc{F.in[3], F.in[2], WSP(bf16, WS_WIN), DM, NIN, win_src_col(nb * 32), nb * 32, kb * 64}; }
        else { r -= I_IN; const int kb = r / 32, nb = r % 32; D = TrDesc{F.in[16], F.in[14], WSP(bf16, WS_WKV), DM, 1024, nb * 32, nb * 32, kb * 64}; }
        return D; };
    for (int it = 2 * gw; it < I_IN + I_KV; it += 2 * NGW) tr_pair(desc0(it), desc0(it + 1), true, scr, F.lane);
    for (int m = gw; m < SEQ; m += 2 * NGW) {
        const int m2 = m + NGW; const bool two = m2 < SEQ;
        const GAS f32x4* xa = (const GAS f32x4*)(F.in[0] + (size_t)m * DM) + F.lane; const GAS f32x4* xb_ = (const GAS f32x4*)(F.in[0] + (size_t)(two ? m2 : m) * DM) + F.lane;
        f32x4 va[8], vb[8]; float sa = 0.f, sb = 0.f;
#pragma unroll
        for (int j = 0; j < 8; ++j) { va[j] = xa[64 * j]; vb[j] = xb_[64 * j]; }
#pragma unroll
        for (int j = 0; j < 8; ++j) { sa += (va[j].x * va[j].x + va[j].y * va[j].y) + (va[j].z * va[j].z + va[j].w * va[j].w); sb += (vb[j].x * vb[j].x + vb[j].y * vb[j].y) + (vb[j].z * vb[j].z + vb[j].w * vb[j].w); }
        sa = wave_sum(sa); sb = wave_sum(sb);
        if (F.lane == 0) { WSP(float, WS_RSTD1)[m] = 1.0f / sqrtf(sa * (1.0f / DM) + RMS_EPS); if (two) WSP(float, WS_RSTD1)[m2] = 1.0f / sqrtf(sb * (1.0f / DM) + RMS_EPS); }
        GAS v2u* oa = (GAS v2u*)(WSP(bf16, WS_XB) + (size_t)m * DM) + F.lane; GAS v2u* ob = (GAS v2u*)(WSP(bf16, WS_XB) + (size_t)m2 * DM) + F.lane;
#pragma unroll
        for (int j = 0; j < 8; ++j) { v2u w; w.x = pk2(va[j].x, va[j].y); w.y = pk2(va[j].z, va[j].w); oa[64 * j] = w; }
        if (two) {
#pragma unroll
            for (int j = 0; j < 8; ++j) { v2u w; w.x = pk2(vb[j].x, vb[j].y); w.y = pk2(vb[j].z, vb[j].w); ob[64 * j] = w; } }
    }
    for (int m = gw; m < MEMT; m += NGW) row_to_bf16_rstd(F.in[1] + (size_t)m * DM, WSP(bf16, WS_MEMB) + (size_t)m * DM, WSP(float, WS_RSTDM) + m, F.lane);
}
__device__ __forceinline__ void p1_late_transposes(Frame& F, int b0, int nb) {
    if ((int)blockIdx.x < b0 || (int)blockIdx.x >= b0 + nb) return;
    LAS float* scr = (LAS float*)(F.lds + RING_OFF + F.wave * TR_WAVE);
    const int gw = ((int)blockIdx.x - b0) * NWAVES + F.wave, NGW = nb * NWAVES;
    constexpr int I_OUT = 32 * 64, I_Q = 32 * 16, I_O = 8 * 64;
    auto desc1 = [&](int r) { TrDesc D;
        if (r < I_OUT) { const int kb = r / 64, nb2 = r % 64; D = TrDesc{F.in[12], nullptr, WSP(bf16, WS_WOUT), DM, DM, nb2 * 32, nb2 * 32, kb * 64}; }
        else if (r < I_OUT + I_Q) { r -= I_OUT; const int kb = r / 16, nb2 = r % 16; D = TrDesc{F.in[15], F.in[13], WSP(bf16, WS_WQ), DM, 512, nb2 * 32, nb2 * 32, kb * 64}; }
        else { r -= I_OUT + I_Q; const int kb = r / 64, nb2 = r % 64; D = TrDesc{F.in[17], nullptr, WSP(bf16, WS_WO), 512, DM, nb2 * 32, nb2 * 32, kb * 64}; }
        return D; };
    for (int it = 2 * gw; it < I_OUT + I_Q + I_O; it += 2 * NGW) tr_pair(desc1(it), desc1(it + 1), true, scr, F.lane);
}
__device__ __forceinline__ void p4_transposes(Frame& F, int b0, int nb) {
    (void)b0; (void)nb;
    LAS float* scr = (LAS float*)(F.lds + RING_OFF + F.wave * TR_WAVE);
    constexpr int I_GU = 32 * (2 * DFF / 32), I_D = (DFF / 64) * 64, BATCH = 8 * NWAVES;
    unsigned* qctr = (unsigned*)(F.ctl + CW_TRQ);
    for (;;) {
        __syncthreads();
        if (F.tid == 0) F.MISC[13] = __hip_atomic_fetch_add(qctr, 1u, __ATOMIC_RELAXED, __HIP_MEMORY_SCOPE_AGENT);
        __syncthreads();
        const int base = (int)F.MISC[13] * BATCH;
        if (base >= I_GU + I_D) break;
        auto desc2 = [&](int r) { TrDesc D;
            if (r < I_GU) { const int nblk = 2 * DFF / 32, kb = r / nblk, nb2 = r % nblk; const int row = nb2 * 32, t = row / 256, w = row % 256;
                D = TrDesc{(w < 128) ? F.in[19] : F.in[20], F.in[18], WSP(bf16, WS_WGU), DM, DFF, 128 * t + (w & 127), row, kb * 64}; }
            else { r -= I_GU; const int kb = r / 64, nb2 = r % 64; D = TrDesc{F.in[21], nullptr, WSP(bf16, WS_WD), DFF, DM, nb2 * 32, nb2 * 32, kb * 64}; }
            return D; };
        for (int k = 0; k < 4; ++k) {
            const int it = base + 2 * (k * NWAVES + F.wave); if (it >= I_GU + I_D) break;
            tr_pair(desc2(it), desc2(it + 1), true, scr, F.lane); }
    }
}

__device__ __forceinline__ float softplusf(float x) { return x > 20.f ? x : log1pf(__expf(x)); }
__device__ __forceinline__ void dn_combine(Frame& F) {
    const int gw = F.vcu * NWAVES + F.wave, NGW = F.G * NWAVES, lane = F.lane;
    const bf16* OFp = WSP(bf16, WS_OF); const bf16* OBp = WSP(bf16, WS_OB); const bf16* Z = DOP(bf16, DO_Z); bf16* Y = WSP(bf16, WS_XB); const float* gn = F.in[9];
    const int cb = (16 * lane) & 127; float gv[16];
#pragma unroll
    for (int i = 0; i < 16; ++i) gv[i] = gn[cb + i];
    for (int t0 = gw; t0 < SEQ; t0 += 2 * NGW) {
        v4u a[2][2], b[2][2], z[2][2];
#pragma unroll
        for (int k = 0; k < 2; ++k) { const int t = (t0 + k * NGW < SEQ) ? t0 + k * NGW : t0; const size_t off = (size_t)t * 1024 + 16 * lane;
            a[k][0] = *(const v4u*)(OFp + off); a[k][1] = *(const v4u*)(OFp + off + 8); b[k][0] = *(const v4u*)(OBp + off); b[k][1] = *(const v4u*)(OBp + off + 8);
            z[k][0] = *(const v4u*)(Z + off); z[k][1] = *(const v4u*)(Z + off + 8); }
#pragma unroll
        for (int k = 0; k < 2; ++k) {
            const int t = t0 + k * NGW; if (t >= SEQ) break;
            float o[16], zz[16];
#pragma unroll
            for (int i = 0; i < 4; ++i) { o[2 * i] = bflo(a[k][0][i]) + bflo(b[k][0][i]); o[2 * i + 1] = bfhi(a[k][0][i]) + bfhi(b[k][0][i]); o[8 + 2 * i] = bflo(a[k][1][i]) + bflo(b[k][1][i]); o[8 + 2 * i + 1] = bfhi(a[k][1][i]) + bfhi(b[k][1][i]);
                zz[2 * i] = bflo(z[k][0][i]); zz[2 * i + 1] = bfhi(z[k][0][i]); zz[8 + 2 * i] = bflo(z[k][1][i]); zz[8 + 2 * i + 1] = bfhi(z[k][1][i]); }
            float ss = 0.f;
#pragma unroll
            for (int i = 0; i < 16; ++i) ss += o[i] * o[i];
            ss += __shfl_xor(ss, 1); ss += __shfl_xor(ss, 2); ss += __shfl_xor(ss, 4);
            const float rs = __builtin_amdgcn_rsqf(ss * (1.0f / 128.0f) + RMS_EPS);
            float y[16];
#pragma unroll
            for (int i = 0; i < 16; ++i) y[i] = o[i] * rs * gv[i] * siluf(zz[i]);
            v4u w0, w1;
#pragma unroll
            for (int i = 0; i < 4; ++i) { w0[i] = pk2(y[2 * i], y[2 * i + 1]); w1[i] = pk2(y[8 + 2 * i], y[8 + 2 * i + 1]); }
            bf16* yp = Y + (size_t)t * DM + 16 * lane; *(v4u*)yp = w0; *(v4u*)(yp + 8) = w1;
        }
    }
}
__device__ __forceinline__ void final_norm(Frame& F) {
    const int gw = F.vcu * NWAVES + F.wave, NGW = F.G * NWAVES, lane = F.lane;
    const float* ss = (const float*)(F.ws + WS_CTL + CTL_SUMSQ4); const GAS f32x4* g = (const GAS f32x4*)F.in[22]; const bf16* H3 = WSP(bf16, WS_H3B);
    for (int m0 = gw; m0 < SEQ; m0 += 2 * NGW) {
        v4u w[2][4]; float r[2];
#pragma unroll
        for (int k = 0; k < 2; ++k) { const int m = (m0 + k * NGW < SEQ) ? m0 + k * NGW : m0; const GAS v4u* hp = (const GAS v4u*)(H3 + (size_t)m * DM);
            r[k] = ss[m];
#pragma unroll
            for (int j = 0; j < 4; ++j) w[k][j] = hp[64 * j + lane]; }
#pragma unroll
        for (int k = 0; k < 2; ++k) {
            const int m = m0 + k * NGW; if (m >= SEQ) break;
            const float rr = __builtin_amdgcn_rsqf(r[k] * (1.0f / DM) + RMS_EPS);
            GAS f32x4* o = (GAS f32x4*)(F.out + (size_t)m * DM);
#pragma unroll
            for (int j = 0; j < 4; ++j) { const v4u x = w[k][j]; const int c4 = 2 * (64 * j + lane); const f32x4 g0 = g[c4], g1 = g[c4 + 1];
                o[c4] = (f32x4){bflo(x.x) * rr * g0[0], bfhi(x.x) * rr * g0[1], bflo(x.y) * rr * g0[2], bfhi(x.y) * rr * g0[3]};
                o[c4 + 1] = (f32x4){bflo(x.z) * rr * g1[0], bfhi(x.z) * rr * g1[1], bflo(x.w) * rr * g1[2], bfhi(x.w) * rr * g1[3]}; }
        }
    }
}

__device__ __forceinline__ int t5_bucket(int rel) {
    const int n = rel < 0 ? -rel : rel; int b;
    if (n < 8) b = n; else { int k = (31 - __builtin_clz((unsigned)(n * n))) - 6; b = 8 + k; if (b > 15) b = 15; }
    return (rel > 0 ? 16 : 0) + b;
}
template <int MODE  >
__device__ __forceinline__ void attn_unit(Frame& F, const bf16* Q, int qpitch, const bf16* Kp, const bf16* Vp, int kvpitch, bf16* O, int opitch, int q0, int kt_beg, int kt_end, const LAS float* btab, float sink2) {
    LAS unsigned char* Ks = F.lds + RING_OFF; LAS unsigned char* Vs = Ks + 16384;
    const int lane = F.lane, c = lane & 15, g = lane >> 4, qw0 = q0 + 16 * F.wave, tid = F.tid;
    bf16x8 qf[4];
#pragma unroll
    for (int t = 0; t < 4; ++t) qf[t] = *(const bf16x8*)(Q + (size_t)(qw0 + c) * qpitch + 32 * t + 8 * g);
    f32x4 oacc[8];
#pragma unroll
    for (int i = 0; i < 8; ++i) oacc[i] = (f32x4){0.f, 0.f, 0.f, 0.f};
    float mrun = (MODE == 0) ? sink2 : -1e30f, lsum = (MODE == 0 && g == 0) ? 1.0f : 0.0f;
    v4u kpre[2], vpre[2];
#pragma unroll
    for (int i = 0; i < 2; ++i) { const int ci = tid + 512 * i, key = ci >> 4, ch = ci & 15;
        kpre[i] = *(const v4u*)(Kp + (size_t)(64 * kt_beg + key) * kvpitch + ch * 8); vpre[i] = *(const v4u*)(Vp + (size_t)(64 * kt_beg + key) * kvpitch + ch * 8); }
    for (int kt = kt_beg; kt < kt_end; ++kt) {
        __syncthreads();
#pragma unroll
        for (int i = 0; i < 2; ++i) { const int ci = tid + 512 * i, key = ci >> 4, ch = ci & 15;
            *(LAS v4u*)(Ks + key * 256 + ((ch ^ (key & 15)) << 4)) = kpre[i]; *(LAS v4u*)(Vs + key * 256 + ((ch ^ ((key & 7) << 1)) << 4)) = vpre[i]; }
        if (kt + 1 < kt_end) {
#pragma unroll
            for (int i = 0; i < 2; ++i) { const int ci = tid + 512 * i, key = ci >> 4, ch = ci & 15;
                kpre[i] = *(const v4u*)(Kp + (size_t)(64 * (kt + 1) + key) * kvpitch + ch * 8); vpre[i] = *(const v4u*)(Vp + (size_t)(64 * (kt + 1) + key) * kvpitch + ch * 8); } }
        __syncthreads();
        bool rel_ok = true;
        if (MODE == 0) rel_ok = (64 * kt <= qw0 + 15 + 128) && (64 * kt + 63 >= qw0 - 128);
        if (!rel_ok) continue;
        f32x4 s[4];
#pragma unroll
        for (int mt = 0; mt < 4; ++mt) s[mt] = (f32x4){0.f, 0.f, 0.f, 0.f};
#pragma unroll
        for (int t = 0; t < 4; ++t)
#pragma unroll
            for (int mt = 0; mt < 4; ++mt) { const bf16x8 kf = *(const LAS bf16x8*)(Ks + (16 * mt + c) * 256 + (((4 * t + g) ^ c) << 4));
                s[mt] = __builtin_amdgcn_mfma_f32_16x16x32_bf16(kf, qf[t], s[mt], 0, 0, 0); }
        float tmax = -INFINITY;
#pragma unroll
        for (int mt = 0; mt < 4; ++mt)
#pragma unroll
            for (int r = 0; r < 4; ++r) {
                if (MODE == 0) { const int rel = (64 * kt + 16 * mt + 4 * g + r) - (qw0 + c); const bool ok = (rel >= -128) && (rel <= 128);
                    const int ri = ok ? rel + 128 : 128; const float bv = btab[ri]; s[mt][r] = ok ? s[mt][r] + bv : -INFINITY; }
                tmax = fmaxf(tmax, s[mt][r]); }
        tmax = fmaxf(tmax, __shfl_xor(tmax, 16)); tmax = fmaxf(tmax, __shfl_xor(tmax, 32));
        const float mnew = fmaxf(mrun, tmax), alpha = __builtin_amdgcn_exp2f(mrun - mnew); mrun = mnew; float ps = 0.f;
#pragma unroll
        for (int mt = 0; mt < 4; ++mt)
#pragma unroll
            for (int r = 0; r < 4; ++r) { const float p = __builtin_amdgcn_exp2f(s[mt][r] - mnew); s[mt][r] = p; ps += p; }
        lsum = lsum * alpha + ps;
#pragma unroll
        for (int i = 0; i < 8; ++i) oacc[i] = oacc[i] * alpha;
        bf16x8 pf[2];
#pragma unroll
        for (int t2 = 0; t2 < 2; ++t2) { v4u w; w.x = cvtpk(s[2 * t2][0], s[2 * t2][1]); w.y = cvtpk(s[2 * t2][2], s[2 * t2][3]); w.z = cvtpk(s[2 * t2 + 1][0], s[2 * t2 + 1][1]); w.w = cvtpk(s[2 * t2 + 1][2], s[2 * t2 + 1][3]);
            pf[t2] = __builtin_bit_cast(bf16x8, w); }
        const int q4 = c >> 2, p4 = c & 3;
#pragma unroll
        for (int t2 = 0; t2 < 2; ++t2)
#pragma unroll
            for (int mo = 0; mo < 8; ++mo) {
                const int k1 = 32 * t2 + 4 * g + q4, k2 = k1 + 16, chn = 2 * mo + (p4 >> 1);
                const s16x4 lo = __builtin_bit_cast(s16x4, __builtin_amdgcn_ds_read_tr16_b64_v4i16((LAS s16x4*)(Vs + k1 * 256 + ((chn ^ ((k1 & 7) << 1)) << 4) + (p4 & 1) * 8)));
                const s16x4 hi = __builtin_bit_cast(s16x4, __builtin_amdgcn_ds_read_tr16_b64_v4i16((LAS s16x4*)(Vs + k2 * 256 + ((chn ^ ((k2 & 7) << 1)) << 4) + (p4 & 1) * 8)));
                const bf16x8 vf = (bf16x8){lo[0], lo[1], lo[2], lo[3], hi[0], hi[1], hi[2], hi[3]};
                oacc[mo] = __builtin_amdgcn_mfma_f32_16x16x32_bf16(vf, pf[t2], oacc[mo], 0, 0, 0); }
    }
    lsum += __shfl_xor(lsum, 16); lsum += __shfl_xor(lsum, 32);
    const float inv = 1.0f / lsum;
#pragma unroll
    for (int mo = 0; mo < 8; ++mo) { v2u w; w.x = cvtpk(oacc[mo][0] * inv, oacc[mo][1] * inv); w.y = cvtpk(oacc[mo][2] * inv, oacc[mo][3] * inv);
        *(v2u*)(O + (size_t)(qw0 + c) * opitch + 16 * mo + 4 * g) = w; }
}
__device__ __forceinline__ void swa_phase(Frame& F, int b0, int nb) {
    LAS float* btab = (LAS float*)(F.lds + RING_OFF + 32768);
    const bf16* QS = DOP(bf16, DO_QSW); const bf16* KV = DOP(bf16, DO_KVSW); bf16* Y = WSP(bf16, WS_XB);
    unsigned* qctr = (unsigned*)(F.ctl + CW_SWAQ); unsigned* fdone = (unsigned*)(F.ctl + CW_FOLDDONE);
    for (;;) {
        __syncthreads();
        if (F.tid == 0) {
            unsigned nx = 0x7fffffffu;
            if (!(b0 && __hip_atomic_load(fdone, __ATOMIC_RELAXED, __HIP_MEMORY_SCOPE_AGENT) >= (unsigned)nb)) nx = __hip_atomic_fetch_add(qctr, 1u, __ATOMIC_RELAXED, __HIP_MEMORY_SCOPE_AGENT);
            F.MISC[12] = nx; }
        __syncthreads();
        const int u = (int)F.MISC[12];
        if (u >= SWH * (SEQ / 128)) break;
        const int h = u & 7, qb = u >> 3, kvh = h >> 2;
        __syncthreads();
        if (F.tid < 257) btab[F.tid] = F.in[11][t5_bucket(F.tid - 128) * 8 + h] * LOG2E;
        __syncthreads();
        int kb = 2 * qb - 2, ke = 2 * qb + 4; if (kb < 0) kb = 0; if (ke > SEQ / 64) ke = SEQ / 64;
        attn_unit<0>(F, QS + h * 128, 1024, KV + kvh * 128, KV + 256 + kvh * 128, 512, Y + 1024 + h * 128, DM, qb * 128, kb, ke, btab, F.in[10][h] * LOG2E);
    }
}
__device__ __forceinline__ void mem_attn_phase(Frame& F) {
    const bf16* QM = WSP(bf16, WS_QM); const bf16* KVm = WSP(bf16, WS_KVM); bf16* OM = WSP(bf16, WS_OM);
    for (int u = blockIdx.x; u < MEMH * (SEQ / 128); u += F.G) {
        const int h = u & 3, qb = u >> 2;
        attn_unit<1>(F, QM + h * 128, 512, KVm + h * 128, KVm + 512 + h * 128, 1024, OM + h * 128, 512, qb * 128, 0, 4, nullptr, 0.f);
    }
}

typedef float f32x16 __attribute__((ext_vector_type(16)));
constexpr int DX_W = 0, DX_K = 16384, DX_U = 32768, DX_Q = 49152, DX_A = 65536, DX_BYTES = 73728;
constexpr size_t WS_GL = 1 * MiB + 128 * 1024;
constexpr int L_RAW = 0, RAW_PITCH = 784, L_MTF = 0, L_MTB = 16384, L_TB = 32768, TB_PITCH = 144, TB_SZ = 9216;
constexpr int L_QB = 69632, L_KB = 86016, L_KT = 102400, L_VT = 120832, L_PART = 139264, L_SC = 143360;
constexpr int L_CW = 145408;
static_assert(L_SC + 2048 <= L_CW && L_CW + 7680 <= LDSCTL_OFF, "prep LDS map");
__device__ __forceinline__ unsigned char* dnx_rec(Frame& F, int dir, int hd, int cn) { return F.ws + WS_DNX + (size_t)((dir * 8 + hd) * 256 + cn) * DX_BYTES; }
__device__ __forceinline__ v4u pack8f(const float* v) { v4u w; w.x = cvtpk(v[0], v[1]); w.y = cvtpk(v[2], v[3]); w.z = cvtpk(v[4], v[5]); w.w = cvtpk(v[6], v[7]); return w; }

__device__ __forceinline__ bf16x8 cvt8(const f32x16& v, int o) { v4u w; w.x = cvtpk(v[o], v[o + 1]); w.y = cvtpk(v[o + 2], v[o + 3]); w.z = cvtpk(v[o + 4], v[o + 5]); w.w = cvtpk(v[o + 6], v[o + 7]); return __builtin_bit_cast(bf16x8, w); }
__device__ __forceinline__ bf16x8 cvt8f(f32x4 a, f32x4 b) { v4u w; w.x = cvtpk(a[0], a[1]); w.y = cvtpk(a[2], a[3]); w.z = cvtpk(b[0], b[1]); w.w = cvtpk(b[2], b[3]); return __builtin_bit_cast(bf16x8, w); }
template <int dir> __device__ __forceinline__ void dn_solve_and_write(LAS unsigned char* lds, int lane) {
    const LAS float* MT = (const LAS float*)(lds + (dir ? L_MTB : L_MTF));
    LAS float* T0 = (LAS float*)(lds + L_TB + dir * 2 * TB_SZ);
    LAS float* Trow = T0 + lane * 68;
    const int blk = lane >> 5, cb = 16 * (lane >> 4);
#pragma unroll 1
    for (int jr = 3; jr >= 0; --jr) {
        const int j0 = cb + 4 * jr;
        float a0 = (lane == j0) ? 1.f : 0.f, a1 = (lane == j0 + 1) ? 1.f : 0.f, a2 = (lane == j0 + 2) ? 1.f : 0.f, a3 = (lane == j0 + 3) ? 1.f : 0.f;
        const LAS float* mr = MT + j0 * 64;
#pragma unroll
        for (int sr = 1; sr < 4; ++sr) if (sr > jr) {
            const int s0 = cb + 4 * sr;
            const f32x4 tv = *(const LAS f32x4*)(Trow + s0);
            const f32x4 m0 = *(const LAS f32x4*)(mr + s0), m1 = *(const LAS f32x4*)(mr + 64 + s0), m2 = *(const LAS f32x4*)(mr + 128 + s0), m3 = *(const LAS f32x4*)(mr + 192 + s0);
            a0 -= (tv[0] * m0[0] + tv[1] * m0[1]) + (tv[2] * m0[2] + tv[3] * m0[3]);
            a1 -= (tv[0] * m1[0] + tv[1] * m1[1]) + (tv[2] * m1[2] + tv[3] * m1[3]);
            a2 -= (tv[0] * m2[0] + tv[1] * m2[1]) + (tv[2] * m2[2] + tv[3] * m2[3]);
            a3 -= (tv[0] * m3[0] + tv[1] * m3[1]) + (tv[2] * m3[2] + tv[3] * m3[3]);
        }
        const f32x4 d0 = *(const LAS f32x4*)(mr + j0), d1 = *(const LAS f32x4*)(mr + 64 + j0), d2 = *(const LAS f32x4*)(mr + 128 + j0);
        const float t3 = a3, t2 = a2 - t3 * d2[3], t1 = a1 - t2 * d1[2] - t3 * d1[3], t0 = a0 - t1 * d0[1] - t2 * d0[2] - t3 * d0[3];
        *(LAS f32x4*)(Trow + j0) = (f32x4){t0, t1, t2, t3};
    }
    if (((lane >> 4) & 1) == 0) {
#pragma unroll
        for (int q = 0; q < 4; ++q) *(LAS f32x4*)(Trow + cb + 16 + 4 * q) = (f32x4){0.f, 0.f, 0.f, 0.f}; }
    if (blk == 0) {
#pragma unroll
        for (int q = 8; q < 16; ++q) *(LAS f32x4*)(Trow + 4 * q) = (f32x4){0.f, 0.f, 0.f, 0.f}; }
    asm volatile("s_waitcnt lgkmcnt(0)" ::: "memory");
    {
        const int r = lane & 31, lh = lane >> 5, B = r >> 4, rl = r & 15, c0 = 32 * B;
        float av[8], bv[8];
#pragma unroll
        for (int jj = 0; jj < 8; ++jj) { const int k = 8 * lh + jj; av[jj] = MT[(c0 + k) * 64 + c0 + 16 + rl]; bv[jj] = T0[(c0 + k) * 68 + c0 + rl]; }
        f32x16 Y;
#pragma unroll
        for (int e = 0; e < 16; ++e) Y[e] = 0.f;
        Y = __builtin_amdgcn_mfma_f32_32x32x16_bf16(cvt8f((f32x4){av[0], av[1], av[2], av[3]}, (f32x4){av[4], av[5], av[6], av[7]}), cvt8f((f32x4){bv[0], bv[1], bv[2], bv[3]}, (f32x4){bv[4], bv[5], bv[6], bv[7]}), Y, 0, 0, 0);
        const bf16x8 y0 = cvt8(Y, 0), y1 = cvt8(Y, 8); bf16x8 yb;
#pragma unroll
        for (int e = 0; e < 8; ++e) yb[e] = B ? y1[e] : y0[e];
        const f32x4 t0 = *(const LAS f32x4*)(T0 + (c0 + 16 + rl) * 68 + c0 + 16 + 4 * lh), t1 = *(const LAS f32x4*)(T0 + (c0 + 16 + rl) * 68 + c0 + 16 + 8 + 4 * lh);
        f32x16 Z;
#pragma unroll
        for (int e = 0; e < 16; ++e) Z[e] = 0.f;
        Z = __builtin_amdgcn_mfma_f32_32x32x16_bf16(cvt8f(t0, t1), yb, Z, 0, 0, 0);
#pragma unroll
        for (int j = 0; j < 8; ++j) { const float z = B ? Z[8 + j] : Z[j]; T0[(c0 + 16 + 8 * (j >> 2) + 4 * lh + (j & 3)) * 68 + c0 + rl] = -z; }
    }
    asm volatile("s_waitcnt lgkmcnt(0)" ::: "memory");
    {
        const int r = lane & 31, lh = lane >> 5;
        f32x16 Y;
#pragma unroll
        for (int e = 0; e < 16; ++e) Y[e] = 0.f;
#pragma unroll
        for (int kk = 0; kk < 2; ++kk) {
            float av[8], bv[8];
#pragma unroll
            for (int jj = 0; jj < 8; ++jj) { const int k = 16 * kk + 8 * lh + jj; av[jj] = MT[k * 64 + 32 + r]; bv[jj] = T0[k * 68 + r]; }
            Y = __builtin_amdgcn_mfma_f32_32x32x16_bf16(cvt8f((f32x4){av[0], av[1], av[2], av[3]}, (f32x4){av[4], av[5], av[6], av[7]}), cvt8f((f32x4){bv[0], bv[1], bv[2], bv[3]}, (f32x4){bv[4], bv[5], bv[6], bv[7]}), Y, 0, 0, 0);
        }
        f32x16 Z;
#pragma unroll
        for (int e = 0; e < 16; ++e) Z[e] = 0.f;
#pragma unroll
        for (int kk = 0; kk < 2; ++kk) {
            const f32x4 t0 = *(const LAS f32x4*)(T0 + (32 + r) * 68 + 32 + 16 * kk + 4 * lh), t1 = *(const LAS f32x4*)(T0 + (32 + r) * 68 + 32 + 16 * kk + 8 + 4 * lh);
            Z = __builtin_amdgcn_mfma_f32_32x32x16_bf16(cvt8f(t0, t1), cvt8(Y, 8 * kk), Z, 0, 0, 0);
        }
#pragma unroll
        for (int e = 0; e < 16; ++e) T0[(32 + (e & 3) + 8 * (e >> 2) + 4 * lh) * 68 + r] = -Z[e];
    }
    asm volatile("s_waitcnt lgkmcnt(0)" ::: "memory");
    f32x4 tr[16];
#pragma unroll
    for (int q = 0; q < 16; ++q) tr[q] = *(const LAS f32x4*)(Trow + 4 * q);
    asm volatile("s_waitcnt lgkmcnt(0)" ::: "memory");
    const LAS float* sc = (const LAS float*)(lds + L_SC);
    const LAS float* cU = sc + (dir ? 384 : 256); const LAS float* cW = sc + (dir ? 448 : 320);
    const int pos = dir ? 63 - lane : lane;
    LAS unsigned char* tu = lds + L_TB + dir * 2 * TB_SZ + pos * TB_PITCH; LAS unsigned char* tw = tu + TB_SZ;
#pragma unroll
    for (int q = 0; q < 8; ++q) {
        float u8[8], w8[8];
#pragma unroll
        for (int e = 0; e < 8; ++e) { const int s = 8 * q + e, sp = dir ? 63 - s : s; const float t = tr[sp >> 2][sp & 3]; u8[e] = t * cU[s]; w8[e] = t * cW[s]; }
        *(LAS v4u*)(tu + q * 16) = pack8f(u8); *(LAS v4u*)(tw + q * 16) = pack8f(w8);
    }
}

struct PrepRegs { v4u raw[7]; float ab[4]; };
__device__ __forceinline__ void prep_load(Frame& F, int u, int tid, int lane, PrepRegs& R) {
    const int cn = u >> 3, hd = u & 7; const bf16* QKV = WSP(bf16, WS_QKV);
#pragma unroll
    for (int k = 0; k < 7; ++k) { const int ci = tid + 512 * k; const int row = ci / 48, cc = ci % 48, seg = cc >> 4, ch = (cc & 15) * 8, tok = 64 * cn - 2 + row;
        v4u v = (v4u){0u, 0u, 0u, 0u};
        if (ci < 68 * 48 && tok >= 0 && tok < SEQ) v = *(const v4u*)(QKV + (size_t)tok * 3072 + seg * 1024 + hd * 128 + ch);
        R.raw[k] = v; }
    if (tid < 64) { const float* ab = WSP(float, WS_AB) + (size_t)(64 * cn + lane) * 32; R.ab[0] = ab[hd]; R.ab[1] = ab[8 + hd]; R.ab[2] = ab[16 + hd]; R.ab[3] = ab[24 + hd]; }
}
#define DNX_ST(ptr, val) do { const v4u v_ = (val); if (MASK & 32) *(v4u*)(ptr) = v_; else asm volatile("" :: "v"(v_)); } while (0)
template <int MASK> __device__ __forceinline__ void dn_prep_unit(Frame& F, int cn, int hd, PrepRegs& PR, int next_u) {
    LAS unsigned char* lds = F.lds; int tid = F.tid, lane = F.lane; const int wave = F.wave;
    asm volatile("" : "+v"(tid), "+v"(lane));
    LAS float* sc = (LAS float*)(lds + L_SC);
    __syncthreads();
    if (MASK & 1) {
    const float abv[4] = {PR.ab[0], PR.ab[1], PR.ab[2], PR.ab[3]};
#pragma unroll
    for (int k = 0; k < 7; ++k) { const int ci = tid + 512 * k; const int row = ci / 48, cc = ci % 48, seg = cc >> 4, ch = (cc & 15) * 8;
        if (ci < 68 * 48) *(LAS v4u*)(lds + L_RAW + row * RAW_PITCH + (seg * 128 + ch) * 2) = PR.raw[k]; }
    if (wave == 0) {
        const float bfv = 1.0f / (1.0f + __expf(-abv[0])), bbv = 1.0f / (1.0f + __expf(-abv[1]));
        const float gf = -__expf(F.in[5][hd]) * softplusf(abv[2] + F.in[7][hd]), gb = -__expf(F.in[6][hd]) * softplusf(abv[3] + F.in[8][hd]);
        float Gf = gf, Gb = gb;
#pragma unroll
        for (int o = 1; o < 64; o <<= 1) { const float a = __shfl_up(Gf, o), b = __shfl_down(Gb, o); if (lane >= o) Gf += a; if (lane + o < 64) Gb += b; }
        sc[lane] = Gf; sc[64 + lane] = Gb; sc[128 + lane] = bfv; sc[192 + lane] = bbv;
        sc[256 + lane] = bfv; sc[320 + lane] = -bfv * __expf(Gf); sc[384 + lane] = bbv; sc[448 + lane] = -bbv * __expf(Gb);
        float* GL = WSP(float, WS_GL);
        if (MASK & 32) { if (lane == 63) GL[(0 * 8 + hd) * 256 + cn] = __expf(Gf);
        if (lane == 0) GL[(1 * 8 + hd) * 256 + cn] = __expf(Gb); }
    }
    }
    __syncthreads();
    asm volatile("" : "+v"(tid), "+v"(lane));
    if (MASK & 2) {
        const int t = wave, pos = lane; const LAS float* cw = (const LAS float*)(lds + L_CW) + 16 * t;
        float qv[16], kv[16], vv[16];
#pragma unroll
        for (int seg = 0; seg < 3; ++seg) {
            float a[16];
#pragma unroll
            for (int i = 0; i < 16; ++i) a[i] = 0.f;
#pragma unroll
            for (int j = 0; j < 5; ++j) {
                const LAS unsigned char* rp = lds + L_RAW + (pos + j) * RAW_PITCH + (seg * 128 + 16 * t) * 2;
                const v4u r0 = *(const LAS v4u*)rp, r1 = *(const LAS v4u*)(rp + 16);
                const LAS float* w = cw + j * 384 + seg * 128;
#pragma unroll
                for (int i = 0; i < 4; ++i) { a[2 * i] += w[2 * i] * bflo(r0[i]); a[2 * i + 1] += w[2 * i + 1] * bfhi(r0[i]); a[8 + 2 * i] += w[8 + 2 * i] * bflo(r1[i]); a[8 + 2 * i + 1] += w[8 + 2 * i + 1] * bfhi(r1[i]); }
            }
#pragma unroll
            for (int i = 0; i < 16; ++i) { const float s = siluf(a[i]); if (seg == 0) qv[i] = s; else if (seg == 1) kv[i] = s; else vv[i] = s; }
        }
        float sq = 0.f, sk = 0.f;
#pragma unroll
        for (int i = 0; i < 16; ++i) { sq += qv[i] * qv[i]; sk += kv[i] * kv[i]; }
        LAS float* part = (LAS float*)(lds + L_PART);
        part[t * 64 + pos] = sq; part[512 + t * 64 + pos] = sk;
        __syncthreads();
        float tq = 0.f, tk = 0.f;
#pragma unroll
        for (int i = 0; i < 8; ++i) { tq += part[i * 64 + pos]; tk += part[512 + i * 64 + pos]; }
        const float rq = (1.0f / sqrtf(tq + 1e-6f)) * 0.08838834764831845f, rk = 1.0f / sqrtf(tk + 1e-6f);
#pragma unroll
        for (int i = 0; i < 16; ++i) { qv[i] *= rq; kv[i] *= rk; }
        *(LAS v4u*)(lds + L_QB + pos * 256 + (((2 * t) ^ (pos & 15)) << 4)) = pack8f(qv); *(LAS v4u*)(lds + L_QB + pos * 256 + (((2 * t + 1) ^ (pos & 15)) << 4)) = pack8f(qv + 8);
        *(LAS v4u*)(lds + L_KB + pos * 256 + (((2 * t) ^ (pos & 15)) << 4)) = pack8f(kv); *(LAS v4u*)(lds + L_KB + pos * 256 + (((2 * t + 1) ^ (pos & 15)) << 4)) = pack8f(kv + 8);
#pragma unroll
        for (int i = 0; i < 16; ++i) { const unsigned w = cvtpk(kv[i], vv[i]); *(LAS unsigned short*)(lds + L_KT + (16 * t + i) * TB_PITCH + pos * 2) = (unsigned short)w; *(LAS unsigned short*)(lds + L_VT + (16 * t + i) * TB_PITCH + pos * 2) = (unsigned short)(w >> 16); }
        const float ef = __expf(sc[pos]), eb = __expf(sc[64 + pos]); const int mt = pos >> 5;
#pragma unroll
        for (int dir = 0; dir < 2; ++dir) { const float e = dir ? eb : ef; unsigned char* rec = dnx_rec(F, dir, hd, cn) + DX_Q;
#pragma unroll
            for (int lh = 0; lh < 2; ++lh) { float o8[8];
#pragma unroll
                for (int j = 0; j < 8; ++j) o8[j] = qv[8 * (j >> 2) + 4 * lh + (j & 3)] * e;
                DNX_ST(rec + ((mt * 8 + t) * 64 + 32 * lh + (pos & 31)) * 16, pack8f(o8)); } }
    }
    __syncthreads();
    asm volatile("" : "+v"(tid), "+v"(lane));
    if (MASK & 4) {
        const int r = lane & 31, lh = lane >> 5, x = wave & 3, ta = x >> 1, tb = x & 1;
        const LAS unsigned char* Ab = lds + L_KB + (32 * ta + r) * 256; const LAS unsigned char* Bb = lds + (wave < 4 ? L_KB : L_QB) + (32 * tb + r) * 256;
        f32x16 acc;
#pragma unroll
        for (int i = 0; i < 16; ++i) acc[i] = 0.f;
#pragma unroll
        for (int kk = 0; kk < 8; ++kk) { const int ch = ((2 * kk + lh) ^ (r & 15)) << 4;
            acc = __builtin_amdgcn_mfma_f32_32x32x16_bf16(*(const LAS bf16x8*)(Ab + ch), *(const LAS bf16x8*)(Bb + ch), acc, 0, 0, 0); }
        const int b = 32 * tb + r;
        if (wave < 4) {
            const float Gfb = sc[b], Gbb = sc[64 + b];
#pragma unroll
            for (int q = 0; q < 4; ++q) { const int a0 = 32 * ta + 8 * q + 4 * lh; f32x4 mf, mb;
#pragma unroll
                for (int e = 0; e < 4; ++e) { const int a = a0 + e; const float kkv = acc[4 * q + e];
                    const float vf = sc[128 + a] * kkv * __expf(fminf(sc[a] - Gfb, 0.f)), vb = sc[192 + a] * kkv * __expf(fminf(sc[64 + a] - Gbb, 0.f));
                    mf[e] = (a > b) ? vf : 0.f; mb[3 - e] = (a < b) ? vb : 0.f; }
                *(LAS f32x4*)(lds + L_MTF + (b * 64 + a0) * 4) = mf; *(LAS f32x4*)(lds + L_MTB + ((63 - b) * 64 + 60 - a0) * 4) = mb; }
        } else {
            const float Gfc = sc[b], Gbc = sc[64 + b];
#pragma unroll
            for (int dir = 0; dir < 2; ++dir) { unsigned char* rec = dnx_rec(F, dir, hd, cn) + DX_A;
#pragma unroll
                for (int s2 = 0; s2 < 2; ++s2) { float o8[8];
#pragma unroll
                    for (int j = 0; j < 8; ++j) { const int s = 32 * ta + 16 * s2 + 8 * (j >> 2) + 4 * lh + (j & 3); const float v = acc[8 * s2 + j];
                        const float ev = v * __expf(fminf(dir ? Gbc - sc[64 + s] : Gfc - sc[s], 0.f)); o8[j] = (dir ? (s >= b) : (s <= b)) ? ev : 0.f; }
                    DNX_ST(rec + ((tb * 4 + 2 * ta + s2) * 64 + lane) * 16, pack8f(o8)); } }
        }
    }
    __syncthreads();
    asm volatile("" : "+v"(tid), "+v"(lane));
    if ((MASK & 1) && next_u < 256 * DNH) prep_load(F, next_u, tid, lane, PR);
    if (!(MASK & 8)) {} else if (wave == 0) dn_solve_and_write<0>(lds, lane);
    else if (wave == 1) dn_solve_and_write<1>(lds, lane);
    else {
        const int r = lane & 31, lh = lane >> 5;
        for (int f = wave - 2; f < 32; f += 6) { const int dir = f >> 4, m = (f >> 2) & 3, t = f & 3; const int dk = 32 * m + r;
            const v2u k0 = *(const LAS v2u*)(lds + L_KT + dk * TB_PITCH + (16 * t + 4 * lh) * 2), k1 = *(const LAS v2u*)(lds + L_KT + dk * TB_PITCH + (16 * t + 8 + 4 * lh) * 2);
            const float Gl = dir ? sc[64] : sc[63]; const LAS float* Gs = sc + (dir ? 64 : 0) + 16 * t + 4 * lh; float o8[8];
            o8[0] = bflo(k0.x) * __expf(Gl - Gs[0]); o8[1] = bfhi(k0.x) * __expf(Gl - Gs[1]); o8[2] = bflo(k0.y) * __expf(Gl - Gs[2]); o8[3] = bfhi(k0.y) * __expf(Gl - Gs[3]);
            o8[4] = bflo(k1.x) * __expf(Gl - Gs[8]); o8[5] = bfhi(k1.x) * __expf(Gl - Gs[9]); o8[6] = bflo(k1.y) * __expf(Gl - Gs[10]); o8[7] = bfhi(k1.y) * __expf(Gl - Gs[11]);
            DNX_ST(dnx_rec(F, dir, hd, cn) + DX_K + ((m * 4 + t) * 64 + lane) * 16, pack8f(o8)); }
    }
    __syncthreads();
    asm volatile("" : "+v"(tid), "+v"(lane));
    if (MASK & 16) {
        const int dir = wave >> 2, x = wave & 3, r = lane & 31, lh = lane >> 5;
        const LAS unsigned char* Tu = lds + L_TB + (dir ? 2 : 0) * TB_SZ; const LAS unsigned char* Tw = Tu + TB_SZ;
        unsigned char* rec = dnx_rec(F, dir, hd, cn);
#pragma unroll
        for (int mt = 0; mt < 2; ++mt) {
            f32x16 aw, au;
#pragma unroll
            for (int i = 0; i < 16; ++i) { aw[i] = 0.f; au[i] = 0.f; }
#pragma unroll
            for (int kk = 0; kk < 4; ++kk) { const int so = (16 * kk + 8 * lh) * 2;
                aw = __builtin_amdgcn_mfma_f32_32x32x16_bf16(*(const LAS bf16x8*)(lds + L_KT + (32 * x + r) * TB_PITCH + so), *(const LAS bf16x8*)(Tw + (32 * mt + r) * TB_PITCH + so), aw, 0, 0, 0);
                au = __builtin_amdgcn_mfma_f32_32x32x16_bf16(*(const LAS bf16x8*)(Tu + (32 * mt + r) * TB_PITCH + so), *(const LAS bf16x8*)(lds + L_VT + (32 * x + r) * TB_PITCH + so), au, 0, 0, 0); }
            float tmp[16];
#pragma unroll
            for (int i = 0; i < 16; ++i) tmp[i] = aw[i];
            DNX_ST(rec + DX_W + ((mt * 8 + 2 * x) * 64 + lane) * 16, pack8f(tmp)); DNX_ST(rec + DX_W + ((mt * 8 + 2 * x + 1) * 64 + lane) * 16, pack8f(tmp + 8));
#pragma unroll
            for (int i = 0; i < 16; ++i) tmp[i] = au[i];
            DNX_ST(rec + DX_U + ((x * 2 + mt) * 64 + lane) * 32, pack8f(tmp)); DNX_ST(rec + DX_U + ((x * 2 + mt) * 64 + lane) * 32 + 16, pack8f(tmp + 8));
        }
    }
}
#undef DNX_ST
template <int MASK> __device__ __forceinline__ void dn_prep_phase(Frame& F) {
    PrepRegs PR; int u = blockIdx.x; int cur_hd = -1;
    if (u < 256 * DNH) prep_load(F, u, F.tid, F.lane, PR);
    for (; u < 256 * DNH; u += F.G) {
        const int hd = u & 7;
        if (hd != cur_hd) {
            __syncthreads();
            for (int i = F.tid; i < 5 * 384; i += NWAVES * 64) { const int j = i / 384, c = i % 384; ((LAS float*)(F.lds + L_CW))[i] = F.in[4][j * 3072 + (c >> 7) * 1024 + hd * 128 + (c & 127)]; }
            cur_hd = hd;
        }
        dn_prep_unit<MASK>(F, u >> 3, hd, PR, u + F.G);
    }
}


constexpr int NSEG = 16, SEGL = 16;
constexpr size_t WS_PF = 176 * MiB, WS_RG = 184 * MiB, WS_SIN = 24 * MiB;
constexpr int SLOT1 = 49152, SLOT3 = 73728, L_GLS = 147456;
#define DN_WAIT(V) asm volatile("s_waitcnt vmcnt(" #V ") lgkmcnt(0)" ::: "memory")
#define DN_BAR() do { __builtin_amdgcn_s_barrier(); asm volatile("" ::: "memory"); } while (0)
__device__ __forceinline__ int seg_chunk(int dir, int g, int i) { const int n = SEGL * g + i; return dir ? 255 - n : n; }
__device__ __forceinline__ void u_to_acc(f32x16& a, const LAS unsigned char* up) {
    const v4u u0 = *(const LAS v4u*)up, u1 = *(const LAS v4u*)(up + 16);
#pragma unroll
    for (int i = 0; i < 4; ++i) { a[2 * i] = bflo(u0[i]); a[2 * i + 1] = bfhi(u0[i]); a[8 + 2 * i] = bflo(u1[i]); a[8 + 2 * i + 1] = bfhi(u1[i]); }
}
template <bool OUT>
__device__ __forceinline__ void dn_step(f32x16 (&S)[4], f32x16 (&aV)[2], f32x16 (&aO)[2], const LAS unsigned char* buf, float gl) {
#pragma unroll
    for (int t = 0; t < 8; ++t) { const bf16x8 sb = cvt8(S[t >> 1], 8 * (t & 1));
#pragma unroll
        for (int mt = 0; mt < 2; ++mt) {
            aV[mt] = __builtin_amdgcn_mfma_f32_32x32x16_bf16(*(const LAS bf16x8*)(buf + DX_W + (mt * 8 + t) * 1024), sb, aV[mt], 0, 0, 0);
            if (OUT) aO[mt] = __builtin_amdgcn_mfma_f32_32x32x16_bf16(*(const LAS bf16x8*)(buf + DX_Q + (mt * 8 + t) * 1024), sb, aO[mt], 0, 0, 0); } }
    bf16x8 vb[4];
#pragma unroll
    for (int t = 0; t < 4; ++t) vb[t] = cvt8(aV[t >> 1], 8 * (t & 1));
#pragma unroll
    for (int m = 0; m < 4; ++m) S[m] = S[m] * gl;
#pragma unroll
    for (int t = 0; t < 4; ++t) {
#pragma unroll
        for (int m = 0; m < 4; ++m) S[m] = __builtin_amdgcn_mfma_f32_32x32x16_bf16(*(const LAS bf16x8*)(buf + DX_K + (m * 4 + t) * 1024), vb[t], S[m], 0, 0, 0);
        if (OUT) {
#pragma unroll
            for (int mt = 0; mt < 2; ++mt) aO[mt] = __builtin_amdgcn_mfma_f32_32x32x16_bf16(*(const LAS bf16x8*)(buf + DX_A + (mt * 4 + t) * 1024), vb[t], aO[mt], 0, 0, 0); } }
}

__device__ __forceinline__ void dn_pass1(Frame& F) {
    LAS unsigned char* lds = F.lds; const int lane = F.lane, wave = F.wave, r = lane & 31, lh = lane >> 5, part = wave >> 2, d = wave & 3;
    LAS float* gls = (LAS float*)(lds + L_GLS);
    for (int unit = blockIdx.x; unit < 16 * NSEG; unit += F.G) {
        const int dir = unit >> 7, hd = (unit >> 4) & 7, g = unit & 15;
        DN_WAIT(0); __syncthreads();
        if (F.tid < SEGL) gls[F.tid] = WSP(float, WS_GL)[(dir * 8 + hd) * 256 + seg_chunk(dir, g, F.tid)];
        DN_WAIT(0);
        f32x16 S[4];
#pragma unroll
        for (int m = 0; m < 4; ++m)
#pragma unroll
            for (int i = 0; i < 16; ++i) S[m][i] = (part && (32 * m + (i & 3) + 8 * (i >> 2) + 4 * lh == 32 * d + r)) ? 1.f : 0.f;
#define P1_ISSUE(i) do { const unsigned char* src_ = dnx_rec(F, dir, hd, seg_chunk(dir, g, (i))) + lane * 16; LAS unsigned char* dst_ = lds + ((i) % 3) * SLOT1; \
            _Pragma("unroll") for (int k_ = 0; k_ < 6; ++k_) { const int p_ = wave + 8 * k_; __builtin_amdgcn_global_load_lds((const unsigned*)(src_ + p_ * 1024), (LAS unsigned*)(dst_ + p_ * 1024), 16, 0, 0); } } while (0)
        P1_ISSUE(0); P1_ISSUE(1);
        for (int i = 0; i < SEGL; ++i) {
            if (i + 1 < SEGL) DN_WAIT(6); else DN_WAIT(0);
            DN_BAR();
            if (i + 2 < SEGL) P1_ISSUE(i + 2);
            const LAS unsigned char* buf = lds + (i % 3) * SLOT1 + lane * 16;
            f32x16 aV[2], aO[2];
#pragma unroll
            for (int mt = 0; mt < 2; ++mt) {
                if (part == 0) u_to_acc(aV[mt], lds + (i % 3) * SLOT1 + DX_U + ((d * 2 + mt) * 64 + lane) * 32);
                else {
#pragma unroll
                    for (int e = 0; e < 16; ++e) aV[mt][e] = 0.f; } }
            dn_step<false>(S, aV, aO, buf, gls[i]);
        }
#undef P1_ISSUE
        DN_WAIT(0); DN_BAR();
        if (part == 0) {
            float* rg = (float*)(F.ws + WS_RG) + (size_t)unit * 16384;
#pragma unroll
            for (int m = 0; m < 4; ++m)
#pragma unroll
                for (int q = 0; q < 4; ++q) *(f32x4*)(rg + ((d * 4 + m) * 64 + lane) * 16 + 4 * q) = (f32x4){S[m][4 * q], S[m][4 * q + 1], S[m][4 * q + 2], S[m][4 * q + 3]};
        } else {
#pragma unroll
            for (int m = 0; m < 4; ++m)
#pragma unroll
                for (int i = 0; i < 16; ++i) *(LAS unsigned short*)(lds + (32 * m + (i & 3) + 8 * (i >> 2) + 4 * lh) * 272 + (32 * d + r) * 2) = (unsigned short)f2bf(S[m][i]);
        }
        DN_WAIT(0); DN_BAR();
        if (part == 1) {
            unsigned char* pf = F.ws + WS_PF + (size_t)unit * 32768;
#pragma unroll
            for (int k = 0; k < 8; ++k) { const int f = d * 8 + k, m = f >> 3, t = f & 7;
                const v2u a = *(const LAS v2u*)(lds + (32 * m + r) * 272 + (16 * t + 4 * lh) * 2), b = *(const LAS v2u*)(lds + (32 * m + r) * 272 + (16 * t + 8 + 4 * lh) * 2);
                *(v4u*)(pf + (f * 64 + lane) * 16) = (v4u){a.x, a.y, b.x, b.y}; }
        }
    }
}
constexpr int FOLD_SLOT = 49152, NFOLD = 64;
__device__ __forceinline__ void dn_fold(Frame& F) {
    const int b = blockIdx.x; if (b >= NFOLD) return;
    LAS unsigned char* lds = F.lds; const int lane = F.lane, wave = F.wave, dir = b >> 5, hd = (b >> 2) & 7, d = b & 3;
    const int unit0 = (dir * 8 + hd) * 16;
    const unsigned char* pf0 = F.ws + WS_PF + (size_t)unit0 * 32768; const unsigned char* rg0 = F.ws + WS_RG + (size_t)unit0 * 65536 + d * 16384;
    float* sin0 = (float*)(F.ws + WS_SIN) + (size_t)unit0 * 16384 + d * 4096;
    DN_WAIT(0); __syncthreads();
    const bool loader = (wave >= 1 && wave <= 6);
#define FOLD_ISSUE(g) do { if (loader) { LAS unsigned char* dst_ = lds + ((g) % 3) * FOLD_SLOT; const unsigned char* ps_ = pf0 + (size_t)(g) * 32768 + lane * 16; const unsigned char* rs_ = rg0 + (size_t)(g) * 65536 + lane * 16; \
        _Pragma("unroll") for (int k_ = 0; k_ < 8; ++k_) { const int p_ = (wave - 1) + 6 * k_; \
            if (p_ < 32) __builtin_amdgcn_global_load_lds((const unsigned*)(ps_ + p_ * 1024), (LAS unsigned*)(dst_ + p_ * 1024), 16, 0, 0); \
            else __builtin_amdgcn_global_load_lds((const unsigned*)(rs_ + (p_ - 32) * 1024), (LAS unsigned*)(dst_ + p_ * 1024), 16, 0, 0); } } } while (0)
    f32x16 S[4];
#pragma unroll
    for (int m = 0; m < 4; ++m)
#pragma unroll
        for (int i = 0; i < 16; ++i) S[m][i] = 0.f;
    FOLD_ISSUE(0); FOLD_ISSUE(1);
    for (int g = 0; g < NSEG - 1; ++g) {
        if (g + 1 < NSEG - 1) DN_WAIT(8); else DN_WAIT(0);
        DN_BAR();
        if (g + 2 < NSEG - 1) FOLD_ISSUE(g + 2);
        if (wave == 0) {
            float* so = sin0 + (size_t)g * 16384;
#pragma unroll
            for (int m = 0; m < 4; ++m)
#pragma unroll
                for (int q = 0; q < 4; ++q) *(f32x4*)(so + (m * 64 + lane) * 16 + 4 * q) = (f32x4){S[m][4 * q], S[m][4 * q + 1], S[m][4 * q + 2], S[m][4 * q + 3]};
            const LAS unsigned char* slot = lds + (g % 3) * FOLD_SLOT;
            bf16x8 sb[8];
#pragma unroll
            for (int t = 0; t < 8; ++t) sb[t] = cvt8(S[t >> 1], 8 * (t & 1));
#pragma unroll
            for (int m = 0; m < 4; ++m) {
#pragma unroll
                for (int q = 0; q < 4; ++q) { const f32x4 v = *(const LAS f32x4*)(slot + 32768 + (m * 64 + lane) * 64 + q * 16); S[m][4 * q] = v[0]; S[m][4 * q + 1] = v[1]; S[m][4 * q + 2] = v[2]; S[m][4 * q + 3] = v[3]; }
#pragma unroll
                for (int t = 0; t < 8; ++t) S[m] = __builtin_amdgcn_mfma_f32_32x32x16_bf16(*(const LAS bf16x8*)(slot + lane * 16 + (m * 8 + t) * 1024), sb[t], S[m], 0, 0, 0); }
        }
    }
#undef FOLD_ISSUE
    if (wave == 0) {
        float* so = sin0 + (size_t)(NSEG - 1) * 16384;
#pragma unroll
        for (int m = 0; m < 4; ++m)
#pragma unroll
            for (int q = 0; q < 4; ++q) *(f32x4*)(so + (m * 64 + lane) * 16 + 4 * q) = (f32x4){S[m][4 * q], S[m][4 * q + 1], S[m][4 * q + 2], S[m][4 * q + 3]};
    }
    DN_WAIT(0); __syncthreads();
    if (F.tid == 0) __hip_atomic_fetch_add((unsigned*)(F.ctl + CW_FOLDDONE), 1u, __ATOMIC_RELAXED, __HIP_MEMORY_SCOPE_AGENT);
}
__device__ __forceinline__ void dn_pass3(Frame& F) {
    LAS unsigned char* lds = F.lds; const int lane = F.lane, wave = F.wave, r = lane & 31, lh = lane >> 5;
    LAS float* gls = (LAS float*)(lds + L_GLS);
    const int nb3 = F.G >= 2 ? (F.G >> 1) : 1;
    if ((int)blockIdx.x >= nb3) return;
    for (int unit = blockIdx.x; unit < 16 * NSEG; unit += nb3) {
        const int dir = unit >> 7, hd = (unit >> 4) & 7, g = unit & 15;
        __syncthreads();
        if (F.tid < SEGL) gls[F.tid] = WSP(float, WS_GL)[(dir * 8 + hd) * 256 + seg_chunk(dir, g, F.tid)];
        asm volatile("s_waitcnt lgkmcnt(0)" ::: "memory");
        if (wave >= 4) {
            const int lw = wave - 4;
            for (int i = 0; i <= SEGL; ++i) {
                if (i < SEGL) { const unsigned char* src = dnx_rec(F, dir, hd, seg_chunk(dir, g, i)) + lane * 16; LAS unsigned char* dst = lds + (i & 1) * SLOT3;
#pragma unroll
                    for (int k = 0; k < 18; ++k) { const int p = lw + 4 * k; __builtin_amdgcn_global_load_lds((const unsigned*)(src + p * 1024), (LAS unsigned*)(dst + p * 1024), 16, 0, 0); } }
                DN_WAIT(0); DN_BAR();
            }
        } else {
            const int d = wave;
            f32x16 S[4];
            const float* si = (const float*)(F.ws + WS_SIN) + (size_t)unit * 16384;
#pragma unroll
            for (int m = 0; m < 4; ++m)
#pragma unroll
                for (int q = 0; q < 4; ++q) { const f32x4 v = *(const f32x4*)(si + ((d * 4 + m) * 64 + lane) * 16 + 4 * q); S[m][4 * q] = v[0]; S[m][4 * q + 1] = v[1]; S[m][4 * q + 2] = v[2]; S[m][4 * q + 3] = v[3]; }
            bf16* O = WSP(bf16, dir ? WS_OB : WS_OF);
            DN_BAR();
            for (int i = 0; i < SEGL; ++i) {
                const int cn = seg_chunk(dir, g, i); const LAS unsigned char* slot = lds + (i & 1) * SLOT3;
                f32x16 aV[2], aO[2];
#pragma unroll
                for (int mt = 0; mt < 2; ++mt) { u_to_acc(aV[mt], slot + DX_U + ((d * 2 + mt) * 64 + lane) * 32);
#pragma unroll
                    for (int e = 0; e < 16; ++e) aO[mt][e] = 0.f; }
                dn_step<true>(S, aV, aO, slot + lane * 16, gls[i]);
                {
                    LAS unsigned char* stg = (LAS unsigned char*)slot + DX_U + d * 4096;
#pragma unroll
                    for (int mt = 0; mt < 2; ++mt)
#pragma unroll
                        for (int e = 0; e < 16; e += 2) { const unsigned w = cvtpk(aO[mt][e], aO[mt][e + 1]);
                            *(LAS unsigned short*)(stg + (32 * mt + (e & 3) + 8 * (e >> 2) + 4 * lh) * 64 + r * 2) = (unsigned short)w;
                            *(LAS unsigned short*)(stg + (32 * mt + ((e + 1) & 3) + 8 * (e >> 2) + 4 * lh) * 64 + r * 2) = (unsigned short)(w >> 16); }
                    asm volatile("s_waitcnt lgkmcnt(0)" ::: "memory");
                    bf16* ob = O + (size_t)(64 * cn) * 1024 + hd * 128 + 32 * d;
#pragma unroll
                    for (int k = 0; k < 4; ++k) { const int pc = lane + 64 * k, row = pc >> 2, c4 = pc & 3;
                        *(v4u*)(ob + (size_t)row * 1024 + c4 * 8) = *(const LAS v4u*)(stg + row * 64 + c4 * 16); }
                }
                asm volatile("s_waitcnt lgkmcnt(0)" ::: "memory");
                DN_BAR();
            }
        }
    }
    __syncthreads();
}

#ifndef MK_N_LAUNCHES
#define MK_N_LAUNCHES 1
#endif
constexpr int N_PHASES = 14;
struct Args { const float* in[23]; float* out; unsigned char* ws; int ph_lo, ph_hi; };
static_assert(sizeof(Args) == 23 * 8 + 8 + 8 + 8, "Args has no padding");

__global__ void __launch_bounds__(NWAVES * 64, 2) enc_fwd(Args args) {
    extern __shared__ __attribute__((aligned(16))) unsigned char lds[];
    Frame F;
    F.lds = (LAS unsigned char*)lds;
    F.MISC = (volatile LAS unsigned*)(F.lds + MISC_OFF);
    F.tid = threadIdx.x; F.lane = F.tid & 63; F.wave = __builtin_amdgcn_readfirstlane(F.tid >> 6);
    F.G = gridDim.x; { const int bx = blockIdx.x; F.vcu = (F.G % 8 == 0) ? (bx % 8) * (F.G / 8) + bx / 8 : bx; }
#pragma unroll
    for (int i = 0; i < 23; ++i) F.in[i] = args.in[i];
    F.out = args.out; F.ws = args.ws; F.ctl = (gu32*)(args.ws + WS_CTL);
    for (int u = F.tid; u < (LDS_BYTES - LDSCTL_OFF) / 4; u += NWAVES * 64) ((LAS unsigned*)(F.lds + LDSCTL_OFF))[u] = 0u;
    __syncthreads();
    const int lo = args.ph_lo, hi = args.ph_hi;
    XcdBarrier bar; bar.bar = (unsigned*)(F.ctl + CW_BAR); bar.x = 0; bar.st = nullptr;
    if (hi - lo > 1) bar = xcd_barrier_post((unsigned*)(F.ctl + CW_BAR), F.MISC + 8);
#define IN(k) (lo <= (k) && (k) < hi)
#ifdef TS_IDX
    unsigned long long ts_a = 0, ts_b = 0; int tsi = 0;
#define TSP() do { const unsigned long long now_ = __builtin_amdgcn_s_memrealtime(); if (tsi == TS_IDX) ts_a = now_; if (tsi == TS_IDX + 1) ts_b = now_; ++tsi; } while (0)
#else
#define TSP() do { } while (0)
#endif
#define SEAM(k) do { if (IN(k) && IN((k) + 1)) xcd_barrier(bar); TSP(); } while (0)
    TSP();
    float* sumsq2 = (float*)(F.ws + WS_CTL + CTL_SUMSQ2); float* sumsq3 = (float*)(F.ws + WS_CTL + CTL_SUMSQ3); float* sumsq4 = (float*)(F.ws + WS_CTL + CTL_SUMSQ4);

    if (IN(0)) { p0_prologue(F);
#if defined(REPEAT_PHASE) && REPEAT_PHASE == 0
        p0_prologue(F);
#endif
    } SEAM(0);
    if (IN(1)) {
        { pg8::Gemm g{WSP(bf16, WS_XB), WSP(bf16, WS_WIN), SEQ, NINP, DM}; pg8::StaticOrder S; S.init(SEQ, NINP, F.G, (int)blockIdx.x);
          EpiProj E{WSP(float, WS_RSTD1), WSP(bf16, WS_QKV), DOP(bf16, DO_Z), DOP(bf16, DO_QSW), DOP(bf16, DO_KVSW), WSP(float, WS_AB)};
          pg8::gemm_phase<EpiProj, pg8::StaticOrder, true, true>(F.lds + RING_OFF, g, S, E);
#if defined(REPEAT_PHASE) && REPEAT_PHASE == 1
          pg8::gemm_phase<EpiProj, pg8::StaticOrder, true, true>(F.lds + RING_OFF, g, S, E);
#endif
          }
        { const int nwg = (SEQ / 256) * (NINP / 256), rem = nwg % F.G; if (rem) p1_late_transposes(F, rem, F.G - rem); else p1_late_transposes(F, 0, F.G); }
    } SEAM(1);
    if (IN(2)) { dn_prep_phase<63>(F);
#if defined(REPEAT_PHASE) && REPEAT_PHASE == 2
        dn_prep_phase<63>(F);
#endif
#if defined(REPEAT_PHASE) && REPEAT_PHASE >= 1000 && REPEAT_PHASE < 1064
        dn_prep_phase<REPEAT_PHASE - 1000>(F);
#endif
    } SEAM(2);
    if (IN(3)) { dn_pass1(F);
#if defined(REPEAT_PHASE) && REPEAT_PHASE == 3
        dn_pass1(F);
#endif
    } SEAM(3);
    if (IN(12)) { dn_fold(F); swa_phase(F, 1, F.G < NFOLD ? F.G : NFOLD); }
#if defined(REPEAT_PHASE) && REPEAT_PHASE == 12
    if (IN(12)) { dn_fold(F); swa_phase(F, 1, F.G < NFOLD ? F.G : NFOLD); }
#endif
#if defined(REPEAT_PHASE) && REPEAT_PHASE == 112
    if (IN(12)) { dn_fold(F); }
#endif
#if defined(REPEAT_PHASE) && REPEAT_PHASE == 212
    if (IN(12)) { swa_phase(F, 0, F.G); }
#endif
    if (IN(12) && IN(13)) xcd_barrier(bar);
    TSP();
    if (IN(13)) { dn_pass3(F); swa_phase(F, 0, 0);
#if defined(REPEAT_PHASE) && REPEAT_PHASE == 13
        dn_pass3(F);
#endif
    } if (IN(13) && IN(4)) xcd_barrier(bar);
    TSP();
    if (IN(4)) { dn_combine(F);
#if defined(REPEAT_PHASE) && REPEAT_PHASE == 4
        dn_combine(F);
#endif
    } SEAM(4);
    if (IN(5)) {
        pg8::Gemm g{WSP(bf16, WS_XB), WSP(bf16, WS_WOUT), SEQ, DM, DM}; pg8::StaticOrder S; S.init(SEQ, DM, F.G, (int)blockIdx.x);
        EpiRes E{F.in[0], nullptr, nullptr, WSP(bf16, WS_H1B), sumsq2, (LAS float*)(F.lds + RING_BYTES)};
        pg8::gemm_phase<EpiRes, pg8::StaticOrder, true, true>(F.lds + RING_OFF, g, S, E);
#if defined(REPEAT_PHASE) && REPEAT_PHASE == 5
        { EpiRes E2{F.in[0], nullptr, nullptr, nullptr, (float*)(F.ws + WS_CTL + 448 * 1024), (LAS float*)(F.lds + RING_BYTES)}; pg8::gemm_phase<EpiRes, pg8::StaticOrder, true, true>(F.lds + RING_OFF, g, S, E2); }
#endif
    } SEAM(5);
    if (IN(6)) {
        pg8::Gemm g{WSP(bf16, WS_H1B), WSP(bf16, WS_WQ), SEQ, 512, DM}; pg8::StaticOrder S; S.init(SEQ, 512, F.G, (int)blockIdx.x);
        EpiScaleBf16 E{sumsq2, 1, QSCALE, WSP(bf16, WS_QM), 512};
        pg8::gemm_phase<EpiScaleBf16, pg8::StaticOrder, true, true>(F.lds + RING_OFF, g, S, E);
        { pg8::Gemm g2{WSP(bf16, WS_MEMB), WSP(bf16, WS_WKV), MEMT, 1024, DM}; pg8::StaticOrder S2; S2.init(MEMT, 1024, F.G, (int)((blockIdx.x + F.G - (F.G >> 1)) % F.G));
          EpiScaleBf16 E2{WSP(float, WS_RSTDM), 0, 1.0f, WSP(bf16, WS_KVM), 1024};
          pg8::gemm_phase<EpiScaleBf16, pg8::StaticOrder, true, true>(F.lds + RING_OFF, g2, S2, E2); }
        p4_transposes(F, 0, F.G);
#if defined(REPEAT_PHASE) && REPEAT_PHASE == 6
        pg8::gemm_phase<EpiScaleBf16, pg8::StaticOrder, true, true>(F.lds + RING_OFF, g, S, E);
#endif
    } SEAM(6);
    if (IN(7)) { mem_attn_phase(F);
#if defined(REPEAT_PHASE) && REPEAT_PHASE == 7
        mem_attn_phase(F);
#endif
    } SEAM(7);
    if (IN(8)) {
        pg8::Gemm g{WSP(bf16, WS_OM), WSP(bf16, WS_WO), SEQ, DM, 512}; pg8::StaticOrder S; S.init(SEQ, DM, F.G, (int)blockIdx.x);
        EpiRes E{nullptr, WSP(bf16, WS_H1B), nullptr, WSP(bf16, WS_XB), sumsq3, (LAS float*)(F.lds + RING_BYTES)};
        pg8::gemm_phase<EpiRes, pg8::StaticOrder, true, true>(F.lds + RING_OFF, g, S, E);
#if defined(REPEAT_PHASE) && REPEAT_PHASE == 8
        { EpiRes E2{nullptr, WSP(bf16, WS_H1B), nullptr, nullptr, (float*)(F.ws + WS_CTL + 448 * 1024), (LAS float*)(F.lds + RING_BYTES)}; pg8::gemm_phase<EpiRes, pg8::StaticOrder, true, true>(F.lds + RING_OFF, g, S, E2); }
#endif
    } SEAM(8);
    if (IN(9)) {
        pg8::Gemm g{WSP(bf16, WS_XB), WSP(bf16, WS_WGU), SEQ, 2 * DFF, DM}; pg8::StaticOrder S; S.init(SEQ, 2 * DFF, F.G, (int)blockIdx.x);
        EpiSwiglu E{sumsq3, WSP(bf16, WS_HID)};
        pg8::gemm_phase<EpiSwiglu, pg8::StaticOrder, true, true>(F.lds + RING_OFF, g, S, E);
#if defined(REPEAT_PHASE) && REPEAT_PHASE == 9
        pg8::gemm_phase<EpiSwiglu, pg8::StaticOrder, true, true>(F.lds + RING_OFF, g, S, E);
#endif
    } SEAM(9);
    if (IN(10)) {
        pg8::Gemm g{WSP(bf16, WS_HID), WSP(bf16, WS_WD), SEQ, DM, DFF}; pg8::StaticOrder S; S.init(SEQ, DM, F.G, (int)blockIdx.x);
        EpiRes E{nullptr, WSP(bf16, WS_XB), nullptr, WSP(bf16, WS_H3B), sumsq4, (LAS float*)(F.lds + RING_BYTES)};
        pg8::gemm_phase<EpiRes, pg8::StaticOrder, true, true>(F.lds + RING_OFF, g, S, E);
#if defined(REPEAT_PHASE) && REPEAT_PHASE == 10
        { EpiRes E2{nullptr, WSP(bf16, WS_XB), nullptr, nullptr, (float*)(F.ws + WS_CTL + 448 * 1024), (LAS float*)(F.lds + RING_BYTES)}; pg8::gemm_phase<EpiRes, pg8::StaticOrder, true, true>(F.lds + RING_OFF, g, S, E2); }
#endif
    } SEAM(10);
#if defined(REPEAT_PHASE) && REPEAT_PHASE == 99
    for (int k_ = 0; k_ < 10; ++k_) xcd_barrier(bar);
#endif
    if (IN(11)) { final_norm(F);
#if defined(REPEAT_PHASE) && REPEAT_PHASE == 11
        final_norm(F);
#endif
    }
    TSP();
#ifdef TS_IDX
    __syncthreads();
    if (blockIdx.x == 0 && F.tid == 0) F.out[0] += (float)(ts_b - ts_a) * TS_SCALE;
#endif
#undef IN
#undef SEAM
}

extern "C" void kernel_launch(void* const* d_in, const int* in_sizes, int n_in, void* d_out, int out_size, void* d_ws, size_t ws_size, hipStream_t stream) {
    static int grid = 0;
    if (grid == 0) {
        if (n_in != 23 || out_size != SEQ * DM || ws_size < WS_END) { fprintf(stderr, "kernel_launch: unexpected shapes (n_in %d out %d ws %zu)\n", n_in, out_size, ws_size); grid = -1; return; }
        int dev = 0, cus = 0;
        if (hipGetDevice(&dev) != hipSuccess || hipDeviceGetAttribute(&cus, hipDeviceAttributeMultiprocessorCount, dev) != hipSuccess) { grid = -1; return; }
        if (hipFuncSetAttribute((const void*)enc_fwd, hipFuncAttributeMaxDynamicSharedMemorySize, LDS_BYTES) != hipSuccess) { fprintf(stderr, "kernel_launch: hipFuncSetAttribute failed\n"); grid = -1; return; }
        (void)hipGetLastError();
        grid = cus;
    }
    if (grid < 0) return;
    if (hipMemsetAsync((char*)d_ws + WS_CTL, 0, CTL_ZERO_BYTES, stream) != hipSuccess) return;
    Args a{};
    for (int i = 0; i < 23; ++i) a.in[i] = (const float*)d_in[i];
    a.out = (float*)d_out; a.ws = (unsigned char*)d_ws;
    const int per = (N_PHASES + MK_N_LAUNCHES - 1) / MK_N_LAUNCHES;
    for (int lo = 0; lo < N_PHASES; lo += per) {
        a.ph_lo = lo; a.ph_hi = (lo + per < N_PHASES) ? lo + per : N_PHASES;
        hipLaunchKernelGGL(enc_fwd, dim3(grid), dim3(NWAVES * 64), LDS_BYTES, stream, a);
    }
}
```

```cpp
#include <hip/hip_runtime.h>
#include <cstdio>
#include <cstdint>
namespace pg8 {
__device__ __forceinline__ unsigned cvt_pk_bf16(float lo, float hi) { unsigned r; asm volatile("v_cvt_pk_bf16_f32 %0, %1, %2" : "=v"(r) : "v"(lo), "v"(hi)); return r; }
#define PG8_LAS __attribute__((address_space(3)))
typedef unsigned short bf16_t;
typedef short bf16x8 __attribute__((ext_vector_type(8)));
typedef float f32x4 __attribute__((ext_vector_type(4)));
typedef unsigned u32x4 __attribute__((ext_vector_type(4)));
constexpr int BM = 256, BK = 64, HALF = 128, HTB = HALF * BK * 2  , STAGE_BYTES = 8 * HTB, NXCD = 8, WGM = 8;

__host__ __device__ __forceinline__ int lds_byte(int r, int c) { const int st = (r >> 4) * 2 + (c >> 5), rr = r & 15, cc = c & 31, ob = rr * 64 + cc * 2; return st * 1024 + (ob ^ (((ob >> 9) & 1) << 5)); }
__host__ __device__ __forceinline__ void stage_rc(int b, int& R, int& C) { const int st = b / 1024, sb = b % 1024, swz = sb ^ (((sb >> 9) & 1) << 5); R = (st >> 1) * 16 + swz / 64; C = (st & 1) * 32 + (swz % 64) / 2; }
__host__ __device__ __forceinline__ int perm32(int rho) { const int n = rho >> 4, i = rho & 15; return 8 * (i >> 2) + 4 * n + (i & 3); }

struct Unit { int pm, pn; };
struct Gemm { const bf16_t* A; const bf16_t* Bt; int M, N, K; };

struct StaticOrder {
    int nM, nN, nwg, G, c;
    __host__ __device__ void init(int M, int N, int G_, int c_) { nM = M / BM; nN = N / BM; nwg = nM * nN; G = G_; c = c_; }
    __host__ __device__ bool next(int i, Unit& u) const {
        const long L = (long)i * G + c; if (L >= nwg) return false;
        int wgid = (int)L; { const int q = nwg / NXCD, r = nwg % NXCD, xcd = wgid % NXCD, off = wgid / NXCD; wgid = (xcd < r ? xcd * (q + 1) : r * (q + 1) + (xcd - r) * q) + off; }
        const int nig = WGM * nN, gid = wgid / nig, fm = gid * WGM, gsz = (nM - fm) < WGM ? (nM - fm) : WGM;
        u.pm = fm + ((wgid % nig) % gsz); u.pn = (wgid % nig) / gsz; return true;
    }
    __device__ __forceinline__ void a_ready(const Unit&) const {}
    __device__ __forceinline__ void done(const Unit&) const {}
};

template <class Epi, class Sched, bool ALIGN_EPI = false, bool SP2 = false>
__device__ __forceinline__ void gemm_phase(PG8_LAS unsigned char* lds, const Gemm g, const Sched& S, const Epi& E) {
    const int tid = threadIdx.x, wid = __builtin_amdgcn_readfirstlane(tid >> 6), lane = tid & 63, wr = wid >> 2, wc = wid & 3, fr = lane & 15, fq = lane >> 4;
    const int K = g.K, nt = K / BK;
    unsigned voffA[2], voffB[2];
#pragma unroll
    for (int i = 0; i < 2; ++i) { int R, C; stage_rc(tid * 16 + i * 8192, R, C); const int Rb = Epi::PERM ? ((R & ~31) + perm32(R & 31)) : R;
        voffA[i] = (unsigned)(R * K + C) * 2u; voffB[i] = (unsigned)(Rb * K + C) * 2u; }
    const size_t kstep = (size_t)(BK * 2);
    const size_t hstep = (size_t)HALF * K * 2;
    const size_t tstep = 2 * hstep;
    const unsigned ldsw = (unsigned)wid * 1024u;
    const int aoff = lds_byte(wr * 64 + fr, fq * 8), boff = lds_byte(wc * 32 + fr, fq * 8);
#define PG8_SA(b, h) (((b) * 2 + (h)) * HTB)
#define PG8_SB(b, h) ((4 + (b) * 2 + (h)) * HTB)
#define PG8_STAGE(bufoff, gbase, voff) do { _Pragma("unroll") for (int _i = 0; _i < 2; ++_i) \
        __builtin_amdgcn_global_load_lds((const unsigned*)((const char*)(gbase) + (voff)[_i]), (PG8_LAS unsigned*)(lds + (bufoff) + ldsw + _i * 8192), 16, 0, 0); } while (0)
#define PG8_LDA(dst, b, h) do { _Pragma("unroll") for (int m = 0; m < 4; ++m) _Pragma("unroll") for (int k = 0; k < 2; ++k) dst[m][k] = *(const PG8_LAS bf16x8*)(lds + PG8_SA(b, h) + aoff + m * 2048 + k * 1024); } while (0)
#define PG8_LDB(dst, b, h) do { _Pragma("unroll") for (int n = 0; n < 2; ++n) _Pragma("unroll") for (int k = 0; k < 2; ++k) dst[n][k] = *(const PG8_LAS bf16x8*)(lds + PG8_SB(b, h) + boff + n * 2048 + k * 1024); } while (0)
#define PG8_MMA(ai, bj, At, Bt) do { __builtin_amdgcn_s_setprio(1); _Pragma("unroll") for (int m = 0; m < 4; ++m) _Pragma("unroll") for (int n = 0; n < 2; ++n) _Pragma("unroll") for (int k = 0; k < 2; ++k) \
        acc[ai][bj][m][n] = __builtin_amdgcn_mfma_f32_16x16x32_bf16(Bt[n][k], At[m][k], acc[ai][bj][m][n], 0, 0, 0); __builtin_amdgcn_s_setprio(0); } while (0)
#define PG8_WAIT_V(n) asm volatile("s_waitcnt vmcnt(" #n ")" ::: "memory")
#define PG8_WAIT_L(n) asm volatile("s_waitcnt lgkmcnt(" #n ")" ::: "memory")
#define PG8_BAR __builtin_amdgcn_s_barrier()
#define PG8_SCHED __builtin_amdgcn_sched_barrier(0)
    Unit cur, nxt; int ui = 0;
    if (!S.next(0, cur)) return;
    f32x4 acc[2][2][4][2];
#pragma unroll
    for (int a = 0; a < 2; ++a)
#pragma unroll
        for (int b = 0; b < 2; ++b)
#pragma unroll
            for (int m = 0; m < 4; ++m)
#pragma unroll
                for (int n = 0; n < 2; ++n) acc[a][b][m][n] = (f32x4){0.f, 0.f, 0.f, 0.f};
    bf16x8 At[4][2], B0[2][2], B1[2][2];
    const char* cA = (const char*)g.A + (size_t)cur.pm * tstep; const char* cB = (const char*)g.Bt + (size_t)cur.pn * tstep;
    S.a_ready(cur);
    if constexpr (SP2) {
        PG8_STAGE(PG8_SB(0, 0), cB, voffB); PG8_STAGE(PG8_SB(0, 1), cB + hstep, voffB); PG8_STAGE(PG8_SA(0, 0), cA, voffA); PG8_STAGE(PG8_SA(0, 1), cA + hstep, voffA);
        if (wr == 1) PG8_BAR;
        PG8_WAIT_V(2); PG8_BAR;
        PG8_STAGE(PG8_SB(1, 0), cB + kstep, voffB); PG8_STAGE(PG8_SA(1, 0), cA + kstep, voffA); PG8_STAGE(PG8_SB(1, 1), cB + hstep + kstep, voffB);
        PG8_WAIT_V(6); PG8_BAR;
    } else {
        PG8_STAGE(PG8_SB(0, 0), cB, voffB); PG8_STAGE(PG8_SA(0, 0), cA, voffA); PG8_STAGE(PG8_SB(0, 1), cB + hstep, voffB); PG8_STAGE(PG8_SA(0, 1), cA + hstep, voffA);
        if (wr == 1) PG8_BAR;
        PG8_WAIT_V(4); PG8_BAR;
        PG8_STAGE(PG8_SB(1, 0), cB + kstep, voffB); PG8_STAGE(PG8_SA(1, 0), cA + kstep, voffA); PG8_STAGE(PG8_SB(1, 1), cB + hstep + kstep, voffB);
        PG8_WAIT_V(6); PG8_BAR;
    }
    for (;;) {
        const bool has_next = S.next(ui + 1, nxt);
        const char* nA = has_next ? (const char*)g.A + (size_t)nxt.pm * tstep : cA; const char* nB = has_next ? (const char*)g.Bt + (size_t)nxt.pn * tstep : cB;
        for (int t = 0; t < nt; t += 2) {
            const bool last = (t == nt - 2);
            const char* a1 = cA + (size_t)(t + 1) * kstep;
            const char* a2 = last ? nA : cA + (size_t)(t + 2) * kstep; const char* b2 = last ? nB : cB + (size_t)(t + 2) * kstep;
            const char* a3 = a2 + kstep; const char* b3 = b2 + kstep;
            if (last && has_next) S.a_ready(nxt);
            if constexpr (SP2) {
            PG8_LDB(B0, 0, 0); PG8_LDB(B1, 0, 1); PG8_SCHED; PG8_LDA(At, 0, 0); PG8_STAGE(PG8_SA(1, 1), a1 + hstep, voffA);
            PG8_WAIT_V(8); PG8_WAIT_L(0); PG8_BAR; PG8_MMA(0, 0, At, B0); PG8_MMA(0, 1, At, B1); PG8_BAR; PG8_SCHED;
            PG8_LDA(At, 0, 1); PG8_STAGE(PG8_SB(0, 0), b2, voffB); PG8_STAGE(PG8_SB(0, 1), b2 + hstep, voffB); PG8_STAGE(PG8_SA(0, 0), a2, voffA);
            PG8_WAIT_V(8); PG8_WAIT_L(0); PG8_BAR; PG8_MMA(1, 0, At, B0); PG8_MMA(1, 1, At, B1); PG8_BAR; PG8_SCHED;
            PG8_LDB(B0, 1, 0); PG8_LDB(B1, 1, 1); PG8_SCHED; PG8_LDA(At, 1, 0); PG8_STAGE(PG8_SA(0, 1), a2 + hstep, voffA);
            PG8_WAIT_V(8); PG8_WAIT_L(0); PG8_BAR; PG8_MMA(0, 0, At, B0); PG8_MMA(0, 1, At, B1); PG8_BAR; PG8_SCHED;
            PG8_LDA(At, 1, 1); PG8_STAGE(PG8_SB(1, 0), b3, voffB); PG8_STAGE(PG8_SB(1, 1), b3 + hstep, voffB); PG8_STAGE(PG8_SA(1, 0), a3, voffA);
            PG8_WAIT_V(8); PG8_WAIT_L(0); PG8_BAR; PG8_MMA(1, 0, At, B0); PG8_MMA(1, 1, At, B1); PG8_BAR; PG8_SCHED;
            } else {
            PG8_LDB(B0, 0, 0); PG8_SCHED; PG8_LDA(At, 0, 0); PG8_STAGE(PG8_SA(1, 1), a1 + hstep, voffA);
            PG8_WAIT_L(8); PG8_BAR; PG8_WAIT_L(0); PG8_MMA(0, 0, At, B0); PG8_BAR; PG8_SCHED;
            PG8_LDB(B1, 0, 1); PG8_STAGE(PG8_SB(0, 0), b2, voffB);
            PG8_BAR; PG8_WAIT_L(0); PG8_MMA(0, 1, At, B1); PG8_BAR;
            PG8_LDA(At, 0, 1); PG8_STAGE(PG8_SA(0, 0), a2, voffA);
            PG8_BAR; PG8_WAIT_L(0); PG8_MMA(1, 0, At, B0); PG8_BAR; PG8_SCHED;
            PG8_STAGE(PG8_SB(0, 1), b2 + hstep, voffB);
            PG8_WAIT_V(6); PG8_BAR; PG8_MMA(1, 1, At, B1); PG8_BAR;
            PG8_LDB(B0, 1, 0); PG8_SCHED; PG8_LDA(At, 1, 0); PG8_STAGE(PG8_SA(0, 1), a2 + hstep, voffA);
            PG8_WAIT_L(8); PG8_BAR; PG8_WAIT_L(0); PG8_MMA(0, 0, At, B0); PG8_BAR; PG8_SCHED;
            PG8_LDB(B1, 1, 1); PG8_STAGE(PG8_SB(1, 0), b3, voffB);
            PG8_BAR; PG8_WAIT_L(0); PG8_MMA(0, 1, At, B1); PG8_BAR;
            PG8_LDA(At, 1, 1); PG8_STAGE(PG8_SA(1, 0), a3, voffA);
            PG8_BAR; PG8_WAIT_L(0); PG8_MMA(1, 0, At, B0); PG8_BAR; PG8_SCHED;
            PG8_STAGE(PG8_SB(1, 1), b3 + hstep, voffB);
            PG8_WAIT_V(6); PG8_BAR; PG8_MMA(1, 1, At, B1); PG8_BAR;
            }
        }
        if constexpr (ALIGN_EPI) { if (wr == 0) PG8_BAR; }
        if constexpr (!Epi::AFTER_DRAIN) { E(acc, cur, wr, wc, fr, fq); S.done(cur); }
        if (!has_next) break;
#pragma unroll
        for (int a = 0; a < 2; ++a)
#pragma unroll
            for (int b = 0; b < 2; ++b)
#pragma unroll
                for (int m = 0; m < 4; ++m)
#pragma unroll
                    for (int n = 0; n < 2; ++n) acc[a][b][m][n] = (f32x4){0.f, 0.f, 0.f, 0.f};
        cur = nxt; cA = nA; cB = nB; ++ui;
        if constexpr (ALIGN_EPI) { if (wr == 1) PG8_BAR; }
    }
    PG8_WAIT_V(0);
    if constexpr (!ALIGN_EPI) { if (wr == 0) PG8_BAR; }
    PG8_BAR;
    if constexpr (Epi::AFTER_DRAIN) { E.fused(acc, cur, wr, wc, fr, fq, lds, wid, lane); S.done(cur); }
#undef PG8_SA
#undef PG8_SB
#undef PG8_STAGE
#undef PG8_LDA
#undef PG8_LDB
#undef PG8_MMA
#undef PG8_WAIT_V
#undef PG8_WAIT_L
#undef PG8_BAR
#undef PG8_SCHED
}
}

constexpr int NWAVES = 8;
constexpr int SEQ = 16384, DM = 2048, NIN = 5664, NINP = 5888, DFF = 5632;
constexpr int DNH = 8, HD = 128, SWH = 8, MEMH = 4, MEMT = 256;
constexpr float RMS_EPS = 1e-6f;
constexpr float LOG2E = 1.4426950408889634f;
constexpr float QSCALE = 0.08838834764831845f * 1.4426950408889634f;

constexpr size_t MiB = 1u << 20;
constexpr size_t WS_CTL = 0, CTL_ZERO_BYTES = 1 * MiB;
constexpr size_t CTL_SUMSQ2 = 256 * 1024, CTL_SUMSQ3 = 320 * 1024, CTL_SUMSQ4 = 384 * 1024;
constexpr size_t WS_RSTD1 = 1 * MiB, WS_RSTDM = 1 * MiB + 64 * 1024;
constexpr size_t WS_MEMB = 2 * MiB, WS_KVM = 3 * MiB, WS_AB = 4 * MiB, WS_BG = 6 * MiB;
constexpr size_t WS_WOUT = 8 * MiB, WS_WQ = 16 * MiB, WS_WKV = 18 * MiB, WS_WO = 22 * MiB, WS_WIN = 24 * MiB;
constexpr size_t WS_XB = 48 * MiB;
constexpr size_t WS_QKV = 112 * MiB;
constexpr size_t WS_H3B = 112 * MiB;
constexpr size_t WS_OF = 112 * MiB, WS_OB = 144 * MiB, WS_H1B = 112 * MiB, WS_QM = 176 * MiB, WS_OM = 192 * MiB;
constexpr size_t WS_DNX = 208 * MiB;
constexpr size_t WS_WGU = 208 * MiB, WS_WD = 252 * MiB, WS_HID = 274 * MiB, WS_END = 496 * MiB;
constexpr size_t DO_Z = 0, DO_QSW = 32 * MiB, DO_KVSW = 64 * MiB;
constexpr int CW_BAR = 4096, CW_SWAQ = 8192, CW_FOLDDONE = 8256, CW_TRQ = 8320;

constexpr int RING_OFF = 0, RING_BYTES = 131072;
constexpr int LDS_BYTES = 163840;
constexpr int LDSCTL_OFF = LDS_BYTES - 512, MISC_OFF = LDSCTL_OFF + 320;

#define GAS __attribute__((address_space(1)))
#define LAS __attribute__((address_space(3)))
typedef unsigned short bf16;
typedef unsigned v4u __attribute__((ext_vector_type(4)));
typedef unsigned v2u __attribute__((ext_vector_type(2)));
typedef float f32x4 __attribute__((ext_vector_type(4)));
typedef short bf16x8 __attribute__((ext_vector_type(8)));
typedef short s16x4 __attribute__((ext_vector_type(4)));
typedef GAS unsigned gu32;
#define RLX_AGENT __ATOMIC_RELAXED, __HIP_MEMORY_SCOPE_AGENT
#define LDS_WAIT() asm volatile("s_waitcnt lgkmcnt(0)" ::: "memory")
#define VM_WAIT() asm volatile("s_waitcnt vmcnt(0)" ::: "memory")
__device__ __forceinline__ unsigned f2bf(float f) { unsigned u = __builtin_bit_cast(unsigned, f); return (u + 0x7fffu + ((u >> 16) & 1u)) >> 16; }
__device__ __forceinline__ unsigned pk2(float lo, float hi) { return f2bf(lo) | (f2bf(hi) << 16); }
__device__ __forceinline__ float bf2f(unsigned short b) { return __builtin_bit_cast(float, (unsigned)b << 16); }
__device__ __forceinline__ float bflo(unsigned w) { return __builtin_bit_cast(float, w << 16); }
__device__ __forceinline__ float bfhi(unsigned w) { return __builtin_bit_cast(float, w & 0xffff0000u); }
typedef float f32x2_t __attribute__((ext_vector_type(2))); typedef __bf16 bf16x2_t __attribute__((ext_vector_type(2)));
__device__ __forceinline__ unsigned cvtpk(float lo, float hi) { f32x2_t v = {lo, hi}; bf16x2_t b = __builtin_convertvector(v, bf16x2_t); return __builtin_bit_cast(unsigned, b); }
__device__ __forceinline__ float wave_sum(float v) {
#pragma unroll
    for (int o = 1; o < 64; o <<= 1) v += __shfl_xor(v, o);
    return v;
}
__device__ __forceinline__ float siluf(float x) { return x * __builtin_amdgcn_rcpf(1.0f + __expf(-x)); }
#define XB_TMO      128
#define XB_XCNT(j)  (256  + 64 * (j))
#define XB_XSUB(j)  (1280 + 64 * (j))
#define XB_XGEN(j)  (2304 + 64 * (j))
#define XB_TOP      3328
#define XB_TOPGEN   3392
#define XCD_BAR_WORDS 3456
#define XB_SPIN_CAP (1u << 18)

__device__ __forceinline__ unsigned xb_ld(unsigned* p)              { return __hip_atomic_load(p, __ATOMIC_RELAXED, __HIP_MEMORY_SCOPE_AGENT); }
__device__ __forceinline__ unsigned xb_add(unsigned* p, unsigned v) { return __hip_atomic_fetch_add(p, v, __ATOMIC_RELAXED, __HIP_MEMORY_SCOPE_AGENT); }
__device__ __forceinline__ unsigned xb_xcc_id() { return (unsigned)__builtin_amdgcn_s_getreg((3 << 11) | 20) & 0xFu; }
#define XB_SPIN(cond, bar) do { unsigned _sp = 0; while (cond) { __builtin_amdgcn_s_sleep(1); \
    if ((++_sp & 255u) == 0u) { if (xb_ld(&(bar)[XB_TMO])) break; if (_sp > XB_SPIN_CAP) { atomicAdd(&(bar)[XB_TMO], 1u); break; } } } } while (0)

struct XcdBarrier {
    unsigned* bar; unsigned x;
    volatile LAS unsigned* st;
};

__device__ __forceinline__ XcdBarrier xcd_barrier_post(unsigned* bar, volatile LAS unsigned* st) {
    XcdBarrier b; b.bar = bar; b.x = xb_xcc_id(); b.st = st;
    if (threadIdx.x == 0) (void)xb_add(&bar[XB_XCNT(b.x)], 1u);
    return b;
}
__device__ __forceinline__ void xcd_barrier_complete(unsigned* bar, unsigned x, unsigned& nloc, unsigned& nx) {
    const unsigned G = gridDim.x * gridDim.y * gridDim.z;
    unsigned sum, cnt, mine, sp = 0u;
    for (;;) {
        sum = 0u; cnt = 0u; mine = 0u;
#pragma unroll
        for (unsigned j = 0; j < 16; ++j) { const unsigned c = xb_ld(&bar[XB_XCNT(j)]); sum += c; cnt += (c > 0u) ? 1u : 0u; mine = (j == x) ? c : mine; }
        if (sum == G) break;
        __builtin_amdgcn_s_sleep(1);
        if ((++sp & 255u) == 0u) { if (xb_ld(&bar[XB_TMO])) break; if (sp > XB_SPIN_CAP) { atomicAdd(&bar[XB_TMO], 1u); break; } }
    }
    nloc = mine > 0u ? mine : 1u; nx = cnt > 0u ? cnt : 1u;
}

__device__ __forceinline__ void xcd_barrier(const XcdBarrier& b) {
    asm volatile("s_waitcnt vmcnt(0)" ::: "memory");
    __syncthreads();
    if (threadIdx.x == 0) {
        unsigned* bar = b.bar;
        __builtin_amdgcn_s_waitcnt(0);
        unsigned nloc = b.st[0], nx = b.st[1];
        if (nloc == 0u) { xcd_barrier_complete(bar, b.x, nloc, nx); b.st[0] = nloc; b.st[1] = nx; }
        const unsigned old = xb_add(&bar[XB_XSUB(b.x)], 1u);
        const unsigned gen = old / nloc;
        if (old + 1u == (gen + 1u) * nloc) {
            __builtin_amdgcn_fence(__ATOMIC_RELEASE, "agent");
            asm volatile("s_waitcnt vmcnt(0)" ::: "memory");
            const unsigned og = xb_add(&bar[XB_TOP], 1u);
            const unsigned tg = og / nx;
            if (og + 1u == (tg + 1u) * nx) xb_add(&bar[XB_TOPGEN], 1u);
            else XB_SPIN(xb_ld(&bar[XB_TOPGEN]) == tg, bar);
            __builtin_amdgcn_fence(__ATOMIC_ACQUIRE, "agent");
            xb_add(&bar[XB_XGEN(b.x)], 1u);
            asm volatile("s_waitcnt vmcnt(0)" ::: "memory");
        } else {
            XB_SPIN(xb_ld(&bar[XB_XGEN(b.x)]) == gen, bar);
            __builtin_amdgcn_fence(__ATOMIC_ACQUIRE, "agent");
            asm volatile("s_waitcnt vmcnt(0)" ::: "memory");
        }
    }
    __syncthreads();
}

using pg8::Unit;
__device__ __forceinline__ v4u pack8(f32x4 v0, f32x4 v1) { v4u w; w.x = cvtpk(v0[0], v0[1]); w.y = cvtpk(v0[2], v0[3]); w.z = cvtpk(v1[0], v1[1]); w.w = cvtpk(v1[2], v1[3]); return w; }

struct EpiProj {
    static constexpr bool PERM = true, AFTER_DRAIN = false;
    const float* rstd; bf16* qkv; bf16* z; bf16* qsw; bf16* kvsw; float* ab;
    __device__ __forceinline__ void operator()(const f32x4 (&acc)[2][2][4][2], const Unit& u, int wr, int wc, int fr, int fq) const {
        const int pn = u.pn; bf16* base; int ldc, colt; float sc = 1.f;
        if (pn < 12) { base = qkv; ldc = 3072; colt = pn * 256; }
        else if (pn < 16) { base = z; ldc = 1024; colt = (pn - 12) * 256; }
        else if (pn < 20) { base = qsw; ldc = 1024; colt = (pn - 16) * 256; sc = QSCALE; }
        else if (pn < 22) { base = kvsw; ldc = 512; colt = (pn - 20) * 256; }
        else { base = nullptr; ldc = 0; colt = 0; }
        const int row0 = u.pm * 256 + wr * 64 + fr, col0 = colt + wc * 32 + 8 * fq;
        float rsv[2][4];
#pragma unroll
        for (int ai = 0; ai < 2; ++ai)
#pragma unroll
            for (int m = 0; m < 4; ++m) rsv[ai][m] = rstd[row0 + ai * 128 + m * 16];
#pragma unroll
        for (int ai = 0; ai < 2; ++ai)
#pragma unroll
            for (int m = 0; m < 4; ++m) {
                const int row = row0 + ai * 128 + m * 16; const float rs = rsv[ai][m] * sc;
                if (base) {
                    bf16* rowp = base + (size_t)row * ldc + col0;
#pragma unroll
                    for (int bj = 0; bj < 2; ++bj) *(v4u*)(rowp + bj * 128) = pack8(acc[ai][bj][m][0] * rs, acc[ai][bj][m][1] * rs);
                } else if (wc == 0) {
                    float* rowp = ab + (size_t)row * 32 + 8 * fq;
                    *(f32x4*)(rowp) = acc[ai][0][m][0] * rs; *(f32x4*)(rowp + 4) = acc[ai][0][m][1] * rs;
                }
            }
    }
};
struct EpiScaleBf16 {
    static constexpr bool PERM = true, AFTER_DRAIN = false;
    const float* rs; int from_sumsq; float sc; bf16* O; int ldc;
    __device__ __forceinline__ void operator()(const f32x4 (&acc)[2][2][4][2], const Unit& u, int wr, int wc, int fr, int fq) const {
        const int row0 = u.pm * 256 + wr * 64 + fr, col0 = u.pn * 256 + wc * 32 + 8 * fq;
        float rsv[2][4];
#pragma unroll
        for (int ai = 0; ai < 2; ++ai)
#pragma unroll
            for (int m = 0; m < 4; ++m) rsv[ai][m] = rs[row0 + ai * 128 + m * 16];
#pragma unroll
        for (int ai = 0; ai < 2; ++ai)
#pragma unroll
            for (int m = 0; m < 4; ++m) {
                const int row = row0 + ai * 128 + m * 16; float r = rsv[ai][m];
                if (from_sumsq) r = __builtin_amdgcn_rsqf(r * (1.0f / DM) + RMS_EPS);
                r *= sc; bf16* rowp = O + (size_t)row * ldc + col0;
#pragma unroll
                for (int bj = 0; bj < 2; ++bj) *(v4u*)(rowp + bj * 128) = pack8(acc[ai][bj][m][0] * r, acc[ai][bj][m][1] * r);
            }
    }
};
struct EpiRes {
    static constexpr bool PERM = true, AFTER_DRAIN = false;
    const float* res; const bf16* resb; float* out; bf16* ob; float* sumsq; LAS float* part;
    __device__ __forceinline__ void tail(const f32x4 (&acc)[2][2][4][2], const f32x4 (&rr)[4][2][2], int ai, int row0, int col0, int fq, int prow0, int wc) const {
#pragma unroll
        for (int m = 0; m < 4; ++m) {
            const int row = row0 + ai * 128 + m * 16; const size_t off = (size_t)row * DM + col0; float ss = 0.f;
#pragma unroll
            for (int bj = 0; bj < 2; ++bj) {
                const f32x4 v0 = acc[ai][bj][m][0] + rr[m][bj][0], v1 = acc[ai][bj][m][1] + rr[m][bj][1];
                if (out) { *(f32x4*)(out + off + bj * 128) = v0; *(f32x4*)(out + off + bj * 128 + 4) = v1; }
                if (ob) *(v4u*)(ob + off + bj * 128) = pack8(v0, v1);
                ss += (v0[0] * v0[0] + v0[1] * v0[1]) + (v0[2] * v0[2] + v0[3] * v0[3]) + (v1[0] * v1[0] + v1[1] * v1[1]) + (v1[2] * v1[2] + v1[3] * v1[3]);
            }
            ss += __shfl_xor(ss, 16); ss += __shfl_xor(ss, 32);
            if (fq == 0) part[(prow0 + ai * 128 + m * 16) * 4 + wc] = ss;
        }
    }
    __device__ __forceinline__ void finish(const Unit& u) const {
        asm volatile("s_waitcnt lgkmcnt(0)" ::: "memory"); __builtin_amdgcn_s_barrier(); asm volatile("" ::: "memory");
        const int tid = threadIdx.x, lane = tid & 63, w = tid >> 6;
        if (lane < 32) { const int r = 32 * w + lane; const f32x4 v = *(const LAS f32x4*)(part + r * 4); atomicAdd(sumsq + u.pm * 256 + r, (v[0] + v[1]) + (v[2] + v[3])); }
        asm volatile("s_waitcnt lgkmcnt(0)" ::: "memory"); __builtin_amdgcn_s_barrier(); asm volatile("" ::: "memory");
    }
    __device__ __forceinline__ void operator()(const f32x4 (&acc)[2][2][4][2], const Unit& u, int wr, int wc, int fr, int fq) const {
        const int row0 = u.pm * 256 + wr * 64 + fr, col0 = u.pn * 256 + wc * 32 + 8 * fq, prow0 = wr * 64 + fr;
        if (resb) {
#pragma unroll
            for (int ai = 0; ai < 2; ++ai) {
                v4u rb[4][2]; f32x4 rr[4][2][2];
#pragma unroll
                for (int m = 0; m < 4; ++m) { const size_t off = (size_t)(row0 + ai * 128 + m * 16) * DM + col0;
#pragma unroll
                    for (int bj = 0; bj < 2; ++bj) rb[m][bj] = *(const v4u*)(resb + off + bj * 128); }
                asm volatile("" ::: "memory");
#pragma unroll
                for (int m = 0; m < 4; ++m)
#pragma unroll
                    for (int bj = 0; bj < 2; ++bj) { const v4u w = rb[m][bj]; rr[m][bj][0] = (f32x4){bflo(w.x), bfhi(w.x), bflo(w.y), bfhi(w.y)}; rr[m][bj][1] = (f32x4){bflo(w.z), bfhi(w.z), bflo(w.w), bfhi(w.w)}; }
                tail(acc, rr, ai, row0, col0, fq, prow0, wc);
                asm volatile("" ::: "memory");
            }
        } else {
#pragma unroll
            for (int ai = 0; ai < 2; ++ai) {
                f32x4 rr[4][2][2];
#pragma unroll
                for (int m = 0; m < 4; ++m) { const size_t off = (size_t)(row0 + ai * 128 + m * 16) * DM + col0;
#pragma unroll
                    for (int bj = 0; bj < 2; ++bj) { rr[m][bj][0] = *(const f32x4*)(res + off + bj * 128); rr[m][bj][1] = *(const f32x4*)(res + off + bj * 128 + 4); } }
                asm volatile("" ::: "memory");
                tail(acc, rr, ai, row0, col0, fq, prow0, wc);
                asm volatile("" ::: "memory");
            }
        }
        finish(u);
    }
};
struct EpiSwiglu {
    static constexpr bool PERM = true, AFTER_DRAIN = false;
    const float* sumsq; bf16* H;
    __device__ __forceinline__ void operator()(const f32x4 (&acc)[2][2][4][2], const Unit& u, int wr, int wc, int fr, int fq) const {
        const int row0 = u.pm * 256 + wr * 64 + fr, col0 = u.pn * 128 + wc * 32 + 8 * fq;
        float rsv[2][4];
#pragma unroll
        for (int ai = 0; ai < 2; ++ai)
#pragma unroll
            for (int m = 0; m < 4; ++m) rsv[ai][m] = sumsq[row0 + ai * 128 + m * 16];
#pragma unroll
        for (int ai = 0; ai < 2; ++ai)
#pragma unroll
            for (int m = 0; m < 4; ++m) {
                const int row = row0 + ai * 128 + m * 16; const float r = __builtin_amdgcn_rsqf(rsv[ai][m] * (1.0f / DM) + RMS_EPS);
                f32x4 h[2];
#pragma unroll
                for (int n = 0; n < 2; ++n)
#pragma unroll
                    for (int e = 0; e < 4; ++e) { const float g = acc[ai][0][m][n][e] * r, up = acc[ai][1][m][n][e] * r; h[n][e] = siluf(g) * up; }
                *(v4u*)(H + (size_t)row * DFF + col0) = pack8(h[0], h[1]);
            }
    }
};

struct Frame {
    LAS unsigned char* lds;
    volatile LAS unsigned* MISC;
    gu32* ctl;
    int tid, lane, wave, vcu, G;
    const float* in[23]; float* out; unsigned char* ws;
};
#define WSP(T, off) ((T*)(F.ws + (off)))
#define DOP(T, off) ((T*)((unsigned char*)F.out + (off)))

struct TrDesc { const float* W; const float* gain; bf16* WT; int K, Nsrc, src_col0, dst_row0, k0; };
constexpr int TR_SCR = 8704, TR_WAVE = 2 * TR_SCR;
__device__ __forceinline__ void tr_store(const TrDesc& D, const LAS float* scr, int lane) {
    const int c = lane & 7;
#pragma unroll
    for (int j = 0; j < 4; ++j) { const int n = (lane >> 3) + 8 * j; const LAS float* s = scr + (8 * c) * 33 + n;
        v4u o; o.x = pk2(s[0 * 33], s[1 * 33]); o.y = pk2(s[2 * 33], s[3 * 33]); o.z = pk2(s[4 * 33], s[5 * 33]); o.w = pk2(s[6 * 33], s[7 * 33]);
        *(GAS v4u*)(D.WT + (size_t)(D.dst_row0 + n) * D.K + D.k0 + 8 * c) = o; }
}
__device__ __forceinline__ void tr_pair(const TrDesc& A, const TrDesc& B, bool hasB, LAS float* scr, int lane) {
    const bool second = lane >= 32; const TrDesc& D = second ? B : A;
    const bool live = (!second || hasB) && D.src_col0 >= 0;
    LAS float* s = second ? (LAS float*)((LAS unsigned char*)scr + TR_SCR) : scr;
    const float* src = D.W + (size_t)D.k0 * D.Nsrc + (live ? D.src_col0 : 0) + (lane & 31);
    float v[64];
#pragma unroll
    for (int i = 0; i < 64; ++i) v[i] = live ? src[(size_t)i * D.Nsrc] : 0.f;
    if (D.gain) {
#pragma unroll
        for (int i = 0; i < 64; ++i) v[i] *= D.gain[D.k0 + i]; }
#pragma unroll
    for (int i = 0; i < 64; ++i) s[i * 33 + (lane & 31)] = v[i];
    LDS_WAIT(); asm volatile("" ::: "memory");
    tr_store(A, scr, lane); if (hasB) tr_store(B, (const LAS float*)((const LAS unsigned char*)scr + TR_SCR), lane);
    LDS_WAIT(); asm volatile("" ::: "memory");
}
__device__ __forceinline__ int win_src_col(int c) {
    if (c < 4096) return c;
    if (c < 5120) return c - 4096 + 4128;
    if (c < 5376) return c - 5120 + 5152;
    if (c < 5632) return c - 5376 + 5408;
    if (c < 5664) return c - 5632 + 4096;
    return -1;
}
__device__ __forceinline__ void row_to_bf16_rstd(const float* xrow, bf16* orow, float* rstd_out, int lane) {
    const GAS f32x4* xr = (const GAS f32x4*)xrow + lane;
    f32x4 v[8]; float s = 0.f;
#pragma unroll
    for (int j = 0; j < 8; ++j) { v[j] = xr[64 * j]; s += (v[j].x * v[j].x + v[j].y * v[j].y) + (v[j].z * v[j].z + v[j].w * v[j].w); }
    s = wave_sum(s);
    if (lane == 0) *rstd_out = 1.0f / sqrtf(s * (1.0f / DM) + RMS_EPS);
    GAS v2u* o8 = (GAS v2u*)orow + lane;
#pragma unroll
    for (int j = 0; j < 8; ++j) { v2u w; w.x = pk2(v[j].x, v[j].y); w.y = pk2(v[j].z, v[j].w); o8[64 * j] = w; }
}

__device__ __forceinline__ void p0_prologue(Frame& F) {
    LAS float* scr = (LAS float*)(F.lds + RING_OFF + F.wave * TR_WAVE);
    const int gw = F.vcu * NWAVES + F.wave, NGW = F.G * NWAVES;
    constexpr int I_IN = 32 * (NINP / 32), I_KV = 32 * 32;
    auto desc0 = [&](int r) { TrDesc D;
        if (r < I_IN) { const int nblk = NINP / 32, kb = r / nblk, nb = r % nblk; D = TrDesc{F.in[3], F.in[2], WSP(bf16, WS_WIN), DM, NIN, win_src_col(nb * 32), nb * 32, kb * 64}; }
        else { r -= I_IN; const int kb = r / 32, nb = r % 32; D = TrDesc{F.in[16], F.in[14], WSP(bf16, WS_WKV), DM, 1024, nb * 32, nb * 32, kb * 64}; }
        return D; };
    for (int it = 2 * gw; it < I_IN + I_KV; it += 2 * NGW) tr_pair(desc0(it), desc0(it + 1), true, scr, F.lane);
    for (int m = gw; m < SEQ; m += 2 * NGW) {
        const int m2 = m + NGW; const bool two = m2 < SEQ;
        const GAS f32x4* xa = (const GAS f32x4*)(F.in[0] + (size_t)m * DM) + F.lane; const GAS f32x4* xb_ = (const GAS f32x4*)(F.in[0] + (size_t)(two ? m2 : m) * DM) + F.lane;
        f32x4 va[8], vb[8]; float sa = 0.f, sb = 0.f;
#pragma unroll
        for (int j = 0; j < 8; ++j) { va[j] = xa[64 * j]; vb[j] = xb_[64 * j]; }
#pragma unroll
        for (int j = 0; j < 8; ++j) { sa += (va[j].x * va[j].x + va[j].y * va[j].y) + (va[j].z * va[j].z + va[j].w * va[j].w); sb += (vb[j].x * vb[j].x + vb[j].y * vb[j].y) + (vb[j].z * vb[j].z + vb[j].w * vb[j].w); }
        sa = wave_sum(sa); sb = wave_sum(sb);
        if (F.lane == 0) { WSP(float, WS_RSTD1)[m] = 1.0f / sqrtf(sa * (1.0f / DM) + RMS_EPS); if (two) WSP(float, WS_RSTD1)[m2] = 1.0f / sqrtf(sb * (1.0f / DM) + RMS_EPS); }
        GAS v2u* oa = (GAS v2u*)(WSP(bf16, WS_XB) + (size_t)m * DM) + F.lane; GAS v2u* ob = (GAS v2u*)(WSP(bf16, WS_XB) + (size_t)m2 * DM) + F.lane;
#pragma unroll
        for (int j = 0; j < 8; ++j) { v2u w; w.x = pk2(va[j].x, va[j].y); w.y = pk2(va[j].z, va[j].w); oa[64 * j] = w; }
        if (two) {
#pragma unroll
            for (int j = 0; j < 8; ++j) { v2u w; w.x = pk2(vb[j].x, vb[j].y); w.y = pk2(vb[j].z, vb[j].w); ob[64 * j] = w; } }
    }
    for (int m = gw; m < MEMT; m += NGW) row_to_bf16_rstd(F.in[1] + (size_t)m * DM, WSP(bf16, WS_MEMB) + (size_t)m * DM, WSP(float, WS_RSTDM) + m, F.lane);
}
__device__ __forceinline__ void p1_late_transposes(Frame& F, int b0, int nb) {
    if ((int)blockIdx.x < b0 || (int)blockIdx.x >= b0 + nb) return;
    LAS float* scr = (LAS float*)(F.lds + RING_OFF + F.wave * TR_WAVE);
    const int gw = ((int)blockIdx.x - b0) * NWAVES + F.wave, NGW = nb * NWAVES;
    constexpr int I_OUT = 32 * 64, I_Q = 32 * 16, I_O = 8 * 64;
    auto desc1 = [&](int r) { TrDesc D;
        if (r < I_OUT) { const int kb = r / 64, nb2 = r % 64; D = TrDesc{F.in[12], nullptr, WSP(bf16, WS_WOUT), DM, DM, nb2 * 32, nb2 * 32, kb * 64}; }
        else if (r < I_OUT + I_Q) { r -= I_OUT; const int kb = r / 16, nb2 = r % 16; D = TrDesc{F.in[15], F.in[13], WSP(bf16, WS_WQ), DM, 512, nb2 * 32, nb2 * 32, kb * 64}; }
        else { r -= I_OUT + I_Q; const int kb = r / 64, nb2 = r % 64; D = TrDesc{F.in[17], nullptr, WSP(bf16, WS_WO), 512, DM, nb2 * 32, nb2 * 32, kb * 64}; }
        return D; };
    for (int it = 2 * gw; it < I_OUT + I_Q + I_O; it += 2 * NGW) tr_pair(desc1(it), desc1(it + 1), true, scr, F.lane);
}
__device__ __forceinline__ void p4_transposes(Frame& F, int b0, int nb) {
    (void)b0; (void)nb;
    LAS float* scr = (LAS float*)(F.lds + RING_OFF + F.wave * TR_WAVE);
    constexpr int I_GU = 32 * (2 * DFF / 32), I_D = (DFF / 64) * 64, BATCH = 8 * NWAVES;
    unsigned* qctr = (unsigned*)(F.ctl + CW_TRQ);
    for (;;) {
        __syncthreads();
        if (F.tid == 0) F.MISC[13] = __hip_atomic_fetch_add(qctr, 1u, __ATOMIC_RELAXED, __HIP_MEMORY_SCOPE_AGENT);
        __syncthreads();
        const int base = (int)F.MISC[13] * BATCH;
        if (base >= I_GU + I_D) break;
        auto desc2 = [&](int r) { TrDesc D;
            if (r < I_GU) { const int nblk = 2 * DFF / 32, kb = r / nblk, nb2 = r % nblk; const int row = nb2 * 32, t = row / 256, w = row % 256;
                D = TrDesc{(w < 128) ? F.in[19] : F.in[20], F.in[18], WSP(bf16, WS_WGU), DM, DFF, 128 * t + (w & 127), row, kb * 64}; }
            else { r -= I_GU; const int kb = r / 64, nb2 = r % 64; D = TrDesc{F.in[21], nullptr, WSP(bf16, WS_WD), DFF, DM, nb2 * 32, nb2 * 32, kb * 64}; }
            return D; };
        for (int k = 0; k < 4; ++k) {
            const int it = base + 2 * (k * NWAVES + F.wave); if (it >= I_GU + I_D) break;
            tr_pair(desc2(it), desc2(it + 1), true, scr, F.lane); }
    }
}

__device__ __forceinline__ float softplusf(float x) { return x > 20.f ? x : log1pf(__expf(x)); }
__device__ __forceinline__ void dn_combine(Frame& F) {
    const int gw = F.vcu * NWAVES + F.wave, NGW = F.G * NWAVES, lane = F.lane;
    const bf16* OFp = WSP(bf16, WS_OF); const bf16* OBp = WSP(bf16, WS_OB); const bf16* Z = DOP(bf16, DO_Z); bf16* Y = WSP(bf16, WS_XB); const float* gn = F.in[9];
    const int cb = (16 * lane) & 127; float gv[16];
#pragma unroll
    for (int i = 0; i < 16; ++i) gv[i] = gn[cb + i];
    for (int t0 = gw; t0 < SEQ; t0 += 2 * NGW) {
        v4u a[2][2], b[2][2], z[2][2];
#pragma unroll
        for (int k = 0; k < 2; ++k) { const int t = (t0 + k * NGW < SEQ) ? t0 + k * NGW : t0; const size_t off = (size_t)t * 1024 + 16 * lane;
            a[k][0] = *(const v4u*)(OFp + off); a[k][1] = *(const v4u*)(OFp + off + 8); b[k][0] = *(const v4u*)(OBp + off); b[k][1] = *(const v4u*)(OBp + off + 8);
            z[k][0] = *(const v4u*)(Z + off); z[k][1] = *(const v4u*)(Z + off + 8); }
#pragma unroll
        for (int k = 0; k < 2; ++k) {
            const int t = t0 + k * NGW; if (t >= SEQ) break;
            float o[16], zz[16];
#pragma unroll
            for (int i = 0; i < 4; ++i) { o[2 * i] = bflo(a[k][0][i]) + bflo(b[k][0][i]); o[2 * i + 1] = bfhi(a[k][0][i]) + bfhi(b[k][0][i]); o[8 + 2 * i] = bflo(a[k][1][i]) + bflo(b[k][1][i]); o[8 + 2 * i + 1] = bfhi(a[k][1][i]) + bfhi(b[k][1][i]);
                zz[2 * i] = bflo(z[k][0][i]); zz[2 * i + 1] = bfhi(z[k][0][i]); zz[8 + 2 * i] = bflo(z[k][1][i]); zz[8 + 2 * i + 1] = bfhi(z[k][1][i]); }
            float ss = 0.f;
#pragma unroll
            for (int i = 0; i < 16; ++i) ss += o[i] * o[i];
            ss += __shfl_xor(ss, 1); ss += __shfl_xor(ss, 2); ss += __shfl_xor(ss, 4);
            const float rs = __builtin_amdgcn_rsqf(ss * (1.0f / 128.0f) + RMS_EPS);
            float y[16];
#pragma unroll
            for (int i = 0; i < 16; ++i) y[i] = o[i] * rs * gv[i] * siluf(zz[i]);
            v4u w0, w1;
#pragma unroll
            for (int i = 0; i < 4; ++i) { w0[i] = pk2(y[2 * i], y[2 * i + 1]); w1[i] = pk2(y[8 + 2 * i], y[8 + 2 * i + 1]); }
            bf16* yp = Y + (size_t)t * DM + 16 * lane; *(v4u*)yp = w0; *(v4u*)(yp + 8) = w1;
        }
    }
}
__device__ __forceinline__ void final_norm(Frame& F) {
    const int gw = F.vcu * NWAVES + F.wave, NGW = F.G * NWAVES, lane = F.lane;
    const float* ss = (const float*)(F.ws + WS_CTL + CTL_SUMSQ4); const GAS f32x4* g = (const GAS f32x4*)F.in[22]; const bf16* H3 = WSP(bf16, WS_H3B);
    for (int m0 = gw; m0 < SEQ; m0 += 2 * NGW) {
        v4u w[2][4]; float r[2];
#pragma unroll
        for (int k = 0; k < 2; ++k) { const int m = (m0 + k * NGW < SEQ) ? m0 + k * NGW : m0; const GAS v4u* hp = (const GAS v4u*)(H3 + (size_t)m * DM);
            r[k] = ss[m];
#pragma unroll
            for (int j = 0; j < 4; ++j) w[k][j] = hp[64 * j + lane]; }
#pragma unroll
        for (int k = 0; k < 2; ++k) {
            const int m = m0 + k * NGW; if (m >= SEQ) break;
            const float rr = __builtin_amdgcn_rsqf(r[k] * (1.0f / DM) + RMS_EPS);
            GAS f32x4* o = (GAS f32x4*)(F.out + (size_t)m * DM);
#pragma unroll
            for (int j = 0; j < 4; ++j) { const v4u x = w[k][j]; const int c4 = 2 * (64 * j + lane); const f32x4 g0 = g[c4], g1 = g[c4 + 1];
                o[c4] = (f32x4){bflo(x.x) * rr * g0[0], bfhi(x.x) * rr * g0[1], bflo(x.y) * rr * g0[2], bfhi(x.y) * rr * g0[3]};
                o[c4 + 1] = (f32x4){bflo(x.z) * rr * g1[0], bfhi(x.z) * rr * g1[1], bflo(x.w) * rr * g1[2], bfhi(x.w) * rr * g1[3]}; }
        }
    }
}

__device__ __forceinline__ int t5_bucket(int rel) {
    const int n = rel < 0 ? -rel : rel; int b;
    if (n < 8) b = n; else { int k = (31 - __builtin_clz((unsigned)(n * n))) - 6; b = 8 + k; if (b > 15) b = 15; }
    return (rel > 0 ? 16 : 0) + b;
}
template <int MODE  >
__device__ __forceinline__ void attn_unit(Frame& F, const bf16* Q, int qpitch, const bf16* Kp, const bf16* Vp, int kvpitch, bf16* O, int opitch, int q0, int kt_beg, int kt_end, const LAS float* btab, float sink2) {
    LAS unsigned char* Ks = F.lds + RING_OFF; LAS unsigned char* Vs = Ks + 16384;
    const int lane = F.lane, c = lane & 15, g = lane >> 4, qw0 = q0 + 16 * F.wave, tid = F.tid;
    bf16x8 qf[4];
#pragma unroll
    for (int t = 0; t < 4; ++t) qf[t] = *(const bf16x8*)(Q + (size_t)(qw0 + c) * qpitch + 32 * t + 8 * g);
    f32x4 oacc[8];
#pragma unroll
    for (int i = 0; i < 8; ++i) oacc[i] = (f32x4){0.f, 0.f, 0.f, 0.f};
    float mrun = (MODE == 0) ? sink2 : -1e30f, lsum = (MODE == 0 && g == 0) ? 1.0f : 0.0f;
    v4u kpre[2], vpre[2];
#pragma unroll
    for (int i = 0; i < 2; ++i) { const int ci = tid + 512 * i, key = ci >> 4, ch = ci & 15;
        kpre[i] = *(const v4u*)(Kp + (size_t)(64 * kt_beg + key) * kvpitch + ch * 8); vpre[i] = *(const v4u*)(Vp + (size_t)(64 * kt_beg + key) * kvpitch + ch * 8); }
    for (int kt = kt_beg; kt < kt_end; ++kt) {
        __syncthreads();
#pragma unroll
        for (int i = 0; i < 2; ++i) { const int ci = tid + 512 * i, key = ci >> 4, ch = ci & 15;
            *(LAS v4u*)(Ks + key * 256 + ((ch ^ (key & 15)) << 4)) = kpre[i]; *(LAS v4u*)(Vs + key * 256 + ((ch ^ ((key & 7) << 1)) << 4)) = vpre[i]; }
        if (kt + 1 < kt_end) {
#pragma unroll
            for (int i = 0; i < 2; ++i) { const int ci = tid + 512 * i, key = ci >> 4, ch = ci & 15;
                kpre[i] = *(const v4u*)(Kp + (size_t)(64 * (kt + 1) + key) * kvpitch + ch * 8); vpre[i] = *(const v4u*)(Vp + (size_t)(64 * (kt + 1) + key) * kvpitch + ch * 8); } }
        __syncthreads();
        bool rel_ok = true;
        if (MODE == 0) rel_ok = (64 * kt <= qw0 + 15 + 128) && (64 * kt + 63 >= qw0 - 128);
        if (!rel_ok) continue;
        f32x4 s[4];
#pragma unroll
        for (int mt = 0; mt < 4; ++mt) s[mt] = (f32x4){0.f, 0.f, 0.f, 0.f};
#pragma unroll
        for (int t = 0; t < 4; ++t)
#pragma unroll
            for (int mt = 0; mt < 4; ++mt) { const bf16x8 kf = *(const LAS bf16x8*)(Ks + (16 * mt + c) * 256 + (((4 * t + g) ^ c) << 4));
                s[mt] = __builtin_amdgcn_mfma_f32_16x16x32_bf16(kf, qf[t], s[mt], 0, 0, 0); }
        float tmax = -INFINITY;
#pragma unroll
        for (int mt = 0; mt < 4; ++mt)
#pragma unroll
            for (int r = 0; r < 4; ++r) {
                if (MODE == 0) { const int rel = (64 * kt + 16 * mt + 4 * g + r) - (qw0 + c); const bool ok = (rel >= -128) && (rel <= 128);
                    const int ri = ok ? rel + 128 : 128; const float bv = btab[ri]; s[mt][r] = ok ? s[mt][r] + bv : -INFINITY; }
                tmax = fmaxf(tmax, s[mt][r]); }
        tmax = fmaxf(tmax, __shfl_xor(tmax, 16)); tmax = fmaxf(tmax, __shfl_xor(tmax, 32));
        const float mnew = fmaxf(mrun, tmax), alpha = __builtin_amdgcn_exp2f(mrun - mnew); mrun = mnew; float ps = 0.f;
#pragma unroll
        for (int mt = 0; mt < 4; ++mt)
#pragma unroll
            for (int r = 0; r < 4; ++r) { const float p = __builtin_amdgcn_exp2f(s[mt][r] - mnew); s[mt][r] = p; ps += p; }
        lsum = lsum * alpha + ps;
#pragma unroll
        for (int i = 0; i < 8; ++i) oacc[i] = oacc[i] * alpha;
        bf16x8 pf[2];
#pragma unroll
        for (int t2 = 0; t2 < 2; ++t2) { v4u w; w.x = cvtpk(s[2 * t2][0], s[2 * t2][1]); w.y = cvtpk(s[2 * t2][2], s[2 * t2][3]); w.z = cvtpk(s[2 * t2 + 1][0], s[2 * t2 + 1][1]); w.w = cvtpk(s[2 * t2 + 1][2], s[2 * t2 + 1][3]);
            pf[t2] = __builtin_bit_cast(bf16x8, w); }
        const int q4 = c >> 2, p4 = c & 3;
#pragma unroll
        for (int t2 = 0; t2 < 2; ++t2)
#pragma unroll
            for (int mo = 0; mo < 8; ++mo) {
                const int k1 = 32 * t2 + 4 * g + q4, k2 = k1 + 16, chn = 2 * mo + (p4 >> 1);
                const s16x4 lo = __builtin_bit_cast(s16x4, __builtin_amdgcn_ds_read_tr16_b64_v4i16((LAS s16x4*)(Vs + k1 * 256 + ((chn ^ ((k1 & 7) << 1)) << 4) + (p4 & 1) * 8)));
                const s16x4 hi = __builtin_bit_cast(s16x4, __builtin_amdgcn_ds_read_tr16_b64_v4i16((LAS s16x4*)(Vs + k2 * 256 + ((chn ^ ((k2 & 7) << 1)) << 4) + (p4 & 1) * 8)));
                const bf16x8 vf = (bf16x8){lo[0], lo[1], lo[2], lo[3], hi[0], hi[1], hi[2], hi[3]};
                oacc[mo] = __builtin_amdgcn_mfma_f32_16x16x32_bf16(vf, pf[t2], oacc[mo], 0, 0, 0); }
    }
    lsum += __shfl_xor(lsum, 16); lsum += __shfl_xor(lsum, 32);
    const float inv = 1.0f / lsum;
#pragma unroll
    for (int mo = 0; mo < 8; ++mo) { v2u w; w.x = cvtpk(oacc[mo][0] * inv, oacc[mo][1] * inv); w.y = cvtpk(oacc[mo][2] * inv, oacc[mo][3] * inv);
        *(v2u*)(O + (size_t)(qw0 + c) * opitch + 16 * mo + 4 * g) = w; }
}
__device__ __forceinline__ void swa_phase(Frame& F, int b0, int nb) {
    LAS float* btab = (LAS float*)(F.lds + RING_OFF + 32768);
    const bf16* QS = DOP(bf16, DO_QSW); const bf16* KV = DOP(bf16, DO_KVSW); bf16* Y = WSP(bf16, WS_XB);
    unsigned* qctr = (unsigned*)(F.ctl + CW_SWAQ); unsigned* fdone = (unsigned*)(F.ctl + CW_FOLDDONE);
    for (;;) {
        __syncthreads();
        if (F.tid == 0) {
            unsigned nx = 0x7fffffffu;
            if (!(b0 && __hip_atomic_load(fdone, __ATOMIC_RELAXED, __HIP_MEMORY_SCOPE_AGENT) >= (unsigned)nb)) nx = __hip_atomic_fetch_add(qctr, 1u, __ATOMIC_RELAXED, __HIP_MEMORY_SCOPE_AGENT);
            F.MISC[12] = nx; }
        __syncthreads();
        const int u = (int)F.MISC[12];
        if (u >= SWH * (SEQ / 128)) break;
        const int h = u & 7, qb = u >> 3, kvh = h >> 2;
        __syncthreads();
        if (F.tid < 257) btab[F.tid] = F.in[11][t5_bucket(F.tid - 128) * 8 + h] * LOG2E;
        __syncthreads();
        int kb = 2 * qb - 2, ke = 2 * qb + 4; if (kb < 0) kb = 0; if (ke > SEQ / 64) ke = SEQ / 64;
        attn_unit<0>(F, QS + h * 128, 1024, KV + kvh * 128, KV + 256 + kvh * 128, 512, Y + 1024 + h * 128, DM, qb * 128, kb, ke, btab, F.in[10][h] * LOG2E);
    }
}
__device__ __forceinline__ void mem_attn_phase(Frame& F) {
    const bf16* QM = WSP(bf16, WS_QM); const bf16* KVm = WSP(bf16, WS_KVM); bf16* OM = WSP(bf16, WS_OM);
    for (int u = blockIdx.x; u < MEMH * (SEQ / 128); u += F.G) {
        const int h = u & 3, qb = u >> 2;
        attn_unit<1>(F, QM + h * 128, 512, KVm + h * 128, KVm + 512 + h * 128, 1024, OM + h * 128, 512, qb * 128, 0, 4, nullptr, 0.f);
    }
}

typedef float f32x16 __attribute__((ext_vector_type(16)));
constexpr int DX_W = 0, DX_K = 16384, DX_U = 32768, DX_Q = 49152, DX_A = 65536, DX_BYTES = 73728;
constexpr size_t WS_GL = 1 * MiB + 128 * 1024;
constexpr int L_RAW = 0, RAW_PITCH = 784, L_MTF = 0, L_MTB = 16384, L_TB = 32768, TB_PITCH = 144, TB_SZ = 9216;
constexpr int L_QB = 69632, L_KB = 86016, L_KT = 102400, L_VT = 120832, L_PART = 139264, L_SC = 143360;
constexpr int L_CW = 145408;
static_assert(L_SC + 2048 <= L_CW && L_CW + 7680 <= LDSCTL_OFF, "prep LDS map");
__device__ __forceinline__ unsigned char* dnx_rec(Frame& F, int dir, int hd, int cn) { return F.ws + WS_DNX + (size_t)((dir * 8 + hd) * 256 + cn) * DX_BYTES; }
__device__ __forceinline__ v4u pack8f(const float* v) { v4u w; w.x = cvtpk(v[0], v[1]); w.y = cvtpk(v[2], v[3]); w.z = cvtpk(v[4], v[5]); w.w = cvtpk(v[6], v[7]); return w; }

__device__ __forceinline__ bf16x8 cvt8(const f32x16& v, int o) { v4u w; w.x = cvtpk(v[o], v[o + 1]); w.y = cvtpk(v[o + 2], v[o + 3]); w.z = cvtpk(v[o + 4], v[o + 5]); w.w = cvtpk(v[o + 6], v[o + 7]); return __builtin_bit_cast(bf16x8, w); }
__device__ __forceinline__ bf16x8 cvt8f(f32x4 a, f32x4 b) { v4u w; w.x = cvtpk(a[0], a[1]); w.y = cvtpk(a[2], a[3]); w.z = cvtpk(b[0], b[1]); w.w = cvtpk(b[2], b[3]); return __builtin_bit_cast(bf16x8, w); }
template <int dir> __device__ __forceinline__ void dn_solve_and_write(LAS unsigned char* lds, int lane) {
    const LAS float* MT = (const LAS float*)(lds + (dir ? L_MTB : L_MTF));
    LAS float* T0 = (LAS float*)(lds + L_TB + dir * 2 * TB_SZ);
    LAS float* Trow = T0 + lane * 68;
    const int blk = lane >> 5, cb = 16 * (lane >> 4);
#pragma unroll 1
    for (int jr = 3; jr >= 0; --jr) {
        const int j0 = cb + 4 * jr;
        float a0 = (lane == j0) ? 1.f : 0.f, a1 = (lane == j0 + 1) ? 1.f : 0.f, a2 = (lane == j0 + 2) ? 1.f : 0.f, a3 = (lane == j0 + 3) ? 1.f : 0.f;
        const LAS float* mr = MT + j0 * 64;
#pragma unroll
        for (int sr = 1; sr < 4; ++sr) if (sr > jr) {
            const int s0 = cb + 4 * sr;
            const f32x4 tv = *(const LAS f32x4*)(Trow + s0);
            const f32x4 m0 = *(const LAS f32x4*)(mr + s0), m1 = *(const LAS f32x4*)(mr + 64 + s0), m2 = *(const LAS f32x4*)(mr + 128 + s0), m3 = *(const LAS f32x4*)(mr + 192 + s0);
            a0 -= (tv[0] * m0[0] + tv[1] * m0[1]) + (tv[2] * m0[2] + tv[3] * m0[3]);
            a1 -= (tv[0] * m1[0] + tv[1] * m1[1]) + (tv[2] * m1[2] + tv[3] * m1[3]);
            a2 -= (tv[0] * m2[0] + tv[1] * m2[1]) + (tv[2] * m2[2] + tv[3] * m2[3]);
            a3 -= (tv[0] * m3[0] + tv[1] * m3[1]) + (tv[2] * m3[2] + tv[3] * m3[3]);
        }
        const f32x4 d0 = *(const LAS f32x4*)(mr + j0), d1 = *(const LAS f32x4*)(mr + 64 + j0), d2 = *(const LAS f32x4*)(mr + 128 + j0);
        const float t3 = a3, t2 = a2 - t3 * d2[3], t1 = a1 - t2 * d1[2] - t3 * d1[3], t0 = a0 - t1 * d0[1] - t2 * d0[2] - t3 * d0[3];
        *(LAS f32x4*)(Trow + j0) = (f32x4){t0, t1, t2, t3};
    }
    if (((lane >> 4) & 1) == 0) {
#pragma unroll
        for (int q = 0; q < 4; ++q) *(LAS f32x4*)(Trow + cb + 16 + 4 * q) = (f32x4){0.f, 0.f, 0.f, 0.f}; }
    if (blk == 0) {
#pragma unroll
        for (int q = 8; q < 16; ++q) *(LAS f32x4*)(Trow + 4 * q) = (f32x4){0.f, 0.f, 0.f, 0.f}; }
    asm volatile("s_waitcnt lgkmcnt(0)" ::: "memory");
    {
        const int r = lane & 31, lh = lane >> 5, B = r >> 4, rl = r & 15, c0 = 32 * B;
        float av[8], bv[8];
#pragma unroll
        for (int jj = 0; jj < 8; ++jj) { const int k = 8 * lh + jj; av[jj] = MT[(c0 + k) * 64 + c0 + 16 + rl]; bv[jj] = T0[(c0 + k) * 68 + c0 + rl]; }
        f32x16 Y;
#pragma unroll
        for (int e = 0; e < 16; ++e) Y[e] = 0.f;
        Y = __builtin_amdgcn_mfma_f32_32x32x16_bf16(cvt8f((f32x4){av[0], av[1], av[2], av[3]}, (f32x4){av[4], av[5], av[6], av[7]}), cvt8f((f32x4){bv[0], bv[1], bv[2], bv[3]}, (f32x4){bv[4], bv[5], bv[6], bv[7]}), Y, 0, 0, 0);
        const bf16x8 y0 = cvt8(Y, 0), y1 = cvt8(Y, 8); bf16x8 yb;
#pragma unroll
        for (int e = 0; e < 8; ++e) yb[e] = B ? y1[e] : y0[e];
        const f32x4 t0 = *(const LAS f32x4*)(T0 + (c0 + 16 + rl) * 68 + c0 + 16 + 4 * lh), t1 = *(const LAS f32x4*)(T0 + (c0 + 16 + rl) * 68 + c0 + 16 + 8 + 4 * lh);
        f32x16 Z;
#pragma unroll
        for (int e = 0; e < 16; ++e) Z[e] = 0.f;
        Z = __builtin_amdgcn_mfma_f32_32x32x16_bf16(cvt8f(t0, t1), yb, Z, 0, 0, 0);
#pragma unroll
        for (int j = 0; j < 8; ++j) { const float z = B ? Z[8 + j] : Z[j]; T0[(c0 + 16 + 8 * (j >> 2) + 4 * lh + (j & 3)) * 68 + c0 + rl] = -z; }
    }
    asm volatile("s_waitcnt lgkmcnt(0)" ::: "memory");
    {
        const int r = lane & 31, lh = lane >> 5;
        f32x16 Y;
#pragma unroll
        for (int e = 0; e < 16; ++e) Y[e] = 0.f;
#pragma unroll
        for (int kk = 0; kk < 2; ++kk) {
            float av[8], bv[8];
#pragma unroll
            for (int jj = 0; jj < 8; ++jj) { const int k = 16 * kk + 8 * lh + jj; av[jj] = MT[k * 64 + 32 + r]; bv[jj] = T0[k * 68 + r]; }
            Y = __builtin_amdgcn_mfma_f32_32x32x16_bf16(cvt8f((f32x4){av[0], av[1], av[2], av[3]}, (f32x4){av[4], av[5], av[6], av[7]}), cvt8f((f32x4){bv[0], bv[1], bv[2], bv[3]}, (f32x4){bv[4], bv[5], bv[6], bv[7]}), Y, 0, 0, 0);
        }
        f32x16 Z;
#pragma unroll
        for (int e = 0; e < 16; ++e) Z[e] = 0.f;
#pragma unroll
        for (int kk = 0; kk < 2; ++kk) {
            const f32x4 t0 = *(const LAS f32x4*)(T0 + (32 + r) * 68 + 32 + 16 * kk + 4 * lh), t1 = *(const LAS f32x4*)(T0 + (32 + r) * 68 + 32 + 16 * kk + 8 + 4 * lh);
            Z = __builtin_amdgcn_mfma_f32_32x32x16_bf16(cvt8f(t0, t1), cvt8(Y, 8 * kk), Z, 0, 0, 0);
        }
#pragma unroll
        for (int e = 0; e < 16; ++e) T0[(32 + (e & 3) + 8 * (e >> 2) + 4 * lh) * 68 + r] = -Z[e];
    }
    asm volatile("s_waitcnt lgkmcnt(0)" ::: "memory");
    f32x4 tr[16];
#pragma unroll
    for (int q = 0; q < 16; ++q) tr[q] = *(const LAS f32x4*)(Trow + 4 * q);
    asm volatile("s_waitcnt lgkmcnt(0)" ::: "memory");
    const LAS float* sc = (const LAS float*)(lds + L_SC);
    const LAS float* cU = sc + (dir ? 384 : 256); const LAS float* cW = sc + (dir ? 448 : 320);
    const int pos = dir ? 63 - lane : lane;
    LAS unsigned char* tu = lds + L_TB + dir * 2 * TB_SZ + pos * TB_PITCH; LAS unsigned char* tw = tu + TB_SZ;
#pragma unroll
    for (int q = 0; q < 8; ++q) {
        float u8[8], w8[8];
#pragma unroll
        for (int e = 0; e < 8; ++e) { const int s = 8 * q + e, sp = dir ? 63 - s : s; const float t = tr[sp >> 2][sp & 3]; u8[e] = t * cU[s]; w8[e] = t * cW[s]; }
        *(LAS v4u*)(tu + q * 16) = pack8f(u8); *(LAS v4u*)(tw + q * 16) = pack8f(w8);
    }
}

struct PrepRegs { v4u raw[7]; float ab[4]; };
__device__ __forceinline__ void prep_load(Frame& F, int u, int tid, int lane, PrepRegs& R) {
    const int cn = u >> 3, hd = u & 7; const bf16* QKV = WSP(bf16, WS_QKV);
#pragma unroll
    for (int k = 0; k < 7; ++k) { const int ci = tid + 512 * k; const int row = ci / 48, cc = ci % 48, seg = cc >> 4, ch = (cc & 15) * 8, tok = 64 * cn - 2 + row;
        v4u v = (v4u){0u, 0u, 0u, 0u};
        if (ci < 68 * 48 && tok >= 0 && tok < SEQ) v = *(const v4u*)(QKV + (size_t)tok * 3072 + seg * 1024 + hd * 128 + ch);
        R.raw[k] = v; }
    if (tid < 64) { const float* ab = WSP(float, WS_AB) + (size_t)(64 * cn + lane) * 32; R.ab[0] = ab[hd]; R.ab[1] = ab[8 + hd]; R.ab[2] = ab[16 + hd]; R.ab[3] = ab[24 + hd]; }
}
#define DNX_ST(ptr, val) do { const v4u v_ = (val); if (MASK & 32) *(v4u*)(ptr) = v_; else asm volatile("" :: "v"(v_)); } while (0)
template <int MASK> __device__ __forceinline__ void dn_prep_unit(Frame& F, int cn, int hd, PrepRegs& PR, int next_u) {
    LAS unsigned char* lds = F.lds; int tid = F.tid, lane = F.lane; const int wave = F.wave;
    asm volatile("" : "+v"(tid), "+v"(lane));
    LAS float* sc = (LAS float*)(lds + L_SC);
    __syncthreads();
    if (MASK & 1) {
    const float abv[4] = {PR.ab[0], PR.ab[1], PR.ab[2], PR.ab[3]};
#pragma unroll
    for (int k = 0; k < 7; ++k) { const int ci = tid + 512 * k; const int row = ci / 48, cc = ci % 48, seg = cc >> 4, ch = (cc & 15) * 8;
        if (ci < 68 * 48) *(LAS v4u*)(lds + L_RAW + row * RAW_PITCH + (seg * 128 + ch) * 2) = PR.raw[k]; }
    if (wave == 0) {
        const float bfv = 1.0f / (1.0f + __expf(-abv[0])), bbv = 1.0f / (1.0f + __expf(-abv[1]));
        const float gf = -__expf(F.in[5][hd]) * softplusf(abv[2] + F.in[7][hd]), gb = -__expf(F.in[6][hd]) * softplusf(abv[3] + F.in[8][hd]);
        float Gf = gf, Gb = gb;
#pragma unroll
        for (int o = 1; o < 64; o <<= 1) { const float a = __shfl_up(Gf, o), b = __shfl_down(Gb, o); if (lane >= o) Gf += a; if (lane + o < 64) Gb += b; }
        sc[lane] = Gf; sc[64 + lane] = Gb; sc[128 + lane] = bfv; sc[192 + lane] = bbv;
        sc[256 + lane] = bfv; sc[320 + lane] = -bfv * __expf(Gf); sc[384 + lane] = bbv; sc[448 + lane] = -bbv * __expf(Gb);
        float* GL = WSP(float, WS_GL);
        if (MASK & 32) { if (lane == 63) GL[(0 * 8 + hd) * 256 + cn] = __expf(Gf);
        if (lane == 0) GL[(1 * 8 + hd) * 256 + cn] = __expf(Gb); }
    }
    }
    __syncthreads();
    asm volatile("" : "+v"(tid), "+v"(lane));
    if (MASK & 2) {
        const int t = wave, pos = lane; const LAS float* cw = (const LAS float*)(lds + L_CW) + 16 * t;
        float qv[16], kv[16], vv[16];
#pragma unroll
        for (int seg = 0; seg < 3; ++seg) {
            float a[16];
#pragma unroll
            for (int i = 0; i < 16; ++i) a[i] = 0.f;
#pragma unroll
            for (int j = 0; j < 5; ++j) {
                const LAS unsigned char* rp = lds + L_RAW + (pos + j) * RAW_PITCH + (seg * 128 + 16 * t) * 2;
                const v4u r0 = *(const LAS v4u*)rp, r1 = *(const LAS v4u*)(rp + 16);
                const LAS float* w = cw + j * 384 + seg * 128;
#pragma unroll
                for (int i = 0; i < 4; ++i) { a[2 * i] += w[2 * i] * bflo(r0[i]); a[2 * i + 1] += w[2 * i + 1] * bfhi(r0[i]); a[8 + 2 * i] += w[8 + 2 * i] * bflo(r1[i]); a[8 + 2 * i + 1] += w[8 + 2 * i + 1] * bfhi(r1[i]); }
            }
#pragma unroll
            for (int i = 0; i < 16; ++i) { const float s = siluf(a[i]); if (seg == 0) qv[i] = s; else if (seg == 1) kv[i] = s; else vv[i] = s; }
        }
        float sq = 0.f, sk = 0.f;
#pragma unroll
        for (int i = 0; i < 16; ++i) { sq += qv[i] * qv[i]; sk += kv[i] * kv[i]; }
        LAS float* part = (LAS float*)(lds + L_PART);
        part[t * 64 + pos] = sq; part[512 + t * 64 + pos] = sk;
        __syncthreads();
        float tq = 0.f, tk = 0.f;
#pragma unroll
        for (int i = 0; i < 8; ++i) { tq += part[i * 64 + pos]; tk += part[512 + i * 64 + pos]; }
        const float rq = (1.0f / sqrtf(tq + 1e-6f)) * 0.08838834764831845f, rk = 1.0f / sqrtf(tk + 1e-6f);
#pragma unroll
        for (int i = 0; i < 16; ++i) { qv[i] *= rq; kv[i] *= rk; }
        *(LAS v4u*)(lds + L_QB + pos * 256 + (((2 * t) ^ (pos & 15)) << 4)) = pack8f(qv); *(LAS v4u*)(lds + L_QB + pos * 256 + (((2 * t + 1) ^ (pos & 15)) << 4)) = pack8f(qv + 8);
        *(LAS v4u*)(lds + L_KB + pos * 256 + (((2 * t) ^ (pos & 15)) << 4)) = pack8f(kv); *(LAS v4u*)(lds + L_KB + pos * 256 + (((2 * t + 1) ^ (pos & 15)) << 4)) = pack8f(kv + 8);
#pragma unroll
        for (int i = 0; i < 16; ++i) { const unsigned w = cvtpk(kv[i], vv[i]); *(LAS unsigned short*)(lds + L_KT + (16 * t + i) * TB_PITCH + pos * 2) = (unsigned short)w; *(LAS unsigned short*)(lds + L_VT + (16 * t + i) * TB_PITCH + pos * 2) = (unsigned short)(w >> 16); }
        const float ef = __expf(sc[pos]), eb = __expf(sc[64 + pos]); const int mt = pos >> 5;
#pragma unroll
        for (int dir = 0; dir < 2; ++dir) { const float e = dir ? eb : ef; unsigned char* rec = dnx_rec(F, dir, hd, cn) + DX_Q;
#pragma unroll
            for (int lh = 0; lh < 2; ++lh) { float o8[8];
#pragma unroll
                for (int j = 0; j < 8; ++j) o8[j] = qv[8 * (j >> 2) + 4 * lh + (j & 3)] * e;
                DNX_ST(rec + ((mt * 8 + t) * 64 + 32 * lh + (pos & 31)) * 16, pack8f(o8)); } }
    }
    __syncthreads();
    asm volatile("" : "+v"(tid), "+v"(lane));
    if (MASK & 4) {
        const int r = lane & 31, lh = lane >> 5, x = wave & 3, ta = x >> 1, tb = x & 1;
        const LAS unsigned char* Ab = lds + L_KB + (32 * ta + r) * 256; const LAS unsigned char* Bb = lds + (wave < 4 ? L_KB : L_QB) + (32 * tb + r) * 256;
        f32x16 acc;
#pragma unroll
        for (int i = 0; i < 16; ++i) acc[i] = 0.f;
#pragma unroll
        for (int kk = 0; kk < 8; ++kk) { const int ch = ((2 * kk + lh) ^ (r & 15)) << 4;
            acc = __builtin_amdgcn_mfma_f32_32x32x16_bf16(*(const LAS bf16x8*)(Ab + ch), *(const LAS bf16x8*)(Bb + ch), acc, 0, 0, 0); }
        const int b = 32 * tb + r;
        if (wave < 4) {
            const float Gfb = sc[b], Gbb = sc[64 + b];
#pragma unroll
            for (int q = 0; q < 4; ++q) { const int a0 = 32 * ta + 8 * q + 4 * lh; f32x4 mf, mb;
#pragma unroll
                for (int e = 0; e < 4; ++e) { const int a = a0 + e; const float kkv = acc[4 * q + e];
                    const float vf = sc[128 + a] * kkv * __expf(fminf(sc[a] - Gfb, 0.f)), vb = sc[192 + a] * kkv * __expf(fminf(sc[64 + a] - Gbb, 0.f));
                    mf[e] = (a > b) ? vf : 0.f; mb[3 - e] = (a < b) ? vb : 0.f; }
                *(LAS f32x4*)(lds + L_MTF + (b * 64 + a0) * 4) = mf; *(LAS f32x4*)(lds + L_MTB + ((63 - b) * 64 + 60 - a0) * 4) = mb; }
        } else {
            const float Gfc = sc[b], Gbc = sc[64 + b];
#pragma unroll
            for (int dir = 0; dir < 2; ++dir) { unsigned char* rec = dnx_rec(F, dir, hd, cn) + DX_A;
#pragma unroll
                for (int s2 = 0; s2 < 2; ++s2) { float o8[8];
#pragma unroll
                    for (int j = 0; j < 8; ++j) { const int s = 32 * ta + 16 * s2 + 8 * (j >> 2) + 4 * lh + (j & 3); const float v = acc[8 * s2 + j];
                        const float ev = v * __expf(fminf(dir ? Gbc - sc[64 + s] : Gfc - sc[s], 0.f)); o8[j] = (dir ? (s >= b) : (s <= b)) ? ev : 0.f; }
                    DNX_ST(rec + ((tb * 4 + 2 * ta + s2) * 64 + lane) * 16, pack8f(o8)); } }
        }
    }
    __syncthreads();
    asm volatile("" : "+v"(tid), "+v"(lane));
    if ((MASK & 1) && next_u < 256 * DNH) prep_load(F, next_u, tid, lane, PR);
    if (!(MASK & 8)) {} else if (wave == 0) dn_solve_and_write<0>(lds, lane);
    else if (wave == 1) dn_solve_and_write<1>(lds, lane);
    else {
        const int r = lane & 31, lh = lane >> 5;
        for (int f = wave - 2; f < 32; f += 6) { const int dir = f >> 4, m = (f >> 2) & 3, t = f & 3; const int dk = 32 * m + r;
            const v2u k0 = *(const LAS v2u*)(lds + L_KT + dk * TB_PITCH + (16 * t + 4 * lh) * 2), k1 = *(const LAS v2u*)(lds + L_KT + dk * TB_PITCH + (16 * t + 8 + 4 * lh) * 2);
            const float Gl = dir ? sc[64] : sc[63]; const LAS float* Gs = sc + (dir ? 64 : 0) + 16 * t + 4 * lh; float o8[8];
            o8[0] = bflo(k0.x) * __expf(Gl - Gs[0]); o8[1] = bfhi(k0.x) * __expf(Gl - Gs[1]); o8[2] = bflo(k0.y) * __expf(Gl - Gs[2]); o8[3] = bfhi(k0.y) * __expf(Gl - Gs[3]);
            o8[4] = bflo(k1.x) * __expf(Gl - Gs[8]); o8[5] = bfhi(k1.x) * __expf(Gl - Gs[9]); o8[6] = bflo(k1.y) * __expf(Gl - Gs[10]); o8[7] = bfhi(k1.y) * __expf(Gl - Gs[11]);
            DNX_ST(dnx_rec(F, dir, hd, cn) + DX_K + ((m * 4 + t) * 64 + lane) * 16, pack8f(o8)); }
    }
    __syncthreads();
    asm volatile("" : "+v"(tid), "+v"(lane));
    if (MASK & 16) {
        const int dir = wave >> 2, x = wave & 3, r = lane & 31, lh = lane >> 5;
        const LAS unsigned char* Tu = lds + L_TB + (dir ? 2 : 0) * TB_SZ; const LAS unsigned char* Tw = Tu + TB_SZ;
        unsigned char* rec = dnx_rec(F, dir, hd, cn);
#pragma unroll
        for (int mt = 0; mt < 2; ++mt) {
            f32x16 aw, au;
#pragma unroll
            for (int i = 0; i < 16; ++i) { aw[i] = 0.f; au[i] = 0.f; }
#pragma unroll
            for (int kk = 0; kk < 4; ++kk) { const int so = (16 * kk + 8 * lh) * 2;
                aw = __builtin_amdgcn_mfma_f32_32x32x16_bf16(*(const LAS bf16x8*)(lds + L_KT + (32 * x + r) * TB_PITCH + so), *(const LAS bf16x8*)(Tw + (32 * mt + r) * TB_PITCH + so), aw, 0, 0, 0);
                au = __builtin_amdgcn_mfma_f32_32x32x16_bf16(*(const LAS bf16x8*)(Tu + (32 * mt + r) * TB_PITCH + so), *(const LAS bf16x8*)(lds + L_VT + (32 * x + r) * TB_PITCH + so), au, 0, 0, 0); }
            float tmp[16];
#pragma unroll
            for (int i = 0; i < 16; ++i) tmp[i] = aw[i];
            DNX_ST(rec + DX_W + ((mt * 8 + 2 * x) * 64 + lane) * 16, pack8f(tmp)); DNX_ST(rec + DX_W + ((mt * 8 + 2 * x + 1) * 64 + lane) * 16, pack8f(tmp + 8));
#pragma unroll
            for (int i = 0; i < 16; ++i) tmp[i] = au[i];
            DNX_ST(rec + DX_U + ((x * 2 + mt) * 64 + lane) * 32, pack8f(tmp)); DNX_ST(rec + DX_U + ((x * 2 + mt) * 64 + lane) * 32 + 16, pack8f(tmp + 8));
        }
    }
}
#undef DNX_ST
template <int MASK> __device__ __forceinline__ void dn_prep_phase(Frame& F) {
    PrepRegs PR; int u = blockIdx.x; int cur_hd = -1;
    if (u < 256 * DNH) prep_load(F, u, F.tid, F.lane, PR);
    for (; u < 256 * DNH; u += F.G) {
        const int hd = u & 7;
        if (hd != cur_hd) {
            __syncthreads();
            for (int i = F.tid; i < 5 * 384; i += NWAVES * 64) { const int j = i / 384, c = i % 384; ((LAS float*)(F.lds + L_CW))[i] = F.in[4][j * 3072 + (c >> 7) * 1024 + hd * 128 + (c & 127)]; }
            cur_hd = hd;
        }
        dn_prep_unit<MASK>(F, u >> 3, hd, PR, u + F.G);
    }
}


constexpr int NSEG = 16, SEGL = 16;
constexpr size_t WS_PF = 176 * MiB, WS_RG = 184 * MiB, WS_SIN = 24 * MiB;
constexpr int SLOT1 = 49152, SLOT3 = 73728, L_GLS = 147456;
#define DN_WAIT(V) asm volatile("s_waitcnt vmcnt(" #V ") lgkmcnt(0)" ::: "memory")
#define DN_BAR() do { __builtin_amdgcn_s_barrier(); asm volatile("" ::: "memory"); } while (0)
__device__ __forceinline__ int seg_chunk(int dir, int g, int i) { const int n = SEGL * g + i; return dir ? 255 - n : n; }
__device__ __forceinline__ void u_to_acc(f32x16& a, const LAS unsigned char* up) {
    const v4u u0 = *(const LAS v4u*)up, u1 = *(const LAS v4u*)(up + 16);
#pragma unroll
    for (int i = 0; i < 4; ++i) { a[2 * i] = bflo(u0[i]); a[2 * i + 1] = bfhi(u0[i]); a[8 + 2 * i] = bflo(u1[i]); a[8 + 2 * i + 1] = bfhi(u1[i]); }
}
template <bool OUT>
__device__ __forceinline__ void dn_step(f32x16 (&S)[4], f32x16 (&aV)[2], f32x16 (&aO)[2], const LAS unsigned char* buf, float gl) {
#pragma unroll
    for (int t = 0; t < 8; ++t) { const bf16x8 sb = cvt8(S[t >> 1], 8 * (t & 1));
#pragma unroll
        for (int mt = 0; mt < 2; ++mt) {
            aV[mt] = __builtin_amdgcn_mfma_f32_32x32x16_bf16(*(const LAS bf16x8*)(buf + DX_W + (mt * 8 + t) * 1024), sb, aV[mt], 0, 0, 0);
            if (OUT) aO[mt] = __builtin_amdgcn_mfma_f32_32x32x16_bf16(*(const LAS bf16x8*)(buf + DX_Q + (mt * 8 + t) * 1024), sb, aO[mt], 0, 0, 0); } }
    bf16x8 vb[4];
#pragma unroll
    for (int t = 0; t < 4; ++t) vb[t] = cvt8(aV[t >> 1], 8 * (t & 1));
#pragma unroll
    for (int m = 0; m < 4; ++m) S[m] = S[m] * gl;
#pragma unroll
    for (int t = 0; t < 4; ++t) {
#pragma unroll
        for (int m = 0; m < 4; ++m) S[m] = __builtin_amdgcn_mfma_f32_32x32x16_bf16(*(const LAS bf16x8*)(buf + DX_K + (m * 4 + t) * 1024), vb[t], S[m], 0, 0, 0);
        if (OUT) {
#pragma unroll
            for (int mt = 0; mt < 2; ++mt) aO[mt] = __builtin_amdgcn_mfma_f32_32x32x16_bf16(*(const LAS bf16x8*)(buf + DX_A + (mt * 4 + t) * 1024), vb[t], aO[mt], 0, 0, 0); } }
}

__device__ __forceinline__ void dn_pass1(Frame& F) {
    LAS unsigned char* lds = F.lds; const int lane = F.lane, wave = F.wave, r = lane & 31, lh = lane >> 5, part = wave >> 2, d = wave & 3;
    LAS float* gls = (LAS float*)(lds + L_GLS);
    for (int unit = blockIdx.x; unit < 16 * NSEG; unit += F.G) {
        const int dir = unit >> 7, hd = (unit >> 4) & 7, g = unit & 15;
        DN_WAIT(0); __syncthreads();
        if (F.tid < SEGL) gls[F.tid] = WSP(float, WS_GL)[(dir * 8 + hd) * 256 + seg_chunk(dir, g, F.tid)];
        DN_WAIT(0);
        f32x16 S[4];
#pragma unroll
        for (int m = 0; m < 4; ++m)
#pragma unroll
            for (int i = 0; i < 16; ++i) S[m][i] = (part && (32 * m + (i & 3) + 8 * (i >> 2) + 4 * lh == 32 * d + r)) ? 1.f : 0.f;
#define P1_ISSUE(i) do { const unsigned char* src_ = dnx_rec(F, dir, hd, seg_chunk(dir, g, (i))) + lane * 16; LAS unsigned char* dst_ = lds + ((i) % 3) * SLOT1; \
            _Pragma("unroll") for (int k_ = 0; k_ < 6; ++k_) { const int p_ = wave + 8 * k_; __builtin_amdgcn_global_load_lds((const unsigned*)(src_ + p_ * 1024), (LAS unsigned*)(dst_ + p_ * 1024), 16, 0, 0); } } while (0)
        P1_ISSUE(0); P1_ISSUE(1);
        for (int i = 0; i < SEGL; ++i) {
            if (i + 1 < SEGL) DN_WAIT(6); else DN_WAIT(0);
            DN_BAR();
            if (i + 2 < SEGL) P1_ISSUE(i + 2);
            const LAS unsigned char* buf = lds + (i % 3) * SLOT1 + lane * 16;
            f32x16 aV[2], aO[2];
#pragma unroll
            for (int mt = 0; mt < 2; ++mt) {
                if (part == 0) u_to_acc(aV[mt], lds + (i % 3) * SLOT1 + DX_U + ((d * 2 + mt) * 64 + lane) * 32);
                else {
#pragma unroll
                    for (int e = 0; e < 16; ++e) aV[mt][e] = 0.f; } }
            dn_step<false>(S, aV, aO, buf, gls[i]);
        }
#undef P1_ISSUE
        DN_WAIT(0); DN_BAR();
        if (part == 0) {
            float* rg = (float*)(F.ws + WS_RG) + (size_t)unit * 16384;
#pragma unroll
            for (int m = 0; m < 4; ++m)
#pragma unroll
                for (int q = 0; q < 4; ++q) *(f32x4*)(rg + ((d * 4 + m) * 64 + lane) * 16 + 4 * q) = (f32x4){S[m][4 * q], S[m][4 * q + 1], S[m][4 * q + 2], S[m][4 * q + 3]};
        } else {
#pragma unroll
            for (int m = 0; m < 4; ++m)
#pragma unroll
                for (int i = 0; i < 16; ++i) *(LAS unsigned short*)(lds + (32 * m + (i & 3) + 8 * (i >> 2) + 4 * lh) * 272 + (32 * d + r) * 2) = (unsigned short)f2bf(S[m][i]);
        }
        DN_WAIT(0); DN_BAR();
        if (part == 1) {
            unsigned char* pf = F.ws + WS_PF + (size_t)unit * 32768;
#pragma unroll
            for (int k = 0; k < 8; ++k) { const int f = d * 8 + k, m = f >> 3, t = f & 7;
                const v2u a = *(const LAS v2u*)(lds + (32 * m + r) * 272 + (16 * t + 4 * lh) * 2), b = *(const LAS v2u*)(lds + (32 * m + r) * 272 + (16 * t + 8 + 4 * lh) * 2);
                *(v4u*)(pf + (f * 64 + lane) * 16) = (v4u){a.x, a.y, b.x, b.y}; }
        }
    }
}
constexpr int FOLD_SLOT = 49152, NFOLD = 64;
__device__ __forceinline__ void dn_fold(Frame& F) {
    const int b = blockIdx.x; if (b >= NFOLD) return;
    LAS unsigned char* lds = F.lds; const int lane = F.lane, wave = F.wave, dir = b >> 5, hd = (b >> 2) & 7, d = b & 3;
    const int unit0 = (dir * 8 + hd) * 16;
    const unsigned char* pf0 = F.ws + WS_PF + (size_t)unit0 * 32768; const unsigned char* rg0 = F.ws + WS_RG + (size_t)unit0 * 65536 + d * 16384;
    float* sin0 = (float*)(F.ws + WS_SIN) + (size_t)unit0 * 16384 + d * 4096;
    DN_WAIT(0); __syncthreads();
    const bool loader = (wave >= 1 && wave <= 6);
#define FOLD_ISSUE(g) do { if (loader) { LAS unsigned char* dst_ = lds + ((g) % 3) * FOLD_SLOT; const unsigned char* ps_ = pf0 + (size_t)(g) * 32768 + lane * 16; const unsigned char* rs_ = rg0 + (size_t)(g) * 65536 + lane * 16; \
        _Pragma("unroll") for (int k_ = 0; k_ < 8; ++k_) { const int p_ = (wave - 1) + 6 * k_; \
            if (p_ < 32) __builtin_amdgcn_global_load_lds((const unsigned*)(ps_ + p_ * 1024), (LAS unsigned*)(dst_ + p_ * 1024), 16, 0, 0); \
            else __builtin_amdgcn_global_load_lds((const unsigned*)(rs_ + (p_ - 32) * 1024), (LAS unsigned*)(dst_ + p_ * 1024), 16, 0, 0); } } } while (0)
    f32x16 S[4];
#pragma unroll
    for (int m = 0; m < 4; ++m)
#pragma unroll
        for (int i = 0; i < 16; ++i) S[m][i] = 0.f;
    FOLD_ISSUE(0); FOLD_ISSUE(1);
    for (int g = 0; g < NSEG - 1; ++g) {
        if (g + 1 < NSEG - 1) DN_WAIT(8); else DN_WAIT(0);
        DN_BAR();
        if (g + 2 < NSEG - 1) FOLD_ISSUE(g + 2);
        if (wave == 0) {
            float* so = sin0 + (size_t)g * 16384;
#pragma unroll
            for (int m = 0; m < 4; ++m)
#pragma unroll
                for (int q = 0; q < 4; ++q) *(f32x4*)(so + (m * 64 + lane) * 16 + 4 * q) = (f32x4){S[m][4 * q], S[m][4 * q + 1], S[m][4 * q + 2], S[m][4 * q + 3]};
            const LAS unsigned char* slot = lds + (g % 3) * FOLD_SLOT;
            bf16x8 sb[8];
#pragma unroll
            for (int t = 0; t < 8; ++t) sb[t] = cvt8(S[t >> 1], 8 * (t & 1));
#pragma unroll
            for (int m = 0; m < 4; ++m) {
#pragma unroll
                for (int q = 0; q < 4; ++q) { const f32x4 v = *(const LAS f32x4*)(slot + 32768 + (m * 64 + lane) * 64 + q * 16); S[m][4 * q] = v[0]; S[m][4 * q + 1] = v[1]; S[m][4 * q + 2] = v[2]; S[m][4 * q + 3] = v[3]; }
#pragma unroll
                for (int t = 0; t < 8; ++t) S[m] = __builtin_amdgcn_mfma_f32_32x32x16_bf16(*(const LAS bf16x8*)(slot + lane * 16 + (m * 8 + t) * 1024), sb[t], S[m], 0, 0, 0); }
        }
    }
#undef FOLD_ISSUE
    if (wave == 0) {
        float* so = sin0 + (size_t)(NSEG - 1) * 16384;
#pragma unroll
        for (int m = 0; m < 4; ++m)
#pragma unroll
            for (int q = 0; q < 4; ++q) *(f32x4*)(so + (m * 64 + lane) * 16 + 4 * q) = (f32x4){S[m][4 * q], S[m][4 * q + 1], S[m][4 * q + 2], S[m][4 * q + 3]};
    }
    DN_WAIT(0); __syncthreads();
    if (F.tid == 0) __hip_atomic_fetch_add((unsigned*)(F.ctl + CW_FOLDDONE), 1u, __ATOMIC_RELAXED, __HIP_MEMORY_SCOPE_AGENT);
}
__device__ __forceinline__ void dn_pass3(Frame& F) {
    LAS unsigned char* lds = F.lds; const int lane = F.lane, wave = F.wave, r = lane & 31, lh = lane >> 5;
    LAS float* gls = (LAS float*)(lds + L_GLS);
    const int nb3 = F.G >= 2 ? (F.G >> 1) : 1;
    if ((int)blockIdx.x >= nb3) return;
    for (int unit = blockIdx.x; unit < 16 * NSEG; unit += nb3) {
        const int dir = unit >> 7, hd = (unit >> 4) & 7, g = unit & 15;
        __syncthreads();
        if (F.tid < SEGL) gls[F.tid] = WSP(float, WS_GL)[(dir * 8 + hd) * 256 + seg_chunk(dir, g, F.tid)];
        asm volatile("s_waitcnt lgkmcnt(0)" ::: "memory");
        if (wave >= 4) {
            const int lw = wave - 4;
            for (int i = 0; i <= SEGL; ++i) {
                if (i < SEGL) { const unsigned char* src = dnx_rec(F, dir, hd, seg_chunk(dir, g, i)) + lane * 16; LAS unsigned char* dst = lds + (i & 1) * SLOT3;
#pragma unroll
                    for (int k = 0; k < 18; ++k) { const int p = lw + 4 * k; __builtin_amdgcn_global_load_lds((const unsigned*)(src + p * 1024), (LAS unsigned*)(dst + p * 1024), 16, 0, 0); } }
                DN_WAIT(0); DN_BAR();
            }
        } else {
            const int d = wave;
            f32x16 S[4];
            const float* si = (const float*)(F.ws + WS_SIN) + (size_t)unit * 16384;
#pragma unroll
            for (int m = 0; m < 4; ++m)
#pragma unroll
                for (int q = 0; q < 4; ++q) { const f32x4 v = *(const f32x4*)(si + ((d * 4 + m) * 64 + lane) * 16 + 4 * q); S[m][4 * q] = v[0]; S[m][4 * q + 1] = v[1]; S[m][4 * q + 2] = v[2]; S[m][4 * q + 3] = v[3]; }
            bf16* O = WSP(bf16, dir ? WS_OB : WS_OF);
            DN_BAR();
            for (int i = 0; i < SEGL; ++i) {
                const int cn = seg_chunk(dir, g, i); const LAS unsigned char* slot = lds + (i & 1) * SLOT3;
                f32x16 aV[2], aO[2];
#pragma unroll
                for (int mt = 0; mt < 2; ++mt) { u_to_acc(aV[mt], slot + DX_U + ((d * 2 + mt) * 64 + lane) * 32);
#pragma unroll
                    for (int e = 0; e < 16; ++e) aO[mt][e] = 0.f; }
                dn_step<true>(S, aV, aO, slot + lane * 16, gls[i]);
                {
                    LAS unsigned char* stg = (LAS unsigned char*)slot + DX_U + d * 4096;
#pragma unroll
                    for (int mt = 0; mt < 2; ++mt)
#pragma unroll
                        for (int e = 0; e < 16; e += 2) { const unsigned w = cvtpk(aO[mt][e], aO[mt][e + 1]);
                            *(LAS unsigned short*)(stg + (32 * mt + (e & 3) + 8 * (e >> 2) + 4 * lh) * 64 + r * 2) = (unsigned short)w;
                            *(LAS unsigned short*)(stg + (32 * mt + ((e + 1) & 3) + 8 * (e >> 2) + 4 * lh) * 64 + r * 2) = (unsigned short)(w >> 16); }
                    asm volatile("s_waitcnt lgkmcnt(0)" ::: "memory");
                    bf16* ob = O + (size_t)(64 * cn) * 1024 + hd * 128 + 32 * d;
#pragma unroll
                    for (int k = 0; k < 4; ++k) { const int pc = lane + 64 * k, row = pc >> 2, c4 = pc & 3;
                        *(v4u*)(ob + (size_t)row * 1024 + c4 * 8) = *(const LAS v4u*)(stg + row * 64 + c4 * 16); }
                }
                asm volatile("s_waitcnt lgkmcnt(0)" ::: "memory");
                DN_BAR();
            }
        }
    }
    __syncthreads();
}

#ifndef MK_N_LAUNCHES
#define MK_N_LAUNCHES 1
#endif
constexpr int N_PHASES = 14;
struct Args { const float* in[23]; float* out; unsigned char* ws; int ph_lo, ph_hi; };
static_assert(sizeof(Args) == 23 * 8 + 8 + 8 + 8, "Args has no padding");

__global__ void __launch_bounds__(NWAVES * 64, 2) enc_fwd(Args args) {
    extern __shared__ __attribute__((aligned(16))) unsigned char lds[];
    Frame F;
    F.lds = (LAS unsigned char*)lds;
    F.MISC = (volatile LAS unsigned*)(F.lds + MISC_OFF);
    F.tid = threadIdx.x; F.lane = F.tid & 63; F.wave = __builtin_amdgcn_readfirstlane(F.tid >> 6);
    F.G = gridDim.x; { const int bx = blockIdx.x; F.vcu = (F.G % 8 == 0) ? (bx % 8) * (F.G / 8) + bx / 8 : bx; }
#pragma unroll
    for (int i = 0; i < 23; ++i) F.in[i] = args.in[i];
    F.out = args.out; F.ws = args.ws; F.ctl = (gu32*)(args.ws + WS_CTL);
    for (int u = F.tid; u < (LDS_BYTES - LDSCTL_OFF) / 4; u += NWAVES * 64) ((LAS unsigned*)(F.lds + LDSCTL_OFF))[u] = 0u;
    __syncthreads();
    const int lo = args.ph_lo, hi = args.ph_hi;
    XcdBarrier bar; bar.bar = (unsigned*)(F.ctl + CW_BAR); bar.x = 0; bar.st = nullptr;
    if (hi - lo > 1) bar = xcd_barrier_post((unsigned*)(F.ctl + CW_BAR), F.MISC + 8);
#define IN(k) (lo <= (k) && (k) < hi)
#ifdef TS_IDX
#ifndef TS_OFFSET
#define TS_OFFSET 0
#endif
    unsigned long long ts_a = 0, ts_b = 0; int tsi = 0;
#define TSP() do { const unsigned long long now_ = __builtin_amdgcn_s_memrealtime(); if (tsi == TS_IDX) ts_a = now_; if (tsi == TS_IDX + 1) ts_b = now_; ++tsi; } while (0)
#else
#define TSP() do { } while (0)
#endif
#define SEAM(k) do { if (IN(k) && IN((k) + 1)) xcd_barrier(bar); TSP(); } while (0)
    TSP();
    float* sumsq2 = (float*)(F.ws + WS_CTL + CTL_SUMSQ2); float* sumsq3 = (float*)(F.ws + WS_CTL + CTL_SUMSQ3); float* sumsq4 = (float*)(F.ws + WS_CTL + CTL_SUMSQ4);

    if (IN(0)) { p0_prologue(F);
#if defined(REPEAT_PHASE) && REPEAT_PHASE == 0
        p0_prologue(F);
#endif
    } SEAM(0);
    if (IN(1)) {
        { pg8::Gemm g{WSP(bf16, WS_XB), WSP(bf16, WS_WIN), SEQ, NINP, DM}; pg8::StaticOrder S; S.init(SEQ, NINP, F.G, (int)blockIdx.x);
          EpiProj E{WSP(float, WS_RSTD1), WSP(bf16, WS_QKV), DOP(bf16, DO_Z), DOP(bf16, DO_QSW), DOP(bf16, DO_KVSW), WSP(float, WS_AB)};
          pg8::gemm_phase<EpiProj, pg8::StaticOrder, true, true>(F.lds + RING_OFF, g, S, E);
#if defined(REPEAT_PHASE) && REPEAT_PHASE == 1
          pg8::gemm_phase<EpiProj, pg8::StaticOrder, true, true>(F.lds + RING_OFF, g, S, E);
#endif
          }
        { const int nwg = (SEQ / 256) * (NINP / 256), rem = nwg % F.G; if (rem) p1_late_transposes(F, rem, F.G - rem); else p1_late_transposes(F, 0, F.G); }
    } SEAM(1);
    if (IN(2)) { dn_prep_phase<63>(F);
#if defined(REPEAT_PHASE) && REPEAT_PHASE == 2
        dn_prep_phase<63>(F);
#endif
#if defined(REPEAT_PHASE) && REPEAT_PHASE >= 1000 && REPEAT_PHASE < 1064
        dn_prep_phase<REPEAT_PHASE - 1000>(F);
#endif
    } SEAM(2);
    if (IN(3)) { dn_pass1(F);
#if defined(REPEAT_PHASE) && REPEAT_PHASE == 3
        dn_pass1(F);
#endif
    } SEAM(3);
    if (IN(12)) { dn_fold(F); }
#if defined(REPEAT_PHASE) && REPEAT_PHASE == 12
    if (IN(12)) { dn_fold(F); swa_phase(F, 1, F.G < NFOLD ? F.G : NFOLD); }
#endif
#if defined(REPEAT_PHASE) && REPEAT_PHASE == 112
    if (IN(12)) { dn_fold(F); }
#endif
#if defined(REPEAT_PHASE) && REPEAT_PHASE == 212
    if (IN(12)) { swa_phase(F, 0, F.G); }
#endif
    if (IN(12) && IN(13)) xcd_barrier(bar);
    TSP();
    if (IN(13)) { dn_pass3(F); swa_phase(F, 0, 0);
#if defined(REPEAT_PHASE) && REPEAT_PHASE == 13
        dn_pass3(F);
#endif
    } if (IN(13) && IN(4)) xcd_barrier(bar);
    TSP();
    if (IN(4)) { dn_combine(F);
#if defined(REPEAT_PHASE) && REPEAT_PHASE == 4
        dn_combine(F);
#endif
    } SEAM(4);
    if (IN(5)) {
        pg8::Gemm g{WSP(bf16, WS_XB), WSP(bf16, WS_WOUT), SEQ, DM, DM}; pg8::StaticOrder S; S.init(SEQ, DM, F.G, (int)blockIdx.x);
        EpiRes E{F.in[0], nullptr, nullptr, WSP(bf16, WS_H1B), sumsq2, (LAS float*)(F.lds + RING_BYTES)};
        pg8::gemm_phase<EpiRes, pg8::StaticOrder, true, true>(F.lds + RING_OFF, g, S, E);
#if defined(REPEAT_PHASE) && REPEAT_PHASE == 5
        { EpiRes E2{F.in[0], nullptr, nullptr, nullptr, (float*)(F.ws + WS_CTL + 448 * 1024), (LAS float*)(F.lds + RING_BYTES)}; pg8::gemm_phase<EpiRes, pg8::StaticOrder, true, true>(F.lds + RING_OFF, g, S, E2); }
#endif
    } SEAM(5);
    if (IN(6)) {
        pg8::Gemm g{WSP(bf16, WS_H1B), WSP(bf16, WS_WQ), SEQ, 512, DM}; pg8::StaticOrder S; S.init(SEQ, 512, F.G, (int)blockIdx.x);
        EpiScaleBf16 E{sumsq2, 1, QSCALE, WSP(bf16, WS_QM), 512};
        pg8::gemm_phase<EpiScaleBf16, pg8::StaticOrder, true, true>(F.lds + RING_OFF, g, S, E);
        { pg8::Gemm g2{WSP(bf16, WS_MEMB), WSP(bf16, WS_WKV), MEMT, 1024, DM}; pg8::StaticOrder S2; S2.init(MEMT, 1024, F.G, (int)((blockIdx.x + F.G - (F.G >> 1)) % F.G));
          EpiScaleBf16 E2{WSP(float, WS_RSTDM), 0, 1.0f, WSP(bf16, WS_KVM), 1024};
          pg8::gemm_phase<EpiScaleBf16, pg8::StaticOrder, true, true>(F.lds + RING_OFF, g2, S2, E2); }
        p4_transposes(F, 0, F.G);
#if defined(REPEAT_PHASE) && REPEAT_PHASE == 6
        pg8::gemm_phase<EpiScaleBf16, pg8::StaticOrder, true, true>(F.lds + RING_OFF, g, S, E);
#endif
    } SEAM(6);
    if (IN(7)) { mem_attn_phase(F);
#if defined(REPEAT_PHASE) && REPEAT_PHASE == 7
        mem_attn_phase(F);
#endif
    } SEAM(7);
    if (IN(8)) {
        pg8::Gemm g{WSP(bf16, WS_OM), WSP(bf16, WS_WO), SEQ, DM, 512}; pg8::StaticOrder S; S.init(SEQ, DM, F.G, (int)blockIdx.x);
        EpiRes E{nullptr, WSP(bf16, WS_H1B), nullptr, WSP(bf16, WS_XB), sumsq3, (LAS float*)(F.lds + RING_BYTES)};
        pg8::gemm_phase<EpiRes, pg8::StaticOrder, true, true>(F.lds + RING_OFF, g, S, E);
#if defined(REPEAT_PHASE) && REPEAT_PHASE == 8
        { EpiRes E2{nullptr, WSP(bf16, WS_H1B), nullptr, nullptr, (float*)(F.ws + WS_CTL + 448 * 1024), (LAS float*)(F.lds + RING_BYTES)}; pg8::gemm_phase<EpiRes, pg8::StaticOrder, true, true>(F.lds + RING_OFF, g, S, E2); }
#endif
    } SEAM(8);
    if (IN(9)) {
        pg8::Gemm g{WSP(bf16, WS_XB), WSP(bf16, WS_WGU), SEQ, 2 * DFF, DM}; pg8::StaticOrder S; S.init(SEQ, 2 * DFF, F.G, (int)blockIdx.x);
        EpiSwiglu E{sumsq3, WSP(bf16, WS_HID)};
        pg8::gemm_phase<EpiSwiglu, pg8::StaticOrder, true, true>(F.lds + RING_OFF, g, S, E);
#if defined(REPEAT_PHASE) && REPEAT_PHASE == 9
        pg8::gemm_phase<EpiSwiglu, pg8::StaticOrder, true, true>(F.lds + RING_OFF, g, S, E);
#endif
    } SEAM(9);
    if (IN(10)) {
        pg8::Gemm g{WSP(bf16, WS_HID), WSP(bf16, WS_WD), SEQ, DM, DFF}; pg8::StaticOrder S; S.init(SEQ, DM, F.G, (int)blockIdx.x);
        EpiRes E{nullptr, WSP(bf16, WS_XB), nullptr, WSP(bf16, WS_H3B), sumsq4, (LAS float*)(F.lds + RING_BYTES)};
        pg8::gemm_phase<EpiRes, pg8::StaticOrder, true, true>(F.lds + RING_OFF, g, S, E);
#if defined(REPEAT_PHASE) && REPEAT_PHASE == 10
        { EpiRes E2{nullptr, WSP(bf16, WS_XB), nullptr, nullptr, (float*)(F.ws + WS_CTL + 448 * 1024), (LAS float*)(F.lds + RING_BYTES)}; pg8::gemm_phase<EpiRes, pg8::StaticOrder, true, true>(F.lds + RING_OFF, g, S, E2); }
#endif
    } SEAM(10);
#if defined(REPEAT_PHASE) && REPEAT_PHASE == 99
    for (int k_ = 0; k_ < 10; ++k_) xcd_barrier(bar);
#endif
    if (IN(11)) { final_norm(F);
#if defined(REPEAT_PHASE) && REPEAT_PHASE == 11
        final_norm(F);
#endif
    }
    TSP();
#ifdef TS_IDX
    __syncthreads();
    if (blockIdx.x == 0 && F.tid == 0) F.out[0] += ((float)(ts_b - ts_a) - (float)(TS_OFFSET)) * TS_SCALE;
#endif
#undef IN
#undef SEAM
}

extern "C" void kernel_launch(void* const* d_in, const int* in_sizes, int n_in, void* d_out, int out_size, void* d_ws, size_t ws_size, hipStream_t stream) {
    static int grid = 0;
    if (grid == 0) {
        if (n_in != 23 || out_size != SEQ * DM || ws_size < WS_END) { fprintf(stderr, "kernel_launch: unexpected shapes (n_in %d out %d ws %zu)\n", n_in, out_size, ws_size); grid = -1; return; }
        int dev = 0, cus = 0;
        if (hipGetDevice(&dev) != hipSuccess || hipDeviceGetAttribute(&cus, hipDeviceAttributeMultiprocessorCount, dev) != hipSuccess) { grid = -1; return; }
        if (hipFuncSetAttribute((const void*)enc_fwd, hipFuncAttributeMaxDynamicSharedMemorySize, LDS_BYTES) != hipSuccess) { fprintf(stderr, "kernel_launch: hipFuncSetAttribute failed\n"); grid = -1; return; }
        (void)hipGetLastError();
        grid = cus;
    }
    if (grid < 0) return;
    if (hipMemsetAsync((char*)d_ws + WS_CTL, 0, CTL_ZERO_BYTES, stream) != hipSuccess) return;
    Args a{};
    for (int i = 0; i < 23; ++i) a.in[i] = (const float*)d_in[i];
    a.out = (float*)d_out; a.ws = (unsigned char*)d_ws;
    const int per = (N_PHASES + MK_N_LAUNCHES - 1) / MK_N_LAUNCHES;
    for (int lo = 0; lo < N_PHASES; lo += per) {
        a.ph_lo = lo; a.ph_hi = (lo + per < N_PHASES) ? lo + per : N_PHASES;
        hipLaunchKernelGGL(enc_fwd, dim3(grid), dim3(NWAVES * 64), LDS_BYTES, stream, a);
    }
}
```

```cpp
#include <hip/hip_runtime.h>
#include <cstdio>
#include <cstdint>

namespace pg8 {
__device__ __forceinline__ unsigned cvt_pk_bf16(float lo, float hi) { unsigned r; asm volatile("v_cvt_pk_bf16_f32 %0, %1, %2" : "=v"(r) : "v"(lo), "v"(hi)); return r; }
#define PG8_LAS __attribute__((address_space(3)))
typedef unsigned short bf16_t;
typedef short bf16x8 __attribute__((ext_vector_type(8)));
typedef float f32x4 __attribute__((ext_vector_type(4)));
typedef unsigned u32x4 __attribute__((ext_vector_type(4)));
constexpr int BM = 256, BK = 64, HALF = 128, HTB = HALF * BK * 2  , STAGE_BYTES = 8 * HTB, NXCD = 8, WGM = 8;

__host__ __device__ __forceinline__ int lds_byte(int r, int c) { const int st = (r >> 4) * 2 + (c >> 5), rr = r & 15, cc = c & 31, ob = rr * 64 + cc * 2; return st * 1024 + (ob ^ (((ob >> 9) & 1) << 5)); }
__host__ __device__ __forceinline__ void stage_rc(int b, int& R, int& C) { const int st = b / 1024, sb = b % 1024, swz = sb ^ (((sb >> 9) & 1) << 5); R = (st >> 1) * 16 + swz / 64; C = (st & 1) * 32 + (swz % 64) / 2; }
__host__ __device__ __forceinline__ int perm32(int rho) { const int n = rho >> 4, i = rho & 15; return 8 * (i >> 2) + 4 * n + (i & 3); }

struct Unit { int pm, pn; };
struct Gemm { const bf16_t* A; const bf16_t* Bt; int M, N, K; };

struct StaticOrder {
    int nM, nN, nwg, G, c;
    __host__ __device__ void init(int M, int N, int G_, int c_) { nM = M / BM; nN = N / BM; nwg = nM * nN; G = G_; c = c_; }
    __host__ __device__ bool next(int i, Unit& u) const {
        const long L = (long)i * G + c; if (L >= nwg) return false;
        int wgid = (int)L; { const int q = nwg / NXCD, r = nwg % NXCD, xcd = wgid % NXCD, off = wgid / NXCD; wgid = (xcd < r ? xcd * (q + 1) : r * (q + 1) + (xcd - r) * q) + off; }
        const int nig = WGM * nN, gid = wgid / nig, fm = gid * WGM, gsz = (nM - fm) < WGM ? (nM - fm) : WGM;
        u.pm = fm + ((wgid % nig) % gsz); u.pn = (wgid % nig) / gsz; return true;
    }
    __device__ __forceinline__ void a_ready(const Unit&) const {}
    __device__ __forceinline__ void done(const Unit&) const {}
};

template <class Epi, class Sched, bool ALIGN_EPI = false, bool SP2 = false>
__device__ __forceinline__ void gemm_phase(PG8_LAS unsigned char* lds, const Gemm g, const Sched& S, const Epi& E) {
    const int tid = threadIdx.x, wid = __builtin_amdgcn_readfirstlane(tid >> 6), lane = tid & 63, wr = wid >> 2, wc = wid & 3, fr = lane & 15, fq = lane >> 4;
    const int K = g.K, nt = K / BK;
    unsigned voffA[2], voffB[2];
#pragma unroll
    for (int i = 0; i < 2; ++i) { int R, C; stage_rc(tid * 16 + i * 8192, R, C); const int Rb = Epi::PERM ? ((R & ~31) + perm32(R & 31)) : R;
        voffA[i] = (unsigned)(R * K + C) * 2u; voffB[i] = (unsigned)(Rb * K + C) * 2u; }
    const size_t kstep = (size_t)(BK * 2);
    const size_t hstep = (size_t)HALF * K * 2;
    const size_t tstep = 2 * hstep;
    const unsigned ldsw = (unsigned)wid * 1024u;
    const int aoff = lds_byte(wr * 64 + fr, fq * 8), boff = lds_byte(wc * 32 + fr, fq * 8);
#define PG8_SA(b, h) (((b) * 2 + (h)) * HTB)
#define PG8_SB(b, h) ((4 + (b) * 2 + (h)) * HTB)
#define PG8_STAGE(bufoff, gbase, voff) do { _Pragma("unroll") for (int _i = 0; _i < 2; ++_i) \
        __builtin_amdgcn_global_load_lds((const unsigned*)((const char*)(gbase) + (voff)[_i]), (PG8_LAS unsigned*)(lds + (bufoff) + ldsw + _i * 8192), 16, 0, 0); } while (0)
#define PG8_LDA(dst, b, h) do { _Pragma("unroll") for (int m = 0; m < 4; ++m) _Pragma("unroll") for (int k = 0; k < 2; ++k) dst[m][k] = *(const PG8_LAS bf16x8*)(lds + PG8_SA(b, h) + aoff + m * 2048 + k * 1024); } while (0)
#define PG8_LDB(dst, b, h) do { _Pragma("unroll") for (int n = 0; n < 2; ++n) _Pragma("unroll") for (int k = 0; k < 2; ++k) dst[n][k] = *(const PG8_LAS bf16x8*)(lds + PG8_SB(b, h) + boff + n * 2048 + k * 1024); } while (0)
#define PG8_MMA(ai, bj, At, Bt) do { __builtin_amdgcn_s_setprio(1); _Pragma("unroll") for (int m = 0; m < 4; ++m) _Pragma("unroll") for (int n = 0; n < 2; ++n) _Pragma("unroll") for (int k = 0; k < 2; ++k) \
        acc[ai][bj][m][n] = __builtin_amdgcn_mfma_f32_16x16x32_bf16(Bt[n][k], At[m][k], acc[ai][bj][m][n], 0, 0, 0); __builtin_amdgcn_s_setprio(0); } while (0)
#define PG8_WAIT_V(n) asm volatile("s_waitcnt vmcnt(" #n ")" ::: "memory")
#define PG8_WAIT_L(n) asm volatile("s_waitcnt lgkmcnt(" #n ")" ::: "memory")
#define PG8_BAR __builtin_amdgcn_s_barrier()
#define PG8_SCHED __builtin_amdgcn_sched_barrier(0)
    Unit cur, nxt; int ui = 0;
    if (!S.next(0, cur)) return;
    f32x4 acc[2][2][4][2];
#pragma unroll
    for (int a = 0; a < 2; ++a)
#pragma unroll
        for (int b = 0; b < 2; ++b)
#pragma unroll
            for (int m = 0; m < 4; ++m)
#pragma unroll
                for (int n = 0; n < 2; ++n) acc[a][b][m][n] = (f32x4){0.f, 0.f, 0.f, 0.f};
    bf16x8 At[4][2], B0[2][2], B1[2][2];
    const char* cA = (const char*)g.A + (size_t)cur.pm * tstep; const char* cB = (const char*)g.Bt + (size_t)cur.pn * tstep;
    S.a_ready(cur);
    if constexpr (SP2) {
        PG8_STAGE(PG8_SB(0, 0), cB, voffB); PG8_STAGE(PG8_SB(0, 1), cB + hstep, voffB); PG8_STAGE(PG8_SA(0, 0), cA, voffA); PG8_STAGE(PG8_SA(0, 1), cA + hstep, voffA);
        if (wr == 1) PG8_BAR;
        PG8_WAIT_V(2); PG8_BAR;
        PG8_STAGE(PG8_SB(1, 0), cB + kstep, voffB); PG8_STAGE(PG8_SA(1, 0), cA + kstep, voffA); PG8_STAGE(PG8_SB(1, 1), cB + hstep + kstep, voffB);
        PG8_WAIT_V(6); PG8_BAR;
    } else {
        PG8_STAGE(PG8_SB(0, 0), cB, voffB); PG8_STAGE(PG8_SA(0, 0), cA, voffA); PG8_STAGE(PG8_SB(0, 1), cB + hstep, voffB); PG8_STAGE(PG8_SA(0, 1), cA + hstep, voffA);
        if (wr == 1) PG8_BAR;
        PG8_WAIT_V(4); PG8_BAR;
        PG8_STAGE(PG8_SB(1, 0), cB + kstep, voffB); PG8_STAGE(PG8_SA(1, 0), cA + kstep, voffA); PG8_STAGE(PG8_SB(1, 1), cB + hstep + kstep, voffB);
        PG8_WAIT_V(6); PG8_BAR;
    }
    for (;;) {
        const bool has_next = S.next(ui + 1, nxt);
        const char* nA = has_next ? (const char*)g.A + (size_t)nxt.pm * tstep : cA; const char* nB = has_next ? (const char*)g.Bt + (size_t)nxt.pn * tstep : cB;
        for (int t = 0; t < nt; t += 2) {
            const bool last = (t == nt - 2);
            const char* a1 = cA + (size_t)(t + 1) * kstep;
            const char* a2 = last ? nA : cA + (size_t)(t + 2) * kstep; const char* b2 = last ? nB : cB + (size_t)(t + 2) * kstep;
            const char* a3 = a2 + kstep; const char* b3 = b2 + kstep;
            if (last && has_next) S.a_ready(nxt);
            if constexpr (SP2) {
            PG8_LDB(B0, 0, 0); PG8_LDB(B1, 0, 1); PG8_SCHED; PG8_LDA(At, 0, 0); PG8_STAGE(PG8_SA(1, 1), a1 + hstep, voffA);
            PG8_WAIT_V(8); PG8_WAIT_L(0); PG8_BAR; PG8_MMA(0, 0, At, B0); PG8_MMA(0, 1, At, B1); PG8_BAR; PG8_SCHED;
            PG8_LDA(At, 0, 1); PG8_STAGE(PG8_SB(0, 0), b2, voffB); PG8_STAGE(PG8_SB(0, 1), b2 + hstep, voffB); PG8_STAGE(PG8_SA(0, 0), a2, voffA);
            PG8_WAIT_V(8); PG8_WAIT_L(0); PG8_BAR; PG8_MMA(1, 0, At, B0); PG8_MMA(1, 1, At, B1); PG8_BAR; PG8_SCHED;
            PG8_LDB(B0, 1, 0); PG8_LDB(B1, 1, 1); PG8_SCHED; PG8_LDA(At, 1, 0); PG8_STAGE(PG8_SA(0, 1), a2 + hstep, voffA);
            PG8_WAIT_V(8); PG8_WAIT_L(0); PG8_BAR; PG8_MMA(0, 0, At, B0); PG8_MMA(0, 1, At, B1); PG8_BAR; PG8_SCHED;
            PG8_LDA(At, 1, 1); PG8_STAGE(PG8_SB(1, 0), b3, voffB); PG8_STAGE(PG8_SB(1, 1), b3 + hstep, voffB); PG8_STAGE(PG8_SA(1, 0), a3, voffA);
            PG8_WAIT_V(8); PG8_WAIT_L(0); PG8_BAR; PG8_MMA(1, 0, At, B0); PG8_MMA(1, 1, At, B1); PG8_BAR; PG8_SCHED;
            } else {
            PG8_LDB(B0, 0, 0); PG8_SCHED; PG8_LDA(At, 0, 0); PG8_STAGE(PG8_SA(1, 1), a1 + hstep, voffA);
            PG8_WAIT_L(8); PG8_BAR; PG8_WAIT_L(0); PG8_MMA(0, 0, At, B0); PG8_BAR; PG8_SCHED;
            PG8_LDB(B1, 0, 1); PG8_STAGE(PG8_SB(0, 0), b2, voffB);
            PG8_BAR; PG8_WAIT_L(0); PG8_MMA(0, 1, At, B1); PG8_BAR;
            PG8_LDA(At, 0, 1); PG8_STAGE(PG8_SA(0, 0), a2, voffA);
            PG8_BAR; PG8_WAIT_L(0); PG8_MMA(1, 0, At, B0); PG8_BAR; PG8_SCHED;
            PG8_STAGE(PG8_SB(0, 1), b2 + hstep, voffB);
            PG8_WAIT_V(6); PG8_BAR; PG8_MMA(1, 1, At, B1); PG8_BAR;
            PG8_LDB(B0, 1, 0); PG8_SCHED; PG8_LDA(At, 1, 0); PG8_STAGE(PG8_SA(0, 1), a2 + hstep, voffA);
            PG8_WAIT_L(8); PG8_BAR; PG8_WAIT_L(0); PG8_MMA(0, 0, At, B0); PG8_BAR; PG8_SCHED;
            PG8_LDB(B1, 1, 1); PG8_STAGE(PG8_SB(1, 0), b3, voffB);
            PG8_BAR; PG8_WAIT_L(0); PG8_MMA(0, 1, At, B1); PG8_BAR;
            PG8_LDA(At, 1, 1); PG8_STAGE(PG8_SA(1, 0), a3, voffA);
            PG8_BAR; PG8_WAIT_L(0); PG8_MMA(1, 0, At, B0); PG8_BAR; PG8_SCHED;
            PG8_STAGE(PG8_SB(1, 1), b3 + hstep, voffB);
            PG8_WAIT_V(6); PG8_BAR; PG8_MMA(1, 1, At, B1); PG8_BAR;
            }
        }
        if constexpr (ALIGN_EPI) { if (wr == 0) PG8_BAR; }
        if constexpr (!Epi::AFTER_DRAIN) { E(acc, cur, wr, wc, fr, fq); S.done(cur); }
        if (!has_next) break;
#pragma unroll
        for (int a = 0; a < 2; ++a)
#pragma unroll
            for (int b = 0; b < 2; ++b)
#pragma unroll
                for (int m = 0; m < 4; ++m)
#pragma unroll
                    for (int n = 0; n < 2; ++n) acc[a][b][m][n] = (f32x4){0.f, 0.f, 0.f, 0.f};
        cur = nxt; cA = nA; cB = nB; ++ui;
        if constexpr (ALIGN_EPI) { if (wr == 1) PG8_BAR; }
    }
    PG8_WAIT_V(0);
    if constexpr (!ALIGN_EPI) { if (wr == 0) PG8_BAR; }
    PG8_BAR;
    if constexpr (Epi::AFTER_DRAIN) { E.fused(acc, cur, wr, wc, fr, fq, lds, wid, lane); S.done(cur); }
#undef PG8_SA
#undef PG8_SB
#undef PG8_STAGE
#undef PG8_LDA
#undef PG8_LDB
#undef PG8_MMA
#undef PG8_WAIT_V
#undef PG8_WAIT_L
#undef PG8_BAR
#undef PG8_SCHED
}
}

constexpr int NWAVES = 8;
constexpr int SEQ = 16384, DM = 2048, NIN = 5664, NINP = 5888, DFF = 5632;
constexpr int DNH = 8, HD = 128, SWH = 8, MEMH = 4, MEMT = 256;
constexpr float RMS_EPS = 1e-6f;
constexpr float LOG2E = 1.4426950408889634f;
constexpr float QSCALE = 0.08838834764831845f * 1.4426950408889634f;

constexpr size_t MiB = 1u << 20;
constexpr size_t WS_CTL = 0, CTL_ZERO_BYTES = 1 * MiB;
constexpr size_t CTL_SUMSQ2 = 256 * 1024, CTL_SUMSQ3 = 320 * 1024, CTL_SUMSQ4 = 384 * 1024;
constexpr size_t WS_RSTD1 = 1 * MiB, WS_RSTDM = 1 * MiB + 64 * 1024;
constexpr size_t WS_MEMB = 2 * MiB, WS_KVM = 3 * MiB, WS_AB = 4 * MiB, WS_BG = 6 * MiB;
constexpr size_t WS_WOUT = 8 * MiB, WS_WQ = 16 * MiB, WS_WKV = 18 * MiB, WS_WO = 22 * MiB, WS_WIN = 24 * MiB;
constexpr size_t WS_XB = 48 * MiB;
constexpr size_t WS_QKV = 112 * MiB;
constexpr size_t WS_H3B = 112 * MiB;
constexpr size_t WS_YMIX = 112 * MiB;
constexpr size_t WS_OB = 176 * MiB, WS_H1B = 406 * MiB, WS_QM = 176 * MiB, WS_OM = 192 * MiB;
constexpr size_t WS_DNX = 208 * MiB;
constexpr size_t WS_WD = 208 * MiB, WS_HID = 230 * MiB, WS_END = 496 * MiB;
constexpr size_t DO_Z = 0, DO_QSW = 32 * MiB, DO_KVSW = 64 * MiB, DO_WGU = 80 * MiB;
constexpr int CW_BAR = 4096, CW_SWAQ = 8192, CW_FOLDDONE = 8256, CW_TRQ = 8320;

constexpr int RING_OFF = 0, RING_BYTES = 131072;
constexpr int LDS_BYTES = 163840;
constexpr int LDSCTL_OFF = LDS_BYTES - 512, MISC_OFF = LDSCTL_OFF + 320;

#define GAS __attribute__((address_space(1)))
#define LAS __attribute__((address_space(3)))
typedef unsigned short bf16;
typedef unsigned v4u __attribute__((ext_vector_type(4)));
typedef unsigned v2u __attribute__((ext_vector_type(2)));
typedef float f32x4 __attribute__((ext_vector_type(4)));
typedef short bf16x8 __attribute__((ext_vector_type(8)));
typedef short s16x4 __attribute__((ext_vector_type(4)));
typedef GAS unsigned gu32;
#define RLX_AGENT __ATOMIC_RELAXED, __HIP_MEMORY_SCOPE_AGENT
#define LDS_WAIT() asm volatile("s_waitcnt lgkmcnt(0)" ::: "memory")
#define VM_WAIT() asm volatile("s_waitcnt vmcnt(0)" ::: "memory")
__device__ __forceinline__ unsigned f2bf(float f) { unsigned u = __builtin_bit_cast(unsigned, f); return (u + 0x7fffu + ((u >> 16) & 1u)) >> 16; }
__device__ __forceinline__ unsigned pk2(float lo, float hi) { return f2bf(lo) | (f2bf(hi) << 16); }
__device__ __forceinline__ float bf2f(unsigned short b) { return __builtin_bit_cast(float, (unsigned)b << 16); }
__device__ __forceinline__ float bflo(unsigned w) { return __builtin_bit_cast(float, w << 16); }
__device__ __forceinline__ float bfhi(unsigned w) { return __builtin_bit_cast(float, w & 0xffff0000u); }
typedef float f32x2_t __attribute__((ext_vector_type(2))); typedef __bf16 bf16x2_t __attribute__((ext_vector_type(2)));
__device__ __forceinline__ unsigned cvtpk(float lo, float hi) { f32x2_t v = {lo, hi}; bf16x2_t b = __builtin_convertvector(v, bf16x2_t); return __builtin_bit_cast(unsigned, b); }
__device__ __forceinline__ float wave_sum(float v) {
#pragma unroll
    for (int o = 1; o < 64; o <<= 1) v += __shfl_xor(v, o);
    return v;
}
__device__ __forceinline__ float siluf(float x) { return x * __builtin_amdgcn_rcpf(1.0f + __expf(-x)); }
#define XB_TMO      128
#define XB_XCNT(j)  (256  + 64 * (j))
#define XB_XSUB(j)  (1280 + 64 * (j))
#define XB_XGEN(j)  (2304 + 64 * (j))
#define XB_TOP      3328
#define XB_TOPGEN   3392
#define XCD_BAR_WORDS 3456
#define XB_SPIN_CAP (1u << 18)

__device__ __forceinline__ unsigned xb_ld(unsigned* p)              { return __hip_atomic_load(p, __ATOMIC_RELAXED, __HIP_MEMORY_SCOPE_AGENT); }
__device__ __forceinline__ unsigned xb_add(unsigned* p, unsigned v) { return __hip_atomic_fetch_add(p, v, __ATOMIC_RELAXED, __HIP_MEMORY_SCOPE_AGENT); }
__device__ __forceinline__ unsigned xb_xcc_id() { return (unsigned)__builtin_amdgcn_s_getreg((3 << 11) | 20) & 0xFu; }
#define XB_SPIN(cond, bar) do { unsigned _sp = 0; while (cond) { __builtin_amdgcn_s_sleep(1); \
    if ((++_sp & 255u) == 0u) { if (xb_ld(&(bar)[XB_TMO])) break; if (_sp > XB_SPIN_CAP) { atomicAdd(&(bar)[XB_TMO], 1u); break; } } } } while (0)

struct XcdBarrier {
    unsigned* bar; unsigned x;
    volatile LAS unsigned* st;
};

__device__ __forceinline__ XcdBarrier xcd_barrier_post(unsigned* bar, volatile LAS unsigned* st) {
    XcdBarrier b; b.bar = bar; b.x = xb_xcc_id(); b.st = st;
    if (threadIdx.x == 0) (void)xb_add(&bar[XB_XCNT(b.x)], 1u);
    return b;
}
__device__ __forceinline__ void xcd_barrier_complete(unsigned* bar, unsigned x, unsigned& nloc, unsigned& nx) {
    const unsigned G = gridDim.x * gridDim.y * gridDim.z;
    unsigned sum, cnt, mine, sp = 0u;
    for (;;) {
        sum = 0u; cnt = 0u; mine = 0u;
#pragma unroll
        for (unsigned j = 0; j < 16; ++j) { const unsigned c = xb_ld(&bar[XB_XCNT(j)]); sum += c; cnt += (c > 0u) ? 1u : 0u; mine = (j == x) ? c : mine; }
        if (sum == G) break;
        __builtin_amdgcn_s_sleep(1);
        if ((++sp & 255u) == 0u) { if (xb_ld(&bar[XB_TMO])) break; if (sp > XB_SPIN_CAP) { atomicAdd(&bar[XB_TMO], 1u); break; } }
    }
    nloc = mine > 0u ? mine : 1u; nx = cnt > 0u ? cnt : 1u;
}

__device__ __forceinline__ void xcd_barrier(const XcdBarrier& b) {
    asm volatile("s_waitcnt vmcnt(0)" ::: "memory");
    __syncthreads();
    if (threadIdx.x == 0) {
        unsigned* bar = b.bar;
        __builtin_amdgcn_s_waitcnt(0);
        unsigned nloc = b.st[0], nx = b.st[1];
        if (nloc == 0u) { xcd_barrier_complete(bar, b.x, nloc, nx); b.st[0] = nloc; b.st[1] = nx; }
        const unsigned old = xb_add(&bar[XB_XSUB(b.x)], 1u);
        const unsigned gen = old / nloc;
        if (old + 1u == (gen + 1u) * nloc) {
            __builtin_amdgcn_fence(__ATOMIC_RELEASE, "agent");
            asm volatile("s_waitcnt vmcnt(0)" ::: "memory");
            const unsigned og = xb_add(&bar[XB_TOP], 1u);
            const unsigned tg = og / nx;
            if (og + 1u == (tg + 1u) * nx) xb_add(&bar[XB_TOPGEN], 1u);
            else XB_SPIN(xb_ld(&bar[XB_TOPGEN]) == tg, bar);
            __builtin_amdgcn_fence(__ATOMIC_ACQUIRE, "agent");
            xb_add(&bar[XB_XGEN(b.x)], 1u);
            asm volatile("s_waitcnt vmcnt(0)" ::: "memory");
        } else {
            XB_SPIN(xb_ld(&bar[XB_XGEN(b.x)]) == gen, bar);
            __builtin_amdgcn_fence(__ATOMIC_ACQUIRE, "agent");
            asm volatile("s_waitcnt vmcnt(0)" ::: "memory");
        }
    }
    __syncthreads();
}

using pg8::Unit;
__device__ __forceinline__ v4u pack8(f32x4 v0, f32x4 v1) { v4u w; w.x = cvtpk(v0[0], v0[1]); w.y = cvtpk(v0[2], v0[3]); w.z = cvtpk(v1[0], v1[1]); w.w = cvtpk(v1[2], v1[3]); return w; }

struct EpiProj {
    static constexpr bool PERM = true, AFTER_DRAIN = false;
    const float* rstd; bf16* qkv; bf16* z; bf16* qsw; bf16* kvsw; float* ab;
    __device__ __forceinline__ void operator()(const f32x4 (&acc)[2][2][4][2], const Unit& u, int wr, int wc, int fr, int fq) const {
        const int pn = u.pn; bf16* base; int ldc, colt; float sc = 1.f;
        if (pn < 12) { base = qkv; ldc = 3072; colt = pn * 256; }
        else if (pn < 16) { base = z; ldc = 1024; colt = (pn - 12) * 256; }
        else if (pn < 20) { base = qsw; ldc = 1024; colt = (pn - 16) * 256; sc = QSCALE; }
        else if (pn < 22) { base = kvsw; ldc = 512; colt = (pn - 20) * 256; }
        else { base = nullptr; ldc = 0; colt = 0; }
        const int row0 = u.pm * 256 + wr * 64 + fr, col0 = colt + wc * 32 + 8 * fq;
        float rsv[2][4];
#pragma unroll
        for (int ai = 0; ai < 2; ++ai)
#pragma unroll
            for (int m = 0; m < 4; ++m) rsv[ai][m] = rstd[row0 + ai * 128 + m * 16];
#pragma unroll
        for (int ai = 0; ai < 2; ++ai)
#pragma unroll
            for (int m = 0; m < 4; ++m) {
                const int row = row0 + ai * 128 + m * 16; const float rs = rsv[ai][m] * sc;
                if (base) {
                    bf16* rowp = base + (size_t)row * ldc + col0;
#pragma unroll
                    for (int bj = 0; bj < 2; ++bj) *(v4u*)(rowp + bj * 128) = pack8(acc[ai][bj][m][0] * rs, acc[ai][bj][m][1] * rs);
                } else if (wc == 0) {
                    float* rowp = ab + (size_t)row * 32 + 8 * fq;
                    *(f32x4*)(rowp) = acc[ai][0][m][0] * rs; *(f32x4*)(rowp + 4) = acc[ai][0][m][1] * rs;
                }
            }
    }
};
struct EpiScaleBf16 {
    static constexpr bool PERM = true, AFTER_DRAIN = false;
    const float* rs; int from_sumsq; float sc; bf16* O; int ldc;
    __device__ __forceinline__ void operator()(const f32x4 (&acc)[2][2][4][2], const Unit& u, int wr, int wc, int fr, int fq) const {
        const int row0 = u.pm * 256 + wr * 64 + fr, col0 = u.pn * 256 + wc * 32 + 8 * fq;
        float rsv[2][4];
#pragma unroll
        for (int ai = 0; ai < 2; ++ai)
#pragma unroll
            for (int m = 0; m < 4; ++m) rsv[ai][m] = rs[row0 + ai * 128 + m * 16];
#pragma unroll
        for (int ai = 0; ai < 2; ++ai)
#pragma unroll
            for (int m = 0; m < 4; ++m) {
                const int row = row0 + ai * 128 + m * 16; float r = rsv[ai][m];
                if (from_sumsq) r = __builtin_amdgcn_rsqf(r * (1.0f / DM) + RMS_EPS);
                r *= sc; bf16* rowp = O + (size_t)row * ldc + col0;
#pragma unroll
                for (int bj = 0; bj < 2; ++bj) *(v4u*)(rowp + bj * 128) = pack8(acc[ai][bj][m][0] * r, acc[ai][bj][m][1] * r);
            }
    }
};
struct EpiRes {
    static constexpr bool PERM = true, AFTER_DRAIN = false;
    const float* res; const bf16* resb; float* out; bf16* ob; float* sumsq; LAS float* part;
    __device__ __forceinline__ void tail(const f32x4 (&acc)[2][2][4][2], const f32x4 (&rr)[4][2][2], int ai, int row0, int col0, int fq, int prow0, int wc) const {
#pragma unroll
        for (int m = 0; m < 4; ++m) {
            const int row = row0 + ai * 128 + m * 16; const size_t off = (size_t)row * DM + col0; float ss = 0.f;
#pragma unroll
            for (int bj = 0; bj < 2; ++bj) {
                const f32x4 v0 = acc[ai][bj][m][0] + rr[m][bj][0], v1 = acc[ai][bj][m][1] + rr[m][bj][1];
                if (out) { *(f32x4*)(out + off + bj * 128) = v0; *(f32x4*)(out + off + bj * 128 + 4) = v1; }
                if (ob) *(v4u*)(ob + off + bj * 128) = pack8(v0, v1);
                ss += (v0[0] * v0[0] + v0[1] * v0[1]) + (v0[2] * v0[2] + v0[3] * v0[3]) + (v1[0] * v1[0] + v1[1] * v1[1]) + (v1[2] * v1[2] + v1[3] * v1[3]);
            }
            ss += __shfl_xor(ss, 16); ss += __shfl_xor(ss, 32);
            if (fq == 0) part[(prow0 + ai * 128 + m * 16) * 4 + wc] = ss;
        }
    }
    __device__ __forceinline__ void finish(const Unit& u) const {
        asm volatile("s_waitcnt lgkmcnt(0)" ::: "memory"); __builtin_amdgcn_s_barrier(); asm volatile("" ::: "memory");
        const int tid = threadIdx.x, lane = tid & 63, w = tid >> 6;
        if (lane < 32) { const int r = 32 * w + lane; const f32x4 v = *(const LAS f32x4*)(part + r * 4); atomicAdd(sumsq + u.pm * 256 + r, (v[0] + v[1]) + (v[2] + v[3])); }
        asm volatile("s_waitcnt lgkmcnt(0)" ::: "memory"); __builtin_amdgcn_s_barrier(); asm volatile("" ::: "memory");
    }
    __device__ __forceinline__ void operator()(const f32x4 (&acc)[2][2][4][2], const Unit& u, int wr, int wc, int fr, int fq) const {
        const int row0 = u.pm * 256 + wr * 64 + fr, col0 = u.pn * 256 + wc * 32 + 8 * fq, prow0 = wr * 64 + fr;
        if (resb) {
#pragma unroll
            for (int ai = 0; ai < 2; ++ai) {
                v4u rb[4][2]; f32x4 rr[4][2][2];
#pragma unroll
                for (int m = 0; m < 4; ++m) { const size_t off = (size_t)(row0 + ai * 128 + m * 16) * DM + col0;
#pragma unroll
                    for (int bj = 0; bj < 2; ++bj) rb[m][bj] = *(const v4u*)(resb + off + bj * 128); }
                asm volatile("" ::: "memory");
#pragma unroll
                for (int m = 0; m < 4; ++m)
#pragma unroll
                    for (int bj = 0; bj < 2; ++bj) { const v4u w = rb[m][bj]; rr[m][bj][0] = (f32x4){bflo(w.x), bfhi(w.x), bflo(w.y), bfhi(w.y)}; rr[m][bj][1] = (f32x4){bflo(w.z), bfhi(w.z), bflo(w.w), bfhi(w.w)}; }
                tail(acc, rr, ai, row0, col0, fq, prow0, wc);
                asm volatile("" ::: "memory");
            }
        } else {
#pragma unroll
            for (int ai = 0; ai < 2; ++ai) {
                f32x4 rr[4][2][2];
#pragma unroll
                for (int m = 0; m < 4; ++m) { const size_t off = (size_t)(row0 + ai * 128 + m * 16) * DM + col0;
#pragma unroll
                    for (int bj = 0; bj < 2; ++bj) { rr[m][bj][0] = *(const f32x4*)(res + off + bj * 128); rr[m][bj][1] = *(const f32x4*)(res + off + bj * 128 + 4); } }
                asm volatile("" ::: "memory");
                tail(acc, rr, ai, row0, col0, fq, prow0, wc);
                asm volatile("" ::: "memory");
            }
        }
        finish(u);
    }
};
struct EpiSwiglu {
    static constexpr bool PERM = true, AFTER_DRAIN = false;
    const float* sumsq; bf16* H;
    __device__ __forceinline__ void operator()(const f32x4 (&acc)[2][2][4][2], const Unit& u, int wr, int wc, int fr, int fq) const {
        const int row0 = u.pm * 256 + wr * 64 + fr, col0 = u.pn * 128 + wc * 32 + 8 * fq;
        float rsv[2][4];
#pragma unroll
        for (int ai = 0; ai < 2; ++ai)
#pragma unroll
            for (int m = 0; m < 4; ++m) rsv[ai][m] = sumsq[row0 + ai * 128 + m * 16];
#pragma unroll
        for (int ai = 0; ai < 2; ++ai)
#pragma unroll
            for (int m = 0; m < 4; ++m) {
                const int row = row0 + ai * 128 + m * 16; const float r = __builtin_amdgcn_rsqf(rsv[ai][m] * (1.0f / DM) + RMS_EPS);
                f32x4 h[2];
#pragma unroll
                for (int n = 0; n < 2; ++n)
#pragma unroll
                    for (int e = 0; e < 4; ++e) { const float g = acc[ai][0][m][n][e] * r, up = acc[ai][1][m][n][e] * r; h[n][e] = siluf(g) * up; }
                *(v4u*)(H + (size_t)row * DFF + col0) = pack8(h[0], h[1]);
            }
    }
};

struct Frame {
    LAS unsigned char* lds;
    volatile LAS unsigned* MISC;
    gu32* ctl;
    int tid, lane, wave, vcu, G;
    const float* in[23]; float* out; unsigned char* ws;
};
#define WSP(T, off) ((T*)(F.ws + (off)))
#define DOP(T, off) ((T*)((unsigned char*)F.out + (off)))

#ifndef W_TEMPORAL
#define W_NT 1
#endif
struct TrDesc { const float* W; const float* gain; bf16* WT; int K, Nsrc, src_col0, dst_row0, k0; };
constexpr int TR_SCR = 8704, TR_WAVE = 2 * TR_SCR;
__device__ __forceinline__ void tr_store(const TrDesc& D, const LAS float* scr, int lane) {
    const int c = lane & 7;
#pragma unroll
    for (int j = 0; j < 4; ++j) { const int n = (lane >> 3) + 8 * j; const LAS float* s = scr + (8 * c) * 33 + n;
        v4u o; o.x = pk2(s[0 * 33], s[1 * 33]); o.y = pk2(s[2 * 33], s[3 * 33]); o.z = pk2(s[4 * 33], s[5 * 33]); o.w = pk2(s[6 * 33], s[7 * 33]);
        *(GAS v4u*)(D.WT + (size_t)(D.dst_row0 + n) * D.K + D.k0 + 8 * c) = o; }
}
__device__ __forceinline__ void tr_pair(const TrDesc& A, const TrDesc& B, bool hasB, LAS float* scr, int lane) {
#ifndef TR_NO_X4
    if (hasB && A.W == B.W && A.src_col0 >= 0 && B.src_col0 == A.src_col0 + 32 && A.k0 == B.k0) {
        const int q = lane & 15, r = lane >> 4;
        const float* src = A.W + (size_t)(A.k0 + r) * A.Nsrc + A.src_col0 + 4 * q;
        f32x4 v[16];
#pragma unroll
#ifdef W_NT
        for (int i = 0; i < 16; ++i) v[i] = __builtin_nontemporal_load((const f32x4*)(src + (size_t)(4 * i) * A.Nsrc));
#else
        for (int i = 0; i < 16; ++i) v[i] = *(const f32x4*)(src + (size_t)(4 * i) * A.Nsrc);
#endif
        if (A.gain) {
#pragma unroll
            for (int i = 0; i < 16; ++i) v[i] = v[i] * A.gain[A.k0 + 4 * i + r]; }
        LAS float* sh = (q >= 8) ? (LAS float*)((LAS unsigned char*)scr + TR_SCR) : scr; const int nn = (4 * q) & 31;
#pragma unroll
        for (int i = 0; i < 16; ++i) { LAS float* d = sh + (4 * i + r) * 33 + nn; d[0] = v[i][0]; d[1] = v[i][1]; d[2] = v[i][2]; d[3] = v[i][3]; }
        LDS_WAIT(); asm volatile("" ::: "memory");
        tr_store(A, scr, lane); tr_store(B, (const LAS float*)((const LAS unsigned char*)scr + TR_SCR), lane);
        LDS_WAIT(); asm volatile("" ::: "memory");
        return;
    }
#endif
    const bool second = lane >= 32; const TrDesc& D = second ? B : A;
    const bool live = (!second || hasB) && D.src_col0 >= 0;
    LAS float* s = second ? (LAS float*)((LAS unsigned char*)scr + TR_SCR) : scr;
    const float* src = D.W + (size_t)D.k0 * D.Nsrc + (live ? D.src_col0 : 0) + (lane & 31);
    float v[64];
#pragma unroll
#ifdef W_NT
    for (int i = 0; i < 64; ++i) v[i] = live ? __builtin_nontemporal_load(src + (size_t)i * D.Nsrc) : 0.f;
#else
    for (int i = 0; i < 64; ++i) v[i] = live ? src[(size_t)i * D.Nsrc] : 0.f;
#endif
    if (D.gain) {
#pragma unroll
        for (int i = 0; i < 64; ++i) v[i] *= D.gain[D.k0 + i]; }
#pragma unroll
    for (int i = 0; i < 64; ++i) s[i * 33 + (lane & 31)] = v[i];
    LDS_WAIT(); asm volatile("" ::: "memory");
    tr_store(A, scr, lane); if (hasB) tr_store(B, (const LAS float*)((const LAS unsigned char*)scr + TR_SCR), lane);
    LDS_WAIT(); asm volatile("" ::: "memory");
}
__device__ __forceinline__ int win_src_col(int c) {
    if (c < 4096) return c;
    if (c < 5120) return c - 4096 + 4128;
    if (c < 5376) return c - 5120 + 5152;
    if (c < 5632) return c - 5376 + 5408;
    if (c < 5664) return c - 5632 + 4096;
    return -1;
}
__device__ __forceinline__ void row_to_bf16_rstd(const float* xrow, bf16* orow, float* rstd_out, int lane) {
    const GAS f32x4* xr = (const GAS f32x4*)xrow + lane;
    f32x4 v[8]; float s = 0.f;
#pragma unroll
    for (int j = 0; j < 8; ++j) { v[j] = xr[64 * j]; s += (v[j].x * v[j].x + v[j].y * v[j].y) + (v[j].z * v[j].z + v[j].w * v[j].w); }
    s = wave_sum(s);
    if (lane == 0) *rstd_out = 1.0f / sqrtf(s * (1.0f / DM) + RMS_EPS);
    GAS v2u* o8 = (GAS v2u*)orow + lane;
#pragma unroll
    for (int j = 0; j < 8; ++j) { v2u w; w.x = pk2(v[j].x, v[j].y); w.y = pk2(v[j].z, v[j].w); o8[64 * j] = w; }
}

__device__ __forceinline__ void p0_prologue(Frame& F) {
    LAS float* scr = (LAS float*)(F.lds + RING_OFF + F.wave * TR_WAVE);
    const int gw = F.vcu * NWAVES + F.wave, NGW = F.G * NWAVES;
    constexpr int I_IN = 32 * (NINP / 32), I_KV = 32 * 32;
    auto desc0 = [&](int r) { TrDesc D;
        if (r < I_IN) { const int nblk = NINP / 32, kb = r / nblk, nb = r % nblk; D = TrDesc{F.in[3], F.in[2], WSP(bf16, WS_WIN), DM, NIN, win_src_col(nb * 32), nb * 32, kb * 64}; }
        else { r -= I_IN; const int kb = r / 32, nb = r % 32; D = TrDesc{F.in[16], F.in[14], WSP(bf16, WS_WKV), DM, 1024, nb * 32, nb * 32, kb * 64}; }
        return D; };
    for (int it = 2 * gw; it < I_IN + I_KV; it += 2 * NGW) tr_pair(desc0(it), desc0(it + 1), true, scr, F.lane);
    for (int m = gw; m < SEQ; m += 2 * NGW) {
        const int m2 = m + NGW; const bool two = m2 < SEQ;
        const GAS f32x4* xa = (const GAS f32x4*)(F.in[0] + (size_t)m * DM) + F.lane; const GAS f32x4* xb_ = (const GAS f32x4*)(F.in[0] + (size_t)(two ? m2 : m) * DM) + F.lane;
        f32x4 va[8], vb[8]; float sa = 0.f, sb = 0.f;
#pragma unroll
        for (int j = 0; j < 8; ++j) { va[j] = __builtin_nontemporal_load((const f32x4*)(xa + 64 * j)); vb[j] = __builtin_nontemporal_load((const f32x4*)(xb_ + 64 * j)); }
#pragma unroll
        for (int j = 0; j < 8; ++j) { sa += (va[j].x * va[j].x + va[j].y * va[j].y) + (va[j].z * va[j].z + va[j].w * va[j].w); sb += (vb[j].x * vb[j].x + vb[j].y * vb[j].y) + (vb[j].z * vb[j].z + vb[j].w * vb[j].w); }
        sa = wave_sum(sa); sb = wave_sum(sb);
        if (F.lane == 0) { WSP(float, WS_RSTD1)[m] = 1.0f / sqrtf(sa * (1.0f / DM) + RMS_EPS); if (two) WSP(float, WS_RSTD1)[m2] = 1.0f / sqrtf(sb * (1.0f / DM) + RMS_EPS); }
        GAS v2u* oa = (GAS v2u*)(WSP(bf16, WS_XB) + (size_t)m * DM) + F.lane; GAS v2u* ob = (GAS v2u*)(WSP(bf16, WS_XB) + (size_t)m2 * DM) + F.lane;
#pragma unroll
        for (int j = 0; j < 8; ++j) { v2u w; w.x = pk2(va[j].x, va[j].y); w.y = pk2(va[j].z, va[j].w); oa[64 * j] = w; }
        if (two) {
#pragma unroll
            for (int j = 0; j < 8; ++j) { v2u w; w.x = pk2(vb[j].x, vb[j].y); w.y = pk2(vb[j].z, vb[j].w); ob[64 * j] = w; } }
    }
    for (int m = gw; m < MEMT; m += NGW) row_to_bf16_rstd(F.in[1] + (size_t)m * DM, WSP(bf16, WS_MEMB) + (size_t)m * DM, WSP(float, WS_RSTDM) + m, F.lane);
}
__device__ __forceinline__ TrDesc gud_desc(Frame& F, int r) {
    constexpr int I_GU = 32 * (2 * DFF / 32); TrDesc D;
    if (r < I_GU) { const int nblk = 2 * DFF / 32, kb = r / nblk, nb2 = r % nblk; const int row = nb2 * 32, t = row / 256, w = row % 256;
        D = TrDesc{(w < 128) ? F.in[19] : F.in[20], F.in[18], DOP(bf16, DO_WGU), DM, DFF, 128 * t + (w & 127), row, kb * 64}; }
    else { r -= I_GU; const int kb = r / 64, nb2 = r % 64; D = TrDesc{F.in[21], nullptr, WSP(bf16, WS_WD), DFF, DM, nb2 * 32, nb2 * 32, kb * 64}; }
    return D;
}
constexpr int N_GUD_EARLY = 3072;
__device__ __forceinline__ void p1_late_transposes(Frame& F, int b0, int nb) {
    if ((int)blockIdx.x < b0 || (int)blockIdx.x >= b0 + nb) return;
    LAS float* scr = (LAS float*)(F.lds + RING_OFF + F.wave * TR_WAVE);
    const int gw = ((int)blockIdx.x - b0) * NWAVES + F.wave, NGW = nb * NWAVES;
    constexpr int I_OUT = 32 * 64, I_Q = 32 * 16, I_O = 8 * 64;
    auto desc1 = [&](int r) { TrDesc D;
        if (r < I_OUT) { const int kb = r / 64, nb2 = r % 64; D = TrDesc{F.in[12], nullptr, WSP(bf16, WS_WOUT), DM, DM, nb2 * 32, nb2 * 32, kb * 64}; }
        else if (r < I_OUT + I_Q) { r -= I_OUT; const int kb = r / 16, nb2 = r % 16; D = TrDesc{F.in[15], F.in[13], WSP(bf16, WS_WQ), DM, 512, nb2 * 32, nb2 * 32, kb * 64}; }
        else { r -= I_OUT + I_Q; const int kb = r / 64, nb2 = r % 64; D = TrDesc{F.in[17], nullptr, WSP(bf16, WS_WO), 512, DM, nb2 * 32, nb2 * 32, kb * 64}; }
        return D; };
    for (int it = 2 * gw; it < I_OUT + I_Q + I_O; it += 2 * NGW) tr_pair(desc1(it), desc1(it + 1), true, scr, F.lane);
    for (int it = 2 * gw; it < N_GUD_EARLY; it += 2 * NGW) tr_pair(gud_desc(F, it), gud_desc(F, it + 1), true, scr, F.lane);
}
__device__ __forceinline__ void p4_transposes(Frame& F, int b0, int nb) {
    (void)nb; if ((int)blockIdx.x < b0) return;
    LAS float* scr = (LAS float*)(F.lds + RING_OFF + F.wave * TR_WAVE);
    constexpr int I_GU = 32 * (2 * DFF / 32), I_D = (DFF / 64) * 64, BATCH = 8 * NWAVES;
    unsigned* qctr = (unsigned*)(F.ctl + CW_TRQ);
    for (;;) {
        __syncthreads();
        if (F.tid == 0) F.MISC[13] = __hip_atomic_fetch_add(qctr, 1u, __ATOMIC_RELAXED, __HIP_MEMORY_SCOPE_AGENT);
        __syncthreads();
        const int base = N_GUD_EARLY + (int)F.MISC[13] * BATCH;
        if (base >= I_GU + I_D) break;
        for (int k = 0; k < 4; ++k) {
            const int it = base + 2 * (k * NWAVES + F.wave); if (it >= I_GU + I_D) break;
            tr_pair(gud_desc(F, it), gud_desc(F, it + 1), true, scr, F.lane); }
    }
}

__device__ __forceinline__ float softplusf(float x) { return x > 20.f ? x : log1pf(__expf(x)); }
__device__ __forceinline__ void dn_combine(Frame& F) {
    const int gw = F.vcu * NWAVES + F.wave, NGW = F.G * NWAVES, lane = F.lane;
    const bf16* OBp = WSP(bf16, WS_OB); const bf16* Z = DOP(bf16, DO_Z); bf16* Y = WSP(bf16, WS_YMIX); const float* gn = F.in[9];
    const int cb = (16 * lane) & 127; float gv[16];
#pragma unroll
    for (int i = 0; i < 16; ++i) gv[i] = gn[cb + i];
    for (int t0 = gw; t0 < SEQ; t0 += 2 * NGW) {
        v4u a[2][2], b[2][2], z[2][2];
#pragma unroll
        for (int k = 0; k < 2; ++k) { const int t = (t0 + k * NGW < SEQ) ? t0 + k * NGW : t0; const size_t off = (size_t)t * 1024 + 16 * lane;
            const size_t offy = (size_t)t * DM + 16 * lane; a[k][0] = *(const v4u*)(Y + offy); a[k][1] = *(const v4u*)(Y + offy + 8); b[k][0] = *(const v4u*)(OBp + off); b[k][1] = *(const v4u*)(OBp + off + 8);
            z[k][0] = *(const v4u*)(Z + off); z[k][1] = *(const v4u*)(Z + off + 8); }
#pragma unroll
        for (int k = 0; k < 2; ++k) {
            const int t = t0 + k * NGW; if (t >= SEQ) break;
            float o[16], zz[16];
#pragma unroll
            for (int i = 0; i < 4; ++i) { o[2 * i] = bflo(a[k][0][i]) + bflo(b[k][0][i]); o[2 * i + 1] = bfhi(a[k][0][i]) + bfhi(b[k][0][i]); o[8 + 2 * i] = bflo(a[k][1][i]) + bflo(b[k][1][i]); o[8 + 2 * i + 1] = bfhi(a[k][1][i]) + bfhi(b[k][1][i]);
                zz[2 * i] = bflo(z[k][0][i]); zz[2 * i + 1] = bfhi(z[k][0][i]); zz[8 + 2 * i] = bflo(z[k][1][i]); zz[8 + 2 * i + 1] = bfhi(z[k][1][i]); }
            float ss = 0.f;
#pragma unroll
            for (int i = 0; i < 16; ++i) ss += o[i] * o[i];
            ss += __shfl_xor(ss, 1); ss += __shfl_xor(ss, 2); ss += __shfl_xor(ss, 4);
            const float rs = __builtin_amdgcn_rsqf(ss * (1.0f / 128.0f) + RMS_EPS);
            float y[16];
#pragma unroll
            for (int i = 0; i < 16; ++i) y[i] = o[i] * rs * gv[i] * siluf(zz[i]);
            v4u w0, w1;
#pragma unroll
            for (int i = 0; i < 4; ++i) { w0[i] = pk2(y[2 * i], y[2 * i + 1]); w1[i] = pk2(y[8 + 2 * i], y[8 + 2 * i + 1]); }
            bf16* yp = Y + (size_t)t * DM + 16 * lane; *(v4u*)yp = w0; *(v4u*)(yp + 8) = w1;
        }
    }
}
__device__ __forceinline__ void final_norm(Frame& F) {
    const int gw = F.vcu * NWAVES + F.wave, NGW = F.G * NWAVES, lane = F.lane;
    const float* ss = (const float*)(F.ws + WS_CTL + CTL_SUMSQ4); const GAS f32x4* g = (const GAS f32x4*)F.in[22]; const bf16* H3 = WSP(bf16, WS_H3B);
    for (int m0 = gw; m0 < SEQ; m0 += 2 * NGW) {
        v4u w[2][4]; float r[2];
#pragma unroll
        for (int k = 0; k < 2; ++k) { const int m = (m0 + k * NGW < SEQ) ? m0 + k * NGW : m0; const GAS v4u* hp = (const GAS v4u*)(H3 + (size_t)m * DM);
            r[k] = ss[m];
#pragma unroll
            for (int j = 0; j < 4; ++j) w[k][j] = hp[64 * j + lane]; }
#pragma unroll
        for (int k = 0; k < 2; ++k) {
            const int m = m0 + k * NGW; if (m >= SEQ) break;
            const float rr = __builtin_amdgcn_rsqf(r[k] * (1.0f / DM) + RMS_EPS);
            GAS f32x4* o = (GAS f32x4*)(F.out + (size_t)m * DM);
#pragma unroll
            for (int j = 0; j < 4; ++j) { const v4u x = w[k][j]; const int c4 = 2 * (64 * j + lane); const f32x4 g0 = g[c4], g1 = g[c4 + 1];
                o[c4] = (f32x4){bflo(x.x) * rr * g0[0], bfhi(x.x) * rr * g0[1], bflo(x.y) * rr * g0[2], bfhi(x.y) * rr * g0[3]};
                o[c4 + 1] = (f32x4){bflo(x.z) * rr * g1[0], bfhi(x.z) * rr * g1[1], bflo(x.w) * rr * g1[2], bfhi(x.w) * rr * g1[3]}; }
        }
    }
}

__device__ __forceinline__ int t5_bucket(int rel) {
    const int n = rel < 0 ? -rel : rel; int b;
    if (n < 8) b = n; else { int k = (31 - __builtin_clz((unsigned)(n * n))) - 6; b = 8 + k; if (b > 15) b = 15; }
    return (rel > 0 ? 16 : 0) + b;
}
template <int MODE  >
__device__ __forceinline__ void attn_unit(Frame& F, const bf16* Qa, const bf16* Qb, int qpitch, const bf16* Kp, const bf16* Vp, int kvpitch, bf16* Oa, bf16* Ob, int opitch, int q0, int kt_beg, int kt_end,
                                          const LAS float* bta, const LAS float* btb, float sinka, float sinkb) {
    int lane_ = F.lane, tid_ = F.tid;
    asm volatile("" : "+v"(lane_), "+v"(tid_));
    const int lane = lane_, c = lane & 15, g = lane >> 4, qw0 = q0 + 16 * F.wave, tid = tid_;
    bf16x8 qf[2][4];
#pragma unroll
    for (int t = 0; t < 4; ++t) { qf[0][t] = *(const bf16x8*)(Qa + (size_t)(qw0 + c) * qpitch + 32 * t + 8 * g); qf[1][t] = *(const bf16x8*)(Qb + (size_t)(qw0 + c) * qpitch + 32 * t + 8 * g); }
    f32x4 oacc[2][8];
#pragma unroll
    for (int gi = 0; gi < 2; ++gi)
#pragma unroll
        for (int i = 0; i < 8; ++i) oacc[gi][i] = (f32x4){0.f, 0.f, 0.f, 0.f};
    float mrun[2], lsum[2];
    mrun[0] = (MODE == 0) ? sinka : -1e30f; mrun[1] = (MODE == 0) ? sinkb : -1e30f; lsum[0] = lsum[1] = (MODE == 0 && g == 0) ? 1.0f : 0.0f;
    const int skey = tid >> 4, sch = tid & 15;
    const bf16* kg = Kp + (size_t)skey * kvpitch + ((sch ^ (skey & 15)) << 3); const bf16* vg = Vp + (size_t)skey * kvpitch + ((sch ^ ((skey & 7) << 1)) << 3);
    LAS unsigned char* const L0 = F.lds + RING_OFF;
    LAS unsigned char* const Lw = L0 + F.wave * 1024;
#define ATT_LOADK(kt_, par_) do { _Pragma("unroll") for (int i = 0; i < 2; ++i) __builtin_amdgcn_global_load_lds((const unsigned*)(kg + (size_t)(64 * (kt_) + 32 * i) * kvpitch), (LAS unsigned*)(Lw + (par_) * 16384 + i * 8192), 16, 0, 0); } while (0)
#define ATT_LOADV(kt_, par_) do { _Pragma("unroll") for (int i = 0; i < 2; ++i) __builtin_amdgcn_global_load_lds((const unsigned*)(vg + (size_t)(64 * (kt_) + 32 * i) * kvpitch), (LAS unsigned*)(Lw + 32768 + (par_) * 16384 + i * 8192), 16, 0, 0); } while (0)
#define ATT_QK(dst_, par_, kt_) do { const LAS unsigned char* Ks_ = L0 + (par_) * 16384; \
        if (MODE == 0) {   \
            const LAS float* b0_ = bta + ((64 * (kt_) + 4 * g) - (qw0 + c) + 255); const LAS float* b1_ = btb + ((64 * (kt_) + 4 * g) - (qw0 + c) + 255); \
            _Pragma("unroll") for (int mt = 0; mt < 4; ++mt) { dst_[0][mt] = (f32x4){b0_[16 * mt], b0_[16 * mt + 1], b0_[16 * mt + 2], b0_[16 * mt + 3]}; dst_[1][mt] = (f32x4){b1_[16 * mt], b1_[16 * mt + 1], b1_[16 * mt + 2], b1_[16 * mt + 3]}; } \
        } else { _Pragma("unroll") for (int gi = 0; gi < 2; ++gi) _Pragma("unroll") for (int mt = 0; mt < 4; ++mt) dst_[gi][mt] = (f32x4){0.f, 0.f, 0.f, 0.f}; } \
        _Pragma("unroll") for (int t = 0; t < 4; ++t) _Pragma("unroll") for (int mt = 0; mt < 4; ++mt) { const bf16x8 kf = *(const LAS bf16x8*)(Ks_ + (16 * mt + c) * 256 + (((4 * t + g) ^ c) << 4)); \
            dst_[0][mt] = __builtin_amdgcn_mfma_f32_16x16x32_bf16(kf, qf[0][t], dst_[0][mt], 0, 0, 0); dst_[1][mt] = __builtin_amdgcn_mfma_f32_16x16x32_bf16(kf, qf[1][t], dst_[1][mt], 0, 0, 0); } } while (0)
#define ATT_RELOK(kt_) ((MODE != 0) || ((64 * (kt_) <= qw0 + 15 + 128) && (64 * (kt_) + 63 >= qw0 - 128)))
    ATT_LOADK(kt_beg, 0); ATT_LOADV(kt_beg, 0);
    if (kt_beg + 1 < kt_end) ATT_LOADK(kt_beg + 1, 1);
    VM_WAIT(); __syncthreads();
    f32x4 s[2][4];
    bool ok_cur = ATT_RELOK(kt_beg);
    if (ok_cur) ATT_QK(s, 0, kt_beg);
#pragma unroll 1
    for (int kt = kt_beg; kt < kt_end; ++kt) {
        const int par = (kt - kt_beg) & 1;
        __syncthreads();
        if (kt + 2 < kt_end) ATT_LOADK(kt + 2, par);
        if (kt + 1 < kt_end) ATT_LOADV(kt + 1, par ^ 1);
        const bool ok_next = (kt + 1 < kt_end) && ATT_RELOK(kt + 1);
        f32x4 sn[2][4];
        if (ok_next) ATT_QK(sn, par ^ 1, kt + 1);
        if (ok_cur) {
            const LAS unsigned char* Vs = L0 + 32768 + par * 16384;
            bf16x8 pf[2][2];
#pragma unroll
            for (int gi = 0; gi < 2; ++gi) {
                float tmax = -INFINITY;
#pragma unroll
                for (int mt = 0; mt < 4; ++mt)
#pragma unroll
                    for (int r = 0; r < 4; ++r) tmax = fmaxf(tmax, s[gi][mt][r]);
                tmax = fmaxf(tmax, __shfl_xor(tmax, 16)); tmax = fmaxf(tmax, __shfl_xor(tmax, 32));
                const bool need = tmax > mrun[gi] + 6.0f;
                const float mnew = need ? tmax : mrun[gi]; float ps = 0.f;
                if (__builtin_amdgcn_ballot_w64(need) != 0ull) {
                    const float alpha = __builtin_amdgcn_exp2f(mrun[gi] - mnew);
                    lsum[gi] *= alpha;
#pragma unroll
                    for (int i = 0; i < 8; ++i) oacc[gi][i] = oacc[gi][i] * alpha;
                }
                mrun[gi] = mnew;
#pragma unroll
                for (int mt = 0; mt < 4; ++mt)
#pragma unroll
                    for (int r = 0; r < 4; ++r) { const float p = __builtin_amdgcn_exp2f(s[gi][mt][r] - mnew); s[gi][mt][r] = p; ps += p; }
                lsum[gi] += ps;
#pragma unroll
                for (int t2 = 0; t2 < 2; ++t2) { v4u w; w.x = cvtpk(s[gi][2 * t2][0], s[gi][2 * t2][1]); w.y = cvtpk(s[gi][2 * t2][2], s[gi][2 * t2][3]); w.z = cvtpk(s[gi][2 * t2 + 1][0], s[gi][2 * t2 + 1][1]); w.w = cvtpk(s[gi][2 * t2 + 1][2], s[gi][2 * t2 + 1][3]);
                    pf[gi][t2] = __builtin_bit_cast(bf16x8, w); }
            }
            const int q4 = c >> 2, p4 = c & 3;
#pragma unroll
            for (int t2 = 0; t2 < 2; ++t2)
#pragma unroll
                for (int mo = 0; mo < 8; ++mo) {
                    const int k1 = 32 * t2 + 4 * g + q4, k2 = k1 + 16, chn = 2 * mo + (p4 >> 1);
                    const s16x4 lo = __builtin_bit_cast(s16x4, __builtin_amdgcn_ds_read_tr16_b64_v4i16((LAS s16x4*)(Vs + k1 * 256 + ((chn ^ ((k1 & 7) << 1)) << 4) + (p4 & 1) * 8)));
                    const s16x4 hi = __builtin_bit_cast(s16x4, __builtin_amdgcn_ds_read_tr16_b64_v4i16((LAS s16x4*)(Vs + k2 * 256 + ((chn ^ ((k2 & 7) << 1)) << 4) + (p4 & 1) * 8)));
                    const bf16x8 vf = (bf16x8){lo[0], lo[1], lo[2], lo[3], hi[0], hi[1], hi[2], hi[3]};
                    oacc[0][mo] = __builtin_amdgcn_mfma_f32_16x16x32_bf16(vf, pf[0][t2], oacc[0][mo], 0, 0, 0);
                    oacc[1][mo] = __builtin_amdgcn_mfma_f32_16x16x32_bf16(vf, pf[1][t2], oacc[1][mo], 0, 0, 0); }
        }
#pragma unroll
        for (int gi = 0; gi < 2; ++gi)
#pragma unroll
            for (int mt = 0; mt < 4; ++mt) s[gi][mt] = sn[gi][mt];
        ok_cur = ok_next;
        VM_WAIT();
    }
    __syncthreads();
#undef ATT_LOADK
#undef ATT_LOADV
#undef ATT_QK
#undef ATT_RELOK
#pragma unroll
    for (int gi = 0; gi < 2; ++gi) {
        float l = lsum[gi]; l += __shfl_xor(l, 16); l += __shfl_xor(l, 32);
        const float inv = 1.0f / l; bf16* O = gi ? Ob : Oa;
#pragma unroll
        for (int mo = 0; mo < 8; ++mo) { v2u w; w.x = cvtpk(oacc[gi][mo][0] * inv, oacc[gi][mo][1] * inv); w.y = cvtpk(oacc[gi][mo][2] * inv, oacc[gi][mo][3] * inv);
            *(v2u*)(O + (size_t)(qw0 + c) * opitch + 16 * mo + 4 * g) = w; }
    }
}
constexpr int SWA_UNITS = (SWH / 2) * (SEQ / 128);
__device__ __forceinline__ void swa_phase(Frame& F, int b0, int nb) {
    LAS float* btab = (LAS float*)(F.lds + RING_OFF + 65536);
    const bf16* QS = DOP(bf16, DO_QSW); const bf16* KV = DOP(bf16, DO_KVSW); bf16* Y = WSP(bf16, WS_YMIX);
    unsigned* qctr = (unsigned*)(F.ctl + CW_SWAQ); unsigned* fdone = (unsigned*)(F.ctl + CW_FOLDDONE);
    __syncthreads();
    for (int i = F.tid; i < SWH * 512; i += NWAVES * 64) { const int rel = (i & 511) - 255, h = i >> 9;
        btab[i] = (rel >= -128 && rel <= 128) ? F.in[11][t5_bucket(rel) * 8 + h] * LOG2E : -INFINITY; }
    for (;;) {
        __syncthreads();
        if (F.tid == 0) {
            unsigned nx = 0x7fffffffu;
            if (!(b0 && __hip_atomic_load(fdone, __ATOMIC_RELAXED, __HIP_MEMORY_SCOPE_AGENT) >= (unsigned)nb)) nx = __hip_atomic_fetch_add(qctr, 1u, __ATOMIC_RELAXED, __HIP_MEMORY_SCOPE_AGENT);
            F.MISC[12] = nx; }
        __syncthreads();
        const int u = (int)F.MISC[12];
        if (u >= SWA_UNITS) break;
        const int hp = u & 3, qb = u >> 2, kvh = hp >> 1, h0 = 2 * hp;
        int kb = 2 * qb - 2, ke = 2 * qb + 4; if (kb < 0) kb = 0; if (ke > SEQ / 64) ke = SEQ / 64;
        attn_unit<0>(F, QS + h0 * 128, QS + (h0 + 1) * 128, 1024, KV + kvh * 128, KV + 256 + kvh * 128, 512, Y + 1024 + h0 * 128, Y + 1024 + (h0 + 1) * 128, DM, qb * 128, kb, ke,
                     btab + h0 * 512, btab + (h0 + 1) * 512, F.in[10][h0] * LOG2E, F.in[10][h0 + 1] * LOG2E);
    }
}
__device__ __forceinline__ void mem_attn_phase(Frame& F) {
    const bf16* QM = WSP(bf16, WS_QM); const bf16* KVm = WSP(bf16, WS_KVM); bf16* OM = WSP(bf16, WS_OM);
    for (int u = blockIdx.x; u < MEMH * (SEQ / 256); u += F.G) {
        const int h = u & 3, qb = u >> 2;
        __syncthreads();
        attn_unit<1>(F, QM + h * 128, QM + (size_t)128 * 512 + h * 128, 512, KVm + h * 128, KVm + 512 + h * 128, 1024, OM + h * 128, OM + (size_t)128 * 512 + h * 128, 512, qb * 256, 0, 4, nullptr, nullptr, 0.f, 0.f);
    }
}

typedef float f32x16 __attribute__((ext_vector_type(16)));
constexpr int DX_W = 0, DX_K = 16384, DX_U = 32768, DX_Q = 49152, DX_A = 65536, DX_BYTES = 73728;
constexpr size_t WS_GL = 1 * MiB + 128 * 1024;
constexpr int L_RAW = 0, RAW_PITCH = 784, L_MTF = 0, L_MTB = 16384, L_TB = 32768, TB_PITCH = 144, TB_SZ = 9216;
constexpr int L_QB = 69632, L_KB = 86016, L_KT = 102400, L_VT = 120832, L_PART = 139264, L_SC = 143360;
constexpr int L_CW = 145408;
static_assert(L_SC + 2048 <= L_CW && L_CW + 7680 <= LDSCTL_OFF, "prep LDS map");
__device__ __forceinline__ unsigned char* dnx_rec(Frame& F, int dir, int hd, int cn) { return F.ws + WS_DNX + (size_t)((dir * 8 + hd) * 256 + cn) * DX_BYTES; }
__device__ __forceinline__ v4u pack8f(const float* v) { v4u w; w.x = cvtpk(v[0], v[1]); w.y = cvtpk(v[2], v[3]); w.z = cvtpk(v[4], v[5]); w.w = cvtpk(v[6], v[7]); return w; }

__device__ __forceinline__ bf16x8 cvt8(const f32x16& v, int o) { v4u w; w.x = cvtpk(v[o], v[o + 1]); w.y = cvtpk(v[o + 2], v[o + 3]); w.z = cvtpk(v[o + 4], v[o + 5]); w.w = cvtpk(v[o + 6], v[o + 7]); return __builtin_bit_cast(bf16x8, w); }
__device__ __forceinline__ bf16x8 cvt8f(f32x4 a, f32x4 b) { v4u w; w.x = cvtpk(a[0], a[1]); w.y = cvtpk(a[2], a[3]); w.z = cvtpk(b[0], b[1]); w.w = cvtpk(b[2], b[3]); return __builtin_bit_cast(bf16x8, w); }
template <int dir> __device__ __forceinline__ void dn_solve_and_write(LAS unsigned char* lds, int lane) {
    const LAS float* MT = (const LAS float*)(lds + (dir ? L_MTB : L_MTF));
    LAS float* T0 = (LAS float*)(lds + L_TB + dir * 2 * TB_SZ);
    LAS float* Trow = T0 + lane * 68;
    const int blk = lane >> 5, cb = 16 * (lane >> 4);
#pragma unroll 1
    for (int jr = 3; jr >= 0; --jr) {
        const int j0 = cb + 4 * jr;
        float a0 = (lane == j0) ? 1.f : 0.f, a1 = (lane == j0 + 1) ? 1.f : 0.f, a2 = (lane == j0 + 2) ? 1.f : 0.f, a3 = (lane == j0 + 3) ? 1.f : 0.f;
        const LAS float* mr = MT + j0 * 64;
#pragma unroll
        for (int sr = 1; sr < 4; ++sr) if (sr > jr) {
            const int s0 = cb + 4 * sr;
            const f32x4 tv = *(const LAS f32x4*)(Trow + s0);
            const f32x4 m0 = *(const LAS f32x4*)(mr + s0), m1 = *(const LAS f32x4*)(mr + 64 + s0), m2 = *(const LAS f32x4*)(mr + 128 + s0), m3 = *(const LAS f32x4*)(mr + 192 + s0);
            a0 -= (tv[0] * m0[0] + tv[1] * m0[1]) + (tv[2] * m0[2] + tv[3] * m0[3]);
            a1 -= (tv[0] * m1[0] + tv[1] * m1[1]) + (tv[2] * m1[2] + tv[3] * m1[3]);
            a2 -= (tv[0] * m2[0] + tv[1] * m2[1]) + (tv[2] * m2[2] + tv[3] * m2[3]);
            a3 -= (tv[0] * m3[0] + tv[1] * m3[1]) + (tv[2] * m3[2] + tv[3] * m3[3]);
        }
        const f32x4 d0 = *(const LAS f32x4*)(mr + j0), d1 = *(const LAS f32x4*)(mr + 64 + j0), d2 = *(const LAS f32x4*)(mr + 128 + j0);
        const float t3 = a3, t2 = a2 - t3 * d2[3], t1 = a1 - t2 * d1[2] - t3 * d1[3], t0 = a0 - t1 * d0[1] - t2 * d0[2] - t3 * d0[3];
        *(LAS f32x4*)(Trow + j0) = (f32x4){t0, t1, t2, t3};
    }
    if (((lane >> 4) & 1) == 0) {
#pragma unroll
        for (int q = 0; q < 4; ++q) *(LAS f32x4*)(Trow + cb + 16 + 4 * q) = (f32x4){0.f, 0.f, 0.f, 0.f}; }
    if (blk == 0) {
#pragma unroll
        for (int q = 8; q < 16; ++q) *(LAS f32x4*)(Trow + 4 * q) = (f32x4){0.f, 0.f, 0.f, 0.f}; }
    asm volatile("s_waitcnt lgkmcnt(0)" ::: "memory");
    {
        const int r = lane & 31, lh = lane >> 5, B = r >> 4, rl = r & 15, c0 = 32 * B;
        float av[8], bv[8];
#pragma unroll
        for (int jj = 0; jj < 8; ++jj) { const int k = 8 * lh + jj; av[jj] = MT[(c0 + k) * 64 + c0 + 16 + rl]; bv[jj] = T0[(c0 + k) * 68 + c0 + rl]; }
        f32x16 Y;
#pragma unroll
        for (int e = 0; e < 16; ++e) Y[e] = 0.f;
        Y = __builtin_amdgcn_mfma_f32_32x32x16_bf16(cvt8f((f32x4){av[0], av[1], av[2], av[3]}, (f32x4){av[4], av[5], av[6], av[7]}), cvt8f((f32x4){bv[0], bv[1], bv[2], bv[3]}, (f32x4){bv[4], bv[5], bv[6], bv[7]}), Y, 0, 0, 0);
        const bf16x8 y0 = cvt8(Y, 0), y1 = cvt8(Y, 8); bf16x8 yb;
#pragma unroll
        for (int e = 0; e < 8; ++e) yb[e] = B ? y1[e] : y0[e];
        const f32x4 t0 = *(const LAS f32x4*)(T0 + (c0 + 16 + rl) * 68 + c0 + 16 + 4 * lh), t1 = *(const LAS f32x4*)(T0 + (c0 + 16 + rl) * 68 + c0 + 16 + 8 + 4 * lh);
        f32x16 Z;
#pragma unroll
        for (int e = 0; e < 16; ++e) Z[e] = 0.f;
        Z = __builtin_amdgcn_mfma_f32_32x32x16_bf16(cvt8f(t0, t1), yb, Z, 0, 0, 0);
#pragma unroll
        for (int j = 0; j < 8; ++j) { const float z = B ? Z[8 + j] : Z[j]; T0[(c0 + 16 + 8 * (j >> 2) + 4 * lh + (j & 3)) * 68 + c0 + rl] = -z; }
    }
    asm volatile("s_waitcnt lgkmcnt(0)" ::: "memory");
    {
        const int r = lane & 31, lh = lane >> 5;
        f32x16 Y;
#pragma unroll
        for (int e = 0; e < 16; ++e) Y[e] = 0.f;
#pragma unroll
        for (int kk = 0; kk < 2; ++kk) {
            float av[8], bv[8];
#pragma unroll
            for (int jj = 0; jj < 8; ++jj) { const int k = 16 * kk + 8 * lh + jj; av[jj] = MT[k * 64 + 32 + r]; bv[jj] = T0[k * 68 + r]; }
            Y = __builtin_amdgcn_mfma_f32_32x32x16_bf16(cvt8f((f32x4){av[0], av[1], av[2], av[3]}, (f32x4){av[4], av[5], av[6], av[7]}), cvt8f((f32x4){bv[0], bv[1], bv[2], bv[3]}, (f32x4){bv[4], bv[5], bv[6], bv[7]}), Y, 0, 0, 0);
        }
        f32x16 Z;
#pragma unroll
        for (int e = 0; e < 16; ++e) Z[e] = 0.f;
#pragma unroll
        for (int kk = 0; kk < 2; ++kk) {
            const f32x4 t0 = *(const LAS f32x4*)(T0 + (32 + r) * 68 + 32 + 16 * kk + 4 * lh), t1 = *(const LAS f32x4*)(T0 + (32 + r) * 68 + 32 + 16 * kk + 8 + 4 * lh);
            Z = __builtin_amdgcn_mfma_f32_32x32x16_bf16(cvt8f(t0, t1), cvt8(Y, 8 * kk), Z, 0, 0, 0);
        }
#pragma unroll
        for (int e = 0; e < 16; ++e) T0[(32 + (e & 3) + 8 * (e >> 2) + 4 * lh) * 68 + r] = -Z[e];
    }
    asm volatile("s_waitcnt lgkmcnt(0)" ::: "memory");
    f32x4 tr[16];
#pragma unroll
    for (int q = 0; q < 16; ++q) tr[q] = *(const LAS f32x4*)(Trow + 4 * q);
    asm volatile("s_waitcnt lgkmcnt(0)" ::: "memory");
    const LAS float* sc = (const LAS float*)(lds + L_SC);
    const LAS float* cU = sc + (dir ? 384 : 256); const LAS float* cW = sc + (dir ? 448 : 320);
    const int pos = dir ? 63 - lane : lane;
    LAS unsigned char* tu = lds + L_TB + dir * 2 * TB_SZ + pos * TB_PITCH; LAS unsigned char* tw = tu + TB_SZ;
#pragma unroll
    for (int q = 0; q < 8; ++q) {
        float u8[8], w8[8];
#pragma unroll
        for (int e = 0; e < 8; ++e) { const int s = 8 * q + e, sp = dir ? 63 - s : s; const float t = tr[sp >> 2][sp & 3]; u8[e] = t * cU[s]; w8[e] = t * cW[s]; }
        *(LAS v4u*)(tu + q * 16) = pack8f(u8); *(LAS v4u*)(tw + q * 16) = pack8f(w8);
    }
}

struct PrepRegs { v4u raw[7]; float ab[4]; };
__device__ __forceinline__ void prep_load(Frame& F, int u, int tid, int lane, PrepRegs& R) {
    const int cn = u >> 3, hd = u & 7; const bf16* QKV = WSP(bf16, WS_QKV);
#pragma unroll
    for (int k = 0; k < 7; ++k) { const int ci = tid + 512 * k; const int row = ci / 48, cc = ci % 48, seg = cc >> 4, ch = (cc & 15) * 8, tok = 64 * cn - 2 + row;
        v4u v = (v4u){0u, 0u, 0u, 0u};
#ifdef RAW_NT
        if (ci < 68 * 48 && tok >= 0 && tok < SEQ) v = __builtin_nontemporal_load((const v4u*)(QKV + (size_t)tok * 3072 + seg * 1024 + hd * 128 + ch));
#else
        if (ci < 68 * 48 && tok >= 0 && tok < SEQ) v = *(const v4u*)(QKV + (size_t)tok * 3072 + seg * 1024 + hd * 128 + ch);
#endif
        R.raw[k] = v; }
    if (tid < 64) { const float* ab = WSP(float, WS_AB) + (size_t)(64 * cn + lane) * 32; R.ab[0] = ab[hd]; R.ab[1] = ab[8 + hd]; R.ab[2] = ab[16 + hd]; R.ab[3] = ab[24 + hd]; }
}
#ifdef DNX_NT_STORE
#define DNX_ST(ptr, val) do { const v4u v_ = (val); if (MASK & 32) __builtin_nontemporal_store(v_, (v4u*)(ptr)); else asm volatile("" :: "v"(v_)); } while (0)
#else
#define DNX_ST(ptr, val) do { const v4u v_ = (val); if (MASK & 32) *(v4u*)(ptr) = v_; else asm volatile("" :: "v"(v_)); } while (0)
#endif
template <int MASK> __device__ __forceinline__ void dn_prep_unit(Frame& F, int cn, int hd, PrepRegs& PR, int next_u) {
    LAS unsigned char* lds = F.lds; int tid = F.tid, lane = F.lane; const int wave = F.wave;
    asm volatile("" : "+v"(tid), "+v"(lane));
    LAS float* sc = (LAS float*)(lds + L_SC);
    __syncthreads();
    if (MASK & 1) {
    const float abv[4] = {PR.ab[0], PR.ab[1], PR.ab[2], PR.ab[3]};
#pragma unroll
    for (int k = 0; k < 7; ++k) { const int ci = tid + 512 * k; const int row = ci / 48, cc = ci % 48, seg = cc >> 4, ch = (cc & 15) * 8;
        if (ci < 68 * 48) *(LAS v4u*)(lds + L_RAW + row * RAW_PITCH + (seg * 128 + ch) * 2) = PR.raw[k]; }
    if (wave == 0) {
        const float bfv = 1.0f / (1.0f + __expf(-abv[0])), bbv = 1.0f / (1.0f + __expf(-abv[1]));
        const float gf = -__expf(F.in[5][hd]) * softplusf(abv[2] + F.in[7][hd]), gb = -__expf(F.in[6][hd]) * softplusf(abv[3] + F.in[8][hd]);
        float Gf = gf, Gb = gb;
#pragma unroll
        for (int o = 1; o < 64; o <<= 1) { const float a = __shfl_up(Gf, o), b = __shfl_down(Gb, o); if (lane >= o) Gf += a; if (lane + o < 64) Gb += b; }
        sc[lane] = Gf; sc[64 + lane] = Gb; sc[128 + lane] = bfv; sc[192 + lane] = bbv;
        sc[256 + lane] = bfv; sc[320 + lane] = -bfv * __expf(Gf); sc[384 + lane] = bbv; sc[448 + lane] = -bbv * __expf(Gb);
        float* GL = WSP(float, WS_GL);
        if (MASK & 32) { if (lane == 63) GL[(0 * 8 + hd) * 256 + cn] = __expf(Gf);
        if (lane == 0) GL[(1 * 8 + hd) * 256 + cn] = __expf(Gb); }
    }
    }
    __syncthreads();
    asm volatile("" : "+v"(tid), "+v"(lane));
    if (MASK & 2) {
        const int t = wave, pos = lane; const LAS float* cw = (const LAS float*)(lds + L_CW) + 16 * t;
        float qv[16], kv[16], vv[16];
#pragma unroll
        for (int seg = 0; seg < 3; ++seg) {
            float a[16];
#pragma unroll
            for (int i = 0; i < 16; ++i) a[i] = 0.f;
#pragma unroll
            for (int j = 0; j < 5; ++j) {
                const LAS unsigned char* rp = lds + L_RAW + (pos + j) * RAW_PITCH + (seg * 128 + 16 * t) * 2;
                const v4u r0 = *(const LAS v4u*)rp, r1 = *(const LAS v4u*)(rp + 16);
                const LAS float* w = cw + j * 384 + seg * 128;
#pragma unroll
                for (int i = 0; i < 4; ++i) { a[2 * i] += w[2 * i] * bflo(r0[i]); a[2 * i + 1] += w[2 * i + 1] * bfhi(r0[i]); a[8 + 2 * i] += w[8 + 2 * i] * bflo(r1[i]); a[8 + 2 * i + 1] += w[8 + 2 * i + 1] * bfhi(r1[i]); }
            }
#pragma unroll
            for (int i = 0; i < 16; ++i) { const float s = siluf(a[i]); if (seg == 0) qv[i] = s; else if (seg == 1) kv[i] = s; else vv[i] = s; }
        }
        float sq = 0.f, sk = 0.f;
#pragma unroll
        for (int i = 0; i < 16; ++i) { sq += qv[i] * qv[i]; sk += kv[i] * kv[i]; }
        LAS float* part = (LAS float*)(lds + L_PART);
        part[t * 64 + pos] = sq; part[512 + t * 64 + pos] = sk;
        __syncthreads();
        float tq = 0.f, tk = 0.f;
#pragma unroll
        for (int i = 0; i < 8; ++i) { tq += part[i * 64 + pos]; tk += part[512 + i * 64 + pos]; }
        const float rq = (1.0f / sqrtf(tq + 1e-6f)) * 0.08838834764831845f, rk = 1.0f / sqrtf(tk + 1e-6f);
#pragma unroll
        for (int i = 0; i < 16; ++i) { qv[i] *= rq; kv[i] *= rk; }
        *(LAS v4u*)(lds + L_QB + pos * 256 + (((2 * t) ^ (pos & 15)) << 4)) = pack8f(qv); *(LAS v4u*)(lds + L_QB + pos * 256 + (((2 * t + 1) ^ (pos & 15)) << 4)) = pack8f(qv + 8);
        *(LAS v4u*)(lds + L_KB + pos * 256 + (((2 * t) ^ (pos & 15)) << 4)) = pack8f(kv); *(LAS v4u*)(lds + L_KB + pos * 256 + (((2 * t + 1) ^ (pos & 15)) << 4)) = pack8f(kv + 8);
#pragma unroll
        for (int i = 0; i < 16; ++i) { const unsigned w = cvtpk(kv[i], vv[i]); *(LAS unsigned short*)(lds + L_KT + (16 * t + i) * TB_PITCH + pos * 2) = (unsigned short)w; *(LAS unsigned short*)(lds + L_VT + (16 * t + i) * TB_PITCH + pos * 2) = (unsigned short)(w >> 16); }
        const float ef = __expf(sc[pos]), eb = __expf(sc[64 + pos]); const int mt = pos >> 5;
#pragma unroll
        for (int dir = 0; dir < 2; ++dir) { const float e = dir ? eb : ef; unsigned char* rec = dnx_rec(F, dir, hd, cn) + DX_Q;
#pragma unroll
            for (int lh = 0; lh < 2; ++lh) { float o8[8];
#pragma unroll
                for (int j = 0; j < 8; ++j) o8[j] = qv[8 * (j >> 2) + 4 * lh + (j & 3)] * e;
                DNX_ST(rec + ((mt * 8 + t) * 64 + 32 * lh + (pos & 31)) * 16, pack8f(o8)); } }
    }
    __syncthreads();
    asm volatile("" : "+v"(tid), "+v"(lane));
    if (MASK & 4) {
        const int r = lane & 31, lh = lane >> 5, x = wave & 3, ta = x >> 1, tb = x & 1;
        const LAS unsigned char* Ab = lds + L_KB + (32 * ta + r) * 256; const LAS unsigned char* Bb = lds + (wave < 4 ? L_KB : L_QB) + (32 * tb + r) * 256;
        f32x16 acc;
#pragma unroll
        for (int i = 0; i < 16; ++i) acc[i] = 0.f;
#pragma unroll
        for (int kk = 0; kk < 8; ++kk) { const int ch = ((2 * kk + lh) ^ (r & 15)) << 4;
            acc = __builtin_amdgcn_mfma_f32_32x32x16_bf16(*(const LAS bf16x8*)(Ab + ch), *(const LAS bf16x8*)(Bb + ch), acc, 0, 0, 0); }
        const int b = 32 * tb + r;
        if (wave < 4) {
            const float Gfb = sc[b], Gbb = sc[64 + b];
#pragma unroll
            for (int q = 0; q < 4; ++q) { const int a0 = 32 * ta + 8 * q + 4 * lh; f32x4 mf, mb;
#pragma unroll
                for (int e = 0; e < 4; ++e) { const int a = a0 + e; const float kkv = acc[4 * q + e];
                    const float vf = sc[128 + a] * kkv * __expf(fminf(sc[a] - Gfb, 0.f)), vb = sc[192 + a] * kkv * __expf(fminf(sc[64 + a] - Gbb, 0.f));
                    mf[e] = (a > b) ? vf : 0.f; mb[3 - e] = (a < b) ? vb : 0.f; }
                *(LAS f32x4*)(lds + L_MTF + (b * 64 + a0) * 4) = mf; *(LAS f32x4*)(lds + L_MTB + ((63 - b) * 64 + 60 - a0) * 4) = mb; }
        } else {
            const float Gfc = sc[b], Gbc = sc[64 + b];
#pragma unroll
            for (int dir = 0; dir < 2; ++dir) { unsigned char* rec = dnx_rec(F, dir, hd, cn) + DX_A;
#pragma unroll
                for (int s2 = 0; s2 < 2; ++s2) { float o8[8];
#pragma unroll
                    for (int j = 0; j < 8; ++j) { const int s = 32 * ta + 16 * s2 + 8 * (j >> 2) + 4 * lh + (j & 3); const float v = acc[8 * s2 + j];
                        const float ev = v * __expf(fminf(dir ? Gbc - sc[64 + s] : Gfc - sc[s], 0.f)); o8[j] = (dir ? (s >= b) : (s <= b)) ? ev : 0.f; }
                    DNX_ST(rec + ((tb * 4 + 2 * ta + s2) * 64 + lane) * 16, pack8f(o8)); } }
        }
    }
    __syncthreads();
    asm volatile("" : "+v"(tid), "+v"(lane));
    if ((MASK & 1) && next_u < 256 * DNH) prep_load(F, next_u, tid, lane, PR);
    if (!(MASK & 8)) {} else if (wave == 0) dn_solve_and_write<0>(lds, lane);
    else if (wave == 1) dn_solve_and_write<1>(lds, lane);
    else {
        const int r = lane & 31, lh = lane >> 5;
        for (int f = wave - 2; f < 32; f += 6) { const int dir = f >> 4, m = (f >> 2) & 3, t = f & 3; const int dk = 32 * m + r;
            const v2u k0 = *(const LAS v2u*)(lds + L_KT + dk * TB_PITCH + (16 * t + 4 * lh) * 2), k1 = *(const LAS v2u*)(lds + L_KT + dk * TB_PITCH + (16 * t + 8 + 4 * lh) * 2);
            const float Gl = dir ? sc[64] : sc[63]; const LAS float* Gs = sc + (dir ? 64 : 0) + 16 * t + 4 * lh; float o8[8];
            o8[0] = bflo(k0.x) * __expf(Gl - Gs[0]); o8[1] = bfhi(k0.x) * __expf(Gl - Gs[1]); o8[2] = bflo(k0.y) * __expf(Gl - Gs[2]); o8[3] = bfhi(k0.y) * __expf(Gl - Gs[3]);
            o8[4] = bflo(k1.x) * __expf(Gl - Gs[8]); o8[5] = bfhi(k1.x) * __expf(Gl - Gs[9]); o8[6] = bflo(k1.y) * __expf(Gl - Gs[10]); o8[7] = bfhi(k1.y) * __expf(Gl - Gs[11]);
            DNX_ST(dnx_rec(F, dir, hd, cn) + DX_K + ((m * 4 + t) * 64 + lane) * 16, pack8f(o8)); }
    }
    __syncthreads();
    asm volatile("" : "+v"(tid), "+v"(lane));
    if (MASK & 16) {
        const int dir = wave >> 2, x = wave & 3, r = lane & 31, lh = lane >> 5;
        const LAS unsigned char* Tu = lds + L_TB + (dir ? 2 : 0) * TB_SZ; const LAS unsigned char* Tw = Tu + TB_SZ;
        unsigned char* rec = dnx_rec(F, dir, hd, cn);
#pragma unroll
        for (int mt = 0; mt < 2; ++mt) {
            f32x16 aw, au;
#pragma unroll
            for (int i = 0; i < 16; ++i) { aw[i] = 0.f; au[i] = 0.f; }
#pragma unroll
            for (int kk = 0; kk < 4; ++kk) { const int so = (16 * kk + 8 * lh) * 2;
                aw = __builtin_amdgcn_mfma_f32_32x32x16_bf16(*(const LAS bf16x8*)(lds + L_KT + (32 * x + r) * TB_PITCH + so), *(const LAS bf16x8*)(Tw + (32 * mt + r) * TB_PITCH + so), aw, 0, 0, 0);
                au = __builtin_amdgcn_mfma_f32_32x32x16_bf16(*(const LAS bf16x8*)(Tu + (32 * mt + r) * TB_PITCH + so), *(const LAS bf16x8*)(lds + L_VT + (32 * x + r) * TB_PITCH + so), au, 0, 0, 0); }
            float tmp[16];
#pragma unroll
            for (int i = 0; i < 16; ++i) tmp[i] = aw[i];
            DNX_ST(rec + DX_W + ((mt * 8 + 2 * x) * 64 + lane) * 16, pack8f(tmp)); DNX_ST(rec + DX_W + ((mt * 8 + 2 * x + 1) * 64 + lane) * 16, pack8f(tmp + 8));
#pragma unroll
            for (int i = 0; i < 16; ++i) tmp[i] = au[i];
            DNX_ST(rec + DX_U + ((x * 2 + mt) * 64 + lane) * 32, pack8f(tmp)); DNX_ST(rec + DX_U + ((x * 2 + mt) * 64 + lane) * 32 + 16, pack8f(tmp + 8));
        }
    }
}
#undef DNX_ST
template <int MASK> __device__ __forceinline__ void dn_prep_phase(Frame& F) {
    PrepRegs PR; int u = blockIdx.x; int cur_hd = -1;
    if (u < 256 * DNH) prep_load(F, u, F.tid, F.lane, PR);
    for (; u < 256 * DNH; u += F.G) {
        const int hd = u & 7;
        if (hd != cur_hd) {
            __syncthreads();
            for (int i = F.tid; i < 5 * 384; i += NWAVES * 64) { const int j = i / 384, c = i % 384; ((LAS float*)(F.lds + L_CW))[i] = F.in[4][j * 3072 + (c >> 7) * 1024 + hd * 128 + (c & 127)]; }
            cur_hd = hd;
        }
        dn_prep_unit<MASK>(F, u >> 3, hd, PR, u + F.G);
    }
}


constexpr int NSEG = 16, SEGL = 16;
#ifndef DMA_AUX_P3
#define DMA_AUX_P3 2
#endif
#ifndef DMA_AUX_P1
#define DMA_AUX_P1 0
#endif
#ifndef DMA_AUX_FOLD
#define DMA_AUX_FOLD 0
#endif
constexpr size_t WS_PF = 176 * MiB, WS_RG = 184 * MiB, WS_SIN = 24 * MiB;
constexpr int SLOT1 = 49152, SLOT3 = 73728, L_GLS = 147456;
#define DN_WAIT(V) asm volatile("s_waitcnt vmcnt(" #V ") lgkmcnt(0)" ::: "memory")
#define DN_BAR() do { __builtin_amdgcn_s_barrier(); asm volatile("" ::: "memory"); } while (0)
__device__ __forceinline__ int seg_chunk(int dir, int g, int i) { const int n = SEGL * g + i; return dir ? 255 - n : n; }
__device__ __forceinline__ void u_to_acc(f32x16& a, const LAS unsigned char* up) {
    const v4u u0 = *(const LAS v4u*)up, u1 = *(const LAS v4u*)(up + 16);
#pragma unroll
    for (int i = 0; i < 4; ++i) { a[2 * i] = bflo(u0[i]); a[2 * i + 1] = bfhi(u0[i]); a[8 + 2 * i] = bflo(u1[i]); a[8 + 2 * i + 1] = bfhi(u1[i]); }
}
template <bool OUT>
__device__ __forceinline__ void dn_step(f32x16 (&S)[4], f32x16 (&aV)[2], f32x16 (&aO)[2], const LAS unsigned char* buf, float gl) {
#pragma unroll
    for (int t = 0; t < 8; ++t) { const bf16x8 sb = cvt8(S[t >> 1], 8 * (t & 1));
#pragma unroll
        for (int mt = 0; mt < 2; ++mt) {
            aV[mt] = __builtin_amdgcn_mfma_f32_32x32x16_bf16(*(const LAS bf16x8*)(buf + DX_W + (mt * 8 + t) * 1024), sb, aV[mt], 0, 0, 0);
            if (OUT) aO[mt] = __builtin_amdgcn_mfma_f32_32x32x16_bf16(*(const LAS bf16x8*)(buf + DX_Q + (mt * 8 + t) * 1024), sb, aO[mt], 0, 0, 0); } }
    bf16x8 vb[4];
#pragma unroll
    for (int t = 0; t < 4; ++t) vb[t] = cvt8(aV[t >> 1], 8 * (t & 1));
#pragma unroll
    for (int m = 0; m < 4; ++m) S[m] = S[m] * gl;
#pragma unroll
    for (int t = 0; t < 4; ++t) {
#pragma unroll
        for (int m = 0; m < 4; ++m) S[m] = __builtin_amdgcn_mfma_f32_32x32x16_bf16(*(const LAS bf16x8*)(buf + DX_K + (m * 4 + t) * 1024), vb[t], S[m], 0, 0, 0);
        if (OUT) {
#pragma unroll
            for (int mt = 0; mt < 2; ++mt) aO[mt] = __builtin_amdgcn_mfma_f32_32x32x16_bf16(*(const LAS bf16x8*)(buf + DX_A + (mt * 4 + t) * 1024), vb[t], aO[mt], 0, 0, 0); } }
}

__device__ __forceinline__ void dn_pass1(Frame& F) {
    LAS unsigned char* lds = F.lds; const int lane = F.lane, wave = F.wave, r = lane & 31, lh = lane >> 5, part = wave >> 2, d = wave & 3;
    LAS float* gls = (LAS float*)(lds + L_GLS);
    for (int unit = blockIdx.x; unit < 16 * NSEG; unit += F.G) {
        const int dir = unit >> 7, hd = (unit >> 4) & 7, g = unit & 15;
        DN_WAIT(0); __syncthreads();
        if (F.tid < SEGL) gls[F.tid] = WSP(float, WS_GL)[(dir * 8 + hd) * 256 + seg_chunk(dir, g, F.tid)];
        DN_WAIT(0);
        f32x16 S[4];
#pragma unroll
        for (int m = 0; m < 4; ++m)
#pragma unroll
            for (int i = 0; i < 16; ++i) S[m][i] = (part && (32 * m + (i & 3) + 8 * (i >> 2) + 4 * lh == 32 * d + r)) ? 1.f : 0.f;
#define P1_ISSUE(i) do { const unsigned char* src_ = dnx_rec(F, dir, hd, seg_chunk(dir, g, (i))) + lane * 16; LAS unsigned char* dst_ = lds + ((i) % 3) * SLOT1; \
            _Pragma("unroll") for (int k_ = 0; k_ < 6; ++k_) { const int p_ = wave + 8 * k_; __builtin_amdgcn_global_load_lds((const unsigned*)(src_ + p_ * 1024), (LAS unsigned*)(dst_ + p_ * 1024), 16, 0, DMA_AUX_P1); } } while (0)
        P1_ISSUE(0); P1_ISSUE(1);
        for (int i = 0; i < SEGL; ++i) {
            if (i + 1 < SEGL) DN_WAIT(6); else DN_WAIT(0);
            DN_BAR();
            if (i + 2 < SEGL) P1_ISSUE(i + 2);
            const LAS unsigned char* buf = lds + (i % 3) * SLOT1 + lane * 16;
            f32x16 aV[2], aO[2];
#pragma unroll
            for (int mt = 0; mt < 2; ++mt) {
                if (part == 0) u_to_acc(aV[mt], lds + (i % 3) * SLOT1 + DX_U + ((d * 2 + mt) * 64 + lane) * 32);
                else {
#pragma unroll
                    for (int e = 0; e < 16; ++e) aV[mt][e] = 0.f; } }
            dn_step<false>(S, aV, aO, buf, gls[i]);
        }
#undef P1_ISSUE
        DN_WAIT(0); DN_BAR();
        if (part == 0) {
            float* rg = (float*)(F.ws + WS_RG) + (size_t)unit * 16384;
#pragma unroll
            for (int m = 0; m < 4; ++m)
#pragma unroll
                for (int q = 0; q < 4; ++q) *(f32x4*)(rg + ((d * 4 + m) * 64 + lane) * 16 + 4 * q) = (f32x4){S[m][4 * q], S[m][4 * q + 1], S[m][4 * q + 2], S[m][4 * q + 3]};
        } else {
#pragma unroll
            for (int m = 0; m < 4; ++m)
#pragma unroll
                for (int i = 0; i < 16; ++i) *(LAS unsigned short*)(lds + (32 * m + (i & 3) + 8 * (i >> 2) + 4 * lh) * 272 + (32 * d + r) * 2) = (unsigned short)f2bf(S[m][i]);
        }
        DN_WAIT(0); DN_BAR();
        if (part == 1) {
            unsigned char* pf = F.ws + WS_PF + (size_t)unit * 32768;
#pragma unroll
            for (int k = 0; k < 8; ++k) { const int f = d * 8 + k, m = f >> 3, t = f & 7;
                const v2u a = *(const LAS v2u*)(lds + (32 * m + r) * 272 + (16 * t + 4 * lh) * 2), b = *(const LAS v2u*)(lds + (32 * m + r) * 272 + (16 * t + 8 + 4 * lh) * 2);
                *(v4u*)(pf + (f * 64 + lane) * 16) = (v4u){a.x, a.y, b.x, b.y}; }
        }
    }
}
constexpr int FOLD_SLOT = 49152, NFOLD = 64;
__device__ __forceinline__ void dn_fold(Frame& F) {
    const int b = blockIdx.x; if (b >= NFOLD) return;
    LAS unsigned char* lds = F.lds; const int lane = F.lane, wave = F.wave, dir = b >> 5, hd = (b >> 2) & 7, d = b & 3;
    const int unit0 = (dir * 8 + hd) * 16;
    const unsigned char* pf0 = F.ws + WS_PF + (size_t)unit0 * 32768; const unsigned char* rg0 = F.ws + WS_RG + (size_t)unit0 * 65536 + d * 16384;
    float* sin0 = (float*)(F.ws + WS_SIN) + (size_t)unit0 * 16384 + d * 4096;
    DN_WAIT(0); __syncthreads();
    const bool loader = (wave >= 1 && wave <= 6);
#define FOLD_ISSUE(g) do { if (loader) { LAS unsigned char* dst_ = lds + ((g) % 3) * FOLD_SLOT; const unsigned char* ps_ = pf0 + (size_t)(g) * 32768 + lane * 16; const unsigned char* rs_ = rg0 + (size_t)(g) * 65536 + lane * 16; \
        _Pragma("unroll") for (int k_ = 0; k_ < 8; ++k_) { const int p_ = (wave - 1) + 6 * k_; \
            if (p_ < 32) __builtin_amdgcn_global_load_lds((const unsigned*)(ps_ + p_ * 1024), (LAS unsigned*)(dst_ + p_ * 1024), 16, 0, DMA_AUX_FOLD); \
            else __builtin_amdgcn_global_load_lds((const unsigned*)(rs_ + (p_ - 32) * 1024), (LAS unsigned*)(dst_ + p_ * 1024), 16, 0, DMA_AUX_FOLD); } } } while (0)
    f32x16 S[4];
#pragma unroll
    for (int m = 0; m < 4; ++m)
#pragma unroll
        for (int i = 0; i < 16; ++i) S[m][i] = 0.f;
    FOLD_ISSUE(0); FOLD_ISSUE(1);
    for (int g = 0; g < NSEG - 1; ++g) {
        if (g + 1 < NSEG - 1) DN_WAIT(8); else DN_WAIT(0);
        DN_BAR();
        if (g + 2 < NSEG - 1) FOLD_ISSUE(g + 2);
        if (wave == 0) {
            float* so = sin0 + (size_t)g * 16384;
#pragma unroll
            for (int m = 0; m < 4; ++m)
#pragma unroll
                for (int q = 0; q < 4; ++q) *(f32x4*)(so + (m * 64 + lane) * 16 + 4 * q) = (f32x4){S[m][4 * q], S[m][4 * q + 1], S[m][4 * q + 2], S[m][4 * q + 3]};
            const LAS unsigned char* slot = lds + (g % 3) * FOLD_SLOT;
            bf16x8 sb[8];
#pragma unroll
            for (int t = 0; t < 8; ++t) sb[t] = cvt8(S[t >> 1], 8 * (t & 1));
#pragma unroll
            for (int m = 0; m < 4; ++m) {
#pragma unroll
                for (int q = 0; q < 4; ++q) { const f32x4 v = *(const LAS f32x4*)(slot + 32768 + (m * 64 + lane) * 64 + q * 16); S[m][4 * q] = v[0]; S[m][4 * q + 1] = v[1]; S[m][4 * q + 2] = v[2]; S[m][4 * q + 3] = v[3]; }
#pragma unroll
                for (int t = 0; t < 8; ++t) S[m] = __builtin_amdgcn_mfma_f32_32x32x16_bf16(*(const LAS bf16x8*)(slot + lane * 16 + (m * 8 + t) * 1024), sb[t], S[m], 0, 0, 0); }
        }
    }
#undef FOLD_ISSUE
    if (wave == 0) {
        float* so = sin0 + (size_t)(NSEG - 1) * 16384;
#pragma unroll
        for (int m = 0; m < 4; ++m)
#pragma unroll
            for (int q = 0; q < 4; ++q) *(f32x4*)(so + (m * 64 + lane) * 16 + 4 * q) = (f32x4){S[m][4 * q], S[m][4 * q + 1], S[m][4 * q + 2], S[m][4 * q + 3]};
    }
    DN_WAIT(0); __syncthreads();
    if (F.tid == 0) __hip_atomic_fetch_add((unsigned*)(F.ctl + CW_FOLDDONE), 1u, __ATOMIC_RELAXED, __HIP_MEMORY_SCOPE_AGENT);
}
__device__ __forceinline__ void dn_pass3(Frame& F) {
    LAS unsigned char* lds = F.lds; const int lane = F.lane, wave = F.wave, r = lane & 31, lh = lane >> 5;
    LAS float* gls = (LAS float*)(lds + L_GLS);
    const int nb3 = F.G >= 2 ? (F.G >> 1) : 1;
    if ((int)blockIdx.x >= nb3) return;
    for (int unit = blockIdx.x; unit < 16 * NSEG; unit += nb3) {
        const int dir = unit >> 7, hd = (unit >> 4) & 7, g = unit & 15;
        __syncthreads();
        if (F.tid < SEGL) gls[F.tid] = WSP(float, WS_GL)[(dir * 8 + hd) * 256 + seg_chunk(dir, g, F.tid)];
        asm volatile("s_waitcnt lgkmcnt(0)" ::: "memory");
        if (wave >= 4) {
            const int lw = wave - 4;
            for (int i = 0; i <= SEGL; ++i) {
                if (i < SEGL) { const unsigned char* src = dnx_rec(F, dir, hd, seg_chunk(dir, g, i)) + lane * 16; LAS unsigned char* dst = lds + (i & 1) * SLOT3;
#pragma unroll
                    for (int k = 0; k < 18; ++k) { const int p = lw + 4 * k; __builtin_amdgcn_global_load_lds((const unsigned*)(src + p * 1024), (LAS unsigned*)(dst + p * 1024), 16, 0, DMA_AUX_P3); } }
                DN_WAIT(0); DN_BAR();
            }
        } else {
            const int d = wave;
            f32x16 S[4];
            const float* si = (const float*)(F.ws + WS_SIN) + (size_t)unit * 16384;
#pragma unroll
            for (int m = 0; m < 4; ++m)
#pragma unroll
                for (int q = 0; q < 4; ++q) { const f32x4 v = *(const f32x4*)(si + ((d * 4 + m) * 64 + lane) * 16 + 4 * q); S[m][4 * q] = v[0]; S[m][4 * q + 1] = v[1]; S[m][4 * q + 2] = v[2]; S[m][4 * q + 3] = v[3]; }
            bf16* O = dir ? WSP(bf16, WS_OB) : WSP(bf16, WS_YMIX); const int opitch = dir ? 1024 : DM;
            DN_BAR();
            for (int i = 0; i < SEGL; ++i) {
                const int cn = seg_chunk(dir, g, i); const LAS unsigned char* slot = lds + (i & 1) * SLOT3;
                f32x16 aV[2], aO[2];
#pragma unroll
                for (int mt = 0; mt < 2; ++mt) { u_to_acc(aV[mt], slot + DX_U + ((d * 2 + mt) * 64 + lane) * 32);
#pragma unroll
                    for (int e = 0; e < 16; ++e) aO[mt][e] = 0.f; }
                dn_step<true>(S, aV, aO, slot + lane * 16, gls[i]);
                {
                    LAS unsigned char* stg = (LAS unsigned char*)slot + DX_U + d * 4096;
#pragma unroll
                    for (int mt = 0; mt < 2; ++mt)
#pragma unroll
                        for (int e = 0; e < 16; e += 2) { const unsigned w = cvtpk(aO[mt][e], aO[mt][e + 1]);
                            *(LAS unsigned short*)(stg + (32 * mt + (e & 3) + 8 * (e >> 2) + 4 * lh) * 64 + r * 2) = (unsigned short)w;
                            *(LAS unsigned short*)(stg + (32 * mt + ((e + 1) & 3) + 8 * (e >> 2) + 4 * lh) * 64 + r * 2) = (unsigned short)(w >> 16); }
                    asm volatile("s_waitcnt lgkmcnt(0)" ::: "memory");
                    bf16* ob = O + (size_t)(64 * cn) * opitch + hd * 128 + 32 * d;
#pragma unroll
                    for (int k = 0; k < 4; ++k) { const int pc = lane + 64 * k, row = pc >> 2, c4 = pc & 3;
                        *(v4u*)(ob + (size_t)row * opitch + c4 * 8) = *(const LAS v4u*)(stg + row * 64 + c4 * 16); }
                }
                asm volatile("s_waitcnt lgkmcnt(0)" ::: "memory");
                DN_BAR();
            }
        }
    }
    __syncthreads();
}

#ifndef MK_N_LAUNCHES
#define MK_N_LAUNCHES 1
#endif
constexpr int N_PHASES = 14;
struct Args { const float* in[23]; float* out; unsigned char* ws; int ph_lo, ph_hi; };
static_assert(sizeof(Args) == 23 * 8 + 8 + 8 + 8, "Args has no padding");

__global__ void __launch_bounds__(NWAVES * 64, 2) enc_fwd(Args args) {
    extern __shared__ __attribute__((aligned(16))) unsigned char lds[];
    Frame F;
    F.lds = (LAS unsigned char*)lds;
    F.MISC = (volatile LAS unsigned*)(F.lds + MISC_OFF);
    F.tid = threadIdx.x; F.lane = F.tid & 63; F.wave = __builtin_amdgcn_readfirstlane(F.tid >> 6);
    F.G = gridDim.x; { const int bx = blockIdx.x; F.vcu = (F.G % 8 == 0) ? (bx % 8) * (F.G / 8) + bx / 8 : bx; }
#pragma unroll
    for (int i = 0; i < 23; ++i) F.in[i] = args.in[i];
    F.out = args.out; F.ws = args.ws; F.ctl = (gu32*)(args.ws + WS_CTL);
    for (int u = F.tid; u < (LDS_BYTES - LDSCTL_OFF) / 4; u += NWAVES * 64) ((LAS unsigned*)(F.lds + LDSCTL_OFF))[u] = 0u;
    __syncthreads();
    const int lo = args.ph_lo, hi = args.ph_hi;
    XcdBarrier bar; bar.bar = (unsigned*)(F.ctl + CW_BAR); bar.x = 0; bar.st = nullptr;
    if (hi - lo > 1) bar = xcd_barrier_post((unsigned*)(F.ctl + CW_BAR), F.MISC + 8);
#define IN(k) (lo <= (k) && (k) < hi)
#ifdef TS_IDX
#ifndef TS_OFFSET
#define TS_OFFSET 0
#endif
    unsigned long long ts_a = 0, ts_b = 0; int tsi = 0;
#define TSP() do { const unsigned long long now_ = __builtin_amdgcn_s_memrealtime(); if (tsi == TS_IDX || (TS_IDX == 100 && tsi == 0)) ts_a = now_; if (tsi == TS_IDX + 1 || TS_IDX == 100) ts_b = now_; ++tsi; } while (0)
#else
#define TSP() do { } while (0)
#endif
#define SEAM(k) do { if (IN(k) && IN((k) + 1)) xcd_barrier(bar); TSP(); } while (0)
    TSP();
    float* sumsq2 = (float*)(F.ws + WS_CTL + CTL_SUMSQ2); float* sumsq3 = (float*)(F.ws + WS_CTL + CTL_SUMSQ3); float* sumsq4 = (float*)(F.ws + WS_CTL + CTL_SUMSQ4);

    if (IN(0)) { p0_prologue(F);
#if defined(REPEAT_PHASE) && REPEAT_PHASE == 0
        p0_prologue(F);
#endif
    } SEAM(0);
    if (IN(1)) {
        { pg8::Gemm g{WSP(bf16, WS_XB), WSP(bf16, WS_WIN), SEQ, NINP, DM}; pg8::StaticOrder S; S.init(SEQ, NINP, F.G, (int)blockIdx.x);
          EpiProj E{WSP(float, WS_RSTD1), WSP(bf16, WS_QKV), DOP(bf16, DO_Z), DOP(bf16, DO_QSW), DOP(bf16, DO_KVSW), WSP(float, WS_AB)};
          pg8::gemm_phase<EpiProj, pg8::StaticOrder, true, true>(F.lds + RING_OFF, g, S, E);
#if defined(REPEAT_PHASE) && REPEAT_PHASE == 1
          pg8::gemm_phase<EpiProj, pg8::StaticOrder, true, true>(F.lds + RING_OFF, g, S, E);
#endif
          }
        { const int nwg = (SEQ / 256) * (NINP / 256), rem = nwg % F.G; if (rem) p1_late_transposes(F, rem, F.G - rem); else p1_late_transposes(F, 0, F.G); }
    } SEAM(1);
    if (IN(2)) { dn_prep_phase<63>(F);
#if defined(REPEAT_PHASE) && REPEAT_PHASE == 2
        dn_prep_phase<63>(F);
#endif
#if defined(REPEAT_PHASE) && REPEAT_PHASE >= 1000 && REPEAT_PHASE < 1064
        dn_prep_phase<REPEAT_PHASE - 1000>(F);
#endif
    } SEAM(2);
    if (IN(3)) { dn_pass1(F);
#if defined(REPEAT_PHASE) && REPEAT_PHASE == 3
        dn_pass1(F);
#endif
    } SEAM(3);
    if (IN(12)) { dn_fold(F); }
#if defined(REPEAT_PHASE) && REPEAT_PHASE == 12
    if (IN(12)) { dn_fold(F); swa_phase(F, 1, F.G < NFOLD ? F.G : NFOLD); }
#endif
#if defined(REPEAT_PHASE) && REPEAT_PHASE == 112
    if (IN(12)) { dn_fold(F); }
#endif
#if defined(REPEAT_PHASE) && REPEAT_PHASE == 212
    if (IN(12)) { swa_phase(F, 0, F.G); }
#endif
    if (IN(12) && IN(13)) xcd_barrier(bar);
    TSP();
#ifdef P13_SPLIT
    if (IN(13)) { dn_pass3(F); xcd_barrier(bar); TSP(); swa_phase(F, 0, 0);
#else
    if (IN(13)) { dn_pass3(F); swa_phase(F, 0, 0);
#endif
#if defined(REPEAT_PHASE) && REPEAT_PHASE == 13
        dn_pass3(F);
#endif
    } if (IN(13) && IN(4)) xcd_barrier(bar);
    TSP();
    if (IN(4)) { dn_combine(F);
#if defined(REPEAT_PHASE) && REPEAT_PHASE == 4
        dn_combine(F);
#endif
    } SEAM(4);
    if (IN(5)) {
        pg8::Gemm g{WSP(bf16, WS_YMIX), WSP(bf16, WS_WOUT), SEQ, DM, DM}; pg8::StaticOrder S; S.init(SEQ, DM, F.G, (int)blockIdx.x);
        EpiRes E{nullptr, WSP(bf16, WS_XB), nullptr, WSP(bf16, WS_H1B), sumsq2, (LAS float*)(F.lds + RING_BYTES)};
        pg8::gemm_phase<EpiRes, pg8::StaticOrder, true, true>(F.lds + RING_OFF, g, S, E);
#if defined(REPEAT_PHASE) && REPEAT_PHASE == 5
        { EpiRes E2{nullptr, WSP(bf16, WS_XB), nullptr, nullptr, (float*)(F.ws + WS_CTL + 448 * 1024), (LAS float*)(F.lds + RING_BYTES)}; pg8::gemm_phase<EpiRes, pg8::StaticOrder, true, true>(F.lds + RING_OFF, g, S, E2); }
#endif
    } SEAM(5);
    if (IN(6)) {
        pg8::Gemm g{WSP(bf16, WS_H1B), WSP(bf16, WS_WQ), SEQ, 512, DM}; pg8::StaticOrder S; S.init(SEQ, 512, F.G, (int)blockIdx.x);
        EpiScaleBf16 E{sumsq2, 1, QSCALE, WSP(bf16, WS_QM), 512};
        pg8::gemm_phase<EpiScaleBf16, pg8::StaticOrder, true, true>(F.lds + RING_OFF, g, S, E);
        { pg8::Gemm g2{WSP(bf16, WS_MEMB), WSP(bf16, WS_WKV), MEMT, 1024, DM}; pg8::StaticOrder S2; S2.init(MEMT, 1024, F.G, (int)((blockIdx.x + F.G - (F.G >> 1)) % F.G));
          EpiScaleBf16 E2{WSP(float, WS_RSTDM), 0, 1.0f, WSP(bf16, WS_KVM), 1024};
          pg8::gemm_phase<EpiScaleBf16, pg8::StaticOrder, true, true>(F.lds + RING_OFF, g2, S2, E2); }
#ifdef TRQ_SPLIT
        p4_transposes(F, (F.G >> 1) + 4 < F.G ? (F.G >> 1) + 4 : 0, F.G);
#else
        p4_transposes(F, 0, F.G);
#endif
#if defined(REPEAT_PHASE) && REPEAT_PHASE == 6
        pg8::gemm_phase<EpiScaleBf16, pg8::StaticOrder, true, true>(F.lds + RING_OFF, g, S, E);
#endif
    } SEAM(6);
    if (IN(7)) { mem_attn_phase(F);
#ifdef TRQ_SPLIT
        p4_transposes(F, 0, F.G);
#endif
#if defined(REPEAT_PHASE) && REPEAT_PHASE == 7
        mem_attn_phase(F);
#endif
    } SEAM(7);
    if (IN(8)) {
        pg8::Gemm g{WSP(bf16, WS_OM), WSP(bf16, WS_WO), SEQ, DM, 512}; pg8::StaticOrder S; S.init(SEQ, DM, F.G, (int)blockIdx.x);
        EpiRes E{nullptr, WSP(bf16, WS_H1B), nullptr, WSP(bf16, WS_XB), sumsq3, (LAS float*)(F.lds + RING_BYTES)};
        pg8::gemm_phase<EpiRes, pg8::StaticOrder, true, true>(F.lds + RING_OFF, g, S, E);
#if defined(REPEAT_PHASE) && REPEAT_PHASE == 8
        { EpiRes E2{nullptr, WSP(bf16, WS_H1B), nullptr, nullptr, (float*)(F.ws + WS_CTL + 448 * 1024), (LAS float*)(F.lds + RING_BYTES)}; pg8::gemm_phase<EpiRes, pg8::StaticOrder, true, true>(F.lds + RING_OFF, g, S, E2); }
#endif
    } SEAM(8);
    if (IN(9)) {
        pg8::Gemm g{WSP(bf16, WS_XB), DOP(bf16, DO_WGU), SEQ, 2 * DFF, DM}; pg8::StaticOrder S; S.init(SEQ, 2 * DFF, F.G, (int)blockIdx.x);
        EpiSwiglu E{sumsq3, WSP(bf16, WS_HID)};
        pg8::gemm_phase<EpiSwiglu, pg8::StaticOrder, true, true>(F.lds + RING_OFF, g, S, E);
#if defined(REPEAT_PHASE) && REPEAT_PHASE == 9
        pg8::gemm_phase<EpiSwiglu, pg8::StaticOrder, true, true>(F.lds + RING_OFF, g, S, E);
#endif
    } SEAM(9);
    if (IN(10)) {
        pg8::Gemm g{WSP(bf16, WS_HID), WSP(bf16, WS_WD), SEQ, DM, DFF}; pg8::StaticOrder S; S.init(SEQ, DM, F.G, (int)blockIdx.x);
        EpiRes E{nullptr, WSP(bf16, WS_XB), nullptr, WSP(bf16, WS_H3B), sumsq4, (LAS float*)(F.lds + RING_BYTES)};
        pg8::gemm_phase<EpiRes, pg8::StaticOrder, true, true>(F.lds + RING_OFF, g, S, E);
#if defined(REPEAT_PHASE) && REPEAT_PHASE == 10
        { EpiRes E2{nullptr, WSP(bf16, WS_XB), nullptr, nullptr, (float*)(F.ws + WS_CTL + 448 * 1024), (LAS float*)(F.lds + RING_BYTES)}; pg8::gemm_phase<EpiRes, pg8::StaticOrder, true, true>(F.lds + RING_OFF, g, S, E2); }
#endif
    } SEAM(10);
#if defined(REPEAT_PHASE) && REPEAT_PHASE == 99
    for (int k_ = 0; k_ < 10; ++k_) xcd_barrier(bar);
#endif
    if (IN(11)) { final_norm(F);
#if defined(REPEAT_PHASE) && REPEAT_PHASE == 11
        final_norm(F);
#endif
    }
    TSP();
#ifdef TS_IDX
    __syncthreads();
    if (blockIdx.x == 0 && F.tid == 0) F.out[0] += ((float)(ts_b - ts_a) - (float)(TS_OFFSET)) * TS_SCALE;
#endif
#undef IN
#undef SEAM
}

extern "C" void kernel_launch(void* const* d_in, const int* in_sizes, int n_in, void* d_out, int out_size, void* d_ws, size_t ws_size, hipStream_t stream) {
    static int grid = 0;
    if (grid == 0) {
        if (n_in != 23 || out_size != SEQ * DM || ws_size < WS_END) { fprintf(stderr, "kernel_launch: unexpected shapes (n_in %d out %d ws %zu)\n", n_in, out_size, ws_size); grid = -1; return; }
        int dev = 0, cus = 0;
        if (hipGetDevice(&dev) != hipSuccess || hipDeviceGetAttribute(&cus, hipDeviceAttributeMultiprocessorCount, dev) != hipSuccess) { grid = -1; return; }
        if (hipFuncSetAttribute((const void*)enc_fwd, hipFuncAttributeMaxDynamicSharedMemorySize, LDS_BYTES) != hipSuccess) { fprintf(stderr, "kernel_launch: hipFuncSetAttribute failed\n"); grid = -1; return; }
        int per_cu = 0;
        if (hipOccupancyMaxActiveBlocksPerMultiprocessor(&per_cu, enc_fwd, NWAVES * 64, LDS_BYTES) != hipSuccess || per_cu < 1) { fprintf(stderr, "kernel_launch: occupancy query says %d workgroups per CU\n", per_cu); grid = -1; return; }
        (void)hipGetLastError();
        grid = cus;
    }
    if (grid < 0) return;
    if (hipMemsetAsync((char*)d_ws + WS_CTL, 0, CTL_ZERO_BYTES, stream) != hipSuccess) return;
    Args a{};
    for (int i = 0; i < 23; ++i) a.in[i] = (const float*)d_in[i];
    a.out = (float*)d_out; a.ws = (unsigned char*)d_ws;
    const int per = (N_PHASES + MK_N_LAUNCHES - 1) / MK_N_LAUNCHES;
    for (int lo = 0; lo < N_PHASES; lo += per) {
        a.ph_lo = lo; a.ph_hi = (lo + per < N_PHASES) ? lo + per : N_PHASES;
        hipLaunchKernelGGL(enc_fwd, dim3(grid), dim3(NWAVES * 64), LDS_BYTES, stream, a);
    }
}
```
